# Optimizing an MI355X kernel written in HIP

```python
import jax
import jax.numpy as jnp
from jax import lax
import numpy as np

D_MODEL = 1024
BATCH = 4
SEQ = 4096
DEPTH = 4

N_GROUPS = 4
GROUP = D_MODEL // N_GROUPS
CHUNK = 64

HGRN_HEADS = 4
GLA_HEADS = 4
GLA_KEY = GROUP // (2 * GLA_HEADS)
GLA_GATE_RANK = 16
GLA_GATE_NORM = 16.0
RWKV_HEADS = 4
RWKV_HEAD = GROUP // RWKV_HEADS
RWKV_DECAY_RANK = 64
RWKV_A_RANK = 64
RWKV_V_RANK = 32
RWKV_GATE_RANK = 160
RWKV_LNX_EPS = 64e-5
RET_HEADS = 4
RET_KEY = GROUP // RET_HEADS
ROPE_BASE = 10000.0

HGRN_COLS = (GROUP, GROUP, GROUP, GROUP)
GLA_COLS = (GLA_HEADS * GLA_KEY, GLA_HEADS * GLA_KEY, GROUP, GLA_GATE_RANK, GROUP)
RWKV_COLS = (GROUP, GROUP, GROUP, RWKV_DECAY_RANK, RWKV_A_RANK, RWKV_GATE_RANK)
RET_COLS = (GROUP, GROUP, GROUP, GROUP)
MIXER_COLS = (sum(HGRN_COLS), sum(GLA_COLS), sum(RWKV_COLS), sum(RET_COLS))
IN_COLS = sum(MIXER_COLS)

FFN_DENSE = 2816
N_EXPERTS = 8
TOP_K = 2
FFN_EXPERT = 1408
N_DENSE = (DEPTH + 1) // 2
N_MOE = DEPTH // 2

DN_ALPHA = (2.0 * DEPTH) ** 0.25
DN_BETA = (8.0 * DEPTH) ** -0.25
LN_EPS = 1e-5
F32 = jnp.float32

kernel_name = 'hybrid_hgrn2_gla_rwkv7_retnet_moe'


def _split(p, sizes):
    return jnp.split(p, np.cumsum(sizes)[:-1].tolist(), axis=-1)


def _heads(t, n):
    return t.reshape(t.shape[:-1] + (n, t.shape[-1] // n))


def _merge(t):
    return t.reshape(t.shape[:-2] + (t.shape[-2] * t.shape[-1],))


def _layer_norm(x, g, b):
    x = x.astype(F32)
    mu = jnp.mean(x, -1, keepdims=True)
    var = jnp.mean(jnp.square(x - mu), -1, keepdims=True)
    return (x - mu) * lax.rsqrt(var + LN_EPS) * g + b


def _rms_norm(x, g, eps=1e-6):
    return x * lax.rsqrt(jnp.mean(jnp.square(x), -1, keepdims=True) + eps) * g


def _group_norm(x, eps):
    mu = jnp.mean(x, -1, keepdims=True)
    var = jnp.mean(jnp.square(x - mu), -1, keepdims=True)
    return (x - mu) * lax.rsqrt(var + eps)


def _to_chunks(t):
    b, s, h, d = t.shape
    return t.reshape(b, s // CHUNK, CHUNK, h, d).transpose(1, 0, 3, 2, 4)


def _from_chunks(t):
    n, b, h, c, d = t.shape
    return t.transpose(1, 0, 3, 2, 4).reshape(b, n * c, h, d)


def _chunked_gated_linear(q, k, v, log_f):
    b, _, h, kd = q.shape
    vd = v.shape[-1]
    qc, kc, vc, gc = (_to_chunks(t.astype(F32)) for t in (q, k, v, log_f))
    causal = jnp.tril(jnp.ones((CHUNK, CHUNK), dtype=bool))

    def step(state, inp):
        qi, ki, vi, gi = inp
        cum = jnp.cumsum(gi, axis=2)
        diff = cum[:, :, :, None, :] - cum[:, :, None, :, :]
        decay = jnp.exp(jnp.where(causal[:, :, None], diff, -jnp.inf))
        scores = jnp.einsum('bhik,bhjk,bhijk->bhij', qi, ki, decay)
        out = (jnp.einsum('bhij,bhjv->bhiv', scores, vi)
               + jnp.einsum('bhik,bhkv->bhiv', qi * jnp.exp(cum), state))
        cum_end = cum[:, :, -1:, :]
        state = (jnp.exp(cum_end[:, :, 0, :])[..., None] * state
                 + jnp.einsum('bhjk,bhjv->bhkv', ki * jnp.exp(cum_end - cum), vi))
        return state, out

    _, o = lax.scan(step, jnp.zeros((b, h, kd, vd), F32), (qc, kc, vc, gc))
    return _from_chunks(o)


def _retention_chunkwise(q, k, v, log_gamma):
    b, _, h, kd = q.shape
    vd = v.shape[-1]
    qc, kc, vc = (_to_chunks(t.astype(F32)) for t in (q, k, v))
    idx = jnp.arange(CHUNK, dtype=F32)
    rel = idx[:, None] - idx[None, :]
    intra = jnp.exp(jnp.where(rel >= 0, rel * log_gamma[:, None, None], -jnp.inf))
    q_dec = jnp.exp((idx + 1.0)[None, :] * log_gamma[:, None])
    k_dec = jnp.exp((CHUNK - 1.0 - idx)[None, :] * log_gamma[:, None])
    c_dec = jnp.exp(CHUNK * log_gamma)

    def step(state, inp):
        qi, ki, vi = inp
        scores = jnp.einsum('bhik,bhjk->bhij', qi, ki) * intra
        out = (jnp.einsum('bhij,bhjv->bhiv', scores, vi)
               + jnp.einsum('bhik,bhkv->bhiv', qi * q_dec[..., None], state))
        state = (c_dec[:, None, None] * state
                 + jnp.einsum('bhjk,bhjv->bhkv', ki * k_dec[..., None], vi))
        return state, out

    _, o = lax.scan(step, jnp.zeros((b, h, kd, vd), F32), (qc, kc, vc))
    return _from_chunks(o)


def _rotary(t, positions):
    half = t.shape[-1] // 2
    inv_freq = ROPE_BASE ** (-jnp.arange(half, dtype=F32) / half)
    ang = positions.astype(F32)[:, :, None, None] * inv_freq
    cos, sin = jnp.cos(ang), jnp.sin(ang)
    t1, t2 = t[..., :half], t[..., half:]
    return jnp.concatenate([t1 * cos - t2 * sin, t1 * sin + t2 * cos], axis=-1)


def _rwkv7_scan(r, w, k, v, kk, a):
    b, _, h, n = r.shape
    xs = tuple(jnp.moveaxis(t, 1, 0) for t in (r, w, k, v, kk, a))

    def step(state, inp):
        rt, wt, kt, vt, kkt, at = inp
        sa = jnp.einsum('bhvk,bhk->bhv', state, -kkt)
        state = (state * wt[:, :, None, :]
                 + sa[..., None] * (kkt * at)[:, :, None, :]
                 + vt[..., None] * kt[:, :, None, :])
        return state, jnp.einsum('bhvk,bhk->bhv', state, rt)

    _, o = lax.scan(step, jnp.zeros((b, h, n, n), F32), xs)
    return jnp.moveaxis(o, 0, 1)


def _hgrn2_mixer(p, lb, norm_g):
    q_raw, f_raw, i_raw, g_raw = _split(p, HGRN_COLS)
    f = lb + (1.0 - lb) * jax.nn.sigmoid(f_raw)
    hd = lambda t: _heads(t, HGRN_HEADS)
    o = _chunked_gated_linear(hd(jax.nn.silu(q_raw)), hd(1.0 - f), hd(i_raw), hd(jnp.log(f)))
    o = _rms_norm(o, norm_g) * jax.nn.silu(hd(g_raw))
    return _merge(o)


def _gla_mixer(p, gate_w2, gate_b, norm_g):
    q, k, v, g_lr, r = _split(p, GLA_COLS)
    log_f = jax.nn.log_sigmoid(g_lr @ gate_w2 + gate_b) / GLA_GATE_NORM
    hd = lambda t: _heads(t, GLA_HEADS)
    o = _chunked_gated_linear(hd(q) * GLA_KEY ** -0.5, hd(k), hd(v), hd(log_f))
    o = _rms_norm(o, norm_g) * jax.nn.silu(hd(r))
    return _merge(o)


def _rwkv7_mixer(p, v_first, v_mix, mu, w0, w2, a0, a2, g2, k_k, k_a, r_k, lnx_g, lnx_b):
    p_prev = jnp.pad(p, ((0, 0), (1, 0), (0, 0)))[:, :-1]
    p = p + (p_prev - p) * mu
    r, k, v, w_lr, a_lr, g_lr = _split(p, RWKV_COLS)
    w = -jax.nn.softplus(-(w0 + jnp.tanh(w_lr) @ w2)) - 0.5
    decay = jnp.exp(-jnp.exp(w))
    a = jax.nn.sigmoid(a0 + a_lr @ a2)
    g = jax.nn.sigmoid(g_lr) @ g2
    if v_mix is None:
        v_first = v
    else:
        v0, v1, v2 = v_mix
        v = v + (v_first - v) * jax.nn.sigmoid(v0 + (v @ v1) @ v2)
    hd = lambda t: _heads(t, RWKV_HEADS)
    kk = hd(k * k_k)
    kk = kk / jnp.maximum(jnp.sqrt(jnp.sum(jnp.square(kk), -1, keepdims=True)), 1e-12)
    k = k * (1.0 + (a - 1.0) * k_a)
    rh, kh, vh = hd(r), hd(k), hd(v)
    o = _rwkv7_scan(rh, hd(decay), kh, vh, kk, hd(a))
    o = _group_norm(o, RWKV_LNX_EPS) * hd(lnx_g) + hd(lnx_b)
    o = o + jnp.sum(rh * kh * r_k, -1, keepdims=True) * vh
    return _merge(o) * g, v_first


def _retnet_mixer(p, positions, log_gamma):
    q, k, v, g = _split(p, RET_COLS)
    hd = lambda t: _heads(t, RET_HEADS)
    qh = _rotary(hd(q), positions)
    kh = _rotary(hd(k), positions) * RET_KEY ** -0.5
    o = _group_norm(_retention_chunkwise(qh, kh, hd(v), log_gamma), LN_EPS)
    return jax.nn.silu(g) * _merge(o)


def _swiglu(h, wg, wu, wd):
    return (jax.nn.silu(h @ wg) * (h @ wu)) @ wd


def _moe(h, router, wg, wu, wd):
    b, s, d = h.shape
    hf = h.reshape(b * s, d)
    probs = jax.nn.softmax((hf @ router).astype(F32), axis=-1)
    top_p, top_i = lax.top_k(probs, TOP_K)
    top_p = top_p / jnp.sum(top_p, -1, keepdims=True)
    gates = jnp.sum(jax.nn.one_hot(top_i, N_EXPERTS, dtype=F32) * top_p[..., None], axis=1)
    out = jnp.zeros_like(hf)
    for e in range(N_EXPERTS):
        out = out + gates[:, e:e + 1] * _swiglu(hf, wg[e], wu[e], wd[e])
    return out.reshape(b, s, d)


def setup_inputs(seed: int = 0) -> dict:
    key = jax.random.key(seed)
    ks = iter(jax.random.split(key, 48))

    def nrm(shape, scale):
        return scale * jax.random.normal(next(ks), shape, F32)

    D = D_MODEL
    decay_base = -6.0 + 5.0 * (jnp.arange(GROUP, dtype=F32) / (GROUP - 1)) ** 0.9
    return {
        'x': nrm((BATCH, SEQ, D), 1.0),
        'positions': jnp.broadcast_to(jnp.arange(SEQ, dtype=jnp.int32)[None, :], (BATCH, SEQ)),
        'w_in': nrm((DEPTH, D, IN_COLS), D ** -0.5),
        'w_out': nrm((DEPTH, D, D), DN_BETA * D ** -0.5),
        'ln1_g': 1.0 + nrm((DEPTH, D), 0.01),
        'ln1_b': nrm((DEPTH, D), 0.01),
        'ln2_g': 1.0 + nrm((DEPTH, D), 0.01),
        'ln2_b': nrm((DEPTH, D), 0.01),
        'hgrn_lb_logits': nrm((DEPTH, GROUP), 0.5),
        'hgrn_norm_g': 1.0 + nrm((DEPTH, GROUP // HGRN_HEADS), 0.01),
        'gla_gate_w2': nrm((DEPTH, GLA_GATE_RANK, GLA_HEADS * GLA_KEY), GLA_GATE_RANK ** -0.5),
        'gla_gate_b': nrm((DEPTH, GLA_HEADS * GLA_KEY), 0.1),
        'gla_norm_g': 1.0 + nrm((DEPTH, GROUP // GLA_HEADS), 0.01),
        'rwkv_mu': jax.random.uniform(next(ks), (DEPTH, sum(RWKV_COLS)), F32),
        'rwkv_w0': decay_base[None, :] + nrm((DEPTH, GROUP), 0.1),
        'rwkv_w2': nrm((DEPTH, RWKV_DECAY_RANK, GROUP), 0.5 * RWKV_DECAY_RANK ** -0.5),
        'rwkv_a0': nrm((DEPTH, GROUP), 0.1),
        'rwkv_a2': nrm((DEPTH, RWKV_A_RANK, GROUP), 0.5 * RWKV_A_RANK ** -0.5),
        'rwkv_g2': nrm((DEPTH, RWKV_GATE_RANK, GROUP), RWKV_GATE_RANK ** -0.5),
        'rwkv_k_k': 0.85 + nrm((DEPTH, GROUP), 0.02),
        'rwkv_k_a': 1.0 + nrm((DEPTH, GROUP), 0.02),
        'rwkv_r_k': -0.04 + nrm((DEPTH, RWKV_HEADS, RWKV_HEAD), 0.02),
        'rwkv_lnx_g': 1.0 + nrm((DEPTH, GROUP), 0.01),
        'rwkv_lnx_b': nrm((DEPTH, GROUP), 0.01),
        'rwkv_v0': 1.0 + nrm((DEPTH - 1, GROUP), 0.1),
        'rwkv_v1': nrm((DEPTH - 1, GROUP, RWKV_V_RANK), GROUP ** -0.5),
        'rwkv_v2': nrm((DEPTH - 1, RWKV_V_RANK, GROUP), 0.5 * RWKV_V_RANK ** -0.5),
        'ffn_w_gate': nrm((N_DENSE, D, FFN_DENSE), D ** -0.5),
        'ffn_w_up': nrm((N_DENSE, D, FFN_DENSE), D ** -0.5),
        'ffn_w_down': nrm((N_DENSE, FFN_DENSE, D), DN_BETA * FFN_DENSE ** -0.5),
        'moe_router': nrm((N_MOE, D, N_EXPERTS), D ** -0.5),
        'moe_w_gate': nrm((N_MOE, N_EXPERTS, D, FFN_EXPERT), D ** -0.5),
        'moe_w_up': nrm((N_MOE, N_EXPERTS, D, FFN_EXPERT), D ** -0.5),
        'moe_w_down': nrm((N_MOE, N_EXPERTS, FFN_EXPERT, D), DN_BETA * FFN_EXPERT ** -0.5),
    }


def reference(x, positions, w_in, w_out, ln1_g, ln1_b, ln2_g, ln2_b, hgrn_lb_logits, hgrn_norm_g,
              gla_gate_w2, gla_gate_b, gla_norm_g, rwkv_mu, rwkv_w0, rwkv_w2, rwkv_a0, rwkv_a2,
              rwkv_g2, rwkv_k_k, rwkv_k_a, rwkv_r_k, rwkv_lnx_g, rwkv_lnx_b, rwkv_v0, rwkv_v1,
              rwkv_v2, ffn_w_gate, ffn_w_up, ffn_w_down, moe_router, moe_w_gate, moe_w_up,
              moe_w_down):
    out_dtype = x.dtype
    h = x.astype(F32)
    lb_all = jnp.cumsum(jax.nn.softmax(hgrn_lb_logits.astype(F32), axis=0), axis=0)
    lb_all = lb_all - lb_all[:1]
    log_gamma = jnp.log(1.0 - 2.0 ** (-5.0 - jnp.arange(RET_HEADS, dtype=F32)))
    v_first = None
    for l in range(DEPTH):
        p = jnp.einsum('btd,dc->btc', h, w_in[l]).astype(F32)
        pa, pb, pc, pd = _split(p, MIXER_COLS)
        ya = _hgrn2_mixer(pa, lb_all[l], hgrn_norm_g[l])
        yb = _gla_mixer(pb, gla_gate_w2[l], gla_gate_b[l], gla_norm_g[l])
        v_mix = None if l == 0 else (rwkv_v0[l - 1], rwkv_v1[l - 1], rwkv_v2[l - 1])
        yc, v_first = _rwkv7_mixer(pc, v_first, v_mix, rwkv_mu[l], rwkv_w0[l], rwkv_w2[l],
                                   rwkv_a0[l], rwkv_a2[l], rwkv_g2[l], rwkv_k_k[l], rwkv_k_a[l],
                                   rwkv_r_k[l], rwkv_lnx_g[l], rwkv_lnx_b[l])
        yd = _retnet_mixer(pd, positions, log_gamma)
        mix = jnp.einsum('btc,cd->btd', jnp.concatenate([ya, yb, yc, yd], axis=-1), w_out[l])
        h = _layer_norm(DN_ALPHA * h + mix, ln1_g[l], ln1_b[l])
        if l % 2 == 0:
            i = l // 2
            f = _swiglu(h, ffn_w_gate[i], ffn_w_up[i], ffn_w_down[i])
        else:
            i = l // 2
            f = _moe(h, moe_router[i], moe_w_gate[i], moe_w_up[i], moe_w_down[i])
        h = _layer_norm(DN_ALPHA * h + f, ln2_g[l], ln2_b[l])
    return h.astype(out_dtype)
```

```cpp
#include <hip/hip_runtime.h>
#include <cstdio>
#include <cstdint>
#ifndef PHMASK
#define PHMASK 0x7ff
#endif
#ifndef MK_PER_PHASE
#define MK_PER_PHASE 0
#endif
namespace pg8 {
#define PG8_LAS __attribute__((address_space(3)))
typedef unsigned short bf16_t;
typedef short bf16x8 __attribute__((ext_vector_type(8)));
typedef float f32x4 __attribute__((ext_vector_type(4)));
typedef unsigned u32x4 __attribute__((ext_vector_type(4)));
constexpr int BM = 256, BK = 64, HALF = 128, HTB = HALF * BK * 2  , STAGE_BYTES = 8 * HTB, NXCD = 8, WGM = 8;

__host__ __device__ __forceinline__ int lds_byte(int r, int c) { const int st = (r >> 4) * 2 + (c >> 5), rr = r & 15, cc = c & 31, ob = rr * 64 + cc * 2; return st * 1024 + (ob ^ (((ob >> 9) & 1) << 5)); }
__host__ __device__ __forceinline__ void stage_rc(int b, int& R, int& C) { const int st = b / 1024, sb = b % 1024, swz = sb ^ (((sb >> 9) & 1) << 5); R = (st >> 1) * 16 + swz / 64; C = (st & 1) * 32 + (swz % 64) / 2; }
__host__ __device__ __forceinline__ int perm32(int rho) { const int n = rho >> 4, i = rho & 15; return 8 * (i >> 2) + 4 * n + (i & 3); }

struct Unit { int pm, pn; };
struct Gemm { const bf16_t* A; const bf16_t* Bt; int M, N, K; };

struct StaticOrder {
    int nM, nN, nwg, G, c;
    __host__ __device__ void init(int M, int N, int G_, int c_) { nM = M / BM; nN = N / BM; nwg = nM * nN; G = G_; c = c_; }
    __host__ __device__ bool next(int i, Unit& u) const {
        const long L = (long)i * G + c; if (L >= nwg) return false;
        int wgid = (int)L; { const int q = nwg / NXCD, r = nwg % NXCD, xcd = wgid % NXCD, off = wgid / NXCD; wgid = (xcd < r ? xcd * (q + 1) : r * (q + 1) + (xcd - r) * q) + off; }
        const int nig = WGM * nN, gid = wgid / nig, fm = gid * WGM, gsz = (nM - fm) < WGM ? (nM - fm) : WGM;
        u.pm = fm + ((wgid % nig) % gsz); u.pn = (wgid % nig) / gsz; return true;
    }
    __device__ __forceinline__ void a_ready(const Unit&) const {}
    __device__ __forceinline__ void done(const Unit&) const {}
};
__device__ __forceinline__ unsigned cvt_pk_bf16(float lo, float hi) { unsigned r; asm volatile("v_cvt_pk_bf16_f32 %0, %1, %2" : "=v"(r) : "v"(lo), "v"(hi)); return r; }
typedef float f32x2 __attribute__((ext_vector_type(2)));
struct EpiBf16 {
    static constexpr bool PERM = true, AFTER_DRAIN = false;
    bf16_t* O; int ldc;
    __device__ __forceinline__ void operator()(const f32x4 (&acc)[2][2][4][2], const Unit& u, int wr, int wc, int fr, int fq) const {
        const int row0 = u.pm * BM + wr * 64 + fr; const int col0 = u.pn * BM + wc * 32 + 8 * fq;
#pragma unroll
        for (int ai = 0; ai < 2; ++ai)
#pragma unroll
            for (int m = 0; m < 4; ++m) { bf16_t* rowp = O + (size_t)(row0 + ai * HALF + m * 16) * ldc + col0;
#pragma unroll
                for (int bj = 0; bj < 2; ++bj) { const f32x4 v0 = acc[ai][bj][m][0], v1 = acc[ai][bj][m][1];
                    u32x4 w; w.x = cvt_pk_bf16(v0[0], v0[1]); w.y = cvt_pk_bf16(v0[2], v0[3]); w.z = cvt_pk_bf16(v1[0], v1[1]); w.w = cvt_pk_bf16(v1[2], v1[3]);
                    *(u32x4*)(rowp + bj * HALF) = w; } }
    }
};
struct EpiF32 {
    static constexpr bool PERM = false, AFTER_DRAIN = false;
    float* C; int ldc;
    __device__ __forceinline__ void operator()(const f32x4 (&acc)[2][2][4][2], const Unit& u, int wr, int wc, int fr, int fq) const {
        const int row0 = u.pm * BM + wr * 64 + fr, col0 = u.pn * BM + wc * 32 + 4 * fq;
#pragma unroll
        for (int ai = 0; ai < 2; ++ai)
#pragma unroll
            for (int m = 0; m < 4; ++m) { float* rowp = C + (size_t)(row0 + ai * HALF + m * 16) * ldc + col0;
#pragma unroll
                for (int bj = 0; bj < 2; ++bj)
#pragma unroll
                    for (int n = 0; n < 2; ++n) *(f32x4*)(rowp + bj * HALF + n * 16) = acc[ai][bj][m][n]; }
    }
};
__device__ __forceinline__ float silu_f(float x) { return x * __builtin_amdgcn_rcpf(1.0f + __expf(-x)); }
struct EpiSwiGLU {
    static constexpr bool PERM = true, AFTER_DRAIN = false;
    bf16_t* O; int ldc; int tiles_per_group;
    __device__ __forceinline__ void operator()(const f32x4 (&acc)[2][2][4][2], const Unit& u, int wr, int wc, int fr, int fq) const {
        const int row0 = u.pm * BM + wr * 64 + fr; const int pnl = u.pn % tiles_per_group; const int col0 = pnl * HALF + wc * 32 + 8 * fq;
#pragma unroll
        for (int ai = 0; ai < 2; ++ai)
#pragma unroll
            for (int m = 0; m < 4; ++m) { bf16_t* rowp = O + (size_t)(row0 + ai * HALF + m * 16) * ldc + col0;
                float h[8];
#pragma unroll
                for (int n = 0; n < 2; ++n)
#pragma unroll
                    for (int j = 0; j < 4; ++j) h[4 * n + j] = silu_f(acc[ai][0][m][n][j]) * acc[ai][1][m][n][j];
                u32x4 w; w.x = cvt_pk_bf16(h[0], h[1]); w.y = cvt_pk_bf16(h[2], h[3]); w.z = cvt_pk_bf16(h[4], h[5]); w.w = cvt_pk_bf16(h[6], h[7]);
                *(u32x4*)rowp = w; }
    }
};
struct EpiScatter {
    static constexpr bool PERM = true, AFTER_DRAIN = false;
    bf16_t* O; const int* tab;
    const int* list;
    __device__ __forceinline__ void operator()(const f32x4 (&acc)[2][2][4][2], const Unit& u, int wr, int wc, int fr, int fq) const {
        const int e = tab[4 * u.pm + 0], lr = tab[4 * u.pm + 1], cnt = tab[4 * u.pm + 2];
        const int pnl = u.pn & 3; const int col0 = pnl * BM + wc * 32 + 8 * fq; const int* lst = list + e * 16384;
#pragma unroll
        for (int ai = 0; ai < 2; ++ai)
#pragma unroll
            for (int m = 0; m < 4; ++m) { const int r = lr + wr * 64 + fr + ai * HALF + m * 16;
                if (r < cnt) { const int slot = lst[r]; bf16_t* rowp = O + (size_t)slot * 1024 + col0;
#pragma unroll
                    for (int bj = 0; bj < 2; ++bj) { const f32x4 v0 = acc[ai][bj][m][0], v1 = acc[ai][bj][m][1];
                        u32x4 w; w.x = cvt_pk_bf16(v0[0], v0[1]); w.y = cvt_pk_bf16(v0[2], v0[3]); w.z = cvt_pk_bf16(v1[0], v1[1]); w.w = cvt_pk_bf16(v1[2], v1[3]);
                        *(u32x4*)(rowp + bj * HALF) = w; } } }
    }
};
struct MoeOrder {
    const int* tab; int tpg, G, c, nunits;
    __device__ __forceinline__ bool next(int i, Unit& u) const {
        const int L = i * G + c; if (L >= nunits) return false;
        const int P = L / tpg, pnl = L - P * tpg; const int e = tab[4 * P];
        u.pm = P; u.pn = e * tpg + pnl; return true;
    }
    __device__ __forceinline__ void a_ready(const Unit&) const {}
    __device__ __forceinline__ void done(const Unit&) const {}
};
template <class Epi, class Sched, bool ALIGN_EPI = false, bool SP2 = false>
__device__ __forceinline__ void gemm_phase(PG8_LAS unsigned char* lds, const Gemm g, const Sched& S, const Epi& E) {
    int tid_ = threadIdx.x; asm volatile("" : "+v"(tid_));
    const int tid = tid_, wid = __builtin_amdgcn_readfirstlane(tid >> 6), lane = tid & 63, wr = wid >> 2, wc = wid & 3, fr = lane & 15, fq = lane >> 4;
    const int K = g.K, nt = K / BK;
    unsigned voffA[2], voffB[2];
#pragma unroll
    for (int i = 0; i < 2; ++i) { int R, C; stage_rc(tid * 16 + i * 8192, R, C); const int Rb = Epi::PERM ? ((R & ~31) + perm32(R & 31)) : R;
        voffA[i] = (unsigned)(R * K + C) * 2u; voffB[i] = (unsigned)(Rb * K + C) * 2u; }
    const size_t kstep = (size_t)(BK * 2);
    const size_t hstep = (size_t)HALF * K * 2;
    const size_t tstep = 2 * hstep;
    const unsigned ldsw = (unsigned)wid * 1024u;
    const int aoff = lds_byte(wr * 64 + fr, fq * 8), boff = lds_byte(wc * 32 + fr, fq * 8);
#define PG8_SA(b, h) (((b) * 2 + (h)) * HTB)
#define PG8_SB(b, h) ((4 + (b) * 2 + (h)) * HTB)
#define PG8_STAGE(bufoff, gbase, voff) do { _Pragma("unroll") for (int _i = 0; _i < 2; ++_i) \
        __builtin_amdgcn_global_load_lds((const unsigned*)((const char*)(gbase) + (voff)[_i]), (PG8_LAS unsigned*)(lds + (bufoff) + ldsw + _i * 8192), 16, 0, 0); } while (0)
#define PG8_LDA(dst, b, h) do { _Pragma("unroll") for (int m = 0; m < 4; ++m) _Pragma("unroll") for (int k = 0; k < 2; ++k) dst[m][k] = *(const PG8_LAS bf16x8*)(lds + PG8_SA(b, h) + aoff + m * 2048 + k * 1024); } while (0)
#define PG8_LDB(dst, b, h) do { _Pragma("unroll") for (int n = 0; n < 2; ++n) _Pragma("unroll") for (int k = 0; k < 2; ++k) dst[n][k] = *(const PG8_LAS bf16x8*)(lds + PG8_SB(b, h) + boff + n * 2048 + k * 1024); } while (0)
#define PG8_MMA(ai, bj, At, Bt) do { __builtin_amdgcn_s_setprio(1); _Pragma("unroll") for (int m = 0; m < 4; ++m) _Pragma("unroll") for (int n = 0; n < 2; ++n) _Pragma("unroll") for (int k = 0; k < 2; ++k) \
        acc[ai][bj][m][n] = __builtin_amdgcn_mfma_f32_16x16x32_bf16(Bt[n][k], At[m][k], acc[ai][bj][m][n], 0, 0, 0); __builtin_amdgcn_s_setprio(0); } while (0)
#define PG8_WAIT_V(n) asm volatile("s_waitcnt vmcnt(" #n ")" ::: "memory")
#define PG8_WAIT_L(n) asm volatile("s_waitcnt lgkmcnt(" #n ")" ::: "memory")
#define PG8_BAR __builtin_amdgcn_s_barrier()
#define PG8_SCHED __builtin_amdgcn_sched_barrier(0)
    Unit cur, nxt; int ui = 0;
    if (!S.next(0, cur)) return;
    f32x4 acc[2][2][4][2];
#pragma unroll
    for (int a = 0; a < 2; ++a)
#pragma unroll
        for (int b = 0; b < 2; ++b)
#pragma unroll
            for (int m = 0; m < 4; ++m)
#pragma unroll
                for (int n = 0; n < 2; ++n) acc[a][b][m][n] = (f32x4){0.f, 0.f, 0.f, 0.f};
    bf16x8 At[4][2], B0[2][2], B1[2][2];
    const char* cA = (const char*)g.A + (size_t)cur.pm * tstep; const char* cB = (const char*)g.Bt + (size_t)cur.pn * tstep;
    S.a_ready(cur);
    if constexpr (SP2) {
        PG8_STAGE(PG8_SB(0, 0), cB, voffB); PG8_STAGE(PG8_SB(0, 1), cB + hstep, voffB); PG8_STAGE(PG8_SA(0, 0), cA, voffA); PG8_STAGE(PG8_SA(0, 1), cA + hstep, voffA);
        if (wr == 1) PG8_BAR;
        PG8_WAIT_V(2); PG8_BAR;
        PG8_STAGE(PG8_SB(1, 0), cB + kstep, voffB); PG8_STAGE(PG8_SA(1, 0), cA + kstep, voffA); PG8_STAGE(PG8_SB(1, 1), cB + hstep + kstep, voffB);
        PG8_WAIT_V(6); PG8_BAR;
    } else {
        PG8_STAGE(PG8_SB(0, 0), cB, voffB); PG8_STAGE(PG8_SA(0, 0), cA, voffA); PG8_STAGE(PG8_SB(0, 1), cB + hstep, voffB); PG8_STAGE(PG8_SA(0, 1), cA + hstep, voffA);
        if (wr == 1) PG8_BAR;
        PG8_WAIT_V(4); PG8_BAR;
        PG8_STAGE(PG8_SB(1, 0), cB + kstep, voffB); PG8_STAGE(PG8_SA(1, 0), cA + kstep, voffA); PG8_STAGE(PG8_SB(1, 1), cB + hstep + kstep, voffB);
        PG8_WAIT_V(6); PG8_BAR;
    }
    for (;;) {
        const bool has_next = S.next(ui + 1, nxt);
        const char* nA = has_next ? (const char*)g.A + (size_t)nxt.pm * tstep : cA; const char* nB = has_next ? (const char*)g.Bt + (size_t)nxt.pn * tstep : cB;
        for (int t = 0; t < nt; t += 2) {
            const bool last = (t == nt - 2);
            const char* a1 = cA + (size_t)(t + 1) * kstep;
            const char* a2 = last ? nA : cA + (size_t)(t + 2) * kstep; const char* b2 = last ? nB : cB + (size_t)(t + 2) * kstep;
            const char* a3 = a2 + kstep; const char* b3 = b2 + kstep;
            if (last && has_next) S.a_ready(nxt);
            if constexpr (SP2) {
            PG8_LDB(B0, 0, 0); PG8_LDB(B1, 0, 1); PG8_SCHED; PG8_LDA(At, 0, 0); PG8_STAGE(PG8_SA(1, 1), a1 + hstep, voffA);
            PG8_WAIT_V(8); PG8_WAIT_L(0); PG8_BAR; PG8_MMA(0, 0, At, B0); PG8_MMA(0, 1, At, B1); PG8_BAR; PG8_SCHED;
            PG8_LDA(At, 0, 1); PG8_STAGE(PG8_SB(0, 0), b2, voffB); PG8_STAGE(PG8_SB(0, 1), b2 + hstep, voffB); PG8_STAGE(PG8_SA(0, 0), a2, voffA);
            PG8_WAIT_V(8); PG8_WAIT_L(0); PG8_BAR; PG8_MMA(1, 0, At, B0); PG8_MMA(1, 1, At, B1); PG8_BAR; PG8_SCHED;
            PG8_LDB(B0, 1, 0); PG8_LDB(B1, 1, 1); PG8_SCHED; PG8_LDA(At, 1, 0); PG8_STAGE(PG8_SA(0, 1), a2 + hstep, voffA);
            PG8_WAIT_V(8); PG8_WAIT_L(0); PG8_BAR; PG8_MMA(0, 0, At, B0); PG8_MMA(0, 1, At, B1); PG8_BAR; PG8_SCHED;
            PG8_LDA(At, 1, 1); PG8_STAGE(PG8_SB(1, 0), b3, voffB); PG8_STAGE(PG8_SB(1, 1), b3 + hstep, voffB); PG8_STAGE(PG8_SA(1, 0), a3, voffA);
            PG8_WAIT_V(8); PG8_WAIT_L(0); PG8_BAR; PG8_MMA(1, 0, At, B0); PG8_MMA(1, 1, At, B1); PG8_BAR; PG8_SCHED;
            } else {
            PG8_LDB(B0, 0, 0); PG8_SCHED; PG8_LDA(At, 0, 0); PG8_STAGE(PG8_SA(1, 1), a1 + hstep, voffA);
            PG8_WAIT_L(8); PG8_BAR; PG8_WAIT_L(0); PG8_MMA(0, 0, At, B0); PG8_BAR; PG8_SCHED;
            PG8_LDB(B1, 0, 1); PG8_STAGE(PG8_SB(0, 0), b2, voffB);
            PG8_BAR; PG8_WAIT_L(0); PG8_MMA(0, 1, At, B1); PG8_BAR;
            PG8_LDA(At, 0, 1); PG8_STAGE(PG8_SA(0, 0), a2, voffA);
            PG8_BAR; PG8_WAIT_L(0); PG8_MMA(1, 0, At, B0); PG8_BAR; PG8_SCHED;
            PG8_STAGE(PG8_SB(0, 1), b2 + hstep, voffB);
            PG8_WAIT_V(6); PG8_BAR; PG8_MMA(1, 1, At, B1); PG8_BAR;
            PG8_LDB(B0, 1, 0); PG8_SCHED; PG8_LDA(At, 1, 0); PG8_STAGE(PG8_SA(0, 1), a2 + hstep, voffA);
            PG8_WAIT_L(8); PG8_BAR; PG8_WAIT_L(0); PG8_MMA(0, 0, At, B0); PG8_BAR; PG8_SCHED;
            PG8_LDB(B1, 1, 1); PG8_STAGE(PG8_SB(1, 0), b3, voffB);
            PG8_BAR; PG8_WAIT_L(0); PG8_MMA(0, 1, At, B1); PG8_BAR;
            PG8_LDA(At, 1, 1); PG8_STAGE(PG8_SA(1, 0), a3, voffA);
            PG8_BAR; PG8_WAIT_L(0); PG8_MMA(1, 0, At, B0); PG8_BAR; PG8_SCHED;
            PG8_STAGE(PG8_SB(1, 1), b3 + hstep, voffB);
            PG8_WAIT_V(6); PG8_BAR; PG8_MMA(1, 1, At, B1); PG8_BAR;
            }
        }
        if constexpr (ALIGN_EPI) { if (wr == 0) PG8_BAR; }
        if constexpr (!Epi::AFTER_DRAIN) { E(acc, cur, wr, wc, fr, fq); S.done(cur); }
        if (!has_next) break;
#pragma unroll
        for (int a = 0; a < 2; ++a)
#pragma unroll
            for (int b = 0; b < 2; ++b)
#pragma unroll
                for (int m = 0; m < 4; ++m)
#pragma unroll
                    for (int n = 0; n < 2; ++n) acc[a][b][m][n] = (f32x4){0.f, 0.f, 0.f, 0.f};
        cur = nxt; cA = nA; cB = nB; ++ui;
        if constexpr (ALIGN_EPI) { if (wr == 1) PG8_BAR; }
    }
    PG8_WAIT_V(0);
    if constexpr (!ALIGN_EPI) { if (wr == 0) PG8_BAR; }
    PG8_BAR;
    if constexpr (Epi::AFTER_DRAIN) { E.fused(acc, cur, wr, wc, fr, fq, lds, wid, lane); S.done(cur); }
#undef PG8_SA
#undef PG8_SB
#undef PG8_STAGE
#undef PG8_LDA
#undef PG8_LDB
#undef PG8_MMA
#undef PG8_WAIT_V
#undef PG8_WAIT_L
#undef PG8_BAR
#undef PG8_SCHED
}
}
constexpr int NWAVES = 8;
constexpr int TOK = 16384, SEQ = 4096, D = 1024, NP = 4096, INC = 3888, DEPTH = 4;
constexpr int HG_Q = 0, HG_F = 256, HG_I = 512, HG_G = 768;
constexpr int GL_Q = 1024, GL_K = 1152, GL_V = 1280, GL_GLR = 1536, GL_R = 1552;
constexpr int RW_BASE = 1808, RW_R = 1808, RW_K = 2064, RW_V = 2320, RW_WLR = 2576, RW_ALR = 2640, RW_GLR = 2704;
constexpr int RT_Q = 2864, RT_K = 3120, RT_V = 3376, RT_G = 3632;
constexpr int FFD = 2816, FFE = 1408, NE = 8;
constexpr float DN_ALPHA = 1.6817928305074290f;
constexpr int NPH = 11;
constexpr int NPHASES = NPH * DEPTH;
constexpr size_t MiB = 1u << 20;
constexpr size_t WS_CTL = 0, CTL_ZERO_BYTES = 1 * MiB;
constexpr size_t WS_LIST = 1 * MiB;
constexpr size_t WS_GATE = 2 * MiB;
constexpr size_t WS_TAB = 3 * MiB;
constexpr size_t WS_WIN = 4 * MiB, WS_WOUT = 12 * MiB, WS_WUP = 14 * MiB, WS_WDN = 58 * MiB;
constexpr size_t WS_HB = 80 * MiB;
constexpr size_t WS_MIX = 112 * MiB;
constexpr size_t WS_O = WS_MIX;
constexpr size_t WS_VF = 176 * MiB;
constexpr size_t WS_P = 184 * MiB;
constexpr size_t WS_RWW = 312 * MiB;
constexpr size_t WS_RWR = 328 * MiB, WS_RWK = 336 * MiB, WS_RWV = 344 * MiB, WS_RWKK = 352 * MiB, WS_RWB = 360 * MiB, WS_RWG = 368 * MiB;
constexpr size_t WS_Y = 376 * MiB;
constexpr size_t WS_HID = 184 * MiB;
constexpr size_t WS_DOUT = 280 * MiB;
constexpr size_t WS_HPERM = 344 * MiB;
constexpr size_t WS_END = 412 * MiB;
constexpr int CW_BAR = 4096;
constexpr int CW_CNT = 16384;
constexpr int TAB_STRIDE = 4 * 160 + 16;
constexpr int RING_BYTES = 131072, LDSCTL_OFF = RING_BYTES, MISC_OFF = LDSCTL_OFF + 320, LDS_BYTES = 147456;
#define GAS __attribute__((address_space(1)))
#define LAS __attribute__((address_space(3)))
typedef unsigned short bf16;
typedef unsigned v4u __attribute__((ext_vector_type(4)));
typedef unsigned v2u __attribute__((ext_vector_type(2)));
typedef float f32x4 __attribute__((ext_vector_type(4)));
typedef short bf16x8 __attribute__((ext_vector_type(8)));
typedef GAS unsigned gu32;
#define RLX_AGENT __ATOMIC_RELAXED, __HIP_MEMORY_SCOPE_AGENT
#define LDS_WAIT() asm volatile("s_waitcnt lgkmcnt(0)" ::: "memory")
#define VM_WAIT() asm volatile("s_waitcnt vmcnt(0)" ::: "memory")
__device__ __forceinline__ unsigned f2bf(float f) { unsigned u = __builtin_bit_cast(unsigned, f); return (u + 0x7fffu + ((u >> 16) & 1u)) >> 16; }
__device__ __forceinline__ unsigned pk2(float lo, float hi) { return f2bf(lo) | (f2bf(hi) << 16); }
__device__ __forceinline__ float bflo(unsigned w) { return __builtin_bit_cast(float, w << 16); }
__device__ __forceinline__ float bfhi(unsigned w) { return __builtin_bit_cast(float, w & 0xffff0000u); }
__device__ __forceinline__ float bf1(bf16 b) { return __builtin_bit_cast(float, ((unsigned)b) << 16); }
__device__ __forceinline__ void unpack8(const v4u w, float (&f)[8]) { f[0] = bflo(w.x); f[1] = bfhi(w.x); f[2] = bflo(w.y); f[3] = bfhi(w.y); f[4] = bflo(w.z); f[5] = bfhi(w.z); f[6] = bflo(w.w); f[7] = bfhi(w.w); }
__device__ __forceinline__ v4u pack8(const float (&f)[8]) { v4u w; w.x = pk2(f[0], f[1]); w.y = pk2(f[2], f[3]); w.z = pk2(f[4], f[5]); w.w = pk2(f[6], f[7]); return w; }
__device__ __forceinline__ float sigm(float x) { return __builtin_amdgcn_rcpf(1.0f + __expf(-x)); }
template <int CTRL> __device__ __forceinline__ float dpp(float x) { return __builtin_bit_cast(float, __builtin_amdgcn_mov_dpp(__builtin_bit_cast(int, x), CTRL, 0xf, 0xf, true)); }
__device__ __forceinline__ float sum16(float x) { x += dpp<0xB1>(x); x += dpp<0x4E>(x); x += dpp<0x141>(x); x += dpp<0x128>(x); return x; }
__device__ __forceinline__ float sum4(float x) { x += dpp<0xB1>(x); x += dpp<0x4E>(x); return x; }
__device__ __forceinline__ float wave_sum(float v) {
#pragma unroll
    for (int o = 1; o < 64; o <<= 1) v += __shfl_xor(v, o);
    return v;
}
__device__ const double INVF2PI[32] = {0.15915494309189535, 0.11934937021124886, 0.08949940160889101, 0.06711508300522726, 0.050329212104487035, 0.03774158471741977, 0.0283021958306234, 0.02122365276477766, 0.015915494309189534, 0.011934937021124886, 0.008949940160889102, 0.006711508300522725, 0.005032921210448704, 0.003774158471741977, 0.00283021958306234, 0.0021223652764777662, 0.0015915494309189536, 0.0011934937021124885, 0.0008949940160889102, 0.0006711508300522726, 0.0005032921210448703, 0.00037741584717419774, 0.00028302195830623395, 0.0002122365276477766, 0.00015915494309189535, 0.00011934937021124886, 8.949940160889102e-05, 6.711508300522725e-05, 5.0329212104487035e-05, 3.774158471741978e-05, 2.8302195830623396e-05, 2.122365276477766e-05};
#define XB_TMO      128
#define XB_XCNT(j)  (256  + 64 * (j))
#define XB_XSUB(j)  (1280 + 64 * (j))
#define XB_XGEN(j)  (2304 + 64 * (j))
#define XB_TOP      3328
#define XB_TOPGEN   3392
#define XCD_BAR_WORDS 3456
#define XB_SPIN_CAP (1u << 18)

__device__ __forceinline__ unsigned xb_ld(unsigned* p)              { return __hip_atomic_load(p, __ATOMIC_RELAXED, __HIP_MEMORY_SCOPE_AGENT); }
__device__ __forceinline__ unsigned xb_add(unsigned* p, unsigned v) { return __hip_atomic_fetch_add(p, v, __ATOMIC_RELAXED, __HIP_MEMORY_SCOPE_AGENT); }
__device__ __forceinline__ unsigned xb_xcc_id() { return (unsigned)__builtin_amdgcn_s_getreg((3 << 11) | 20) & 0xFu; }
#define XB_SPIN(cond, bar) do { unsigned _sp = 0; while (cond) { __builtin_amdgcn_s_sleep(1); \
    if ((++_sp & 255u) == 0u) { if (xb_ld(&(bar)[XB_TMO])) break; if (_sp > XB_SPIN_CAP) { atomicAdd(&(bar)[XB_TMO], 1u); break; } } } } while (0)

struct XcdBarrier {
    unsigned* bar; unsigned x;
    volatile LAS unsigned* st;
};

__device__ __forceinline__ XcdBarrier xcd_barrier_post(unsigned* bar, volatile LAS unsigned* st) {
    XcdBarrier b; b.bar = bar; b.x = xb_xcc_id(); b.st = st;
    if (threadIdx.x == 0) (void)xb_add(&bar[XB_XCNT(b.x)], 1u);
    return b;
}
__device__ __forceinline__ void xcd_barrier_complete(unsigned* bar, unsigned x, unsigned& nloc, unsigned& nx) {
    const unsigned G = gridDim.x * gridDim.y * gridDim.z;
    unsigned sum, cnt, mine, sp = 0u;
    for (;;) {
        sum = 0u; cnt = 0u; mine = 0u;
#pragma unroll
        for (unsigned j = 0; j < 16; ++j) { const unsigned c = xb_ld(&bar[XB_XCNT(j)]); sum += c; cnt += (c > 0u) ? 1u : 0u; mine = (j == x) ? c : mine; }
        if (sum == G) break;
        __builtin_amdgcn_s_sleep(1);
        if ((++sp & 255u) == 0u) { if (xb_ld(&bar[XB_TMO])) break; if (sp > XB_SPIN_CAP) { atomicAdd(&bar[XB_TMO], 1u); break; } }
    }
    nloc = mine > 0u ? mine : 1u; nx = cnt > 0u ? cnt : 1u;
}

__device__ __forceinline__ void xcd_barrier(const XcdBarrier& b) {
    asm volatile("s_waitcnt vmcnt(0)" ::: "memory");
    __syncthreads();
    if (threadIdx.x == 0) {
        unsigned* bar = b.bar;
        __builtin_amdgcn_s_waitcnt(0);
        unsigned nloc = b.st[0], nx = b.st[1];
        if (nloc == 0u) { xcd_barrier_complete(bar, b.x, nloc, nx); b.st[0] = nloc; b.st[1] = nx; }
        const unsigned old = xb_add(&bar[XB_XSUB(b.x)], 1u);
        const unsigned gen = old / nloc;
        if (old + 1u == (gen + 1u) * nloc) {
            __builtin_amdgcn_fence(__ATOMIC_RELEASE, "agent");
            asm volatile("s_waitcnt vmcnt(0)" ::: "memory");
            const unsigned og = xb_add(&bar[XB_TOP], 1u);
            const unsigned tg = og / nx;
            if (og + 1u == (tg + 1u) * nx) xb_add(&bar[XB_TOPGEN], 1u);
            else XB_SPIN(xb_ld(&bar[XB_TOPGEN]) == tg, bar);
            __builtin_amdgcn_fence(__ATOMIC_ACQUIRE, "agent");
            xb_add(&bar[XB_XGEN(b.x)], 1u);
            asm volatile("s_waitcnt vmcnt(0)" ::: "memory");
        } else {
            XB_SPIN(xb_ld(&bar[XB_XGEN(b.x)]) == gen, bar);
            __builtin_amdgcn_fence(__ATOMIC_ACQUIRE, "agent");
            asm volatile("s_waitcnt vmcnt(0)" ::: "memory");
        }
    }
    __syncthreads();
}
struct Frame {
    LAS unsigned char* lds;
    volatile LAS unsigned* MISC;
    gu32* ctl;
    int tid, lane, wave;
    int vcu, G;
    unsigned char* ws;
    const void* const* in;
    float* h;
};
__device__ __forceinline__ const void* ldptr(const void* const* tab, int k) { int z; asm volatile("s_mov_b32 %0, 0" : "=s"(z)); return tab[k + z]; }
#define INF(k) ((const float*)ldptr(F.in, k))
#define WSP(T, off) ((T*)(F.ws + (off)))

__device__ __forceinline__ void xpose_item(const float* W, int ldw, int nvalid, int k0, int n0, bf16* WT, int ldt, int drow0, LAS float* scr, int lane) {
#pragma unroll 8
    for (int i = 0; i < 32; ++i) { const int kk = 2 * i + (lane >> 5), n = n0 + (lane & 31); scr[kk * 33 + (lane & 31)] = (n < nvalid) ? W[(size_t)(k0 + kk) * ldw + n] : 0.f; }
    LDS_WAIT(); asm volatile("" ::: "memory");
    const int c = lane & 7;
#pragma unroll
    for (int j = 0; j < 4; ++j) { const int n = (lane >> 3) + 8 * j; const LAS float* s = scr + (8 * c) * 33 + n;
        v4u o; o.x = pk2(s[0 * 33], s[1 * 33]); o.y = pk2(s[2 * 33], s[3 * 33]); o.z = pk2(s[4 * 33], s[5 * 33]); o.w = pk2(s[6 * 33], s[7 * 33]);
        *(GAS v4u*)(WT + (size_t)(drow0 + n) * ldt + k0 + 8 * c) = o; }
    LDS_WAIT(); asm volatile("" ::: "memory");
}
__device__ __forceinline__ int gu_row(int n) { return 256 * (n >> 7) + (n & 127); }
__device__ __forceinline__ void phase_weights(Frame& F, int l) {
    LAS float* scr = (LAS float*)(F.lds + F.wave * 16384);
    const int gw = F.vcu * NWAVES + F.wave, NGW = F.G * NWAVES;
    const bool moe = (l & 1); const int fi = l >> 1;
    constexpr int I_IN = 16 * 128, I_OUT = 16 * 32;
    constexpr int I_DG = 16 * 88, I_DD = 44 * 32;
    constexpr int I_MG = 16 * 44, I_MD = 22 * 32;
    const int nitems = I_IN + I_OUT + (moe ? NE * (2 * I_MG + I_MD) : (2 * I_DG + I_DD));
    for (int it = gw; it < nitems; it += NGW) {
        int r = it;
        if (r < I_IN) { const int kb = r >> 7, nb = r & 127; xpose_item(INF(2) + (size_t)l * D * INC, INC, INC, 64 * kb, 32 * nb, WSP(bf16, WS_WIN), D, 32 * nb, scr, F.lane); continue; } r -= I_IN;
        if (r < I_OUT) { const int kb = r >> 5, nb = r & 31; xpose_item(INF(3) + (size_t)l * D * D, D, D, 64 * kb, 32 * nb, WSP(bf16, WS_WOUT), D, 32 * nb, scr, F.lane); continue; } r -= I_OUT;
        if (!moe) {
            if (r < 2 * I_DG) { const int up = r >= I_DG; if (up) r -= I_DG; const int kb = r / 88, nb = r % 88;
                xpose_item(INF(up ? 28 : 27) + (size_t)fi * D * FFD, FFD, FFD, 64 * kb, 32 * nb, WSP(bf16, WS_WUP), D, gu_row(32 * nb) + (up ? 128 : 0), scr, F.lane); continue; } r -= 2 * I_DG;
            { const int kb = r >> 5, nb = r & 31; xpose_item(INF(29) + (size_t)fi * FFD * D, D, D, 64 * kb, 32 * nb, WSP(bf16, WS_WDN), FFD, 32 * nb, scr, F.lane); }
        } else {
            const int per = 2 * I_MG + I_MD; const int e = r / per; r -= e * per;
            if (r < 2 * I_MG) { const int up = r >= I_MG; if (up) r -= I_MG; const int kb = r / 44, nb = r % 44;
                xpose_item(INF(up ? 32 : 31) + (size_t)(fi * NE + e) * D * FFE, FFE, FFE, 64 * kb, 32 * nb, WSP(bf16, WS_WUP) + (size_t)e * 2 * FFE * D, D, gu_row(32 * nb) + (up ? 128 : 0), scr, F.lane); continue; } r -= 2 * I_MG;
            { const int kb = r >> 5, nb = r & 31; xpose_item(INF(33) + (size_t)(fi * NE + e) * FFE * D, D, D, 64 * kb, 32 * nb, WSP(bf16, WS_WDN) + (size_t)e * D * FFE, FFE, 32 * nb, scr, F.lane); }
        }
    }
    if (l == 0) {
        const float* x = INF(0); bf16* hb = WSP(bf16, WS_HB);
        for (int m = gw; m < TOK; m += NGW) {
            const GAS f32x4* xr = (const GAS f32x4*)(x + (size_t)m * D) + F.lane; GAS f32x4* hr = (GAS f32x4*)(F.h + (size_t)m * D) + F.lane; GAS v2u* o8 = (GAS v2u*)(hb + (size_t)m * D) + F.lane;
#pragma unroll
            for (int j = 0; j < 4; ++j) { const f32x4 v = xr[64 * j]; hr[64 * j] = v; v2u w; w.x = pk2(v.x, v.y); w.y = pk2(v.z, v.w); o8[64 * j] = w; }
        }
    }
}
__device__ __forceinline__ void rw_xs8(const bf16* P, const float* mu, int t, int col0, float (&xs)[8]) {
    const v4u cur = *(const GAS v4u*)(P + (size_t)t * NP + col0);
    v4u prv = (v4u){0u, 0u, 0u, 0u}; if ((t & (SEQ - 1)) != 0) prv = *(const GAS v4u*)(P + (size_t)(t - 1) * NP + col0);
    const f32x4 m0 = *(const GAS f32x4*)(mu + col0 - RW_BASE), m1 = *(const GAS f32x4*)(mu + col0 - RW_BASE + 4);
    float c[8], p[8]; unpack8(cur, c); unpack8(prv, p);
    const float m[8] = {m0.x, m0.y, m0.z, m0.w, m1.x, m1.y, m1.z, m1.w};
#pragma unroll
    for (int j = 0; j < 8; ++j) xs[j] = c[j] + (p[j] - c[j]) * m[j];
}
__device__ __forceinline__ float rw_xs1(const bf16* P, const float* mu, int t, int col) {
    const float c = bf1(P[(size_t)t * NP + col]); const float p = ((t & (SEQ - 1)) != 0) ? bf1(P[(size_t)(t - 1) * NP + col]) : 0.f;
    return c + (p - c) * mu[col - RW_BASE];
}
__device__ __forceinline__ void rw_mm(f32x4 (&acc)[2][4], const LAS float* A, int lda, int mb0, const float* B, int hh, int nsteps, int lane) {
    const int fr = lane & 15, fq = lane >> 4;
    for (int s = 0; s < nsteps; ++s) {
        float bf[4];
#pragma unroll
        for (int nbl = 0; nbl < 4; ++nbl) bf[nbl] = B[(size_t)(4 * s + fq) * 256 + 64 * hh + 16 * nbl + fr];
#pragma unroll
        for (int mi = 0; mi < 2; ++mi) { const float af = A[(16 * (mb0 + mi) + fr) * lda + 4 * s + fq];
#pragma unroll
            for (int nbl = 0; nbl < 4; ++nbl) acc[mi][nbl] = __builtin_amdgcn_mfma_f32_16x16x4f32(af, bf[nbl], acc[mi][nbl], 0, 0, 0); }
    }
}
__device__ __forceinline__ void phase_rwprep(Frame& F, int l) {
    const bf16* P = WSP(const bf16, WS_P);
    const float* mu = INF(13) + l * 1056;
    LAS float* X1 = (LAS float*)F.lds; LAS float* X2 = X1 + 64 * 66; LAS float* X3 = X2 + 64 * 66;
    LAS float* X4 = (LAS float*)F.lds; LAS float* X5 = X4 + 64 * 258;
    float* RWW = WSP(float, WS_RWW); bf16* RWR = WSP(bf16, WS_RWR); bf16* RWK = WSP(bf16, WS_RWK); bf16* RWV = WSP(bf16, WS_RWV);
    bf16* RWKK = WSP(bf16, WS_RWKK); bf16* RWB = WSP(bf16, WS_RWB); bf16* RWG = WSP(bf16, WS_RWG); bf16* VF = WSP(bf16, WS_VF);
    const int fr = F.lane & 15, fq = F.lane >> 4, hh = F.wave & 3, mb0 = 2 * (F.wave >> 2);
    for (int tile = F.vcu; tile < TOK / 64; tile += F.G) {
        const int t0 = tile * 64;
        for (int g = F.tid; g < 64 * 36; g += NWAVES * 64) { const int tt = g / 36, cg = g - tt * 36; float xs[8]; rw_xs8(P, mu, t0 + tt, RW_WLR + 8 * cg, xs);
            if (cg < 8) {
#pragma unroll
                for (int j = 0; j < 8; ++j) { const float e2 = __expf(2.f * xs[j]); X1[tt * 66 + 8 * cg + j] = 1.f - 2.f * __builtin_amdgcn_rcpf(e2 + 1.f); }
            } else if (cg < 16) {
#pragma unroll
                for (int j = 0; j < 8; ++j) X2[tt * 66 + 8 * (cg - 8) + j] = xs[j];
            } else {
#pragma unroll
                for (int j = 0; j < 8; ++j) X3[tt * 162 + 8 * (cg - 16) + j] = sigm(xs[j]);
            } }
        for (int g = F.tid; g < 64 * 32; g += NWAVES * 64) { const int tt = g >> 5, cg = g & 31; float xs[8]; rw_xs8(P, mu, t0 + tt, RW_R + 8 * cg, xs);
            *(GAS v4u*)(RWR + (size_t)(t0 + tt) * 256 + 8 * cg) = pack8(xs);
            if (l == 0) { rw_xs8(P, mu, t0 + tt, RW_V + 8 * cg, xs); const v4u w = pack8(xs); *(GAS v4u*)(RWV + (size_t)(t0 + tt) * 256 + 8 * cg) = w; *(GAS v4u*)(VF + (size_t)(t0 + tt) * 256 + 8 * cg) = w; } }
        __syncthreads();
        {   f32x4 acc[2][4];
#pragma unroll
            for (int mi = 0; mi < 2; ++mi)
#pragma unroll
                for (int nb = 0; nb < 4; ++nb) acc[mi][nb] = (f32x4){0.f, 0.f, 0.f, 0.f};
            rw_mm(acc, X1, 66, mb0, INF(15) + (size_t)l * 64 * 256, hh, 16, F.lane);
            const float* w0 = INF(14) + l * 256;
#pragma unroll
            for (int mi = 0; mi < 2; ++mi)
#pragma unroll
                for (int nb = 0; nb < 4; ++nb) { const int col = 64 * hh + 16 * nb + fr; const float w0c = w0[col];
#pragma unroll
                    for (int r = 0; r < 4; ++r) { const int t = t0 + 16 * (mb0 + mi) + 4 * fq + r; RWW[(size_t)t * 256 + col] = __expf(-0.6065306597126334f * sigm(acc[mi][nb][r] + w0c)); } }
#pragma unroll
            for (int mi = 0; mi < 2; ++mi)
#pragma unroll
                for (int nb = 0; nb < 4; ++nb) acc[mi][nb] = (f32x4){0.f, 0.f, 0.f, 0.f};
            rw_mm(acc, X2, 66, mb0, INF(17) + (size_t)l * 64 * 256, hh, 16, F.lane);
            const float* a0 = INF(16) + l * 256; const float* kkw = INF(19) + l * 256; const float* kaw = INF(20) + l * 256;
#pragma unroll
            for (int mi = 0; mi < 2; ++mi) {
                float kr[4][4], kq[4][4], ssq[4] = {0.f, 0.f, 0.f, 0.f};
#pragma unroll
                for (int nb = 0; nb < 4; ++nb) { const int col = 64 * hh + 16 * nb + fr; const float kkc = kkw[col];
#pragma unroll
                    for (int r = 0; r < 4; ++r) { const int t = t0 + 16 * (mb0 + mi) + 4 * fq + r; kr[nb][r] = rw_xs1(P, mu, t, RW_K + col); kq[nb][r] = kr[nb][r] * kkc; ssq[r] += kq[nb][r] * kq[nb][r]; } }
#pragma unroll
                for (int r = 0; r < 4; ++r) { ssq[r] = sum16(ssq[r]); ssq[r] = 1.0f / fmaxf(sqrtf(ssq[r]), 1e-12f); }
#pragma unroll
                for (int nb = 0; nb < 4; ++nb) { const int col = 64 * hh + 16 * nb + fr; const float a0c = a0[col], kac = kaw[col];
#pragma unroll
                    for (int r = 0; r < 4; ++r) { const int t = t0 + 16 * (mb0 + mi) + 4 * fq + r; const float a = sigm(acc[mi][nb][r] + a0c); const float kk = kq[nb][r] * ssq[r];
                        const size_t o = (size_t)t * 256 + col; RWKK[o] = (bf16)f2bf(kk); RWB[o] = (bf16)f2bf(kk * a); RWK[o] = (bf16)f2bf(kr[nb][r] * (1.f + (a - 1.f) * kac)); } }
            }
#pragma unroll
            for (int mi = 0; mi < 2; ++mi)
#pragma unroll
                for (int nb = 0; nb < 4; ++nb) acc[mi][nb] = (f32x4){0.f, 0.f, 0.f, 0.f};
            rw_mm(acc, X3, 162, mb0, INF(18) + (size_t)l * 160 * 256, hh, 40, F.lane);
#pragma unroll
            for (int mi = 0; mi < 2; ++mi)
#pragma unroll
                for (int nb = 0; nb < 4; ++nb) { const int col = 64 * hh + 16 * nb + fr;
#pragma unroll
                    for (int r = 0; r < 4; ++r) { const int t = t0 + 16 * (mb0 + mi) + 4 * fq + r; RWG[(size_t)t * 256 + col] = (bf16)f2bf(acc[mi][nb][r]); } }
        }
        __syncthreads();
        if (l > 0) {
            const float* v0 = INF(24) + (l - 1) * 256; const float* v1 = INF(25) + (size_t)(l - 1) * 256 * 32; const float* v2 = INF(26) + (size_t)(l - 1) * 32 * 256;
            for (int g = F.tid; g < 64 * 32; g += NWAVES * 64) { const int tt = g >> 5, cg = g & 31; float xs[8]; rw_xs8(P, mu, t0 + tt, RW_V + 8 * cg, xs);
#pragma unroll
                for (int j = 0; j < 8; ++j) X4[tt * 258 + 8 * cg + j] = xs[j]; }
            __syncthreads();
            {
                const int mb = F.wave & 3, nb = F.wave >> 2; f32x4 a4 = (f32x4){0.f, 0.f, 0.f, 0.f};
                for (int s = 0; s < 64; ++s) { const float af = X4[(16 * mb + fr) * 258 + 4 * s + fq]; const float bfv = v1[(size_t)(4 * s + fq) * 32 + 16 * nb + fr]; a4 = __builtin_amdgcn_mfma_f32_16x16x4f32(af, bfv, a4, 0, 0, 0); }
#pragma unroll
                for (int r = 0; r < 4; ++r) X5[(16 * mb + 4 * fq + r) * 34 + 16 * nb + fr] = a4[r];
            }
            __syncthreads();
            {   f32x4 acc[2][4];
#pragma unroll
                for (int mi = 0; mi < 2; ++mi)
#pragma unroll
                    for (int nb = 0; nb < 4; ++nb) acc[mi][nb] = (f32x4){0.f, 0.f, 0.f, 0.f};
                rw_mm(acc, X5, 34, mb0, v2, hh, 8, F.lane);
#pragma unroll
                for (int mi = 0; mi < 2; ++mi)
#pragma unroll
                    for (int nb = 0; nb < 4; ++nb) { const int col = 64 * hh + 16 * nb + fr; const float v0c = v0[col];
#pragma unroll
                        for (int r = 0; r < 4; ++r) { const int row = 16 * (mb0 + mi) + 4 * fq + r; const size_t o = (size_t)(t0 + row) * 256 + col;
                            const float xv = X4[row * 258 + col]; const float vf = bf1(VF[o]); RWV[o] = (bf16)f2bf(xv + (vf - xv) * sigm(acc[mi][nb][r] + v0c)); } }
            }
            __syncthreads();
        }
    }
}
constexpr int SC_TB = 32, SC_SLOT = 5 * SC_TB * 64 * 4 + SC_TB * 16 * 4;
constexpr int SC_GW2 = 3 * SC_SLOT;
template <int MIX> __device__ __forceinline__ void scan_fill(Frame& F, int l, int b, int h, int q4, int blk, LAS unsigned char* slot, const float (&lbv)[8]) {
    const int lt = F.tid - 256; const int tt = lt >> 3, j8 = (lt & 7) * 8; const int t = b * SEQ + blk * SC_TB + tt;
    LAS float* Wd = (LAS float*)slot + tt * 64 + j8; LAS float* Kd = Wd + SC_TB * 64; LAS float* Qd = Kd + SC_TB * 64; LAS float* Ad = Qd + SC_TB * 64; LAS float* Bd = Ad + SC_TB * 64;
    LAS float* Vd = (LAS float*)slot + 5 * SC_TB * 64;
    const bf16* P = WSP(const bf16, WS_P);
    float w[8], k[8], q[8];
    int vcol;
    if (MIX == 0) {
        float fr_[8], qr[8]; unpack8(*(const GAS v4u*)(P + (size_t)t * NP + HG_F + 64 * h + j8), fr_); unpack8(*(const GAS v4u*)(P + (size_t)t * NP + HG_Q + 64 * h + j8), qr);
#pragma unroll
        for (int j = 0; j < 8; ++j) { w[j] = lbv[j] + (1.f - lbv[j]) * sigm(fr_[j]); k[j] = 1.f - w[j]; q[j] = qr[j] * sigm(qr[j]); }
        vcol = HG_I;
    } else if (MIX == 1) {
        if (j8 < 32) {
            float qr[8], kr[8], g0[8], g1[8]; unpack8(*(const GAS v4u*)(P + (size_t)t * NP + GL_Q + 32 * h + j8), qr); unpack8(*(const GAS v4u*)(P + (size_t)t * NP + GL_K + 32 * h + j8), kr);
            unpack8(*(const GAS v4u*)(P + (size_t)t * NP + GL_GLR), g0); unpack8(*(const GAS v4u*)(P + (size_t)t * NP + GL_GLR + 8), g1);
            const LAS float* w2 = (const LAS float*)(F.lds + SC_GW2); const float* gb = INF(11) + l * 128 + 32 * h + j8;
            float x[8];
#pragma unroll
            for (int j = 0; j < 8; ++j) x[j] = gb[j];
#pragma unroll
            for (int r = 0; r < 8; ++r)
#pragma unroll
                for (int j = 0; j < 8; ++j) { x[j] += g0[r] * w2[r * 32 + j8 + j]; x[j] += g1[r] * w2[(r + 8) * 32 + j8 + j]; }
#pragma unroll
            for (int j = 0; j < 8; ++j) { const float ls = fminf(x[j], 0.f) - __logf(1.f + __expf(-fabsf(x[j]))); w[j] = __expf(ls * 0.0625f); k[j] = kr[j]; q[j] = qr[j] * 0.17677669529663687f; }
        } else {
#pragma unroll
            for (int j = 0; j < 8; ++j) { w[j] = 1.f; k[j] = 0.f; q[j] = 0.f; }
        }
        vcol = GL_V;
    } else if (MIX == 2) {
        const size_t o = (size_t)t * 256 + 64 * h + j8;
        const f32x4 w0 = *(const GAS f32x4*)(WSP(const float, WS_RWW) + o), w1 = *(const GAS f32x4*)(WSP(const float, WS_RWW) + o + 4);
        w[0] = w0.x; w[1] = w0.y; w[2] = w0.z; w[3] = w0.w; w[4] = w1.x; w[5] = w1.y; w[6] = w1.z; w[7] = w1.w;
        unpack8(*(const GAS v4u*)(WSP(const bf16, WS_RWK) + o), k); unpack8(*(const GAS v4u*)(WSP(const bf16, WS_RWR) + o), q);
        float a[8], bb[8]; unpack8(*(const GAS v4u*)(WSP(const bf16, WS_RWKK) + o), a); unpack8(*(const GAS v4u*)(WSP(const bf16, WS_RWB) + o), bb);
        *(LAS f32x4*)Ad = (f32x4){a[0], a[1], a[2], a[3]}; *(LAS f32x4*)(Ad + 4) = (f32x4){a[4], a[5], a[6], a[7]};
        *(LAS f32x4*)Bd = (f32x4){bb[0], bb[1], bb[2], bb[3]}; *(LAS f32x4*)(Bd + 4) = (f32x4){bb[4], bb[5], bb[6], bb[7]};
        vcol = 0;
    } else {
        const int i0 = j8 & 31; const bool hi = j8 >= 32;
        float q1[8], q2[8], k1[8], k2[8];
        unpack8(*(const GAS v4u*)(P + (size_t)t * NP + RT_Q + 64 * h + i0), q1); unpack8(*(const GAS v4u*)(P + (size_t)t * NP + RT_Q + 64 * h + 32 + i0), q2);
        unpack8(*(const GAS v4u*)(P + (size_t)t * NP + RT_K + 64 * h + i0), k1); unpack8(*(const GAS v4u*)(P + (size_t)t * NP + RT_K + 64 * h + 32 + i0), k2);
        const double pos = (double)((const int*)ldptr(F.in, 1))[t];
        const float gam = 1.f - exp2f(-5.f - (float)h);
#pragma unroll
        for (int j = 0; j < 8; ++j) { const double rev = pos * INVF2PI[i0 + j]; const float fr_ = (float)(rev - floor(rev)); const float s = __builtin_amdgcn_sinf(fr_), c = __builtin_amdgcn_cosf(fr_);
            q[j] = hi ? (q1[j] * s + q2[j] * c) : (q1[j] * c - q2[j] * s); k[j] = 0.125f * (hi ? (k1[j] * s + k2[j] * c) : (k1[j] * c - k2[j] * s)); w[j] = gam; }
        vcol = RT_V;
    }
    *(LAS f32x4*)Wd = (f32x4){w[0], w[1], w[2], w[3]}; *(LAS f32x4*)(Wd + 4) = (f32x4){w[4], w[5], w[6], w[7]};
    *(LAS f32x4*)Kd = (f32x4){k[0], k[1], k[2], k[3]}; *(LAS f32x4*)(Kd + 4) = (f32x4){k[4], k[5], k[6], k[7]};
    *(LAS f32x4*)Qd = (f32x4){q[0], q[1], q[2], q[3]}; *(LAS f32x4*)(Qd + 4) = (f32x4){q[4], q[5], q[6], q[7]};
    if (lt < 64) {
        const int t2 = b * SEQ + blk * SC_TB + (lt >> 1), hf = lt & 1; float v[8];
        if (MIX == 2) unpack8(*(const GAS v4u*)(WSP(const bf16, WS_RWV) + (size_t)t2 * 256 + 64 * h + 16 * q4 + 8 * hf), v);
        else unpack8(*(const GAS v4u*)(P + (size_t)t2 * NP + vcol + 64 * h + 16 * q4 + 8 * hf), v);
        LAS float* vd = Vd + (lt >> 1) * 16 + 8 * hf;
        *(LAS f32x4*)vd = (f32x4){v[0], v[1], v[2], v[3]}; *(LAS f32x4*)(vd + 4) = (f32x4){v[4], v[5], v[6], v[7]};
    }
}
template <int MIX> __device__ __forceinline__ void scan_unit(Frame& F, int l, int b, int h, int q4) {
    float lbv[8] = {0.f, 0.f, 0.f, 0.f, 0.f, 0.f, 0.f, 0.f};
    const bool loader = F.wave >= 4;
    if (MIX == 0 && loader) {
        const float* lg = INF(8); const int c0 = 64 * h + ((F.tid - 256) & 7) * 8;
#pragma unroll
        for (int j = 0; j < 8; ++j) { const float x0 = lg[c0 + j], x1 = lg[256 + c0 + j], x2 = lg[512 + c0 + j], x3 = lg[768 + c0 + j]; const float mx = fmaxf(fmaxf(x0, x1), fmaxf(x2, x3));
            const float e0 = __expf(x0 - mx), e1 = __expf(x1 - mx), e2 = __expf(x2 - mx), e3 = __expf(x3 - mx); const float inv = 1.f / (e0 + e1 + e2 + e3);
            lbv[j] = (l >= 1 ? e1 : 0.f) + (l >= 2 ? e2 : 0.f) + (l >= 3 ? e3 : 0.f); lbv[j] *= inv; }
    }
    if (MIX == 1) { if (F.tid < 512) { const float* w2 = INF(10) + l * 16 * 128; LAS float* d = (LAS float*)(F.lds + SC_GW2); d[F.tid] = w2[(F.tid >> 5) * 128 + 32 * h + (F.tid & 31)]; } __syncthreads(); }
    constexpr int NBLK = SEQ / SC_TB;
    if (loader) { scan_fill<MIX>(F, l, b, h, q4, 0, F.lds, lbv); scan_fill<MIX>(F, l, b, h, q4, 1, F.lds + SC_SLOT, lbv); }
    __syncthreads();
    float s0 = 0.f, s1 = 0.f, s2 = 0.f, s3 = 0.f;
    const int sub = F.lane & 15, rq = F.lane >> 4, row = 4 * F.wave + rq;
    float* Ob = WSP(float, WS_O) + (size_t)MIX * TOK * 256 + 64 * h + 16 * q4 + row;
    for (int blk = 0; blk < NBLK; ++blk) {
        if (loader) { if (blk + 2 < NBLK) scan_fill<MIX>(F, l, b, h, q4, blk + 2, F.lds + ((blk + 2) % 3) * SC_SLOT, lbv); }
        else {
            const LAS float* S = (const LAS float*)(F.lds + (blk % 3) * SC_SLOT);
            const int tb = b * SEQ + blk * SC_TB;
#pragma unroll 4
            for (int tt = 0; tt < SC_TB; ++tt) {
                const f32x4 w4 = *(const LAS f32x4*)(S + tt * 64 + 4 * sub), k4 = *(const LAS f32x4*)(S + SC_TB * 64 + tt * 64 + 4 * sub), q4v = *(const LAS f32x4*)(S + 2 * SC_TB * 64 + tt * 64 + 4 * sub);
                const float v = S[5 * SC_TB * 64 + tt * 16 + row];
                if (MIX == 2) {
                    const f32x4 a4 = *(const LAS f32x4*)(S + 3 * SC_TB * 64 + tt * 64 + 4 * sub), b4 = *(const LAS f32x4*)(S + 4 * SC_TB * 64 + tt * 64 + 4 * sub);
                    float d = (s0 * a4.x + s1 * a4.y) + (s2 * a4.z + s3 * a4.w); d = -sum16(d);
                    s0 = fmaf(s0, w4.x, fmaf(d, b4.x, v * k4.x)); s1 = fmaf(s1, w4.y, fmaf(d, b4.y, v * k4.y)); s2 = fmaf(s2, w4.z, fmaf(d, b4.z, v * k4.z)); s3 = fmaf(s3, w4.w, fmaf(d, b4.w, v * k4.w));
                } else {
                    s0 = fmaf(s0, w4.x, v * k4.x); s1 = fmaf(s1, w4.y, v * k4.y); s2 = fmaf(s2, w4.z, v * k4.z); s3 = fmaf(s3, w4.w, v * k4.w);
                }
                float o = (s0 * q4v.x + s1 * q4v.y) + (s2 * q4v.z + s3 * q4v.w); o = sum16(o);
                if (sub == 0) Ob[(size_t)(tb + tt) * 256] = o;
            }
        }
        __syncthreads();
    }
}
__device__ __forceinline__ void phase_scan(Frame& F, int l) {
    for (int u = F.vcu; u < 256; u += F.G) {
        const int m = u & 3, bhq = u >> 2, b = bhq >> 4, h = (bhq >> 2) & 3, q4 = bhq & 3;
        if (m == 0) scan_unit<0>(F, l, b, h, q4); else if (m == 1) scan_unit<1>(F, l, b, h, q4); else if (m == 2) scan_unit<2>(F, l, b, h, q4); else scan_unit<3>(F, l, b, h, q4);
    }
}
__device__ __forceinline__ void phase_post(Frame& F, int l) {
    const int gw = F.vcu * NWAVES + F.wave, NGW = F.G * NWAVES;
    const int m = F.lane >> 4, h = (F.lane >> 2) & 3, qd = F.lane & 3; const int c0 = 64 * h + 16 * qd;
    const bf16* P = WSP(const bf16, WS_P); bf16* Y = WSP(bf16, WS_Y);
    const float* Ob = WSP(const float, WS_O) + (size_t)m * TOK * 256;
    for (int t = gw; t < TOK; t += NGW) {
        float o[16];
#pragma unroll
        for (int j = 0; j < 4; ++j) { const f32x4 v = *(const GAS f32x4*)(Ob + (size_t)t * 256 + c0 + 4 * j); o[4 * j] = v.x; o[4 * j + 1] = v.y; o[4 * j + 2] = v.z; o[4 * j + 3] = v.w; }
        float s1 = 0.f, s2 = 0.f;
#pragma unroll
        for (int j = 0; j < 16; ++j) { s1 += o[j]; s2 += o[j] * o[j]; }
        s1 = sum4(s1); s2 = sum4(s2);
        float y[16];
        if (m < 2) {
            const float rs = rsqrtf(s2 * (1.f / 64.f) + 1e-6f); const float* ng = INF(m == 0 ? 9 : 12) + l * 64 + 16 * qd;
            const int gc = (m == 0 ? HG_G : GL_R) + c0; float g[16]; { float a[8], b[8]; unpack8(*(const GAS v4u*)(P + (size_t)t * NP + gc), a); unpack8(*(const GAS v4u*)(P + (size_t)t * NP + gc + 8), b);
#pragma unroll
                for (int j = 0; j < 8; ++j) { g[j] = a[j]; g[8 + j] = b[j]; } }
#pragma unroll
            for (int j = 0; j < 16; ++j) y[j] = o[j] * rs * ng[j] * (g[j] * sigm(g[j]));
        } else if (m == 2) {
            const float mean = s1 * (1.f / 64.f); float var = s2 * (1.f / 64.f) - mean * mean; var = fmaxf(var, 0.f); const float rs = rsqrtf(var + 64e-5f);
            const size_t ob = (size_t)t * 256 + c0; float r[16], k[16], v[16], g[16];
            { float a[8], b[8];
              unpack8(*(const GAS v4u*)(WSP(const bf16, WS_RWR) + ob), a); unpack8(*(const GAS v4u*)(WSP(const bf16, WS_RWR) + ob + 8), b);
#pragma unroll
              for (int j = 0; j < 8; ++j) { r[j] = a[j]; r[8 + j] = b[j]; }
              unpack8(*(const GAS v4u*)(WSP(const bf16, WS_RWK) + ob), a); unpack8(*(const GAS v4u*)(WSP(const bf16, WS_RWK) + ob + 8), b);
#pragma unroll
              for (int j = 0; j < 8; ++j) { k[j] = a[j]; k[8 + j] = b[j]; }
              unpack8(*(const GAS v4u*)(WSP(const bf16, WS_RWV) + ob), a); unpack8(*(const GAS v4u*)(WSP(const bf16, WS_RWV) + ob + 8), b);
#pragma unroll
              for (int j = 0; j < 8; ++j) { v[j] = a[j]; v[8 + j] = b[j]; }
              unpack8(*(const GAS v4u*)(WSP(const bf16, WS_RWG) + ob), a); unpack8(*(const GAS v4u*)(WSP(const bf16, WS_RWG) + ob + 8), b);
#pragma unroll
              for (int j = 0; j < 8; ++j) { g[j] = a[j]; g[8 + j] = b[j]; } }
            const float* rk = INF(21) + l * 256 + c0; const float* lg = INF(22) + l * 256 + c0; const float* lb = INF(23) + l * 256 + c0;
            float bon = 0.f;
#pragma unroll
            for (int j = 0; j < 16; ++j) bon += r[j] * k[j] * rk[j];
            bon = sum4(bon);
#pragma unroll
            for (int j = 0; j < 16; ++j) y[j] = ((o[j] - mean) * rs * lg[j] + lb[j] + bon * v[j]) * g[j];
        } else {
            const float mean = s1 * (1.f / 64.f); float var = s2 * (1.f / 64.f) - mean * mean; var = fmaxf(var, 0.f); const float rs = rsqrtf(var + 1e-5f);
            float g[16]; { float a[8], b[8]; unpack8(*(const GAS v4u*)(P + (size_t)t * NP + RT_G + c0), a); unpack8(*(const GAS v4u*)(P + (size_t)t * NP + RT_G + c0 + 8), b);
#pragma unroll
                for (int j = 0; j < 8; ++j) { g[j] = a[j]; g[8 + j] = b[j]; } }
#pragma unroll
            for (int j = 0; j < 16; ++j) y[j] = (g[j] * sigm(g[j])) * ((o[j] - mean) * rs);
        }
        v4u w0, w1; w0.x = pk2(y[0], y[1]); w0.y = pk2(y[2], y[3]); w0.z = pk2(y[4], y[5]); w0.w = pk2(y[6], y[7]); w1.x = pk2(y[8], y[9]); w1.y = pk2(y[10], y[11]); w1.z = pk2(y[12], y[13]); w1.w = pk2(y[14], y[15]);
        GAS v4u* yo = (GAS v4u*)(Y + (size_t)t * D + 256 * m + c0); yo[0] = w0; yo[1] = w1;
    }
}
template <int MODE, bool ROUTE> __device__ __forceinline__ void phase_ln(Frame& F, const float* gw_, const float* bw_, const float* router, int mi) {
    const int gw = F.vcu * NWAVES + F.wave, NGW = F.G * NWAVES;
    bf16* hb = WSP(bf16, WS_HB); const float* MIXB = WSP(const float, WS_MIX); const bf16* DOUT = WSP(const bf16, WS_DOUT); float* GATE = WSP(float, WS_GATE);
    f32x4 gv[4], bv[4];
#pragma unroll
    for (int j = 0; j < 4; ++j) { gv[j] = ((const GAS f32x4*)gw_)[F.lane + 64 * j]; bv[j] = ((const GAS f32x4*)bw_)[F.lane + 64 * j]; }
    for (int m = gw; m < TOK; m += NGW) {
        GAS f32x4* hr = (GAS f32x4*)(F.h + (size_t)m * D) + F.lane;
        f32x4 v[4]; float s = 0.f;
        float g1 = 0.f, g2 = 0.f; if (MODE == 1) { g1 = GATE[2 * m]; g2 = GATE[2 * m + 1]; }
#pragma unroll
        for (int j = 0; j < 4; ++j) {
            f32x4 a;
            if (MODE == 0) a = ((const GAS f32x4*)(MIXB + (size_t)m * D))[F.lane + 64 * j];
            else { const v2u d1 = ((const GAS v2u*)(DOUT + (size_t)(2 * m) * D))[F.lane + 64 * j], d2 = ((const GAS v2u*)(DOUT + (size_t)(2 * m + 1) * D))[F.lane + 64 * j];
                a.x = g1 * bflo(d1.x) + g2 * bflo(d2.x); a.y = g1 * bfhi(d1.x) + g2 * bfhi(d2.x); a.z = g1 * bflo(d1.y) + g2 * bflo(d2.y); a.w = g1 * bfhi(d1.y) + g2 * bfhi(d2.y); }
            v[j] = hr[64 * j] * DN_ALPHA + a; s += (v[j].x + v[j].y) + (v[j].z + v[j].w); }
        const float mean = wave_sum(s) * (1.f / D); float s2 = 0.f;
#pragma unroll
        for (int j = 0; j < 4; ++j) { v[j] = v[j] - mean; s2 += (v[j].x * v[j].x + v[j].y * v[j].y) + (v[j].z * v[j].z + v[j].w * v[j].w); }
        const float rstd = 1.f / sqrtf(wave_sum(s2) * (1.f / D) + 1e-5f);
        GAS v2u* o8 = (GAS v2u*)(hb + (size_t)m * D) + F.lane;
#pragma unroll
        for (int j = 0; j < 4; ++j) { v[j] = v[j] * rstd * gv[j] + bv[j]; hr[64 * j] = v[j]; v2u w; w.x = pk2(v[j].x, v[j].y); w.y = pk2(v[j].z, v[j].w); o8[64 * j] = w; }
        if (ROUTE) {
            float lg[8] = {0.f, 0.f, 0.f, 0.f, 0.f, 0.f, 0.f, 0.f};
#pragma unroll
            for (int j = 0; j < 4; ++j) { const float hv[4] = {v[j].x, v[j].y, v[j].z, v[j].w};
#pragma unroll
                for (int c = 0; c < 4; ++c) { const int d = 4 * (F.lane + 64 * j) + c; const f32x4 r0 = *(const GAS f32x4*)(router + d * 8), r1 = *(const GAS f32x4*)(router + d * 8 + 4);
                    lg[0] += hv[c] * r0.x; lg[1] += hv[c] * r0.y; lg[2] += hv[c] * r0.z; lg[3] += hv[c] * r0.w; lg[4] += hv[c] * r1.x; lg[5] += hv[c] * r1.y; lg[6] += hv[c] * r1.z; lg[7] += hv[c] * r1.w; } }
#pragma unroll
            for (int e = 0; e < 8; ++e) lg[e] = wave_sum(lg[e]);
            int e1 = 0; float l1 = lg[0];
#pragma unroll
            for (int e = 1; e < 8; ++e) if (lg[e] > l1) { l1 = lg[e]; e1 = e; }
            int e2 = -1; float l2 = -3.0e38f;
#pragma unroll
            for (int e = 0; e < 8; ++e) if (e != e1 && lg[e] > l2) { l2 = lg[e]; e2 = e; }
            if (F.lane == 0) {
                const float p2 = __expf(l2 - l1); const float ga = 1.f / (1.f + p2);
                GATE[2 * m] = ga; GATE[2 * m + 1] = p2 * ga;
                int* list = WSP(int, WS_LIST) + (size_t)mi * NE * TOK;
                const unsigned p1 = __hip_atomic_fetch_add((unsigned*)(F.ctl + CW_CNT + (mi * 8 + e1) * 64), 1u, RLX_AGENT); list[e1 * TOK + p1] = 2 * m;
                const unsigned q2 = __hip_atomic_fetch_add((unsigned*)(F.ctl + CW_CNT + (mi * 8 + e2) * 64), 1u, RLX_AGENT); list[e2 * TOK + q2] = 2 * m + 1;
            }
        }
    }
}
__device__ __forceinline__ void phase_gather(Frame& F, int mi) {
    int cnt[8], poff[9]; poff[0] = 0;
#pragma unroll
    for (int e = 0; e < 8; ++e) { cnt[e] = (int)__hip_atomic_load((unsigned*)(F.ctl + CW_CNT + (mi * 8 + e) * 64), RLX_AGENT); poff[e + 1] = poff[e] + ((cnt[e] + 255) >> 8); }
    const int npan = poff[8];
    int* tab = WSP(int, WS_TAB) + mi * TAB_STRIDE;
    if (blockIdx.x == 0) {
        for (int P = F.tid; P < npan; P += NWAVES * 64) { int e = 0, pe = 0, ce = cnt[0];
#pragma unroll
            for (int j = 1; j < 8; ++j) if (P >= poff[j]) { e = j; pe = poff[j]; ce = cnt[j]; }
            tab[4 * P] = e; tab[4 * P + 1] = 256 * (P - pe); tab[4 * P + 2] = ce; tab[4 * P + 3] = 0; }
        if (F.tid == 0) tab[640] = npan;
    }
    const int gw = F.vcu * NWAVES + F.wave, NGW = F.G * NWAVES;
    const int* list = WSP(const int, WS_LIST) + (size_t)mi * NE * TOK; const bf16* hb = WSP(const bf16, WS_HB); bf16* HP = WSP(bf16, WS_HPERM);
    for (int row = gw; row < 256 * npan; row += NGW) { const int P = row >> 8; int e = 0, pe = 0, ce = cnt[0];
#pragma unroll
        for (int j = 1; j < 8; ++j) if (P >= poff[j]) { e = j; pe = poff[j]; ce = cnt[j]; }
        const int r = row - 256 * pe; const int tok = (r < ce) ? (list[e * TOK + r] >> 1) : 0;
        const GAS v4u* s = (const GAS v4u*)(hb + (size_t)tok * D) + F.lane; GAS v4u* d = (GAS v4u*)(HP + (size_t)row * D) + F.lane; d[0] = s[0]; d[64] = s[64]; }
}
struct Args { const void* in[34]; float* out; unsigned char* ws; int ph_lo, ph_hi; };
__global__ void __launch_bounds__(NWAVES * 64, 2) mk_fwd(Args args) {
    extern __shared__ __attribute__((aligned(16))) unsigned char lds[];
    Frame F;
    F.lds = (LAS unsigned char*)lds;
    F.MISC = (volatile LAS unsigned*)(F.lds + MISC_OFF);
    F.tid = threadIdx.x; F.lane = F.tid & 63; F.wave = __builtin_amdgcn_readfirstlane(F.tid >> 6);
    F.G = gridDim.x; { const int bx = blockIdx.x; F.vcu = (F.G % 8 == 0) ? (bx % 8) * (F.G / 8) + bx / 8 : bx; }
    F.ws = args.ws; F.in = args.in; F.h = args.out;
    F.ctl = (gu32*)(args.ws + WS_CTL);
    for (int u = F.tid; u < (LDS_BYTES - LDSCTL_OFF) / 4; u += NWAVES * 64) ((LAS unsigned*)(F.lds + LDSCTL_OFF))[u] = 0u;
    __syncthreads();
    XcdBarrier bar; bar.bar = (unsigned*)(F.ctl + CW_BAR); bar.x = 0; bar.st = nullptr;
    if (!MK_PER_PHASE) bar = xcd_barrier_post((unsigned*)(F.ctl + CW_BAR), F.MISC + 8);
    const int lo = args.ph_lo, hi = args.ph_hi;
#define IN(k) (lo <= (k) && (k) < hi)
#define PHASE_BEGIN() do { int t_ = threadIdx.x; asm volatile("" : "+v"(t_)); F.tid = t_; F.lane = t_ & 63; F.wave = __builtin_amdgcn_readfirstlane(t_ >> 6); } while (0)
#define SEAM(k) do { if (IN(k) && IN((k) + 1)) xcd_barrier(bar); } while (0)
    for (int l = 0; l < DEPTH; ++l) {
        const int pb = l * NPH; const bool moe = (l & 1); const int mi = l >> 1;
        if (((PHMASK >> 0) & 1) && IN(pb + 0)) { PHASE_BEGIN(); phase_weights(F, l); } SEAM(pb + 0);
        if (((PHMASK >> 1) & 1) && IN(pb + 1)) { PHASE_BEGIN();
            pg8::Gemm g{WSP(const bf16, WS_HB), WSP(const bf16, WS_WIN), TOK, NP, D}; pg8::StaticOrder S; S.init(TOK, NP, F.G, (int)blockIdx.x);
            pg8::EpiBf16 E{WSP(bf16, WS_P), NP};
            pg8::gemm_phase<pg8::EpiBf16, pg8::StaticOrder, true, true>(F.lds, g, S, E);
        } SEAM(pb + 1);
        if (((PHMASK >> 2) & 1) && IN(pb + 2)) { PHASE_BEGIN(); phase_rwprep(F, l); } SEAM(pb + 2);
        if (((PHMASK >> 3) & 1) && IN(pb + 3)) { PHASE_BEGIN(); phase_scan(F, l); } SEAM(pb + 3);
        if (((PHMASK >> 4) & 1) && IN(pb + 4)) { PHASE_BEGIN(); phase_post(F, l); } SEAM(pb + 4);
        if (((PHMASK >> 5) & 1) && IN(pb + 5)) { PHASE_BEGIN();
            pg8::Gemm g{WSP(const bf16, WS_Y), WSP(const bf16, WS_WOUT), TOK, D, D}; pg8::StaticOrder S; S.init(TOK, D, F.G, (int)blockIdx.x);
            pg8::EpiF32 E{WSP(float, WS_MIX), D};
            pg8::gemm_phase<pg8::EpiF32, pg8::StaticOrder, false, true>(F.lds, g, S, E);
        } SEAM(pb + 5);
        if (((PHMASK >> 6) & 1) && IN(pb + 6)) { PHASE_BEGIN();
            if (moe) phase_ln<0, true>(F, INF(4) + l * D, INF(5) + l * D, INF(30) + (size_t)mi * D * NE, mi);
            else phase_ln<0, false>(F, INF(4) + l * D, INF(5) + l * D, nullptr, 0);
        } SEAM(pb + 6);
        if (((PHMASK >> 7) & 1) && IN(pb + 7)) { PHASE_BEGIN(); if (moe) phase_gather(F, mi); } SEAM(pb + 7);
        if (((PHMASK >> 8) & 1) && IN(pb + 8)) { PHASE_BEGIN();
            if (!moe) { pg8::Gemm g{WSP(const bf16, WS_HB), WSP(const bf16, WS_WUP), TOK, 2 * FFD, D}; pg8::StaticOrder S; S.init(TOK, 2 * FFD, F.G, (int)blockIdx.x);
                pg8::EpiSwiGLU E{WSP(bf16, WS_HID), FFD, 22};
                pg8::gemm_phase<pg8::EpiSwiGLU, pg8::StaticOrder, true, true>(F.lds, g, S, E);
            } else { const int* tab = WSP(const int, WS_TAB) + mi * TAB_STRIDE; const int npan = tab[640];
                pg8::Gemm g{WSP(const bf16, WS_HPERM), WSP(const bf16, WS_WUP), 256 * npan, 2 * FFE, D}; pg8::MoeOrder S{tab, 11, F.G, (int)blockIdx.x, npan * 11};
                pg8::EpiSwiGLU E{WSP(bf16, WS_HID), FFE, 11};
                pg8::gemm_phase<pg8::EpiSwiGLU, pg8::MoeOrder, true, true>(F.lds, g, S, E);
            }
        } SEAM(pb + 8);
        if (((PHMASK >> 9) & 1) && IN(pb + 9)) { PHASE_BEGIN();
            if (!moe) { pg8::Gemm g{WSP(const bf16, WS_HID), WSP(const bf16, WS_WDN), TOK, D, FFD}; pg8::StaticOrder S; S.init(TOK, D, F.G, (int)blockIdx.x);
                pg8::EpiF32 E{WSP(float, WS_MIX), D};
                pg8::gemm_phase<pg8::EpiF32, pg8::StaticOrder, false, true>(F.lds, g, S, E);
            } else { const int* tab = WSP(const int, WS_TAB) + mi * TAB_STRIDE; const int npan = tab[640];
                pg8::Gemm g{WSP(const bf16, WS_HID), WSP(const bf16, WS_WDN), 256 * npan, D, FFE}; pg8::MoeOrder S{tab, 4, F.G, (int)blockIdx.x, npan * 4};
                pg8::EpiScatter E{WSP(bf16, WS_DOUT), tab, WSP(const int, WS_LIST) + (size_t)mi * NE * TOK};
                pg8::gemm_phase<pg8::EpiScatter, pg8::MoeOrder, true, true>(F.lds, g, S, E);
            }
        } SEAM(pb + 9);
        if (((PHMASK >> 10) & 1) && IN(pb + 10)) { PHASE_BEGIN();
            if (moe) phase_ln<1, false>(F, INF(6) + l * D, INF(7) + l * D, nullptr, 0);
            else phase_ln<0, false>(F, INF(6) + l * D, INF(7) + l * D, nullptr, 0);
        } SEAM(pb + 10);
    }
#undef IN
#undef SEAM
}

extern "C" void kernel_launch(void* const* d_in, const int* in_sizes, int n_in, void* d_out, int out_size, void* d_ws, size_t ws_size, hipStream_t stream) {
    static int grid = 0;
    if (grid == 0) {
        if (n_in != 34 || out_size != TOK * D || ws_size < WS_END) { fprintf(stderr, "kernel_launch: unexpected shapes (n_in %d, out %d, ws %zu)\n", n_in, out_size, ws_size); grid = -1; return; }
        int dev = 0, cus = 0, per_cu = 0;
        if (hipGetDevice(&dev) != hipSuccess || hipDeviceGetAttribute(&cus, hipDeviceAttributeMultiprocessorCount, dev) != hipSuccess) { grid = -1; return; }
        if (hipFuncSetAttribute((const void*)mk_fwd, hipFuncAttributeMaxDynamicSharedMemorySize, LDS_BYTES) != hipSuccess) { fprintf(stderr, "kernel_launch: hipFuncSetAttribute failed\n"); grid = -1; return; }
        if (hipOccupancyMaxActiveBlocksPerMultiprocessor(&per_cu, (const void*)mk_fwd, NWAVES * 64, LDS_BYTES) != hipSuccess || per_cu < 1) fprintf(stderr, "kernel_launch: occupancy query reports %d\n", per_cu);
        (void)hipGetLastError();
        grid = cus;
    }
    if (grid < 0) return;
    if (hipMemsetAsync((char*)d_ws + WS_CTL, 0, CTL_ZERO_BYTES, stream) != hipSuccess) return;
    Args a{};
    for (int i = 0; i < 34; ++i) a.in[i] = d_in[i];
    a.out = (float*)d_out; a.ws = (unsigned char*)d_ws;
#if MK_PER_PHASE
    for (int p = 0; p < NPHASES; ++p) { a.ph_lo = p; a.ph_hi = p + 1; hipLaunchKernelGGL(mk_fwd, dim3(grid), dim3(NWAVES * 64), LDS_BYTES, stream, a); }
#else
    a.ph_lo = 0; a.ph_hi = NPHASES; hipLaunchKernelGGL(mk_fwd, dim3(grid), dim3(NWAVES * 64), LDS_BYTES, stream, a);
#endif
}
```

```cpp
#include <hip/hip_runtime.h>
#include <cstdio>
#include <cstdint>
#ifndef PHMASK
#define PHMASK 0xfff
#endif
#ifndef DUPMASK
#define DUPMASK 0
#endif
#ifndef MK_PER_PHASE
#define MK_PER_PHASE 0
#endif
namespace pg8 {
#define PG8_LAS __attribute__((address_space(3)))
typedef unsigned short bf16_t;
typedef short bf16x8 __attribute__((ext_vector_type(8)));
typedef float f32x4 __attribute__((ext_vector_type(4)));
typedef unsigned u32x4 __attribute__((ext_vector_type(4)));
constexpr int BM = 256, BK = 64, HALF = 128, HTB = HALF * BK * 2  , STAGE_BYTES = 8 * HTB, NXCD = 8, WGM = 8;

__host__ __device__ __forceinline__ int lds_byte(int r, int c) { const int st = (r >> 4) * 2 + (c >> 5), rr = r & 15, cc = c & 31, ob = rr * 64 + cc * 2; return st * 1024 + (ob ^ (((ob >> 9) & 1) << 5)); }
__host__ __device__ __forceinline__ void stage_rc(int b, int& R, int& C) { const int st = b / 1024, sb = b % 1024, swz = sb ^ (((sb >> 9) & 1) << 5); R = (st >> 1) * 16 + swz / 64; C = (st & 1) * 32 + (swz % 64) / 2; }
__host__ __device__ __forceinline__ int perm32(int rho) { const int n = rho >> 4, i = rho & 15; return 8 * (i >> 2) + 4 * n + (i & 3); }

struct Unit { int pm, pn; };
struct Gemm { const bf16_t* A; const bf16_t* Bt; int M, N, K; };

struct StaticOrder {
    int nM, nN, nwg, G, c;
    __host__ __device__ void init(int M, int N, int G_, int c_) { nM = M / BM; nN = N / BM; nwg = nM * nN; G = G_; c = c_; }
    __host__ __device__ bool next(int i, Unit& u) const {
        const long L = (long)i * G + c; if (L >= nwg) return false;
        int wgid = (int)L; { const int q = nwg / NXCD, r = nwg % NXCD, xcd = wgid % NXCD, off = wgid / NXCD; wgid = (xcd < r ? xcd * (q + 1) : r * (q + 1) + (xcd - r) * q) + off; }
        const int nig = WGM * nN, gid = wgid / nig, fm = gid * WGM, gsz = (nM - fm) < WGM ? (nM - fm) : WGM;
        u.pm = fm + ((wgid % nig) % gsz); u.pn = (wgid % nig) / gsz; return true;
    }
    __device__ __forceinline__ void a_ready(const Unit&) const {}
    __device__ __forceinline__ void done(const Unit&) const {}
};
__device__ __forceinline__ unsigned cvt_pk_bf16(float lo, float hi) { unsigned r; asm volatile("v_cvt_pk_bf16_f32 %0, %1, %2" : "=v"(r) : "v"(lo), "v"(hi)); return r; }
typedef float f32x2 __attribute__((ext_vector_type(2)));
struct EpiBf16 {
    static constexpr bool PERM = true, AFTER_DRAIN = false;
    bf16_t* O; int ldc;
    __device__ __forceinline__ void operator()(const f32x4 (&acc)[2][2][4][2], const Unit& u, int wr, int wc, int fr, int fq) const {
        const int row0 = u.pm * BM + wr * 64 + fr; const int col0 = u.pn * BM + wc * 32 + 8 * fq;
#pragma unroll
        for (int ai = 0; ai < 2; ++ai)
#pragma unroll
            for (int m = 0; m < 4; ++m) { bf16_t* rowp = O + (size_t)(row0 + ai * HALF + m * 16) * ldc + col0;
#pragma unroll
                for (int bj = 0; bj < 2; ++bj) { const f32x4 v0 = acc[ai][bj][m][0], v1 = acc[ai][bj][m][1];
                    u32x4 w; w.x = cvt_pk_bf16(v0[0], v0[1]); w.y = cvt_pk_bf16(v0[2], v0[3]); w.z = cvt_pk_bf16(v1[0], v1[1]); w.w = cvt_pk_bf16(v1[2], v1[3]);
                    *(u32x4*)(rowp + bj * HALF) = w; } }
    }
};
struct EpiF32 {
    static constexpr bool PERM = false, AFTER_DRAIN = false;
    float* C; int ldc;
    __device__ __forceinline__ void operator()(const f32x4 (&acc)[2][2][4][2], const Unit& u, int wr, int wc, int fr, int fq) const {
        const int row0 = u.pm * BM + wr * 64 + fr, col0 = u.pn * BM + wc * 32 + 4 * fq;
#pragma unroll
        for (int ai = 0; ai < 2; ++ai)
#pragma unroll
            for (int m = 0; m < 4; ++m) { float* rowp = C + (size_t)(row0 + ai * HALF + m * 16) * ldc + col0;
#pragma unroll
                for (int bj = 0; bj < 2; ++bj)
#pragma unroll
                    for (int n = 0; n < 2; ++n) *(f32x4*)(rowp + bj * HALF + n * 16) = acc[ai][bj][m][n]; }
    }
};
__device__ __forceinline__ float silu_f(float x) { return x * __builtin_amdgcn_rcpf(1.0f + __expf(-x)); }
struct EpiSwiGLU {
    static constexpr bool PERM = true, AFTER_DRAIN = false;
    bf16_t* O; int ldc; int tiles_per_group;
    __device__ __forceinline__ void operator()(const f32x4 (&acc)[2][2][4][2], const Unit& u, int wr, int wc, int fr, int fq) const {
        const int row0 = u.pm * BM + wr * 64 + fr; const int pnl = u.pn % tiles_per_group; const int col0 = pnl * HALF + wc * 32 + 8 * fq;
#pragma unroll
        for (int ai = 0; ai < 2; ++ai)
#pragma unroll
            for (int m = 0; m < 4; ++m) { bf16_t* rowp = O + (size_t)(row0 + ai * HALF + m * 16) * ldc + col0;
                float h[8];
#pragma unroll
                for (int n = 0; n < 2; ++n)
#pragma unroll
                    for (int j = 0; j < 4; ++j) h[4 * n + j] = silu_f(acc[ai][0][m][n][j]) * acc[ai][1][m][n][j];
                u32x4 w; w.x = cvt_pk_bf16(h[0], h[1]); w.y = cvt_pk_bf16(h[2], h[3]); w.z = cvt_pk_bf16(h[4], h[5]); w.w = cvt_pk_bf16(h[6], h[7]);
                *(u32x4*)rowp = w; }
    }
};
struct EpiScatter {
    static constexpr bool PERM = true, AFTER_DRAIN = false;
    bf16_t* O; const int* tab;
    const int* list;
    __device__ __forceinline__ void operator()(const f32x4 (&acc)[2][2][4][2], const Unit& u, int wr, int wc, int fr, int fq) const {
        const int e = tab[4 * u.pm + 0], lr = tab[4 * u.pm + 1], cnt = tab[4 * u.pm + 2];
        const int pnl = u.pn & 3; const int col0 = pnl * BM + wc * 32 + 8 * fq; const int* lst = list + e * 16384;
#pragma unroll
        for (int ai = 0; ai < 2; ++ai)
#pragma unroll
            for (int m = 0; m < 4; ++m) { const int r = lr + wr * 64 + fr + ai * HALF + m * 16;
                if (r < cnt) { const int slot = lst[r]; bf16_t* rowp = O + (size_t)slot * 1024 + col0;
#pragma unroll
                    for (int bj = 0; bj < 2; ++bj) { const f32x4 v0 = acc[ai][bj][m][0], v1 = acc[ai][bj][m][1];
                        u32x4 w; w.x = cvt_pk_bf16(v0[0], v0[1]); w.y = cvt_pk_bf16(v0[2], v0[3]); w.z = cvt_pk_bf16(v1[0], v1[1]); w.w = cvt_pk_bf16(v1[2], v1[3]);
                        *(u32x4*)(rowp + bj * HALF) = w; } } }
    }
};
struct MoeOrder {
    const int* tab; int tpg, G, c, nunits;
    __device__ __forceinline__ bool next(int i, Unit& u) const {
        const int L = i * G + c; if (L >= nunits) return false;
        const int P = L / tpg, pnl = L - P * tpg; const int e = tab[4 * P];
        u.pm = P; u.pn = e * tpg + pnl; return true;
    }
    __device__ __forceinline__ void a_ready(const Unit&) const {}
    __device__ __forceinline__ void done(const Unit&) const {}
};
template <class Epi, class Sched, bool ALIGN_EPI = false, bool SP2 = false>
__device__ __forceinline__ void gemm_phase(PG8_LAS unsigned char* lds, const Gemm g, const Sched& S, const Epi& E) {
    int tid_ = threadIdx.x; asm volatile("" : "+v"(tid_));
    const int tid = tid_, wid = __builtin_amdgcn_readfirstlane(tid >> 6), lane = tid & 63, wr = wid >> 2, wc = wid & 3, fr = lane & 15, fq = lane >> 4;
    const int K = g.K, nt = K / BK;
    unsigned voffA[2], voffB[2];
#pragma unroll
    for (int i = 0; i < 2; ++i) { int R, C; stage_rc(tid * 16 + i * 8192, R, C); const int Rb = Epi::PERM ? ((R & ~31) + perm32(R & 31)) : R;
        voffA[i] = (unsigned)(R * K + C) * 2u; voffB[i] = (unsigned)(Rb * K + C) * 2u; }
    const size_t kstep = (size_t)(BK * 2);
    const size_t hstep = (size_t)HALF * K * 2;
    const size_t tstep = 2 * hstep;
    const unsigned ldsw = (unsigned)wid * 1024u;
    const int aoff = lds_byte(wr * 64 + fr, fq * 8), boff = lds_byte(wc * 32 + fr, fq * 8);
#define PG8_SA(b, h) (((b) * 2 + (h)) * HTB)
#define PG8_SB(b, h) ((4 + (b) * 2 + (h)) * HTB)
#define PG8_STAGE(bufoff, gbase, voff) do { _Pragma("unroll") for (int _i = 0; _i < 2; ++_i) \
        __builtin_amdgcn_global_load_lds((const unsigned*)((const char*)(gbase) + (voff)[_i]), (PG8_LAS unsigned*)(lds + (bufoff) + ldsw + _i * 8192), 16, 0, 0); } while (0)
#define PG8_LDA(dst, b, h) do { _Pragma("unroll") for (int m = 0; m < 4; ++m) _Pragma("unroll") for (int k = 0; k < 2; ++k) dst[m][k] = *(const PG8_LAS bf16x8*)(lds + PG8_SA(b, h) + aoff + m * 2048 + k * 1024); } while (0)
#define PG8_LDB(dst, b, h) do { _Pragma("unroll") for (int n = 0; n < 2; ++n) _Pragma("unroll") for (int k = 0; k < 2; ++k) dst[n][k] = *(const PG8_LAS bf16x8*)(lds + PG8_SB(b, h) + boff + n * 2048 + k * 1024); } while (0)
#define PG8_MMA(ai, bj, At, Bt) do { __builtin_amdgcn_s_setprio(1); _Pragma("unroll") for (int m = 0; m < 4; ++m) _Pragma("unroll") for (int n = 0; n < 2; ++n) _Pragma("unroll") for (int k = 0; k < 2; ++k) \
        acc[ai][bj][m][n] = __builtin_amdgcn_mfma_f32_16x16x32_bf16(Bt[n][k], At[m][k], acc[ai][bj][m][n], 0, 0, 0); __builtin_amdgcn_s_setprio(0); } while (0)
#define PG8_WAIT_V(n) asm volatile("s_waitcnt vmcnt(" #n ")" ::: "memory")
#define PG8_WAIT_L(n) asm volatile("s_waitcnt lgkmcnt(" #n ")" ::: "memory")
#define PG8_BAR __builtin_amdgcn_s_barrier()
#define PG8_SCHED __builtin_amdgcn_sched_barrier(0)
    Unit cur, nxt; int ui = 0;
    if (!S.next(0, cur)) return;
    f32x4 acc[2][2][4][2];
#pragma unroll
    for (int a = 0; a < 2; ++a)
#pragma unroll
        for (int b = 0; b < 2; ++b)
#pragma unroll
            for (int m = 0; m < 4; ++m)
#pragma unroll
                for (int n = 0; n < 2; ++n) acc[a][b][m][n] = (f32x4){0.f, 0.f, 0.f, 0.f};
    bf16x8 At[4][2], B0[2][2], B1[2][2];
    const char* cA = (const char*)g.A + (size_t)cur.pm * tstep; const char* cB = (const char*)g.Bt + (size_t)cur.pn * tstep;
    S.a_ready(cur);
    if constexpr (SP2) {
        PG8_STAGE(PG8_SB(0, 0), cB, voffB); PG8_STAGE(PG8_SB(0, 1), cB + hstep, voffB); PG8_STAGE(PG8_SA(0, 0), cA, voffA); PG8_STAGE(PG8_SA(0, 1), cA + hstep, voffA);
        if (wr == 1) PG8_BAR;
        PG8_WAIT_V(2); PG8_BAR;
        PG8_STAGE(PG8_SB(1, 0), cB + kstep, voffB); PG8_STAGE(PG8_SA(1, 0), cA + kstep, voffA); PG8_STAGE(PG8_SB(1, 1), cB + hstep + kstep, voffB);
        PG8_WAIT_V(6); PG8_BAR;
    } else {
        PG8_STAGE(PG8_SB(0, 0), cB, voffB); PG8_STAGE(PG8_SA(0, 0), cA, voffA); PG8_STAGE(PG8_SB(0, 1), cB + hstep, voffB); PG8_STAGE(PG8_SA(0, 1), cA + hstep, voffA);
        if (wr == 1) PG8_BAR;
        PG8_WAIT_V(4); PG8_BAR;
        PG8_STAGE(PG8_SB(1, 0), cB + kstep, voffB); PG8_STAGE(PG8_SA(1, 0), cA + kstep, voffA); PG8_STAGE(PG8_SB(1, 1), cB + hstep + kstep, voffB);
        PG8_WAIT_V(6); PG8_BAR;
    }
    for (;;) {
        const bool has_next = S.next(ui + 1, nxt);
        const char* nA = has_next ? (const char*)g.A + (size_t)nxt.pm * tstep : cA; const char* nB = has_next ? (const char*)g.Bt + (size_t)nxt.pn * tstep : cB;
        for (int t = 0; t < nt; t += 2) {
            const bool last = (t == nt - 2);
            const char* a1 = cA + (size_t)(t + 1) * kstep;
            const char* a2 = last ? nA : cA + (size_t)(t + 2) * kstep; const char* b2 = last ? nB : cB + (size_t)(t + 2) * kstep;
            const char* a3 = a2 + kstep; const char* b3 = b2 + kstep;
            if (last && has_next) S.a_ready(nxt);
            if constexpr (SP2) {
            PG8_LDB(B0, 0, 0); PG8_LDB(B1, 0, 1); PG8_SCHED; PG8_LDA(At, 0, 0); PG8_STAGE(PG8_SA(1, 1), a1 + hstep, voffA);
            PG8_WAIT_V(8); PG8_WAIT_L(0); PG8_BAR; PG8_MMA(0, 0, At, B0); PG8_MMA(0, 1, At, B1); PG8_BAR; PG8_SCHED;
            PG8_LDA(At, 0, 1); PG8_STAGE(PG8_SB(0, 0), b2, voffB); PG8_STAGE(PG8_SB(0, 1), b2 + hstep, voffB); PG8_STAGE(PG8_SA(0, 0), a2, voffA);
            PG8_WAIT_V(8); PG8_WAIT_L(0); PG8_BAR; PG8_MMA(1, 0, At, B0); PG8_MMA(1, 1, At, B1); PG8_BAR; PG8_SCHED;
            PG8_LDB(B0, 1, 0); PG8_LDB(B1, 1, 1); PG8_SCHED; PG8_LDA(At, 1, 0); PG8_STAGE(PG8_SA(0, 1), a2 + hstep, voffA);
            PG8_WAIT_V(8); PG8_WAIT_L(0); PG8_BAR; PG8_MMA(0, 0, At, B0); PG8_MMA(0, 1, At, B1); PG8_BAR; PG8_SCHED;
            PG8_LDA(At, 1, 1); PG8_STAGE(PG8_SB(1, 0), b3, voffB); PG8_STAGE(PG8_SB(1, 1), b3 + hstep, voffB); PG8_STAGE(PG8_SA(1, 0), a3, voffA);
            PG8_WAIT_V(8); PG8_WAIT_L(0); PG8_BAR; PG8_MMA(1, 0, At, B0); PG8_MMA(1, 1, At, B1); PG8_BAR; PG8_SCHED;
            } else {
            PG8_LDB(B0, 0, 0); PG8_SCHED; PG8_LDA(At, 0, 0); PG8_STAGE(PG8_SA(1, 1), a1 + hstep, voffA);
            PG8_WAIT_L(8); PG8_BAR; PG8_WAIT_L(0); PG8_MMA(0, 0, At, B0); PG8_BAR; PG8_SCHED;
            PG8_LDB(B1, 0, 1); PG8_STAGE(PG8_SB(0, 0), b2, voffB);
            PG8_BAR; PG8_WAIT_L(0); PG8_MMA(0, 1, At, B1); PG8_BAR;
            PG8_LDA(At, 0, 1); PG8_STAGE(PG8_SA(0, 0), a2, voffA);
            PG8_BAR; PG8_WAIT_L(0); PG8_MMA(1, 0, At, B0); PG8_BAR; PG8_SCHED;
            PG8_STAGE(PG8_SB(0, 1), b2 + hstep, voffB);
            PG8_WAIT_V(6); PG8_BAR; PG8_MMA(1, 1, At, B1); PG8_BAR;
            PG8_LDB(B0, 1, 0); PG8_SCHED; PG8_LDA(At, 1, 0); PG8_STAGE(PG8_SA(0, 1), a2 + hstep, voffA);
            PG8_WAIT_L(8); PG8_BAR; PG8_WAIT_L(0); PG8_MMA(0, 0, At, B0); PG8_BAR; PG8_SCHED;
            PG8_LDB(B1, 1, 1); PG8_STAGE(PG8_SB(1, 0), b3, voffB);
            PG8_BAR; PG8_WAIT_L(0); PG8_MMA(0, 1, At, B1); PG8_BAR;
            PG8_LDA(At, 1, 1); PG8_STAGE(PG8_SA(1, 0), a3, voffA);
            PG8_BAR; PG8_WAIT_L(0); PG8_MMA(1, 0, At, B0); PG8_BAR; PG8_SCHED;
            PG8_STAGE(PG8_SB(1, 1), b3 + hstep, voffB);
            PG8_WAIT_V(6); PG8_BAR; PG8_MMA(1, 1, At, B1); PG8_BAR;
            }
        }
        if constexpr (ALIGN_EPI) { if (wr == 0) PG8_BAR; }
        if constexpr (!Epi::AFTER_DRAIN) { E(acc, cur, wr, wc, fr, fq); S.done(cur); }
        if (!has_next) break;
#pragma unroll
        for (int a = 0; a < 2; ++a)
#pragma unroll
            for (int b = 0; b < 2; ++b)
#pragma unroll
                for (int m = 0; m < 4; ++m)
#pragma unroll
                    for (int n = 0; n < 2; ++n) acc[a][b][m][n] = (f32x4){0.f, 0.f, 0.f, 0.f};
        cur = nxt; cA = nA; cB = nB; ++ui;
        if constexpr (ALIGN_EPI) { if (wr == 1) PG8_BAR; }
    }
    PG8_WAIT_V(0);
    if constexpr (!ALIGN_EPI) { if (wr == 0) PG8_BAR; }
    PG8_BAR;
    if constexpr (Epi::AFTER_DRAIN) { E.fused(acc, cur, wr, wc, fr, fq, lds, wid, lane); S.done(cur); }
#undef PG8_SA
#undef PG8_SB
#undef PG8_STAGE
#undef PG8_LDA
#undef PG8_LDB
#undef PG8_MMA
#undef PG8_WAIT_V
#undef PG8_WAIT_L
#undef PG8_BAR
#undef PG8_SCHED
}
}
constexpr int NWAVES = 8;
constexpr int TOK = 16384, SEQ = 4096, D = 1024, NP = 4096, INC = 3888, DEPTH = 4;
constexpr int HG_Q = 0, HG_F = 256, HG_I = 512, HG_G = 768;
constexpr int GL_Q = 1024, GL_K = 1152, GL_V = 1280, GL_GLR = 1536, GL_R = 1552;
constexpr int RW_BASE = 1808, RW_R = 1808, RW_K = 2064, RW_V = 2320, RW_WLR = 2576, RW_ALR = 2640, RW_GLR = 2704;
constexpr int RT_Q = 2864, RT_K = 3120, RT_V = 3376, RT_G = 3632;
constexpr int FFD = 2816, FFE = 1408, NE = 8;
constexpr float DN_ALPHA = 1.6817928305074290f;
constexpr int NPH = 12;
constexpr int NPHASES = NPH * DEPTH;
constexpr size_t MiB = 1u << 20;
constexpr size_t WS_CTL = 0, CTL_ZERO_BYTES = 1 * MiB;
constexpr size_t WS_LIST = 1 * MiB;
constexpr size_t WS_GATE = 2 * MiB;
constexpr size_t WS_TAB = 3 * MiB;
constexpr size_t WS_WIN = 4 * MiB, WS_WOUT = 12 * MiB, WS_WUP = 14 * MiB, WS_WDN = 58 * MiB;
constexpr size_t WS_HB = 80 * MiB;
constexpr size_t WS_MIX = 112 * MiB;
constexpr size_t WS_O = WS_MIX;
constexpr size_t WS_VF = 176 * MiB;
constexpr size_t WS_P = 184 * MiB;
constexpr size_t WS_RWW = 312 * MiB;
constexpr size_t WS_RWR = 328 * MiB, WS_RWK = 336 * MiB, WS_RWV = 344 * MiB, WS_RWKK = 352 * MiB, WS_RWB = 360 * MiB, WS_RWG = 368 * MiB;
constexpr size_t WS_Y = 376 * MiB;
constexpr size_t WS_HID = 184 * MiB;
constexpr size_t WS_DOUT = 280 * MiB;
constexpr size_t WS_HPERM = 344 * MiB;
constexpr size_t WS_END = 461 * MiB;
constexpr int CW_BAR = 4096;
constexpr int CW_CNT = 16384;
constexpr int TAB_STRIDE = 4 * 160 + 16;
constexpr int RING_BYTES = 131072, LDSCTL_OFF = 146432, MISC_OFF = LDSCTL_OFF + 320, LDS_BYTES = 147456;
#define GAS __attribute__((address_space(1)))
#define LAS __attribute__((address_space(3)))
typedef unsigned short bf16;
typedef unsigned v4u __attribute__((ext_vector_type(4)));
typedef unsigned v2u __attribute__((ext_vector_type(2)));
typedef float f32x4 __attribute__((ext_vector_type(4)));
typedef short bf16x8 __attribute__((ext_vector_type(8)));
typedef GAS unsigned gu32;
#define RLX_AGENT __ATOMIC_RELAXED, __HIP_MEMORY_SCOPE_AGENT
#define LDS_WAIT() asm volatile("s_waitcnt lgkmcnt(0)" ::: "memory")
#define VM_WAIT() asm volatile("s_waitcnt vmcnt(0)" ::: "memory")
__device__ __forceinline__ unsigned f2bf(float f) { unsigned u = __builtin_bit_cast(unsigned, f); return (u + 0x7fffu + ((u >> 16) & 1u)) >> 16; }
__device__ __forceinline__ unsigned pk2(float lo, float hi) { return f2bf(lo) | (f2bf(hi) << 16); }
__device__ __forceinline__ float bflo(unsigned w) { return __builtin_bit_cast(float, w << 16); }
__device__ __forceinline__ float bfhi(unsigned w) { return __builtin_bit_cast(float, w & 0xffff0000u); }
__device__ __forceinline__ float bf1(bf16 b) { return __builtin_bit_cast(float, ((unsigned)b) << 16); }
__device__ __forceinline__ void unpack8(const v4u w, float (&f)[8]) { f[0] = bflo(w.x); f[1] = bfhi(w.x); f[2] = bflo(w.y); f[3] = bfhi(w.y); f[4] = bflo(w.z); f[5] = bfhi(w.z); f[6] = bflo(w.w); f[7] = bfhi(w.w); }
__device__ __forceinline__ v4u pack8(const float (&f)[8]) { v4u w; w.x = pk2(f[0], f[1]); w.y = pk2(f[2], f[3]); w.z = pk2(f[4], f[5]); w.w = pk2(f[6], f[7]); return w; }
__device__ __forceinline__ float sigm(float x) { return __builtin_amdgcn_rcpf(1.0f + __expf(-x)); }
template <int CTRL> __device__ __forceinline__ float dpp(float x) { return __builtin_bit_cast(float, __builtin_amdgcn_mov_dpp(__builtin_bit_cast(int, x), CTRL, 0xf, 0xf, true)); }
__device__ __forceinline__ float sum16(float x) { x += dpp<0xB1>(x); x += dpp<0x4E>(x); x += dpp<0x141>(x); x += dpp<0x128>(x); return x; }
__device__ __forceinline__ float sum4(float x) { x += dpp<0xB1>(x); x += dpp<0x4E>(x); return x; }
__device__ __forceinline__ float wave_sum(float v) {
#pragma unroll
    for (int o = 1; o < 64; o <<= 1) v += __shfl_xor(v, o);
    return v;
}
__device__ const double INVF2PI[32] = {0.15915494309189535, 0.11934937021124886, 0.08949940160889101, 0.06711508300522726, 0.050329212104487035, 0.03774158471741977, 0.0283021958306234, 0.02122365276477766, 0.015915494309189534, 0.011934937021124886, 0.008949940160889102, 0.006711508300522725, 0.005032921210448704, 0.003774158471741977, 0.00283021958306234, 0.0021223652764777662, 0.0015915494309189536, 0.0011934937021124885, 0.0008949940160889102, 0.0006711508300522726, 0.0005032921210448703, 0.00037741584717419774, 0.00028302195830623395, 0.0002122365276477766, 0.00015915494309189535, 0.00011934937021124886, 8.949940160889102e-05, 6.711508300522725e-05, 5.0329212104487035e-05, 3.774158471741978e-05, 2.8302195830623396e-05, 2.122365276477766e-05};
#define XB_TMO      128
#define XB_XCNT(j)  (256  + 64 * (j))
#define XB_XSUB(j)  (1280 + 64 * (j))
#define XB_XGEN(j)  (2304 + 64 * (j))
#define XB_TOP      3328
#define XB_TOPGEN   3392
#define XCD_BAR_WORDS 3456
#define XB_SPIN_CAP (1u << 18)

__device__ __forceinline__ unsigned xb_ld(unsigned* p)              { return __hip_atomic_load(p, __ATOMIC_RELAXED, __HIP_MEMORY_SCOPE_AGENT); }
__device__ __forceinline__ unsigned xb_add(unsigned* p, unsigned v) { return __hip_atomic_fetch_add(p, v, __ATOMIC_RELAXED, __HIP_MEMORY_SCOPE_AGENT); }
__device__ __forceinline__ unsigned xb_xcc_id() { return (unsigned)__builtin_amdgcn_s_getreg((3 << 11) | 20) & 0xFu; }
#define XB_SPIN(cond, bar) do { unsigned _sp = 0; while (cond) { __builtin_amdgcn_s_sleep(1); \
    if ((++_sp & 255u) == 0u) { if (xb_ld(&(bar)[XB_TMO])) break; if (_sp > XB_SPIN_CAP) { atomicAdd(&(bar)[XB_TMO], 1u); break; } } } } while (0)

struct XcdBarrier {
    unsigned* bar; unsigned x;
    volatile LAS unsigned* st;
};

__device__ __forceinline__ XcdBarrier xcd_barrier_post(unsigned* bar, volatile LAS unsigned* st) {
    XcdBarrier b; b.bar = bar; b.x = xb_xcc_id(); b.st = st;
    if (threadIdx.x == 0) (void)xb_add(&bar[XB_XCNT(b.x)], 1u);
    return b;
}
__device__ __forceinline__ void xcd_barrier_complete(unsigned* bar, unsigned x, unsigned& nloc, unsigned& nx) {
    const unsigned G = gridDim.x * gridDim.y * gridDim.z;
    unsigned sum, cnt, mine, sp = 0u;
    for (;;) {
        sum = 0u; cnt = 0u; mine = 0u;
#pragma unroll
        for (unsigned j = 0; j < 16; ++j) { const unsigned c = xb_ld(&bar[XB_XCNT(j)]); sum += c; cnt += (c > 0u) ? 1u : 0u; mine = (j == x) ? c : mine; }
        if (sum == G) break;
        __builtin_amdgcn_s_sleep(1);
        if ((++sp & 255u) == 0u) { if (xb_ld(&bar[XB_TMO])) break; if (sp > XB_SPIN_CAP) { atomicAdd(&bar[XB_TMO], 1u); break; } }
    }
    nloc = mine > 0u ? mine : 1u; nx = cnt > 0u ? cnt : 1u;
}

__device__ __forceinline__ void xcd_barrier(const XcdBarrier& b) {
    asm volatile("s_waitcnt vmcnt(0)" ::: "memory");
    __syncthreads();
    if (threadIdx.x == 0) {
        unsigned* bar = b.bar;
        __builtin_amdgcn_s_waitcnt(0);
        unsigned nloc = b.st[0], nx = b.st[1];
        if (nloc == 0u) { xcd_barrier_complete(bar, b.x, nloc, nx); b.st[0] = nloc; b.st[1] = nx; }
        const unsigned old = xb_add(&bar[XB_XSUB(b.x)], 1u);
        const unsigned gen = old / nloc;
        if (old + 1u == (gen + 1u) * nloc) {
            __builtin_amdgcn_fence(__ATOMIC_RELEASE, "agent");
            asm volatile("s_waitcnt vmcnt(0)" ::: "memory");
            const unsigned og = xb_add(&bar[XB_TOP], 1u);
            const unsigned tg = og / nx;
            if (og + 1u == (tg + 1u) * nx) xb_add(&bar[XB_TOPGEN], 1u);
            else XB_SPIN(xb_ld(&bar[XB_TOPGEN]) == tg, bar);
            __builtin_amdgcn_fence(__ATOMIC_ACQUIRE, "agent");
            xb_add(&bar[XB_XGEN(b.x)], 1u);
            asm volatile("s_waitcnt vmcnt(0)" ::: "memory");
        } else {
            XB_SPIN(xb_ld(&bar[XB_XGEN(b.x)]) == gen, bar);
            __builtin_amdgcn_fence(__ATOMIC_ACQUIRE, "agent");
            asm volatile("s_waitcnt vmcnt(0)" ::: "memory");
        }
    }
    __syncthreads();
}
struct Frame {
    LAS unsigned char* lds;
    volatile LAS unsigned* MISC;
    gu32* ctl;
    int tid, lane, wave;
    int vcu, G;
    unsigned char* ws;
    const void* const* in;
    float* h;
};
__device__ __forceinline__ const void* ldptr(const void* const* tab, int k) { int z; asm volatile("s_mov_b32 %0, 0" : "=s"(z)); return tab[k + z]; }
#define INF(k) ((const float*)ldptr(F.in, k))
#define WSP(T, off) ((T*)(F.ws + (off)))

__device__ __forceinline__ void xpose_item(const float* W, int ldw, int nvalid, int k0, int n0, bf16* WT, int ldt, int drow0, LAS float* scr, int lane) {
#pragma unroll 8
    for (int i = 0; i < 32; ++i) { const int kk = 2 * i + (lane >> 5), n = n0 + (lane & 31); scr[kk * 33 + (lane & 31)] = (n < nvalid) ? W[(size_t)(k0 + kk) * ldw + n] : 0.f; }
    LDS_WAIT(); asm volatile("" ::: "memory");
    const int c = lane & 7;
#pragma unroll
    for (int j = 0; j < 4; ++j) { const int n = (lane >> 3) + 8 * j; const LAS float* s = scr + (8 * c) * 33 + n;
        v4u o; o.x = pk2(s[0 * 33], s[1 * 33]); o.y = pk2(s[2 * 33], s[3 * 33]); o.z = pk2(s[4 * 33], s[5 * 33]); o.w = pk2(s[6 * 33], s[7 * 33]);
        *(GAS v4u*)(WT + (size_t)(drow0 + n) * ldt + k0 + 8 * c) = o; }
    LDS_WAIT(); asm volatile("" ::: "memory");
}
__device__ __forceinline__ int gu_row(int n) { return 256 * (n >> 7) + (n & 127); }
template <int PART> __device__ __forceinline__ void phase_weights(Frame& F, int l) {
    LAS float* scr = (LAS float*)(F.lds + F.wave * 16384);
    const int gw = F.vcu * NWAVES + F.wave, NGW = F.G * NWAVES;
    const bool moe = (l & 1); const int fi = l >> 1;
    constexpr int I_IN = 16 * 128, I_OUT = 16 * 32;
    constexpr int I_DG = 16 * 88, I_DD = 44 * 32;
    constexpr int I_MG = 16 * 44, I_MD = 22 * 32;
    const int nitems = PART == 0 ? (I_IN + I_OUT) : (moe ? NE * (2 * I_MG + I_MD) : (2 * I_DG + I_DD));
    for (int it = gw; it < nitems; it += NGW) {
        int r = it + (PART == 0 ? 0 : I_IN + I_OUT);
        if (r < I_IN) { const int kb = r >> 7, nb = r & 127; xpose_item(INF(2) + (size_t)l * D * INC, INC, INC, 64 * kb, 32 * nb, WSP(bf16, WS_WIN), D, 32 * nb, scr, F.lane); continue; } r -= I_IN;
        if (r < I_OUT) { const int kb = r >> 5, nb = r & 31; xpose_item(INF(3) + (size_t)l * D * D, D, D, 64 * kb, 32 * nb, WSP(bf16, WS_WOUT), D, 32 * nb, scr, F.lane); continue; } r -= I_OUT;
        if (!moe) {
            if (r < 2 * I_DG) { const int up = r >= I_DG; if (up) r -= I_DG; const int kb = r / 88, nb = r % 88;
                xpose_item(INF(up ? 28 : 27) + (size_t)fi * D * FFD, FFD, FFD, 64 * kb, 32 * nb, WSP(bf16, WS_WUP), D, gu_row(32 * nb) + (up ? 128 : 0), scr, F.lane); continue; } r -= 2 * I_DG;
            { const int kb = r >> 5, nb = r & 31; xpose_item(INF(29) + (size_t)fi * FFD * D, D, D, 64 * kb, 32 * nb, WSP(bf16, WS_WDN), FFD, 32 * nb, scr, F.lane); }
        } else {
            const int per = 2 * I_MG + I_MD; const int e = r / per; r -= e * per;
            if (r < 2 * I_MG) { const int up = r >= I_MG; if (up) r -= I_MG; const int kb = r / 44, nb = r % 44;
                xpose_item(INF(up ? 32 : 31) + (size_t)(fi * NE + e) * D * FFE, FFE, FFE, 64 * kb, 32 * nb, WSP(bf16, WS_WUP) + (size_t)e * 2 * FFE * D, D, gu_row(32 * nb) + (up ? 128 : 0), scr, F.lane); continue; } r -= 2 * I_MG;
            { const int kb = r >> 5, nb = r & 31; xpose_item(INF(33) + (size_t)(fi * NE + e) * FFE * D, D, D, 64 * kb, 32 * nb, WSP(bf16, WS_WDN) + (size_t)e * D * FFE, FFE, 32 * nb, scr, F.lane); }
        }
    }
    if (PART == 0 && l == 0) {
        const float* x = INF(0); bf16* hb = WSP(bf16, WS_HB);
        for (int m = gw; m < TOK; m += NGW) {
            const GAS f32x4* xr = (const GAS f32x4*)(x + (size_t)m * D) + F.lane; GAS f32x4* hr = (GAS f32x4*)(F.h + (size_t)m * D) + F.lane; GAS v2u* o8 = (GAS v2u*)(hb + (size_t)m * D) + F.lane;
#pragma unroll
            for (int j = 0; j < 4; ++j) { const f32x4 v = xr[64 * j]; hr[64 * j] = v; v2u w; w.x = pk2(v.x, v.y); w.y = pk2(v.z, v.w); o8[64 * j] = w; }
        }
    }
}
__device__ __forceinline__ void rw_xs8(const bf16* P, const float* mu, int t, int col0, float (&xs)[8]) {
    const v4u cur = *(const GAS v4u*)(P + (size_t)t * NP + col0);
    v4u prv = (v4u){0u, 0u, 0u, 0u}; if ((t & (SEQ - 1)) != 0) prv = *(const GAS v4u*)(P + (size_t)(t - 1) * NP + col0);
    const f32x4 m0 = *(const GAS f32x4*)(mu + col0 - RW_BASE), m1 = *(const GAS f32x4*)(mu + col0 - RW_BASE + 4);
    float c[8], p[8]; unpack8(cur, c); unpack8(prv, p);
    const float m[8] = {m0.x, m0.y, m0.z, m0.w, m1.x, m1.y, m1.z, m1.w};
#pragma unroll
    for (int j = 0; j < 8; ++j) xs[j] = c[j] + (p[j] - c[j]) * m[j];
}
__device__ __forceinline__ float rw_xs1(const bf16* P, const float* mu, int t, int col) {
    const float c = bf1(P[(size_t)t * NP + col]); const float p = ((t & (SEQ - 1)) != 0) ? bf1(P[(size_t)(t - 1) * NP + col]) : 0.f;
    return c + (p - c) * mu[col - RW_BASE];
}
__device__ __forceinline__ void rw_mm(f32x4 (&acc)[2][4], const LAS float* A, int lda, int mb0, const float* B, int hh, int nsteps, int lane) {
    const int fr = lane & 15, fq = lane >> 4;
    for (int s = 0; s < nsteps; ++s) {
        float bf[4];
#pragma unroll
        for (int nbl = 0; nbl < 4; ++nbl) bf[nbl] = B[(size_t)(4 * s + fq) * 256 + 64 * hh + 16 * nbl + fr];
#pragma unroll
        for (int mi = 0; mi < 2; ++mi) { const float af = A[(16 * (mb0 + mi) + fr) * lda + 4 * s + fq];
#pragma unroll
            for (int nbl = 0; nbl < 4; ++nbl) acc[mi][nbl] = __builtin_amdgcn_mfma_f32_16x16x4f32(af, bf[nbl], acc[mi][nbl], 0, 0, 0); }
    }
}
__device__ __forceinline__ void phase_rwprep(Frame& F, int l) {
    const bf16* P = WSP(const bf16, WS_P);
    const float* mu = INF(13) + l * 1056;
    LAS float* X1 = (LAS float*)F.lds; LAS float* X2 = X1 + 64 * 66; LAS float* X3 = X2 + 64 * 66;
    LAS float* X4 = (LAS float*)F.lds; LAS float* X5 = X4 + 64 * 258;
    float* RWW = WSP(float, WS_RWW); bf16* RWR = WSP(bf16, WS_RWR); bf16* RWK = WSP(bf16, WS_RWK); bf16* RWV = WSP(bf16, WS_RWV);
    bf16* RWKK = WSP(bf16, WS_RWKK); bf16* RWB = WSP(bf16, WS_RWB); bf16* RWG = WSP(bf16, WS_RWG); bf16* VF = WSP(bf16, WS_VF);
    const int fr = F.lane & 15, fq = F.lane >> 4, hh = F.wave & 3, mb0 = 2 * (F.wave >> 2);
    for (int tile = F.vcu; tile < TOK / 64; tile += F.G) {
        const int t0 = tile * 64;
        for (int g = F.tid; g < 64 * 36; g += NWAVES * 64) { const int tt = g / 36, cg = g - tt * 36; float xs[8]; rw_xs8(P, mu, t0 + tt, RW_WLR + 8 * cg, xs);
            if (cg < 8) {
#pragma unroll
                for (int j = 0; j < 8; ++j) { const float e2 = __expf(2.f * xs[j]); X1[tt * 66 + 8 * cg + j] = 1.f - 2.f * __builtin_amdgcn_rcpf(e2 + 1.f); }
            } else if (cg < 16) {
#pragma unroll
                for (int j = 0; j < 8; ++j) X2[tt * 66 + 8 * (cg - 8) + j] = xs[j];
            } else {
#pragma unroll
                for (int j = 0; j < 8; ++j) X3[tt * 162 + 8 * (cg - 16) + j] = sigm(xs[j]);
            } }
        for (int g = F.tid; g < 64 * 32; g += NWAVES * 64) { const int tt = g >> 5, cg = g & 31; float xs[8]; rw_xs8(P, mu, t0 + tt, RW_R + 8 * cg, xs);
            *(GAS v4u*)(RWR + (size_t)(t0 + tt) * 256 + 8 * cg) = pack8(xs);
            if (l == 0) { rw_xs8(P, mu, t0 + tt, RW_V + 8 * cg, xs); const v4u w = pack8(xs); *(GAS v4u*)(RWV + (size_t)(t0 + tt) * 256 + 8 * cg) = w; *(GAS v4u*)(VF + (size_t)(t0 + tt) * 256 + 8 * cg) = w; } }
        __syncthreads();
        {   f32x4 acc[2][4];
#pragma unroll
            for (int mi = 0; mi < 2; ++mi)
#pragma unroll
                for (int nb = 0; nb < 4; ++nb) acc[mi][nb] = (f32x4){0.f, 0.f, 0.f, 0.f};
            rw_mm(acc, X1, 66, mb0, INF(15) + (size_t)l * 64 * 256, hh, 16, F.lane);
            const float* w0 = INF(14) + l * 256;
#pragma unroll
            for (int mi = 0; mi < 2; ++mi)
#pragma unroll
                for (int nb = 0; nb < 4; ++nb) { const int col = 64 * hh + 16 * nb + fr; const float w0c = w0[col];
#pragma unroll
                    for (int r = 0; r < 4; ++r) { const int t = t0 + 16 * (mb0 + mi) + 4 * fq + r; RWW[(size_t)t * 256 + col] = -0.6065306597126334f * sigm(acc[mi][nb][r] + w0c);     } }
#pragma unroll
            for (int mi = 0; mi < 2; ++mi)
#pragma unroll
                for (int nb = 0; nb < 4; ++nb) acc[mi][nb] = (f32x4){0.f, 0.f, 0.f, 0.f};
            rw_mm(acc, X2, 66, mb0, INF(17) + (size_t)l * 64 * 256, hh, 16, F.lane);
            const float* a0 = INF(16) + l * 256; const float* kkw = INF(19) + l * 256; const float* kaw = INF(20) + l * 256;
#pragma unroll
            for (int mi = 0; mi < 2; ++mi) {
                float kr[4][4], kq[4][4], ssq[4] = {0.f, 0.f, 0.f, 0.f};
#pragma unroll
                for (int nb = 0; nb < 4; ++nb) { const int col = 64 * hh + 16 * nb + fr; const float kkc = kkw[col];
#pragma unroll
                    for (int r = 0; r < 4; ++r) { const int t = t0 + 16 * (mb0 + mi) + 4 * fq + r; kr[nb][r] = rw_xs1(P, mu, t, RW_K + col); kq[nb][r] = kr[nb][r] * kkc; ssq[r] += kq[nb][r] * kq[nb][r]; } }
#pragma unroll
                for (int r = 0; r < 4; ++r) { ssq[r] = sum16(ssq[r]); ssq[r] = 1.0f / fmaxf(sqrtf(ssq[r]), 1e-12f); }
#pragma unroll
                for (int nb = 0; nb < 4; ++nb) { const int col = 64 * hh + 16 * nb + fr; const float a0c = a0[col], kac = kaw[col];
#pragma unroll
                    for (int r = 0; r < 4; ++r) { const int t = t0 + 16 * (mb0 + mi) + 4 * fq + r; const float a = sigm(acc[mi][nb][r] + a0c); const float kk = kq[nb][r] * ssq[r];
                        const size_t o = (size_t)t * 256 + col; RWKK[o] = (bf16)f2bf(kk); RWB[o] = (bf16)f2bf(kk * a); RWK[o] = (bf16)f2bf(kr[nb][r] * (1.f + (a - 1.f) * kac)); } }
            }
#pragma unroll
            for (int mi = 0; mi < 2; ++mi)
#pragma unroll
                for (int nb = 0; nb < 4; ++nb) acc[mi][nb] = (f32x4){0.f, 0.f, 0.f, 0.f};
            rw_mm(acc, X3, 162, mb0, INF(18) + (size_t)l * 160 * 256, hh, 40, F.lane);
#pragma unroll
            for (int mi = 0; mi < 2; ++mi)
#pragma unroll
                for (int nb = 0; nb < 4; ++nb) { const int col = 64 * hh + 16 * nb + fr;
#pragma unroll
                    for (int r = 0; r < 4; ++r) { const int t = t0 + 16 * (mb0 + mi) + 4 * fq + r; RWG[(size_t)t * 256 + col] = (bf16)f2bf(acc[mi][nb][r]); } }
        }
        __syncthreads();
        if (l > 0) {
            const float* v0 = INF(24) + (l - 1) * 256; const float* v1 = INF(25) + (size_t)(l - 1) * 256 * 32; const float* v2 = INF(26) + (size_t)(l - 1) * 32 * 256;
            for (int g = F.tid; g < 64 * 32; g += NWAVES * 64) { const int tt = g >> 5, cg = g & 31; float xs[8]; rw_xs8(P, mu, t0 + tt, RW_V + 8 * cg, xs);
#pragma unroll
                for (int j = 0; j < 8; ++j) X4[tt * 258 + 8 * cg + j] = xs[j]; }
            __syncthreads();
            {
                const int mb = F.wave & 3, nb = F.wave >> 2; f32x4 a4 = (f32x4){0.f, 0.f, 0.f, 0.f};
                for (int s = 0; s < 64; ++s) { const float af = X4[(16 * mb + fr) * 258 + 4 * s + fq]; const float bfv = v1[(size_t)(4 * s + fq) * 32 + 16 * nb + fr]; a4 = __builtin_amdgcn_mfma_f32_16x16x4f32(af, bfv, a4, 0, 0, 0); }
#pragma unroll
                for (int r = 0; r < 4; ++r) X5[(16 * mb + 4 * fq + r) * 34 + 16 * nb + fr] = a4[r];
            }
            __syncthreads();
            {   f32x4 acc[2][4];
#pragma unroll
                for (int mi = 0; mi < 2; ++mi)
#pragma unroll
                    for (int nb = 0; nb < 4; ++nb) acc[mi][nb] = (f32x4){0.f, 0.f, 0.f, 0.f};
                rw_mm(acc, X5, 34, mb0, v2, hh, 8, F.lane);
#pragma unroll
                for (int mi = 0; mi < 2; ++mi)
#pragma unroll
                    for (int nb = 0; nb < 4; ++nb) { const int col = 64 * hh + 16 * nb + fr; const float v0c = v0[col];
#pragma unroll
                        for (int r = 0; r < 4; ++r) { const int row = 16 * (mb0 + mi) + 4 * fq + r; const size_t o = (size_t)(t0 + row) * 256 + col;
                            const float xv = X4[row * 258 + col]; const float vf = bf1(VF[o]); RWV[o] = (bf16)f2bf(xv + (vf - xv) * sigm(acc[mi][nb][r] + v0c)); } }
            }
            __syncthreads();
        }
    }
}
constexpr int CB = 64 * 66;
constexpr int HB_ = 64 * 72;
constexpr int PRE_H0 = 3 * CB * 4;
constexpr int PV_OFF = (PRE_H0 + 10 * HB_ * 2) / 4;
constexpr int REC_RW = 61440, REC_GL = 16640;
constexpr int RO_QH = 0, RO_AT = 8192, RO_TT = 16384, RO_BH = 24576, RO_MRB = 32768, RO_Y = 40960, RO_SK = 49152, RO_GAM = 57344;
constexpr int GO_QH = 0, GO_SK = 8192, GO_GAM = 16384;
#define PBUF(i) ((LAS float*)F.lds + (i) * CB)
#define HBUF(i) ((LAS bf16*)(F.lds + PRE_H0) + (i) * HB_)
__device__ __forceinline__ void nt16(f32x4 (&acc)[2], const LAS bf16* X, const LAS bf16* Y, int mb, int nb0, int lane) {
    const int fr = lane & 15, fq = lane >> 4;
    acc[0] = (f32x4){0.f, 0.f, 0.f, 0.f}; acc[1] = acc[0];
#pragma unroll
    for (int ks = 0; ks < 2; ++ks) { const bf16x8 a = *(const LAS bf16x8*)(X + (16 * mb + fr) * 72 + 32 * ks + 8 * fq);
        const bf16x8 b0 = *(const LAS bf16x8*)(Y + (16 * nb0 + fr) * 72 + 32 * ks + 8 * fq), b1 = *(const LAS bf16x8*)(Y + (16 * nb0 + 16 + fr) * 72 + 32 * ks + 8 * fq);
        acc[0] = __builtin_amdgcn_mfma_f32_16x16x32_bf16(a, b0, acc[0], 0, 0, 0); acc[1] = __builtin_amdgcn_mfma_f32_16x16x32_bf16(a, b1, acc[1], 0, 0, 0); }
}
template <int MASK> __device__ __forceinline__ void hst(const f32x4 (&acc)[2], LAS bf16* S, int mb, int nb0, int lane) {
    const int fr = lane & 15, fq = lane >> 4;
#pragma unroll
    for (int n = 0; n < 2; ++n)
#pragma unroll
        for (int r = 0; r < 4; ++r) { const int row = 16 * mb + 4 * fq + r, col = 16 * (nb0 + n) + fr; float v = acc[n][r];
            if (MASK == 1 && col > row) v = 0.f; if (MASK == 2 && col >= row) v = 0.f; S[row * 72 + col] = (bf16)f2bf(v); }
}
template <int MASK> __device__ __forceinline__ void cst(const f32x4 (&acc)[2], LAS float* S, int mb, int nb0, int lane) {
    const int fr = lane & 15, fq = lane >> 4;
#pragma unroll
    for (int n = 0; n < 2; ++n)
#pragma unroll
        for (int r = 0; r < 4; ++r) { const int row = 16 * mb + 4 * fq + r, col = 16 * (nb0 + n) + fr; float v = acc[n][r];
            if (MASK == 1 && col > row) v = 0.f; if (MASK == 2 && col >= row) v = 0.f; S[row * 66 + col] = v; }
}
__device__ __forceinline__ void hfrag(const LAS bf16* M, const LAS float* colscale, unsigned char* dst, int wave, int lane) {
    const int mb = wave >> 1, ks = wave & 1, i = lane & 15, q = lane >> 4; const LAS bf16* rowp = M + (16 * mb + i) * 72 + 32 * ks + 4 * q;
    const v2u lo = *(const LAS v2u*)rowp, hi = *(const LAS v2u*)(rowp + 16);
    v4u w; w.x = lo.x; w.y = lo.y; w.z = hi.x; w.w = hi.y;
    if (colscale) { float e[8]; unpack8(w, e); const f32x4 s0 = *(const LAS f32x4*)(colscale + 32 * ks + 4 * q), s1 = *(const LAS f32x4*)(colscale + 32 * ks + 16 + 4 * q);
        e[0] *= s0.x; e[1] *= s0.y; e[2] *= s0.z; e[3] *= s0.w; e[4] *= s1.x; e[5] *= s1.y; e[6] *= s1.z; e[7] *= s1.w; w = pack8(e); }
    *(GAS v4u*)(dst + ((size_t)wave * 64 + lane) * 16) = w;
}
__device__ __forceinline__ void cfrag(const LAS float* M, unsigned char* dst, int wave, int lane) {
    const int mb = wave >> 1, ks = wave & 1, i = lane & 15, q = lane >> 4; float e[8];
#pragma unroll
    for (int jj = 0; jj < 8; ++jj) { const int rho = 32 * ks + (jj < 4 ? 4 * q + jj : 16 + 4 * q + jj - 4); e[jj] = M[(16 * mb + i) * 66 + rho]; }
    *(GAS v4u*)(dst + ((size_t)wave * 64 + lane) * 16) = pack8(e);
}
__device__ __forceinline__ void cacc(const f32x4 (&acc)[2], const LAS float* rowscale, unsigned char* dst, int mb, int nb0, int lane) {
    const int fq = lane >> 4;
#pragma unroll
    for (int n = 0; n < 2; ++n) { float v[4];
#pragma unroll
        for (int r = 0; r < 4; ++r) { v[r] = acc[n][r]; if (rowscale) v[r] *= rowscale[16 * mb + 4 * fq + r]; }
        v2u w; w.x = pk2(v[0], v[1]); w.y = pk2(v[2], v[3]); *(GAS v2u*)(dst + ((size_t)((nb0 + n) * 4 + mb) * 64 + lane) * 8) = w; }
}
__device__ __forceinline__ void ccumsum(Frame& F, LAS float* CU) {
    LAS float* vec = (LAS float*)F.lds + PV_OFF; LAS float* seg = vec + 128;
    { float run = 0.f;
#pragma unroll
      for (int i = 0; i < 8; ++i) { run += CU[(8 * F.wave + i) * 66 + F.lane]; CU[(8 * F.wave + i) * 66 + F.lane] = run; }
      seg[F.wave * 64 + F.lane] = run; }
    __syncthreads();
    { float off = 0.f;
#pragma unroll
      for (int w = 0; w < 8; ++w) if (w < F.wave) off += seg[w * 64 + F.lane];
#pragma unroll
      for (int i = 0; i < 8; ++i) { const float c = CU[(8 * F.wave + i) * 66 + F.lane] + off; CU[(8 * F.wave + i) * 66 + F.lane] = c; if (8 * F.wave + i == 31) vec[F.lane] = c; if (8 * F.wave + i == 63) vec[64 + F.lane] = c; } }
    __syncthreads();
}
__device__ __forceinline__ f32x4 blk16(f32x4 acc, const LAS float* A, int ar0, int ac0, const LAS float* B, int br0, int bc0, int lane) {
    const int fr = lane & 15, fq = lane >> 4;
#pragma unroll
    for (int s = 0; s < 4; ++s) acc = __builtin_amdgcn_mfma_f32_16x16x4f32(A[(ar0 + fr) * 66 + ac0 + 4 * s + fq], B[(br0 + 4 * s + fq) * 66 + bc0 + fr], acc, 0, 0, 0);
    return acc;
}
__device__ __forceinline__ void blkst(const f32x4 acc, LAS float* S, int r0, int c0, int lane) {
    const int fr = lane & 15, fq = lane >> 4;
#pragma unroll
    for (int r = 0; r < 4; ++r) S[(r0 + 4 * fq + r) * 66 + c0 + fr] = acc[r];
}
__device__ __forceinline__ void tri_inverse(Frame& F, const LAS float* L, LAS float* T, LAS float* W) {
    for (int e = F.tid; e < 64 * 64; e += NWAVES * 64) { const int i = e >> 6, j = e & 63; if ((i >> 4) != (j >> 4)) T[i * 66 + j] = 0.f; }
    if (F.wave == 0) {
        const int d0 = 16 * (F.lane >> 4), c = F.lane & 15; float t[16];
#pragma unroll
        for (int i = 0; i < 16; ++i) { float a = (i == c) ? 1.f : 0.f;
#pragma unroll
            for (int j = 0; j < i; ++j) a += L[(d0 + i) * 66 + d0 + j] * t[j];
            t[i] = a; T[(d0 + i) * 66 + d0 + c] = a; }
    }
    __syncthreads();
#pragma unroll
    for (int d = 1; d <= 3; ++d) {
        if (F.wave < 4 - d) { const int i = d + F.wave, j = F.wave; f32x4 acc = (f32x4){0.f, 0.f, 0.f, 0.f};
#pragma unroll
            for (int k = 0; k < 3; ++k) if (k >= j && k < i) acc = blk16(acc, L, 16 * i, 16 * k, T, 16 * k, 16 * j, F.lane);
            blkst(acc, W, 16 * i, 16 * j, F.lane); }
        __syncthreads();
        if (F.wave < 4 - d) { const int i = d + F.wave, j = F.wave; f32x4 acc = (f32x4){0.f, 0.f, 0.f, 0.f};
            acc = blk16(acc, T, 16 * i, 16 * i, W, 16 * i, 16 * j, F.lane); blkst(acc, T, 16 * i, 16 * j, F.lane); }
        __syncthreads();
    }
}
__device__ __forceinline__ void chunk_pre(Frame& F, int l, const int MIX, int b, int h, int c, unsigned char* rec) {
    const int t0 = b * SEQ + c * 64;
    LAS float* CU = PBUF(0); LAS float* LL = PBUF(1); LAS float* T32 = PBUF(2);
    LAS bf16* A1 = HBUF(0); LAS bf16* R1 = HBUF(1); LAS bf16* B1 = HBUF(2); LAS bf16* K1 = HBUF(3); LAS bf16* KeT = HBUF(4); LAS bf16* VT = HBUF(5); LAS bf16* BeT = HBUF(6); LAS bf16* M1 = HBUF(7); LAS bf16* M2 = HBUF(8); LAS bf16* M3 = HBUF(9);
    LAS float* vec = (LAS float*)F.lds + PV_OFF; LAS float* cmid = vec; LAS float* cend = vec + 64; LAS float* ecm = vec + 640;
    const int tt = F.tid >> 3, j8 = (F.tid & 7) * 8, t = t0 + tt;
    const int mb = F.wave >> 1, nb0 = 2 * (F.wave & 1), fr = F.lane & 15, fq = F.lane >> 4;
    const bf16* P = WSP(const bf16, WS_P);
    float q[8], k[8], lw[8];
    if (MIX == 0) {
        float fr_[8], qr[8]; unpack8(*(const GAS v4u*)(P + (size_t)t * NP + HG_F + 64 * h + j8), fr_); unpack8(*(const GAS v4u*)(P + (size_t)t * NP + HG_Q + 64 * h + j8), qr);
        const float* lg = INF(8); const int c0 = 64 * h + j8;
#pragma unroll
        for (int j = 0; j < 8; ++j) { const float x0 = lg[c0 + j], x1 = lg[256 + c0 + j], x2 = lg[512 + c0 + j], x3 = lg[768 + c0 + j]; const float mx = fmaxf(fmaxf(x0, x1), fmaxf(x2, x3));
            const float e0 = __expf(x0 - mx), e1 = __expf(x1 - mx), e2 = __expf(x2 - mx), e3 = __expf(x3 - mx); const float inv = 1.f / (e0 + e1 + e2 + e3);
            const float lb = ((l >= 1 ? e1 : 0.f) + (l >= 2 ? e2 : 0.f) + (l >= 3 ? e3 : 0.f)) * inv;
            const float w = lb + (1.f - lb) * sigm(fr_[j]); lw[j] = __logf(w); k[j] = 1.f - w; q[j] = qr[j] * sigm(qr[j]); }
    } else if (MIX == 1) {
        if (j8 < 32) {
            float qr[8], kr[8], g0[8], g1[8]; unpack8(*(const GAS v4u*)(P + (size_t)t * NP + GL_Q + 32 * h + j8), qr); unpack8(*(const GAS v4u*)(P + (size_t)t * NP + GL_K + 32 * h + j8), kr);
            unpack8(*(const GAS v4u*)(P + (size_t)t * NP + GL_GLR), g0); unpack8(*(const GAS v4u*)(P + (size_t)t * NP + GL_GLR + 8), g1);
            const float* w2 = INF(10) + l * 16 * 128 + 32 * h + j8; const float* gb = INF(11) + l * 128 + 32 * h + j8;
            float x[8];
#pragma unroll
            for (int j = 0; j < 8; ++j) x[j] = gb[j];
#pragma unroll
            for (int r = 0; r < 8; ++r) { const f32x4 wa = *(const GAS f32x4*)(w2 + r * 128), wb = *(const GAS f32x4*)(w2 + r * 128 + 4), wc = *(const GAS f32x4*)(w2 + (r + 8) * 128), wd = *(const GAS f32x4*)(w2 + (r + 8) * 128 + 4);
                x[0] += g0[r] * wa.x + g1[r] * wc.x; x[1] += g0[r] * wa.y + g1[r] * wc.y; x[2] += g0[r] * wa.z + g1[r] * wc.z; x[3] += g0[r] * wa.w + g1[r] * wc.w;
                x[4] += g0[r] * wb.x + g1[r] * wd.x; x[5] += g0[r] * wb.y + g1[r] * wd.y; x[6] += g0[r] * wb.z + g1[r] * wd.z; x[7] += g0[r] * wb.w + g1[r] * wd.w; }
#pragma unroll
            for (int j = 0; j < 8; ++j) { lw[j] = 0.0625f * (fminf(x[j], 0.f) - __logf(1.f + __expf(-fabsf(x[j])))); k[j] = kr[j]; q[j] = qr[j] * 0.17677669529663687f; }
        } else {
#pragma unroll
            for (int j = 0; j < 8; ++j) { lw[j] = 0.f; k[j] = 0.f; q[j] = 0.f; }
        }
    } else if (MIX == 2) {
        const size_t o = (size_t)t * 256 + 64 * h + j8;
        const f32x4 w0 = *(const GAS f32x4*)(WSP(const float, WS_RWW) + o), w1 = *(const GAS f32x4*)(WSP(const float, WS_RWW) + o + 4);
        lw[0] = w0.x; lw[1] = w0.y; lw[2] = w0.z; lw[3] = w0.w; lw[4] = w1.x; lw[5] = w1.y; lw[6] = w1.z; lw[7] = w1.w;
        unpack8(*(const GAS v4u*)(WSP(const bf16, WS_RWK) + o), k); unpack8(*(const GAS v4u*)(WSP(const bf16, WS_RWR) + o), q);
    } else {
        const int i0 = j8 & 31; const bool hi = j8 >= 32;
        float q1[8], q2[8], k1[8], k2[8];
        unpack8(*(const GAS v4u*)(P + (size_t)t * NP + RT_Q + 64 * h + i0), q1); unpack8(*(const GAS v4u*)(P + (size_t)t * NP + RT_Q + 64 * h + 32 + i0), q2);
        unpack8(*(const GAS v4u*)(P + (size_t)t * NP + RT_K + 64 * h + i0), k1); unpack8(*(const GAS v4u*)(P + (size_t)t * NP + RT_K + 64 * h + 32 + i0), k2);
        const double pos = (double)((const int*)ldptr(F.in, 1))[t];
        const float lgam = __logf(1.f - exp2f(-5.f - (float)h));
#pragma unroll
        for (int j = 0; j < 8; ++j) { const double rev = pos * INVF2PI[i0 + j]; const float fr_ = (float)(rev - floor(rev)); const float s = __builtin_amdgcn_sinf(fr_), cs = __builtin_amdgcn_cosf(fr_);
            q[j] = hi ? (q1[j] * s + q2[j] * cs) : (q1[j] * cs - q2[j] * s); k[j] = 0.125f * (hi ? (k1[j] * s + k2[j] * cs) : (k1[j] * cs - k2[j] * s)); lw[j] = lgam; }
    }
    *(LAS f32x4*)(CU + tt * 66 + j8) = (f32x4){lw[0], lw[1], lw[2], lw[3]}; *(LAS f32x4*)(CU + tt * 66 + j8 + 4) = (f32x4){lw[4], lw[5], lw[6], lw[7]};
    __syncthreads();
    ccumsum(F, CU);
    {   float cu[8], cm[8], ce[8], cp[8];
#pragma unroll
        for (int j = 0; j < 8; ++j) { cu[j] = CU[tt * 66 + j8 + j]; cm[j] = cmid[j8 + j]; ce[j] = cend[j8 + j]; cp[j] = tt > 0 ? CU[(tt - 1) * 66 + j8 + j] : 0.f; }
        float v[8];
        if (MIX == 2) unpack8(*(const GAS v4u*)(WSP(const bf16, WS_RWV) + (size_t)t * 256 + 64 * h + j8), v);
        else unpack8(*(const GAS v4u*)(P + (size_t)t * NP + (MIX == 0 ? HG_I : MIX == 1 ? GL_V : RT_V) + 64 * h + j8), v);
        float e1[8], e2[8];
#pragma unroll
        for (int j = 0; j < 8; ++j) { e1[j] = q[j] * __expf(cu[j] - cm[j]); e2[j] = k[j] * __expf(cm[j] - cu[j]);
            KeT[(j8 + j) * 72 + tt] = (bf16)f2bf(k[j] * __expf(ce[j] - cu[j])); VT[(j8 + j) * 72 + tt] = (bf16)f2bf(v[j]); }
        *(LAS v4u*)(R1 + tt * 72 + j8) = pack8(e1); *(LAS v4u*)(K1 + tt * 72 + j8) = pack8(e2);
        if (MIX == 2) { float a[8], bb[8]; const size_t o = (size_t)t * 256 + 64 * h + j8; unpack8(*(const GAS v4u*)(WSP(const bf16, WS_RWKK) + o), a); unpack8(*(const GAS v4u*)(WSP(const bf16, WS_RWB) + o), bb);
#pragma unroll
            for (int j = 0; j < 8; ++j) { e1[j] = -a[j] * __expf(cp[j] - cm[j]); e2[j] = bb[j] * __expf(cm[j] - cu[j]); BeT[(j8 + j) * 72 + tt] = (bf16)f2bf(bb[j] * __expf(ce[j] - cu[j])); }
            *(LAS v4u*)(A1 + tt * 72 + j8) = pack8(e1); *(LAS v4u*)(B1 + tt * 72 + j8) = pack8(e2); }
        if (F.tid < 64) { const float m_ = cmid[F.tid], e_ = cend[F.tid]; ecm[F.tid] = __expf(m_);
            *(GAS float*)(rec + (MIX == 2 ? RO_GAM : GO_GAM) + 4 * F.tid) = __expf(e_); }
    }
    __syncthreads();
    float* Og = WSP(float, WS_O) + (size_t)MIX * TOK * 256 + (size_t)t0 * 256 + 64 * h;
    f32x4 acc[2];
    nt16(acc, R1, K1, mb, nb0, F.lane); hst<1>(acc, M1, mb, nb0, F.lane);
    hfrag(R1, ecm, rec + (MIX == 2 ? RO_QH : GO_QH), F.wave, F.lane);
    nt16(acc, KeT, VT, mb, nb0, F.lane); cacc(acc, nullptr, rec + (MIX == 2 ? RO_SK : GO_SK), mb, nb0, F.lane);
    if (MIX == 2) {
        nt16(acc, A1, B1, mb, nb0, F.lane); cst<2>(acc, LL, mb, nb0, F.lane);
        nt16(acc, R1, B1, mb, nb0, F.lane); hst<1>(acc, M2, mb, nb0, F.lane);
        nt16(acc, A1, K1, mb, nb0, F.lane); hst<2>(acc, M3, mb, nb0, F.lane);
        hfrag(A1, ecm, rec + RO_AT, F.wave, F.lane);
        hfrag(BeT, nullptr, rec + RO_BH, F.wave, F.lane);
    }
    __syncthreads();
    nt16(acc, M1, VT, mb, nb0, F.lane);
#pragma unroll
    for (int n = 0; n < 2; ++n)
#pragma unroll
        for (int r = 0; r < 4; ++r) Og[(size_t)(16 * mb + 4 * fq + r) * 256 + 16 * (nb0 + n) + fr] = acc[n][r];
    if (MIX == 2) {
        nt16(acc, M3, VT, mb, nb0, F.lane); cacc(acc, nullptr, rec + RO_Y, mb, nb0, F.lane);
        hfrag(M2, nullptr, rec + RO_MRB, F.wave, F.lane);
        tri_inverse(F, LL, T32, CU);
        cfrag(T32, rec + RO_TT, F.wave, F.lane);
    }
    __syncthreads();
}
constexpr size_t WS_REC_RW = 14 * MiB, WS_REC_GL = 412 * MiB;
__device__ __forceinline__ void phase_chunkpre(Frame& F, int l) {
#pragma unroll 1
    for (int i = 0; i < 16; ++i) {
        const int m = i & 3, j = (i >> 2) * 256 + F.vcu; if (j >= 1024) continue;
        const int b = j >> 8, h = (j >> 6) & 3, c = j & 63;
        unsigned char* rec = (m == 2) ? F.ws + WS_REC_RW + (size_t)(((b * 4 + h) * 64) + c) * REC_RW : F.ws + WS_REC_GL + (size_t)((((m == 3 ? 2 : m) * 16 + b * 4 + h) * 64) + c) * REC_GL;
        chunk_pre(F, l, m, b, h, c, rec);
    }
}
__device__ __forceinline__ bf16x8 pack_b(const f32x4 a, const f32x4 b) { v4u w; w.x = pk2(a.x, a.y); w.y = pk2(a.z, a.w); w.z = pk2(b.x, b.y); w.w = pk2(b.z, b.w); return __builtin_bit_cast(bf16x8, w); }
__device__ __forceinline__ f32x4 unpk4(const v2u w) { return (f32x4){bflo(w.x), bfhi(w.x), bflo(w.y), bfhi(w.y)}; }
template <int NF> struct SeqRegs { v4u r[NF]; v4u tail; };
template <int NF, int NLT, bool TAIL> __device__ __forceinline__ void seq_ld(SeqRegs<NF>& R, const unsigned char* rec, int lt) {
    const GAS v4u* src = (const GAS v4u*)rec;
#pragma unroll
    for (int i = 0; i < NF; ++i) R.r[i] = src[i * NLT + lt];
    if (TAIL && lt < 16) R.tail = src[NF * NLT + lt];
}
template <int NF, int NLT, bool TAIL> __device__ __forceinline__ void seq_st(const SeqRegs<NF>& R, LAS unsigned char* slot, int lt) {
    LAS v4u* dst = (LAS v4u*)slot;
#pragma unroll
    for (int i = 0; i < NF; ++i) dst[i * NLT + lt] = R.r[i];
    if (TAIL && lt < 16) dst[NF * NLT + lt] = R.tail;
}
template <bool RW> __device__ __forceinline__ void seq_unit(Frame& F, int mix, int b, int h, int vb_, const unsigned char* recs) {
    constexpr int REC = RW ? REC_RW : REC_GL, SLOT = 61440, NCW = RW ? 1 : 4, LW0 = RW ? 2 : 4, NLT = (8 - LW0) * 64, NF = REC / (NLT * 16); constexpr bool TAIL = (REC % (NLT * 16)) != 0;
    static_assert(REC % (NLT * 16) == 0 || REC % (NLT * 16) == 256, "record = NF loader rounds (+ 256 B)");
    const bool loader = F.wave >= LW0, compute = F.wave < NCW; const int lt = F.tid - 64 * LW0;
    SeqRegs<NF> RA, RB;
    if (loader) { seq_ld<NF, NLT, TAIL>(RA, recs, lt); seq_st<NF, NLT, TAIL>(RA, F.lds, lt); seq_ld<NF, NLT, TAIL>(RB, recs + (size_t)1 * REC, lt); seq_ld<NF, NLT, TAIL>(RA, recs + (size_t)2 * REC, lt); }
    __syncthreads();
    f32x4 S[4];
#pragma unroll
    for (int kb = 0; kb < 4; ++kb) S[kb] = (f32x4){0.f, 0.f, 0.f, 0.f};
    const int vb = RW ? vb_ : (F.wave & 3), fr = F.lane & 15, fq = F.lane >> 4;
    bf16* Oi = WSP(bf16, WS_Y) + (size_t)b * SEQ * D + 256 * mix + 64 * h + 16 * vb + fr;
#pragma unroll 1
    for (int c2 = 0; c2 < 64; c2 += 2) {
#pragma unroll
        for (int par = 0; par < 2; ++par) {
            const int c = c2 + par;
            if (loader) {
                if (par == 0) { seq_st<NF, NLT, TAIL>(RB, F.lds + SLOT, lt); if (c + 3 < 64) seq_ld<NF, NLT, TAIL>(RB, recs + (size_t)(c + 3) * REC, lt); }
                else { if (c + 1 < 64) seq_st<NF, NLT, TAIL>(RA, F.lds, lt); if (c + 3 < 64) seq_ld<NF, NLT, TAIL>(RA, recs + (size_t)(c + 3) * REC, lt); }
            } else if (compute) {
                const LAS unsigned char* R = F.lds + par * SLOT;
                const f32x4 z = (f32x4){0.f, 0.f, 0.f, 0.f};
                bf16x8 bS[2]; bS[0] = pack_b(S[0], S[1]); bS[1] = pack_b(S[2], S[3]);
                f32x4 O[4]; bf16x8 bU[2];
#pragma unroll
                for (int mb = 0; mb < 4; ++mb) { O[mb] = z;
#pragma unroll
                    for (int ks = 0; ks < 2; ++ks) O[mb] = __builtin_amdgcn_mfma_f32_16x16x32_bf16(*(const LAS bf16x8*)(R + (RW ? RO_QH : GO_QH) + ((mb * 2 + ks) * 64 + F.lane) * 16), bS[ks], O[mb], 0, 0, 0); }
                if (RW) {
                    f32x4 X[4], U[4];
#pragma unroll
                    for (int mb = 0; mb < 4; ++mb) { X[mb] = unpk4(*(const LAS v2u*)(R + RO_Y + ((vb * 4 + mb) * 64 + F.lane) * 8));
#pragma unroll
                        for (int ks = 0; ks < 2; ++ks) X[mb] = __builtin_amdgcn_mfma_f32_16x16x32_bf16(*(const LAS bf16x8*)(R + RO_AT + ((mb * 2 + ks) * 64 + F.lane) * 16), bS[ks], X[mb], 0, 0, 0); }
                    bf16x8 bX[2]; bX[0] = pack_b(X[0], X[1]); bX[1] = pack_b(X[2], X[3]);
#pragma unroll
                    for (int mb = 0; mb < 4; ++mb) { U[mb] = z;
#pragma unroll
                        for (int ks = 0; ks < 2; ++ks) if (!(ks == 1 && mb < 2)) U[mb] = __builtin_amdgcn_mfma_f32_16x16x32_bf16(*(const LAS bf16x8*)(R + RO_TT + ((mb * 2 + ks) * 64 + F.lane) * 16), bX[ks], U[mb], 0, 0, 0); }
                    bU[0] = pack_b(U[0], U[1]); bU[1] = pack_b(U[2], U[3]);
#pragma unroll
                    for (int mb = 0; mb < 4; ++mb)
#pragma unroll
                        for (int ks = 0; ks < 2; ++ks) if (!(ks == 1 && mb < 2)) O[mb] = __builtin_amdgcn_mfma_f32_16x16x32_bf16(*(const LAS bf16x8*)(R + RO_MRB + ((mb * 2 + ks) * 64 + F.lane) * 16), bU[ks], O[mb], 0, 0, 0);
                }
#pragma unroll
                for (int kb = 0; kb < 4; ++kb) { const f32x4 g = *(const LAS f32x4*)(R + (RW ? RO_GAM : GO_GAM) + (16 * kb + 4 * fq) * 4); const f32x4 sk = unpk4(*(const LAS v2u*)(R + (RW ? RO_SK : GO_SK) + ((vb * 4 + kb) * 64 + F.lane) * 8));
                    f32x4 n = S[kb] * g + sk;
                    if (RW) {
#pragma unroll
                        for (int ks = 0; ks < 2; ++ks) n = __builtin_amdgcn_mfma_f32_16x16x32_bf16(*(const LAS bf16x8*)(R + RO_BH + ((kb * 2 + ks) * 64 + F.lane) * 16), bU[ks], n, 0, 0, 0);
                    }
                    S[kb] = n; }
#pragma unroll
                for (int mb = 0; mb < 4; ++mb)
#pragma unroll
                    for (int r = 0; r < 4; ++r) Oi[(size_t)(c * 64 + 16 * mb + 4 * fq + r) * D] = (bf16)f2bf(O[mb][r]);
            }
            __syncthreads();
        }
    }
}
__device__ __forceinline__ void phase_seq(Frame& F, int l) {
    for (int u = blockIdx.x; u < 112; u += F.G) {
        if (u < 64) { const int bh = u >> 2, vb = u & 3; seq_unit<true>(F, 2, bh >> 2, bh & 3, vb, F.ws + WS_REC_RW + (size_t)(bh * 64) * REC_RW); }
        else { const int v = u - 64, mm = v % 3, bh = v / 3; seq_unit<false>(F, mm == 2 ? 3 : mm, bh >> 2, bh & 3, 0, F.ws + WS_REC_GL + (size_t)((mm * 16 + bh) * 64) * REC_GL); }
    }
}
struct PostRaw { f32x4 o0, o1, o2, o3; v4u y0, y1; v4u x0, x1, x2, x3, x4, x5, x6, x7; };
__device__ __forceinline__ void post_load(Frame& F, PostRaw& R, int t, int m, int c0) {
    const bf16* P = WSP(const bf16, WS_P); const bf16* Y = WSP(const bf16, WS_Y);
    const float* Ob = WSP(const float, WS_O) + (size_t)m * TOK * 256 + (size_t)t * 256 + c0;
    R.o0 = *(const GAS f32x4*)(Ob); R.o1 = *(const GAS f32x4*)(Ob + 4); R.o2 = *(const GAS f32x4*)(Ob + 8); R.o3 = *(const GAS f32x4*)(Ob + 12);
    R.y0 = *(const GAS v4u*)(Y + (size_t)t * D + 256 * m + c0); R.y1 = *(const GAS v4u*)(Y + (size_t)t * D + 256 * m + c0 + 8);
    const v4u zz = (v4u){0u, 0u, 0u, 0u}; R.x2 = zz; R.x3 = zz; R.x4 = zz; R.x5 = zz; R.x6 = zz; R.x7 = zz;
    if (m != 2) { const int gc = (m == 0 ? HG_G : m == 1 ? GL_R : RT_G) + c0; R.x0 = *(const GAS v4u*)(P + (size_t)t * NP + gc); R.x1 = *(const GAS v4u*)(P + (size_t)t * NP + gc + 8); }
    else { const size_t ob = (size_t)t * 256 + c0;
        R.x0 = *(const GAS v4u*)(WSP(const bf16, WS_RWR) + ob); R.x1 = *(const GAS v4u*)(WSP(const bf16, WS_RWR) + ob + 8); R.x2 = *(const GAS v4u*)(WSP(const bf16, WS_RWK) + ob); R.x3 = *(const GAS v4u*)(WSP(const bf16, WS_RWK) + ob + 8);
        R.x4 = *(const GAS v4u*)(WSP(const bf16, WS_RWV) + ob); R.x5 = *(const GAS v4u*)(WSP(const bf16, WS_RWV) + ob + 8); R.x6 = *(const GAS v4u*)(WSP(const bf16, WS_RWG) + ob); R.x7 = *(const GAS v4u*)(WSP(const bf16, WS_RWG) + ob + 8); }
}
__device__ __forceinline__ void unpack16(const v4u a, const v4u b, float (&f)[16]) { float x[8], y[8]; unpack8(a, x); unpack8(b, y);
#pragma unroll
    for (int j = 0; j < 8; ++j) { f[j] = x[j]; f[8 + j] = y[j]; } }
__device__ __forceinline__ void phase_post(Frame& F, int l) {
    const int gw = F.vcu * NWAVES + F.wave, NGW = F.G * NWAVES;
    const int m = F.lane >> 4, h = (F.lane >> 2) & 3, qd = F.lane & 3; const int c0 = 64 * h + 16 * qd;
    bf16* Y = WSP(bf16, WS_Y);
    PostRaw cur, nxt;
    if (gw < TOK) post_load(F, cur, gw, m, c0);
    for (int t = gw; t < TOK; t += NGW) {
        if (t + NGW < TOK) post_load(F, nxt, t + NGW, m, c0);
        float o[16], oi[16];
        { const f32x4 q0 = cur.o0, q1 = cur.o1, q2 = cur.o2, q3 = cur.o3; o[0] = q0.x; o[1] = q0.y; o[2] = q0.z; o[3] = q0.w; o[4] = q1.x; o[5] = q1.y; o[6] = q1.z; o[7] = q1.w; o[8] = q2.x; o[9] = q2.y; o[10] = q2.z; o[11] = q2.w; o[12] = q3.x; o[13] = q3.y; o[14] = q3.z; o[15] = q3.w; }
        unpack16(cur.y0, cur.y1, oi);
        float s1 = 0.f, s2 = 0.f;
#pragma unroll
        for (int j = 0; j < 16; ++j) { o[j] += oi[j]; s1 += o[j]; s2 += o[j] * o[j]; }
        s1 = sum4(s1); s2 = sum4(s2);
        float y[16];
        if (m < 2) {
            const float rs = rsqrtf(s2 * (1.f / 64.f) + 1e-6f); const float* ng = INF(m == 0 ? 9 : 12) + l * 64 + 16 * qd;
            float g[16]; unpack16(cur.x0, cur.x1, g);
#pragma unroll
            for (int j = 0; j < 16; ++j) y[j] = o[j] * rs * ng[j] * (g[j] * sigm(g[j]));
        } else if (m == 2) {
            const float mean = s1 * (1.f / 64.f); float var = s2 * (1.f / 64.f) - mean * mean; var = fmaxf(var, 0.f); const float rs = rsqrtf(var + 64e-5f);
            float r[16], k[16], v[16], g[16]; unpack16(cur.x0, cur.x1, r); unpack16(cur.x2, cur.x3, k); unpack16(cur.x4, cur.x5, v); unpack16(cur.x6, cur.x7, g);
            const float* rk = INF(21) + l * 256 + c0; const float* lg = INF(22) + l * 256 + c0; const float* lb = INF(23) + l * 256 + c0;
            float bon = 0.f;
#pragma unroll
            for (int j = 0; j < 16; ++j) bon += r[j] * k[j] * rk[j];
            bon = sum4(bon);
#pragma unroll
            for (int j = 0; j < 16; ++j) y[j] = ((o[j] - mean) * rs * lg[j] + lb[j] + bon * v[j]) * g[j];
        } else {
            const float mean = s1 * (1.f / 64.f); float var = s2 * (1.f / 64.f) - mean * mean; var = fmaxf(var, 0.f); const float rs = rsqrtf(var + 1e-5f);
            float g[16]; unpack16(cur.x0, cur.x1, g);
#pragma unroll
            for (int j = 0; j < 16; ++j) y[j] = (g[j] * sigm(g[j])) * ((o[j] - mean) * rs);
        }
        v4u w0, w1; w0.x = pk2(y[0], y[1]); w0.y = pk2(y[2], y[3]); w0.z = pk2(y[4], y[5]); w0.w = pk2(y[6], y[7]); w1.x = pk2(y[8], y[9]); w1.y = pk2(y[10], y[11]); w1.z = pk2(y[12], y[13]); w1.w = pk2(y[14], y[15]);
        GAS v4u* yo = (GAS v4u*)(Y + (size_t)t * D + 256 * m + c0); yo[0] = w0; yo[1] = w1;
        cur = nxt;
    }
}
template <int MODE> struct LnRaw { f32x4 h[4]; f32x4 a[4]; v2u d1[4], d2[4]; float g1, g2; };
template <int MODE> __device__ __forceinline__ void ln_load(Frame& F, LnRaw<MODE>& R, int m) {
    const GAS f32x4* hr = (const GAS f32x4*)(F.h + (size_t)m * D) + F.lane;
#pragma unroll
    for (int j = 0; j < 4; ++j) R.h[j] = hr[64 * j];
    if (MODE == 0) { const GAS f32x4* ar = (const GAS f32x4*)(WSP(const float, WS_MIX) + (size_t)m * D) + F.lane;
#pragma unroll
        for (int j = 0; j < 4; ++j) R.a[j] = ar[64 * j]; }
    else { const bf16* DOUT = WSP(const bf16, WS_DOUT); const float* GATE = WSP(const float, WS_GATE); R.g1 = GATE[2 * m]; R.g2 = GATE[2 * m + 1];
#pragma unroll
        for (int j = 0; j < 4; ++j) { R.d1[j] = ((const GAS v2u*)(DOUT + (size_t)(2 * m) * D))[F.lane + 64 * j]; R.d2[j] = ((const GAS v2u*)(DOUT + (size_t)(2 * m + 1) * D))[F.lane + 64 * j]; } }
}
template <int MODE, bool ROUTE> __device__ __forceinline__ void phase_ln(Frame& F, const float* gw_, const float* bw_, const float* router, int mi) {
    const int gw = F.vcu * NWAVES + F.wave, NGW = F.G * NWAVES;
    bf16* hb = WSP(bf16, WS_HB); float* GATE = WSP(float, WS_GATE);
    LAS float* RT = (LAS float*)F.lds;
    if (ROUTE) { for (int i = F.tid; i < D * NE; i += NWAVES * 64) RT[(i & 7) * D + (i >> 3)] = router[i]; __syncthreads(); }
    f32x4 gv[4], bv[4];
#pragma unroll
    for (int j = 0; j < 4; ++j) { gv[j] = ((const GAS f32x4*)gw_)[F.lane + 64 * j]; bv[j] = ((const GAS f32x4*)bw_)[F.lane + 64 * j]; }
    LnRaw<MODE> cur, nxt;
    if (gw < TOK) ln_load<MODE>(F, cur, gw);
    for (int m = gw; m < TOK; m += NGW) {
        if (m + NGW < TOK) ln_load<MODE>(F, nxt, m + NGW);
        GAS f32x4* hr = (GAS f32x4*)(F.h + (size_t)m * D) + F.lane;
        f32x4 v[4]; float s = 0.f;
#pragma unroll
        for (int j = 0; j < 4; ++j) {
            f32x4 a;
            if (MODE == 0) a = cur.a[j];
            else { const v2u d1 = cur.d1[j], d2 = cur.d2[j]; const float g1 = cur.g1, g2 = cur.g2;
                a.x = g1 * bflo(d1.x) + g2 * bflo(d2.x); a.y = g1 * bfhi(d1.x) + g2 * bfhi(d2.x); a.z = g1 * bflo(d1.y) + g2 * bflo(d2.y); a.w = g1 * bfhi(d1.y) + g2 * bfhi(d2.y); }
            v[j] = cur.h[j] * DN_ALPHA + a; s += (v[j].x + v[j].y) + (v[j].z + v[j].w); }
        const float mean = wave_sum(s) * (1.f / D); float s2 = 0.f;
#pragma unroll
        for (int j = 0; j < 4; ++j) { v[j] = v[j] - mean; s2 += (v[j].x * v[j].x + v[j].y * v[j].y) + (v[j].z * v[j].z + v[j].w * v[j].w); }
        const float rstd = 1.f / sqrtf(wave_sum(s2) * (1.f / D) + 1e-5f);
        GAS v2u* o8 = (GAS v2u*)(hb + (size_t)m * D) + F.lane;
#pragma unroll
        for (int j = 0; j < 4; ++j) { v[j] = v[j] * rstd * gv[j] + bv[j]; hr[64 * j] = v[j]; v2u w; w.x = pk2(v[j].x, v[j].y); w.y = pk2(v[j].z, v[j].w); o8[64 * j] = w; }
        if (ROUTE) {
            float lg[8];
#pragma unroll
            for (int e = 0; e < 8; ++e) { float a = 0.f;
#pragma unroll
                for (int j = 0; j < 4; ++j) { const f32x4 r = *(const LAS f32x4*)(RT + e * D + 4 * (F.lane + 64 * j)); a += (v[j].x * r.x + v[j].y * r.y) + (v[j].z * r.z + v[j].w * r.w); }
                lg[e] = wave_sum(a); }
            int e1 = 0; float l1 = lg[0];
#pragma unroll
            for (int e = 1; e < 8; ++e) if (lg[e] > l1) { l1 = lg[e]; e1 = e; }
            int e2 = -1; float l2 = -3.0e38f;
#pragma unroll
            for (int e = 0; e < 8; ++e) if (e != e1 && lg[e] > l2) { l2 = lg[e]; e2 = e; }
            if (F.lane == 0) {
                const float p2 = __expf(l2 - l1); const float ga = 1.f / (1.f + p2);
                GATE[2 * m] = ga; GATE[2 * m + 1] = p2 * ga;
                int* list = WSP(int, WS_LIST) + (size_t)mi * NE * TOK;
                const unsigned p1 = __hip_atomic_fetch_add((unsigned*)(F.ctl + CW_CNT + (mi * 8 + e1) * 64), 1u, RLX_AGENT); list[e1 * TOK + p1] = 2 * m;
                const unsigned q2 = __hip_atomic_fetch_add((unsigned*)(F.ctl + CW_CNT + (mi * 8 + e2) * 64), 1u, RLX_AGENT); list[e2 * TOK + q2] = 2 * m + 1;
            }
        }
        cur = nxt;
    }
}
__device__ __forceinline__ void phase_gather(Frame& F, int mi) {
    int cnt[8], poff[9]; poff[0] = 0;
#pragma unroll
    for (int e = 0; e < 8; ++e) { cnt[e] = (int)__hip_atomic_load((unsigned*)(F.ctl + CW_CNT + (mi * 8 + e) * 64), RLX_AGENT); poff[e + 1] = poff[e] + ((cnt[e] + 255) >> 8); }
    const int npan = poff[8];
    int* tab = WSP(int, WS_TAB) + mi * TAB_STRIDE;
    if (blockIdx.x == 0) {
        for (int P = F.tid; P < npan; P += NWAVES * 64) { int e = 0, pe = 0, ce = cnt[0];
#pragma unroll
            for (int j = 1; j < 8; ++j) if (P >= poff[j]) { e = j; pe = poff[j]; ce = cnt[j]; }
            tab[4 * P] = e; tab[4 * P + 1] = 256 * (P - pe); tab[4 * P + 2] = ce; tab[4 * P + 3] = 0; }
        if (F.tid == 0) tab[640] = npan;
    }
    const int gw = F.vcu * NWAVES + F.wave, NGW = F.G * NWAVES;
    const int* list = WSP(const int, WS_LIST) + (size_t)mi * NE * TOK; const bf16* hb = WSP(const bf16, WS_HB); bf16* HP = WSP(bf16, WS_HPERM);
    for (int row = gw; row < 256 * npan; row += NGW) { const int P = row >> 8; int e = 0, pe = 0, ce = cnt[0];
#pragma unroll
        for (int j = 1; j < 8; ++j) if (P >= poff[j]) { e = j; pe = poff[j]; ce = cnt[j]; }
        const int r = row - 256 * pe; const int tok = (r < ce) ? (list[e * TOK + r] >> 1) : 0;
        const GAS v4u* s = (const GAS v4u*)(hb + (size_t)tok * D) + F.lane; GAS v4u* d = (GAS v4u*)(HP + (size_t)row * D) + F.lane; d[0] = s[0]; d[64] = s[64]; }
}
struct Args { const void* in[34]; float* out; unsigned char* ws; int ph_lo, ph_hi; };
__global__ void __launch_bounds__(NWAVES * 64, 2) mk_fwd(Args args) {
    extern __shared__ __attribute__((aligned(16))) unsigned char lds[];
    Frame F;
    F.lds = (LAS unsigned char*)lds;
    F.MISC = (volatile LAS unsigned*)(F.lds + MISC_OFF);
    F.tid = threadIdx.x; F.lane = F.tid & 63; F.wave = __builtin_amdgcn_readfirstlane(F.tid >> 6);
    F.G = gridDim.x; { const int bx = blockIdx.x; F.vcu = (F.G % 8 == 0) ? (bx % 8) * (F.G / 8) + bx / 8 : bx; }
    F.ws = args.ws; F.in = args.in; F.h = args.out;
    F.ctl = (gu32*)(args.ws + WS_CTL);
    for (int u = F.tid; u < (LDS_BYTES - LDSCTL_OFF) / 4; u += NWAVES * 64) ((LAS unsigned*)(F.lds + LDSCTL_OFF))[u] = 0u;
    __syncthreads();
    XcdBarrier bar; bar.bar = (unsigned*)(F.ctl + CW_BAR); bar.x = 0; bar.st = nullptr;
    if (!MK_PER_PHASE) bar = xcd_barrier_post((unsigned*)(F.ctl + CW_BAR), F.MISC + 8);
    const int lo = args.ph_lo, hi = args.ph_hi;
#define IN(k) (lo <= (k) && (k) < hi)
#define PHASE_BEGIN() do { int t_ = threadIdx.x; asm volatile("" : "+v"(t_)); F.tid = t_; F.lane = t_ & 63; F.wave = __builtin_amdgcn_readfirstlane(t_ >> 6); } while (0)
#define SEAM(k) do { if (IN(k) && IN((k) + 1)) { xcd_barrier(bar); if (DUPMASK & 4096) xcd_barrier(bar); } } while (0)
    for (int l = 0; l < DEPTH; ++l) {
        const int pb = l * NPH; const bool moe = (l & 1); const int mi = l >> 1;
#define PH(k) (((PHMASK >> (k)) & 1) && IN(pb + (k)))
        if (PH(0)) { PHASE_BEGIN(); phase_weights<0>(F, l); if (DUPMASK & 1) { __syncthreads(); phase_weights<0>(F, l); } } SEAM(pb + 0);
        if (PH(1)) for (int rep_ = 0; rep_ < (((DUPMASK >> 1) & 1) ? 2 : 1); ++rep_) { PHASE_BEGIN(); if (rep_) __syncthreads();
            pg8::Gemm g{WSP(const bf16, WS_HB), WSP(const bf16, WS_WIN), TOK, NP, D}; pg8::StaticOrder S; S.init(TOK, NP, F.G, (int)blockIdx.x);
            pg8::EpiBf16 E{WSP(bf16, WS_P), NP};
            pg8::gemm_phase<pg8::EpiBf16, pg8::StaticOrder, true, true>(F.lds, g, S, E);
        } SEAM(pb + 1);
        if (PH(2)) { PHASE_BEGIN(); phase_rwprep(F, l); if (DUPMASK & 4) { __syncthreads(); phase_rwprep(F, l); } } SEAM(pb + 2);
        if (PH(3)) { PHASE_BEGIN(); phase_chunkpre(F, l); if (DUPMASK & 8) { __syncthreads(); phase_chunkpre(F, l); } } SEAM(pb + 3);
        if (PH(4)) { PHASE_BEGIN(); phase_seq(F, l); if (DUPMASK & 16) { __syncthreads(); phase_seq(F, l); } } SEAM(pb + 4);
        if (PH(5)) { PHASE_BEGIN(); phase_post(F, l); __syncthreads(); phase_weights<1>(F, l); if (DUPMASK & 32) { __syncthreads(); phase_weights<1>(F, l); } } SEAM(pb + 5);
        if (PH(6)) for (int rep_ = 0; rep_ < (((DUPMASK >> 6) & 1) ? 2 : 1); ++rep_) { PHASE_BEGIN(); if (rep_) __syncthreads();
            pg8::Gemm g{WSP(const bf16, WS_Y), WSP(const bf16, WS_WOUT), TOK, D, D}; pg8::StaticOrder S; S.init(TOK, D, F.G, (int)blockIdx.x);
            pg8::EpiF32 E{WSP(float, WS_MIX), D};
            pg8::gemm_phase<pg8::EpiF32, pg8::StaticOrder, false, true>(F.lds, g, S, E);
        } SEAM(pb + 6);
        if (PH(7)) { PHASE_BEGIN();
            if (moe) phase_ln<0, true>(F, INF(4) + l * D, INF(5) + l * D, INF(30) + (size_t)mi * D * NE, mi);
            else phase_ln<0, false>(F, INF(4) + l * D, INF(5) + l * D, nullptr, 0);
        } SEAM(pb + 7);
        if (PH(8)) { PHASE_BEGIN(); if (moe) phase_gather(F, mi); } SEAM(pb + 8);
        if (PH(9)) for (int rep_ = 0; rep_ < (((DUPMASK >> 9) & 1) ? 2 : 1); ++rep_) { PHASE_BEGIN(); if (rep_) __syncthreads();
            if (!moe) { pg8::Gemm g{WSP(const bf16, WS_HB), WSP(const bf16, WS_WUP), TOK, 2 * FFD, D}; pg8::StaticOrder S; S.init(TOK, 2 * FFD, F.G, (int)blockIdx.x);
                pg8::EpiSwiGLU E{WSP(bf16, WS_HID), FFD, 22};
                pg8::gemm_phase<pg8::EpiSwiGLU, pg8::StaticOrder, true, true>(F.lds, g, S, E);
            } else { const int* tab = WSP(const int, WS_TAB) + mi * TAB_STRIDE; const int npan = tab[640];
                pg8::Gemm g{WSP(const bf16, WS_HPERM), WSP(const bf16, WS_WUP), 256 * npan, 2 * FFE, D}; pg8::MoeOrder S{tab, 11, F.G, (int)blockIdx.x, npan * 11};
                pg8::EpiSwiGLU E{WSP(bf16, WS_HID), FFE, 11};
                pg8::gemm_phase<pg8::EpiSwiGLU, pg8::MoeOrder, true, true>(F.lds, g, S, E);
            }
        } SEAM(pb + 9);
        if (PH(10)) for (int rep_ = 0; rep_ < (((DUPMASK >> 10) & 1) ? 2 : 1); ++rep_) { PHASE_BEGIN(); if (rep_) __syncthreads();
            if (!moe) { pg8::Gemm g{WSP(const bf16, WS_HID), WSP(const bf16, WS_WDN), TOK, D, FFD}; pg8::StaticOrder S; S.init(TOK, D, F.G, (int)blockIdx.x);
                pg8::EpiF32 E{WSP(float, WS_MIX), D};
                pg8::gemm_phase<pg8::EpiF32, pg8::StaticOrder, false, true>(F.lds, g, S, E);
            } else { const int* tab = WSP(const int, WS_TAB) + mi * TAB_STRIDE; const int npan = tab[640];
                pg8::Gemm g{WSP(const bf16, WS_HID), WSP(const bf16, WS_WDN), 256 * npan, D, FFE}; pg8::MoeOrder S{tab, 4, F.G, (int)blockIdx.x, npan * 4};
                pg8::EpiScatter E{WSP(bf16, WS_DOUT), tab, WSP(const int, WS_LIST) + (size_t)mi * NE * TOK};
                pg8::gemm_phase<pg8::EpiScatter, pg8::MoeOrder, true, true>(F.lds, g, S, E);
            }
        } SEAM(pb + 10);
        if (PH(11)) { PHASE_BEGIN();
            if (moe) phase_ln<1, false>(F, INF(6) + l * D, INF(7) + l * D, nullptr, 0);
            else phase_ln<0, false>(F, INF(6) + l * D, INF(7) + l * D, nullptr, 0);
        } SEAM(pb + 11);
#undef PH
    }
#undef IN
#undef SEAM
}

extern "C" void kernel_launch(void* const* d_in, const int* in_sizes, int n_in, void* d_out, int out_size, void* d_ws, size_t ws_size, hipStream_t stream) {
    static int grid = 0;
    if (grid == 0) {
        if (n_in != 34 || out_size != TOK * D || ws_size < WS_END) { fprintf(stderr, "kernel_launch: unexpected shapes (n_in %d, out %d, ws %zu)\n", n_in, out_size, ws_size); grid = -1; return; }
        int dev = 0, cus = 0, per_cu = 0;
        if (hipGetDevice(&dev) != hipSuccess || hipDeviceGetAttribute(&cus, hipDeviceAttributeMultiprocessorCount, dev) != hipSuccess) { grid = -1; return; }
        if (hipFuncSetAttribute((const void*)mk_fwd, hipFuncAttributeMaxDynamicSharedMemorySize, LDS_BYTES) != hipSuccess) { fprintf(stderr, "kernel_launch: hipFuncSetAttribute failed\n"); grid = -1; return; }
        if (hipOccupancyMaxActiveBlocksPerMultiprocessor(&per_cu, (const void*)mk_fwd, NWAVES * 64, LDS_BYTES) != hipSuccess || per_cu < 1) fprintf(stderr, "kernel_launch: occupancy query reports %d\n", per_cu);
        (void)hipGetLastError();
        grid = cus;
    }
    if (grid < 0) return;
    if (hipMemsetAsync((char*)d_ws + WS_CTL, 0, CTL_ZERO_BYTES, stream) != hipSuccess) return;
    Args a{};
    for (int i = 0; i < 34; ++i) a.in[i] = d_in[i];
    a.out = (float*)d_out; a.ws = (unsigned char*)d_ws;
#if MK_PER_PHASE
    for (int p = 0; p < NPHASES; ++p) { a.ph_lo = p; a.ph_hi = p + 1; hipLaunchKernelGGL(mk_fwd, dim3(grid), dim3(NWAVES * 64), LDS_BYTES, stream, a); }
#else
    a.ph_lo = 0; a.ph_hi = NPHASES; hipLaunchKernelGGL(mk_fwd, dim3(grid), dim3(NWAVES * 64), LDS_BYTES, stream, a);
#endif
}
```

```cpp
#include <hip/hip_runtime.h>
#include <cstdio>
#include <cstdint>
#ifndef PHMASK
#define PHMASK 0xfff
#endif
#ifndef DUPMASK
#define DUPMASK 0
#endif
#ifndef MK_PER_PHASE
#define MK_PER_PHASE 0
#endif
namespace pg8 {
#define PG8_LAS __attribute__((address_space(3)))
typedef unsigned short bf16_t;
typedef short bf16x8 __attribute__((ext_vector_type(8)));
typedef float f32x4 __attribute__((ext_vector_type(4)));
typedef unsigned u32x4 __attribute__((ext_vector_type(4)));
constexpr int BM = 256, BK = 64, HALF = 128, HTB = HALF * BK * 2  , STAGE_BYTES = 8 * HTB, NXCD = 8, WGM = 8;

__host__ __device__ __forceinline__ int lds_byte(int r, int c) { const int st = (r >> 4) * 2 + (c >> 5), rr = r & 15, cc = c & 31, ob = rr * 64 + cc * 2; return st * 1024 + (ob ^ (((ob >> 9) & 1) << 5)); }
__host__ __device__ __forceinline__ void stage_rc(int b, int& R, int& C) { const int st = b / 1024, sb = b % 1024, swz = sb ^ (((sb >> 9) & 1) << 5); R = (st >> 1) * 16 + swz / 64; C = (st & 1) * 32 + (swz % 64) / 2; }
__host__ __device__ __forceinline__ int perm32(int rho) { const int n = rho >> 4, i = rho & 15; return 8 * (i >> 2) + 4 * n + (i & 3); }

struct Unit { int pm, pn; };
struct Gemm { const bf16_t* A; const bf16_t* Bt; int M, N, K; };

struct StaticOrder {
    int nM, nN, nwg, G, c;
    __host__ __device__ void init(int M, int N, int G_, int c_) { nM = M / BM; nN = N / BM; nwg = nM * nN; G = G_; c = c_; }
    __host__ __device__ bool next(int i, Unit& u) const {
        const long L = (long)i * G + c; if (L >= nwg) return false;
        int wgid = (int)L; { const int q = nwg / NXCD, r = nwg % NXCD, xcd = wgid % NXCD, off = wgid / NXCD; wgid = (xcd < r ? xcd * (q + 1) : r * (q + 1) + (xcd - r) * q) + off; }
        const int nig = WGM * nN, gid = wgid / nig, fm = gid * WGM, gsz = (nM - fm) < WGM ? (nM - fm) : WGM;
        u.pm = fm + ((wgid % nig) % gsz); u.pn = (wgid % nig) / gsz; return true;
    }
    __device__ __forceinline__ void a_ready(const Unit&) const {}
    __device__ __forceinline__ void done(const Unit&) const {}
};
__device__ __forceinline__ unsigned cvt_pk_bf16(float lo, float hi) { unsigned r; asm volatile("v_cvt_pk_bf16_f32 %0, %1, %2" : "=v"(r) : "v"(lo), "v"(hi)); return r; }
typedef float f32x2 __attribute__((ext_vector_type(2)));
struct EpiBf16 {
    static constexpr bool PERM = true, AFTER_DRAIN = false;
    bf16_t* O; int ldc;
    __device__ __forceinline__ void operator()(const f32x4 (&acc)[2][2][4][2], const Unit& u, int wr, int wc, int fr, int fq) const {
        const int row0 = u.pm * BM + wr * 64 + fr; const int col0 = u.pn * BM + wc * 32 + 8 * fq;
#pragma unroll
        for (int ai = 0; ai < 2; ++ai)
#pragma unroll
            for (int m = 0; m < 4; ++m) { bf16_t* rowp = O + (size_t)(row0 + ai * HALF + m * 16) * ldc + col0;
#pragma unroll
                for (int bj = 0; bj < 2; ++bj) { const f32x4 v0 = acc[ai][bj][m][0], v1 = acc[ai][bj][m][1];
                    u32x4 w; w.x = cvt_pk_bf16(v0[0], v0[1]); w.y = cvt_pk_bf16(v0[2], v0[3]); w.z = cvt_pk_bf16(v1[0], v1[1]); w.w = cvt_pk_bf16(v1[2], v1[3]);
                    *(u32x4*)(rowp + bj * HALF) = w; } }
    }
};
struct EpiF32 {
    static constexpr bool PERM = false, AFTER_DRAIN = false;
    float* C; int ldc;
    __device__ __forceinline__ void operator()(const f32x4 (&acc)[2][2][4][2], const Unit& u, int wr, int wc, int fr, int fq) const {
        const int row0 = u.pm * BM + wr * 64 + fr, col0 = u.pn * BM + wc * 32 + 4 * fq;
#pragma unroll
        for (int ai = 0; ai < 2; ++ai)
#pragma unroll
            for (int m = 0; m < 4; ++m) { float* rowp = C + (size_t)(row0 + ai * HALF + m * 16) * ldc + col0;
#pragma unroll
                for (int bj = 0; bj < 2; ++bj)
#pragma unroll
                    for (int n = 0; n < 2; ++n) *(f32x4*)(rowp + bj * HALF + n * 16) = acc[ai][bj][m][n]; }
    }
};
__device__ __forceinline__ float silu_f(float x) { return x * __builtin_amdgcn_rcpf(1.0f + __expf(-x)); }
struct EpiSwiGLU {
    static constexpr bool PERM = true, AFTER_DRAIN = false;
    bf16_t* O; int ldc; int tiles_per_group;
    __device__ __forceinline__ void operator()(const f32x4 (&acc)[2][2][4][2], const Unit& u, int wr, int wc, int fr, int fq) const {
        const int row0 = u.pm * BM + wr * 64 + fr; const int pnl = u.pn % tiles_per_group; const int col0 = pnl * HALF + wc * 32 + 8 * fq;
#pragma unroll
        for (int ai = 0; ai < 2; ++ai)
#pragma unroll
            for (int m = 0; m < 4; ++m) { bf16_t* rowp = O + (size_t)(row0 + ai * HALF + m * 16) * ldc + col0;
                float h[8];
#pragma unroll
                for (int n = 0; n < 2; ++n)
#pragma unroll
                    for (int j = 0; j < 4; ++j) h[4 * n + j] = silu_f(acc[ai][0][m][n][j]) * acc[ai][1][m][n][j];
                u32x4 w; w.x = cvt_pk_bf16(h[0], h[1]); w.y = cvt_pk_bf16(h[2], h[3]); w.z = cvt_pk_bf16(h[4], h[5]); w.w = cvt_pk_bf16(h[6], h[7]);
                *(u32x4*)rowp = w; }
    }
};
struct EpiScatter {
    static constexpr bool PERM = true, AFTER_DRAIN = false;
    bf16_t* O; const int* tab;
    const int* list;
    __device__ __forceinline__ void operator()(const f32x4 (&acc)[2][2][4][2], const Unit& u, int wr, int wc, int fr, int fq) const {
        const int e = tab[4 * u.pm + 0], lr = tab[4 * u.pm + 1], cnt = tab[4 * u.pm + 2];
        const int pnl = u.pn & 3; const int col0 = pnl * BM + wc * 32 + 8 * fq; const int* lst = list + e * 16384;
#pragma unroll
        for (int ai = 0; ai < 2; ++ai)
#pragma unroll
            for (int m = 0; m < 4; ++m) { const int r = lr + wr * 64 + fr + ai * HALF + m * 16;
                if (r < cnt) { const int slot = lst[r]; bf16_t* rowp = O + (size_t)slot * 1024 + col0;
#pragma unroll
                    for (int bj = 0; bj < 2; ++bj) { const f32x4 v0 = acc[ai][bj][m][0], v1 = acc[ai][bj][m][1];
                        u32x4 w; w.x = cvt_pk_bf16(v0[0], v0[1]); w.y = cvt_pk_bf16(v0[2], v0[3]); w.z = cvt_pk_bf16(v1[0], v1[1]); w.w = cvt_pk_bf16(v1[2], v1[3]);
                        *(u32x4*)(rowp + bj * HALF) = w; } } }
    }
};
struct MoeOrder {
    const int* tab; int tpg, G, c, nunits;
    __device__ __forceinline__ bool next(int i, Unit& u) const {
        const int L = i * G + c; if (L >= nunits) return false;
        const int P = L / tpg, pnl = L - P * tpg; const int e = tab[4 * P];
        u.pm = P; u.pn = e * tpg + pnl; return true;
    }
    __device__ __forceinline__ void a_ready(const Unit&) const {}
    __device__ __forceinline__ void done(const Unit&) const {}
};
template <class Epi, class Sched, bool ALIGN_EPI = false, bool SP2 = false>
__device__ __forceinline__ void gemm_phase(PG8_LAS unsigned char* lds, const Gemm g, const Sched& S, const Epi& E) {
    int tid_ = threadIdx.x; asm volatile("" : "+v"(tid_));
    const int tid = tid_, wid = __builtin_amdgcn_readfirstlane(tid >> 6), lane = tid & 63, wr = wid >> 2, wc = wid & 3, fr = lane & 15, fq = lane >> 4;
    const int K = g.K, nt = K / BK;
    unsigned voffA[2], voffB[2];
#pragma unroll
    for (int i = 0; i < 2; ++i) { int R, C; stage_rc(tid * 16 + i * 8192, R, C); const int Rb = Epi::PERM ? ((R & ~31) + perm32(R & 31)) : R;
        voffA[i] = (unsigned)(R * K + C) * 2u; voffB[i] = (unsigned)(Rb * K + C) * 2u; }
    const size_t kstep = (size_t)(BK * 2);
    const size_t hstep = (size_t)HALF * K * 2;
    const size_t tstep = 2 * hstep;
    const unsigned ldsw = (unsigned)wid * 1024u;
    const int aoff = lds_byte(wr * 64 + fr, fq * 8), boff = lds_byte(wc * 32 + fr, fq * 8);
#define PG8_SA(b, h) (((b) * 2 + (h)) * HTB)
#define PG8_SB(b, h) ((4 + (b) * 2 + (h)) * HTB)
#define PG8_STAGE(bufoff, gbase, voff) do { _Pragma("unroll") for (int _i = 0; _i < 2; ++_i) \
        __builtin_amdgcn_global_load_lds((const unsigned*)((const char*)(gbase) + (voff)[_i]), (PG8_LAS unsigned*)(lds + (bufoff) + ldsw + _i * 8192), 16, 0, 0); } while (0)
#define PG8_LDA(dst, b, h) do { _Pragma("unroll") for (int m = 0; m < 4; ++m) _Pragma("unroll") for (int k = 0; k < 2; ++k) dst[m][k] = *(const PG8_LAS bf16x8*)(lds + PG8_SA(b, h) + aoff + m * 2048 + k * 1024); } while (0)
#define PG8_LDB(dst, b, h) do { _Pragma("unroll") for (int n = 0; n < 2; ++n) _Pragma("unroll") for (int k = 0; k < 2; ++k) dst[n][k] = *(const PG8_LAS bf16x8*)(lds + PG8_SB(b, h) + boff + n * 2048 + k * 1024); } while (0)
#define PG8_MMA(ai, bj, At, Bt) do { __builtin_amdgcn_s_setprio(1); _Pragma("unroll") for (int m = 0; m < 4; ++m) _Pragma("unroll") for (int n = 0; n < 2; ++n) _Pragma("unroll") for (int k = 0; k < 2; ++k) \
        acc[ai][bj][m][n] = __builtin_amdgcn_mfma_f32_16x16x32_bf16(Bt[n][k], At[m][k], acc[ai][bj][m][n], 0, 0, 0); __builtin_amdgcn_s_setprio(0); } while (0)
#define PG8_WAIT_V(n) asm volatile("s_waitcnt vmcnt(" #n ")" ::: "memory")
#define PG8_WAIT_L(n) asm volatile("s_waitcnt lgkmcnt(" #n ")" ::: "memory")
#define PG8_BAR __builtin_amdgcn_s_barrier()
#define PG8_SCHED __builtin_amdgcn_sched_barrier(0)
    Unit cur, nxt; int ui = 0;
    if (!S.next(0, cur)) return;
    f32x4 acc[2][2][4][2];
#pragma unroll
    for (int a = 0; a < 2; ++a)
#pragma unroll
        for (int b = 0; b < 2; ++b)
#pragma unroll
            for (int m = 0; m < 4; ++m)
#pragma unroll
                for (int n = 0; n < 2; ++n) acc[a][b][m][n] = (f32x4){0.f, 0.f, 0.f, 0.f};
    bf16x8 At[4][2], B0[2][2], B1[2][2];
    const char* cA = (const char*)g.A + (size_t)cur.pm * tstep; const char* cB = (const char*)g.Bt + (size_t)cur.pn * tstep;
    S.a_ready(cur);
    if constexpr (SP2) {
        PG8_STAGE(PG8_SB(0, 0), cB, voffB); PG8_STAGE(PG8_SB(0, 1), cB + hstep, voffB); PG8_STAGE(PG8_SA(0, 0), cA, voffA); PG8_STAGE(PG8_SA(0, 1), cA + hstep, voffA);
        if (wr == 1) PG8_BAR;
        PG8_WAIT_V(2); PG8_BAR;
        PG8_STAGE(PG8_SB(1, 0), cB + kstep, voffB); PG8_STAGE(PG8_SA(1, 0), cA + kstep, voffA); PG8_STAGE(PG8_SB(1, 1), cB + hstep + kstep, voffB);
        PG8_WAIT_V(6); PG8_BAR;
    } else {
        PG8_STAGE(PG8_SB(0, 0), cB, voffB); PG8_STAGE(PG8_SA(0, 0), cA, voffA); PG8_STAGE(PG8_SB(0, 1), cB + hstep, voffB); PG8_STAGE(PG8_SA(0, 1), cA + hstep, voffA);
        if (wr == 1) PG8_BAR;
        PG8_WAIT_V(4); PG8_BAR;
        PG8_STAGE(PG8_SB(1, 0), cB + kstep, voffB); PG8_STAGE(PG8_SA(1, 0), cA + kstep, voffA); PG8_STAGE(PG8_SB(1, 1), cB + hstep + kstep, voffB);
        PG8_WAIT_V(6); PG8_BAR;
    }
    for (;;) {
        const bool has_next = S.next(ui + 1, nxt);
        const char* nA = has_next ? (const char*)g.A + (size_t)nxt.pm * tstep : cA; const char* nB = has_next ? (const char*)g.Bt + (size_t)nxt.pn * tstep : cB;
        for (int t = 0; t < nt; t += 2) {
            const bool last = (t == nt - 2);
            const char* a1 = cA + (size_t)(t + 1) * kstep;
            const char* a2 = last ? nA : cA + (size_t)(t + 2) * kstep; const char* b2 = last ? nB : cB + (size_t)(t + 2) * kstep;
            const char* a3 = a2 + kstep; const char* b3 = b2 + kstep;
            if (last && has_next) S.a_ready(nxt);
            if constexpr (SP2) {
            PG8_LDB(B0, 0, 0); PG8_LDB(B1, 0, 1); PG8_SCHED; PG8_LDA(At, 0, 0); PG8_STAGE(PG8_SA(1, 1), a1 + hstep, voffA);
            PG8_WAIT_V(8); PG8_WAIT_L(0); PG8_BAR; PG8_MMA(0, 0, At, B0); PG8_MMA(0, 1, At, B1); PG8_BAR; PG8_SCHED;
            PG8_LDA(At, 0, 1); PG8_STAGE(PG8_SB(0, 0), b2, voffB); PG8_STAGE(PG8_SB(0, 1), b2 + hstep, voffB); PG8_STAGE(PG8_SA(0, 0), a2, voffA);
            PG8_WAIT_V(8); PG8_WAIT_L(0); PG8_BAR; PG8_MMA(1, 0, At, B0); PG8_MMA(1, 1, At, B1); PG8_BAR; PG8_SCHED;
            PG8_LDB(B0, 1, 0); PG8_LDB(B1, 1, 1); PG8_SCHED; PG8_LDA(At, 1, 0); PG8_STAGE(PG8_SA(0, 1), a2 + hstep, voffA);
            PG8_WAIT_V(8); PG8_WAIT_L(0); PG8_BAR; PG8_MMA(0, 0, At, B0); PG8_MMA(0, 1, At, B1); PG8_BAR; PG8_SCHED;
            PG8_LDA(At, 1, 1); PG8_STAGE(PG8_SB(1, 0), b3, voffB); PG8_STAGE(PG8_SB(1, 1), b3 + hstep, voffB); PG8_STAGE(PG8_SA(1, 0), a3, voffA);
            PG8_WAIT_V(8); PG8_WAIT_L(0); PG8_BAR; PG8_MMA(1, 0, At, B0); PG8_MMA(1, 1, At, B1); PG8_BAR; PG8_SCHED;
            } else {
            PG8_LDB(B0, 0, 0); PG8_SCHED; PG8_LDA(At, 0, 0); PG8_STAGE(PG8_SA(1, 1), a1 + hstep, voffA);
            PG8_WAIT_L(8); PG8_BAR; PG8_WAIT_L(0); PG8_MMA(0, 0, At, B0); PG8_BAR; PG8_SCHED;
            PG8_LDB(B1, 0, 1); PG8_STAGE(PG8_SB(0, 0), b2, voffB);
            PG8_BAR; PG8_WAIT_L(0); PG8_MMA(0, 1, At, B1); PG8_BAR;
            PG8_LDA(At, 0, 1); PG8_STAGE(PG8_SA(0, 0), a2, voffA);
            PG8_BAR; PG8_WAIT_L(0); PG8_MMA(1, 0, At, B0); PG8_BAR; PG8_SCHED;
            PG8_STAGE(PG8_SB(0, 1), b2 + hstep, voffB);
            PG8_WAIT_V(6); PG8_BAR; PG8_MMA(1, 1, At, B1); PG8_BAR;
            PG8_LDB(B0, 1, 0); PG8_SCHED; PG8_LDA(At, 1, 0); PG8_STAGE(PG8_SA(0, 1), a2 + hstep, voffA);
            PG8_WAIT_L(8); PG8_BAR; PG8_WAIT_L(0); PG8_MMA(0, 0, At, B0); PG8_BAR; PG8_SCHED;
            PG8_LDB(B1, 1, 1); PG8_STAGE(PG8_SB(1, 0), b3, voffB);
            PG8_BAR; PG8_WAIT_L(0); PG8_MMA(0, 1, At, B1); PG8_BAR;
            PG8_LDA(At, 1, 1); PG8_STAGE(PG8_SA(1, 0), a3, voffA);
            PG8_BAR; PG8_WAIT_L(0); PG8_MMA(1, 0, At, B0); PG8_BAR; PG8_SCHED;
            PG8_STAGE(PG8_SB(1, 1), b3 + hstep, voffB);
            PG8_WAIT_V(6); PG8_BAR; PG8_MMA(1, 1, At, B1); PG8_BAR;
            }
        }
        if constexpr (ALIGN_EPI) { if (wr == 0) PG8_BAR; }
        if constexpr (!Epi::AFTER_DRAIN) { E(acc, cur, wr, wc, fr, fq); S.done(cur); }
        if (!has_next) break;
#pragma unroll
        for (int a = 0; a < 2; ++a)
#pragma unroll
            for (int b = 0; b < 2; ++b)
#pragma unroll
                for (int m = 0; m < 4; ++m)
#pragma unroll
                    for (int n = 0; n < 2; ++n) acc[a][b][m][n] = (f32x4){0.f, 0.f, 0.f, 0.f};
        cur = nxt; cA = nA; cB = nB; ++ui;
        if constexpr (ALIGN_EPI) { if (wr == 1) PG8_BAR; }
    }
    PG8_WAIT_V(0);
    if constexpr (!ALIGN_EPI) { if (wr == 0) PG8_BAR; }
    PG8_BAR;
    if constexpr (Epi::AFTER_DRAIN) { E.fused(acc, cur, wr, wc, fr, fq, lds, wid, lane); S.done(cur); }
#undef PG8_SA
#undef PG8_SB
#undef PG8_STAGE
#undef PG8_LDA
#undef PG8_LDB
#undef PG8_MMA
#undef PG8_WAIT_V
#undef PG8_WAIT_L
#undef PG8_BAR
#undef PG8_SCHED
}
}
constexpr int NWAVES = 8;
constexpr int TOK = 16384, SEQ = 4096, D = 1024, NP = 4096, INC = 3888, DEPTH = 4;
constexpr int HG_Q = 0, HG_F = 256, HG_I = 512, HG_G = 768;
constexpr int GL_Q = 1024, GL_K = 1152, GL_V = 1280, GL_GLR = 1536, GL_R = 1552;
constexpr int RW_BASE = 1808, RW_R = 1808, RW_K = 2064, RW_V = 2320, RW_WLR = 2576, RW_ALR = 2640, RW_GLR = 2704;
constexpr int RT_Q = 2864, RT_K = 3120, RT_V = 3376, RT_G = 3632;
constexpr int FFD = 2816, FFE = 1408, NE = 8;
constexpr float DN_ALPHA = 1.6817928305074290f;
constexpr int NPH = 12;
constexpr int NPHASES = NPH * DEPTH;
constexpr size_t MiB = 1u << 20;
constexpr size_t WS_CTL = 0, CTL_ZERO_BYTES = 1 * MiB;
constexpr size_t WS_LIST = 1 * MiB;
constexpr size_t WS_GATE = 2 * MiB;
constexpr size_t WS_TAB = 3 * MiB;
constexpr size_t WS_WIN = 4 * MiB, WS_WOUT = 12 * MiB, WS_WUP = 14 * MiB, WS_WDN = 58 * MiB;
constexpr size_t WS_HB = 80 * MiB;
constexpr size_t WS_MIX = 112 * MiB;
constexpr size_t WS_O = WS_MIX;
constexpr size_t WS_VF = 176 * MiB;
constexpr size_t WS_P = 184 * MiB;
constexpr size_t WS_RWW = 312 * MiB;
constexpr size_t WS_RWR = 328 * MiB, WS_RWK = 336 * MiB, WS_RWV = 344 * MiB, WS_RWKK = 352 * MiB, WS_RWB = 360 * MiB, WS_RWG = 368 * MiB;
constexpr size_t WS_Y = 376 * MiB;
constexpr size_t WS_HID = 184 * MiB;
constexpr size_t WS_DOUT = 280 * MiB;
constexpr size_t WS_HPERM = 344 * MiB;
constexpr size_t WS_END = 461 * MiB;
constexpr int CW_BAR = 4096;
constexpr int CW_CNT = 16384;
constexpr int TAB_STRIDE = 4 * 160 + 16;
constexpr size_t WS_LORA = 2 * MiB + 512 * 1024;
constexpr int LO_W2 = 0, LO_A2 = 256 * 64, LO_G2 = 2 * 256 * 64, LO_V1 = LO_G2 + 256 * 160, LO_V2 = LO_V1 + 32 * 256, LO_END = LO_V2 + 256 * 32;
constexpr int RING_BYTES = 131072, LDSCTL_OFF = 146432, MISC_OFF = LDSCTL_OFF + 320, LDS_BYTES = 147456;
#define GAS __attribute__((address_space(1)))
#define LAS __attribute__((address_space(3)))
typedef unsigned short bf16;
typedef unsigned v4u __attribute__((ext_vector_type(4)));
typedef unsigned v2u __attribute__((ext_vector_type(2)));
typedef float f32x4 __attribute__((ext_vector_type(4)));
typedef short bf16x8 __attribute__((ext_vector_type(8)));
typedef GAS unsigned gu32;
#define RLX_AGENT __ATOMIC_RELAXED, __HIP_MEMORY_SCOPE_AGENT
#define LDS_WAIT() asm volatile("s_waitcnt lgkmcnt(0)" ::: "memory")
#define VM_WAIT() asm volatile("s_waitcnt vmcnt(0)" ::: "memory")
#define LDS_BARRIER() do { asm volatile("s_waitcnt lgkmcnt(0)" ::: "memory"); __builtin_amdgcn_s_barrier(); asm volatile("" ::: "memory"); } while (0)
typedef float f32x2_t __attribute__((ext_vector_type(2))); typedef __bf16 bf16x2_t __attribute__((ext_vector_type(2)));
__device__ __forceinline__ unsigned pk2(float lo, float hi) { f32x2_t v = {lo, hi}; bf16x2_t b = __builtin_convertvector(v, bf16x2_t); return __builtin_bit_cast(unsigned, b); }
__device__ __forceinline__ unsigned f2bf(float f) { return pk2(f, f) & 0xffffu; }
__device__ __forceinline__ float bflo(unsigned w) { return __builtin_bit_cast(float, w << 16); }
__device__ __forceinline__ float bfhi(unsigned w) { return __builtin_bit_cast(float, w & 0xffff0000u); }
__device__ __forceinline__ float bf1(bf16 b) { return __builtin_bit_cast(float, ((unsigned)b) << 16); }
__device__ __forceinline__ void unpack8(const v4u w, float (&f)[8]) { f[0] = bflo(w.x); f[1] = bfhi(w.x); f[2] = bflo(w.y); f[3] = bfhi(w.y); f[4] = bflo(w.z); f[5] = bfhi(w.z); f[6] = bflo(w.w); f[7] = bfhi(w.w); }
__device__ __forceinline__ v4u pack8(const float (&f)[8]) { v4u w; w.x = pk2(f[0], f[1]); w.y = pk2(f[2], f[3]); w.z = pk2(f[4], f[5]); w.w = pk2(f[6], f[7]); return w; }
__device__ __forceinline__ float sigm(float x) { return __builtin_amdgcn_rcpf(1.0f + __expf(-x)); }
template <int CTRL> __device__ __forceinline__ float dpp(float x) { return __builtin_bit_cast(float, __builtin_amdgcn_mov_dpp(__builtin_bit_cast(int, x), CTRL, 0xf, 0xf, true)); }
__device__ __forceinline__ float sum16(float x) { x += dpp<0xB1>(x); x += dpp<0x4E>(x); x += dpp<0x141>(x); x += dpp<0x128>(x); return x; }
__device__ __forceinline__ float sum4(float x) { x += dpp<0xB1>(x); x += dpp<0x4E>(x); return x; }
__device__ __forceinline__ float wave_sum(float v) {
#pragma unroll
    for (int o = 1; o < 64; o <<= 1) v += __shfl_xor(v, o);
    return v;
}
__device__ const double INVF2PI[32] = {0.15915494309189535, 0.11934937021124886, 0.08949940160889101, 0.06711508300522726, 0.050329212104487035, 0.03774158471741977, 0.0283021958306234, 0.02122365276477766, 0.015915494309189534, 0.011934937021124886, 0.008949940160889102, 0.006711508300522725, 0.005032921210448704, 0.003774158471741977, 0.00283021958306234, 0.0021223652764777662, 0.0015915494309189536, 0.0011934937021124885, 0.0008949940160889102, 0.0006711508300522726, 0.0005032921210448703, 0.00037741584717419774, 0.00028302195830623395, 0.0002122365276477766, 0.00015915494309189535, 0.00011934937021124886, 8.949940160889102e-05, 6.711508300522725e-05, 5.0329212104487035e-05, 3.774158471741978e-05, 2.8302195830623396e-05, 2.122365276477766e-05};
#define XB_TMO      128
#define XB_XCNT(j)  (256  + 64 * (j))
#define XB_XSUB(j)  (1280 + 64 * (j))
#define XB_XGEN(j)  (2304 + 64 * (j))
#define XB_TOP      3328
#define XB_TOPGEN   3392
#define XCD_BAR_WORDS 3456
#define XB_SPIN_CAP (1u << 18)

__device__ __forceinline__ unsigned xb_ld(unsigned* p)              { return __hip_atomic_load(p, __ATOMIC_RELAXED, __HIP_MEMORY_SCOPE_AGENT); }
__device__ __forceinline__ unsigned xb_add(unsigned* p, unsigned v) { return __hip_atomic_fetch_add(p, v, __ATOMIC_RELAXED, __HIP_MEMORY_SCOPE_AGENT); }
__device__ __forceinline__ unsigned xb_xcc_id() { return (unsigned)__builtin_amdgcn_s_getreg((3 << 11) | 20) & 0xFu; }
#define XB_SPIN(cond, bar) do { unsigned _sp = 0; while (cond) { __builtin_amdgcn_s_sleep(1); \
    if ((++_sp & 255u) == 0u) { if (xb_ld(&(bar)[XB_TMO])) break; if (_sp > XB_SPIN_CAP) { atomicAdd(&(bar)[XB_TMO], 1u); break; } } } } while (0)

struct XcdBarrier {
    unsigned* bar; unsigned x;
    volatile LAS unsigned* st;
};

__device__ __forceinline__ XcdBarrier xcd_barrier_post(unsigned* bar, volatile LAS unsigned* st) {
    XcdBarrier b; b.bar = bar; b.x = xb_xcc_id(); b.st = st;
    if (threadIdx.x == 0) (void)xb_add(&bar[XB_XCNT(b.x)], 1u);
    return b;
}
__device__ __forceinline__ void xcd_barrier_complete(unsigned* bar, unsigned x, unsigned& nloc, unsigned& nx) {
    const unsigned G = gridDim.x * gridDim.y * gridDim.z;
    unsigned sum, cnt, mine, sp = 0u;
    for (;;) {
        sum = 0u; cnt = 0u; mine = 0u;
#pragma unroll
        for (unsigned j = 0; j < 16; ++j) { const unsigned c = xb_ld(&bar[XB_XCNT(j)]); sum += c; cnt += (c > 0u) ? 1u : 0u; mine = (j == x) ? c : mine; }
        if (sum == G) break;
        __builtin_amdgcn_s_sleep(1);
        if ((++sp & 255u) == 0u) { if (xb_ld(&bar[XB_TMO])) break; if (sp > XB_SPIN_CAP) { atomicAdd(&bar[XB_TMO], 1u); break; } }
    }
    nloc = mine > 0u ? mine : 1u; nx = cnt > 0u ? cnt : 1u;
}

__device__ __forceinline__ void xcd_barrier(const XcdBarrier& b) {
    asm volatile("s_waitcnt vmcnt(0)" ::: "memory");
    __syncthreads();
    if (threadIdx.x == 0) {
        unsigned* bar = b.bar;
        __builtin_amdgcn_s_waitcnt(0);
        unsigned nloc = b.st[0], nx = b.st[1];
        if (nloc == 0u) { xcd_barrier_complete(bar, b.x, nloc, nx); b.st[0] = nloc; b.st[1] = nx; }
        const unsigned old = xb_add(&bar[XB_XSUB(b.x)], 1u);
        const unsigned gen = old / nloc;
        if (old + 1u == (gen + 1u) * nloc) {
            __builtin_amdgcn_fence(__ATOMIC_RELEASE, "agent");
            asm volatile("s_waitcnt vmcnt(0)" ::: "memory");
            const unsigned og = xb_add(&bar[XB_TOP], 1u);
            const unsigned tg = og / nx;
            if (og + 1u == (tg + 1u) * nx) xb_add(&bar[XB_TOPGEN], 1u);
            else XB_SPIN(xb_ld(&bar[XB_TOPGEN]) == tg, bar);
            __builtin_amdgcn_fence(__ATOMIC_ACQUIRE, "agent");
            xb_add(&bar[XB_XGEN(b.x)], 1u);
            asm volatile("s_waitcnt vmcnt(0)" ::: "memory");
        } else {
            XB_SPIN(xb_ld(&bar[XB_XGEN(b.x)]) == gen, bar);
            __builtin_amdgcn_fence(__ATOMIC_ACQUIRE, "agent");
            asm volatile("s_waitcnt vmcnt(0)" ::: "memory");
        }
    }
    __syncthreads();
}
struct Frame {
    LAS unsigned char* lds;
    volatile LAS unsigned* MISC;
    gu32* ctl;
    int tid, lane, wave;
    int vcu, G;
    unsigned char* ws;
    const void* const* in;
    float* h;
};
__device__ __forceinline__ const void* ldptr(const void* const* tab, int k) { int z; asm volatile("s_mov_b32 %0, 0" : "=s"(z)); return tab[k + z]; }
#define INF(k) ((const float*)ldptr(F.in, k))
#define WSP(T, off) ((T*)(F.ws + (off)))

__device__ __forceinline__ void xpose_item(const float* W, int ldw, int nvalid, int k0, int n0, bf16* WT, int ldt, int drow0, LAS float* scr, int lane) {
#pragma unroll 8
    for (int i = 0; i < 32; ++i) { const int kk = 2 * i + (lane >> 5), n = n0 + (lane & 31); scr[kk * 33 + (lane & 31)] = (n < nvalid) ? W[(size_t)(k0 + kk) * ldw + n] : 0.f; }
    LDS_WAIT(); asm volatile("" ::: "memory");
    const int c = lane & 7;
#pragma unroll
    for (int j = 0; j < 4; ++j) { const int n = (lane >> 3) + 8 * j; const LAS float* s = scr + (8 * c) * 33 + n;
        v4u o; o.x = pk2(s[0 * 33], s[1 * 33]); o.y = pk2(s[2 * 33], s[3 * 33]); o.z = pk2(s[4 * 33], s[5 * 33]); o.w = pk2(s[6 * 33], s[7 * 33]);
        *(GAS v4u*)(WT + (size_t)(drow0 + n) * ldt + k0 + 8 * c) = o; }
    LDS_WAIT(); asm volatile("" ::: "memory");
}
__device__ __forceinline__ int gu_row(int n) { return 256 * (n >> 7) + (n & 127); }
template <int PART> __device__ __forceinline__ void phase_weights(Frame& F, int l) {
    LAS float* scr = (LAS float*)(F.lds + F.wave * 16384);
    const int gw = F.vcu * NWAVES + F.wave, NGW = F.G * NWAVES;
    const bool moe = (l & 1); const int fi = l >> 1;
    constexpr int I_IN = 16 * 128, I_OUT = 16 * 32;
    constexpr int I_DG = 16 * 88, I_DD = 44 * 32;
    constexpr int I_MG = 16 * 44, I_MD = 22 * 32;
    const int nitems = PART == 0 ? (I_IN + I_OUT) : (moe ? NE * (2 * I_MG + I_MD) : (2 * I_DG + I_DD));
    for (int it = gw; it < nitems; it += NGW) {
        int r = it + (PART == 0 ? 0 : I_IN + I_OUT);
        if (r < I_IN) { const int kb = r >> 7, nb = r & 127; xpose_item(INF(2) + (size_t)l * D * INC, INC, INC, 64 * kb, 32 * nb, WSP(bf16, WS_WIN), D, 32 * nb, scr, F.lane); continue; } r -= I_IN;
        if (r < I_OUT) { const int kb = r >> 5, nb = r & 31; xpose_item(INF(3) + (size_t)l * D * D, D, D, 64 * kb, 32 * nb, WSP(bf16, WS_WOUT), D, 32 * nb, scr, F.lane); continue; } r -= I_OUT;
        if (!moe) {
            if (r < 2 * I_DG) { const int up = r >= I_DG; if (up) r -= I_DG; const int kb = r / 88, nb = r % 88;
                xpose_item(INF(up ? 28 : 27) + (size_t)fi * D * FFD, FFD, FFD, 64 * kb, 32 * nb, WSP(bf16, WS_WUP), D, gu_row(32 * nb) + (up ? 128 : 0), scr, F.lane); continue; } r -= 2 * I_DG;
            { const int kb = r >> 5, nb = r & 31; xpose_item(INF(29) + (size_t)fi * FFD * D, D, D, 64 * kb, 32 * nb, WSP(bf16, WS_WDN), FFD, 32 * nb, scr, F.lane); }
        } else {
            const int per = 2 * I_MG + I_MD; const int e = r / per; r -= e * per;
            if (r < 2 * I_MG) { const int up = r >= I_MG; if (up) r -= I_MG; const int kb = r / 44, nb = r % 44;
                xpose_item(INF(up ? 32 : 31) + (size_t)(fi * NE + e) * D * FFE, FFE, FFE, 64 * kb, 32 * nb, WSP(bf16, WS_WUP) + (size_t)e * 2 * FFE * D, D, gu_row(32 * nb) + (up ? 128 : 0), scr, F.lane); continue; } r -= 2 * I_MG;
            { const int kb = r >> 5, nb = r & 31; xpose_item(INF(33) + (size_t)(fi * NE + e) * FFE * D, D, D, 64 * kb, 32 * nb, WSP(bf16, WS_WDN) + (size_t)e * D * FFE, FFE, 32 * nb, scr, F.lane); }
        }
    }
    if (PART == 0) {
        bf16* LO = WSP(bf16, WS_LORA); const int gt = F.vcu * NWAVES * 64 + F.tid, NT = F.G * NWAVES * 64;
        const float* w2 = INF(15) + (size_t)l * 64 * 256; const float* a2 = INF(17) + (size_t)l * 64 * 256; const float* g2 = INF(18) + (size_t)l * 160 * 256;
        for (int e = gt; e < LO_END; e += NT) { float v;
            if (e < LO_A2) { const int n = e >> 6, k = e & 63; v = w2[k * 256 + n]; }
            else if (e < LO_G2) { const int q = e - LO_A2, n = q >> 6, k = q & 63; v = a2[k * 256 + n]; }
            else if (e < LO_V1) { const int q = e - LO_G2, n = q / 160, k = q - n * 160; v = g2[k * 256 + n]; }
            else if (e < LO_V2) { const int q = e - LO_V1, n = q >> 8, k = q & 255; v = (l > 0) ? (INF(25) + (size_t)(l - 1) * 256 * 32)[k * 32 + n] : 0.f; }
            else { const int q = e - LO_V2, n = q >> 5, k = q & 31; v = (l > 0) ? (INF(26) + (size_t)(l - 1) * 32 * 256)[k * 256 + n] : 0.f; }
            LO[e] = (bf16)f2bf(v); }
    }
    if (PART == 0 && l == 0) {
        const float* x = INF(0); bf16* hb = WSP(bf16, WS_HB);
        for (int m = gw; m < TOK; m += NGW) {
            const GAS f32x4* xr = (const GAS f32x4*)(x + (size_t)m * D) + F.lane; GAS f32x4* hr = (GAS f32x4*)(F.h + (size_t)m * D) + F.lane; GAS v2u* o8 = (GAS v2u*)(hb + (size_t)m * D) + F.lane;
#pragma unroll
            for (int j = 0; j < 4; ++j) { const f32x4 v = xr[64 * j]; hr[64 * j] = v; v2u w; w.x = pk2(v.x, v.y); w.y = pk2(v.z, v.w); o8[64 * j] = w; }
        }
    }
}
template <int NKS> __device__ __forceinline__ void rw_mm16(f32x4 (&acc)[2][4], const LAS bf16* X, int ldx, int mb0, const bf16* BT, int hh, int lane) {
    const int fr = lane & 15, fq = lane >> 4; constexpr int K = 32 * NKS;
    bf16x8 bfr[NKS][4];
#pragma unroll
    for (int ks = 0; ks < NKS; ++ks)
#pragma unroll
        for (int nb = 0; nb < 4; ++nb) bfr[ks][nb] = *(const GAS bf16x8*)(BT + (size_t)(64 * hh + 16 * nb + fr) * K + 32 * ks + 8 * fq);
#pragma unroll
    for (int ks = 0; ks < NKS; ++ks)
#pragma unroll
        for (int mi = 0; mi < 2; ++mi) { const bf16x8 a = *(const LAS bf16x8*)(X + (16 * (mb0 + mi) + fr) * ldx + 32 * ks + 8 * fq);
#pragma unroll
            for (int nb = 0; nb < 4; ++nb) acc[mi][nb] = __builtin_amdgcn_mfma_f32_16x16x32_bf16(a, bfr[ks][nb], acc[mi][nb], 0, 0, 0); }
}
__device__ __forceinline__ void rwprep_tile(Frame& F, int l, int tile) {
    const bf16* P = WSP(const bf16, WS_P);
    const float* mu = INF(13) + l * 1056;
    LAS bf16* X1 = (LAS bf16*)F.lds; LAS bf16* X2 = X1 + 64 * 72; LAS bf16* X3 = X2 + 64 * 72; LAS bf16* XV = X3 + 64 * 168; LAS bf16* X5 = XV + 64 * 264; LAS bf16* XK = X5 + 64 * 40;
    float* RWW = WSP(float, WS_RWW); bf16* RWR = WSP(bf16, WS_RWR); bf16* RWK = WSP(bf16, WS_RWK); bf16* RWV = WSP(bf16, WS_RWV);
    bf16* RWKK = WSP(bf16, WS_RWKK); bf16* RWB = WSP(bf16, WS_RWB); bf16* RWG = WSP(bf16, WS_RWG); bf16* VF = WSP(bf16, WS_VF);
    const bf16* LORA = WSP(const bf16, WS_LORA);
    int tid_ = F.tid; asm volatile("" : "+v"(tid_));
    const int lane_ = tid_ & 63, wave_ = __builtin_amdgcn_readfirstlane(tid_ >> 6);
    const int fr = lane_ & 15, fq = lane_ >> 4, hh = wave_ & 3, mb0 = 2 * (wave_ >> 2);
    const int t0 = tile * 64;
#pragma unroll
    for (int half = 0; half < 2; ++half) {
        v4u rc[9], rp[9];
#pragma unroll
        for (int i = 0; i < 9; ++i) { const int g = tid_ + (half * 9 + i) * 512; rc[i] = (v4u){0u, 0u, 0u, 0u}; rp[i] = rc[i];
            if (g < 64 * 132) { const int tt = g / 132, cg = g - tt * 132, t = t0 + tt; const int col = RW_BASE + 8 * (cg < 36 ? 96 + cg : cg < 68 ? cg - 36 : cg < 100 ? 64 + (cg - 68) : 32 + (cg - 100));
                rc[i] = *(const GAS v4u*)(P + (size_t)t * NP + col); if ((t & (SEQ - 1)) != 0) rp[i] = *(const GAS v4u*)(P + (size_t)(t - 1) * NP + col); } }
#pragma unroll
        for (int i = 0; i < 9; ++i) { const int g = tid_ + (half * 9 + i) * 512;
            if (g < 64 * 132) { const int tt = g / 132, cg = g - tt * 132, t = t0 + tt; const int rel = 8 * (cg < 36 ? 96 + cg : cg < 68 ? cg - 36 : cg < 100 ? 64 + (cg - 68) : 32 + (cg - 100));
                const f32x4 m0 = *(const GAS f32x4*)(mu + rel), m1 = *(const GAS f32x4*)(mu + rel + 4); const float m[8] = {m0.x, m0.y, m0.z, m0.w, m1.x, m1.y, m1.z, m1.w};
                float cv[8], pv[8], xs[8]; unpack8(rc[i], cv); unpack8(rp[i], pv);
#pragma unroll
                for (int j = 0; j < 8; ++j) xs[j] = cv[j] + (pv[j] - cv[j]) * m[j];
                if (cg < 8) {
#pragma unroll
                    for (int j = 0; j < 8; ++j) { const float e2 = __expf(2.f * xs[j]); xs[j] = 1.f - 2.f * __builtin_amdgcn_rcpf(e2 + 1.f); }
                    *(LAS v4u*)(X1 + tt * 72 + 8 * cg) = pack8(xs);
                } else if (cg < 16) { *(LAS v4u*)(X2 + tt * 72 + 8 * (cg - 8)) = pack8(xs);
                } else if (cg < 36) {
#pragma unroll
                    for (int j = 0; j < 8; ++j) xs[j] = sigm(xs[j]);
                    *(LAS v4u*)(X3 + tt * 168 + 8 * (cg - 16)) = pack8(xs);
                } else if (cg < 68) { *(GAS v4u*)(RWR + (size_t)t * 256 + 8 * (cg - 36)) = pack8(xs);
                } else if (cg < 100) { const v4u w = pack8(xs); *(LAS v4u*)(XV + tt * 264 + 8 * (cg - 68)) = w;
                    if (l == 0) { *(GAS v4u*)(RWV + (size_t)t * 256 + 8 * (cg - 68)) = w; *(GAS v4u*)(VF + (size_t)t * 256 + 8 * (cg - 68)) = w; }
                } else { *(LAS v4u*)(XK + tt * 264 + 8 * (cg - 100)) = pack8(xs); } } }
    }
    __syncthreads();
    {   f32x4 acc[2][4];
#pragma unroll
        for (int mi = 0; mi < 2; ++mi)
#pragma unroll
            for (int nb = 0; nb < 4; ++nb) acc[mi][nb] = (f32x4){0.f, 0.f, 0.f, 0.f};
        rw_mm16<2>(acc, X1, 72, mb0, LORA + LO_W2, hh, lane_);
        const float* w0 = INF(14) + l * 256;
#pragma unroll
        for (int mi = 0; mi < 2; ++mi)
#pragma unroll
            for (int nb = 0; nb < 4; ++nb) { const int col = 64 * hh + 16 * nb + fr; const float w0c = w0[col];
#pragma unroll
                for (int r = 0; r < 4; ++r) { const int t = t0 + 16 * (mb0 + mi) + 4 * fq + r; RWW[(size_t)t * 256 + col] = -0.6065306597126334f * sigm(acc[mi][nb][r] + w0c);     } }
#pragma unroll
        for (int mi = 0; mi < 2; ++mi)
#pragma unroll
            for (int nb = 0; nb < 4; ++nb) acc[mi][nb] = (f32x4){0.f, 0.f, 0.f, 0.f};
        rw_mm16<2>(acc, X2, 72, mb0, LORA + LO_A2, hh, lane_);
        const float* a0 = INF(16) + l * 256; const float* kkw = INF(19) + l * 256; const float* kaw = INF(20) + l * 256;
#pragma unroll
        for (int mi = 0; mi < 2; ++mi) {
            float kr[4][4], kq[4][4], ssq[4] = {0.f, 0.f, 0.f, 0.f};
#pragma unroll
            for (int nb = 0; nb < 4; ++nb) { const int col = 64 * hh + 16 * nb + fr; const float kkc = kkw[col];
#pragma unroll
                for (int r = 0; r < 4; ++r) { const int row = 16 * (mb0 + mi) + 4 * fq + r; kr[nb][r] = bf1(XK[row * 264 + col]); kq[nb][r] = kr[nb][r] * kkc; ssq[r] += kq[nb][r] * kq[nb][r]; } }
#pragma unroll
            for (int r = 0; r < 4; ++r) { ssq[r] = sum16(ssq[r]); ssq[r] = 1.0f / fmaxf(sqrtf(ssq[r]), 1e-12f); }
#pragma unroll
            for (int nb = 0; nb < 4; ++nb) { const int col = 64 * hh + 16 * nb + fr; const float a0c = a0[col], kac = kaw[col];
#pragma unroll
                for (int r = 0; r < 4; ++r) { const int t = t0 + 16 * (mb0 + mi) + 4 * fq + r; const float a = sigm(acc[mi][nb][r] + a0c); const float kk = kq[nb][r] * ssq[r];
                    const size_t o = (size_t)t * 256 + col; RWKK[o] = (bf16)f2bf(kk); RWB[o] = (bf16)f2bf(kk * a); RWK[o] = (bf16)f2bf(kr[nb][r] * (1.f + (a - 1.f) * kac)); } }
        }
#pragma unroll
        for (int mi = 0; mi < 2; ++mi)
#pragma unroll
            for (int nb = 0; nb < 4; ++nb) acc[mi][nb] = (f32x4){0.f, 0.f, 0.f, 0.f};
        rw_mm16<5>(acc, X3, 168, mb0, LORA + LO_G2, hh, lane_);
#pragma unroll
        for (int mi = 0; mi < 2; ++mi)
#pragma unroll
            for (int nb = 0; nb < 4; ++nb) { const int col = 64 * hh + 16 * nb + fr;
#pragma unroll
                for (int r = 0; r < 4; ++r) { const int t = t0 + 16 * (mb0 + mi) + 4 * fq + r; RWG[(size_t)t * 256 + col] = (bf16)f2bf(acc[mi][nb][r]); } }
    }
    if (l > 0) {
        const float* v0 = INF(24) + (l - 1) * 256; const bf16* v1T = LORA + LO_V1; const bf16* v2T = LORA + LO_V2;
        {
            const int mb = wave_ & 3, nb = wave_ >> 2; f32x4 a4 = (f32x4){0.f, 0.f, 0.f, 0.f}; bf16x8 bv[8];
#pragma unroll
            for (int ks = 0; ks < 8; ++ks) bv[ks] = *(const GAS bf16x8*)(v1T + (size_t)(16 * nb + fr) * 256 + 32 * ks + 8 * fq);
#pragma unroll
            for (int ks = 0; ks < 8; ++ks) a4 = __builtin_amdgcn_mfma_f32_16x16x32_bf16(*(const LAS bf16x8*)(XV + (16 * mb + fr) * 264 + 32 * ks + 8 * fq), bv[ks], a4, 0, 0, 0);
#pragma unroll
            for (int r = 0; r < 4; ++r) X5[(16 * mb + 4 * fq + r) * 40 + 16 * nb + fr] = (bf16)f2bf(a4[r]);
        }
        __syncthreads();
        {   f32x4 acc[2][4];
#pragma unroll
            for (int mi = 0; mi < 2; ++mi)
#pragma unroll
                for (int nb = 0; nb < 4; ++nb) acc[mi][nb] = (f32x4){0.f, 0.f, 0.f, 0.f};
            rw_mm16<1>(acc, X5, 40, mb0, v2T, hh, lane_);
#pragma unroll
            for (int mi = 0; mi < 2; ++mi)
#pragma unroll
                for (int nb = 0; nb < 4; ++nb) { const int col = 64 * hh + 16 * nb + fr; const float v0c = v0[col];
#pragma unroll
                    for (int r = 0; r < 4; ++r) { const int row = 16 * (mb0 + mi) + 4 * fq + r; const size_t o = (size_t)(t0 + row) * 256 + col;
                        const float xv = bf1(XV[row * 264 + col]); const float vf = bf1(VF[o]); RWV[o] = (bf16)f2bf(xv + (vf - xv) * sigm(acc[mi][nb][r] + v0c)); } }
        }
    }
    __syncthreads();
}
constexpr int CB = 64 * 66;
constexpr int HB_ = 64 * 72;
constexpr int PRE_H0 = 3 * CB * 4;
constexpr int PV_OFF = (PRE_H0 + 10 * HB_ * 2) / 4;
constexpr int REC_RW = 53760, REC_GL = 16640;
constexpr int RO_QH = 0, RO_AT = 8192, RO_BH = 16384, RO_TT = 24576, RO_MRB = 30720, RO_GAM = 36864, RO_VB = 37376;
constexpr int RO_Y = 0, RO_SK = 0;
constexpr int GO_QH = 0, GO_SK = 8192, GO_GAM = 16384;
#define PBUF(i) ((LAS float*)F.lds + (i) * CB)
#define HBUF(i) ((LAS bf16*)(F.lds + PRE_H0) + (i) * HB_)
__device__ __forceinline__ void nt16(f32x4 (&acc)[2], const LAS bf16* X, const LAS bf16* Y, int mb, int nb0, int lane) {
    const int fr = lane & 15, fq = lane >> 4;
    acc[0] = (f32x4){0.f, 0.f, 0.f, 0.f}; acc[1] = acc[0];
#pragma unroll
    for (int ks = 0; ks < 2; ++ks) { const bf16x8 a = *(const LAS bf16x8*)(X + (16 * mb + fr) * 72 + 32 * ks + 8 * fq);
        const bf16x8 b0 = *(const LAS bf16x8*)(Y + (16 * nb0 + fr) * 72 + 32 * ks + 8 * fq), b1 = *(const LAS bf16x8*)(Y + (16 * nb0 + 16 + fr) * 72 + 32 * ks + 8 * fq);
        acc[0] = __builtin_amdgcn_mfma_f32_16x16x32_bf16(a, b0, acc[0], 0, 0, 0); acc[1] = __builtin_amdgcn_mfma_f32_16x16x32_bf16(a, b1, acc[1], 0, 0, 0); }
}
typedef short v4i16_t __attribute__((ext_vector_type(4)));
__device__ __forceinline__ v2u trr(const LAS bf16* p) { return __builtin_bit_cast(v2u, __builtin_amdgcn_ds_read_tr16_b64_v4i16((LAS v4i16_t*)p)); }
__device__ __forceinline__ bf16x8 trfrag(const LAS bf16* M, int c, int ks, int lane) {
    const int g = lane >> 4, q = (lane & 15) >> 2, p = lane & 3; const LAS bf16* a = M + (32 * ks + 8 * g + q) * 72 + 16 * c + 4 * p;
    const v2u lo = trr(a), hi = trr(a + 4 * 72); v4u w; w.x = lo.x; w.y = lo.y; w.z = hi.x; w.w = hi.y; return __builtin_bit_cast(bf16x8, w);
}
__device__ __forceinline__ void tn16(f32x4 (&acc)[2], const LAS bf16* X, const LAS bf16* Y, int mb, int nb0, int lane) {
    acc[0] = (f32x4){0.f, 0.f, 0.f, 0.f}; acc[1] = acc[0];
#pragma unroll
    for (int ks = 0; ks < 2; ++ks) { const bf16x8 a = trfrag(X, mb, ks, lane), b0 = trfrag(Y, nb0, ks, lane), b1 = trfrag(Y, nb0 + 1, ks, lane);
        acc[0] = __builtin_amdgcn_mfma_f32_16x16x32_bf16(a, b0, acc[0], 0, 0, 0); acc[1] = __builtin_amdgcn_mfma_f32_16x16x32_bf16(a, b1, acc[1], 0, 0, 0); }
}
__device__ __forceinline__ void nn16(f32x4 (&acc)[2], const LAS bf16* A, const LAS bf16* B, int mb, int nb0, int lane) {
    const int fr = lane & 15, fq = lane >> 4;
    acc[0] = (f32x4){0.f, 0.f, 0.f, 0.f}; acc[1] = acc[0];
#pragma unroll
    for (int ks = 0; ks < 2; ++ks) { const bf16x8 a = *(const LAS bf16x8*)(A + (16 * mb + fr) * 72 + 32 * ks + 8 * fq), b0 = trfrag(B, nb0, ks, lane), b1 = trfrag(B, nb0 + 1, ks, lane);
        acc[0] = __builtin_amdgcn_mfma_f32_16x16x32_bf16(a, b0, acc[0], 0, 0, 0); acc[1] = __builtin_amdgcn_mfma_f32_16x16x32_bf16(a, b1, acc[1], 0, 0, 0); }
}
__device__ __forceinline__ void hfrag_tr(const LAS bf16* M, unsigned char* dst, int wave, int lane) {
    const int mb = wave >> 1, ks = wave & 1, g = lane >> 4, q = (lane & 15) >> 2, p = lane & 3; const LAS bf16* a = M + (32 * ks + 4 * g + q) * 72 + 16 * mb + 4 * p;
    const v2u lo = trr(a), hi = trr(a + 16 * 72); v4u w; w.x = lo.x; w.y = lo.y; w.z = hi.x; w.w = hi.y;
    *(GAS v4u*)(dst + ((size_t)wave * 64 + lane) * 16) = w;
}
template <int MASK> __device__ __forceinline__ void hst(const f32x4 (&acc)[2], LAS bf16* S, int mb, int nb0, int lane) {
    const int fr = lane & 15, fq = lane >> 4;
#pragma unroll
    for (int n = 0; n < 2; ++n)
#pragma unroll
        for (int r = 0; r < 4; ++r) { const int row = 16 * mb + 4 * fq + r, col = 16 * (nb0 + n) + fr; float v = acc[n][r];
            if (MASK == 1 && col > row) v = 0.f; if (MASK == 2 && col >= row) v = 0.f; S[row * 72 + col] = (bf16)f2bf(v); }
}
template <int MASK> __device__ __forceinline__ void cst(const f32x4 (&acc)[2], LAS float* S, int mb, int nb0, int lane) {
    const int fr = lane & 15, fq = lane >> 4;
#pragma unroll
    for (int n = 0; n < 2; ++n)
#pragma unroll
        for (int r = 0; r < 4; ++r) { const int row = 16 * mb + 4 * fq + r, col = 16 * (nb0 + n) + fr; float v = acc[n][r];
            if (MASK == 1 && col > row) v = 0.f; if (MASK == 2 && col >= row) v = 0.f; S[row * 66 + col] = v; }
}
__device__ __forceinline__ void hfrag(const LAS bf16* M, const LAS float* colscale, unsigned char* dst, int wave, int lane, int slot = -2) {
    const int mb = wave >> 1, ks = wave & 1, i = lane & 15, q = lane >> 4; const LAS bf16* rowp = M + (16 * mb + i) * 72 + 32 * ks + 4 * q;
    const v2u lo = *(const LAS v2u*)rowp, hi = *(const LAS v2u*)(rowp + 16);
    v4u w; w.x = lo.x; w.y = lo.y; w.z = hi.x; w.w = hi.y;
    if (colscale) { float e[8]; unpack8(w, e); const f32x4 s0 = *(const LAS f32x4*)(colscale + 32 * ks + 4 * q), s1 = *(const LAS f32x4*)(colscale + 32 * ks + 16 + 4 * q);
        e[0] *= s0.x; e[1] *= s0.y; e[2] *= s0.z; e[3] *= s0.w; e[4] *= s1.x; e[5] *= s1.y; e[6] *= s1.z; e[7] *= s1.w; w = pack8(e); }
    if (slot == -2) slot = wave; if (slot >= 0) *(GAS v4u*)(dst + ((size_t)slot * 64 + lane) * 16) = w;
}
__device__ __forceinline__ void cfrag(const LAS float* M, unsigned char* dst, int wave, int lane, int slot) {
    const int mb = wave >> 1, ks = wave & 1, i = lane & 15, q = lane >> 4; float e[8];
#pragma unroll
    for (int jj = 0; jj < 8; ++jj) { const int rho = 32 * ks + (jj < 4 ? 4 * q + jj : 16 + 4 * q + jj - 4); e[jj] = M[(16 * mb + i) * 66 + rho]; }
    if (slot >= 0) *(GAS v4u*)(dst + ((size_t)slot * 64 + lane) * 16) = pack8(e);
}
__device__ __forceinline__ void cacc(const f32x4 (&acc)[2], const LAS float* rowscale, unsigned char* dst, int mb, int nb0, int lane, int vbs = 2048) {
    const int fq = lane >> 4;
#pragma unroll
    for (int n = 0; n < 2; ++n) { float v[4];
#pragma unroll
        for (int r = 0; r < 4; ++r) { v[r] = acc[n][r]; if (rowscale) v[r] *= rowscale[16 * mb + 4 * fq + r]; }
        v2u w; w.x = pk2(v[0], v[1]); w.y = pk2(v[2], v[3]); *(GAS v2u*)(dst + (size_t)(nb0 + n) * vbs + ((size_t)mb * 64 + lane) * 8) = w; }
}
__device__ __forceinline__ void ccumsum(Frame& F, LAS float* CU) {
    LAS float* vec = (LAS float*)F.lds + PV_OFF; LAS float* seg = vec + 128;
    { float run = 0.f;
#pragma unroll
      for (int i = 0; i < 8; ++i) { run += CU[(8 * F.wave + i) * 66 + F.lane]; CU[(8 * F.wave + i) * 66 + F.lane] = run; }
      seg[F.wave * 64 + F.lane] = run; }
    LDS_BARRIER();
    { float off = 0.f;
#pragma unroll
      for (int w = 0; w < 8; ++w) if (w < F.wave) off += seg[w * 64 + F.lane];
#pragma unroll
      for (int i = 0; i < 8; ++i) { const float c = CU[(8 * F.wave + i) * 66 + F.lane] + off; CU[(8 * F.wave + i) * 66 + F.lane] = c; if (8 * F.wave + i == 31) vec[F.lane] = c; if (8 * F.wave + i == 63) vec[64 + F.lane] = c; } }
    LDS_BARRIER();
}
__device__ __forceinline__ f32x4 blk16(f32x4 acc, const LAS float* A, int ar0, int ac0, const LAS float* B, int br0, int bc0, int lane) {
    const int fr = lane & 15, fq = lane >> 4;
#pragma unroll
    for (int s = 0; s < 4; ++s) acc = __builtin_amdgcn_mfma_f32_16x16x4f32(A[(ar0 + fr) * 66 + ac0 + 4 * s + fq], B[(br0 + 4 * s + fq) * 66 + bc0 + fr], acc, 0, 0, 0);
    return acc;
}
__device__ __forceinline__ void blkst(const f32x4 acc, LAS float* S, int r0, int c0, int lane) {
    const int fr = lane & 15, fq = lane >> 4;
#pragma unroll
    for (int r = 0; r < 4; ++r) S[(r0 + 4 * fq + r) * 66 + c0 + fr] = acc[r];
}
__device__ __forceinline__ void tri_inverse(Frame& F, const LAS float* L, LAS float* T, LAS float* W) {
    for (int e = F.tid; e < 64 * 64; e += NWAVES * 64) { const int i = e >> 6, j = e & 63; if ((i >> 4) != (j >> 4)) T[i * 66 + j] = 0.f; }
    if (F.wave == 0) {
        const int d0 = 16 * (F.lane >> 4), c = F.lane & 15; float t[16];
#pragma unroll
        for (int i = 0; i < 16; ++i) { float a = (i == c) ? 1.f : 0.f;
#pragma unroll
            for (int j = 0; j < i; ++j) a += L[(d0 + i) * 66 + d0 + j] * t[j];
            t[i] = a; T[(d0 + i) * 66 + d0 + c] = a; }
    }
    LDS_BARRIER();
#pragma unroll
    for (int d = 1; d <= 3; ++d) {
        if (F.wave < 4 - d) { const int i = d + F.wave, j = F.wave; f32x4 acc = (f32x4){0.f, 0.f, 0.f, 0.f};
#pragma unroll
            for (int k = 0; k < 3; ++k) if (k >= j && k < i) acc = blk16(acc, L, 16 * i, 16 * k, T, 16 * k, 16 * j, F.lane);
            blkst(acc, W, 16 * i, 16 * j, F.lane); }
        LDS_BARRIER();
        if (F.wave < 4 - d) { const int i = d + F.wave, j = F.wave; f32x4 acc = (f32x4){0.f, 0.f, 0.f, 0.f};
            acc = blk16(acc, T, 16 * i, 16 * i, W, 16 * i, 16 * j, F.lane); blkst(acc, T, 16 * i, 16 * j, F.lane); }
        LDS_BARRIER();
    }
}
struct PreRaw { v4u r0, r1, r2, r3, r4, r5, r6; int pos; };
__device__ __forceinline__ void pre_load(Frame& F, PreRaw& R, const int MIX, int b, int h, int c) {
    int tid_ = F.tid; asm volatile("" : "+v"(tid_));
    const int tt = tid_ >> 3, j8 = (tid_ & 7) * 8, t = b * SEQ + c * 64 + tt;
    const bf16* P = WSP(const bf16, WS_P);
    const v4u zz = (v4u){0u, 0u, 0u, 0u}; R.r0 = zz; R.r1 = zz; R.r2 = zz; R.r3 = zz; R.r4 = zz; R.r5 = zz; R.r6 = zz; R.pos = 0;
    if (MIX == 0) { R.r0 = *(const GAS v4u*)(P + (size_t)t * NP + HG_F + 64 * h + j8); R.r1 = *(const GAS v4u*)(P + (size_t)t * NP + HG_Q + 64 * h + j8); R.r4 = *(const GAS v4u*)(P + (size_t)t * NP + HG_I + 64 * h + j8); }
    else if (MIX == 1) { if (j8 < 32) { R.r0 = *(const GAS v4u*)(P + (size_t)t * NP + GL_Q + 32 * h + j8); R.r1 = *(const GAS v4u*)(P + (size_t)t * NP + GL_K + 32 * h + j8);
            R.r2 = *(const GAS v4u*)(P + (size_t)t * NP + GL_GLR); R.r3 = *(const GAS v4u*)(P + (size_t)t * NP + GL_GLR + 8); }
        R.r4 = *(const GAS v4u*)(P + (size_t)t * NP + GL_V + 64 * h + j8); }
    else if (MIX == 2) { const size_t o = (size_t)t * 256 + 64 * h + j8;
        R.r0 = *(const GAS v4u*)(WSP(const float, WS_RWW) + o); R.r1 = *(const GAS v4u*)(WSP(const float, WS_RWW) + o + 4);
        R.r2 = *(const GAS v4u*)(WSP(const bf16, WS_RWK) + o); R.r3 = *(const GAS v4u*)(WSP(const bf16, WS_RWR) + o); R.r4 = *(const GAS v4u*)(WSP(const bf16, WS_RWV) + o);
        R.r5 = *(const GAS v4u*)(WSP(const bf16, WS_RWKK) + o); R.r6 = *(const GAS v4u*)(WSP(const bf16, WS_RWB) + o); }
    else { const int i0 = j8 & 31;
        R.r0 = *(const GAS v4u*)(P + (size_t)t * NP + RT_Q + 64 * h + i0); R.r1 = *(const GAS v4u*)(P + (size_t)t * NP + RT_Q + 64 * h + 32 + i0);
        R.r2 = *(const GAS v4u*)(P + (size_t)t * NP + RT_K + 64 * h + i0); R.r3 = *(const GAS v4u*)(P + (size_t)t * NP + RT_K + 64 * h + 32 + i0);
        R.r4 = *(const GAS v4u*)(P + (size_t)t * NP + RT_V + 64 * h + j8); R.pos = ((const int*)ldptr(F.in, 1))[t]; }
}
__device__ __forceinline__ void chunk_pre(Frame& F, PreRaw& R, int l, const int MIX, int b, int h, int c, unsigned char* rec, const int nMIX, int nh) {
    const int t0 = b * SEQ + c * 64;
    LAS float* CU = PBUF(0); LAS float* LL = PBUF(1); LAS float* T32 = PBUF(2);
    LAS bf16* A1 = HBUF(0); LAS bf16* R1 = HBUF(1); LAS bf16* B1 = HBUF(2); LAS bf16* K1 = HBUF(3); LAS bf16* KeT = HBUF(4); LAS bf16* VT = HBUF(5); LAS bf16* BeT = HBUF(6); LAS bf16* M1 = HBUF(7); LAS bf16* M2 = HBUF(8); LAS bf16* M3 = HBUF(9);
    LAS float* vec = (LAS float*)F.lds + PV_OFF; LAS float* cmid = vec; LAS float* cend = vec + 64; LAS float* ecm = vec + 640;
    int tid_ = F.tid; asm volatile("" : "+v"(tid_));
    const int lane_ = tid_ & 63, wave_ = __builtin_amdgcn_readfirstlane(tid_ >> 6);
    const int tt = tid_ >> 3, j8 = (tid_ & 7) * 8, t = t0 + tt;
    const int mb = wave_ >> 1, nb0 = 2 * (wave_ & 1), fr = lane_ & 15, fq = lane_ >> 4;
    const bf16* P = WSP(const bf16, WS_P);
    float q[8], k[8], lw[8];
    if (MIX == 0) {
        float fr_[8], qr[8]; unpack8(R.r0, fr_); unpack8(R.r1, qr);
        const float* lg = INF(8); const int c0 = 64 * h + j8;
#pragma unroll
        for (int j = 0; j < 8; ++j) { const float x0 = lg[c0 + j], x1 = lg[256 + c0 + j], x2 = lg[512 + c0 + j], x3 = lg[768 + c0 + j]; const float mx = fmaxf(fmaxf(x0, x1), fmaxf(x2, x3));
            const float e0 = __expf(x0 - mx), e1 = __expf(x1 - mx), e2 = __expf(x2 - mx), e3 = __expf(x3 - mx); const float inv = 1.f / (e0 + e1 + e2 + e3);
            const float lb = ((l >= 1 ? e1 : 0.f) + (l >= 2 ? e2 : 0.f) + (l >= 3 ? e3 : 0.f)) * inv;
            const float w = lb + (1.f - lb) * sigm(fr_[j]); lw[j] = __logf(w); k[j] = 1.f - w; q[j] = qr[j] * sigm(qr[j]); }
    } else if (MIX == 1) {
        if (j8 < 32) {
            float qr[8], kr[8], g0[8], g1[8]; unpack8(R.r0, qr); unpack8(R.r1, kr); unpack8(R.r2, g0); unpack8(R.r3, g1);
            const float* w2 = INF(10) + l * 16 * 128 + 32 * h + j8; const float* gb = INF(11) + l * 128 + 32 * h + j8;
            float x[8];
#pragma unroll
            for (int j = 0; j < 8; ++j) x[j] = gb[j];
#pragma unroll
            for (int r = 0; r < 8; ++r) { const f32x4 wa = *(const GAS f32x4*)(w2 + r * 128), wb = *(const GAS f32x4*)(w2 + r * 128 + 4), wc = *(const GAS f32x4*)(w2 + (r + 8) * 128), wd = *(const GAS f32x4*)(w2 + (r + 8) * 128 + 4);
                x[0] += g0[r] * wa.x + g1[r] * wc.x; x[1] += g0[r] * wa.y + g1[r] * wc.y; x[2] += g0[r] * wa.z + g1[r] * wc.z; x[3] += g0[r] * wa.w + g1[r] * wc.w;
                x[4] += g0[r] * wb.x + g1[r] * wd.x; x[5] += g0[r] * wb.y + g1[r] * wd.y; x[6] += g0[r] * wb.z + g1[r] * wd.z; x[7] += g0[r] * wb.w + g1[r] * wd.w;
                if (r & 1) asm volatile("" ::: "memory"); }
#pragma unroll
            for (int j = 0; j < 8; ++j) { lw[j] = 0.0625f * (fminf(x[j], 0.f) - __logf(1.f + __expf(-fabsf(x[j])))); k[j] = kr[j]; q[j] = qr[j] * 0.17677669529663687f; }
        } else {
#pragma unroll
            for (int j = 0; j < 8; ++j) { lw[j] = 0.f; k[j] = 0.f; q[j] = 0.f; }
        }
    } else if (MIX == 2) {
        { const v4u a0 = R.r0, a1 = R.r1; lw[0] = __uint_as_float(a0.x); lw[1] = __uint_as_float(a0.y); lw[2] = __uint_as_float(a0.z); lw[3] = __uint_as_float(a0.w); lw[4] = __uint_as_float(a1.x); lw[5] = __uint_as_float(a1.y); lw[6] = __uint_as_float(a1.z); lw[7] = __uint_as_float(a1.w); }
        unpack8(R.r2, k); unpack8(R.r3, q);
    } else {
        const int i0 = j8 & 31; const bool hi = j8 >= 32;
        float q1[8], q2[8], k1[8], k2[8]; unpack8(R.r0, q1); unpack8(R.r1, q2); unpack8(R.r2, k1); unpack8(R.r3, k2);
        const double pos = (double)R.pos;
        const float lgam = __logf(1.f - exp2f(-5.f - (float)h));
#pragma unroll
        for (int j = 0; j < 8; ++j) { const double rev = pos * INVF2PI[i0 + j]; const float fr_ = (float)(rev - floor(rev)); const float s = __builtin_amdgcn_sinf(fr_), cs = __builtin_amdgcn_cosf(fr_);
            q[j] = hi ? (q1[j] * s + q2[j] * cs) : (q1[j] * cs - q2[j] * s); k[j] = 0.125f * (hi ? (k1[j] * s + k2[j] * cs) : (k1[j] * cs - k2[j] * s)); lw[j] = lgam; }
    }
    *(LAS f32x4*)(CU + tt * 66 + j8) = (f32x4){lw[0], lw[1], lw[2], lw[3]}; *(LAS f32x4*)(CU + tt * 66 + j8 + 4) = (f32x4){lw[4], lw[5], lw[6], lw[7]};
    LDS_BARRIER();
    ccumsum(F, CU);
    {   float cu[8], cm[8], ce[8], cp[8];
#pragma unroll
        for (int j = 0; j < 8; ++j) { cu[j] = CU[tt * 66 + j8 + j]; cm[j] = cmid[j8 + j]; ce[j] = cend[j8 + j]; cp[j] = tt > 0 ? CU[(tt - 1) * 66 + j8 + j] : 0.f; }
        float v[8]; unpack8(R.r4, v);
        float e1[8], e2[8];
        float e3[8];
#pragma unroll
        for (int j = 0; j < 8; ++j) { e1[j] = q[j] * __expf(cu[j] - cm[j]); e2[j] = k[j] * __expf(cm[j] - cu[j]); e3[j] = k[j] * __expf(ce[j] - cu[j]); }
        *(LAS v4u*)(R1 + tt * 72 + j8) = pack8(e1); *(LAS v4u*)(K1 + tt * 72 + j8) = pack8(e2); *(LAS v4u*)(KeT + tt * 72 + j8) = pack8(e3); *(LAS v4u*)(VT + tt * 72 + j8) = pack8(v);
        if (MIX == 2) { float a[8], bb[8]; unpack8(R.r5, a); unpack8(R.r6, bb);
#pragma unroll
            for (int j = 0; j < 8; ++j) { e1[j] = -a[j] * __expf(cp[j] - cm[j]); e2[j] = bb[j] * __expf(cm[j] - cu[j]); e3[j] = bb[j] * __expf(ce[j] - cu[j]); }
            *(LAS v4u*)(A1 + tt * 72 + j8) = pack8(e1); *(LAS v4u*)(B1 + tt * 72 + j8) = pack8(e2); *(LAS v4u*)(BeT + tt * 72 + j8) = pack8(e3); }
        if (tid_ < 64) { const float m_ = cmid[tid_], e_ = cend[tid_]; ecm[tid_] = __expf(m_);
            *(GAS float*)(rec + (MIX == 2 ? RO_GAM : GO_GAM) + 4 * tid_) = __expf(e_); }
    }
    LDS_BARRIER();
    if (nMIX >= 0) pre_load(F, R, nMIX, b, nh, c);
    bf16* Og = WSP(bf16, WS_O) + (size_t)MIX * TOK * 256 + (size_t)t0 * 256 + 64 * h;
    f32x4 acc[2];
    nt16(acc, R1, K1, mb, nb0, lane_); hst<1>(acc, M1, mb, nb0, lane_);
    hfrag(R1, ecm, rec + (MIX == 2 ? RO_QH : GO_QH), wave_, lane_);
    tn16(acc, KeT, VT, mb, nb0, lane_); if (MIX == 2) cacc(acc, nullptr, rec + RO_VB + 2048, mb, nb0, lane_, 4096); else cacc(acc, nullptr, rec + GO_SK, mb, nb0, lane_);
    if (MIX == 2) {
        nt16(acc, A1, B1, mb, nb0, lane_); cst<2>(acc, LL, mb, nb0, lane_);
        nt16(acc, R1, B1, mb, nb0, lane_); hst<1>(acc, M2, mb, nb0, lane_);
        nt16(acc, A1, K1, mb, nb0, lane_); hst<2>(acc, M3, mb, nb0, lane_);
        hfrag(A1, ecm, rec + RO_AT, wave_, lane_);
        hfrag_tr(BeT, rec + RO_BH, wave_, lane_);
    }
    LDS_BARRIER();
    nn16(acc, M1, VT, mb, nb0, lane_);
#pragma unroll
    for (int n = 0; n < 2; ++n)
#pragma unroll
        for (int r = 0; r < 4; ++r) Og[(size_t)(16 * mb + 4 * fq + r) * 256 + 16 * (nb0 + n) + fr] = (bf16)f2bf(acc[n][r]);
    if (MIX == 2) {
        nn16(acc, M3, VT, mb, nb0, lane_); cacc(acc, nullptr, rec + RO_VB, mb, nb0, lane_, 4096);
        const int t6 = ((wave_ & 1) == 1 && (wave_ >> 1) < 2) ? -1 : ((wave_ >> 1) < 2 ? (wave_ >> 1) : 2 + ((wave_ >> 1) - 2) * 2 + (wave_ & 1));
        hfrag(M2, nullptr, rec + RO_MRB, wave_, lane_, t6);
        tri_inverse(F, LL, T32, CU);
        cfrag(T32, rec + RO_TT, wave_, lane_, t6);
    }
    LDS_BARRIER();
}
constexpr size_t WS_REC_RW = 14 * MiB, WS_REC_GL = 412 * MiB;
__device__ __forceinline__ unsigned char* pre_rec(Frame& F, int m, int b, int h, int c) {
    return (m == 2) ? F.ws + WS_REC_RW + (size_t)(((b * 4 + h) * 64) + c) * REC_RW : F.ws + WS_REC_GL + (size_t)((((m == 3 ? 2 : m) * 16 + b * 4 + h) * 64) + c) * REC_GL;
}
__device__ __forceinline__ void phase_chunkpre(Frame& F, int l) {
    for (int tile = F.vcu; tile < TOK / 64; tile += F.G) {
        const int b = tile >> 6, c = tile & 63;
        rwprep_tile(F, l, tile);
        __syncthreads();
        PreRaw cur;
        pre_load(F, cur, 0, b, 0, c);
#pragma unroll 1
        for (int i = 0; i < 16; ++i) {
            const int mo = i >> 2, m = (mo == 2) ? 3 : (mo == 3 ? 2 : mo), h = i & 3;
            const int mo2 = (i + 1) >> 2, m2 = (i + 1 < 16) ? ((mo2 == 2) ? 3 : (mo2 == 3 ? 2 : mo2)) : -1;
            chunk_pre(F, cur, l, m, b, h, c, pre_rec(F, m, b, h, c), m2, (i + 1) & 3);
        }
    }
}
__device__ __forceinline__ bf16x8 pack_b(const f32x4 a, const f32x4 b) { v4u w; w.x = pk2(a.x, a.y); w.y = pk2(a.z, a.w); w.z = pk2(b.x, b.y); w.w = pk2(b.z, b.w); return __builtin_bit_cast(bf16x8, w); }
__device__ __forceinline__ f32x4 unpk4(const v2u w) { return (f32x4){bflo(w.x), bfhi(w.x), bflo(w.y), bfhi(w.y)}; }
template <int NF> struct SeqRegs { v4u r[NF]; v4u tail; };
template <int NF, int NLT, bool TAIL> __device__ __forceinline__ void seq_ld(SeqRegs<NF>& R, const unsigned char* rec, int lt) {
    const GAS v4u* src = (const GAS v4u*)rec;
#pragma unroll
    for (int i = 0; i < NF; ++i) R.r[i] = src[i * NLT + lt];
    if (TAIL && lt < 16) R.tail = src[NF * NLT + lt];
}
template <int NF, int NLT, bool TAIL> __device__ __forceinline__ void seq_st(const SeqRegs<NF>& R, LAS unsigned char* slot, int lt) {
    LAS v4u* dst = (LAS v4u*)slot;
#pragma unroll
    for (int i = 0; i < NF; ++i) dst[i * NLT + lt] = R.r[i];
    if (TAIL && lt < 16) dst[NF * NLT + lt] = R.tail;
}
template <bool RW> __device__ __forceinline__ void seq_unit(Frame& F, int mix, int b, int h, int vb_, const unsigned char* recs) {
    constexpr int REC = RW ? REC_RW : REC_GL, SLOT = 61440, NCW = RW ? 1 : 4, LW0 = RW ? 2 : 4, NLT = (8 - LW0) * 64, NF = REC / (NLT * 16); constexpr bool TAIL = (REC % (NLT * 16)) != 0;
    static_assert(REC % (NLT * 16) == 0 || REC % (NLT * 16) == 256, "record = NF loader rounds (+ 256 B)");
    const bool loader = F.wave >= LW0, compute = F.wave < NCW; const int lt = F.tid - 64 * LW0;
    SeqRegs<NF> RA, RB;
    if (loader) { seq_ld<NF, NLT, TAIL>(RA, recs, lt); seq_st<NF, NLT, TAIL>(RA, F.lds, lt); seq_ld<NF, NLT, TAIL>(RB, recs + (size_t)1 * REC, lt); seq_ld<NF, NLT, TAIL>(RA, recs + (size_t)2 * REC, lt); }
    __syncthreads();
    f32x4 S[4];
#pragma unroll
    for (int kb = 0; kb < 4; ++kb) S[kb] = (f32x4){0.f, 0.f, 0.f, 0.f};
    const int vb = RW ? vb_ : (F.wave & 3), fr = F.lane & 15, fq = F.lane >> 4;
    bf16* Oi = WSP(bf16, WS_Y) + (size_t)b * SEQ * D + 256 * mix + 64 * h + 16 * vb + fr;
#pragma unroll 1
    for (int c2 = 0; c2 < 64; c2 += 2) {
#pragma unroll
        for (int par = 0; par < 2; ++par) {
            const int c = c2 + par;
            if (loader) {
                if (par == 0) { seq_st<NF, NLT, TAIL>(RB, F.lds + SLOT, lt); if (c + 3 < 64) seq_ld<NF, NLT, TAIL>(RB, recs + (size_t)(c + 3) * REC, lt); }
                else { if (c + 1 < 64) seq_st<NF, NLT, TAIL>(RA, F.lds, lt); if (c + 3 < 64) seq_ld<NF, NLT, TAIL>(RA, recs + (size_t)(c + 3) * REC, lt); }
            } else if (compute) {
                const LAS unsigned char* R = F.lds + par * SLOT;
                const f32x4 z = (f32x4){0.f, 0.f, 0.f, 0.f};
                bf16x8 fqh[8];
#pragma unroll
                for (int f = 0; f < 8; ++f) fqh[f] = *(const LAS bf16x8*)(R + (RW ? RO_QH : GO_QH) + (f * 64 + F.lane) * 16);
                bf16x8 bS[2]; bS[0] = pack_b(S[0], S[1]); bS[1] = pack_b(S[2], S[3]);
                asm volatile("s_waitcnt lgkmcnt(0)" ::: "memory"); __builtin_amdgcn_sched_barrier(0);
                f32x4 O[4]; bf16x8 bU[2];
#pragma unroll
                for (int mb = 0; mb < 4; ++mb) { O[mb] = z;
#pragma unroll
                    for (int ks = 0; ks < 2; ++ks) O[mb] = __builtin_amdgcn_mfma_f32_16x16x32_bf16(fqh[mb * 2 + ks], bS[ks], O[mb], 0, 0, 0); }
                if (RW) {
                    f32x4 X[4], U[4];
#pragma unroll
                    for (int mb = 0; mb < 4; ++mb) { X[mb] = unpk4(*(const LAS v2u*)(R + RO_Y + ((vb * 4 + mb) * 64 + F.lane) * 8));
#pragma unroll
                        for (int ks = 0; ks < 2; ++ks) X[mb] = __builtin_amdgcn_mfma_f32_16x16x32_bf16(*(const LAS bf16x8*)(R + RO_AT + ((mb * 2 + ks) * 64 + F.lane) * 16), bS[ks], X[mb], 0, 0, 0); }
                    bf16x8 bX[2]; bX[0] = pack_b(X[0], X[1]); bX[1] = pack_b(X[2], X[3]);
#pragma unroll
                    for (int mb = 0; mb < 4; ++mb) { U[mb] = z;
#pragma unroll
                        for (int ks = 0; ks < 2; ++ks) if (!(ks == 1 && mb < 2)) U[mb] = __builtin_amdgcn_mfma_f32_16x16x32_bf16(*(const LAS bf16x8*)(R + RO_TT + ((mb * 2 + ks) * 64 + F.lane) * 16), bX[ks], U[mb], 0, 0, 0); }
                    bU[0] = pack_b(U[0], U[1]); bU[1] = pack_b(U[2], U[3]);
#pragma unroll
                    for (int mb = 0; mb < 4; ++mb)
#pragma unroll
                        for (int ks = 0; ks < 2; ++ks) if (!(ks == 1 && mb < 2)) O[mb] = __builtin_amdgcn_mfma_f32_16x16x32_bf16(*(const LAS bf16x8*)(R + RO_MRB + ((mb * 2 + ks) * 64 + F.lane) * 16), bU[ks], O[mb], 0, 0, 0);
                }
#pragma unroll
                for (int kb = 0; kb < 4; ++kb) { const f32x4 g = *(const LAS f32x4*)(R + (RW ? RO_GAM : GO_GAM) + (16 * kb + 4 * fq) * 4); const f32x4 sk = unpk4(*(const LAS v2u*)(R + (RW ? RO_SK : GO_SK) + ((vb * 4 + kb) * 64 + F.lane) * 8));
                    f32x4 n = S[kb] * g + sk;
                    if (RW) {
#pragma unroll
                        for (int ks = 0; ks < 2; ++ks) n = __builtin_amdgcn_mfma_f32_16x16x32_bf16(*(const LAS bf16x8*)(R + RO_BH + ((kb * 2 + ks) * 64 + F.lane) * 16), bU[ks], n, 0, 0, 0);
                    }
                    S[kb] = n; }
#pragma unroll
                for (int mb = 0; mb < 4; ++mb)
#pragma unroll
                    for (int r = 0; r < 4; ++r) Oi[(size_t)(c * 64 + 16 * mb + 4 * fq + r) * D] = (bf16)f2bf(O[mb][r]);
            }
            LDS_BARRIER();
        }
    }
    __syncthreads();
}
__device__ __forceinline__ int tri6(int mb, int ks) { return mb < 2 ? mb : 2 + (mb - 2) * 2 + ks; }
struct SeqRegs4 { v4u r[6]; v4u t; };
__device__ __forceinline__ void seq4_ld(SeqRegs4& R, const unsigned char* rec, int vb, int lt) {
    const GAS v4u* src = (const GAS v4u*)rec;
#pragma unroll
    for (int i = 0; i < 6; ++i) R.r[i] = src[i * 384 + lt];
    if (lt < 16) R.t = src[6 * 384 + lt];
    if (lt >= 128) R.t = *(const GAS v4u*)(rec + RO_VB + vb * 4096 + (lt - 128) * 16);
}
__device__ __forceinline__ void seq4_st(const SeqRegs4& R, LAS unsigned char* slot, int lt) {
    LAS v4u* dst = (LAS v4u*)slot;
#pragma unroll
    for (int i = 0; i < 6; ++i) dst[i * 384 + lt] = R.r[i];
    if (lt < 16) dst[6 * 384 + lt] = R.t;
    if (lt >= 128) *(LAS v4u*)(slot + 37120 + (lt - 128) * 16) = R.t;
}
__device__ __forceinline__ void seq_rw(Frame& F, int b, int h, int vb, const unsigned char* recs) {
    constexpr int REC = REC_RW, SLOT = 41216, EXO = 3 * SLOT;
    const bool loader = F.wave >= 2; const int lt = F.tid - 128;
    SeqRegs4 RA, RB, RC;
    if (loader) { seq4_ld(RA, recs, vb, lt); seq4_st(RA, F.lds, lt); seq4_ld(RB, recs + (size_t)1 * REC, vb, lt); seq4_ld(RC, recs + (size_t)2 * REC, vb, lt); seq4_ld(RA, recs + (size_t)3 * REC, vb, lt); }
    __syncthreads();
    f32x4 S[4];
#pragma unroll
    for (int kb = 0; kb < 4; ++kb) S[kb] = (f32x4){0.f, 0.f, 0.f, 0.f};
    const int fr = F.lane & 15, fq = F.lane >> 4;
    bf16* Oi = WSP(bf16, WS_Y) + (size_t)b * SEQ * D + 256 * 2 + 64 * h + 16 * vb + fr;
#pragma unroll 1
    for (int c2 = 0; c2 < 66; c2 += 3) {
#pragma unroll
        for (int j3 = 0; j3 < 3; ++j3) {
            const int c = c2 + j3; const int par = c & 1;
            if (loader) {
                LAS unsigned char* dst = F.lds + ((j3 + 1) % 3) * SLOT; const unsigned char* nrec = recs + (size_t)(c + 4) * REC;
                if (c + 1 < 64) { if (j3 == 0) seq4_st(RB, dst, lt); else if (j3 == 1) seq4_st(RC, dst, lt); else seq4_st(RA, dst, lt); }
                if (c + 4 < 64) { if (j3 == 0) seq4_ld(RB, nrec, vb, lt); else if (j3 == 1) seq4_ld(RC, nrec, vb, lt); else seq4_ld(RA, nrec, vb, lt); }
            } else if (F.wave == 0) {
                if (c < 64) {
                    const LAS unsigned char* R = F.lds + (c % 3) * SLOT; LAS unsigned char* EX = F.lds + EXO + par * 4096;
                    const f32x4 z = (f32x4){0.f, 0.f, 0.f, 0.f};
                    v2u yv[4]; bf16x8 fat[8], ftt[6];
#pragma unroll
                    for (int mb = 0; mb < 4; ++mb) yv[mb] = *(const LAS v2u*)(R + 37120 + (mb * 64 + F.lane) * 8);
#pragma unroll
                    for (int f = 0; f < 8; ++f) fat[f] = *(const LAS bf16x8*)(R + RO_AT + (f * 64 + F.lane) * 16);
                    bf16x8 bS[2]; bS[0] = pack_b(S[0], S[1]); bS[1] = pack_b(S[2], S[3]);
                    *(LAS bf16x8*)(EX + F.lane * 16) = bS[0]; *(LAS bf16x8*)(EX + 1024 + F.lane * 16) = bS[1];
                    asm volatile("s_waitcnt lgkmcnt(0)" ::: "memory"); __builtin_amdgcn_sched_barrier(0);
                    f32x4 X[4], U[4];
#pragma unroll
                    for (int mb = 0; mb < 4; ++mb) { X[mb] = unpk4(yv[mb]);
#pragma unroll
                        for (int ks = 0; ks < 2; ++ks) X[mb] = __builtin_amdgcn_mfma_f32_16x16x32_bf16(fat[mb * 2 + ks], bS[ks], X[mb], 0, 0, 0); }
                    __builtin_amdgcn_sched_barrier(0);
                    bf16x8 fbh[8]; f32x4 gm[4]; v2u skv[4];
#pragma unroll
                    for (int f = 0; f < 6; ++f) ftt[f] = *(const LAS bf16x8*)(R + RO_TT + (f * 64 + F.lane) * 16);
#pragma unroll
                    for (int f = 0; f < 8; ++f) fbh[f] = *(const LAS bf16x8*)(R + RO_BH + (f * 64 + F.lane) * 16);
#pragma unroll
                    for (int kb = 0; kb < 4; ++kb) { gm[kb] = *(const LAS f32x4*)(R + RO_GAM + (16 * kb + 4 * fq) * 4); skv[kb] = *(const LAS v2u*)(R + 37120 + 2048 + (kb * 64 + F.lane) * 8); }
                    __builtin_amdgcn_sched_barrier(0);
                    bf16x8 bX[2]; bX[0] = pack_b(X[0], X[1]); bX[1] = pack_b(X[2], X[3]);
#pragma unroll
                    for (int mb = 0; mb < 4; ++mb) { U[mb] = z;
#pragma unroll
                        for (int ks = 0; ks < 2; ++ks) if (!(ks == 1 && mb < 2)) U[mb] = __builtin_amdgcn_mfma_f32_16x16x32_bf16(ftt[tri6(mb, ks)], bX[ks], U[mb], 0, 0, 0); }
                    bf16x8 bU[2]; bU[0] = pack_b(U[0], U[1]); bU[1] = pack_b(U[2], U[3]);
                    *(LAS bf16x8*)(EX + 2048 + F.lane * 16) = bU[0]; *(LAS bf16x8*)(EX + 3072 + F.lane * 16) = bU[1];
                    asm volatile("s_waitcnt lgkmcnt(0)" ::: "memory"); __builtin_amdgcn_sched_barrier(0);
#pragma unroll
                    for (int kb = 0; kb < 4; ++kb) { f32x4 n = S[kb] * gm[kb] + unpk4(skv[kb]);
#pragma unroll
                        for (int ks = 0; ks < 2; ++ks) n = __builtin_amdgcn_mfma_f32_16x16x32_bf16(fbh[kb * 2 + ks], bU[ks], n, 0, 0, 0);
                        S[kb] = n; }
                }
            } else {
                if (c >= 1 && c <= 64) {
                    const int co = c - 1; const LAS unsigned char* R = F.lds + (co % 3) * SLOT; const LAS unsigned char* EX = F.lds + EXO + (par ^ 1) * 4096;
                    bf16x8 fq_[8], fm[6];
#pragma unroll
                    for (int f = 0; f < 8; ++f) fq_[f] = *(const LAS bf16x8*)(R + RO_QH + (f * 64 + F.lane) * 16);
#pragma unroll
                    for (int f = 0; f < 6; ++f) fm[f] = *(const LAS bf16x8*)(R + RO_MRB + (f * 64 + F.lane) * 16);
                    const bf16x8 bS0 = *(const LAS bf16x8*)(EX + F.lane * 16), bS1 = *(const LAS bf16x8*)(EX + 1024 + F.lane * 16), bU0 = *(const LAS bf16x8*)(EX + 2048 + F.lane * 16), bU1 = *(const LAS bf16x8*)(EX + 3072 + F.lane * 16);
                    asm volatile("s_waitcnt lgkmcnt(0)" ::: "memory"); __builtin_amdgcn_sched_barrier(0);
                    f32x4 O[4];
#pragma unroll
                    for (int mb = 0; mb < 4; ++mb) { O[mb] = (f32x4){0.f, 0.f, 0.f, 0.f};
                        O[mb] = __builtin_amdgcn_mfma_f32_16x16x32_bf16(fq_[mb * 2], bS0, O[mb], 0, 0, 0);
                        O[mb] = __builtin_amdgcn_mfma_f32_16x16x32_bf16(fq_[mb * 2 + 1], bS1, O[mb], 0, 0, 0);
                        O[mb] = __builtin_amdgcn_mfma_f32_16x16x32_bf16(fm[tri6(mb, 0)], bU0, O[mb], 0, 0, 0);
                        if (mb >= 2) O[mb] = __builtin_amdgcn_mfma_f32_16x16x32_bf16(fm[tri6(mb, 1)], bU1, O[mb], 0, 0, 0); }
#pragma unroll
                    for (int mb = 0; mb < 4; ++mb)
#pragma unroll
                        for (int r = 0; r < 4; ++r) Oi[(size_t)(co * 64 + 16 * mb + 4 * fq + r) * D] = (bf16)f2bf(O[mb][r]);
                }
            }
            LDS_BARRIER();
        }
    }
    __syncthreads();
}
__device__ __forceinline__ void phase_seq(Frame& F, int l) {
    for (int u = blockIdx.x; u < 112; u += F.G) {
        if (u < 64) { const int bh = u >> 2, vb = u & 3; seq_rw(F, bh >> 2, bh & 3, vb, F.ws + WS_REC_RW + (size_t)(bh * 64) * REC_RW); }
        else { const int v = u - 64, mm = v % 3, bh = v / 3; seq_unit<false>(F, mm == 2 ? 3 : mm, bh >> 2, bh & 3, 0, F.ws + WS_REC_GL + (size_t)((mm * 16 + bh) * 64) * REC_GL); }
    }
}
struct PostRaw { v4u o0, o1; v4u y0, y1; v4u x0, x1, x2, x3, x4, x5, x6, x7; };
__device__ __forceinline__ void post_load(Frame& F, PostRaw& R, int t, int m, int c0) {
    const bf16* P = WSP(const bf16, WS_P); const bf16* Y = WSP(const bf16, WS_Y);
    const bf16* Ob = WSP(const bf16, WS_O) + (size_t)m * TOK * 256 + (size_t)t * 256 + c0;
    R.o0 = *(const GAS v4u*)(Ob); R.o1 = *(const GAS v4u*)(Ob + 8);
    R.y0 = *(const GAS v4u*)(Y + (size_t)t * D + 256 * m + c0); R.y1 = *(const GAS v4u*)(Y + (size_t)t * D + 256 * m + c0 + 8);
    const v4u zz = (v4u){0u, 0u, 0u, 0u}; R.x2 = zz; R.x3 = zz; R.x4 = zz; R.x5 = zz; R.x6 = zz; R.x7 = zz;
    if (m != 2) { const int gc = (m == 0 ? HG_G : m == 1 ? GL_R : RT_G) + c0; R.x0 = *(const GAS v4u*)(P + (size_t)t * NP + gc); R.x1 = *(const GAS v4u*)(P + (size_t)t * NP + gc + 8); }
    else { const size_t ob = (size_t)t * 256 + c0;
        R.x0 = *(const GAS v4u*)(WSP(const bf16, WS_RWR) + ob); R.x1 = *(const GAS v4u*)(WSP(const bf16, WS_RWR) + ob + 8); R.x2 = *(const GAS v4u*)(WSP(const bf16, WS_RWK) + ob); R.x3 = *(const GAS v4u*)(WSP(const bf16, WS_RWK) + ob + 8);
        R.x4 = *(const GAS v4u*)(WSP(const bf16, WS_RWV) + ob); R.x5 = *(const GAS v4u*)(WSP(const bf16, WS_RWV) + ob + 8); R.x6 = *(const GAS v4u*)(WSP(const bf16, WS_RWG) + ob); R.x7 = *(const GAS v4u*)(WSP(const bf16, WS_RWG) + ob + 8); }
}
__device__ __forceinline__ void unpack16(const v4u a, const v4u b, float (&f)[16]) { float x[8], y[8]; unpack8(a, x); unpack8(b, y);
#pragma unroll
    for (int j = 0; j < 8; ++j) { f[j] = x[j]; f[8 + j] = y[j]; } }
__device__ __forceinline__ void phase_post(Frame& F, int l) {
    const int gw = F.vcu * NWAVES + F.wave, NGW = F.G * NWAVES;
    const int m = F.lane >> 4, h = (F.lane >> 2) & 3, qd = F.lane & 3; const int c0 = 64 * h + 16 * qd;
    bf16* Y = WSP(bf16, WS_Y);
    PostRaw cur, nxt;
    if (gw < TOK) post_load(F, cur, gw, m, c0);
    for (int t = gw; t < TOK; t += NGW) {
        if (t + NGW < TOK) post_load(F, nxt, t + NGW, m, c0);
        float o[16], oi[16];
        unpack16(cur.o0, cur.o1, o);
        unpack16(cur.y0, cur.y1, oi);
        float s1 = 0.f, s2 = 0.f;
#pragma unroll
        for (int j = 0; j < 16; ++j) { o[j] += oi[j]; s1 += o[j]; s2 += o[j] * o[j]; }
        s1 = sum4(s1); s2 = sum4(s2);
        float y[16];
        if (m < 2) {
            const float rs = rsqrtf(s2 * (1.f / 64.f) + 1e-6f); const float* ng = INF(m == 0 ? 9 : 12) + l * 64 + 16 * qd;
            float g[16]; unpack16(cur.x0, cur.x1, g);
#pragma unroll
            for (int j = 0; j < 16; ++j) y[j] = o[j] * rs * ng[j] * (g[j] * sigm(g[j]));
        } else if (m == 2) {
            const float mean = s1 * (1.f / 64.f); float var = s2 * (1.f / 64.f) - mean * mean; var = fmaxf(var, 0.f); const float rs = rsqrtf(var + 64e-5f);
            float r[16], k[16], v[16], g[16]; unpack16(cur.x0, cur.x1, r); unpack16(cur.x2, cur.x3, k); unpack16(cur.x4, cur.x5, v); unpack16(cur.x6, cur.x7, g);
            const float* rk = INF(21) + l * 256 + c0; const float* lg = INF(22) + l * 256 + c0; const float* lb = INF(23) + l * 256 + c0;
            float bon = 0.f;
#pragma unroll
            for (int j = 0; j < 16; ++j) bon += r[j] * k[j] * rk[j];
            bon = sum4(bon);
#pragma unroll
            for (int j = 0; j < 16; ++j) y[j] = ((o[j] - mean) * rs * lg[j] + lb[j] + bon * v[j]) * g[j];
        } else {
            const float mean = s1 * (1.f / 64.f); float var = s2 * (1.f / 64.f) - mean * mean; var = fmaxf(var, 0.f); const float rs = rsqrtf(var + 1e-5f);
            float g[16]; unpack16(cur.x0, cur.x1, g);
#pragma unroll
            for (int j = 0; j < 16; ++j) y[j] = (g[j] * sigm(g[j])) * ((o[j] - mean) * rs);
        }
        v4u w0, w1; w0.x = pk2(y[0], y[1]); w0.y = pk2(y[2], y[3]); w0.z = pk2(y[4], y[5]); w0.w = pk2(y[6], y[7]); w1.x = pk2(y[8], y[9]); w1.y = pk2(y[10], y[11]); w1.z = pk2(y[12], y[13]); w1.w = pk2(y[14], y[15]);
        GAS v4u* yo = (GAS v4u*)(Y + (size_t)t * D + 256 * m + c0); yo[0] = w0; yo[1] = w1;
        cur = nxt;
    }
}
template <int MODE> struct LnRaw { f32x4 h[4]; v2u d1[4], d2[4]; float g1, g2; };
template <int MODE> __device__ __forceinline__ void ln_load(Frame& F, LnRaw<MODE>& R, int m) {
    const GAS f32x4* hr = (const GAS f32x4*)(F.h + (size_t)m * D) + F.lane;
#pragma unroll
    for (int j = 0; j < 4; ++j) R.h[j] = hr[64 * j];
    if (MODE == 0) { const GAS v2u* ar = (const GAS v2u*)(WSP(const bf16, WS_MIX) + (size_t)m * D) + F.lane;
#pragma unroll
        for (int j = 0; j < 4; ++j) R.d1[j] = ar[64 * j]; }
    else { const bf16* DOUT = WSP(const bf16, WS_DOUT); const float* GATE = WSP(const float, WS_GATE); R.g1 = GATE[2 * m]; R.g2 = GATE[2 * m + 1];
#pragma unroll
        for (int j = 0; j < 4; ++j) { R.d1[j] = ((const GAS v2u*)(DOUT + (size_t)(2 * m) * D))[F.lane + 64 * j]; R.d2[j] = ((const GAS v2u*)(DOUT + (size_t)(2 * m + 1) * D))[F.lane + 64 * j]; } }
}
template <int MODE, bool ROUTE> __device__ __forceinline__ void phase_ln(Frame& F, const float* gw_, const float* bw_, const float* router, int mi) {
    const int gw = F.vcu * NWAVES + F.wave, NGW = F.G * NWAVES;
    bf16* hb = WSP(bf16, WS_HB); float* GATE = WSP(float, WS_GATE);
    LAS float* RT = (LAS float*)F.lds;
    if (ROUTE) { for (int i = F.tid; i < D * NE; i += NWAVES * 64) RT[(i & 7) * D + (i >> 3)] = router[i]; __syncthreads(); }
    f32x4 gv[4], bv[4];
#pragma unroll
    for (int j = 0; j < 4; ++j) { gv[j] = ((const GAS f32x4*)gw_)[F.lane + 64 * j]; bv[j] = ((const GAS f32x4*)bw_)[F.lane + 64 * j]; }
    LnRaw<MODE> cur, nxt;
    if (gw < TOK) ln_load<MODE>(F, cur, gw);
    for (int m = gw; m < TOK; m += NGW) {
        if (m + NGW < TOK) ln_load<MODE>(F, nxt, m + NGW);
        GAS f32x4* hr = (GAS f32x4*)(F.h + (size_t)m * D) + F.lane;
        f32x4 v[4]; float s = 0.f;
#pragma unroll
        for (int j = 0; j < 4; ++j) {
            f32x4 a;
            if (MODE == 0) { const v2u d1 = cur.d1[j]; a = (f32x4){bflo(d1.x), bfhi(d1.x), bflo(d1.y), bfhi(d1.y)}; }
            else { const v2u d1 = cur.d1[j], d2 = cur.d2[j]; const float g1 = cur.g1, g2 = cur.g2;
                a.x = g1 * bflo(d1.x) + g2 * bflo(d2.x); a.y = g1 * bfhi(d1.x) + g2 * bfhi(d2.x); a.z = g1 * bflo(d1.y) + g2 * bflo(d2.y); a.w = g1 * bfhi(d1.y) + g2 * bfhi(d2.y); }
            v[j] = cur.h[j] * DN_ALPHA + a; s += (v[j].x + v[j].y) + (v[j].z + v[j].w); }
        const float mean = wave_sum(s) * (1.f / D); float s2 = 0.f;
#pragma unroll
        for (int j = 0; j < 4; ++j) { v[j] = v[j] - mean; s2 += (v[j].x * v[j].x + v[j].y * v[j].y) + (v[j].z * v[j].z + v[j].w * v[j].w); }
        const float rstd = 1.f / sqrtf(wave_sum(s2) * (1.f / D) + 1e-5f);
        GAS v2u* o8 = (GAS v2u*)(hb + (size_t)m * D) + F.lane;
#pragma unroll
        for (int j = 0; j < 4; ++j) { v[j] = v[j] * rstd * gv[j] + bv[j]; hr[64 * j] = v[j]; v2u w; w.x = pk2(v[j].x, v[j].y); w.y = pk2(v[j].z, v[j].w); o8[64 * j] = w; }
        if (ROUTE) {
            float lg[8];
#pragma unroll
            for (int e = 0; e < 8; ++e) { float a = 0.f;
#pragma unroll
                for (int j = 0; j < 4; ++j) { const f32x4 r = *(const LAS f32x4*)(RT + e * D + 4 * (F.lane + 64 * j)); a += (v[j].x * r.x + v[j].y * r.y) + (v[j].z * r.z + v[j].w * r.w); }
                lg[e] = wave_sum(a); }
            int e1 = 0; float l1 = lg[0];
#pragma unroll
            for (int e = 1; e < 8; ++e) if (lg[e] > l1) { l1 = lg[e]; e1 = e; }
            int e2 = -1; float l2 = -3.0e38f;
#pragma unroll
            for (int e = 0; e < 8; ++e) if (e != e1 && lg[e] > l2) { l2 = lg[e]; e2 = e; }
            if (F.lane == 0) {
                const float p2 = __expf(l2 - l1); const float ga = 1.f / (1.f + p2);
                GATE[2 * m] = ga; GATE[2 * m + 1] = p2 * ga;
                int* list = WSP(int, WS_LIST) + (size_t)mi * NE * TOK;
                const unsigned p1 = __hip_atomic_fetch_add((unsigned*)(F.ctl + CW_CNT + (mi * 8 + e1) * 64), 1u, RLX_AGENT); list[e1 * TOK + p1] = 2 * m;
                const unsigned q2 = __hip_atomic_fetch_add((unsigned*)(F.ctl + CW_CNT + (mi * 8 + e2) * 64), 1u, RLX_AGENT); list[e2 * TOK + q2] = 2 * m + 1;
            }
        }
        cur = nxt;
    }
}
__device__ __forceinline__ void phase_gather(Frame& F, int mi) {
    int cnt[8], poff[9]; poff[0] = 0;
#pragma unroll
    for (int e = 0; e < 8; ++e) { cnt[e] = (int)__hip_atomic_load((unsigned*)(F.ctl + CW_CNT + (mi * 8 + e) * 64), RLX_AGENT); poff[e + 1] = poff[e] + ((cnt[e] + 255) >> 8); }
    const int npan = poff[8];
    int* tab = WSP(int, WS_TAB) + mi * TAB_STRIDE;
    if (blockIdx.x == 0) {
        for (int P = F.tid; P < npan; P += NWAVES * 64) { int e = 0, pe = 0, ce = cnt[0];
#pragma unroll
            for (int j = 1; j < 8; ++j) if (P >= poff[j]) { e = j; pe = poff[j]; ce = cnt[j]; }
            tab[4 * P] = e; tab[4 * P + 1] = 256 * (P - pe); tab[4 * P + 2] = ce; tab[4 * P + 3] = 0; }
        if (F.tid == 0) tab[640] = npan;
    }
    const int gw = F.vcu * NWAVES + F.wave, NGW = F.G * NWAVES;
    const int* list = WSP(const int, WS_LIST) + (size_t)mi * NE * TOK; const bf16* hb = WSP(const bf16, WS_HB); bf16* HP = WSP(bf16, WS_HPERM);
    for (int row = gw; row < 256 * npan; row += NGW) { const int P = row >> 8; int e = 0, pe = 0, ce = cnt[0];
#pragma unroll
        for (int j = 1; j < 8; ++j) if (P >= poff[j]) { e = j; pe = poff[j]; ce = cnt[j]; }
        const int r = row - 256 * pe; const int tok = (r < ce) ? (list[e * TOK + r] >> 1) : 0;
        const GAS v4u* s = (const GAS v4u*)(hb + (size_t)tok * D) + F.lane; GAS v4u* d = (GAS v4u*)(HP + (size_t)row * D) + F.lane; d[0] = s[0]; d[64] = s[64]; }
}
struct Args { const void* in[34]; float* out; unsigned char* ws; int ph_lo, ph_hi; };
__global__ void __launch_bounds__(NWAVES * 64, 2) mk_fwd(Args args) {
    extern __shared__ __attribute__((aligned(16))) unsigned char lds[];
    Frame F;
    F.lds = (LAS unsigned char*)lds;
    F.MISC = (volatile LAS unsigned*)(F.lds + MISC_OFF);
    F.tid = threadIdx.x; F.lane = F.tid & 63; F.wave = __builtin_amdgcn_readfirstlane(F.tid >> 6);
    F.G = gridDim.x; { const int bx = blockIdx.x; F.vcu = (F.G % 8 == 0) ? (bx % 8) * (F.G / 8) + bx / 8 : bx; }
    F.ws = args.ws; F.in = args.in; F.h = args.out;
    F.ctl = (gu32*)(args.ws + WS_CTL);
    for (int u = F.tid; u < (LDS_BYTES - LDSCTL_OFF) / 4; u += NWAVES * 64) ((LAS unsigned*)(F.lds + LDSCTL_OFF))[u] = 0u;
    __syncthreads();
    XcdBarrier bar; bar.bar = (unsigned*)(F.ctl + CW_BAR); bar.x = 0; bar.st = nullptr;
    if (!MK_PER_PHASE) bar = xcd_barrier_post((unsigned*)(F.ctl + CW_BAR), F.MISC + 8);
    const int lo = args.ph_lo, hi = args.ph_hi;
#define IN(k) (lo <= (k) && (k) < hi)
#define PHASE_BEGIN() do { int t_ = threadIdx.x; asm volatile("" : "+v"(t_)); F.tid = t_; F.lane = t_ & 63; F.wave = __builtin_amdgcn_readfirstlane(t_ >> 6); } while (0)
#define SEAM(k) do { if (IN(k) && IN((k) + 1)) { xcd_barrier(bar); if (DUPMASK & 4096) xcd_barrier(bar); } } while (0)
    for (int l = 0; l < DEPTH; ++l) {
        const int pb = l * NPH; const bool moe = (l & 1); const int mi = l >> 1;
#define PH(k) (((PHMASK >> (k)) & 1) && IN(pb + (k)))
        if (l == 0) { if (PH(0)) { PHASE_BEGIN(); phase_weights<0>(F, 0); } SEAM(pb + 0); }
        if (PH(1)) for (int rep_ = 0; rep_ < (((DUPMASK >> 1) & 1) ? 2 : 1); ++rep_) { PHASE_BEGIN(); if (rep_) __syncthreads();
            pg8::Gemm g{WSP(const bf16, WS_HB), WSP(const bf16, WS_WIN), TOK, NP, D}; pg8::StaticOrder S; S.init(TOK, NP, F.G, (int)blockIdx.x);
            pg8::EpiBf16 E{WSP(bf16, WS_P), NP};
            pg8::gemm_phase<pg8::EpiBf16, pg8::StaticOrder, true, true>(F.lds, g, S, E);
        } SEAM(pb + 1);
        if (PH(3)) { PHASE_BEGIN(); phase_chunkpre(F, l); if (DUPMASK & 8) { __syncthreads(); phase_chunkpre(F, l); } } SEAM(pb + 3);
        if (PH(4)) { PHASE_BEGIN(); phase_seq(F, l); if (DUPMASK & 16) { __syncthreads(); phase_seq(F, l); } } SEAM(pb + 4);
        if (PH(5)) { PHASE_BEGIN(); phase_post(F, l); __syncthreads(); phase_weights<1>(F, l); if (DUPMASK & 32) { __syncthreads(); phase_weights<1>(F, l); } } SEAM(pb + 5);
        if (PH(6)) for (int rep_ = 0; rep_ < (((DUPMASK >> 6) & 1) ? 2 : 1); ++rep_) { PHASE_BEGIN(); if (rep_) __syncthreads();
            pg8::Gemm g{WSP(const bf16, WS_Y), WSP(const bf16, WS_WOUT), TOK, D, D}; pg8::StaticOrder S; S.init(TOK, D, F.G, (int)blockIdx.x);
            pg8::EpiBf16 E{WSP(bf16, WS_MIX), D};
            pg8::gemm_phase<pg8::EpiBf16, pg8::StaticOrder, false, true>(F.lds, g, S, E);
        } SEAM(pb + 6);
        if (PH(7)) { PHASE_BEGIN();
            if (moe) phase_ln<0, true>(F, INF(4) + l * D, INF(5) + l * D, INF(30) + (size_t)mi * D * NE, mi);
            else phase_ln<0, false>(F, INF(4) + l * D, INF(5) + l * D, nullptr, 0);
        } SEAM(pb + 7);
        if (moe) { if (PH(8)) { PHASE_BEGIN(); phase_gather(F, mi); } SEAM(pb + 8); }
        if (PH(9)) for (int rep_ = 0; rep_ < (((DUPMASK >> 9) & 1) ? 2 : 1); ++rep_) { PHASE_BEGIN(); if (rep_) __syncthreads();
            if (!moe) { pg8::Gemm g{WSP(const bf16, WS_HB), WSP(const bf16, WS_WUP), TOK, 2 * FFD, D}; pg8::StaticOrder S; S.init(TOK, 2 * FFD, F.G, (int)blockIdx.x);
                pg8::EpiSwiGLU E{WSP(bf16, WS_HID), FFD, 22};
                pg8::gemm_phase<pg8::EpiSwiGLU, pg8::StaticOrder, true, true>(F.lds, g, S, E);
            } else { const int* tab = WSP(const int, WS_TAB) + mi * TAB_STRIDE; const int npan = tab[640];
                pg8::Gemm g{WSP(const bf16, WS_HPERM), WSP(const bf16, WS_WUP), 256 * npan, 2 * FFE, D}; pg8::MoeOrder S{tab, 11, F.G, (int)blockIdx.x, npan * 11};
                pg8::EpiSwiGLU E{WSP(bf16, WS_HID), FFE, 11};
                pg8::gemm_phase<pg8::EpiSwiGLU, pg8::MoeOrder, true, true>(F.lds, g, S, E);
            }
        } SEAM(pb + 9);
        if (PH(10)) for (int rep_ = 0; rep_ < (((DUPMASK >> 10) & 1) ? 2 : 1); ++rep_) { PHASE_BEGIN(); if (rep_) __syncthreads();
            if (!moe) { pg8::Gemm g{WSP(const bf16, WS_HID), WSP(const bf16, WS_WDN), TOK, D, FFD}; pg8::StaticOrder S; S.init(TOK, D, F.G, (int)blockIdx.x);
                pg8::EpiBf16 E{WSP(bf16, WS_MIX), D};
                pg8::gemm_phase<pg8::EpiBf16, pg8::StaticOrder, false, true>(F.lds, g, S, E);
            } else { const int* tab = WSP(const int, WS_TAB) + mi * TAB_STRIDE; const int npan = tab[640];
                pg8::Gemm g{WSP(const bf16, WS_HID), WSP(const bf16, WS_WDN), 256 * npan, D, FFE}; pg8::MoeOrder S{tab, 4, F.G, (int)blockIdx.x, npan * 4};
                pg8::EpiScatter E{WSP(bf16, WS_DOUT), tab, WSP(const int, WS_LIST) + (size_t)mi * NE * TOK};
                pg8::gemm_phase<pg8::EpiScatter, pg8::MoeOrder, true, true>(F.lds, g, S, E);
            }
        } SEAM(pb + 10);
        if (PH(11)) { PHASE_BEGIN();
            if (moe) phase_ln<1, false>(F, INF(6) + l * D, INF(7) + l * D, nullptr, 0);
            else phase_ln<0, false>(F, INF(6) + l * D, INF(7) + l * D, nullptr, 0);
            if (l + 1 < DEPTH) { __syncthreads(); phase_weights<0>(F, l + 1); }
        } SEAM(pb + 11);
#undef PH
    }
#undef IN
#undef SEAM
}

extern "C" void kernel_launch(void* const* d_in, const int* in_sizes, int n_in, void* d_out, int out_size, void* d_ws, size_t ws_size, hipStream_t stream) {
    static int grid = 0;
    if (grid == 0) {
        if (n_in != 34 || out_size != TOK * D || ws_size < WS_END) { fprintf(stderr, "kernel_launch: unexpected shapes (n_in %d, out %d, ws %zu)\n", n_in, out_size, ws_size); grid = -1; return; }
        int dev = 0, cus = 0, per_cu = 0;
        if (hipGetDevice(&dev) != hipSuccess || hipDeviceGetAttribute(&cus, hipDeviceAttributeMultiprocessorCount, dev) != hipSuccess) { grid = -1; return; }
        if (hipFuncSetAttribute((const void*)mk_fwd, hipFuncAttributeMaxDynamicSharedMemorySize, LDS_BYTES) != hipSuccess) { fprintf(stderr, "kernel_launch: hipFuncSetAttribute failed\n"); grid = -1; return; }
        if (hipOccupancyMaxActiveBlocksPerMultiprocessor(&per_cu, (const void*)mk_fwd, NWAVES * 64, LDS_BYTES) != hipSuccess || per_cu < 1) fprintf(stderr, "kernel_launch: occupancy query reports %d\n", per_cu);
        (void)hipGetLastError();
        grid = cus;
    }
    if (grid < 0) return;
    if (hipMemsetAsync((char*)d_ws + WS_CTL, 0, CTL_ZERO_BYTES, stream) != hipSuccess) return;
    Args a{};
    for (int i = 0; i < 34; ++i) a.in[i] = d_in[i];
    a.out = (float*)d_out; a.ws = (unsigned char*)d_ws;
#if MK_PER_PHASE
    for (int p = 0; p < NPHASES; ++p) { a.ph_lo = p; a.ph_hi = p + 1; hipLaunchKernelGGL(mk_fwd, dim3(grid), dim3(NWAVES * 64), LDS_BYTES, stream, a); }
#else
    a.ph_lo = 0; a.ph_hi = NPHASES; hipLaunchKernelGGL(mk_fwd, dim3(grid), dim3(NWAVES * 64), LDS_BYTES, stream, a);
#endif
}
```

```cpp
#include <hip/hip_runtime.h>
#include <cstdio>
#include <cstdint>
#ifndef PHMASK
#define PHMASK 0xfff
#endif
#ifndef DUPMASK
#define DUPMASK 0
#endif
#ifndef MK_PER_PHASE
#define MK_PER_PHASE 0
#endif
namespace pg8 {
#define PG8_LAS __attribute__((address_space(3)))
typedef unsigned short bf16_t;
typedef short bf16x8 __attribute__((ext_vector_type(8)));
typedef float f32x4 __attribute__((ext_vector_type(4)));
typedef unsigned u32x4 __attribute__((ext_vector_type(4)));
constexpr int BM = 256, BK = 64, HALF = 128, HTB = HALF * BK * 2  , STAGE_BYTES = 8 * HTB, NXCD = 8, WGM = 8;

__host__ __device__ __forceinline__ int lds_byte(int r, int c) { const int st = (r >> 4) * 2 + (c >> 5), rr = r & 15, cc = c & 31, ob = rr * 64 + cc * 2; return st * 1024 + (ob ^ (((ob >> 9) & 1) << 5)); }
__host__ __device__ __forceinline__ void stage_rc(int b, int& R, int& C) { const int st = b / 1024, sb = b % 1024, swz = sb ^ (((sb >> 9) & 1) << 5); R = (st >> 1) * 16 + swz / 64; C = (st & 1) * 32 + (swz % 64) / 2; }
__host__ __device__ __forceinline__ int perm32(int rho) { const int n = rho >> 4, i = rho & 15; return 8 * (i >> 2) + 4 * n + (i & 3); }

struct Unit { int pm, pn; };
struct Gemm { const bf16_t* A; const bf16_t* Bt; int M, N, K; };

struct StaticOrder {
    static constexpr bool GATHER = false;
    int nM, nN, nwg, G, c;
    __device__ __forceinline__ unsigned a_off(const Unit&, int) const { return 0u; }
    __host__ __device__ void init(int M, int N, int G_, int c_) { nM = M / BM; nN = N / BM; nwg = nM * nN; G = G_; c = c_; }
    __host__ __device__ bool next(int i, Unit& u) const {
        const long L = (long)i * G + c; if (L >= nwg) return false;
        int wgid = (int)L; { const int q = nwg / NXCD, r = nwg % NXCD, xcd = wgid % NXCD, off = wgid / NXCD; wgid = (xcd < r ? xcd * (q + 1) : r * (q + 1) + (xcd - r) * q) + off; }
        const int nig = WGM * nN, gid = wgid / nig, fm = gid * WGM, gsz = (nM - fm) < WGM ? (nM - fm) : WGM;
        u.pm = fm + ((wgid % nig) % gsz); u.pn = (wgid % nig) / gsz; return true;
    }
    __device__ __forceinline__ void a_ready(const Unit&) const {}
    __device__ __forceinline__ void done(const Unit&) const {}
};
__device__ __forceinline__ unsigned cvt_pk_bf16(float lo, float hi) { unsigned r; asm volatile("v_cvt_pk_bf16_f32 %0, %1, %2" : "=v"(r) : "v"(lo), "v"(hi)); return r; }
typedef float f32x2 __attribute__((ext_vector_type(2)));
struct EpiBf16 {
    static constexpr bool PERM = true, AFTER_DRAIN = false;
    bf16_t* O; int ldc;
    __device__ __forceinline__ void operator()(const f32x4 (&acc)[2][2][4][2], const Unit& u, int wr, int wc, int fr, int fq) const {
        const int row0 = u.pm * BM + wr * 64 + fr; const int col0 = u.pn * BM + wc * 32 + 8 * fq;
#pragma unroll
        for (int ai = 0; ai < 2; ++ai)
#pragma unroll
            for (int m = 0; m < 4; ++m) { bf16_t* rowp = O + (size_t)(row0 + ai * HALF + m * 16) * ldc + col0;
#pragma unroll
                for (int bj = 0; bj < 2; ++bj) { const f32x4 v0 = acc[ai][bj][m][0], v1 = acc[ai][bj][m][1];
                    u32x4 w; w.x = cvt_pk_bf16(v0[0], v0[1]); w.y = cvt_pk_bf16(v0[2], v0[3]); w.z = cvt_pk_bf16(v1[0], v1[1]); w.w = cvt_pk_bf16(v1[2], v1[3]);
                    *(u32x4*)(rowp + bj * HALF) = w; } }
    }
};
struct EpiF32 {
    static constexpr bool PERM = false, AFTER_DRAIN = false;
    float* C; int ldc;
    __device__ __forceinline__ void operator()(const f32x4 (&acc)[2][2][4][2], const Unit& u, int wr, int wc, int fr, int fq) const {
        const int row0 = u.pm * BM + wr * 64 + fr, col0 = u.pn * BM + wc * 32 + 4 * fq;
#pragma unroll
        for (int ai = 0; ai < 2; ++ai)
#pragma unroll
            for (int m = 0; m < 4; ++m) { float* rowp = C + (size_t)(row0 + ai * HALF + m * 16) * ldc + col0;
#pragma unroll
                for (int bj = 0; bj < 2; ++bj)
#pragma unroll
                    for (int n = 0; n < 2; ++n) *(f32x4*)(rowp + bj * HALF + n * 16) = acc[ai][bj][m][n]; }
    }
};
__device__ __forceinline__ float silu_f(float x) { return x * __builtin_amdgcn_rcpf(1.0f + __expf(-x)); }
struct EpiSwiGLU {
    static constexpr bool PERM = true, AFTER_DRAIN = false;
    bf16_t* O; int ldc; int tiles_per_group;
    __device__ __forceinline__ void operator()(const f32x4 (&acc)[2][2][4][2], const Unit& u, int wr, int wc, int fr, int fq) const {
        const int row0 = u.pm * BM + wr * 64 + fr; const int pnl = u.pn % tiles_per_group; const int col0 = pnl * HALF + wc * 32 + 8 * fq;
#pragma unroll
        for (int ai = 0; ai < 2; ++ai)
#pragma unroll
            for (int m = 0; m < 4; ++m) { bf16_t* rowp = O + (size_t)(row0 + ai * HALF + m * 16) * ldc + col0;
                float h[8];
#pragma unroll
                for (int n = 0; n < 2; ++n)
#pragma unroll
                    for (int j = 0; j < 4; ++j) h[4 * n + j] = silu_f(acc[ai][0][m][n][j]) * acc[ai][1][m][n][j];
                u32x4 w; w.x = cvt_pk_bf16(h[0], h[1]); w.y = cvt_pk_bf16(h[2], h[3]); w.z = cvt_pk_bf16(h[4], h[5]); w.w = cvt_pk_bf16(h[6], h[7]);
                *(u32x4*)rowp = w; }
    }
};
struct MoeMap {
    int cnt[8], poff[9]; const int* list;
    __device__ __forceinline__ void init(const unsigned* counters, const int* list_) { list = list_; poff[0] = 0;
#pragma unroll
        for (int e = 0; e < 8; ++e) { cnt[e] = (int)__hip_atomic_load(counters + e * 64, __ATOMIC_RELAXED, __HIP_MEMORY_SCOPE_AGENT); poff[e + 1] = poff[e] + ((cnt[e] + 255) >> 8); } }
    __device__ __forceinline__ void locate(int P, int& e, int& lr, int& ce) const { e = 0; int pe = 0; ce = cnt[0];
#pragma unroll
        for (int j = 1; j < 8; ++j) if (P >= poff[j]) { e = j; pe = poff[j]; ce = cnt[j]; }
        lr = 256 * (P - pe); }
};
struct EpiScatter {
    static constexpr bool PERM = true, AFTER_DRAIN = false;
    bf16_t* O; MoeMap M;
    __device__ __forceinline__ void operator()(const f32x4 (&acc)[2][2][4][2], const Unit& u, int wr, int wc, int fr, int fq) const {
        int e, lr, cnt; M.locate(u.pm, e, lr, cnt);
        const int pnl = u.pn & 3; const int col0 = pnl * BM + wc * 32 + 8 * fq; const int* lst = M.list + e * 16384;
#pragma unroll
        for (int ai = 0; ai < 2; ++ai)
#pragma unroll
            for (int m = 0; m < 4; ++m) { const int r = lr + wr * 64 + fr + ai * HALF + m * 16;
                if (r < cnt) { const int slot = lst[r]; bf16_t* rowp = O + (size_t)slot * 1024 + col0;
#pragma unroll
                    for (int bj = 0; bj < 2; ++bj) { const f32x4 v0 = acc[ai][bj][m][0], v1 = acc[ai][bj][m][1];
                        u32x4 w; w.x = cvt_pk_bf16(v0[0], v0[1]); w.y = cvt_pk_bf16(v0[2], v0[3]); w.z = cvt_pk_bf16(v1[0], v1[1]); w.w = cvt_pk_bf16(v1[2], v1[3]);
                        *(u32x4*)(rowp + bj * HALF) = w; } } }
    }
};
template <bool GATHER_> struct MoeOrder {
    static constexpr bool GATHER = GATHER_;
    MoeMap M; int tpg, G, c, nunits; unsigned rowbytes;
    __device__ __forceinline__ bool next(int i, Unit& u) const {
        const int L = i * G + c; if (L >= nunits) return false;
        int wgid = L; { const int q = nunits / NXCD, r = nunits % NXCD, xcd = wgid % NXCD, off = wgid / NXCD; wgid = (xcd < r ? xcd * (q + 1) : r * (q + 1) + (xcd - r) * q) + off; }
        const int P = wgid / tpg, pnl = wgid - P * tpg; int e, lr, ce; M.locate(P, e, lr, ce);
        u.pm = P; u.pn = e * tpg + pnl; return true;
    }
    __device__ __forceinline__ unsigned a_off(const Unit& u, int row) const {
        int e, lr, ce; M.locate(u.pm, e, lr, ce); const int r = lr + row; const int tok = (r < ce) ? (M.list[e * 16384 + r] >> 1) : 0; return (unsigned)tok * rowbytes; }
    __device__ __forceinline__ void a_ready(const Unit&) const {}
    __device__ __forceinline__ void done(const Unit&) const {}
};
template <class Epi, class Sched, bool ALIGN_EPI = false, bool SP2 = false>
__device__ __forceinline__ void gemm_phase(PG8_LAS unsigned char* lds, const Gemm g, const Sched& S, const Epi& E) {
    int tid_ = threadIdx.x; asm volatile("" : "+v"(tid_));
    const int tid = tid_, wid = __builtin_amdgcn_readfirstlane(tid >> 6), lane = tid & 63, wr = wid >> 2, wc = wid & 3, fr = lane & 15, fq = lane >> 4;
    const int K = g.K, nt = K / BK;
    unsigned voffA[2], voffB[2];
#pragma unroll
    for (int i = 0; i < 2; ++i) { int R, C; stage_rc(tid * 16 + i * 8192, R, C); const int Rb = Epi::PERM ? ((R & ~31) + perm32(R & 31)) : R;
        voffA[i] = (unsigned)(R * K + C) * 2u; voffB[i] = (unsigned)(Rb * K + C) * 2u; }
    static_assert(!Sched::GATHER || SP2, "A-row gather is implemented for the SP2 loop");
    unsigned aoc[2][2], aon[2][2];
#define PG8_GOFF(dst, u) do { _Pragma("unroll") for (int _i = 0; _i < 2; ++_i) { int R_, C_; stage_rc(tid * 16 + _i * 8192, R_, C_); _Pragma("unroll") for (int _h = 0; _h < 2; ++_h) dst[_h][_i] = S.a_off(u, _h * HALF + R_) + (unsigned)(C_ * 2); } } while (0)
#define PG8_STAGE_A(bufoff, gbase, kofs, h, nx) do { if constexpr (Sched::GATHER) { const unsigned vo_[2] = {(nx) ? aon[h][0] : aoc[h][0], (nx) ? aon[h][1] : aoc[h][1]}; PG8_STAGE(bufoff, (const char*)g.A + (kofs), vo_); } else { PG8_STAGE(bufoff, gbase, voffA); } } while (0)
    const size_t kstep = (size_t)(BK * 2);
    const size_t hstep = (size_t)HALF * K * 2;
    const size_t tstep = 2 * hstep;
    const unsigned ldsw = (unsigned)wid * 1024u;
    const int aoff = lds_byte(wr * 64 + fr, fq * 8), boff = lds_byte(wc * 32 + fr, fq * 8);
#define PG8_SA(b, h) (((b) * 2 + (h)) * HTB)
#define PG8_SB(b, h) ((4 + (b) * 2 + (h)) * HTB)
#define PG8_STAGE(bufoff, gbase, voff) do { _Pragma("unroll") for (int _i = 0; _i < 2; ++_i) \
        __builtin_amdgcn_global_load_lds((const unsigned*)((const char*)(gbase) + (voff)[_i]), (PG8_LAS unsigned*)(lds + (bufoff) + ldsw + _i * 8192), 16, 0, 0); } while (0)
#define PG8_LDA(dst, b, h) do { _Pragma("unroll") for (int m = 0; m < 4; ++m) _Pragma("unroll") for (int k = 0; k < 2; ++k) dst[m][k] = *(const PG8_LAS bf16x8*)(lds + PG8_SA(b, h) + aoff + m * 2048 + k * 1024); } while (0)
#define PG8_LDB(dst, b, h) do { _Pragma("unroll") for (int n = 0; n < 2; ++n) _Pragma("unroll") for (int k = 0; k < 2; ++k) dst[n][k] = *(const PG8_LAS bf16x8*)(lds + PG8_SB(b, h) + boff + n * 2048 + k * 1024); } while (0)
#define PG8_MMA(ai, bj, At, Bt) do { __builtin_amdgcn_s_setprio(1); _Pragma("unroll") for (int m = 0; m < 4; ++m) _Pragma("unroll") for (int n = 0; n < 2; ++n) _Pragma("unroll") for (int k = 0; k < 2; ++k) \
        acc[ai][bj][m][n] = __builtin_amdgcn_mfma_f32_16x16x32_bf16(Bt[n][k], At[m][k], acc[ai][bj][m][n], 0, 0, 0); __builtin_amdgcn_s_setprio(0); } while (0)
#define PG8_WAIT_V(n) asm volatile("s_waitcnt vmcnt(" #n ")" ::: "memory")
#define PG8_WAIT_L(n) asm volatile("s_waitcnt lgkmcnt(" #n ")" ::: "memory")
#define PG8_BAR __builtin_amdgcn_s_barrier()
#define PG8_SCHED __builtin_amdgcn_sched_barrier(0)
    Unit cur, nxt; int ui = 0;
    if (!S.next(0, cur)) return;
    f32x4 acc[2][2][4][2];
#pragma unroll
    for (int a = 0; a < 2; ++a)
#pragma unroll
        for (int b = 0; b < 2; ++b)
#pragma unroll
            for (int m = 0; m < 4; ++m)
#pragma unroll
                for (int n = 0; n < 2; ++n) acc[a][b][m][n] = (f32x4){0.f, 0.f, 0.f, 0.f};
    bf16x8 At[4][2], B0[2][2], B1[2][2];
    const char* cA = (const char*)g.A + (size_t)cur.pm * tstep; const char* cB = (const char*)g.Bt + (size_t)cur.pn * tstep;
    S.a_ready(cur);
    if constexpr (SP2) {
        if constexpr (Sched::GATHER) { PG8_GOFF(aoc, cur); }
        PG8_STAGE(PG8_SB(0, 0), cB, voffB); PG8_STAGE(PG8_SB(0, 1), cB + hstep, voffB); PG8_STAGE_A(PG8_SA(0, 0), cA, (size_t)0, 0, false); PG8_STAGE_A(PG8_SA(0, 1), cA + hstep, (size_t)0, 1, false);
        if (wr == 1) PG8_BAR;
        PG8_WAIT_V(2); PG8_BAR;
        PG8_STAGE(PG8_SB(1, 0), cB + kstep, voffB); PG8_STAGE_A(PG8_SA(1, 0), cA + kstep, kstep, 0, false); PG8_STAGE(PG8_SB(1, 1), cB + hstep + kstep, voffB);
        PG8_WAIT_V(6); PG8_BAR;
    } else {
        PG8_STAGE(PG8_SB(0, 0), cB, voffB); PG8_STAGE(PG8_SA(0, 0), cA, voffA); PG8_STAGE(PG8_SB(0, 1), cB + hstep, voffB); PG8_STAGE(PG8_SA(0, 1), cA + hstep, voffA);
        if (wr == 1) PG8_BAR;
        PG8_WAIT_V(4); PG8_BAR;
        PG8_STAGE(PG8_SB(1, 0), cB + kstep, voffB); PG8_STAGE(PG8_SA(1, 0), cA + kstep, voffA); PG8_STAGE(PG8_SB(1, 1), cB + hstep + kstep, voffB);
        PG8_WAIT_V(6); PG8_BAR;
    }
    for (;;) {
        const bool has_next = S.next(ui + 1, nxt);
        const char* nA = has_next ? (const char*)g.A + (size_t)nxt.pm * tstep : cA; const char* nB = has_next ? (const char*)g.Bt + (size_t)nxt.pn * tstep : cB;
        for (int t = 0; t < nt; t += 2) {
            const bool last = (t == nt - 2);
            const char* a1 = cA + (size_t)(t + 1) * kstep;
            const char* a2 = last ? nA : cA + (size_t)(t + 2) * kstep; const char* b2 = last ? nB : cB + (size_t)(t + 2) * kstep;
            const char* a3 = a2 + kstep; const char* b3 = b2 + kstep;
            if (last && has_next) S.a_ready(nxt);
            const size_t ko2 = last ? (size_t)0 : (size_t)(t + 2) * kstep;
            if constexpr (Sched::GATHER) { if (last) { if (has_next) { PG8_GOFF(aon, nxt); } else { _Pragma("unroll") for (int _h = 0; _h < 2; ++_h) { aon[_h][0] = aoc[_h][0]; aon[_h][1] = aoc[_h][1]; } } } }
            if constexpr (SP2) {
            PG8_LDB(B0, 0, 0); PG8_LDB(B1, 0, 1); PG8_SCHED; PG8_LDA(At, 0, 0); PG8_STAGE_A(PG8_SA(1, 1), a1 + hstep, (size_t)(t + 1) * kstep, 1, false);
            PG8_WAIT_V(8); PG8_WAIT_L(0); PG8_BAR; PG8_MMA(0, 0, At, B0); PG8_MMA(0, 1, At, B1); PG8_BAR; PG8_SCHED;
            PG8_LDA(At, 0, 1); PG8_STAGE(PG8_SB(0, 0), b2, voffB); PG8_STAGE(PG8_SB(0, 1), b2 + hstep, voffB); PG8_STAGE_A(PG8_SA(0, 0), a2, ko2, 0, last);
            PG8_WAIT_V(8); PG8_WAIT_L(0); PG8_BAR; PG8_MMA(1, 0, At, B0); PG8_MMA(1, 1, At, B1); PG8_BAR; PG8_SCHED;
            PG8_LDB(B0, 1, 0); PG8_LDB(B1, 1, 1); PG8_SCHED; PG8_LDA(At, 1, 0); PG8_STAGE_A(PG8_SA(0, 1), a2 + hstep, ko2, 1, last);
            PG8_WAIT_V(8); PG8_WAIT_L(0); PG8_BAR; PG8_MMA(0, 0, At, B0); PG8_MMA(0, 1, At, B1); PG8_BAR; PG8_SCHED;
            PG8_LDA(At, 1, 1); PG8_STAGE(PG8_SB(1, 0), b3, voffB); PG8_STAGE(PG8_SB(1, 1), b3 + hstep, voffB); PG8_STAGE_A(PG8_SA(1, 0), a3, ko2 + kstep, 0, last);
            PG8_WAIT_V(8); PG8_WAIT_L(0); PG8_BAR; PG8_MMA(1, 0, At, B0); PG8_MMA(1, 1, At, B1); PG8_BAR; PG8_SCHED;
            } else {
            PG8_LDB(B0, 0, 0); PG8_SCHED; PG8_LDA(At, 0, 0); PG8_STAGE(PG8_SA(1, 1), a1 + hstep, voffA);
            PG8_WAIT_L(8); PG8_BAR; PG8_WAIT_L(0); PG8_MMA(0, 0, At, B0); PG8_BAR; PG8_SCHED;
            PG8_LDB(B1, 0, 1); PG8_STAGE(PG8_SB(0, 0), b2, voffB);
            PG8_BAR; PG8_WAIT_L(0); PG8_MMA(0, 1, At, B1); PG8_BAR;
            PG8_LDA(At, 0, 1); PG8_STAGE(PG8_SA(0, 0), a2, voffA);
            PG8_BAR; PG8_WAIT_L(0); PG8_MMA(1, 0, At, B0); PG8_BAR; PG8_SCHED;
            PG8_STAGE(PG8_SB(0, 1), b2 + hstep, voffB);
            PG8_WAIT_V(6); PG8_BAR; PG8_MMA(1, 1, At, B1); PG8_BAR;
            PG8_LDB(B0, 1, 0); PG8_SCHED; PG8_LDA(At, 1, 0); PG8_STAGE(PG8_SA(0, 1), a2 + hstep, voffA);
            PG8_WAIT_L(8); PG8_BAR; PG8_WAIT_L(0); PG8_MMA(0, 0, At, B0); PG8_BAR; PG8_SCHED;
            PG8_LDB(B1, 1, 1); PG8_STAGE(PG8_SB(1, 0), b3, voffB);
            PG8_BAR; PG8_WAIT_L(0); PG8_MMA(0, 1, At, B1); PG8_BAR;
            PG8_LDA(At, 1, 1); PG8_STAGE(PG8_SA(1, 0), a3, voffA);
            PG8_BAR; PG8_WAIT_L(0); PG8_MMA(1, 0, At, B0); PG8_BAR; PG8_SCHED;
            PG8_STAGE(PG8_SB(1, 1), b3 + hstep, voffB);
            PG8_WAIT_V(6); PG8_BAR; PG8_MMA(1, 1, At, B1); PG8_BAR;
            }
        }
        if constexpr (ALIGN_EPI) { if (wr == 0) PG8_BAR; }
        if constexpr (!Epi::AFTER_DRAIN) { E(acc, cur, wr, wc, fr, fq); S.done(cur); }
        if (!has_next) break;
#pragma unroll
        for (int a = 0; a < 2; ++a)
#pragma unroll
            for (int b = 0; b < 2; ++b)
#pragma unroll
                for (int m = 0; m < 4; ++m)
#pragma unroll
                    for (int n = 0; n < 2; ++n) acc[a][b][m][n] = (f32x4){0.f, 0.f, 0.f, 0.f};
        cur = nxt; cA = nA; cB = nB; ++ui;
        if constexpr (Sched::GATHER) { _Pragma("unroll") for (int _h = 0; _h < 2; ++_h) { aoc[_h][0] = aon[_h][0]; aoc[_h][1] = aon[_h][1]; } }
        if constexpr (ALIGN_EPI) { if (wr == 1) PG8_BAR; }
    }
    PG8_WAIT_V(0);
    if constexpr (!ALIGN_EPI) { if (wr == 0) PG8_BAR; }
    PG8_BAR;
    if constexpr (Epi::AFTER_DRAIN) { E.fused(acc, cur, wr, wc, fr, fq, lds, wid, lane); S.done(cur); }
#undef PG8_SA
#undef PG8_SB
#undef PG8_STAGE
#undef PG8_STAGE_A
#undef PG8_GOFF
#undef PG8_LDA
#undef PG8_LDB
#undef PG8_MMA
#undef PG8_WAIT_V
#undef PG8_WAIT_L
#undef PG8_BAR
#undef PG8_SCHED
}
}
constexpr int NWAVES = 8;
constexpr int TOK = 16384, SEQ = 4096, D = 1024, NP = 4096, INC = 3888, DEPTH = 4;
constexpr int HG_Q = 0, HG_F = 256, HG_I = 512, HG_G = 768;
constexpr int GL_Q = 1024, GL_K = 1152, GL_V = 1280, GL_GLR = 1536, GL_R = 1552;
constexpr int RW_BASE = 1808, RW_R = 1808, RW_K = 2064, RW_V = 2320, RW_WLR = 2576, RW_ALR = 2640, RW_GLR = 2704;
constexpr int RT_Q = 2864, RT_K = 3120, RT_V = 3376, RT_G = 3632;
constexpr int GL_GX = 3904;
constexpr int FFD = 2816, FFE = 1408, NE = 8;
constexpr float DN_ALPHA = 1.6817928305074290f;
constexpr int NPH = 12;
constexpr int NPHASES = NPH * DEPTH;
constexpr size_t MiB = 1u << 20;
constexpr size_t WS_CTL = 0, CTL_ZERO_BYTES = 1 * MiB;
constexpr size_t WS_LIST = 1 * MiB;
constexpr size_t WS_GATE = 2 * MiB;
constexpr size_t WS_TAB = 3 * MiB;
constexpr size_t WS_WIN = 4 * MiB, WS_WOUT = 12 * MiB, WS_WUP = 14 * MiB, WS_WDN = 58 * MiB;
constexpr size_t WS_HB = 80 * MiB;
constexpr size_t WS_MIX = 112 * MiB;
constexpr size_t WS_O = WS_MIX;
constexpr size_t WS_OI = 144 * MiB;
constexpr size_t OI_GEN = 64 * 4096 * 16;
constexpr size_t WS_VF = 176 * MiB;
constexpr size_t WS_P = 184 * MiB;
constexpr size_t WS_RWW = 312 * MiB;
constexpr size_t WS_RWR = 328 * MiB, WS_RWK = 336 * MiB, WS_RWV = 344 * MiB, WS_RWKK = 352 * MiB, WS_RWB = 360 * MiB, WS_RWG = 368 * MiB;
constexpr size_t WS_Y = 376 * MiB;
constexpr size_t WS_CS = 461 * MiB;
constexpr size_t WS_HID = 184 * MiB;
constexpr size_t WS_DOUT = 280 * MiB;
constexpr size_t WS_HPERM = 344 * MiB;
constexpr size_t WS_END = 465 * MiB;
constexpr int CW_BAR = 4096;
constexpr int CW_CNT = 16384;
constexpr int TAB_STRIDE = 4 * 160 + 16;
constexpr size_t WS_LORA = 2 * MiB + 512 * 1024;
constexpr int LO_W2 = 0, LO_A2 = 256 * 64, LO_G2 = 2 * 256 * 64, LO_V1 = LO_G2 + 256 * 160, LO_V2 = LO_V1 + 32 * 256, LO_END = LO_V2 + 256 * 32;
constexpr int RING_BYTES = 131072, LDSCTL_OFF = 146432, MISC_OFF = LDSCTL_OFF + 320, LDS_BYTES = 147456;
#define GAS __attribute__((address_space(1)))
#define LAS __attribute__((address_space(3)))
typedef unsigned short bf16;
typedef unsigned v4u __attribute__((ext_vector_type(4)));
typedef unsigned v2u __attribute__((ext_vector_type(2)));
typedef float f32x4 __attribute__((ext_vector_type(4)));
typedef short bf16x8 __attribute__((ext_vector_type(8)));
typedef GAS unsigned gu32;
#define RLX_AGENT __ATOMIC_RELAXED, __HIP_MEMORY_SCOPE_AGENT
#define LDS_WAIT() asm volatile("s_waitcnt lgkmcnt(0)" ::: "memory")
#define VM_WAIT() asm volatile("s_waitcnt vmcnt(0)" ::: "memory")
#define LDS_BARRIER() do { asm volatile("s_waitcnt lgkmcnt(0)" ::: "memory"); __builtin_amdgcn_s_barrier(); asm volatile("" ::: "memory"); } while (0)
typedef float f32x2_t __attribute__((ext_vector_type(2))); typedef __bf16 bf16x2_t __attribute__((ext_vector_type(2)));
__device__ __forceinline__ unsigned pk2(float lo, float hi) { f32x2_t v = {lo, hi}; bf16x2_t b = __builtin_convertvector(v, bf16x2_t); return __builtin_bit_cast(unsigned, b); }
__device__ __forceinline__ unsigned f2bf(float f) { return pk2(f, f) & 0xffffu; }
__device__ __forceinline__ float bflo(unsigned w) { return __builtin_bit_cast(float, w << 16); }
__device__ __forceinline__ float bfhi(unsigned w) { return __builtin_bit_cast(float, w & 0xffff0000u); }
__device__ __forceinline__ float bf1(bf16 b) { return __builtin_bit_cast(float, ((unsigned)b) << 16); }
__device__ __forceinline__ void unpack8(const v4u w, float (&f)[8]) { f[0] = bflo(w.x); f[1] = bfhi(w.x); f[2] = bflo(w.y); f[3] = bfhi(w.y); f[4] = bflo(w.z); f[5] = bfhi(w.z); f[6] = bflo(w.w); f[7] = bfhi(w.w); }
__device__ __forceinline__ v4u pack8(const float (&f)[8]) { v4u w; w.x = pk2(f[0], f[1]); w.y = pk2(f[2], f[3]); w.z = pk2(f[4], f[5]); w.w = pk2(f[6], f[7]); return w; }
__device__ __forceinline__ float sigm(float x) { return __builtin_amdgcn_rcpf(1.0f + __expf(-x)); }
template <int CTRL> __device__ __forceinline__ float dpp(float x) { return __builtin_bit_cast(float, __builtin_amdgcn_mov_dpp(__builtin_bit_cast(int, x), CTRL, 0xf, 0xf, true)); }
__device__ __forceinline__ float sum16(float x) { x += dpp<0xB1>(x); x += dpp<0x4E>(x); x += dpp<0x141>(x); x += dpp<0x128>(x); return x; }
__device__ __forceinline__ float sum4(float x) { x += dpp<0xB1>(x); x += dpp<0x4E>(x); return x; }
__device__ __forceinline__ float wave_sum(float x) {
    x = sum16(x);
    auto s = __builtin_amdgcn_permlane16_swap(__float_as_uint(x), __float_as_uint(x), false, false); x = __uint_as_float(s[0]) + __uint_as_float(s[1]);
    auto t = __builtin_amdgcn_permlane32_swap(__float_as_uint(x), __float_as_uint(x), false, false); return __uint_as_float(t[0]) + __uint_as_float(t[1]);
}
__device__ const double INVF2PI[32] = {0.15915494309189535, 0.11934937021124886, 0.08949940160889101, 0.06711508300522726, 0.050329212104487035, 0.03774158471741977, 0.0283021958306234, 0.02122365276477766, 0.015915494309189534, 0.011934937021124886, 0.008949940160889102, 0.006711508300522725, 0.005032921210448704, 0.003774158471741977, 0.00283021958306234, 0.0021223652764777662, 0.0015915494309189536, 0.0011934937021124885, 0.0008949940160889102, 0.0006711508300522726, 0.0005032921210448703, 0.00037741584717419774, 0.00028302195830623395, 0.0002122365276477766, 0.00015915494309189535, 0.00011934937021124886, 8.949940160889102e-05, 6.711508300522725e-05, 5.0329212104487035e-05, 3.774158471741978e-05, 2.8302195830623396e-05, 2.122365276477766e-05};
#define XB_TMO      128
#define XB_XCNT(j)  (256  + 64 * (j))
#define XB_XSUB(j)  (1280 + 64 * (j))
#define XB_XGEN(j)  (2304 + 64 * (j))
#define XB_TOP      3328
#define XB_TOPGEN   3392
#define XCD_BAR_WORDS 3456
#define XB_SPIN_CAP (1u << 18)

__device__ __forceinline__ unsigned xb_ld(unsigned* p)              { return __hip_atomic_load(p, __ATOMIC_RELAXED, __HIP_MEMORY_SCOPE_AGENT); }
__device__ __forceinline__ unsigned xb_add(unsigned* p, unsigned v) { return __hip_atomic_fetch_add(p, v, __ATOMIC_RELAXED, __HIP_MEMORY_SCOPE_AGENT); }
__device__ __forceinline__ unsigned xb_xcc_id() { return (unsigned)__builtin_amdgcn_s_getreg((3 << 11) | 20) & 0xFu; }
#define XB_SPIN(cond, bar) do { unsigned _sp = 0; while (cond) { __builtin_amdgcn_s_sleep(1); \
    if ((++_sp & 255u) == 0u) { if (xb_ld(&(bar)[XB_TMO])) break; if (_sp > XB_SPIN_CAP) { atomicAdd(&(bar)[XB_TMO], 1u); break; } } } } while (0)

struct XcdBarrier {
    unsigned* bar; unsigned x;
    volatile LAS unsigned* st;
};

__device__ __forceinline__ XcdBarrier xcd_barrier_post(unsigned* bar, volatile LAS unsigned* st) {
    XcdBarrier b; b.bar = bar; b.x = xb_xcc_id(); b.st = st;
    if (threadIdx.x == 0) (void)xb_add(&bar[XB_XCNT(b.x)], 1u);
    return b;
}
__device__ __forceinline__ void xcd_barrier_complete(unsigned* bar, unsigned x, unsigned& nloc, unsigned& nx) {
    const unsigned G = gridDim.x * gridDim.y * gridDim.z;
    unsigned sum, cnt, mine, sp = 0u;
    for (;;) {
        sum = 0u; cnt = 0u; mine = 0u;
#pragma unroll 1
        for (unsigned j = 0; j < 16; ++j) { const unsigned c = xb_ld(&bar[XB_XCNT(j)]); sum += c; cnt += (c > 0u) ? 1u : 0u; mine = (j == x) ? c : mine; }
        if (sum == G) break;
        __builtin_amdgcn_s_sleep(1);
        if ((++sp & 255u) == 0u) { if (xb_ld(&bar[XB_TMO])) break; if (sp > XB_SPIN_CAP) { atomicAdd(&bar[XB_TMO], 1u); break; } }
    }
    nloc = mine > 0u ? mine : 1u; nx = cnt > 0u ? cnt : 1u;
}

__device__ __forceinline__ void xcd_barrier(const XcdBarrier& b) {
    asm volatile("s_waitcnt vmcnt(0)" ::: "memory");
    __syncthreads();
    if (threadIdx.x == 0) {
        unsigned* bar = b.bar;
        __builtin_amdgcn_s_waitcnt(0);
        unsigned nloc = b.st[0], nx = b.st[1];
        if (nloc == 0u) { xcd_barrier_complete(bar, b.x, nloc, nx); b.st[0] = nloc; b.st[1] = nx; }
        const unsigned old = xb_add(&bar[XB_XSUB(b.x)], 1u);
        const unsigned gen = old / nloc;
        if (old + 1u == (gen + 1u) * nloc) {
            __builtin_amdgcn_fence(__ATOMIC_RELEASE, "agent");
            asm volatile("s_waitcnt vmcnt(0)" ::: "memory");
            const unsigned og = xb_add(&bar[XB_TOP], 1u);
            const unsigned tg = og / nx;
            if (og + 1u == (tg + 1u) * nx) xb_add(&bar[XB_TOPGEN], 1u);
            else XB_SPIN(xb_ld(&bar[XB_TOPGEN]) == tg, bar);
            __builtin_amdgcn_fence(__ATOMIC_ACQUIRE, "agent");
            xb_add(&bar[XB_XGEN(b.x)], 1u);
            asm volatile("s_waitcnt vmcnt(0)" ::: "memory");
        } else {
            XB_SPIN(xb_ld(&bar[XB_XGEN(b.x)]) == gen, bar);
            __builtin_amdgcn_fence(__ATOMIC_ACQUIRE, "agent");
            asm volatile("s_waitcnt vmcnt(0)" ::: "memory");
        }
    }
    __syncthreads();
}
struct Frame {
    LAS unsigned char* lds;
    volatile LAS unsigned* MISC;
    gu32* ctl;
    int tid, lane, wave;
    int vcu, G;
    unsigned char* ws;
    const void* const* in;
    float* h;
};
__device__ __forceinline__ const void* ldptr(const void* const* tab, int k) { int z; asm volatile("s_mov_b32 %0, 0" : "=s"(z)); return tab[k + z]; }
#define INF(k) ((const float*)ldptr(F.in, k))
#define WSP(T, off) ((T*)(F.ws + (off)))

__device__ __forceinline__ void xpose_item(const float* W, int ldw, int nvalid, int k0, int n0, bf16* WT, int ldt, int drow0, LAS float* scr, int lane) {
#pragma unroll 8
    for (int i = 0; i < 32; ++i) { const int kk = 2 * i + (lane >> 5), n = n0 + (lane & 31); scr[kk * 33 + (lane & 31)] = (n < nvalid) ? W[(size_t)(k0 + kk) * ldw + n] : 0.f; }
    LDS_WAIT(); asm volatile("" ::: "memory");
    const int c = lane & 7;
#pragma unroll
    for (int j = 0; j < 4; ++j) { const int n = (lane >> 3) + 8 * j; const LAS float* s = scr + (8 * c) * 33 + n;
        v4u o; o.x = pk2(s[0 * 33], s[1 * 33]); o.y = pk2(s[2 * 33], s[3 * 33]); o.z = pk2(s[4 * 33], s[5 * 33]); o.w = pk2(s[6 * 33], s[7 * 33]);
        *(GAS v4u*)(WT + (size_t)(drow0 + n) * ldt + k0 + 8 * c) = o; }
    LDS_WAIT(); asm volatile("" ::: "memory");
}
__device__ __forceinline__ int gu_row(int n) { return 256 * (n >> 7) + (n & 127); }
template <int PART> __device__ __forceinline__ void phase_weights(Frame& F, int l) {
    LAS float* scr = (LAS float*)(F.lds + F.wave * 16384);
    const int gw = F.vcu * NWAVES + F.wave, NGW = F.G * NWAVES;
    const bool moe = (l & 1); const int fi = l >> 1;
    constexpr int I_IN = 16 * 128, I_OUT = 16 * 32;
    constexpr int I_DG = 16 * 88, I_DD = 44 * 32;
    constexpr int I_MG = 16 * 44, I_MD = 22 * 32;
    const int nitems = PART == 0 ? (I_IN + I_OUT) : (moe ? NE * (2 * I_MG + I_MD) : (2 * I_DG + I_DD));
    for (int it = gw; it < nitems; it += NGW) {
        int r = it + (PART == 0 ? 0 : I_IN + I_OUT);
        if (r < I_IN) { const int kb = r >> 7, nb = r & 127; if (nb < 122) xpose_item(INF(2) + (size_t)l * D * INC, INC, INC, 64 * kb, 32 * nb, WSP(bf16, WS_WIN), D, 32 * nb, scr, F.lane); continue; } r -= I_IN;
        if (r < I_OUT) { const int kb = r >> 5, nb = r & 31; xpose_item(INF(3) + (size_t)l * D * D, D, D, 64 * kb, 32 * nb, WSP(bf16, WS_WOUT), D, 32 * nb, scr, F.lane); continue; } r -= I_OUT;
        if (!moe) {
            if (r < 2 * I_DG) { const int up = r >= I_DG; if (up) r -= I_DG; const int kb = r / 88, nb = r % 88;
                xpose_item(INF(up ? 28 : 27) + (size_t)fi * D * FFD, FFD, FFD, 64 * kb, 32 * nb, WSP(bf16, WS_WUP), D, gu_row(32 * nb) + (up ? 128 : 0), scr, F.lane); continue; } r -= 2 * I_DG;
            { const int kb = r >> 5, nb = r & 31; xpose_item(INF(29) + (size_t)fi * FFD * D, D, D, 64 * kb, 32 * nb, WSP(bf16, WS_WDN), FFD, 32 * nb, scr, F.lane); }
        } else {
            const int per = 2 * I_MG + I_MD; const int e = r / per; r -= e * per;
            if (r < 2 * I_MG) { const int up = r >= I_MG; if (up) r -= I_MG; const int kb = r / 44, nb = r % 44;
                xpose_item(INF(up ? 32 : 31) + (size_t)(fi * NE + e) * D * FFE, FFE, FFE, 64 * kb, 32 * nb, WSP(bf16, WS_WUP) + (size_t)e * 2 * FFE * D, D, gu_row(32 * nb) + (up ? 128 : 0), scr, F.lane); continue; } r -= 2 * I_MG;
            { const int kb = r >> 5, nb = r & 31; xpose_item(INF(33) + (size_t)(fi * NE + e) * FFE * D, D, D, 64 * kb, 32 * nb, WSP(bf16, WS_WDN) + (size_t)e * D * FFE, FFE, 32 * nb, scr, F.lane); }
        }
    }
    if (PART == 0) {
        const int gt = F.vcu * NWAVES * 64 + F.tid; int NT = F.G * NWAVES * 64; asm volatile("" : "+s"(NT));     const float* win = INF(2) + (size_t)l * D * INC; const float* gw2 = INF(10) + l * 16 * 128; bf16* WT = WSP(bf16, WS_WIN);
        for (int e = gt; e < 128 * D; e += NT) { const int n = e >> 10, d = e & 1023; const float* wr = win + (size_t)d * INC + (GL_GLR - 0); float a = 0.f;
#pragma unroll
            for (int r = 0; r < 16; ++r) a += wr[r] * gw2[r * 128 + n];
            WT[(size_t)(GL_GX + n) * D + d] = (bf16)f2bf(a); }
        if (l == 0) {
            f32x2_t* CS = WSP(f32x2_t, WS_CS); const int* pos = (const int*)ldptr(F.in, 1);
            for (int e = gt; e < TOK * 32; e += NT) { const int t = e >> 5, i = e & 31; const double rev = (double)pos[t] * INVF2PI[i]; const float fr_ = (float)(rev - floor(rev));
                f32x2_t cs; cs.x = __builtin_amdgcn_cosf(fr_); cs.y = __builtin_amdgcn_sinf(fr_); CS[e] = cs; } }
    }
    if (PART == 0) {
        bf16* LO = WSP(bf16, WS_LORA); const int gt = F.vcu * NWAVES * 64 + F.tid; int NT = F.G * NWAVES * 64; asm volatile("" : "+s"(NT));
        const float* w2 = INF(15) + (size_t)l * 64 * 256; const float* a2 = INF(17) + (size_t)l * 64 * 256; const float* g2 = INF(18) + (size_t)l * 160 * 256;
        for (int e = gt; e < LO_END; e += NT) { float v;
            if (e < LO_A2) { const int n = e >> 6, k = e & 63; v = w2[k * 256 + n]; }
            else if (e < LO_G2) { const int q = e - LO_A2, n = q >> 6, k = q & 63; v = a2[k * 256 + n]; }
            else if (e < LO_V1) { const int q = e - LO_G2, n = q / 160, k = q - n * 160; v = g2[k * 256 + n]; }
            else if (e < LO_V2) { const int q = e - LO_V1, n = q >> 8, k = q & 255; v = (l > 0) ? (INF(25) + (size_t)(l - 1) * 256 * 32)[k * 32 + n] : 0.f; }
            else { const int q = e - LO_V2, n = q >> 5, k = q & 31; v = (l > 0) ? (INF(26) + (size_t)(l - 1) * 32 * 256)[k * 256 + n] : 0.f; }
            LO[e] = (bf16)f2bf(v); }
    }
    if (PART == 0 && l == 0) {
        const float* x = INF(0); bf16* hb = WSP(bf16, WS_HB);
        for (int m = gw; m < TOK; m += NGW) {
            const GAS f32x4* xr = (const GAS f32x4*)(x + (size_t)m * D) + F.lane; GAS f32x4* hr = (GAS f32x4*)(F.h + (size_t)m * D) + F.lane; GAS v2u* o8 = (GAS v2u*)(hb + (size_t)m * D) + F.lane;
#pragma unroll
            for (int j = 0; j < 4; ++j) { const f32x4 v = xr[64 * j]; hr[64 * j] = v; v2u w; w.x = pk2(v.x, v.y); w.y = pk2(v.z, v.w); o8[64 * j] = w; }
        }
    }
}
template <int NKS> __device__ __forceinline__ void rw_mm16(f32x4 (&acc)[2][4], const LAS bf16* X, int ldx, int mb0, const bf16* BT, int hh, int lane) {
    const int fr = lane & 15, fq = lane >> 4; constexpr int K = 32 * NKS;
    bf16x8 bfr[NKS][4];
#pragma unroll
    for (int ks = 0; ks < NKS; ++ks)
#pragma unroll
        for (int nb = 0; nb < 4; ++nb) bfr[ks][nb] = *(const GAS bf16x8*)(BT + (size_t)(64 * hh + 16 * nb + fr) * K + 32 * ks + 8 * fq);
#pragma unroll
    for (int ks = 0; ks < NKS; ++ks)
#pragma unroll
        for (int mi = 0; mi < 2; ++mi) { const bf16x8 a = *(const LAS bf16x8*)(X + (16 * (mb0 + mi) + fr) * ldx + 32 * ks + 8 * fq);
#pragma unroll
            for (int nb = 0; nb < 4; ++nb) acc[mi][nb] = __builtin_amdgcn_mfma_f32_16x16x32_bf16(a, bfr[ks][nb], acc[mi][nb], 0, 0, 0); }
}
__device__ __forceinline__ void rwprep_tile(Frame& F, int l, int tile) {
    const bf16* P = WSP(const bf16, WS_P);
    const float* mu = INF(13) + l * 1056;
    LAS bf16* X1 = (LAS bf16*)F.lds; LAS bf16* X2 = X1 + 64 * 72; LAS bf16* X3 = X2 + 64 * 72; LAS bf16* XV = X3 + 64 * 168; LAS bf16* X5 = XV + 64 * 264; LAS bf16* XK = X5 + 64 * 40;
    float* RWW = WSP(float, WS_RWW); bf16* RWR = WSP(bf16, WS_RWR); bf16* RWK = WSP(bf16, WS_RWK); bf16* RWV = WSP(bf16, WS_RWV);
    bf16* RWKK = WSP(bf16, WS_RWKK); bf16* RWB = WSP(bf16, WS_RWB); bf16* RWG = WSP(bf16, WS_RWG); bf16* VF = WSP(bf16, WS_VF);
    const bf16* LORA = WSP(const bf16, WS_LORA);
    int tid_ = F.tid; asm volatile("" : "+v"(tid_));
    const int lane_ = tid_ & 63, wave_ = __builtin_amdgcn_readfirstlane(tid_ >> 6);
    const int fr = lane_ & 15, fq = lane_ >> 4, hh = wave_ & 3, mb0 = 2 * (wave_ >> 2);
    const int t0 = tile * 64;
#pragma unroll
    for (int half = 0; half < 2; ++half) {
        v4u rc[9], rp[9];
#pragma unroll
        for (int i = 0; i < 9; ++i) { const int g = tid_ + (half * 9 + i) * 512; rc[i] = (v4u){0u, 0u, 0u, 0u}; rp[i] = rc[i];
            if (g < 64 * 132) { const int tt = g / 132, cg = g - tt * 132, t = t0 + tt; const int col = RW_BASE + 8 * (cg < 36 ? 96 + cg : cg < 68 ? cg - 36 : cg < 100 ? 64 + (cg - 68) : 32 + (cg - 100));
                rc[i] = *(const GAS v4u*)(P + (size_t)t * NP + col); if ((t & (SEQ - 1)) != 0) rp[i] = *(const GAS v4u*)(P + (size_t)(t - 1) * NP + col); } }
#pragma unroll
        for (int i = 0; i < 9; ++i) { const int g = tid_ + (half * 9 + i) * 512;
            if (g < 64 * 132) { const int tt = g / 132, cg = g - tt * 132, t = t0 + tt; const int rel = 8 * (cg < 36 ? 96 + cg : cg < 68 ? cg - 36 : cg < 100 ? 64 + (cg - 68) : 32 + (cg - 100));
                const f32x4 m0 = *(const GAS f32x4*)(mu + rel), m1 = *(const GAS f32x4*)(mu + rel + 4); const float m[8] = {m0.x, m0.y, m0.z, m0.w, m1.x, m1.y, m1.z, m1.w};
                float cv[8], pv[8], xs[8]; unpack8(rc[i], cv); unpack8(rp[i], pv);
#pragma unroll
                for (int j = 0; j < 8; ++j) xs[j] = cv[j] + (pv[j] - cv[j]) * m[j];
                if (cg < 8) {
#pragma unroll
                    for (int j = 0; j < 8; ++j) { const float e2 = __expf(2.f * xs[j]); xs[j] = 1.f - 2.f * __builtin_amdgcn_rcpf(e2 + 1.f); }
                    *(LAS v4u*)(X1 + tt * 72 + 8 * cg) = pack8(xs);
                } else if (cg < 16) { *(LAS v4u*)(X2 + tt * 72 + 8 * (cg - 8)) = pack8(xs);
                } else if (cg < 36) {
#pragma unroll
                    for (int j = 0; j < 8; ++j) xs[j] = sigm(xs[j]);
                    *(LAS v4u*)(X3 + tt * 168 + 8 * (cg - 16)) = pack8(xs);
                } else if (cg < 68) { *(GAS v4u*)(RWR + (size_t)t * 256 + 8 * (cg - 36)) = pack8(xs);
                } else if (cg < 100) { const v4u w = pack8(xs); *(LAS v4u*)(XV + tt * 264 + 8 * (cg - 68)) = w;
                    if (l == 0) { *(GAS v4u*)(RWV + (size_t)t * 256 + 8 * (cg - 68)) = w; *(GAS v4u*)(VF + (size_t)t * 256 + 8 * (cg - 68)) = w; }
                } else { *(LAS v4u*)(XK + tt * 264 + 8 * (cg - 100)) = pack8(xs); } } }
    }
    __syncthreads();
    {   f32x4 acc[2][4];
#pragma unroll
        for (int mi = 0; mi < 2; ++mi)
#pragma unroll
            for (int nb = 0; nb < 4; ++nb) acc[mi][nb] = (f32x4){0.f, 0.f, 0.f, 0.f};
        rw_mm16<2>(acc, X1, 72, mb0, LORA + LO_W2, hh, lane_);
        const float* w0 = INF(14) + l * 256;
#pragma unroll
        for (int mi = 0; mi < 2; ++mi)
#pragma unroll
            for (int nb = 0; nb < 4; ++nb) { const int col = 64 * hh + 16 * nb + fr; const float w0c = w0[col];
#pragma unroll
                for (int r = 0; r < 4; ++r) { const int t = t0 + 16 * (mb0 + mi) + 4 * fq + r; RWW[(size_t)t * 256 + col] = -0.6065306597126334f * sigm(acc[mi][nb][r] + w0c);     } }
#pragma unroll
        for (int mi = 0; mi < 2; ++mi)
#pragma unroll
            for (int nb = 0; nb < 4; ++nb) acc[mi][nb] = (f32x4){0.f, 0.f, 0.f, 0.f};
        rw_mm16<2>(acc, X2, 72, mb0, LORA + LO_A2, hh, lane_);
        const float* a0 = INF(16) + l * 256; const float* kkw = INF(19) + l * 256; const float* kaw = INF(20) + l * 256;
#pragma unroll
        for (int mi = 0; mi < 2; ++mi) {
            float kr[4][4], kq[4][4], ssq[4] = {0.f, 0.f, 0.f, 0.f};
#pragma unroll
            for (int nb = 0; nb < 4; ++nb) { const int col = 64 * hh + 16 * nb + fr; const float kkc = kkw[col];
#pragma unroll
                for (int r = 0; r < 4; ++r) { const int row = 16 * (mb0 + mi) + 4 * fq + r; kr[nb][r] = bf1(XK[row * 264 + col]); kq[nb][r] = kr[nb][r] * kkc; ssq[r] += kq[nb][r] * kq[nb][r]; } }
#pragma unroll
            for (int r = 0; r < 4; ++r) { ssq[r] = sum16(ssq[r]); ssq[r] = 1.0f / fmaxf(sqrtf(ssq[r]), 1e-12f); }
#pragma unroll
            for (int nb = 0; nb < 4; ++nb) { const int col = 64 * hh + 16 * nb + fr; const float a0c = a0[col], kac = kaw[col];
#pragma unroll
                for (int r = 0; r < 4; ++r) { const int t = t0 + 16 * (mb0 + mi) + 4 * fq + r; const float a = sigm(acc[mi][nb][r] + a0c); const float kk = kq[nb][r] * ssq[r];
                    const size_t o = (size_t)t * 256 + col; RWKK[o] = (bf16)f2bf(kk); RWB[o] = (bf16)f2bf(kk * a); RWK[o] = (bf16)f2bf(kr[nb][r] * (1.f + (a - 1.f) * kac)); } }
        }
#pragma unroll
        for (int mi = 0; mi < 2; ++mi)
#pragma unroll
            for (int nb = 0; nb < 4; ++nb) acc[mi][nb] = (f32x4){0.f, 0.f, 0.f, 0.f};
        rw_mm16<5>(acc, X3, 168, mb0, LORA + LO_G2, hh, lane_);
#pragma unroll
        for (int mi = 0; mi < 2; ++mi)
#pragma unroll
            for (int nb = 0; nb < 4; ++nb) { const int col = 64 * hh + 16 * nb + fr;
#pragma unroll
                for (int r = 0; r < 4; ++r) { const int t = t0 + 16 * (mb0 + mi) + 4 * fq + r; RWG[(size_t)t * 256 + col] = (bf16)f2bf(acc[mi][nb][r]); } }
    }
    if (l > 0) {
        const float* v0 = INF(24) + (l - 1) * 256; const bf16* v1T = LORA + LO_V1; const bf16* v2T = LORA + LO_V2;
        {
            const int mb = wave_ & 3, nb = wave_ >> 2; f32x4 a4 = (f32x4){0.f, 0.f, 0.f, 0.f}; bf16x8 bv[8];
#pragma unroll
            for (int ks = 0; ks < 8; ++ks) bv[ks] = *(const GAS bf16x8*)(v1T + (size_t)(16 * nb + fr) * 256 + 32 * ks + 8 * fq);
#pragma unroll
            for (int ks = 0; ks < 8; ++ks) a4 = __builtin_amdgcn_mfma_f32_16x16x32_bf16(*(const LAS bf16x8*)(XV + (16 * mb + fr) * 264 + 32 * ks + 8 * fq), bv[ks], a4, 0, 0, 0);
#pragma unroll
            for (int r = 0; r < 4; ++r) X5[(16 * mb + 4 * fq + r) * 40 + 16 * nb + fr] = (bf16)f2bf(a4[r]);
        }
        __syncthreads();
        {   f32x4 acc[2][4];
#pragma unroll
            for (int mi = 0; mi < 2; ++mi)
#pragma unroll
                for (int nb = 0; nb < 4; ++nb) acc[mi][nb] = (f32x4){0.f, 0.f, 0.f, 0.f};
            rw_mm16<1>(acc, X5, 40, mb0, v2T, hh, lane_);
#pragma unroll
            for (int mi = 0; mi < 2; ++mi)
#pragma unroll
                for (int nb = 0; nb < 4; ++nb) { const int col = 64 * hh + 16 * nb + fr; const float v0c = v0[col];
#pragma unroll
                    for (int r = 0; r < 4; ++r) { const int row = 16 * (mb0 + mi) + 4 * fq + r; const size_t o = (size_t)(t0 + row) * 256 + col;
                        const float xv = bf1(XV[row * 264 + col]); const float vf = bf1(VF[o]); RWV[o] = (bf16)f2bf(xv + (vf - xv) * sigm(acc[mi][nb][r] + v0c)); } }
        }
    }
    __syncthreads();
}
constexpr int CB = 64 * 66;
constexpr int HB_ = 64 * 72;
constexpr int PRE_H0 = 3 * CB * 4;
constexpr int PV_OFF = (PRE_H0 + 10 * HB_ * 2) / 4;
constexpr int REC_RW = 53760, REC_GL = 16640;
constexpr int RO_QH = 0, RO_AT = 8192, RO_BH = 16384, RO_TT = 24576, RO_MRB = 30720, RO_GAM = 36864, RO_VB = 37376;
constexpr int RO_Y = 0, RO_SK = 0;
constexpr int GO_QH = 0, GO_SK = 8192, GO_GAM = 16384;
#define PBUF(i) ((LAS float*)F.lds + (i) * CB)
#define HBUF(i) ((LAS bf16*)(F.lds + PRE_H0) + (i) * HB_)
__device__ __forceinline__ void nt16(f32x4 (&acc)[2], const LAS bf16* X, const LAS bf16* Y, int mb, int nb0, int lane) {
    const int fr = lane & 15, fq = lane >> 4;
    acc[0] = (f32x4){0.f, 0.f, 0.f, 0.f}; acc[1] = acc[0];
#pragma unroll
    for (int ks = 0; ks < 2; ++ks) { const bf16x8 a = *(const LAS bf16x8*)(X + (16 * mb + fr) * 72 + 32 * ks + 8 * fq);
        const bf16x8 b0 = *(const LAS bf16x8*)(Y + (16 * nb0 + fr) * 72 + 32 * ks + 8 * fq), b1 = *(const LAS bf16x8*)(Y + (16 * nb0 + 16 + fr) * 72 + 32 * ks + 8 * fq);
        acc[0] = __builtin_amdgcn_mfma_f32_16x16x32_bf16(a, b0, acc[0], 0, 0, 0); acc[1] = __builtin_amdgcn_mfma_f32_16x16x32_bf16(a, b1, acc[1], 0, 0, 0); }
}
typedef short v4i16_t __attribute__((ext_vector_type(4)));
__device__ __forceinline__ v2u trr(const LAS bf16* p) { return __builtin_bit_cast(v2u, __builtin_amdgcn_ds_read_tr16_b64_v4i16((LAS v4i16_t*)p)); }
__device__ __forceinline__ bf16x8 trfrag(const LAS bf16* M, int c, int ks, int lane) {
    const int g = lane >> 4, q = (lane & 15) >> 2, p = lane & 3; const LAS bf16* a = M + (32 * ks + 8 * g + q) * 72 + 16 * c + 4 * p;
    const v2u lo = trr(a), hi = trr(a + 4 * 72); v4u w; w.x = lo.x; w.y = lo.y; w.z = hi.x; w.w = hi.y; return __builtin_bit_cast(bf16x8, w);
}
__device__ __forceinline__ void tn16(f32x4 (&acc)[2], const LAS bf16* X, const LAS bf16* Y, int mb, int nb0, int lane) {
    acc[0] = (f32x4){0.f, 0.f, 0.f, 0.f}; acc[1] = acc[0];
#pragma unroll
    for (int ks = 0; ks < 2; ++ks) { const bf16x8 a = trfrag(X, mb, ks, lane), b0 = trfrag(Y, nb0, ks, lane), b1 = trfrag(Y, nb0 + 1, ks, lane);
        acc[0] = __builtin_amdgcn_mfma_f32_16x16x32_bf16(a, b0, acc[0], 0, 0, 0); acc[1] = __builtin_amdgcn_mfma_f32_16x16x32_bf16(a, b1, acc[1], 0, 0, 0); }
}
__device__ __forceinline__ void nn16(f32x4 (&acc)[2], const LAS bf16* A, const LAS bf16* B, int mb, int nb0, int lane) {
    const int fr = lane & 15, fq = lane >> 4;
    acc[0] = (f32x4){0.f, 0.f, 0.f, 0.f}; acc[1] = acc[0];
#pragma unroll
    for (int ks = 0; ks < 2; ++ks) { const bf16x8 a = *(const LAS bf16x8*)(A + (16 * mb + fr) * 72 + 32 * ks + 8 * fq), b0 = trfrag(B, nb0, ks, lane), b1 = trfrag(B, nb0 + 1, ks, lane);
        acc[0] = __builtin_amdgcn_mfma_f32_16x16x32_bf16(a, b0, acc[0], 0, 0, 0); acc[1] = __builtin_amdgcn_mfma_f32_16x16x32_bf16(a, b1, acc[1], 0, 0, 0); }
}
__device__ __forceinline__ void hfrag_tr(const LAS bf16* M, unsigned char* dst, int wave, int lane) {
    const int mb = wave >> 1, ks = wave & 1, g = lane >> 4, q = (lane & 15) >> 2, p = lane & 3; const LAS bf16* a = M + (32 * ks + 4 * g + q) * 72 + 16 * mb + 4 * p;
    const v2u lo = trr(a), hi = trr(a + 16 * 72); v4u w; w.x = lo.x; w.y = lo.y; w.z = hi.x; w.w = hi.y;
    *(GAS v4u*)(dst + ((size_t)wave * 64 + lane) * 16) = w;
}
template <int MASK> __device__ __forceinline__ void hst(const f32x4 (&acc)[2], LAS bf16* S, int mb, int nb0, int lane) {
    const int fr = lane & 15, fq = lane >> 4;
#pragma unroll
    for (int n = 0; n < 2; ++n)
#pragma unroll
        for (int r = 0; r < 4; ++r) { const int row = 16 * mb + 4 * fq + r, col = 16 * (nb0 + n) + fr; float v = acc[n][r];
            if (MASK == 1 && col > row) v = 0.f; if (MASK == 2 && col >= row) v = 0.f; S[row * 72 + col] = (bf16)f2bf(v); }
}
template <int MASK> __device__ __forceinline__ void cst(const f32x4 (&acc)[2], LAS float* S, int mb, int nb0, int lane) {
    const int fr = lane & 15, fq = lane >> 4;
#pragma unroll
    for (int n = 0; n < 2; ++n)
#pragma unroll
        for (int r = 0; r < 4; ++r) { const int row = 16 * mb + 4 * fq + r, col = 16 * (nb0 + n) + fr; float v = acc[n][r];
            if (MASK == 1 && col > row) v = 0.f; if (MASK == 2 && col >= row) v = 0.f; S[row * 66 + col] = v; }
}
__device__ __forceinline__ void hfrag(const LAS bf16* M, const LAS float* colscale, unsigned char* dst, int wave, int lane, int slot = -2) {
    const int mb = wave >> 1, ks = wave & 1, i = lane & 15, q = lane >> 4; const LAS bf16* rowp = M + (16 * mb + i) * 72 + 32 * ks + 4 * q;
    const v2u lo = *(const LAS v2u*)rowp, hi = *(const LAS v2u*)(rowp + 16);
    v4u w; w.x = lo.x; w.y = lo.y; w.z = hi.x; w.w = hi.y;
    if (colscale) { float e[8]; unpack8(w, e); const f32x4 s0 = *(const LAS f32x4*)(colscale + 32 * ks + 4 * q), s1 = *(const LAS f32x4*)(colscale + 32 * ks + 16 + 4 * q);
        e[0] *= s0.x; e[1] *= s0.y; e[2] *= s0.z; e[3] *= s0.w; e[4] *= s1.x; e[5] *= s1.y; e[6] *= s1.z; e[7] *= s1.w; w = pack8(e); }
    if (slot == -2) slot = wave; if (slot >= 0) *(GAS v4u*)(dst + ((size_t)slot * 64 + lane) * 16) = w;
}
__device__ __forceinline__ void cfrag(const LAS float* M, unsigned char* dst, int wave, int lane, int slot) {
    const int mb = wave >> 1, ks = wave & 1, i = lane & 15, q = lane >> 4; float e[8];
#pragma unroll
    for (int jj = 0; jj < 8; ++jj) { const int rho = 32 * ks + (jj < 4 ? 4 * q + jj : 16 + 4 * q + jj - 4); e[jj] = M[(16 * mb + i) * 66 + rho]; }
    if (slot >= 0) *(GAS v4u*)(dst + ((size_t)slot * 64 + lane) * 16) = pack8(e);
}
__device__ __forceinline__ void cacc(const f32x4 (&acc)[2], const LAS float* rowscale, unsigned char* dst, int mb, int nb0, int lane, int vbs = 2048) {
    const int fq = lane >> 4;
#pragma unroll
    for (int n = 0; n < 2; ++n) { float v[4];
#pragma unroll
        for (int r = 0; r < 4; ++r) { v[r] = acc[n][r]; if (rowscale) v[r] *= rowscale[16 * mb + 4 * fq + r]; }
        v2u w; w.x = pk2(v[0], v[1]); w.y = pk2(v[2], v[3]); *(GAS v2u*)(dst + (size_t)(nb0 + n) * vbs + ((size_t)mb * 64 + lane) * 8) = w; }
}
__device__ __forceinline__ void ccumsum(Frame& F, LAS float* CU) {
    LAS float* vec = (LAS float*)F.lds + PV_OFF; LAS float* seg = vec + 128;
    { float run = 0.f;
#pragma unroll
      for (int i = 0; i < 8; ++i) { run += CU[(8 * F.wave + i) * 66 + F.lane]; CU[(8 * F.wave + i) * 66 + F.lane] = run; }
      seg[F.wave * 64 + F.lane] = run; }
    LDS_BARRIER();
    { float off = 0.f;
#pragma unroll
      for (int w = 0; w < 8; ++w) if (w < F.wave) off += seg[w * 64 + F.lane];
#pragma unroll
      for (int i = 0; i < 8; ++i) { const float c = CU[(8 * F.wave + i) * 66 + F.lane] + off; CU[(8 * F.wave + i) * 66 + F.lane] = c; if (8 * F.wave + i == 31) vec[F.lane] = c; if (8 * F.wave + i == 63) vec[64 + F.lane] = c; } }
    LDS_BARRIER();
}
__device__ __forceinline__ f32x4 blk16(f32x4 acc, const LAS float* A, int ar0, int ac0, const LAS float* B, int br0, int bc0, int lane) {
    const int fr = lane & 15, fq = lane >> 4;
#pragma unroll
    for (int s = 0; s < 4; ++s) acc = __builtin_amdgcn_mfma_f32_16x16x4f32(A[(ar0 + fr) * 66 + ac0 + 4 * s + fq], B[(br0 + 4 * s + fq) * 66 + bc0 + fr], acc, 0, 0, 0);
    return acc;
}
__device__ __forceinline__ void blkst(const f32x4 acc, LAS float* S, int r0, int c0, int lane) {
    const int fr = lane & 15, fq = lane >> 4;
#pragma unroll
    for (int r = 0; r < 4; ++r) S[(r0 + 4 * fq + r) * 66 + c0 + fr] = acc[r];
}
__device__ __forceinline__ void tri_inverse(Frame& F, const LAS float* L, LAS float* T, LAS float* W) {
    for (int e = F.tid; e < 64 * 64; e += NWAVES * 64) { const int i = e >> 6, j = e & 63; if ((i >> 4) != (j >> 4)) T[i * 66 + j] = 0.f; }
    if (F.wave == 0) {
        const int d0 = 16 * (F.lane >> 4), c = F.lane & 15; float t[16];
#pragma unroll
        for (int i = 0; i < 16; ++i) { float a = (i == c) ? 1.f : 0.f;
#pragma unroll
            for (int j = 0; j < i; ++j) a += L[(d0 + i) * 66 + d0 + j] * t[j];
            t[i] = a; T[(d0 + i) * 66 + d0 + c] = a; }
    }
    LDS_BARRIER();
#pragma unroll
    for (int d = 1; d <= 3; ++d) {
        if (F.wave < 4 - d) { const int i = d + F.wave, j = F.wave; f32x4 acc = (f32x4){0.f, 0.f, 0.f, 0.f};
#pragma unroll
            for (int k = 0; k < 3; ++k) if (k >= j && k < i) acc = blk16(acc, L, 16 * i, 16 * k, T, 16 * k, 16 * j, F.lane);
            blkst(acc, W, 16 * i, 16 * j, F.lane); }
        LDS_BARRIER();
        if (F.wave < 4 - d) { const int i = d + F.wave, j = F.wave; f32x4 acc = (f32x4){0.f, 0.f, 0.f, 0.f};
            acc = blk16(acc, T, 16 * i, 16 * i, W, 16 * i, 16 * j, F.lane); blkst(acc, T, 16 * i, 16 * j, F.lane); }
        LDS_BARRIER();
    }
}
struct PreRaw { unsigned x[6][8]; f32x2_t cs[8]; };
__device__ __forceinline__ unsigned ldh(const bf16* p) { return (unsigned)*(const GAS bf16*)p; }
#define WSQ(T, off) ((T*)(ws_ + (off)))
__device__ __forceinline__ void pre_load(Frame& F, PreRaw& R, const int MIX, int b, int h, int c) {
    int tid_ = F.tid; asm volatile("" : "+v"(tid_));
    unsigned char* ws_ = F.ws; asm volatile("" : "+s"(ws_));
    const int k = tid_ & 63, w = tid_ >> 6, t0 = b * SEQ + c * 64 + 8 * w;
    const bf16* P = WSQ(const bf16, WS_P) + (size_t)t0 * NP;
#pragma unroll
    for (int s = 0; s < 6; ++s)
#pragma unroll
        for (int i = 0; i < 8; ++i) R.x[s][i] = 0u;
    if (MIX == 0) {
#pragma unroll
        for (int i = 0; i < 8; ++i) { R.x[0][i] = ldh(P + (size_t)i * NP + HG_F + 64 * h + k); R.x[1][i] = ldh(P + (size_t)i * NP + HG_Q + 64 * h + k); R.x[2][i] = ldh(P + (size_t)i * NP + HG_I + 64 * h + k); }
    } else if (MIX == 1) {
#pragma unroll
        for (int i = 0; i < 8; ++i) { R.x[2][i] = ldh(P + (size_t)i * NP + GL_V + 64 * h + k);
            if (k < 32) { R.x[0][i] = ldh(P + (size_t)i * NP + GL_GX + 32 * h + k); R.x[1][i] = ldh(P + (size_t)i * NP + GL_Q + 32 * h + k); R.x[3][i] = ldh(P + (size_t)i * NP + GL_K + 32 * h + k); } }
    } else if (MIX == 2) { const size_t o = (size_t)t0 * 256 + 64 * h + k;
#pragma unroll
        for (int i = 0; i < 8; ++i) { R.x[0][i] = __float_as_uint(*(const GAS float*)(WSQ(const float, WS_RWW) + o + i * 256)); R.x[1][i] = ldh(WSQ(const bf16, WS_RWR) + o + i * 256); R.x[2][i] = ldh(WSQ(const bf16, WS_RWV) + o + i * 256);
            R.x[3][i] = ldh(WSQ(const bf16, WS_RWK) + o + i * 256); R.x[4][i] = ldh(WSQ(const bf16, WS_RWKK) + o + i * 256); R.x[5][i] = ldh(WSQ(const bf16, WS_RWB) + o + i * 256); }
    } else { const int k31 = k & 31; const f32x2_t* CS = WSQ(const f32x2_t, WS_CS) + (size_t)t0 * 32 + k31;
#pragma unroll
        for (int i = 0; i < 8; ++i) { R.x[0][i] = ldh(P + (size_t)i * NP + RT_Q + 64 * h + k31); R.x[1][i] = ldh(P + (size_t)i * NP + RT_Q + 64 * h + 32 + k31); R.x[2][i] = ldh(P + (size_t)i * NP + RT_V + 64 * h + k);
            R.x[3][i] = ldh(P + (size_t)i * NP + RT_K + 64 * h + k31); R.x[4][i] = ldh(P + (size_t)i * NP + RT_K + 64 * h + 32 + k31); R.cs[i] = *(const GAS f32x2_t*)(CS + i * 32); }
    }
}
__device__ __forceinline__ float ubf(unsigned u) { return __uint_as_float(u << 16); }
__device__ __forceinline__ v4u pack8v(const float (&f)[8]) { v4u w; w.x = pk2(f[0], f[1]); w.y = pk2(f[2], f[3]); w.z = pk2(f[4], f[5]); w.w = pk2(f[6], f[7]); return w; }
__device__ __forceinline__ void hfrag_trs(const LAS bf16* M, const LAS float* scale, unsigned char* dst, int wave, int lane) {
    const int mb = wave >> 1, ks = wave & 1, g = lane >> 4, q = (lane & 15) >> 2, p = lane & 3; const LAS bf16* a = M + (32 * ks + 4 * g + q) * 72 + 16 * mb + 4 * p;
    const v2u lo = trr(a), hi = trr(a + 16 * 72); v4u w; w.x = lo.x; w.y = lo.y; w.z = hi.x; w.w = hi.y;
    float e[8]; unpack8(w, e); const f32x4 s0 = *(const LAS f32x4*)(scale + 32 * ks + 4 * g), s1 = *(const LAS f32x4*)(scale + 32 * ks + 16 + 4 * g);
    e[0] *= s0.x; e[1] *= s0.y; e[2] *= s0.z; e[3] *= s0.w; e[4] *= s1.x; e[5] *= s1.y; e[6] *= s1.z; e[7] *= s1.w;
    *(GAS v4u*)(dst + ((size_t)wave * 64 + lane) * 16) = pack8(e);
}
__device__ __forceinline__ void chunk_pre(Frame& F, PreRaw& R, int l, const int MIX, int b, int h, int c, unsigned char* rec, const int nMIX, int nh) {
    const int t0 = b * SEQ + c * 64;
    LAS float* SEG = PBUF(0); LAS float* LL = PBUF(1); LAS float* T32 = PBUF(2); LAS float* WW = PBUF(0);
    LAS bf16* A1 = HBUF(0); LAS bf16* R1 = HBUF(1); LAS bf16* B1 = HBUF(2); LAS bf16* K1 = HBUF(3); LAS bf16* KeT = HBUF(4); LAS bf16* VT = HBUF(5); LAS bf16* BeT = HBUF(6); LAS bf16* M1 = HBUF(7); LAS bf16* M2 = HBUF(8); LAS bf16* M3 = HBUF(9);
    LAS float* vec = (LAS float*)F.lds + PV_OFF; LAS float* ecm = vec + 640;
    int tid_ = F.tid; asm volatile("" : "+v"(tid_));
    unsigned char* ws_ = F.ws; asm volatile("" : "+s"(ws_));
    const int lane_ = tid_ & 63, wave_ = __builtin_amdgcn_readfirstlane(tid_ >> 6);
    const int k_ = lane_;
    const int mb = wave_ >> 1, nb0 = 2 * (wave_ & 1), fr = lane_ & 15, fq = lane_ >> 4;
    float q[8], kx[8], lw[8], v[8], av[8], bv[8];
    if (MIX == 0) {
        const float* lg = INF(8); const int cch = 64 * h + k_;
        const float x0 = lg[cch], x1 = lg[256 + cch], x2 = lg[512 + cch], x3 = lg[768 + cch]; const float mx = fmaxf(fmaxf(x0, x1), fmaxf(x2, x3));
        const float e0 = __expf(x0 - mx), e1 = __expf(x1 - mx), e2 = __expf(x2 - mx), e3 = __expf(x3 - mx);
        const float lb = ((l >= 1 ? e1 : 0.f) + (l >= 2 ? e2 : 0.f) + (l >= 3 ? e3 : 0.f)) / (e0 + e1 + e2 + e3);
#pragma unroll
        for (int i = 0; i < 8; ++i) { const float fr_ = ubf(R.x[0][i]), qr = ubf(R.x[1][i]); const float w = lb + (1.f - lb) * sigm(fr_); lw[i] = __logf(w); kx[i] = 1.f - w; q[i] = qr * sigm(qr); v[i] = ubf(R.x[2][i]); }
    } else if (MIX == 1) {
        const float gb = (k_ < 32) ? (INF(11) + l * 128)[32 * h + k_] : 0.f;
#pragma unroll
        for (int i = 0; i < 8; ++i) { v[i] = ubf(R.x[2][i]);
            if (k_ < 32) { const float x = ubf(R.x[0][i]) + gb; lw[i] = 0.0625f * (fminf(x, 0.f) - __logf(1.f + __expf(-fabsf(x)))); q[i] = ubf(R.x[1][i]) * 0.17677669529663687f; kx[i] = ubf(R.x[3][i]); }
            else { lw[i] = 0.f; q[i] = 0.f; kx[i] = 0.f; } }
    } else if (MIX == 2) {
#pragma unroll
        for (int i = 0; i < 8; ++i) { lw[i] = __uint_as_float(R.x[0][i]); q[i] = ubf(R.x[1][i]); v[i] = ubf(R.x[2][i]); kx[i] = ubf(R.x[3][i]); av[i] = -ubf(R.x[4][i]); bv[i] = ubf(R.x[5][i]); }
    } else {
        const bool hi = k_ >= 32; const float lgam = __logf(1.f - exp2f(-5.f - (float)h));
#pragma unroll
        for (int i = 0; i < 8; ++i) { const float cs_ = R.cs[i].x, sn = R.cs[i].y; const float q1 = ubf(R.x[0][i]), q2 = ubf(R.x[1][i]), k1 = ubf(R.x[3][i]), k2 = ubf(R.x[4][i]);
            q[i] = hi ? (q1 * sn + q2 * cs_) : (q1 * cs_ - q2 * sn); kx[i] = 0.125f * (hi ? (k1 * sn + k2 * cs_) : (k1 * cs_ - k2 * sn)); lw[i] = lgam; v[i] = ubf(R.x[2][i]); }
    }
    float cu[8]; { float run = 0.f;
#pragma unroll
        for (int i = 0; i < 8; ++i) { run += lw[i]; cu[i] = run; }
        SEG[wave_ * 64 + k_] = run; }
    LDS_BARRIER();
    float cm, ce; { float pre = 0.f, tot = 0.f, mid = 0.f;
#pragma unroll
        for (int w = 0; w < 8; ++w) { const float s = SEG[w * 64 + k_]; if (w < wave_) pre += s; if (w < 4) mid += s; tot += s; }
        cm = mid; ce = tot;
#pragma unroll
        for (int i = 0; i < 8; ++i) cu[i] += pre; }
    {   float e1[8], e2[8], e3[8];
#pragma unroll
        for (int i = 0; i < 8; ++i) { const float ef = __expf(cu[i] - cm); e1[i] = q[i] * ef; e2[i] = kx[i] * __builtin_amdgcn_rcpf(ef); e3[i] = kx[i] * __expf(ce - cu[i]); }
        *(LAS v4u*)(R1 + k_ * 72 + 8 * wave_) = pack8v(e1); *(LAS v4u*)(K1 + k_ * 72 + 8 * wave_) = pack8v(e2); *(LAS v4u*)(KeT + k_ * 72 + 8 * wave_) = pack8v(e3); *(LAS v4u*)(VT + k_ * 72 + 8 * wave_) = pack8v(v);
        if (MIX == 2) {
#pragma unroll
            for (int i = 0; i < 8; ++i) { const float ef = __expf(cu[i] - cm); e1[i] = av[i] * __expf(cu[i] - lw[i] - cm); e2[i] = bv[i] * __builtin_amdgcn_rcpf(ef); e3[i] = bv[i] * __expf(ce - cu[i]); }
            *(LAS v4u*)(A1 + k_ * 72 + 8 * wave_) = pack8v(e1); *(LAS v4u*)(B1 + k_ * 72 + 8 * wave_) = pack8v(e2); *(LAS v4u*)(BeT + k_ * 72 + 8 * wave_) = pack8v(e3); }
        if (wave_ == 0) { ecm[k_] = __expf(cm); *(GAS float*)(rec + (MIX == 2 ? RO_GAM : GO_GAM) + 4 * k_) = __expf(ce); }
    }
    LDS_BARRIER();
    if (nMIX >= 0) pre_load(F, R, nMIX, b, nh, c);
    f32x4 acc[2];
    tn16(acc, R1, K1, mb, nb0, lane_); hst<1>(acc, M1, mb, nb0, lane_);
    hfrag_trs(R1, ecm, rec + (MIX == 2 ? RO_QH : GO_QH), wave_, lane_);
    nt16(acc, KeT, VT, mb, nb0, lane_); if (MIX == 2) cacc(acc, nullptr, rec + RO_VB + 2048, mb, nb0, lane_, 4096); else cacc(acc, nullptr, rec + GO_SK, mb, nb0, lane_);
    if (MIX == 2) {
        tn16(acc, A1, B1, mb, nb0, lane_); cst<2>(acc, LL, mb, nb0, lane_);
        tn16(acc, R1, B1, mb, nb0, lane_); hst<1>(acc, M2, mb, nb0, lane_);
        tn16(acc, A1, K1, mb, nb0, lane_); hst<2>(acc, M3, mb, nb0, lane_);
        hfrag_trs(A1, ecm, rec + RO_AT, wave_, lane_);
        hfrag(BeT, nullptr, rec + RO_BH, wave_, lane_);
    }
    LDS_BARRIER();
    nt16(acc, M1, VT, mb, nb0, lane_);
#pragma unroll
    for (int n = 0; n < 2; ++n)
#pragma unroll
        for (int r = 0; r < 4; ++r) A1[(16 * mb + 4 * fq + r) * 72 + 16 * (nb0 + n) + fr] = (bf16)f2bf(acc[n][r]);
    if (MIX == 2) {
        nt16(acc, M3, VT, mb, nb0, lane_); cacc(acc, nullptr, rec + RO_VB, mb, nb0, lane_, 4096);
        const int t6 = ((wave_ & 1) == 1 && (wave_ >> 1) < 2) ? -1 : ((wave_ >> 1) < 2 ? (wave_ >> 1) : 2 + ((wave_ >> 1) - 2) * 2 + (wave_ & 1));
        hfrag(M2, nullptr, rec + RO_MRB, wave_, lane_, t6);
        tri_inverse(F, LL, T32, WW);
        cfrag(T32, rec + RO_TT, wave_, lane_, t6);
    }
    LDS_BARRIER();
}
constexpr size_t WS_REC_RW = 14 * MiB, WS_REC_GL = 412 * MiB;
__device__ __forceinline__ void oloc_flush(Frame& F, int m, int t0, int h) {
    const int t = F.tid >> 3, pc = F.tid & 7; const v4u w = *(const LAS v4u*)(HBUF(0) + t * 72 + 8 * pc);
    *(GAS v4u*)(WSP(bf16, WS_O) + (size_t)m * TOK * 256 + (size_t)(t0 + t) * 256 + 64 * h + 8 * pc) = w;
}
__device__ __forceinline__ unsigned char* pre_rec(Frame& F, int m, int b, int h, int c) {
    return (m == 2) ? F.ws + WS_REC_RW + (size_t)(((b * 4 + h) * 64) + c) * REC_RW : F.ws + WS_REC_GL + (size_t)((((m == 3 ? 2 : m) * 16 + b * 4 + h) * 64) + c) * REC_GL;
}
__device__ __forceinline__ void phase_chunkpre(Frame& F, int l) {
    for (int tile = F.vcu; tile < TOK / 64; tile += F.G) {
        const int b = tile >> 6, c = tile & 63;
        rwprep_tile(F, l, tile);
        __syncthreads();
        PreRaw cur;
        pre_load(F, cur, 0, b, 0, c);
#pragma unroll 1
        for (int i = 0; i < 16; ++i) {
            const int mo = i >> 2, m = (mo == 2) ? 3 : (mo == 3 ? 2 : mo), h = i & 3;
            const int mo2 = (i + 1) >> 2, m2 = (i + 1 < 16) ? ((mo2 == 2) ? 3 : (mo2 == 3 ? 2 : mo2)) : -1;
            chunk_pre(F, cur, l, m, b, h, c, pre_rec(F, m, b, h, c), m2, (i + 1) & 3);
            oloc_flush(F, m, b * SEQ + c * 64, h);
        }
    }
}
__device__ __forceinline__ bf16x8 pack_b(const f32x4 a, const f32x4 b) { v4u w; w.x = pk2(a.x, a.y); w.y = pk2(a.z, a.w); w.z = pk2(b.x, b.y); w.w = pk2(b.z, b.w); return __builtin_bit_cast(bf16x8, w); }
__device__ __forceinline__ f32x4 unpk4(const v2u w) { return (f32x4){bflo(w.x), bfhi(w.x), bflo(w.y), bfhi(w.y)}; }
template <int NF> struct SeqRegs { v4u r[NF]; v4u tail; };
template <int NF, int NLT, bool TAIL> __device__ __forceinline__ void seq_ld(SeqRegs<NF>& R, const unsigned char* rec, int lt) {
    const GAS v4u* src = (const GAS v4u*)rec;
#pragma unroll
    for (int i = 0; i < NF; ++i) R.r[i] = src[i * NLT + lt];
    if (TAIL && lt < 16) R.tail = src[NF * NLT + lt];
}
template <int NF, int NLT, bool TAIL> __device__ __forceinline__ void seq_st(const SeqRegs<NF>& R, LAS unsigned char* slot, int lt) {
    LAS v4u* dst = (LAS v4u*)slot;
#pragma unroll
    for (int i = 0; i < NF; ++i) dst[i * NLT + lt] = R.r[i];
    if (TAIL && lt < 16) dst[NF * NLT + lt] = R.tail;
}
template <bool RW> __device__ __forceinline__ void seq_unit(Frame& F, int mix, int b, int h, int vb_, const unsigned char* recs) {
    constexpr int REC = RW ? REC_RW : REC_GL, SLOT = 61440, NCW = RW ? 1 : 4, LW0 = RW ? 2 : 4, NLT = (8 - LW0) * 64, NF = REC / (NLT * 16); constexpr bool TAIL = (REC % (NLT * 16)) != 0;
    static_assert(REC % (NLT * 16) == 0 || REC % (NLT * 16) == 256, "record = NF loader rounds (+ 256 B)");
    const bool loader = F.wave >= LW0, compute = F.wave < NCW; const int lt = F.tid - 64 * LW0;
    SeqRegs<NF> RA, RB;
    if (loader) { seq_ld<NF, NLT, TAIL>(RA, recs, lt); seq_st<NF, NLT, TAIL>(RA, F.lds, lt); seq_ld<NF, NLT, TAIL>(RB, recs + (size_t)1 * REC, lt); seq_ld<NF, NLT, TAIL>(RA, recs + (size_t)2 * REC, lt); }
    __syncthreads();
    f32x4 S[4];
#pragma unroll
    for (int kb = 0; kb < 4; ++kb) S[kb] = (f32x4){0.f, 0.f, 0.f, 0.f};
    const int vb = RW ? vb_ : (F.wave & 3), fr = F.lane & 15, fq = F.lane >> 4;
    bf16* Og_ = WSP(bf16, WS_OI) + OI_GEN + (size_t)(((mix == 3 ? 2 : mix) * 16 + b * 4 + h)) * (SEQ * 64);
    constexpr int OSO = 122880;
#define SEQ_FLUSH(cc) do { const LAS unsigned char* osr_ = F.lds + OSO + ((cc) & 1) * 8192 + (16 * vb + (F.lane >> 2)) * 128 + (F.lane & 3) * 32; bf16* dst_ = Og_ + ((size_t)(cc) * 64 + 16 * vb + (F.lane >> 2)) * 64 + (F.lane & 3) * 16; \
        const v4u a_ = *(const LAS v4u*)osr_, b_ = *(const LAS v4u*)(osr_ + 16); *(GAS v4u*)dst_ = a_; *(GAS v4u*)(dst_ + 8) = b_; } while (0)
#pragma unroll 1
    for (int c2 = 0; c2 < 64; c2 += 2) {
#pragma unroll
        for (int par = 0; par < 2; ++par) {
            const int c = c2 + par;
            if (loader) {
                if (par == 0) { seq_st<NF, NLT, TAIL>(RB, F.lds + SLOT, lt); if (c + 3 < 64) seq_ld<NF, NLT, TAIL>(RB, recs + (size_t)(c + 3) * REC, lt); }
                else { if (c + 1 < 64) seq_st<NF, NLT, TAIL>(RA, F.lds, lt); if (c + 3 < 64) seq_ld<NF, NLT, TAIL>(RA, recs + (size_t)(c + 3) * REC, lt); }
            } else if (compute) {
                const LAS unsigned char* R = F.lds + par * SLOT;
                const f32x4 z = (f32x4){0.f, 0.f, 0.f, 0.f};
                if (c > 0) SEQ_FLUSH(c - 1);
                bf16x8 fqh[8];
#pragma unroll
                for (int f = 0; f < 8; ++f) fqh[f] = *(const LAS bf16x8*)(R + (RW ? RO_QH : GO_QH) + (f * 64 + F.lane) * 16);
                bf16x8 bS[2]; bS[0] = pack_b(S[0], S[1]); bS[1] = pack_b(S[2], S[3]);
                asm volatile("s_waitcnt lgkmcnt(0)" ::: "memory"); __builtin_amdgcn_sched_barrier(0);
                f32x4 O[4]; bf16x8 bU[2];
#pragma unroll
                for (int mb = 0; mb < 4; ++mb) { O[mb] = z;
#pragma unroll
                    for (int ks = 0; ks < 2; ++ks) O[mb] = __builtin_amdgcn_mfma_f32_16x16x32_bf16(fqh[mb * 2 + ks], bS[ks], O[mb], 0, 0, 0); }
                if (RW) {
                    f32x4 X[4], U[4];
#pragma unroll
                    for (int mb = 0; mb < 4; ++mb) { X[mb] = unpk4(*(const LAS v2u*)(R + RO_Y + ((vb * 4 + mb) * 64 + F.lane) * 8));
#pragma unroll
                        for (int ks = 0; ks < 2; ++ks) X[mb] = __builtin_amdgcn_mfma_f32_16x16x32_bf16(*(const LAS bf16x8*)(R + RO_AT + ((mb * 2 + ks) * 64 + F.lane) * 16), bS[ks], X[mb], 0, 0, 0); }
                    bf16x8 bX[2]; bX[0] = pack_b(X[0], X[1]); bX[1] = pack_b(X[2], X[3]);
#pragma unroll
                    for (int mb = 0; mb < 4; ++mb) { U[mb] = z;
#pragma unroll
                        for (int ks = 0; ks < 2; ++ks) if (!(ks == 1 && mb < 2)) U[mb] = __builtin_amdgcn_mfma_f32_16x16x32_bf16(*(const LAS bf16x8*)(R + RO_TT + ((mb * 2 + ks) * 64 + F.lane) * 16), bX[ks], U[mb], 0, 0, 0); }
                    bU[0] = pack_b(U[0], U[1]); bU[1] = pack_b(U[2], U[3]);
#pragma unroll
                    for (int mb = 0; mb < 4; ++mb)
#pragma unroll
                        for (int ks = 0; ks < 2; ++ks) if (!(ks == 1 && mb < 2)) O[mb] = __builtin_amdgcn_mfma_f32_16x16x32_bf16(*(const LAS bf16x8*)(R + RO_MRB + ((mb * 2 + ks) * 64 + F.lane) * 16), bU[ks], O[mb], 0, 0, 0);
                }
#pragma unroll
                for (int kb = 0; kb < 4; ++kb) { const f32x4 g = *(const LAS f32x4*)(R + (RW ? RO_GAM : GO_GAM) + (16 * kb + 4 * fq) * 4); const f32x4 sk = unpk4(*(const LAS v2u*)(R + (RW ? RO_SK : GO_SK) + ((vb * 4 + kb) * 64 + F.lane) * 8));
                    f32x4 n = S[kb] * g + sk;
                    if (RW) {
#pragma unroll
                        for (int ks = 0; ks < 2; ++ks) n = __builtin_amdgcn_mfma_f32_16x16x32_bf16(*(const LAS bf16x8*)(R + RO_BH + ((kb * 2 + ks) * 64 + F.lane) * 16), bU[ks], n, 0, 0, 0);
                    }
                    S[kb] = n; }
#pragma unroll
                for (int mb = 0; mb < 4; ++mb)
#pragma unroll
                    for (int r = 0; r < 4; ++r) *(LAS bf16*)(F.lds + OSO + par * 8192 + (16 * mb + 4 * fq + r) * 128 + (16 * vb + fr) * 2) = (bf16)f2bf(O[mb][r]);
            }
            LDS_BARRIER();
        }
    }
    if (compute) SEQ_FLUSH(63);
#undef SEQ_FLUSH
    __syncthreads();
}
__device__ __forceinline__ int tri6(int mb, int ks) { return mb < 2 ? mb : 2 + (mb - 2) * 2 + ks; }
struct SeqRegs4 { v4u r[6]; v4u t; };
__device__ __forceinline__ void seq4_ld(SeqRegs4& R, const unsigned char* rec, int vb, int lt) {
    const GAS v4u* src = (const GAS v4u*)rec;
#pragma unroll
    for (int i = 0; i < 6; ++i) R.r[i] = src[i * 384 + lt];
    if (lt < 16) R.t = src[6 * 384 + lt];
    if (lt >= 128) R.t = *(const GAS v4u*)(rec + RO_VB + vb * 4096 + (lt - 128) * 16);
}
__device__ __forceinline__ void seq4_st(const SeqRegs4& R, LAS unsigned char* slot, int lt) {
    LAS v4u* dst = (LAS v4u*)slot;
#pragma unroll
    for (int i = 0; i < 6; ++i) dst[i * 384 + lt] = R.r[i];
    if (lt < 16) dst[6 * 384 + lt] = R.t;
    if (lt >= 128) *(LAS v4u*)(slot + 37120 + (lt - 128) * 16) = R.t;
}
__device__ __forceinline__ void seq_rw(Frame& F, int b, int h, int vb, const unsigned char* recs) {
    constexpr int REC = REC_RW, SLOT = 41216, EXO = 3 * SLOT;
    const bool loader = F.wave >= 2; const int lt = F.tid - 128;
    SeqRegs4 RA, RB, RC;
    if (loader) { seq4_ld(RA, recs, vb, lt); seq4_st(RA, F.lds, lt); seq4_ld(RB, recs + (size_t)1 * REC, vb, lt); seq4_ld(RC, recs + (size_t)2 * REC, vb, lt); seq4_ld(RA, recs + (size_t)3 * REC, vb, lt); }
    __syncthreads();
    f32x4 S[4];
#pragma unroll
    for (int kb = 0; kb < 4; ++kb) S[kb] = (f32x4){0.f, 0.f, 0.f, 0.f};
    const int fr = F.lane & 15, fq = F.lane >> 4;
    bf16* Og_ = WSP(bf16, WS_OI) + (size_t)((b * 4 + h) * 4 + vb) * (SEQ * 16);
    LAS unsigned char* OS = F.lds + EXO + 8192;
#pragma unroll 1
    for (int c2 = 0; c2 < 66; c2 += 3) {
#pragma unroll
        for (int j3 = 0; j3 < 3; ++j3) {
            const int c = c2 + j3; const int par = c & 1;
            if (loader) {
                LAS unsigned char* dst = F.lds + ((j3 + 1) % 3) * SLOT; const unsigned char* nrec = recs + (size_t)(c + 4) * REC;
                if (c + 1 < 64) { if (j3 == 0) seq4_st(RB, dst, lt); else if (j3 == 1) seq4_st(RC, dst, lt); else seq4_st(RA, dst, lt); }
                if (c + 4 < 64) { if (j3 == 0) seq4_ld(RB, nrec, vb, lt); else if (j3 == 1) seq4_ld(RC, nrec, vb, lt); else seq4_ld(RA, nrec, vb, lt); }
            } else if (F.wave == 0) {
                if (c < 64) {
                    const LAS unsigned char* R = F.lds + (c % 3) * SLOT; LAS unsigned char* EX = F.lds + EXO + par * 4096;
                    const f32x4 z = (f32x4){0.f, 0.f, 0.f, 0.f};
                    v2u yv[4]; bf16x8 fat[8], ftt[6];
#pragma unroll
                    for (int mb = 0; mb < 4; ++mb) yv[mb] = *(const LAS v2u*)(R + 37120 + (mb * 64 + F.lane) * 8);
#pragma unroll
                    for (int f = 0; f < 8; ++f) fat[f] = *(const LAS bf16x8*)(R + RO_AT + (f * 64 + F.lane) * 16);
                    bf16x8 bS[2]; bS[0] = pack_b(S[0], S[1]); bS[1] = pack_b(S[2], S[3]);
                    *(LAS bf16x8*)(EX + F.lane * 16) = bS[0]; *(LAS bf16x8*)(EX + 1024 + F.lane * 16) = bS[1];
                    asm volatile("s_waitcnt lgkmcnt(0)" ::: "memory"); __builtin_amdgcn_sched_barrier(0);
                    f32x4 X[4], U[4];
#pragma unroll
                    for (int mb = 0; mb < 4; ++mb) { X[mb] = unpk4(yv[mb]);
#pragma unroll
                        for (int ks = 0; ks < 2; ++ks) X[mb] = __builtin_amdgcn_mfma_f32_16x16x32_bf16(fat[mb * 2 + ks], bS[ks], X[mb], 0, 0, 0); }
                    __builtin_amdgcn_sched_barrier(0);
                    bf16x8 fbh[8]; f32x4 gm[4]; v2u skv[4];
#pragma unroll
                    for (int f = 0; f < 6; ++f) ftt[f] = *(const LAS bf16x8*)(R + RO_TT + (f * 64 + F.lane) * 16);
#pragma unroll
                    for (int f = 0; f < 8; ++f) fbh[f] = *(const LAS bf16x8*)(R + RO_BH + (f * 64 + F.lane) * 16);
#pragma unroll
                    for (int kb = 0; kb < 4; ++kb) { gm[kb] = *(const LAS f32x4*)(R + RO_GAM + (16 * kb + 4 * fq) * 4); skv[kb] = *(const LAS v2u*)(R + 37120 + 2048 + (kb * 64 + F.lane) * 8); }
                    __builtin_amdgcn_sched_barrier(0);
                    bf16x8 bX[2]; bX[0] = pack_b(X[0], X[1]); bX[1] = pack_b(X[2], X[3]);
#pragma unroll
                    for (int mb = 0; mb < 4; ++mb) { U[mb] = z;
#pragma unroll
                        for (int ks = 0; ks < 2; ++ks) if (!(ks == 1 && mb < 2)) U[mb] = __builtin_amdgcn_mfma_f32_16x16x32_bf16(ftt[tri6(mb, ks)], bX[ks], U[mb], 0, 0, 0); }
                    bf16x8 bU[2]; bU[0] = pack_b(U[0], U[1]); bU[1] = pack_b(U[2], U[3]);
                    *(LAS bf16x8*)(EX + 2048 + F.lane * 16) = bU[0]; *(LAS bf16x8*)(EX + 3072 + F.lane * 16) = bU[1];
                    asm volatile("s_waitcnt lgkmcnt(0)" ::: "memory"); __builtin_amdgcn_sched_barrier(0);
#pragma unroll
                    for (int kb = 0; kb < 4; ++kb) { f32x4 n = S[kb] * gm[kb] + unpk4(skv[kb]);
#pragma unroll
                        for (int ks = 0; ks < 2; ++ks) n = __builtin_amdgcn_mfma_f32_16x16x32_bf16(fbh[kb * 2 + ks], bU[ks], n, 0, 0, 0);
                        S[kb] = n; }
                }
            } else {
                if (c >= 1 && c <= 64) {
                    const int co = c - 1; const LAS unsigned char* R = F.lds + (co % 3) * SLOT; const LAS unsigned char* EX = F.lds + EXO + (par ^ 1) * 4096;
                    bf16x8 fq_[8], fm[6];
#pragma unroll
                    for (int f = 0; f < 8; ++f) fq_[f] = *(const LAS bf16x8*)(R + RO_QH + (f * 64 + F.lane) * 16);
#pragma unroll
                    for (int f = 0; f < 6; ++f) fm[f] = *(const LAS bf16x8*)(R + RO_MRB + (f * 64 + F.lane) * 16);
                    const bf16x8 bS0 = *(const LAS bf16x8*)(EX + F.lane * 16), bS1 = *(const LAS bf16x8*)(EX + 1024 + F.lane * 16), bU0 = *(const LAS bf16x8*)(EX + 2048 + F.lane * 16), bU1 = *(const LAS bf16x8*)(EX + 3072 + F.lane * 16);
                    asm volatile("s_waitcnt lgkmcnt(0)" ::: "memory"); __builtin_amdgcn_sched_barrier(0);
                    f32x4 O[4];
#pragma unroll
                    for (int mb = 0; mb < 4; ++mb) { O[mb] = (f32x4){0.f, 0.f, 0.f, 0.f};
                        O[mb] = __builtin_amdgcn_mfma_f32_16x16x32_bf16(fq_[mb * 2], bS0, O[mb], 0, 0, 0);
                        O[mb] = __builtin_amdgcn_mfma_f32_16x16x32_bf16(fq_[mb * 2 + 1], bS1, O[mb], 0, 0, 0);
                        O[mb] = __builtin_amdgcn_mfma_f32_16x16x32_bf16(fm[tri6(mb, 0)], bU0, O[mb], 0, 0, 0);
                        if (mb >= 2) O[mb] = __builtin_amdgcn_mfma_f32_16x16x32_bf16(fm[tri6(mb, 1)], bU1, O[mb], 0, 0, 0); }
#pragma unroll
                    for (int mb = 0; mb < 4; ++mb)
#pragma unroll
                        for (int r = 0; r < 4; ++r) *(LAS bf16*)(OS + (16 * mb + 4 * fq + r) * 32 + fr * 2) = (bf16)f2bf(O[mb][r]);
                    asm volatile("s_waitcnt lgkmcnt(0)" ::: "memory");
                    { const v4u a_ = *(const LAS v4u*)(OS + F.lane * 32), b_ = *(const LAS v4u*)(OS + F.lane * 32 + 16); bf16* dst_ = Og_ + ((size_t)co * 64 + F.lane) * 16; *(GAS v4u*)dst_ = a_; *(GAS v4u*)(dst_ + 8) = b_; }
                    asm volatile("s_waitcnt lgkmcnt(0)" ::: "memory");
                }
            }
            LDS_BARRIER();
        }
    }
    __syncthreads();
}
__device__ __forceinline__ void phase_seq(Frame& F, int l) {
    for (int u = blockIdx.x; u < 112; u += F.G) {
        if (u < 64) { const int bh = u >> 2, vb = u & 3; seq_rw(F, bh >> 2, bh & 3, vb, F.ws + WS_REC_RW + (size_t)(bh * 64) * REC_RW); }
        else { const int v = u - 64, mm = v % 3, bh = v / 3; seq_unit<false>(F, mm == 2 ? 3 : mm, bh >> 2, bh & 3, 0, F.ws + WS_REC_GL + (size_t)((mm * 16 + bh) * 64) * REC_GL); }
    }
}
struct PostRaw { v4u o0, o1; v4u y0, y1; v4u x0, x1, x2, x3, x4, x5, x6, x7; };
__device__ __forceinline__ void post_load(Frame& F, PostRaw& R, int t, int m, int c0) {
    const bf16* P = WSP(const bf16, WS_P);
    const bf16* Ob = WSP(const bf16, WS_O) + (size_t)m * TOK * 256 + (size_t)t * 256 + c0;
    R.o0 = *(const GAS v4u*)(Ob); R.o1 = *(const GAS v4u*)(Ob + 8);
    { const int bb = t >> 12, tb = t & (SEQ - 1), hh = c0 >> 6, qq = (c0 >> 4) & 3; const bf16* oi = WSP(const bf16, WS_OI) + (m == 2 ? ((size_t)((bb * 4 + hh) * 4 + qq) * SEQ + tb) * 16 : OI_GEN + ((size_t)(((m == 3 ? 2 : m) * 16 + bb * 4 + hh)) * SEQ + tb) * 64 + 16 * qq);
      R.y0 = *(const GAS v4u*)oi; R.y1 = *(const GAS v4u*)(oi + 8); }
    const v4u zz = (v4u){0u, 0u, 0u, 0u}; R.x2 = zz; R.x3 = zz; R.x4 = zz; R.x5 = zz; R.x6 = zz; R.x7 = zz;
    if (m != 2) { const int gc = (m == 0 ? HG_G : m == 1 ? GL_R : RT_G) + c0; R.x0 = *(const GAS v4u*)(P + (size_t)t * NP + gc); R.x1 = *(const GAS v4u*)(P + (size_t)t * NP + gc + 8); }
    else { const size_t ob = (size_t)t * 256 + c0;
        R.x0 = *(const GAS v4u*)(WSP(const bf16, WS_RWR) + ob); R.x1 = *(const GAS v4u*)(WSP(const bf16, WS_RWR) + ob + 8); R.x2 = *(const GAS v4u*)(WSP(const bf16, WS_RWK) + ob); R.x3 = *(const GAS v4u*)(WSP(const bf16, WS_RWK) + ob + 8);
        R.x4 = *(const GAS v4u*)(WSP(const bf16, WS_RWV) + ob); R.x5 = *(const GAS v4u*)(WSP(const bf16, WS_RWV) + ob + 8); R.x6 = *(const GAS v4u*)(WSP(const bf16, WS_RWG) + ob); R.x7 = *(const GAS v4u*)(WSP(const bf16, WS_RWG) + ob + 8); }
}
__device__ __forceinline__ void unpack16(const v4u a, const v4u b, float (&f)[16]) { float x[8], y[8]; unpack8(a, x); unpack8(b, y);
#pragma unroll
    for (int j = 0; j < 8; ++j) { f[j] = x[j]; f[8 + j] = y[j]; } }
__device__ __forceinline__ void phase_post(Frame& F, int l) {
    const int gw = F.vcu * NWAVES + F.wave, NGW = F.G * NWAVES;
    const int m = F.lane >> 4, h = (F.lane >> 2) & 3, qd = F.lane & 3; const int c0 = 64 * h + 16 * qd;
    bf16* Y = WSP(bf16, WS_Y);
    PostRaw cur, nxt;
    if (gw < TOK) post_load(F, cur, gw, m, c0);
    for (int t = gw; t < TOK; t += NGW) {
        if (t + NGW < TOK) post_load(F, nxt, t + NGW, m, c0);
        float o[16], oi[16];
        unpack16(cur.o0, cur.o1, o);
        unpack16(cur.y0, cur.y1, oi);
        float s1 = 0.f, s2 = 0.f;
#pragma unroll
        for (int j = 0; j < 16; ++j) { o[j] += oi[j]; s1 += o[j]; s2 += o[j] * o[j]; }
        s1 = sum4(s1); s2 = sum4(s2);
        float y[16];
        if (m < 2) {
            const float rs = rsqrtf(s2 * (1.f / 64.f) + 1e-6f); const float* ng = INF(m == 0 ? 9 : 12) + l * 64 + 16 * qd;
            float g[16]; unpack16(cur.x0, cur.x1, g);
#pragma unroll
            for (int j = 0; j < 16; ++j) y[j] = o[j] * rs * ng[j] * (g[j] * sigm(g[j]));
        } else if (m == 2) {
            const float mean = s1 * (1.f / 64.f); float var = s2 * (1.f / 64.f) - mean * mean; var = fmaxf(var, 0.f); const float rs = rsqrtf(var + 64e-5f);
            float r[16], k[16], v[16], g[16]; unpack16(cur.x0, cur.x1, r); unpack16(cur.x2, cur.x3, k); unpack16(cur.x4, cur.x5, v); unpack16(cur.x6, cur.x7, g);
            const float* rk = INF(21) + l * 256 + c0; const float* lg = INF(22) + l * 256 + c0; const float* lb = INF(23) + l * 256 + c0;
            float bon = 0.f;
#pragma unroll
            for (int j = 0; j < 16; ++j) bon += r[j] * k[j] * rk[j];
            bon = sum4(bon);
#pragma unroll
            for (int j = 0; j < 16; ++j) y[j] = ((o[j] - mean) * rs * lg[j] + lb[j] + bon * v[j]) * g[j];
        } else {
            const float mean = s1 * (1.f / 64.f); float var = s2 * (1.f / 64.f) - mean * mean; var = fmaxf(var, 0.f); const float rs = rsqrtf(var + 1e-5f);
            float g[16]; unpack16(cur.x0, cur.x1, g);
#pragma unroll
            for (int j = 0; j < 16; ++j) y[j] = (g[j] * sigm(g[j])) * ((o[j] - mean) * rs);
        }
        v4u w0, w1; w0.x = pk2(y[0], y[1]); w0.y = pk2(y[2], y[3]); w0.z = pk2(y[4], y[5]); w0.w = pk2(y[6], y[7]); w1.x = pk2(y[8], y[9]); w1.y = pk2(y[10], y[11]); w1.z = pk2(y[12], y[13]); w1.w = pk2(y[14], y[15]);
        GAS v4u* yo = (GAS v4u*)(Y + (size_t)t * D + 256 * m + c0); yo[0] = w0; yo[1] = w1;
        cur = nxt;
    }
}
template <int MODE> struct LnRaw { f32x4 h[4]; v2u d1[4], d2[4]; float g1, g2; };
template <int MODE> __device__ __forceinline__ void ln_load(Frame& F, LnRaw<MODE>& R, int m) {
    const GAS f32x4* hr = (const GAS f32x4*)(F.h + (size_t)m * D) + F.lane;
#pragma unroll
    for (int j = 0; j < 4; ++j) R.h[j] = hr[64 * j];
    if (MODE == 0) { const GAS v2u* ar = (const GAS v2u*)(WSP(const bf16, WS_MIX) + (size_t)m * D) + F.lane;
#pragma unroll
        for (int j = 0; j < 4; ++j) R.d1[j] = ar[64 * j]; }
    else { const bf16* DOUT = WSP(const bf16, WS_DOUT); const float* GATE = WSP(const float, WS_GATE); R.g1 = GATE[2 * m]; R.g2 = GATE[2 * m + 1];
#pragma unroll
        for (int j = 0; j < 4; ++j) { R.d1[j] = ((const GAS v2u*)(DOUT + (size_t)(2 * m) * D))[F.lane + 64 * j]; R.d2[j] = ((const GAS v2u*)(DOUT + (size_t)(2 * m + 1) * D))[F.lane + 64 * j]; } }
}
template <int MODE, bool ROUTE> __device__ __forceinline__ void phase_ln(Frame& F, const float* gw_, const float* bw_, const float* router, int mi) {
    const int gw = F.vcu * NWAVES + F.wave, NGW = F.G * NWAVES;
    bf16* hb = WSP(bf16, WS_HB); float* GATE = WSP(float, WS_GATE);
    LAS float* RT = (LAS float*)F.lds;
    if (ROUTE) { for (int i = F.tid; i < D * NE; i += NWAVES * 64) RT[(i & 7) * D + (i >> 3)] = router[i]; __syncthreads(); }
    f32x4 gv[4], bv[4];
#pragma unroll
    for (int j = 0; j < 4; ++j) { gv[j] = ((const GAS f32x4*)gw_)[F.lane + 64 * j]; bv[j] = ((const GAS f32x4*)bw_)[F.lane + 64 * j]; }
    LnRaw<MODE> cur, nxt;
    if (gw < TOK) ln_load<MODE>(F, cur, gw);
    for (int m = gw; m < TOK; m += NGW) {
        if (m + NGW < TOK) ln_load<MODE>(F, nxt, m + NGW);
        GAS f32x4* hr = (GAS f32x4*)(F.h + (size_t)m * D) + F.lane;
        f32x4 v[4]; float s = 0.f;
#pragma unroll
        for (int j = 0; j < 4; ++j) {
            f32x4 a;
            if (MODE == 0) { const v2u d1 = cur.d1[j]; a = (f32x4){bflo(d1.x), bfhi(d1.x), bflo(d1.y), bfhi(d1.y)}; }
            else { const v2u d1 = cur.d1[j], d2 = cur.d2[j]; const float g1 = cur.g1, g2 = cur.g2;
                a.x = g1 * bflo(d1.x) + g2 * bflo(d2.x); a.y = g1 * bfhi(d1.x) + g2 * bfhi(d2.x); a.z = g1 * bflo(d1.y) + g2 * bflo(d2.y); a.w = g1 * bfhi(d1.y) + g2 * bfhi(d2.y); }
            v[j] = cur.h[j] * DN_ALPHA + a; s += (v[j].x + v[j].y) + (v[j].z + v[j].w); }
        const float mean = wave_sum(s) * (1.f / D); float s2 = 0.f;
#pragma unroll
        for (int j = 0; j < 4; ++j) { v[j] = v[j] - mean; s2 += (v[j].x * v[j].x + v[j].y * v[j].y) + (v[j].z * v[j].z + v[j].w * v[j].w); }
        const float rstd = 1.f / sqrtf(wave_sum(s2) * (1.f / D) + 1e-5f);
        GAS v2u* o8 = (GAS v2u*)(hb + (size_t)m * D) + F.lane;
#pragma unroll
        for (int j = 0; j < 4; ++j) { v[j] = v[j] * rstd * gv[j] + bv[j]; hr[64 * j] = v[j]; v2u w; w.x = pk2(v[j].x, v[j].y); w.y = pk2(v[j].z, v[j].w); o8[64 * j] = w; }
        if (ROUTE) {
            float lg[8];
#pragma unroll
            for (int e = 0; e < 8; ++e) { float a = 0.f;
#pragma unroll
                for (int j = 0; j < 4; ++j) { const f32x4 r = *(const LAS f32x4*)(RT + e * D + 4 * (F.lane + 64 * j)); a += (v[j].x * r.x + v[j].y * r.y) + (v[j].z * r.z + v[j].w * r.w); }
                lg[e] = wave_sum(a); }
            int e1 = 0; float l1 = lg[0];
#pragma unroll
            for (int e = 1; e < 8; ++e) if (lg[e] > l1) { l1 = lg[e]; e1 = e; }
            int e2 = -1; float l2 = -3.0e38f;
#pragma unroll
            for (int e = 0; e < 8; ++e) if (e != e1 && lg[e] > l2) { l2 = lg[e]; e2 = e; }
            if (F.lane == 0) {
                const float p2 = __expf(l2 - l1); const float ga = 1.f / (1.f + p2);
                GATE[2 * m] = ga; GATE[2 * m + 1] = p2 * ga;
                int* list = WSP(int, WS_LIST) + (size_t)mi * NE * TOK;
                const unsigned p1 = __hip_atomic_fetch_add((unsigned*)(F.ctl + CW_CNT + (mi * 8 + e1) * 64), 1u, RLX_AGENT); list[e1 * TOK + p1] = 2 * m;
                const unsigned q2 = __hip_atomic_fetch_add((unsigned*)(F.ctl + CW_CNT + (mi * 8 + e2) * 64), 1u, RLX_AGENT); list[e2 * TOK + q2] = 2 * m + 1;
            }
        }
        cur = nxt;
    }
}
__device__ __forceinline__ void phase_gather(Frame& F, int mi) {
    int cnt[8], poff[9]; poff[0] = 0;
    unsigned* cb_ = (unsigned*)(F.ctl + CW_CNT + mi * 8 * 64); asm volatile("" : "+s"(cb_));
#pragma unroll
    for (int e = 0; e < 8; ++e) { cnt[e] = (int)__hip_atomic_load(cb_ + e * 64, RLX_AGENT); poff[e + 1] = poff[e] + ((cnt[e] + 255) >> 8); }
    const int npan = poff[8];
    int* tab = WSP(int, WS_TAB) + mi * TAB_STRIDE;
    if (blockIdx.x == 0) {
        for (int P = F.tid; P < npan; P += NWAVES * 64) { int e = 0, pe = 0, ce = cnt[0];
#pragma unroll
            for (int j = 1; j < 8; ++j) if (P >= poff[j]) { e = j; pe = poff[j]; ce = cnt[j]; }
            tab[4 * P] = e; tab[4 * P + 1] = 256 * (P - pe); tab[4 * P + 2] = ce; tab[4 * P + 3] = 0; }
        if (F.tid == 0) tab[640] = npan;
    }
    const int gw = F.vcu * NWAVES + F.wave, NGW = F.G * NWAVES;
    const int* list = WSP(const int, WS_LIST) + (size_t)mi * NE * TOK; const bf16* hb = WSP(const bf16, WS_HB); bf16* HP = WSP(bf16, WS_HPERM);
    for (int row = gw; row < 256 * npan; row += NGW) { const int P = row >> 8; int e = 0, pe = 0, ce = cnt[0];
#pragma unroll
        for (int j = 1; j < 8; ++j) if (P >= poff[j]) { e = j; pe = poff[j]; ce = cnt[j]; }
        const int r = row - 256 * pe; const int tok = (r < ce) ? (list[e * TOK + r] >> 1) : 0;
        const GAS v4u* s = (const GAS v4u*)(hb + (size_t)tok * D) + F.lane; GAS v4u* d = (GAS v4u*)(HP + (size_t)row * D) + F.lane; d[0] = s[0]; d[64] = s[64]; }
}
struct Args { const void* in[34]; float* out; unsigned char* ws; int ph_lo, ph_hi; };
__global__ void __launch_bounds__(NWAVES * 64, 2) mk_fwd(Args args) {
    extern __shared__ __attribute__((aligned(16))) unsigned char lds[];
    Frame F;
    F.lds = (LAS unsigned char*)lds;
    F.MISC = (volatile LAS unsigned*)(F.lds + MISC_OFF);
    F.tid = threadIdx.x; F.lane = F.tid & 63; F.wave = __builtin_amdgcn_readfirstlane(F.tid >> 6);
    F.G = gridDim.x; { const int bx = blockIdx.x; F.vcu = (F.G % 8 == 0) ? (bx % 8) * (F.G / 8) + bx / 8 : bx; }
    F.ws = args.ws; F.in = args.in; F.h = args.out;
    F.ctl = (gu32*)(args.ws + WS_CTL);
    for (int u = F.tid; u < (LDS_BYTES - LDSCTL_OFF) / 4; u += NWAVES * 64) ((LAS unsigned*)(F.lds + LDSCTL_OFF))[u] = 0u;
    __syncthreads();
    XcdBarrier bar; bar.bar = (unsigned*)(F.ctl + CW_BAR); bar.x = 0; bar.st = nullptr;
    if (!MK_PER_PHASE) bar = xcd_barrier_post((unsigned*)(F.ctl + CW_BAR), F.MISC + 8);
    const int lo = args.ph_lo, hi = args.ph_hi;
#define IN(k) (lo <= (k) && (k) < hi)
#define PHASE_BEGIN() do { int t_ = threadIdx.x; asm volatile("" : "+v"(t_)); F.tid = t_; F.lane = t_ & 63; F.wave = __builtin_amdgcn_readfirstlane(t_ >> 6); } while (0)
#define SEAM(k) do { if (IN(k) && IN((k) + 1)) { xcd_barrier(bar); if (DUPMASK & 4096) xcd_barrier(bar); } } while (0)
    for (int l = 0; l < DEPTH; ++l) {
        const int pb = l * NPH; const bool moe = (l & 1); const int mi = l >> 1;
#define PH(k) (((PHMASK >> (k)) & 1) && IN(pb + (k)))
        if (l == 0) { if (PH(0)) { PHASE_BEGIN(); phase_weights<0>(F, 0); } SEAM(pb + 0); }
        if (PH(1)) for (int rep_ = 0; rep_ < (((DUPMASK >> 1) & 1) ? 2 : 1); ++rep_) { PHASE_BEGIN(); if (rep_) __syncthreads();
            pg8::Gemm g{WSP(const bf16, WS_HB), WSP(const bf16, WS_WIN), TOK, NP, D}; pg8::StaticOrder S; S.init(TOK, NP, F.G, (int)blockIdx.x);
            pg8::EpiBf16 E{WSP(bf16, WS_P), NP};
            pg8::gemm_phase<pg8::EpiBf16, pg8::StaticOrder, true, true>(F.lds, g, S, E);
        } SEAM(pb + 1);
        if (PH(3)) { PHASE_BEGIN(); phase_chunkpre(F, l); if (DUPMASK & 8) { __syncthreads(); phase_chunkpre(F, l); } } SEAM(pb + 3);
        if (PH(4)) { PHASE_BEGIN(); phase_seq(F, l); if (DUPMASK & 16) { __syncthreads(); phase_seq(F, l); } } SEAM(pb + 4);
        if (PH(5)) { PHASE_BEGIN(); phase_post(F, l); __syncthreads(); phase_weights<1>(F, l); if (DUPMASK & 32) { __syncthreads(); phase_weights<1>(F, l); } } SEAM(pb + 5);
        if (PH(6)) for (int rep_ = 0; rep_ < (((DUPMASK >> 6) & 1) ? 2 : 1); ++rep_) { PHASE_BEGIN(); if (rep_) __syncthreads();
            pg8::Gemm g{WSP(const bf16, WS_Y), WSP(const bf16, WS_WOUT), TOK, D, D}; pg8::StaticOrder S; S.init(TOK, D, F.G, (int)blockIdx.x);
            pg8::EpiBf16 E{WSP(bf16, WS_MIX), D};
            pg8::gemm_phase<pg8::EpiBf16, pg8::StaticOrder, false, true>(F.lds, g, S, E);
        } SEAM(pb + 6);
        if (PH(7)) { PHASE_BEGIN();
            if (moe) phase_ln<0, true>(F, INF(4) + l * D, INF(5) + l * D, INF(30) + (size_t)mi * D * NE, mi);
            else phase_ln<0, false>(F, INF(4) + l * D, INF(5) + l * D, nullptr, 0);
        } SEAM(pb + 7);
        if (PH(9)) for (int rep_ = 0; rep_ < (((DUPMASK >> 9) & 1) ? 2 : 1); ++rep_) { PHASE_BEGIN(); if (rep_) __syncthreads();
            if (!moe) { pg8::Gemm g{WSP(const bf16, WS_HB), WSP(const bf16, WS_WUP), TOK, 2 * FFD, D}; pg8::StaticOrder S; S.init(TOK, 2 * FFD, F.G, (int)blockIdx.x);
                pg8::EpiSwiGLU E{WSP(bf16, WS_HID), FFD, 22};
                pg8::gemm_phase<pg8::EpiSwiGLU, pg8::StaticOrder, true, true>(F.lds, g, S, E);
            } else { pg8::MoeOrder<true> S; S.M.init((const unsigned*)(F.ctl + CW_CNT + mi * 8 * 64), WSP(const int, WS_LIST) + (size_t)mi * NE * TOK); const int npan = S.M.poff[8];
                S.tpg = 11; S.G = F.G; S.c = (int)blockIdx.x; S.nunits = npan * 11; S.rowbytes = D * 2;
                pg8::Gemm g{WSP(const bf16, WS_HB), WSP(const bf16, WS_WUP), 256 * npan, 2 * FFE, D};
                pg8::EpiSwiGLU E{WSP(bf16, WS_HID), FFE, 11};
                pg8::gemm_phase<pg8::EpiSwiGLU, pg8::MoeOrder<true>, true, true>(F.lds, g, S, E);
            }
        } SEAM(pb + 9);
        if (PH(10)) for (int rep_ = 0; rep_ < (((DUPMASK >> 10) & 1) ? 2 : 1); ++rep_) { PHASE_BEGIN(); if (rep_) __syncthreads();
            if (!moe) { pg8::Gemm g{WSP(const bf16, WS_HID), WSP(const bf16, WS_WDN), TOK, D, FFD}; pg8::StaticOrder S; S.init(TOK, D, F.G, (int)blockIdx.x);
                pg8::EpiBf16 E{WSP(bf16, WS_MIX), D};
                pg8::gemm_phase<pg8::EpiBf16, pg8::StaticOrder, false, true>(F.lds, g, S, E);
            } else { pg8::MoeOrder<false> S; S.M.init((const unsigned*)(F.ctl + CW_CNT + mi * 8 * 64), WSP(const int, WS_LIST) + (size_t)mi * NE * TOK); const int npan = S.M.poff[8];
                S.tpg = 4; S.G = F.G; S.c = (int)blockIdx.x; S.nunits = npan * 4; S.rowbytes = 0;
                pg8::Gemm g{WSP(const bf16, WS_HID), WSP(const bf16, WS_WDN), 256 * npan, D, FFE};
                pg8::EpiScatter E{WSP(bf16, WS_DOUT), S.M};
                pg8::gemm_phase<pg8::EpiScatter, pg8::MoeOrder<false>, true, true>(F.lds, g, S, E);
            }
        } SEAM(pb + 10);
        if (PH(11)) { PHASE_BEGIN();
            if (moe) phase_ln<1, false>(F, INF(6) + l * D, INF(7) + l * D, nullptr, 0);
            else phase_ln<0, false>(F, INF(6) + l * D, INF(7) + l * D, nullptr, 0);
            if (l + 1 < DEPTH) { __syncthreads(); phase_weights<0>(F, l + 1); }
        } SEAM(pb + 11);
#undef PH
    }
#undef IN
#undef SEAM
}

extern "C" void kernel_launch(void* const* d_in, const int* in_sizes, int n_in, void* d_out, int out_size, void* d_ws, size_t ws_size, hipStream_t stream) {
    static int grid = 0;
    if (grid == 0) {
        if (n_in != 34 || out_size != TOK * D || ws_size < WS_END) { fprintf(stderr, "kernel_launch: unexpected shapes (n_in %d, out %d, ws %zu)\n", n_in, out_size, ws_size); grid = -1; return; }
        int dev = 0, cus = 0, per_cu = 0;
        if (hipGetDevice(&dev) != hipSuccess || hipDeviceGetAttribute(&cus, hipDeviceAttributeMultiprocessorCount, dev) != hipSuccess) { grid = -1; return; }
        if (hipFuncSetAttribute((const void*)mk_fwd, hipFuncAttributeMaxDynamicSharedMemorySize, LDS_BYTES) != hipSuccess) { fprintf(stderr, "kernel_launch: hipFuncSetAttribute failed\n"); grid = -1; return; }
        if (hipOccupancyMaxActiveBlocksPerMultiprocessor(&per_cu, (const void*)mk_fwd, NWAVES * 64, LDS_BYTES) != hipSuccess || per_cu < 1) fprintf(stderr, "kernel_launch: occupancy query reports %d\n", per_cu);
        (void)hipGetLastError();
        grid = cus;
    }
    if (grid < 0) return;
    if (hipMemsetAsync((char*)d_ws + WS_CTL, 0, CTL_ZERO_BYTES, stream) != hipSuccess) return;
    Args a{};
    for (int i = 0; i < 34; ++i) a.in[i] = d_in[i];
    a.out = (float*)d_out; a.ws = (unsigned char*)d_ws;
#if MK_PER_PHASE
    for (int p = 0; p < NPHASES; ++p) { a.ph_lo = p; a.ph_hi = p + 1; hipLaunchKernelGGL(mk_fwd, dim3(grid), dim3(NWAVES * 64), LDS_BYTES, stream, a); }
#else
    a.ph_lo = 0; a.ph_hi = NPHASES; hipLaunchKernelGGL(mk_fwd, dim3(grid), dim3(NWAVES * 64), LDS_BYTES, stream, a);
#endif
}
```

```cpp
#include <hip/hip_runtime.h>
#include <cstdio>
#include <cstdint>
#ifndef PHMASK
#define PHMASK 0xfff
#endif
#ifndef DUPMASK
#define DUPMASK 0
#endif
#ifndef MK_PER_PHASE
#define MK_PER_PHASE 0
#endif
__device__ __forceinline__ int lane_id_now() { unsigned m_ = ~0u; asm volatile("" : "+s"(m_)); return (int)__builtin_amdgcn_mbcnt_hi(m_, __builtin_amdgcn_mbcnt_lo(m_, 0u)); }
namespace pg8 {
#define PG8_LAS __attribute__((address_space(3)))
typedef unsigned short bf16_t;
typedef short bf16x8 __attribute__((ext_vector_type(8)));
typedef float f32x4 __attribute__((ext_vector_type(4)));
typedef unsigned u32x4 __attribute__((ext_vector_type(4)));
constexpr int BM = 256, BK = 64, HALF = 128, HTB = HALF * BK * 2  , STAGE_BYTES = 8 * HTB, NXCD = 8, WGM = 8;

__host__ __device__ __forceinline__ int lds_byte(int r, int c) { const int st = (r >> 4) * 2 + (c >> 5), rr = r & 15, cc = c & 31, ob = rr * 64 + cc * 2; return st * 1024 + (ob ^ (((ob >> 9) & 1) << 5)); }
__host__ __device__ __forceinline__ void stage_rc(int b, int& R, int& C) { const int st = b / 1024, sb = b % 1024, swz = sb ^ (((sb >> 9) & 1) << 5); R = (st >> 1) * 16 + swz / 64; C = (st & 1) * 32 + (swz % 64) / 2; }
__host__ __device__ __forceinline__ int perm32(int rho) { const int n = rho >> 4, i = rho & 15; return 8 * (i >> 2) + 4 * n + (i & 3); }

struct Unit { int pm, pn; };
struct Gemm { const bf16_t* A; const bf16_t* Bt; int M, N, K; };

struct StaticOrder {
    static constexpr bool GATHER = false;
    int nM, nN, nwg, G, c;
    __device__ __forceinline__ unsigned a_off(const Unit&, int) const { return 0u; }
    __host__ __device__ void init(int M, int N, int G_, int c_) { nM = M / BM; nN = N / BM; nwg = nM * nN; G = G_; c = c_; }
    __host__ __device__ bool next(int i, Unit& u) const {
        const long L = (long)i * G + c; if (L >= nwg) return false;
        int wgid = (int)L; { const int q = nwg / NXCD, r = nwg % NXCD, xcd = wgid % NXCD, off = wgid / NXCD; wgid = (xcd < r ? xcd * (q + 1) : r * (q + 1) + (xcd - r) * q) + off; }
        const int nig = WGM * nN, gid = wgid / nig, fm = gid * WGM, gsz = (nM - fm) < WGM ? (nM - fm) : WGM;
        u.pm = fm + ((wgid % nig) % gsz); u.pn = (wgid % nig) / gsz; return true;
    }
    __device__ __forceinline__ void a_ready(const Unit&) const {}
    __device__ __forceinline__ void done(const Unit&) const {}
};
__device__ __forceinline__ unsigned cvt_pk_bf16(float lo, float hi) { unsigned r; asm volatile("v_cvt_pk_bf16_f32 %0, %1, %2" : "=v"(r) : "v"(lo), "v"(hi)); return r; }
typedef float f32x2 __attribute__((ext_vector_type(2)));
struct EpiBf16 {
    static constexpr bool PERM = true, AFTER_DRAIN = false;
    bf16_t* O; int ldc;
    __device__ __forceinline__ void operator()(const f32x4 (&acc)[2][2][4][2], const Unit& u, int wr, int wc, int fr, int fq) const {
        const int row0 = u.pm * BM + wr * 64 + fr; const int col0 = u.pn * BM + wc * 32 + 8 * fq;
#pragma unroll
        for (int ai = 0; ai < 2; ++ai)
#pragma unroll
            for (int m = 0; m < 4; ++m) { bf16_t* rowp = O + (size_t)(row0 + ai * HALF + m * 16) * ldc + col0;
#pragma unroll
                for (int bj = 0; bj < 2; ++bj) { const f32x4 v0 = acc[ai][bj][m][0], v1 = acc[ai][bj][m][1];
                    u32x4 w; w.x = cvt_pk_bf16(v0[0], v0[1]); w.y = cvt_pk_bf16(v0[2], v0[3]); w.z = cvt_pk_bf16(v1[0], v1[1]); w.w = cvt_pk_bf16(v1[2], v1[3]);
                    *(u32x4*)(rowp + bj * HALF) = w; } }
    }
};
struct EpiF32 {
    static constexpr bool PERM = false, AFTER_DRAIN = false;
    float* C; int ldc;
    __device__ __forceinline__ void operator()(const f32x4 (&acc)[2][2][4][2], const Unit& u, int wr, int wc, int fr, int fq) const {
        const int row0 = u.pm * BM + wr * 64 + fr, col0 = u.pn * BM + wc * 32 + 4 * fq;
#pragma unroll
        for (int ai = 0; ai < 2; ++ai)
#pragma unroll
            for (int m = 0; m < 4; ++m) { float* rowp = C + (size_t)(row0 + ai * HALF + m * 16) * ldc + col0;
#pragma unroll
                for (int bj = 0; bj < 2; ++bj)
#pragma unroll
                    for (int n = 0; n < 2; ++n) *(f32x4*)(rowp + bj * HALF + n * 16) = acc[ai][bj][m][n]; }
    }
};
__device__ __forceinline__ float silu_f(float x) { return x * __builtin_amdgcn_rcpf(1.0f + __expf(-x)); }
struct EpiSwiGLU {
    static constexpr bool PERM = true, AFTER_DRAIN = false;
    bf16_t* O; int ldc; int tiles_per_group;
    __device__ __forceinline__ void operator()(const f32x4 (&acc)[2][2][4][2], const Unit& u, int wr, int wc, int fr, int fq) const {
        const int row0 = u.pm * BM + wr * 64 + fr; const int pnl = u.pn % tiles_per_group; const int col0 = pnl * HALF + wc * 32 + 8 * fq;
#pragma unroll
        for (int ai = 0; ai < 2; ++ai)
#pragma unroll
            for (int m = 0; m < 4; ++m) { bf16_t* rowp = O + (size_t)(row0 + ai * HALF + m * 16) * ldc + col0;
                float h[8];
#pragma unroll
                for (int n = 0; n < 2; ++n)
#pragma unroll
                    for (int j = 0; j < 4; ++j) h[4 * n + j] = silu_f(acc[ai][0][m][n][j]) * acc[ai][1][m][n][j];
                u32x4 w; w.x = cvt_pk_bf16(h[0], h[1]); w.y = cvt_pk_bf16(h[2], h[3]); w.z = cvt_pk_bf16(h[4], h[5]); w.w = cvt_pk_bf16(h[6], h[7]);
                *(u32x4*)rowp = w; }
    }
};
struct MoeMap {
    int cnt[8], poff[9]; const int* list;
    __device__ __forceinline__ void init(const unsigned* counters, const int* list_) { list = list_; poff[0] = 0;
#pragma unroll
        for (int e = 0; e < 8; ++e) { cnt[e] = (int)__hip_atomic_load(counters + e * 64, __ATOMIC_RELAXED, __HIP_MEMORY_SCOPE_AGENT); poff[e + 1] = poff[e] + ((cnt[e] + 255) >> 8); } }
    __device__ __forceinline__ void locate(int P, int& e, int& lr, int& ce) const { e = 0; int pe = 0; ce = cnt[0];
#pragma unroll
        for (int j = 1; j < 8; ++j) if (P >= poff[j]) { e = j; pe = poff[j]; ce = cnt[j]; }
        lr = 256 * (P - pe); }
};
struct EpiScatter {
    static constexpr bool PERM = true, AFTER_DRAIN = false;
    bf16_t* O; MoeMap M;
    __device__ __forceinline__ void operator()(const f32x4 (&acc)[2][2][4][2], const Unit& u, int wr, int wc, int fr, int fq) const {
        int e, lr, cnt; M.locate(u.pm, e, lr, cnt);
        const int pnl = u.pn & 3; const int col0 = pnl * BM + wc * 32 + 8 * fq; const int* lst = M.list + e * 16384;
#pragma unroll
        for (int ai = 0; ai < 2; ++ai)
#pragma unroll
            for (int m = 0; m < 4; ++m) { const int r = lr + wr * 64 + fr + ai * HALF + m * 16;
                if (r < cnt) { const int slot = lst[r]; bf16_t* rowp = O + (size_t)slot * 1024 + col0;
#pragma unroll
                    for (int bj = 0; bj < 2; ++bj) { const f32x4 v0 = acc[ai][bj][m][0], v1 = acc[ai][bj][m][1];
                        u32x4 w; w.x = cvt_pk_bf16(v0[0], v0[1]); w.y = cvt_pk_bf16(v0[2], v0[3]); w.z = cvt_pk_bf16(v1[0], v1[1]); w.w = cvt_pk_bf16(v1[2], v1[3]);
                        *(u32x4*)(rowp + bj * HALF) = w; } } }
    }
};
template <bool GATHER_> struct MoeOrder {
    static constexpr bool GATHER = GATHER_;
    MoeMap M; int tpg, G, c, nunits; unsigned rowbytes;
    __device__ __forceinline__ bool next(int i, Unit& u) const {
        const int L = i * G + c; if (L >= nunits) return false;
        int wgid = L; { const int q = nunits / NXCD, r = nunits % NXCD, xcd = wgid % NXCD, off = wgid / NXCD; wgid = (xcd < r ? xcd * (q + 1) : r * (q + 1) + (xcd - r) * q) + off; }
        const int P = wgid / tpg, pnl = wgid - P * tpg; int e, lr, ce; M.locate(P, e, lr, ce);
        u.pm = P; u.pn = e * tpg + pnl; return true;
    }
    __device__ __forceinline__ unsigned a_off(const Unit& u, int row) const {
        int e, lr, ce; M.locate(u.pm, e, lr, ce); const int r = lr + row; const int tok = (r < ce) ? (M.list[e * 16384 + r] >> 1) : 0; return (unsigned)tok * rowbytes; }
    __device__ __forceinline__ void a_ready(const Unit&) const {}
    __device__ __forceinline__ void done(const Unit&) const {}
};
template <class Epi, class Sched, bool ALIGN_EPI = false, bool SP2 = false>
__device__ __forceinline__ void gemm_phase(PG8_LAS unsigned char* lds, const Gemm g, const Sched& S, const Epi& E, const int wave_in) {
    int tid_ = wave_in * 64 + lane_id_now(); asm volatile("" : "+v"(tid_));
    const int tid = tid_, wid = __builtin_amdgcn_readfirstlane(tid >> 6), lane = tid & 63, wr = wid >> 2, wc = wid & 3, fr = lane & 15, fq = lane >> 4;
    const int K = g.K, nt = K / BK;
    unsigned voffA[2], voffB[2];
#pragma unroll
    for (int i = 0; i < 2; ++i) { int R, C; stage_rc(tid * 16 + i * 8192, R, C); const int Rb = Epi::PERM ? ((R & ~31) + perm32(R & 31)) : R;
        voffA[i] = (unsigned)(R * K + C) * 2u; voffB[i] = (unsigned)(Rb * K + C) * 2u; }
    static_assert(!Sched::GATHER || SP2, "A-row gather is implemented for the SP2 loop");
    unsigned aoc[2][2], aon[2][2];
#define PG8_GOFF(dst, u) do { _Pragma("unroll") for (int _i = 0; _i < 2; ++_i) { int R_, C_; stage_rc(tid * 16 + _i * 8192, R_, C_); _Pragma("unroll") for (int _h = 0; _h < 2; ++_h) dst[_h][_i] = S.a_off(u, _h * HALF + R_) + (unsigned)(C_ * 2); } } while (0)
#define PG8_STAGE_A(bufoff, gbase, kofs, h, nx) do { if constexpr (Sched::GATHER) { const unsigned vo_[2] = {(nx) ? aon[h][0] : aoc[h][0], (nx) ? aon[h][1] : aoc[h][1]}; PG8_STAGE(bufoff, (const char*)g.A + (kofs), vo_); } else { PG8_STAGE(bufoff, gbase, voffA); } } while (0)
    const size_t kstep = (size_t)(BK * 2);
    const size_t hstep = (size_t)HALF * K * 2;
    const size_t tstep = 2 * hstep;
    const unsigned ldsw = (unsigned)wid * 1024u;
    const int aoff = lds_byte(wr * 64 + fr, fq * 8), boff = lds_byte(wc * 32 + fr, fq * 8);
#define PG8_SA(b, h) (((b) * 2 + (h)) * HTB)
#define PG8_SB(b, h) ((4 + (b) * 2 + (h)) * HTB)
#define PG8_STAGE(bufoff, gbase, voff) do { _Pragma("unroll") for (int _i = 0; _i < 2; ++_i) \
        __builtin_amdgcn_global_load_lds((const unsigned*)((const char*)(gbase) + (voff)[_i]), (PG8_LAS unsigned*)(lds + (bufoff) + ldsw + _i * 8192), 16, 0, 0); } while (0)
#define PG8_LDA(dst, b, h) do { _Pragma("unroll") for (int m = 0; m < 4; ++m) _Pragma("unroll") for (int k = 0; k < 2; ++k) dst[m][k] = *(const PG8_LAS bf16x8*)(lds + PG8_SA(b, h) + aoff + m * 2048 + k * 1024); } while (0)
#define PG8_LDB(dst, b, h) do { _Pragma("unroll") for (int n = 0; n < 2; ++n) _Pragma("unroll") for (int k = 0; k < 2; ++k) dst[n][k] = *(const PG8_LAS bf16x8*)(lds + PG8_SB(b, h) + boff + n * 2048 + k * 1024); } while (0)
#define PG8_MMA(ai, bj, At, Bt) do { __builtin_amdgcn_s_setprio(1); _Pragma("unroll") for (int m = 0; m < 4; ++m) _Pragma("unroll") for (int n = 0; n < 2; ++n) _Pragma("unroll") for (int k = 0; k < 2; ++k) \
        acc[ai][bj][m][n] = __builtin_amdgcn_mfma_f32_16x16x32_bf16(Bt[n][k], At[m][k], acc[ai][bj][m][n], 0, 0, 0); __builtin_amdgcn_s_setprio(0); } while (0)
#define PG8_WAIT_V(n) asm volatile("s_waitcnt vmcnt(" #n ")" ::: "memory")
#define PG8_WAIT_L(n) asm volatile("s_waitcnt lgkmcnt(" #n ")" ::: "memory")
#define PG8_BAR __builtin_amdgcn_s_barrier()
#define PG8_SCHED __builtin_amdgcn_sched_barrier(0)
    Unit cur, nxt; int ui = 0;
    if (!S.next(0, cur)) return;
    f32x4 acc[2][2][4][2];
#pragma unroll
    for (int a = 0; a < 2; ++a)
#pragma unroll
        for (int b = 0; b < 2; ++b)
#pragma unroll
            for (int m = 0; m < 4; ++m)
#pragma unroll
                for (int n = 0; n < 2; ++n) acc[a][b][m][n] = (f32x4){0.f, 0.f, 0.f, 0.f};
    bf16x8 At[4][2], B0[2][2], B1[2][2];
    const char* cA = (const char*)g.A + (size_t)cur.pm * tstep; const char* cB = (const char*)g.Bt + (size_t)cur.pn * tstep;
    S.a_ready(cur);
    if constexpr (SP2) {
        if constexpr (Sched::GATHER) { PG8_GOFF(aoc, cur); }
        PG8_STAGE(PG8_SB(0, 0), cB, voffB); PG8_STAGE(PG8_SB(0, 1), cB + hstep, voffB); PG8_STAGE_A(PG8_SA(0, 0), cA, (size_t)0, 0, false); PG8_STAGE_A(PG8_SA(0, 1), cA + hstep, (size_t)0, 1, false);
        if (wr == 1) PG8_BAR;
        PG8_WAIT_V(2); PG8_BAR;
        PG8_STAGE(PG8_SB(1, 0), cB + kstep, voffB); PG8_STAGE_A(PG8_SA(1, 0), cA + kstep, kstep, 0, false); PG8_STAGE(PG8_SB(1, 1), cB + hstep + kstep, voffB);
        PG8_WAIT_V(6); PG8_BAR;
    } else {
        PG8_STAGE(PG8_SB(0, 0), cB, voffB); PG8_STAGE(PG8_SA(0, 0), cA, voffA); PG8_STAGE(PG8_SB(0, 1), cB + hstep, voffB); PG8_STAGE(PG8_SA(0, 1), cA + hstep, voffA);
        if (wr == 1) PG8_BAR;
        PG8_WAIT_V(4); PG8_BAR;
        PG8_STAGE(PG8_SB(1, 0), cB + kstep, voffB); PG8_STAGE(PG8_SA(1, 0), cA + kstep, voffA); PG8_STAGE(PG8_SB(1, 1), cB + hstep + kstep, voffB);
        PG8_WAIT_V(6); PG8_BAR;
    }
    for (;;) {
        const bool has_next = S.next(ui + 1, nxt);
        const char* nA = has_next ? (const char*)g.A + (size_t)nxt.pm * tstep : cA; const char* nB = has_next ? (const char*)g.Bt + (size_t)nxt.pn * tstep : cB;
        for (int t = 0; t < nt; t += 2) {
            const bool last = (t == nt - 2);
            const char* a1 = cA + (size_t)(t + 1) * kstep;
            const char* a2 = last ? nA : cA + (size_t)(t + 2) * kstep; const char* b2 = last ? nB : cB + (size_t)(t + 2) * kstep;
            const char* a3 = a2 + kstep; const char* b3 = b2 + kstep;
            if (last && has_next) S.a_ready(nxt);
            const size_t ko2 = last ? (size_t)0 : (size_t)(t + 2) * kstep;
            if constexpr (Sched::GATHER) { if (last) { if (has_next) { PG8_GOFF(aon, nxt); } else { _Pragma("unroll") for (int _h = 0; _h < 2; ++_h) { aon[_h][0] = aoc[_h][0]; aon[_h][1] = aoc[_h][1]; } } } }
            if constexpr (SP2) {
            PG8_LDB(B0, 0, 0); PG8_LDB(B1, 0, 1); PG8_SCHED; PG8_LDA(At, 0, 0); PG8_STAGE_A(PG8_SA(1, 1), a1 + hstep, (size_t)(t + 1) * kstep, 1, false);
            PG8_WAIT_V(8); PG8_WAIT_L(0); PG8_BAR; PG8_MMA(0, 0, At, B0); PG8_MMA(0, 1, At, B1); PG8_BAR; PG8_SCHED;
            PG8_LDA(At, 0, 1); PG8_STAGE(PG8_SB(0, 0), b2, voffB); PG8_STAGE(PG8_SB(0, 1), b2 + hstep, voffB); PG8_STAGE_A(PG8_SA(0, 0), a2, ko2, 0, last);
            PG8_WAIT_V(8); PG8_WAIT_L(0); PG8_BAR; PG8_MMA(1, 0, At, B0); PG8_MMA(1, 1, At, B1); PG8_BAR; PG8_SCHED;
            PG8_LDB(B0, 1, 0); PG8_LDB(B1, 1, 1); PG8_SCHED; PG8_LDA(At, 1, 0); PG8_STAGE_A(PG8_SA(0, 1), a2 + hstep, ko2, 1, last);
            PG8_WAIT_V(8); PG8_WAIT_L(0); PG8_BAR; PG8_MMA(0, 0, At, B0); PG8_MMA(0, 1, At, B1); PG8_BAR; PG8_SCHED;
            PG8_LDA(At, 1, 1); PG8_STAGE(PG8_SB(1, 0), b3, voffB); PG8_STAGE(PG8_SB(1, 1), b3 + hstep, voffB); PG8_STAGE_A(PG8_SA(1, 0), a3, ko2 + kstep, 0, last);
            PG8_WAIT_V(8); PG8_WAIT_L(0); PG8_BAR; PG8_MMA(1, 0, At, B0); PG8_MMA(1, 1, At, B1); PG8_BAR; PG8_SCHED;
            } else {
            PG8_LDB(B0, 0, 0); PG8_SCHED; PG8_LDA(At, 0, 0); PG8_STAGE(PG8_SA(1, 1), a1 + hstep, voffA);
            PG8_WAIT_L(8); PG8_BAR; PG8_WAIT_L(0); PG8_MMA(0, 0, At, B0); PG8_BAR; PG8_SCHED;
            PG8_LDB(B1, 0, 1); PG8_STAGE(PG8_SB(0, 0), b2, voffB);
            PG8_BAR; PG8_WAIT_L(0); PG8_MMA(0, 1, At, B1); PG8_BAR;
            PG8_LDA(At, 0, 1); PG8_STAGE(PG8_SA(0, 0), a2, voffA);
            PG8_BAR; PG8_WAIT_L(0); PG8_MMA(1, 0, At, B0); PG8_BAR; PG8_SCHED;
            PG8_STAGE(PG8_SB(0, 1), b2 + hstep, voffB);
            PG8_WAIT_V(6); PG8_BAR; PG8_MMA(1, 1, At, B1); PG8_BAR;
            PG8_LDB(B0, 1, 0); PG8_SCHED; PG8_LDA(At, 1, 0); PG8_STAGE(PG8_SA(0, 1), a2 + hstep, voffA);
            PG8_WAIT_L(8); PG8_BAR; PG8_WAIT_L(0); PG8_MMA(0, 0, At, B0); PG8_BAR; PG8_SCHED;
            PG8_LDB(B1, 1, 1); PG8_STAGE(PG8_SB(1, 0), b3, voffB);
            PG8_BAR; PG8_WAIT_L(0); PG8_MMA(0, 1, At, B1); PG8_BAR;
            PG8_LDA(At, 1, 1); PG8_STAGE(PG8_SA(1, 0), a3, voffA);
            PG8_BAR; PG8_WAIT_L(0); PG8_MMA(1, 0, At, B0); PG8_BAR; PG8_SCHED;
            PG8_STAGE(PG8_SB(1, 1), b3 + hstep, voffB);
            PG8_WAIT_V(6); PG8_BAR; PG8_MMA(1, 1, At, B1); PG8_BAR;
            }
        }
        if constexpr (ALIGN_EPI) { if (wr == 0) PG8_BAR; }
        if constexpr (!Epi::AFTER_DRAIN) { E(acc, cur, wr, wc, fr, fq); S.done(cur); }
        if (!has_next) break;
#pragma unroll
        for (int a = 0; a < 2; ++a)
#pragma unroll
            for (int b = 0; b < 2; ++b)
#pragma unroll
                for (int m = 0; m < 4; ++m)
#pragma unroll
                    for (int n = 0; n < 2; ++n) acc[a][b][m][n] = (f32x4){0.f, 0.f, 0.f, 0.f};
        cur = nxt; cA = nA; cB = nB; ++ui;
        if constexpr (Sched::GATHER) { _Pragma("unroll") for (int _h = 0; _h < 2; ++_h) { aoc[_h][0] = aon[_h][0]; aoc[_h][1] = aon[_h][1]; } }
        if constexpr (ALIGN_EPI) { if (wr == 1) PG8_BAR; }
    }
    PG8_WAIT_V(0);
    if constexpr (!ALIGN_EPI) { if (wr == 0) PG8_BAR; }
    PG8_BAR;
    if constexpr (Epi::AFTER_DRAIN) { E.fused(acc, cur, wr, wc, fr, fq, lds, wid, lane); S.done(cur); }
#undef PG8_SA
#undef PG8_SB
#undef PG8_STAGE
#undef PG8_STAGE_A
#undef PG8_GOFF
#undef PG8_LDA
#undef PG8_LDB
#undef PG8_MMA
#undef PG8_WAIT_V
#undef PG8_WAIT_L
#undef PG8_BAR
#undef PG8_SCHED
}
}
constexpr int NWAVES = 8;
constexpr int TOK = 16384, SEQ = 4096, D = 1024, NP = 4096, INC = 3888, DEPTH = 4;
constexpr int HG_Q = 0, HG_F = 256, HG_I = 512, HG_G = 768;
constexpr int GL_Q = 1024, GL_K = 1152, GL_V = 1280, GL_GLR = 1536, GL_R = 1552;
constexpr int RW_BASE = 1808, RW_R = 1808, RW_K = 2064, RW_V = 2320, RW_WLR = 2576, RW_ALR = 2640, RW_GLR = 2704;
constexpr int RT_Q = 2864, RT_K = 3120, RT_V = 3376, RT_G = 3632;
constexpr int GL_GX = 3904;
constexpr int FFD = 2816, FFE = 1408, NE = 8;
constexpr float DN_ALPHA = 1.6817928305074290f;
constexpr int NPH = 12;
constexpr int NPHASES = NPH * DEPTH;
constexpr size_t MiB = 1u << 20;
constexpr size_t WS_CTL = 0, CTL_ZERO_BYTES = 1 * MiB;
constexpr size_t WS_LIST = 1 * MiB;
constexpr size_t WS_GATE = 2 * MiB;
constexpr size_t WS_TAB = 3 * MiB;
constexpr size_t WS_WIN = 4 * MiB, WS_WOUT = 12 * MiB, WS_WUP = 14 * MiB, WS_WDN = 58 * MiB;
constexpr size_t WS_HB = 80 * MiB;
constexpr size_t WS_MIX = 112 * MiB;
constexpr size_t WS_O = WS_MIX;
constexpr size_t WS_OI = 144 * MiB;
constexpr size_t OI_GEN = 64 * 4096 * 16;
constexpr size_t WS_VF = 176 * MiB;
constexpr size_t WS_P = 184 * MiB;
constexpr size_t WS_RWW = 312 * MiB;
constexpr size_t WS_RWR = 328 * MiB, WS_RWK = 336 * MiB, WS_RWV = 344 * MiB, WS_RWKK = 352 * MiB, WS_RWB = 360 * MiB, WS_RWG = 368 * MiB;
constexpr size_t WS_Y = 376 * MiB;
constexpr size_t WS_CS = 461 * MiB;
constexpr size_t WS_HID = 184 * MiB;
constexpr size_t WS_DOUT = 280 * MiB;
constexpr size_t WS_HPERM = 344 * MiB;
constexpr size_t WS_END = 465 * MiB;
constexpr int CW_BAR = 4096;
constexpr int CW_CNT = 16384;
constexpr int TAB_STRIDE = 4 * 160 + 16;
constexpr size_t WS_LORA = 2 * MiB + 512 * 1024;
constexpr int LO_W2 = 0, LO_A2 = 256 * 64, LO_G2 = 2 * 256 * 64, LO_V1 = LO_G2 + 256 * 160, LO_V2 = LO_V1 + 32 * 256, LO_END = LO_V2 + 256 * 32;
constexpr int RING_BYTES = 131072, LDSCTL_OFF = 146432, MISC_OFF = LDSCTL_OFF + 320, LDS_BYTES = 147456;
#define GAS __attribute__((address_space(1)))
#define LAS __attribute__((address_space(3)))
typedef unsigned short bf16;
typedef unsigned v4u __attribute__((ext_vector_type(4)));
typedef unsigned v2u __attribute__((ext_vector_type(2)));
typedef float f32x4 __attribute__((ext_vector_type(4)));
typedef short bf16x8 __attribute__((ext_vector_type(8)));
typedef GAS unsigned gu32;
#define RLX_AGENT __ATOMIC_RELAXED, __HIP_MEMORY_SCOPE_AGENT
#define LDS_WAIT() asm volatile("s_waitcnt lgkmcnt(0)" ::: "memory")
#define VM_WAIT() asm volatile("s_waitcnt vmcnt(0)" ::: "memory")
#define LDS_BARRIER() do { asm volatile("s_waitcnt lgkmcnt(0)" ::: "memory"); __builtin_amdgcn_s_barrier(); asm volatile("" ::: "memory"); } while (0)
typedef float f32x2_t __attribute__((ext_vector_type(2))); typedef __bf16 bf16x2_t __attribute__((ext_vector_type(2)));
__device__ __forceinline__ unsigned pk2(float lo, float hi) { f32x2_t v = {lo, hi}; bf16x2_t b = __builtin_convertvector(v, bf16x2_t); return __builtin_bit_cast(unsigned, b); }
__device__ __forceinline__ unsigned f2bf(float f) { return pk2(f, f) & 0xffffu; }
__device__ __forceinline__ float bflo(unsigned w) { return __builtin_bit_cast(float, w << 16); }
__device__ __forceinline__ float bfhi(unsigned w) { return __builtin_bit_cast(float, w & 0xffff0000u); }
__device__ __forceinline__ float bf1(bf16 b) { return __builtin_bit_cast(float, ((unsigned)b) << 16); }
__device__ __forceinline__ void unpack8(const v4u w, float (&f)[8]) { f[0] = bflo(w.x); f[1] = bfhi(w.x); f[2] = bflo(w.y); f[3] = bfhi(w.y); f[4] = bflo(w.z); f[5] = bfhi(w.z); f[6] = bflo(w.w); f[7] = bfhi(w.w); }
__device__ __forceinline__ v4u pack8(const float (&f)[8]) { v4u w; w.x = pk2(f[0], f[1]); w.y = pk2(f[2], f[3]); w.z = pk2(f[4], f[5]); w.w = pk2(f[6], f[7]); return w; }
__device__ __forceinline__ float sigm(float x) { return __builtin_amdgcn_rcpf(1.0f + __expf(-x)); }
template <int CTRL> __device__ __forceinline__ float dpp(float x) { return __builtin_bit_cast(float, __builtin_amdgcn_mov_dpp(__builtin_bit_cast(int, x), CTRL, 0xf, 0xf, true)); }
__device__ __forceinline__ float sum16(float x) { x += dpp<0xB1>(x); x += dpp<0x4E>(x); x += dpp<0x141>(x); x += dpp<0x128>(x); return x; }
__device__ __forceinline__ float sum4(float x) { x += dpp<0xB1>(x); x += dpp<0x4E>(x); return x; }
__device__ __forceinline__ float wave_sum(float x) {
    x = sum16(x);
    auto s = __builtin_amdgcn_permlane16_swap(__float_as_uint(x), __float_as_uint(x), false, false); x = __uint_as_float(s[0]) + __uint_as_float(s[1]);
    auto t = __builtin_amdgcn_permlane32_swap(__float_as_uint(x), __float_as_uint(x), false, false); return __uint_as_float(t[0]) + __uint_as_float(t[1]);
}
__device__ const double INVF2PI[32] = {0.15915494309189535, 0.11934937021124886, 0.08949940160889101, 0.06711508300522726, 0.050329212104487035, 0.03774158471741977, 0.0283021958306234, 0.02122365276477766, 0.015915494309189534, 0.011934937021124886, 0.008949940160889102, 0.006711508300522725, 0.005032921210448704, 0.003774158471741977, 0.00283021958306234, 0.0021223652764777662, 0.0015915494309189536, 0.0011934937021124885, 0.0008949940160889102, 0.0006711508300522726, 0.0005032921210448703, 0.00037741584717419774, 0.00028302195830623395, 0.0002122365276477766, 0.00015915494309189535, 0.00011934937021124886, 8.949940160889102e-05, 6.711508300522725e-05, 5.0329212104487035e-05, 3.774158471741978e-05, 2.8302195830623396e-05, 2.122365276477766e-05};
#define XB_TMO      128
#define XB_XCNT(j)  (256  + 64 * (j))
#define XB_XSUB(j)  (1280 + 64 * (j))
#define XB_XGEN(j)  (2304 + 64 * (j))
#define XB_TOP      3328
#define XB_TOPGEN   3392
#define XCD_BAR_WORDS 3456
#define XB_SPIN_CAP (1u << 18)

__device__ __forceinline__ unsigned xb_ld(unsigned* p)              { return __hip_atomic_load(p, __ATOMIC_RELAXED, __HIP_MEMORY_SCOPE_AGENT); }
__device__ __forceinline__ unsigned xb_add(unsigned* p, unsigned v) { return __hip_atomic_fetch_add(p, v, __ATOMIC_RELAXED, __HIP_MEMORY_SCOPE_AGENT); }
__device__ __forceinline__ unsigned xb_xcc_id() { return (unsigned)__builtin_amdgcn_s_getreg((3 << 11) | 20) & 0xFu; }
#define XB_SPIN(cond, bar) do { unsigned _sp = 0; while (cond) { __builtin_amdgcn_s_sleep(1); \
    if ((++_sp & 255u) == 0u) { if (xb_ld(&(bar)[XB_TMO])) break; if (_sp > XB_SPIN_CAP) { atomicAdd(&(bar)[XB_TMO], 1u); break; } } } } while (0)

struct XcdBarrier {
    unsigned* bar; unsigned x;
    volatile LAS unsigned* st;
    int wv;
};

__device__ __forceinline__ XcdBarrier xcd_barrier_post(unsigned* bar, volatile LAS unsigned* st) {
    XcdBarrier b; b.bar = bar; b.x = xb_xcc_id(); b.st = st; b.wv = __builtin_amdgcn_readfirstlane((int)threadIdx.x >> 6);
    if (threadIdx.x == 0) (void)xb_add(&bar[XB_XCNT(b.x)], 1u);
    return b;
}
__device__ __forceinline__ void xcd_barrier_complete(unsigned* bar, unsigned x, unsigned& nloc, unsigned& nx) {
    const unsigned G = gridDim.x * gridDim.y * gridDim.z;
    unsigned sum, cnt, mine, sp = 0u;
    for (;;) {
        sum = 0u; cnt = 0u; mine = 0u;
#pragma unroll 1
        for (unsigned j = 0; j < 16; ++j) { const unsigned c = xb_ld(&bar[XB_XCNT(j)]); sum += c; cnt += (c > 0u) ? 1u : 0u; mine = (j == x) ? c : mine; }
        if (sum == G) break;
        __builtin_amdgcn_s_sleep(1);
        if ((++sp & 255u) == 0u) { if (xb_ld(&bar[XB_TMO])) break; if (sp > XB_SPIN_CAP) { atomicAdd(&bar[XB_TMO], 1u); break; } }
    }
    nloc = mine > 0u ? mine : 1u; nx = cnt > 0u ? cnt : 1u;
}

__device__ __forceinline__ void xcd_barrier(const XcdBarrier& b) {
    asm volatile("s_waitcnt vmcnt(0)" ::: "memory");
    __syncthreads();
    if (b.wv == 0 && lane_id_now() == 0) {
        unsigned* bar = b.bar;
        __builtin_amdgcn_s_waitcnt(0);
        unsigned nloc = b.st[0], nx = b.st[1];
        if (nloc == 0u) { xcd_barrier_complete(bar, b.x, nloc, nx); b.st[0] = nloc; b.st[1] = nx; }
        const unsigned old = xb_add(&bar[XB_XSUB(b.x)], 1u);
        const unsigned gen = old / nloc;
        if (old + 1u == (gen + 1u) * nloc) {
            __builtin_amdgcn_fence(__ATOMIC_RELEASE, "agent");
            asm volatile("s_waitcnt vmcnt(0)" ::: "memory");
            const unsigned og = xb_add(&bar[XB_TOP], 1u);
            const unsigned tg = og / nx;
            if (og + 1u == (tg + 1u) * nx) xb_add(&bar[XB_TOPGEN], 1u);
            else XB_SPIN(xb_ld(&bar[XB_TOPGEN]) == tg, bar);
            __builtin_amdgcn_fence(__ATOMIC_ACQUIRE, "agent");
            xb_add(&bar[XB_XGEN(b.x)], 1u);
            asm volatile("s_waitcnt vmcnt(0)" ::: "memory");
        } else {
            XB_SPIN(xb_ld(&bar[XB_XGEN(b.x)]) == gen, bar);
            __builtin_amdgcn_fence(__ATOMIC_ACQUIRE, "agent");
            asm volatile("s_waitcnt vmcnt(0)" ::: "memory");
        }
    }
    __syncthreads();
}
struct Frame {
    LAS unsigned char* lds;
    volatile LAS unsigned* MISC;
    gu32* ctl;
    int tid, lane, wave;
    int vcu, G;
    unsigned char* ws;
    const void* const* in;
    float* h;
};
__device__ __forceinline__ const void* ldptr(const void* const* tab, int k) { int z; asm volatile("s_mov_b32 %0, 0" : "=s"(z)); return tab[k + z]; }
#define INF(k) ((const float*)ldptr(F.in, k))
#define WSP(T, off) ((T*)(F.ws + (off)))

__device__ __forceinline__ void xpose_item(const float* W, int ldw, int nvalid, int k0, int n0, bf16* WT, int ldt, int drow0, LAS float* scr, int lane) {
#pragma unroll 8
    for (int i = 0; i < 32; ++i) { const int kk = 2 * i + (lane >> 5), n = n0 + (lane & 31); scr[kk * 33 + (lane & 31)] = (n < nvalid) ? W[(size_t)(k0 + kk) * ldw + n] : 0.f; }
    LDS_WAIT(); asm volatile("" ::: "memory");
    const int c = lane & 7;
#pragma unroll
    for (int j = 0; j < 4; ++j) { const int n = (lane >> 3) + 8 * j; const LAS float* s = scr + (8 * c) * 33 + n;
        v4u o; o.x = pk2(s[0 * 33], s[1 * 33]); o.y = pk2(s[2 * 33], s[3 * 33]); o.z = pk2(s[4 * 33], s[5 * 33]); o.w = pk2(s[6 * 33], s[7 * 33]);
        *(GAS v4u*)(WT + (size_t)(drow0 + n) * ldt + k0 + 8 * c) = o; }
    LDS_WAIT(); asm volatile("" ::: "memory");
}
__device__ __forceinline__ int gu_row(int n) { return 256 * (n >> 7) + (n & 127); }
template <int PART> __device__ __forceinline__ void phase_weights(Frame& F, int l) {
    LAS float* scr = (LAS float*)(F.lds + F.wave * 16384);
    const int gw = F.vcu * NWAVES + F.wave, NGW = F.G * NWAVES;
    const bool moe = (l & 1); const int fi = l >> 1;
    constexpr int I_IN = 16 * 128, I_OUT = 16 * 32;
    constexpr int I_DG = 16 * 88, I_DD = 44 * 32;
    constexpr int I_MG = 16 * 44, I_MD = 22 * 32;
    const int nitems = PART == 0 ? (I_IN + I_OUT) : (moe ? NE * (2 * I_MG + I_MD) : (2 * I_DG + I_DD));
    for (int it = gw; it < nitems; it += NGW) {
        int r = it + (PART == 0 ? 0 : I_IN + I_OUT);
        if (r < I_IN) { const int kb = r >> 7, nb = r & 127; if (nb < 122) xpose_item(INF(2) + (size_t)l * D * INC, INC, INC, 64 * kb, 32 * nb, WSP(bf16, WS_WIN), D, 32 * nb, scr, F.lane); continue; } r -= I_IN;
        if (r < I_OUT) { const int kb = r >> 5, nb = r & 31; xpose_item(INF(3) + (size_t)l * D * D, D, D, 64 * kb, 32 * nb, WSP(bf16, WS_WOUT), D, 32 * nb, scr, F.lane); continue; } r -= I_OUT;
        if (!moe) {
            if (r < 2 * I_DG) { const int up = r >= I_DG; if (up) r -= I_DG; const int kb = r / 88, nb = r % 88;
                xpose_item(INF(up ? 28 : 27) + (size_t)fi * D * FFD, FFD, FFD, 64 * kb, 32 * nb, WSP(bf16, WS_WUP), D, gu_row(32 * nb) + (up ? 128 : 0), scr, F.lane); continue; } r -= 2 * I_DG;
            { const int kb = r >> 5, nb = r & 31; xpose_item(INF(29) + (size_t)fi * FFD * D, D, D, 64 * kb, 32 * nb, WSP(bf16, WS_WDN), FFD, 32 * nb, scr, F.lane); }
        } else {
            const int per = 2 * I_MG + I_MD; const int e = r / per; r -= e * per;
            if (r < 2 * I_MG) { const int up = r >= I_MG; if (up) r -= I_MG; const int kb = r / 44, nb = r % 44;
                xpose_item(INF(up ? 32 : 31) + (size_t)(fi * NE + e) * D * FFE, FFE, FFE, 64 * kb, 32 * nb, WSP(bf16, WS_WUP) + (size_t)e * 2 * FFE * D, D, gu_row(32 * nb) + (up ? 128 : 0), scr, F.lane); continue; } r -= 2 * I_MG;
            { const int kb = r >> 5, nb = r & 31; xpose_item(INF(33) + (size_t)(fi * NE + e) * FFE * D, D, D, 64 * kb, 32 * nb, WSP(bf16, WS_WDN) + (size_t)e * D * FFE, FFE, 32 * nb, scr, F.lane); }
        }
    }
    if (PART == 0) {
        const int gt = F.vcu * NWAVES * 64 + F.tid; int NT = F.G * NWAVES * 64; asm volatile("" : "+s"(NT));     const float* win = INF(2) + (size_t)l * D * INC; const float* gw2 = INF(10) + l * 16 * 128; bf16* WT = WSP(bf16, WS_WIN);
        for (int e = gt; e < 128 * D; e += NT) { const int n = e >> 10, d = e & 1023; const float* wr = win + (size_t)d * INC + (GL_GLR - 0); float a = 0.f;
#pragma unroll
            for (int r = 0; r < 16; ++r) a += wr[r] * gw2[r * 128 + n];
            WT[(size_t)(GL_GX + n) * D + d] = (bf16)f2bf(a); }
        if (l == 0) {
            f32x2_t* CS = WSP(f32x2_t, WS_CS); const int* pos = (const int*)ldptr(F.in, 1);
            for (int e = gt; e < TOK * 32; e += NT) { const int t = e >> 5, i = e & 31; const double rev = (double)pos[t] * INVF2PI[i]; const float fr_ = (float)(rev - floor(rev));
                f32x2_t cs; cs.x = __builtin_amdgcn_cosf(fr_); cs.y = __builtin_amdgcn_sinf(fr_); CS[e] = cs; } }
    }
    if (PART == 0) {
        bf16* LO = WSP(bf16, WS_LORA); const int gt = F.vcu * NWAVES * 64 + F.tid; int NT = F.G * NWAVES * 64; asm volatile("" : "+s"(NT));
        const float* w2 = INF(15) + (size_t)l * 64 * 256; const float* a2 = INF(17) + (size_t)l * 64 * 256; const float* g2 = INF(18) + (size_t)l * 160 * 256;
        for (int e = gt; e < LO_END; e += NT) { float v;
            if (e < LO_A2) { const int n = e >> 6, k = e & 63; v = w2[k * 256 + n]; }
            else if (e < LO_G2) { const int q = e - LO_A2, n = q >> 6, k = q & 63; v = a2[k * 256 + n]; }
            else if (e < LO_V1) { const int q = e - LO_G2, n = q / 160, k = q - n * 160; v = g2[k * 256 + n]; }
            else if (e < LO_V2) { const int q = e - LO_V1, n = q >> 8, k = q & 255; v = (l > 0) ? (INF(25) + (size_t)(l - 1) * 256 * 32)[k * 32 + n] : 0.f; }
            else { const int q = e - LO_V2, n = q >> 5, k = q & 31; v = (l > 0) ? (INF(26) + (size_t)(l - 1) * 32 * 256)[k * 256 + n] : 0.f; }
            LO[e] = (bf16)f2bf(v); }
    }
    if (PART == 0 && l == 0) {
        const float* x = INF(0); bf16* hb = WSP(bf16, WS_HB);
        for (int m = gw; m < TOK; m += NGW) {
            const GAS f32x4* xr = (const GAS f32x4*)(x + (size_t)m * D) + F.lane; GAS f32x4* hr = (GAS f32x4*)(F.h + (size_t)m * D) + F.lane; GAS v2u* o8 = (GAS v2u*)(hb + (size_t)m * D) + F.lane;
#pragma unroll
            for (int j = 0; j < 4; ++j) { const f32x4 v = xr[64 * j]; v2u w; w.x = pk2(v.x, v.y); w.y = pk2(v.z, v.w); o8[64 * j] = w; }
        }
    }
}
template <int NKS> __device__ __forceinline__ void rw_mm16(f32x4 (&acc)[2][4], const LAS bf16* X, int ldx, int mb0, const bf16* BT, int hh, int lane) {
    const int fr = lane & 15, fq = lane >> 4; constexpr int K = 32 * NKS;
    bf16x8 bfr[NKS][4];
#pragma unroll
    for (int ks = 0; ks < NKS; ++ks)
#pragma unroll
        for (int nb = 0; nb < 4; ++nb) bfr[ks][nb] = *(const GAS bf16x8*)(BT + (size_t)(64 * hh + 16 * nb + fr) * K + 32 * ks + 8 * fq);
#pragma unroll
    for (int ks = 0; ks < NKS; ++ks)
#pragma unroll
        for (int mi = 0; mi < 2; ++mi) { const bf16x8 a = *(const LAS bf16x8*)(X + (16 * (mb0 + mi) + fr) * ldx + 32 * ks + 8 * fq);
#pragma unroll
            for (int nb = 0; nb < 4; ++nb) acc[mi][nb] = __builtin_amdgcn_mfma_f32_16x16x32_bf16(a, bfr[ks][nb], acc[mi][nb], 0, 0, 0); }
}
__device__ __forceinline__ void rwprep_tile(Frame& F, int l, int tile) {
    const bf16* P = WSP(const bf16, WS_P);
    const float* mu = INF(13) + l * 1056;
    LAS bf16* X1 = (LAS bf16*)F.lds; LAS bf16* X2 = X1 + 64 * 72; LAS bf16* X3 = X2 + 64 * 72; LAS bf16* XV = X3 + 64 * 168; LAS bf16* X5 = XV + 64 * 264; LAS bf16* XK = X5 + 64 * 40;
    float* RWW = WSP(float, WS_RWW); bf16* RWR = WSP(bf16, WS_RWR); bf16* RWK = WSP(bf16, WS_RWK); bf16* RWV = WSP(bf16, WS_RWV);
    bf16* RWKK = WSP(bf16, WS_RWKK); bf16* RWB = WSP(bf16, WS_RWB); bf16* RWG = WSP(bf16, WS_RWG); bf16* VF = WSP(bf16, WS_VF);
    const bf16* LORA = WSP(const bf16, WS_LORA);
    int tid_ = F.tid; asm volatile("" : "+v"(tid_));
    const int lane_ = tid_ & 63, wave_ = __builtin_amdgcn_readfirstlane(tid_ >> 6);
    const int fr = lane_ & 15, fq = lane_ >> 4, hh = wave_ & 3, mb0 = 2 * (wave_ >> 2);
    const int t0 = tile * 64;
#pragma unroll
    for (int half = 0; half < 2; ++half) {
        v4u rc[9], rp[9];
#pragma unroll
        for (int i = 0; i < 9; ++i) { const int g = tid_ + (half * 9 + i) * 512; rc[i] = (v4u){0u, 0u, 0u, 0u}; rp[i] = rc[i];
            if (g < 64 * 132) { const int tt = g / 132, cg = g - tt * 132, t = t0 + tt; const int col = RW_BASE + 8 * (cg < 36 ? 96 + cg : cg < 68 ? cg - 36 : cg < 100 ? 64 + (cg - 68) : 32 + (cg - 100));
                rc[i] = *(const GAS v4u*)(P + (size_t)t * NP + col); if ((t & (SEQ - 1)) != 0) rp[i] = *(const GAS v4u*)(P + (size_t)(t - 1) * NP + col); } }
#pragma unroll
        for (int i = 0; i < 9; ++i) { const int g = tid_ + (half * 9 + i) * 512;
            if (g < 64 * 132) { const int tt = g / 132, cg = g - tt * 132, t = t0 + tt; const int rel = 8 * (cg < 36 ? 96 + cg : cg < 68 ? cg - 36 : cg < 100 ? 64 + (cg - 68) : 32 + (cg - 100));
                const f32x4 m0 = *(const GAS f32x4*)(mu + rel), m1 = *(const GAS f32x4*)(mu + rel + 4); const float m[8] = {m0.x, m0.y, m0.z, m0.w, m1.x, m1.y, m1.z, m1.w};
                float cv[8], pv[8], xs[8]; unpack8(rc[i], cv); unpack8(rp[i], pv);
#pragma unroll
                for (int j = 0; j < 8; ++j) xs[j] = cv[j] + (pv[j] - cv[j]) * m[j];
                if (cg < 8) {
#pragma unroll
                    for (int j = 0; j < 8; ++j) { const float e2 = __expf(2.f * xs[j]); xs[j] = 1.f - 2.f * __builtin_amdgcn_rcpf(e2 + 1.f); }
                    *(LAS v4u*)(X1 + tt * 72 + 8 * cg) = pack8(xs);
                } else if (cg < 16) { *(LAS v4u*)(X2 + tt * 72 + 8 * (cg - 8)) = pack8(xs);
                } else if (cg < 36) {
#pragma unroll
                    for (int j = 0; j < 8; ++j) xs[j] = sigm(xs[j]);
                    *(LAS v4u*)(X3 + tt * 168 + 8 * (cg - 16)) = pack8(xs);
                } else if (cg < 68) { *(GAS v4u*)(RWR + (size_t)t * 256 + 8 * (cg - 36)) = pack8(xs);
                } else if (cg < 100) { const v4u w = pack8(xs); *(LAS v4u*)(XV + tt * 264 + 8 * (cg - 68)) = w;
                    if (l == 0) { *(GAS v4u*)(RWV + (size_t)t * 256 + 8 * (cg - 68)) = w; *(GAS v4u*)(VF + (size_t)t * 256 + 8 * (cg - 68)) = w; }
                } else { *(LAS v4u*)(XK + tt * 264 + 8 * (cg - 100)) = pack8(xs); } } }
    }
    __syncthreads();
    {   f32x4 acc[2][4];
#pragma unroll
        for (int mi = 0; mi < 2; ++mi)
#pragma unroll
            for (int nb = 0; nb < 4; ++nb) acc[mi][nb] = (f32x4){0.f, 0.f, 0.f, 0.f};
        rw_mm16<2>(acc, X1, 72, mb0, LORA + LO_W2, hh, lane_);
        const float* w0 = INF(14) + l * 256;
#pragma unroll
        for (int mi = 0; mi < 2; ++mi)
#pragma unroll
            for (int nb = 0; nb < 4; ++nb) { const int col = 64 * hh + 16 * nb + fr; const float w0c = w0[col];
#pragma unroll
                for (int r = 0; r < 4; ++r) { const int t = t0 + 16 * (mb0 + mi) + 4 * fq + r; RWW[(size_t)t * 256 + col] = -0.6065306597126334f * sigm(acc[mi][nb][r] + w0c);     } }
#pragma unroll
        for (int mi = 0; mi < 2; ++mi)
#pragma unroll
            for (int nb = 0; nb < 4; ++nb) acc[mi][nb] = (f32x4){0.f, 0.f, 0.f, 0.f};
        rw_mm16<2>(acc, X2, 72, mb0, LORA + LO_A2, hh, lane_);
        const float* a0 = INF(16) + l * 256; const float* kkw = INF(19) + l * 256; const float* kaw = INF(20) + l * 256;
#pragma unroll
        for (int mi = 0; mi < 2; ++mi) {
            float kr[4][4], kq[4][4], ssq[4] = {0.f, 0.f, 0.f, 0.f};
#pragma unroll
            for (int nb = 0; nb < 4; ++nb) { const int col = 64 * hh + 16 * nb + fr; const float kkc = kkw[col];
#pragma unroll
                for (int r = 0; r < 4; ++r) { const int row = 16 * (mb0 + mi) + 4 * fq + r; kr[nb][r] = bf1(XK[row * 264 + col]); kq[nb][r] = kr[nb][r] * kkc; ssq[r] += kq[nb][r] * kq[nb][r]; } }
#pragma unroll
            for (int r = 0; r < 4; ++r) { ssq[r] = sum16(ssq[r]); ssq[r] = 1.0f / fmaxf(sqrtf(ssq[r]), 1e-12f); }
#pragma unroll
            for (int nb = 0; nb < 4; ++nb) { const int col = 64 * hh + 16 * nb + fr; const float a0c = a0[col], kac = kaw[col];
#pragma unroll
                for (int r = 0; r < 4; ++r) { const int t = t0 + 16 * (mb0 + mi) + 4 * fq + r; const float a = sigm(acc[mi][nb][r] + a0c); const float kk = kq[nb][r] * ssq[r];
                    const size_t o = (size_t)t * 256 + col; RWKK[o] = (bf16)f2bf(kk); RWB[o] = (bf16)f2bf(kk * a); RWK[o] = (bf16)f2bf(kr[nb][r] * (1.f + (a - 1.f) * kac)); } }
        }
#pragma unroll
        for (int mi = 0; mi < 2; ++mi)
#pragma unroll
            for (int nb = 0; nb < 4; ++nb) acc[mi][nb] = (f32x4){0.f, 0.f, 0.f, 0.f};
        rw_mm16<5>(acc, X3, 168, mb0, LORA + LO_G2, hh, lane_);
#pragma unroll
        for (int mi = 0; mi < 2; ++mi)
#pragma unroll
            for (int nb = 0; nb < 4; ++nb) { const int col = 64 * hh + 16 * nb + fr;
#pragma unroll
                for (int r = 0; r < 4; ++r) { const int t = t0 + 16 * (mb0 + mi) + 4 * fq + r; RWG[(size_t)t * 256 + col] = (bf16)f2bf(acc[mi][nb][r]); } }
    }
    if (l > 0) {
        const float* v0 = INF(24) + (l - 1) * 256; const bf16* v1T = LORA + LO_V1; const bf16* v2T = LORA + LO_V2;
        {
            const int mb = wave_ & 3, nb = wave_ >> 2; f32x4 a4 = (f32x4){0.f, 0.f, 0.f, 0.f}; bf16x8 bv[8];
#pragma unroll
            for (int ks = 0; ks < 8; ++ks) bv[ks] = *(const GAS bf16x8*)(v1T + (size_t)(16 * nb + fr) * 256 + 32 * ks + 8 * fq);
#pragma unroll
            for (int ks = 0; ks < 8; ++ks) a4 = __builtin_amdgcn_mfma_f32_16x16x32_bf16(*(const LAS bf16x8*)(XV + (16 * mb + fr) * 264 + 32 * ks + 8 * fq), bv[ks], a4, 0, 0, 0);
#pragma unroll
            for (int r = 0; r < 4; ++r) X5[(16 * mb + 4 * fq + r) * 40 + 16 * nb + fr] = (bf16)f2bf(a4[r]);
        }
        __syncthreads();
        {   f32x4 acc[2][4];
#pragma unroll
            for (int mi = 0; mi < 2; ++mi)
#pragma unroll
                for (int nb = 0; nb < 4; ++nb) acc[mi][nb] = (f32x4){0.f, 0.f, 0.f, 0.f};
            rw_mm16<1>(acc, X5, 40, mb0, v2T, hh, lane_);
#pragma unroll
            for (int mi = 0; mi < 2; ++mi)
#pragma unroll
                for (int nb = 0; nb < 4; ++nb) { const int col = 64 * hh + 16 * nb + fr; const float v0c = v0[col];
#pragma unroll
                    for (int r = 0; r < 4; ++r) { const int row = 16 * (mb0 + mi) + 4 * fq + r; const size_t o = (size_t)(t0 + row) * 256 + col;
                        const float xv = bf1(XV[row * 264 + col]); const float vf = bf1(VF[o]); RWV[o] = (bf16)f2bf(xv + (vf - xv) * sigm(acc[mi][nb][r] + v0c)); } }
        }
    }
    __syncthreads();
}
constexpr int CB = 64 * 66;
constexpr int HB_ = 64 * 72;
constexpr int PRE_H0 = 3 * CB * 4;
constexpr int PV_OFF = (PRE_H0 + 10 * HB_ * 2) / 4;
constexpr int REC_RW = 53760, REC_GL = 16640;
constexpr int RO_QH = 0, RO_AT = 8192, RO_BH = 16384, RO_TT = 24576, RO_MRB = 30720, RO_GAM = 36864, RO_VB = 37376;
constexpr int RO_Y = 0, RO_SK = 0;
constexpr int GO_QH = 0, GO_SK = 8192, GO_GAM = 16384;
#define PBUF(i) ((LAS float*)F.lds + (i) * CB)
#define HBUF(i) ((LAS bf16*)(F.lds + PRE_H0) + (i) * HB_)
__device__ __forceinline__ void nt16(f32x4 (&acc)[2], const LAS bf16* X, const LAS bf16* Y, int mb, int nb0, int lane) {
    const int fr = lane & 15, fq = lane >> 4;
    acc[0] = (f32x4){0.f, 0.f, 0.f, 0.f}; acc[1] = acc[0];
#pragma unroll
    for (int ks = 0; ks < 2; ++ks) { const bf16x8 a = *(const LAS bf16x8*)(X + (16 * mb + fr) * 72 + 32 * ks + 8 * fq);
        const bf16x8 b0 = *(const LAS bf16x8*)(Y + (16 * nb0 + fr) * 72 + 32 * ks + 8 * fq), b1 = *(const LAS bf16x8*)(Y + (16 * nb0 + 16 + fr) * 72 + 32 * ks + 8 * fq);
        acc[0] = __builtin_amdgcn_mfma_f32_16x16x32_bf16(a, b0, acc[0], 0, 0, 0); acc[1] = __builtin_amdgcn_mfma_f32_16x16x32_bf16(a, b1, acc[1], 0, 0, 0); }
}
typedef short v4i16_t __attribute__((ext_vector_type(4)));
__device__ __forceinline__ v2u trr(const LAS bf16* p) { return __builtin_bit_cast(v2u, __builtin_amdgcn_ds_read_tr16_b64_v4i16((LAS v4i16_t*)p)); }
__device__ __forceinline__ bf16x8 trfrag(const LAS bf16* M, int c, int ks, int lane) {
    const int g = lane >> 4, q = (lane & 15) >> 2, p = lane & 3; const LAS bf16* a = M + (32 * ks + 8 * g + q) * 72 + 16 * c + 4 * p;
    const v2u lo = trr(a), hi = trr(a + 4 * 72); v4u w; w.x = lo.x; w.y = lo.y; w.z = hi.x; w.w = hi.y; return __builtin_bit_cast(bf16x8, w);
}
__device__ __forceinline__ void tn16(f32x4 (&acc)[2], const LAS bf16* X, const LAS bf16* Y, int mb, int nb0, int lane) {
    acc[0] = (f32x4){0.f, 0.f, 0.f, 0.f}; acc[1] = acc[0];
#pragma unroll
    for (int ks = 0; ks < 2; ++ks) { const bf16x8 a = trfrag(X, mb, ks, lane), b0 = trfrag(Y, nb0, ks, lane), b1 = trfrag(Y, nb0 + 1, ks, lane);
        acc[0] = __builtin_amdgcn_mfma_f32_16x16x32_bf16(a, b0, acc[0], 0, 0, 0); acc[1] = __builtin_amdgcn_mfma_f32_16x16x32_bf16(a, b1, acc[1], 0, 0, 0); }
}
__device__ __forceinline__ void nn16(f32x4 (&acc)[2], const LAS bf16* A, const LAS bf16* B, int mb, int nb0, int lane) {
    const int fr = lane & 15, fq = lane >> 4;
    acc[0] = (f32x4){0.f, 0.f, 0.f, 0.f}; acc[1] = acc[0];
#pragma unroll
    for (int ks = 0; ks < 2; ++ks) { const bf16x8 a = *(const LAS bf16x8*)(A + (16 * mb + fr) * 72 + 32 * ks + 8 * fq), b0 = trfrag(B, nb0, ks, lane), b1 = trfrag(B, nb0 + 1, ks, lane);
        acc[0] = __builtin_amdgcn_mfma_f32_16x16x32_bf16(a, b0, acc[0], 0, 0, 0); acc[1] = __builtin_amdgcn_mfma_f32_16x16x32_bf16(a, b1, acc[1], 0, 0, 0); }
}
__device__ __forceinline__ void hfrag_tr(const LAS bf16* M, unsigned char* dst, int wave, int lane) {
    const int mb = wave >> 1, ks = wave & 1, g = lane >> 4, q = (lane & 15) >> 2, p = lane & 3; const LAS bf16* a = M + (32 * ks + 4 * g + q) * 72 + 16 * mb + 4 * p;
    const v2u lo = trr(a), hi = trr(a + 16 * 72); v4u w; w.x = lo.x; w.y = lo.y; w.z = hi.x; w.w = hi.y;
    *(GAS v4u*)(dst + ((size_t)wave * 64 + lane) * 16) = w;
}
template <int MASK> __device__ __forceinline__ void hst(const f32x4 (&acc)[2], LAS bf16* S, int mb, int nb0, int lane) {
    const int fr = lane & 15, fq = lane >> 4;
#pragma unroll
    for (int n = 0; n < 2; ++n)
#pragma unroll
        for (int r = 0; r < 4; ++r) { const int row = 16 * mb + 4 * fq + r, col = 16 * (nb0 + n) + fr; float v = acc[n][r];
            if (MASK == 1 && col > row) v = 0.f; if (MASK == 2 && col >= row) v = 0.f; S[row * 72 + col] = (bf16)f2bf(v); }
}
template <int MASK> __device__ __forceinline__ void cst(const f32x4 (&acc)[2], LAS float* S, int mb, int nb0, int lane) {
    const int fr = lane & 15, fq = lane >> 4;
#pragma unroll
    for (int n = 0; n < 2; ++n)
#pragma unroll
        for (int r = 0; r < 4; ++r) { const int row = 16 * mb + 4 * fq + r, col = 16 * (nb0 + n) + fr; float v = acc[n][r];
            if (MASK == 1 && col > row) v = 0.f; if (MASK == 2 && col >= row) v = 0.f; S[row * 66 + col] = v; }
}
__device__ __forceinline__ void hfrag(const LAS bf16* M, const LAS float* colscale, unsigned char* dst, int wave, int lane, int slot = -2) {
    const int mb = wave >> 1, ks = wave & 1, i = lane & 15, q = lane >> 4; const LAS bf16* rowp = M + (16 * mb + i) * 72 + 32 * ks + 4 * q;
    const v2u lo = *(const LAS v2u*)rowp, hi = *(const LAS v2u*)(rowp + 16);
    v4u w; w.x = lo.x; w.y = lo.y; w.z = hi.x; w.w = hi.y;
    if (colscale) { float e[8]; unpack8(w, e); const f32x4 s0 = *(const LAS f32x4*)(colscale + 32 * ks + 4 * q), s1 = *(const LAS f32x4*)(colscale + 32 * ks + 16 + 4 * q);
        e[0] *= s0.x; e[1] *= s0.y; e[2] *= s0.z; e[3] *= s0.w; e[4] *= s1.x; e[5] *= s1.y; e[6] *= s1.z; e[7] *= s1.w; w = pack8(e); }
    if (slot == -2) slot = wave; if (slot >= 0) *(GAS v4u*)(dst + ((size_t)slot * 64 + lane) * 16) = w;
}
__device__ __forceinline__ void cfrag(const LAS float* M, unsigned char* dst, int wave, int lane, int slot) {
    const int mb = wave >> 1, ks = wave & 1, i = lane & 15, q = lane >> 4; float e[8];
#pragma unroll
    for (int jj = 0; jj < 8; ++jj) { const int rho = 32 * ks + (jj < 4 ? 4 * q + jj : 16 + 4 * q + jj - 4); e[jj] = M[(16 * mb + i) * 66 + rho]; }
    if (slot >= 0) *(GAS v4u*)(dst + ((size_t)slot * 64 + lane) * 16) = pack8(e);
}
__device__ __forceinline__ void cacc(const f32x4 (&acc)[2], const LAS float* rowscale, unsigned char* dst, int mb, int nb0, int lane, int vbs = 2048) {
    const int fq = lane >> 4;
#pragma unroll
    for (int n = 0; n < 2; ++n) { float v[4];
#pragma unroll
        for (int r = 0; r < 4; ++r) { v[r] = acc[n][r]; if (rowscale) v[r] *= rowscale[16 * mb + 4 * fq + r]; }
        v2u w; w.x = pk2(v[0], v[1]); w.y = pk2(v[2], v[3]); *(GAS v2u*)(dst + (size_t)(nb0 + n) * vbs + ((size_t)mb * 64 + lane) * 8) = w; }
}
__device__ __forceinline__ void ccumsum(Frame& F, LAS float* CU) {
    LAS float* vec = (LAS float*)F.lds + PV_OFF; LAS float* seg = vec + 128;
    { float run = 0.f;
#pragma unroll
      for (int i = 0; i < 8; ++i) { run += CU[(8 * F.wave + i) * 66 + F.lane]; CU[(8 * F.wave + i) * 66 + F.lane] = run; }
      seg[F.wave * 64 + F.lane] = run; }
    LDS_BARRIER();
    { float off = 0.f;
#pragma unroll
      for (int w = 0; w < 8; ++w) if (w < F.wave) off += seg[w * 64 + F.lane];
#pragma unroll
      for (int i = 0; i < 8; ++i) { const float c = CU[(8 * F.wave + i) * 66 + F.lane] + off; CU[(8 * F.wave + i) * 66 + F.lane] = c; if (8 * F.wave + i == 31) vec[F.lane] = c; if (8 * F.wave + i == 63) vec[64 + F.lane] = c; } }
    LDS_BARRIER();
}
__device__ __forceinline__ f32x4 blk16(f32x4 acc, const LAS float* A, int ar0, int ac0, const LAS float* B, int br0, int bc0, int lane) {
    const int fr = lane & 15, fq = lane >> 4;
#pragma unroll
    for (int s = 0; s < 4; ++s) acc = __builtin_amdgcn_mfma_f32_16x16x4f32(A[(ar0 + fr) * 66 + ac0 + 4 * s + fq], B[(br0 + 4 * s + fq) * 66 + bc0 + fr], acc, 0, 0, 0);
    return acc;
}
__device__ __forceinline__ void blkst(const f32x4 acc, LAS float* S, int r0, int c0, int lane) {
    const int fr = lane & 15, fq = lane >> 4;
#pragma unroll
    for (int r = 0; r < 4; ++r) S[(r0 + 4 * fq + r) * 66 + c0 + fr] = acc[r];
}
__device__ __forceinline__ void tri_inverse(Frame& F, const LAS float* L, LAS float* T, LAS float* W) {
    for (int e = F.tid; e < 64 * 64; e += NWAVES * 64) { const int i = e >> 6, j = e & 63; if ((i >> 4) != (j >> 4)) T[i * 66 + j] = 0.f; }
    if (F.wave == 0) {
        const int d0 = 16 * (F.lane >> 4), c = F.lane & 15; float t[16];
#pragma unroll
        for (int i = 0; i < 16; ++i) { float a = (i == c) ? 1.f : 0.f;
#pragma unroll
            for (int j = 0; j < i; ++j) a += L[(d0 + i) * 66 + d0 + j] * t[j];
            t[i] = a; T[(d0 + i) * 66 + d0 + c] = a; }
    }
    LDS_BARRIER();
#pragma unroll
    for (int d = 1; d <= 3; ++d) {
        if (F.wave < 4 - d) { const int i = d + F.wave, j = F.wave; f32x4 acc = (f32x4){0.f, 0.f, 0.f, 0.f};
#pragma unroll
            for (int k = 0; k < 3; ++k) if (k >= j && k < i) acc = blk16(acc, L, 16 * i, 16 * k, T, 16 * k, 16 * j, F.lane);
            blkst(acc, W, 16 * i, 16 * j, F.lane); }
        LDS_BARRIER();
        if (F.wave < 4 - d) { const int i = d + F.wave, j = F.wave; f32x4 acc = (f32x4){0.f, 0.f, 0.f, 0.f};
            acc = blk16(acc, T, 16 * i, 16 * i, W, 16 * i, 16 * j, F.lane); blkst(acc, T, 16 * i, 16 * j, F.lane); }
        LDS_BARRIER();
    }
}
struct PreRaw { unsigned x[6][8]; f32x2_t cs[8]; };
__device__ __forceinline__ unsigned ldh(const bf16* p) { return (unsigned)*(const GAS bf16*)p; }
#define WSQ(T, off) ((T*)(ws_ + (off)))
__device__ __forceinline__ void pre_load(Frame& F, PreRaw& R, const int MIX, int b, int h, int c) {
    int tid_ = F.tid; asm volatile("" : "+v"(tid_));
    unsigned char* ws_ = F.ws; asm volatile("" : "+s"(ws_));
    const int k = tid_ & 63, w = tid_ >> 6, t0 = b * SEQ + c * 64 + 8 * w;
    const bf16* P = WSQ(const bf16, WS_P) + (size_t)t0 * NP;
#pragma unroll
    for (int s = 0; s < 6; ++s)
#pragma unroll
        for (int i = 0; i < 8; ++i) R.x[s][i] = 0u;
    if (MIX == 0) {
#pragma unroll
        for (int i = 0; i < 8; ++i) { R.x[0][i] = ldh(P + (size_t)i * NP + HG_F + 64 * h + k); R.x[1][i] = ldh(P + (size_t)i * NP + HG_Q + 64 * h + k); R.x[2][i] = ldh(P + (size_t)i * NP + HG_I + 64 * h + k); }
    } else if (MIX == 1) {
#pragma unroll
        for (int i = 0; i < 8; ++i) { R.x[2][i] = ldh(P + (size_t)i * NP + GL_V + 64 * h + k);
            if (k < 32) { R.x[0][i] = ldh(P + (size_t)i * NP + GL_GX + 32 * h + k); R.x[1][i] = ldh(P + (size_t)i * NP + GL_Q + 32 * h + k); R.x[3][i] = ldh(P + (size_t)i * NP + GL_K + 32 * h + k); } }
    } else if (MIX == 2) { const size_t o = (size_t)t0 * 256 + 64 * h + k;
#pragma unroll
        for (int i = 0; i < 8; ++i) { R.x[0][i] = __float_as_uint(*(const GAS float*)(WSQ(const float, WS_RWW) + o + i * 256)); R.x[1][i] = ldh(WSQ(const bf16, WS_RWR) + o + i * 256); R.x[2][i] = ldh(WSQ(const bf16, WS_RWV) + o + i * 256);
            R.x[3][i] = ldh(WSQ(const bf16, WS_RWK) + o + i * 256); R.x[4][i] = ldh(WSQ(const bf16, WS_RWKK) + o + i * 256); R.x[5][i] = ldh(WSQ(const bf16, WS_RWB) + o + i * 256); }
    } else { const int k31 = k & 31; const f32x2_t* CS = WSQ(const f32x2_t, WS_CS) + (size_t)t0 * 32 + k31;
#pragma unroll
        for (int i = 0; i < 8; ++i) { R.x[0][i] = ldh(P + (size_t)i * NP + RT_Q + 64 * h + k31); R.x[1][i] = ldh(P + (size_t)i * NP + RT_Q + 64 * h + 32 + k31); R.x[2][i] = ldh(P + (size_t)i * NP + RT_V + 64 * h + k);
            R.x[3][i] = ldh(P + (size_t)i * NP + RT_K + 64 * h + k31); R.x[4][i] = ldh(P + (size_t)i * NP + RT_K + 64 * h + 32 + k31); R.cs[i] = *(const GAS f32x2_t*)(CS + i * 32); }
    }
}
__device__ __forceinline__ float ubf(unsigned u) { return __uint_as_float(u << 16); }
__device__ __forceinline__ v4u pack8v(const float (&f)[8]) { v4u w; w.x = pk2(f[0], f[1]); w.y = pk2(f[2], f[3]); w.z = pk2(f[4], f[5]); w.w = pk2(f[6], f[7]); return w; }
__device__ __forceinline__ void hfrag_trs(const LAS bf16* M, const LAS float* scale, unsigned char* dst, int wave, int lane) {
    const int mb = wave >> 1, ks = wave & 1, g = lane >> 4, q = (lane & 15) >> 2, p = lane & 3; const LAS bf16* a = M + (32 * ks + 4 * g + q) * 72 + 16 * mb + 4 * p;
    const v2u lo = trr(a), hi = trr(a + 16 * 72); v4u w; w.x = lo.x; w.y = lo.y; w.z = hi.x; w.w = hi.y;
    float e[8]; unpack8(w, e); const f32x4 s0 = *(const LAS f32x4*)(scale + 32 * ks + 4 * g), s1 = *(const LAS f32x4*)(scale + 32 * ks + 16 + 4 * g);
    e[0] *= s0.x; e[1] *= s0.y; e[2] *= s0.z; e[3] *= s0.w; e[4] *= s1.x; e[5] *= s1.y; e[6] *= s1.z; e[7] *= s1.w;
    *(GAS v4u*)(dst + ((size_t)wave * 64 + lane) * 16) = pack8(e);
}
__device__ __forceinline__ void chunk_pre(Frame& F, PreRaw& R, int l, const int MIX, int b, int h, int c, unsigned char* rec, const int nMIX, int nh) {
    const int t0 = b * SEQ + c * 64;
    LAS float* SEG = PBUF(0); LAS float* LL = PBUF(1); LAS float* T32 = PBUF(2); LAS float* WW = PBUF(0);
    LAS bf16* A1 = HBUF(0); LAS bf16* R1 = HBUF(1); LAS bf16* B1 = HBUF(2); LAS bf16* K1 = HBUF(3); LAS bf16* KeT = HBUF(4); LAS bf16* VT = HBUF(5); LAS bf16* BeT = HBUF(6); LAS bf16* M1 = HBUF(7); LAS bf16* M2 = HBUF(8); LAS bf16* M3 = HBUF(9);
    LAS float* vec = (LAS float*)F.lds + PV_OFF; LAS float* ecm = vec + 640;
    int tid_ = F.tid; asm volatile("" : "+v"(tid_));
    unsigned char* ws_ = F.ws; asm volatile("" : "+s"(ws_));
    const int lane_ = tid_ & 63, wave_ = __builtin_amdgcn_readfirstlane(tid_ >> 6);
    const int k_ = lane_;
    const int mb = wave_ >> 1, nb0 = 2 * (wave_ & 1), fr = lane_ & 15, fq = lane_ >> 4;
    float q[8], kx[8], lw[8], v[8], av[8], bv[8];
    if (MIX == 0) {
        const float* lg = INF(8); const int cch = 64 * h + k_;
        const float x0 = lg[cch], x1 = lg[256 + cch], x2 = lg[512 + cch], x3 = lg[768 + cch]; const float mx = fmaxf(fmaxf(x0, x1), fmaxf(x2, x3));
        const float e0 = __expf(x0 - mx), e1 = __expf(x1 - mx), e2 = __expf(x2 - mx), e3 = __expf(x3 - mx);
        const float lb = ((l >= 1 ? e1 : 0.f) + (l >= 2 ? e2 : 0.f) + (l >= 3 ? e3 : 0.f)) / (e0 + e1 + e2 + e3);
#pragma unroll
        for (int i = 0; i < 8; ++i) { const float fr_ = ubf(R.x[0][i]), qr = ubf(R.x[1][i]); const float w = lb + (1.f - lb) * sigm(fr_); lw[i] = __logf(w); kx[i] = 1.f - w; q[i] = qr * sigm(qr); v[i] = ubf(R.x[2][i]); }
    } else if (MIX == 1) {
        const float gb = (k_ < 32) ? (INF(11) + l * 128)[32 * h + k_] : 0.f;
#pragma unroll
        for (int i = 0; i < 8; ++i) { v[i] = ubf(R.x[2][i]);
            if (k_ < 32) { const float x = ubf(R.x[0][i]) + gb; lw[i] = 0.0625f * (fminf(x, 0.f) - __logf(1.f + __expf(-fabsf(x)))); q[i] = ubf(R.x[1][i]) * 0.17677669529663687f; kx[i] = ubf(R.x[3][i]); }
            else { lw[i] = 0.f; q[i] = 0.f; kx[i] = 0.f; } }
    } else if (MIX == 2) {
#pragma unroll
        for (int i = 0; i < 8; ++i) { lw[i] = __uint_as_float(R.x[0][i]); q[i] = ubf(R.x[1][i]); v[i] = ubf(R.x[2][i]); kx[i] = ubf(R.x[3][i]); av[i] = -ubf(R.x[4][i]); bv[i] = ubf(R.x[5][i]); }
    } else {
        const bool hi = k_ >= 32; const float lgam = __logf(1.f - exp2f(-5.f - (float)h));
#pragma unroll
        for (int i = 0; i < 8; ++i) { const float cs_ = R.cs[i].x, sn = R.cs[i].y; const float q1 = ubf(R.x[0][i]), q2 = ubf(R.x[1][i]), k1 = ubf(R.x[3][i]), k2 = ubf(R.x[4][i]);
            q[i] = hi ? (q1 * sn + q2 * cs_) : (q1 * cs_ - q2 * sn); kx[i] = 0.125f * (hi ? (k1 * sn + k2 * cs_) : (k1 * cs_ - k2 * sn)); lw[i] = lgam; v[i] = ubf(R.x[2][i]); }
    }
    float cu[8]; { float run = 0.f;
#pragma unroll
        for (int i = 0; i < 8; ++i) { run += lw[i]; cu[i] = run; }
        SEG[wave_ * 64 + k_] = run; }
    LDS_BARRIER();
    float cm, ce; { float pre = 0.f, tot = 0.f, mid = 0.f;
#pragma unroll
        for (int w = 0; w < 8; ++w) { const float s = SEG[w * 64 + k_]; if (w < wave_) pre += s; if (w < 4) mid += s; tot += s; }
        cm = mid; ce = tot;
#pragma unroll
        for (int i = 0; i < 8; ++i) cu[i] += pre; }
    {   float e1[8], e2[8], e3[8];
#pragma unroll
        for (int i = 0; i < 8; ++i) { const float ef = __expf(cu[i] - cm); e1[i] = q[i] * ef; e2[i] = kx[i] * __builtin_amdgcn_rcpf(ef); e3[i] = kx[i] * __expf(ce - cu[i]); }
        *(LAS v4u*)(R1 + k_ * 72 + 8 * wave_) = pack8v(e1); *(LAS v4u*)(K1 + k_ * 72 + 8 * wave_) = pack8v(e2); *(LAS v4u*)(KeT + k_ * 72 + 8 * wave_) = pack8v(e3); *(LAS v4u*)(VT + k_ * 72 + 8 * wave_) = pack8v(v);
        if (MIX == 2) {
#pragma unroll
            for (int i = 0; i < 8; ++i) { const float ef = __expf(cu[i] - cm); e1[i] = av[i] * __expf(cu[i] - lw[i] - cm); e2[i] = bv[i] * __builtin_amdgcn_rcpf(ef); e3[i] = bv[i] * __expf(ce - cu[i]); }
            *(LAS v4u*)(A1 + k_ * 72 + 8 * wave_) = pack8v(e1); *(LAS v4u*)(B1 + k_ * 72 + 8 * wave_) = pack8v(e2); *(LAS v4u*)(BeT + k_ * 72 + 8 * wave_) = pack8v(e3); }
        if (wave_ == 0) { ecm[k_] = __expf(cm); *(GAS float*)(rec + (MIX == 2 ? RO_GAM : GO_GAM) + 4 * k_) = __expf(ce); }
    }
    LDS_BARRIER();
    if (nMIX >= 0) pre_load(F, R, nMIX, b, nh, c);
    f32x4 acc[2];
    tn16(acc, R1, K1, mb, nb0, lane_); hst<1>(acc, M1, mb, nb0, lane_);
    hfrag_trs(R1, ecm, rec + (MIX == 2 ? RO_QH : GO_QH), wave_, lane_);
    nt16(acc, KeT, VT, mb, nb0, lane_); if (MIX == 2) cacc(acc, nullptr, rec + RO_VB + 2048, mb, nb0, lane_, 4096); else cacc(acc, nullptr, rec + GO_SK, mb, nb0, lane_);
    if (MIX == 2) {
        tn16(acc, A1, B1, mb, nb0, lane_); cst<2>(acc, LL, mb, nb0, lane_);
        tn16(acc, R1, B1, mb, nb0, lane_); hst<1>(acc, M2, mb, nb0, lane_);
        tn16(acc, A1, K1, mb, nb0, lane_); hst<2>(acc, M3, mb, nb0, lane_);
        hfrag_trs(A1, ecm, rec + RO_AT, wave_, lane_);
        hfrag(BeT, nullptr, rec + RO_BH, wave_, lane_);
    }
    LDS_BARRIER();
    nt16(acc, M1, VT, mb, nb0, lane_);
#pragma unroll
    for (int n = 0; n < 2; ++n)
#pragma unroll
        for (int r = 0; r < 4; ++r) A1[(16 * mb + 4 * fq + r) * 72 + 16 * (nb0 + n) + fr] = (bf16)f2bf(acc[n][r]);
    if (MIX == 2) {
        nt16(acc, M3, VT, mb, nb0, lane_); cacc(acc, nullptr, rec + RO_VB, mb, nb0, lane_, 4096);
        const int t6 = ((wave_ & 1) == 1 && (wave_ >> 1) < 2) ? -1 : ((wave_ >> 1) < 2 ? (wave_ >> 1) : 2 + ((wave_ >> 1) - 2) * 2 + (wave_ & 1));
        hfrag(M2, nullptr, rec + RO_MRB, wave_, lane_, t6);
        tri_inverse(F, LL, T32, WW);
        cfrag(T32, rec + RO_TT, wave_, lane_, t6);
    }
    LDS_BARRIER();
}
constexpr size_t WS_REC_RW = 14 * MiB, WS_REC_GL = 412 * MiB;
__device__ __forceinline__ void oloc_flush(Frame& F, int m, int t0, int h) {
    const int t = F.tid >> 3, pc = F.tid & 7; const v4u w = *(const LAS v4u*)(HBUF(0) + t * 72 + 8 * pc);
    *(GAS v4u*)(WSP(bf16, WS_O) + (size_t)m * TOK * 256 + (size_t)(t0 + t) * 256 + 64 * h + 8 * pc) = w;
}
__device__ __forceinline__ unsigned char* pre_rec(Frame& F, int m, int b, int h, int c) {
    return (m == 2) ? F.ws + WS_REC_RW + (size_t)(((b * 4 + h) * 64) + c) * REC_RW : F.ws + WS_REC_GL + (size_t)((((m == 3 ? 2 : m) * 16 + b * 4 + h) * 64) + c) * REC_GL;
}
__device__ __forceinline__ void phase_chunkpre(Frame& F, int l) {
    for (int tile = F.vcu; tile < TOK / 64; tile += F.G) {
        const int b = tile >> 6, c = tile & 63;
        rwprep_tile(F, l, tile);
        __syncthreads();
        PreRaw cur;
        pre_load(F, cur, 0, b, 0, c);
#pragma unroll 1
        for (int i = 0; i < 16; ++i) {
            const int mo = i >> 2, m = (mo == 2) ? 3 : (mo == 3 ? 2 : mo), h = i & 3;
            const int mo2 = (i + 1) >> 2, m2 = (i + 1 < 16) ? ((mo2 == 2) ? 3 : (mo2 == 3 ? 2 : mo2)) : -1;
            chunk_pre(F, cur, l, m, b, h, c, pre_rec(F, m, b, h, c), m2, (i + 1) & 3);
            oloc_flush(F, m, b * SEQ + c * 64, h);
        }
    }
}
__device__ __forceinline__ bf16x8 pack_b(const f32x4 a, const f32x4 b) { v4u w; w.x = pk2(a.x, a.y); w.y = pk2(a.z, a.w); w.z = pk2(b.x, b.y); w.w = pk2(b.z, b.w); return __builtin_bit_cast(bf16x8, w); }
__device__ __forceinline__ f32x4 unpk4(const v2u w) { return (f32x4){bflo(w.x), bfhi(w.x), bflo(w.y), bfhi(w.y)}; }
template <int NF> struct SeqRegs { v4u r[NF]; v4u tail; };
template <int NF, int NLT, bool TAIL> __device__ __forceinline__ void seq_ld(SeqRegs<NF>& R, const unsigned char* rec, int lt) {
    const GAS v4u* src = (const GAS v4u*)rec;
#pragma unroll
    for (int i = 0; i < NF; ++i) R.r[i] = src[i * NLT + lt];
    if (TAIL && lt < 16) R.tail = src[NF * NLT + lt];
}
template <int NF, int NLT, bool TAIL> __device__ __forceinline__ void seq_st(const SeqRegs<NF>& R, LAS unsigned char* slot, int lt) {
    LAS v4u* dst = (LAS v4u*)slot;
#pragma unroll
    for (int i = 0; i < NF; ++i) dst[i * NLT + lt] = R.r[i];
    if (TAIL && lt < 16) dst[NF * NLT + lt] = R.tail;
}
template <bool RW> __device__ __forceinline__ void seq_unit(Frame& F, int mix, int b, int h, int vb_, const unsigned char* recs) {
    constexpr int REC = RW ? REC_RW : REC_GL, SLOT = 61440, NCW = RW ? 1 : 4, LW0 = RW ? 2 : 4, NLT = (8 - LW0) * 64, NF = REC / (NLT * 16); constexpr bool TAIL = (REC % (NLT * 16)) != 0;
    static_assert(REC % (NLT * 16) == 0 || REC % (NLT * 16) == 256, "record = NF loader rounds (+ 256 B)");
    const bool loader = F.wave >= LW0, compute = F.wave < NCW; const int lt = F.tid - 64 * LW0;
    SeqRegs<NF> RA, RB;
    if (loader) { seq_ld<NF, NLT, TAIL>(RA, recs, lt); seq_st<NF, NLT, TAIL>(RA, F.lds, lt); seq_ld<NF, NLT, TAIL>(RB, recs + (size_t)1 * REC, lt); seq_ld<NF, NLT, TAIL>(RA, recs + (size_t)2 * REC, lt); }
    __syncthreads();
    f32x4 S[4];
#pragma unroll
    for (int kb = 0; kb < 4; ++kb) S[kb] = (f32x4){0.f, 0.f, 0.f, 0.f};
    const int vb = RW ? vb_ : (F.wave & 3), fr = F.lane & 15, fq = F.lane >> 4;
    bf16* Og_ = WSP(bf16, WS_OI) + OI_GEN + (size_t)(((mix == 3 ? 2 : mix) * 16 + b * 4 + h)) * (SEQ * 64);
    constexpr int OSO = 122880;
#define SEQ_FLUSH(cc) do { const LAS unsigned char* osr_ = F.lds + OSO + ((cc) & 1) * 8192 + (16 * vb + (F.lane >> 2)) * 128 + (F.lane & 3) * 32; bf16* dst_ = Og_ + ((size_t)(cc) * 64 + 16 * vb + (F.lane >> 2)) * 64 + (F.lane & 3) * 16; \
        const v4u a_ = *(const LAS v4u*)osr_, b_ = *(const LAS v4u*)(osr_ + 16); *(GAS v4u*)dst_ = a_; *(GAS v4u*)(dst_ + 8) = b_; } while (0)
#pragma unroll 1
    for (int c2 = 0; c2 < 64; c2 += 2) {
#pragma unroll
        for (int par = 0; par < 2; ++par) {
            const int c = c2 + par;
            if (loader) {
                if (par == 0) { seq_st<NF, NLT, TAIL>(RB, F.lds + SLOT, lt); if (c + 3 < 64) seq_ld<NF, NLT, TAIL>(RB, recs + (size_t)(c + 3) * REC, lt); }
                else { if (c + 1 < 64) seq_st<NF, NLT, TAIL>(RA, F.lds, lt); if (c + 3 < 64) seq_ld<NF, NLT, TAIL>(RA, recs + (size_t)(c + 3) * REC, lt); }
            } else if (compute) {
                const LAS unsigned char* R = F.lds + par * SLOT;
                const f32x4 z = (f32x4){0.f, 0.f, 0.f, 0.f};
                if (c > 0) SEQ_FLUSH(c - 1);
                bf16x8 fqh[8];
#pragma unroll
                for (int f = 0; f < 8; ++f) fqh[f] = *(const LAS bf16x8*)(R + (RW ? RO_QH : GO_QH) + (f * 64 + F.lane) * 16);
                bf16x8 bS[2]; bS[0] = pack_b(S[0], S[1]); bS[1] = pack_b(S[2], S[3]);
                asm volatile("s_waitcnt lgkmcnt(0)" ::: "memory"); __builtin_amdgcn_sched_barrier(0);
                f32x4 O[4]; bf16x8 bU[2];
#pragma unroll
                for (int mb = 0; mb < 4; ++mb) { O[mb] = z;
#pragma unroll
                    for (int ks = 0; ks < 2; ++ks) O[mb] = __builtin_amdgcn_mfma_f32_16x16x32_bf16(fqh[mb * 2 + ks], bS[ks], O[mb], 0, 0, 0); }
                if (RW) {
                    f32x4 X[4], U[4];
#pragma unroll
                    for (int mb = 0; mb < 4; ++mb) { X[mb] = unpk4(*(const LAS v2u*)(R + RO_Y + ((vb * 4 + mb) * 64 + F.lane) * 8));
#pragma unroll
                        for (int ks = 0; ks < 2; ++ks) X[mb] = __builtin_amdgcn_mfma_f32_16x16x32_bf16(*(const LAS bf16x8*)(R + RO_AT + ((mb * 2 + ks) * 64 + F.lane) * 16), bS[ks], X[mb], 0, 0, 0); }
                    bf16x8 bX[2]; bX[0] = pack_b(X[0], X[1]); bX[1] = pack_b(X[2], X[3]);
#pragma unroll
                    for (int mb = 0; mb < 4; ++mb) { U[mb] = z;
#pragma unroll
                        for (int ks = 0; ks < 2; ++ks) if (!(ks == 1 && mb < 2)) U[mb] = __builtin_amdgcn_mfma_f32_16x16x32_bf16(*(const LAS bf16x8*)(R + RO_TT + ((mb * 2 + ks) * 64 + F.lane) * 16), bX[ks], U[mb], 0, 0, 0); }
                    bU[0] = pack_b(U[0], U[1]); bU[1] = pack_b(U[2], U[3]);
#pragma unroll
                    for (int mb = 0; mb < 4; ++mb)
#pragma unroll
                        for (int ks = 0; ks < 2; ++ks) if (!(ks == 1 && mb < 2)) O[mb] = __builtin_amdgcn_mfma_f32_16x16x32_bf16(*(const LAS bf16x8*)(R + RO_MRB + ((mb * 2 + ks) * 64 + F.lane) * 16), bU[ks], O[mb], 0, 0, 0);
                }
#pragma unroll
                for (int kb = 0; kb < 4; ++kb) { const f32x4 g = *(const LAS f32x4*)(R + (RW ? RO_GAM : GO_GAM) + (16 * kb + 4 * fq) * 4); const f32x4 sk = unpk4(*(const LAS v2u*)(R + (RW ? RO_SK : GO_SK) + ((vb * 4 + kb) * 64 + F.lane) * 8));
                    f32x4 n = S[kb] * g + sk;
                    if (RW) {
#pragma unroll
                        for (int ks = 0; ks < 2; ++ks) n = __builtin_amdgcn_mfma_f32_16x16x32_bf16(*(const LAS bf16x8*)(R + RO_BH + ((kb * 2 + ks) * 64 + F.lane) * 16), bU[ks], n, 0, 0, 0);
                    }
                    S[kb] = n; }
#pragma unroll
                for (int mb = 0; mb < 4; ++mb)
#pragma unroll
                    for (int r = 0; r < 4; ++r) *(LAS bf16*)(F.lds + OSO + par * 8192 + (16 * mb + 4 * fq + r) * 128 + (16 * vb + fr) * 2) = (bf16)f2bf(O[mb][r]);
            }
            LDS_BARRIER();
        }
    }
    if (compute) SEQ_FLUSH(63);
#undef SEQ_FLUSH
    __syncthreads();
}
__device__ __forceinline__ int tri6(int mb, int ks) { return mb < 2 ? mb : 2 + (mb - 2) * 2 + ks; }
struct SeqRegs4 { v4u r[6]; v4u t; };
__device__ __forceinline__ void seq4_ld(SeqRegs4& R, const unsigned char* rec, int vb, int lt) {
    const GAS v4u* src = (const GAS v4u*)rec;
#pragma unroll
    for (int i = 0; i < 6; ++i) R.r[i] = src[i * 384 + lt];
    if (lt < 16) R.t = src[6 * 384 + lt];
    if (lt >= 128) R.t = *(const GAS v4u*)(rec + RO_VB + vb * 4096 + (lt - 128) * 16);
}
__device__ __forceinline__ void seq4_st(const SeqRegs4& R, LAS unsigned char* slot, int lt) {
    LAS v4u* dst = (LAS v4u*)slot;
#pragma unroll
    for (int i = 0; i < 6; ++i) dst[i * 384 + lt] = R.r[i];
    if (lt < 16) dst[6 * 384 + lt] = R.t;
    if (lt >= 128) *(LAS v4u*)(slot + 37120 + (lt - 128) * 16) = R.t;
}
__device__ __forceinline__ void seq_rw(Frame& F, int b, int h, int vb, const unsigned char* recs) {
    constexpr int REC = REC_RW, SLOT = 41216, EXO = 3 * SLOT;
    const bool loader = F.wave >= 2; const int lt = F.tid - 128;
    SeqRegs4 RA, RB, RC;
    if (loader) { seq4_ld(RA, recs, vb, lt); seq4_st(RA, F.lds, lt); seq4_ld(RB, recs + (size_t)1 * REC, vb, lt); seq4_ld(RC, recs + (size_t)2 * REC, vb, lt); seq4_ld(RA, recs + (size_t)3 * REC, vb, lt); }
    __syncthreads();
    f32x4 S[4];
#pragma unroll
    for (int kb = 0; kb < 4; ++kb) S[kb] = (f32x4){0.f, 0.f, 0.f, 0.f};
    const int fr = F.lane & 15, fq = F.lane >> 4;
    bf16* Og_ = WSP(bf16, WS_OI) + (size_t)((b * 4 + h) * 4 + vb) * (SEQ * 16);
    LAS unsigned char* OS = F.lds + EXO + 8192;
#pragma unroll 1
    for (int c2 = 0; c2 < 66; c2 += 3) {
#pragma unroll
        for (int j3 = 0; j3 < 3; ++j3) {
            const int c = c2 + j3; const int par = c & 1;
            if (loader) {
                LAS unsigned char* dst = F.lds + ((j3 + 1) % 3) * SLOT; const unsigned char* nrec = recs + (size_t)(c + 4) * REC;
                if (c + 1 < 64) { if (j3 == 0) seq4_st(RB, dst, lt); else if (j3 == 1) seq4_st(RC, dst, lt); else seq4_st(RA, dst, lt); }
                if (c + 4 < 64) { if (j3 == 0) seq4_ld(RB, nrec, vb, lt); else if (j3 == 1) seq4_ld(RC, nrec, vb, lt); else seq4_ld(RA, nrec, vb, lt); }
            } else if (F.wave == 0) {
                if (c < 64) {
                    const LAS unsigned char* R = F.lds + (c % 3) * SLOT; LAS unsigned char* EX = F.lds + EXO + par * 4096;
                    const f32x4 z = (f32x4){0.f, 0.f, 0.f, 0.f};
                    v2u yv[4]; bf16x8 fat[8], ftt[6];
#pragma unroll
                    for (int mb = 0; mb < 4; ++mb) yv[mb] = *(const LAS v2u*)(R + 37120 + (mb * 64 + F.lane) * 8);
#pragma unroll
                    for (int f = 0; f < 8; ++f) fat[f] = *(const LAS bf16x8*)(R + RO_AT + (f * 64 + F.lane) * 16);
                    bf16x8 bS[2]; bS[0] = pack_b(S[0], S[1]); bS[1] = pack_b(S[2], S[3]);
                    *(LAS bf16x8*)(EX + F.lane * 16) = bS[0]; *(LAS bf16x8*)(EX + 1024 + F.lane * 16) = bS[1];
                    asm volatile("s_waitcnt lgkmcnt(0)" ::: "memory"); __builtin_amdgcn_sched_barrier(0);
                    f32x4 X[4], U[4];
#pragma unroll
                    for (int mb = 0; mb < 4; ++mb) { X[mb] = unpk4(yv[mb]);
#pragma unroll
                        for (int ks = 0; ks < 2; ++ks) X[mb] = __builtin_amdgcn_mfma_f32_16x16x32_bf16(fat[mb * 2 + ks], bS[ks], X[mb], 0, 0, 0); }
                    __builtin_amdgcn_sched_barrier(0);
                    bf16x8 fbh[8]; f32x4 gm[4]; v2u skv[4];
#pragma unroll
                    for (int f = 0; f < 6; ++f) ftt[f] = *(const LAS bf16x8*)(R + RO_TT + (f * 64 + F.lane) * 16);
#pragma unroll
                    for (int f = 0; f < 8; ++f) fbh[f] = *(const LAS bf16x8*)(R + RO_BH + (f * 64 + F.lane) * 16);
#pragma unroll
                    for (int kb = 0; kb < 4; ++kb) { gm[kb] = *(const LAS f32x4*)(R + RO_GAM + (16 * kb + 4 * fq) * 4); skv[kb] = *(const LAS v2u*)(R + 37120 + 2048 + (kb * 64 + F.lane) * 8); }
                    __builtin_amdgcn_sched_barrier(0);
                    bf16x8 bX[2]; bX[0] = pack_b(X[0], X[1]); bX[1] = pack_b(X[2], X[3]);
#pragma unroll
                    for (int mb = 0; mb < 4; ++mb) { U[mb] = z;
#pragma unroll
                        for (int ks = 0; ks < 2; ++ks) if (!(ks == 1 && mb < 2)) U[mb] = __builtin_amdgcn_mfma_f32_16x16x32_bf16(ftt[tri6(mb, ks)], bX[ks], U[mb], 0, 0, 0); }
                    bf16x8 bU[2]; bU[0] = pack_b(U[0], U[1]); bU[1] = pack_b(U[2], U[3]);
                    *(LAS bf16x8*)(EX + 2048 + F.lane * 16) = bU[0]; *(LAS bf16x8*)(EX + 3072 + F.lane * 16) = bU[1];
                    asm volatile("s_waitcnt lgkmcnt(0)" ::: "memory"); __builtin_amdgcn_sched_barrier(0);
#pragma unroll
                    for (int kb = 0; kb < 4; ++kb) { f32x4 n = S[kb] * gm[kb] + unpk4(skv[kb]);
#pragma unroll
                        for (int ks = 0; ks < 2; ++ks) n = __builtin_amdgcn_mfma_f32_16x16x32_bf16(fbh[kb * 2 + ks], bU[ks], n, 0, 0, 0);
                        S[kb] = n; }
                }
            } else {
                if (c >= 1 && c <= 64) {
                    const int co = c - 1; const LAS unsigned char* R = F.lds + (co % 3) * SLOT; const LAS unsigned char* EX = F.lds + EXO + (par ^ 1) * 4096;
                    bf16x8 fq_[8], fm[6];
#pragma unroll
                    for (int f = 0; f < 8; ++f) fq_[f] = *(const LAS bf16x8*)(R + RO_QH + (f * 64 + F.lane) * 16);
#pragma unroll
                    for (int f = 0; f < 6; ++f) fm[f] = *(const LAS bf16x8*)(R + RO_MRB + (f * 64 + F.lane) * 16);
                    const bf16x8 bS0 = *(const LAS bf16x8*)(EX + F.lane * 16), bS1 = *(const LAS bf16x8*)(EX + 1024 + F.lane * 16), bU0 = *(const LAS bf16x8*)(EX + 2048 + F.lane * 16), bU1 = *(const LAS bf16x8*)(EX + 3072 + F.lane * 16);
                    asm volatile("s_waitcnt lgkmcnt(0)" ::: "memory"); __builtin_amdgcn_sched_barrier(0);
                    f32x4 O[4];
#pragma unroll
                    for (int mb = 0; mb < 4; ++mb) { O[mb] = (f32x4){0.f, 0.f, 0.f, 0.f};
                        O[mb] = __builtin_amdgcn_mfma_f32_16x16x32_bf16(fq_[mb * 2], bS0, O[mb], 0, 0, 0);
                        O[mb] = __builtin_amdgcn_mfma_f32_16x16x32_bf16(fq_[mb * 2 + 1], bS1, O[mb], 0, 0, 0);
                        O[mb] = __builtin_amdgcn_mfma_f32_16x16x32_bf16(fm[tri6(mb, 0)], bU0, O[mb], 0, 0, 0);
                        if (mb >= 2) O[mb] = __builtin_amdgcn_mfma_f32_16x16x32_bf16(fm[tri6(mb, 1)], bU1, O[mb], 0, 0, 0); }
#pragma unroll
                    for (int mb = 0; mb < 4; ++mb)
#pragma unroll
                        for (int r = 0; r < 4; ++r) *(LAS bf16*)(OS + (16 * mb + 4 * fq + r) * 32 + fr * 2) = (bf16)f2bf(O[mb][r]);
                    asm volatile("s_waitcnt lgkmcnt(0)" ::: "memory");
                    { const v4u a_ = *(const LAS v4u*)(OS + F.lane * 32), b_ = *(const LAS v4u*)(OS + F.lane * 32 + 16); bf16* dst_ = Og_ + ((size_t)co * 64 + F.lane) * 16; *(GAS v4u*)dst_ = a_; *(GAS v4u*)(dst_ + 8) = b_; }
                    asm volatile("s_waitcnt lgkmcnt(0)" ::: "memory");
                }
            }
            LDS_BARRIER();
        }
    }
    __syncthreads();
}
__device__ __forceinline__ void phase_seq(Frame& F, int l) {
    for (int u = blockIdx.x; u < 112; u += F.G) {
        if (u < 64) { const int bh = u >> 2, vb = u & 3; seq_rw(F, bh >> 2, bh & 3, vb, F.ws + WS_REC_RW + (size_t)(bh * 64) * REC_RW); }
        else { const int v = u - 64, mm = v % 3, bh = v / 3; seq_unit<false>(F, mm == 2 ? 3 : mm, bh >> 2, bh & 3, 0, F.ws + WS_REC_GL + (size_t)((mm * 16 + bh) * 64) * REC_GL); }
    }
}
struct PostRaw { v4u o0, o1; v4u y0, y1; v4u x0, x1, x2, x3, x4, x5, x6, x7; };
__device__ __forceinline__ void post_load(Frame& F, PostRaw& R, int t, int m, int c0) {
    const bf16* P = WSP(const bf16, WS_P);
    const bf16* Ob = WSP(const bf16, WS_O) + (size_t)m * TOK * 256 + (size_t)t * 256 + c0;
    R.o0 = *(const GAS v4u*)(Ob); R.o1 = *(const GAS v4u*)(Ob + 8);
    { const int bb = t >> 12, tb = t & (SEQ - 1), hh = c0 >> 6, qq = (c0 >> 4) & 3; const bf16* oi = WSP(const bf16, WS_OI) + (m == 2 ? ((size_t)((bb * 4 + hh) * 4 + qq) * SEQ + tb) * 16 : OI_GEN + ((size_t)(((m == 3 ? 2 : m) * 16 + bb * 4 + hh)) * SEQ + tb) * 64 + 16 * qq);
      R.y0 = *(const GAS v4u*)oi; R.y1 = *(const GAS v4u*)(oi + 8); }
    const v4u zz = (v4u){0u, 0u, 0u, 0u}; R.x2 = zz; R.x3 = zz; R.x4 = zz; R.x5 = zz; R.x6 = zz; R.x7 = zz;
    if (m != 2) { const int gc = (m == 0 ? HG_G : m == 1 ? GL_R : RT_G) + c0; R.x0 = *(const GAS v4u*)(P + (size_t)t * NP + gc); R.x1 = *(const GAS v4u*)(P + (size_t)t * NP + gc + 8); }
    else { const size_t ob = (size_t)t * 256 + c0;
        R.x0 = *(const GAS v4u*)(WSP(const bf16, WS_RWR) + ob); R.x1 = *(const GAS v4u*)(WSP(const bf16, WS_RWR) + ob + 8); R.x2 = *(const GAS v4u*)(WSP(const bf16, WS_RWK) + ob); R.x3 = *(const GAS v4u*)(WSP(const bf16, WS_RWK) + ob + 8);
        R.x4 = *(const GAS v4u*)(WSP(const bf16, WS_RWV) + ob); R.x5 = *(const GAS v4u*)(WSP(const bf16, WS_RWV) + ob + 8); R.x6 = *(const GAS v4u*)(WSP(const bf16, WS_RWG) + ob); R.x7 = *(const GAS v4u*)(WSP(const bf16, WS_RWG) + ob + 8); }
}
__device__ __forceinline__ void unpack16(const v4u a, const v4u b, float (&f)[16]) { float x[8], y[8]; unpack8(a, x); unpack8(b, y);
#pragma unroll
    for (int j = 0; j < 8; ++j) { f[j] = x[j]; f[8 + j] = y[j]; } }
__device__ __forceinline__ void phase_post(Frame& F, int l) {
    const int gw = F.vcu * NWAVES + F.wave, NGW = F.G * NWAVES;
    const int m = F.lane >> 4, h = (F.lane >> 2) & 3, qd = F.lane & 3; const int c0 = 64 * h + 16 * qd;
    bf16* Y = WSP(bf16, WS_Y);
    PostRaw cur, nxt;
    if (gw < TOK) post_load(F, cur, gw, m, c0);
    for (int t = gw; t < TOK; t += NGW) {
        if (t + NGW < TOK) post_load(F, nxt, t + NGW, m, c0);
        float o[16], oi[16];
        unpack16(cur.o0, cur.o1, o);
        unpack16(cur.y0, cur.y1, oi);
        float s1 = 0.f, s2 = 0.f;
#pragma unroll
        for (int j = 0; j < 16; ++j) { o[j] += oi[j]; s1 += o[j]; s2 += o[j] * o[j]; }
        s1 = sum4(s1); s2 = sum4(s2);
        float y[16];
        if (m < 2) {
            const float rs = rsqrtf(s2 * (1.f / 64.f) + 1e-6f); const float* ng = INF(m == 0 ? 9 : 12) + l * 64 + 16 * qd;
            float g[16]; unpack16(cur.x0, cur.x1, g);
#pragma unroll
            for (int j = 0; j < 16; ++j) y[j] = o[j] * rs * ng[j] * (g[j] * sigm(g[j]));
        } else if (m == 2) {
            const float mean = s1 * (1.f / 64.f); float var = s2 * (1.f / 64.f) - mean * mean; var = fmaxf(var, 0.f); const float rs = rsqrtf(var + 64e-5f);
            float r[16], k[16], v[16], g[16]; unpack16(cur.x0, cur.x1, r); unpack16(cur.x2, cur.x3, k); unpack16(cur.x4, cur.x5, v); unpack16(cur.x6, cur.x7, g);
            const float* rk = INF(21) + l * 256 + c0; const float* lg = INF(22) + l * 256 + c0; const float* lb = INF(23) + l * 256 + c0;
            float bon = 0.f;
#pragma unroll
            for (int j = 0; j < 16; ++j) bon += r[j] * k[j] * rk[j];
            bon = sum4(bon);
#pragma unroll
            for (int j = 0; j < 16; ++j) y[j] = ((o[j] - mean) * rs * lg[j] + lb[j] + bon * v[j]) * g[j];
        } else {
            const float mean = s1 * (1.f / 64.f); float var = s2 * (1.f / 64.f) - mean * mean; var = fmaxf(var, 0.f); const float rs = rsqrtf(var + 1e-5f);
            float g[16]; unpack16(cur.x0, cur.x1, g);
#pragma unroll
            for (int j = 0; j < 16; ++j) y[j] = (g[j] * sigm(g[j])) * ((o[j] - mean) * rs);
        }
        v4u w0, w1; w0.x = pk2(y[0], y[1]); w0.y = pk2(y[2], y[3]); w0.z = pk2(y[4], y[5]); w0.w = pk2(y[6], y[7]); w1.x = pk2(y[8], y[9]); w1.y = pk2(y[10], y[11]); w1.z = pk2(y[12], y[13]); w1.w = pk2(y[14], y[15]);
        GAS v4u* yo = (GAS v4u*)(Y + (size_t)t * D + 256 * m + c0); yo[0] = w0; yo[1] = w1;
        cur = nxt;
    }
}
template <int MODE> struct LnRaw { v2u h[4]; v2u d1[4], d2[4]; float g1, g2; };
template <int MODE> __device__ __forceinline__ void ln_load(Frame& F, LnRaw<MODE>& R, int m) {
    const GAS v2u* hr = (const GAS v2u*)(WSP(const bf16, WS_HB) + (size_t)m * D) + F.lane;
#pragma unroll
    for (int j = 0; j < 4; ++j) R.h[j] = hr[64 * j];
    if (MODE == 0) { const GAS v2u* ar = (const GAS v2u*)(WSP(const bf16, WS_MIX) + (size_t)m * D) + F.lane;
#pragma unroll
        for (int j = 0; j < 4; ++j) R.d1[j] = ar[64 * j]; }
    else { const bf16* DOUT = WSP(const bf16, WS_DOUT); const float* GATE = WSP(const float, WS_GATE); R.g1 = GATE[2 * m]; R.g2 = GATE[2 * m + 1];
#pragma unroll
        for (int j = 0; j < 4; ++j) { R.d1[j] = ((const GAS v2u*)(DOUT + (size_t)(2 * m) * D))[F.lane + 64 * j]; R.d2[j] = ((const GAS v2u*)(DOUT + (size_t)(2 * m + 1) * D))[F.lane + 64 * j]; } }
}
template <int MODE, bool ROUTE> __device__ __forceinline__ void phase_ln(Frame& F, const float* gw_, const float* bw_, const float* router, int mi, const bool final_out = false) {
    const int gw = F.vcu * NWAVES + F.wave, NGW = F.G * NWAVES;
    bf16* hb = WSP(bf16, WS_HB); float* GATE = WSP(float, WS_GATE);
    LAS float* RT = (LAS float*)F.lds;
    if (ROUTE) { for (int i = F.tid; i < D * NE; i += NWAVES * 64) RT[(i & 7) * D + (i >> 3)] = router[i]; __syncthreads(); }
    f32x4 gv[4], bv[4];
#pragma unroll
    for (int j = 0; j < 4; ++j) { gv[j] = ((const GAS f32x4*)gw_)[F.lane + 64 * j]; bv[j] = ((const GAS f32x4*)bw_)[F.lane + 64 * j]; }
    LnRaw<MODE> cur, nxt;
    if (gw < TOK) ln_load<MODE>(F, cur, gw);
    for (int m = gw; m < TOK; m += NGW) {
        if (m + NGW < TOK) ln_load<MODE>(F, nxt, m + NGW);
        GAS f32x4* hr = (GAS f32x4*)(F.h + (size_t)m * D) + F.lane;
        f32x4 v[4]; float s = 0.f;
#pragma unroll
        for (int j = 0; j < 4; ++j) {
            f32x4 a;
            if (MODE == 0) { const v2u d1 = cur.d1[j]; a = (f32x4){bflo(d1.x), bfhi(d1.x), bflo(d1.y), bfhi(d1.y)}; }
            else { const v2u d1 = cur.d1[j], d2 = cur.d2[j]; const float g1 = cur.g1, g2 = cur.g2;
                a.x = g1 * bflo(d1.x) + g2 * bflo(d2.x); a.y = g1 * bfhi(d1.x) + g2 * bfhi(d2.x); a.z = g1 * bflo(d1.y) + g2 * bflo(d2.y); a.w = g1 * bfhi(d1.y) + g2 * bfhi(d2.y); }
            const v2u hq = cur.h[j]; const f32x4 hv = (f32x4){bflo(hq.x), bfhi(hq.x), bflo(hq.y), bfhi(hq.y)};
            v[j] = hv * DN_ALPHA + a; s += (v[j].x + v[j].y) + (v[j].z + v[j].w); }
        const float mean = wave_sum(s) * (1.f / D); float s2 = 0.f;
#pragma unroll
        for (int j = 0; j < 4; ++j) { v[j] = v[j] - mean; s2 += (v[j].x * v[j].x + v[j].y * v[j].y) + (v[j].z * v[j].z + v[j].w * v[j].w); }
        const float rstd = 1.f / sqrtf(wave_sum(s2) * (1.f / D) + 1e-5f);
        GAS v2u* o8 = (GAS v2u*)(hb + (size_t)m * D) + F.lane;
#pragma unroll
        for (int j = 0; j < 4; ++j) { v[j] = v[j] * rstd * gv[j] + bv[j]; if (final_out) hr[64 * j] = v[j]; v2u w; w.x = pk2(v[j].x, v[j].y); w.y = pk2(v[j].z, v[j].w); o8[64 * j] = w; }
        if (ROUTE) {
            float lg[8];
#pragma unroll
            for (int e = 0; e < 8; ++e) { float a = 0.f;
#pragma unroll
                for (int j = 0; j < 4; ++j) { const f32x4 r = *(const LAS f32x4*)(RT + e * D + 4 * (F.lane + 64 * j)); a += (v[j].x * r.x + v[j].y * r.y) + (v[j].z * r.z + v[j].w * r.w); }
                lg[e] = wave_sum(a); }
            int e1 = 0; float l1 = lg[0];
#pragma unroll
            for (int e = 1; e < 8; ++e) if (lg[e] > l1) { l1 = lg[e]; e1 = e; }
            int e2 = -1; float l2 = -3.0e38f;
#pragma unroll
            for (int e = 0; e < 8; ++e) if (e != e1 && lg[e] > l2) { l2 = lg[e]; e2 = e; }
            if (F.lane == 0) {
                const float p2 = __expf(l2 - l1); const float ga = 1.f / (1.f + p2);
                GATE[2 * m] = ga; GATE[2 * m + 1] = p2 * ga;
                int* list = WSP(int, WS_LIST) + (size_t)mi * NE * TOK;
                const unsigned p1 = __hip_atomic_fetch_add((unsigned*)(F.ctl + CW_CNT + (mi * 8 + e1) * 64), 1u, RLX_AGENT); list[e1 * TOK + p1] = 2 * m;
                const unsigned q2 = __hip_atomic_fetch_add((unsigned*)(F.ctl + CW_CNT + (mi * 8 + e2) * 64), 1u, RLX_AGENT); list[e2 * TOK + q2] = 2 * m + 1;
            }
        }
        cur = nxt;
    }
}
__device__ __forceinline__ void phase_gather(Frame& F, int mi) {
    int cnt[8], poff[9]; poff[0] = 0;
    unsigned* cb_ = (unsigned*)(F.ctl + CW_CNT + mi * 8 * 64); asm volatile("" : "+s"(cb_));
#pragma unroll
    for (int e = 0; e < 8; ++e) { cnt[e] = (int)__hip_atomic_load(cb_ + e * 64, RLX_AGENT); poff[e + 1] = poff[e] + ((cnt[e] + 255) >> 8); }
    const int npan = poff[8];
    int* tab = WSP(int, WS_TAB) + mi * TAB_STRIDE;
    if (blockIdx.x == 0) {
        for (int P = F.tid; P < npan; P += NWAVES * 64) { int e = 0, pe = 0, ce = cnt[0];
#pragma unroll
            for (int j = 1; j < 8; ++j) if (P >= poff[j]) { e = j; pe = poff[j]; ce = cnt[j]; }
            tab[4 * P] = e; tab[4 * P + 1] = 256 * (P - pe); tab[4 * P + 2] = ce; tab[4 * P + 3] = 0; }
        if (F.tid == 0) tab[640] = npan;
    }
    const int gw = F.vcu * NWAVES + F.wave, NGW = F.G * NWAVES;
    const int* list = WSP(const int, WS_LIST) + (size_t)mi * NE * TOK; const bf16* hb = WSP(const bf16, WS_HB); bf16* HP = WSP(bf16, WS_HPERM);
    for (int row = gw; row < 256 * npan; row += NGW) { const int P = row >> 8; int e = 0, pe = 0, ce = cnt[0];
#pragma unroll
        for (int j = 1; j < 8; ++j) if (P >= poff[j]) { e = j; pe = poff[j]; ce = cnt[j]; }
        const int r = row - 256 * pe; const int tok = (r < ce) ? (list[e * TOK + r] >> 1) : 0;
        const GAS v4u* s = (const GAS v4u*)(hb + (size_t)tok * D) + F.lane; GAS v4u* d = (GAS v4u*)(HP + (size_t)row * D) + F.lane; d[0] = s[0]; d[64] = s[64]; }
}
struct Args { const void* in[36]; int ph_lo, ph_hi; };
__global__ void __launch_bounds__(NWAVES * 64, 2) mk_fwd(Args args) {
    extern __shared__ __attribute__((aligned(16))) unsigned char lds[];
    Frame F;
    F.lds = (LAS unsigned char*)lds;
    F.MISC = (volatile LAS unsigned*)(F.lds + MISC_OFF);
    F.tid = threadIdx.x; F.lane = F.tid & 63; F.wave = __builtin_amdgcn_readfirstlane(F.tid >> 6);
    const int wave_k = F.wave;
    F.G = gridDim.x; { const int bx = blockIdx.x; F.vcu = (F.G % 8 == 0) ? (bx % 8) * (F.G / 8) + bx / 8 : bx; }
    F.in = args.in; F.ws = (unsigned char*)ldptr(F.in, 35); F.h = (float*)ldptr(F.in, 34);
    F.ctl = (gu32*)(F.ws + WS_CTL);
    for (int u = F.tid; u < (LDS_BYTES - LDSCTL_OFF) / 4; u += NWAVES * 64) ((LAS unsigned*)(F.lds + LDSCTL_OFF))[u] = 0u;
    __syncthreads();
    XcdBarrier bar; bar.bar = (unsigned*)(F.ctl + CW_BAR); bar.x = 0; bar.st = nullptr; bar.wv = 0;
    if (!MK_PER_PHASE) bar = xcd_barrier_post((unsigned*)(F.ctl + CW_BAR), F.MISC + 8);
    const int lo = args.ph_lo, hi = args.ph_hi;
#define IN(k) (lo <= (k) && (k) < hi)
#define PHASE_BEGIN() do { int t_ = wave_k * 64 + lane_id_now(); asm volatile("" : "+v"(t_)); F.tid = t_; F.lane = t_ & 63; F.wave = wave_k; \
        F.ws = (unsigned char*)ldptr(F.in, 35); F.ctl = (gu32*)(F.ws + WS_CTL); F.h = (float*)ldptr(F.in, 34); } while (0)
#define SEAM(k) do { if (IN(k) && IN((k) + 1)) { xcd_barrier(bar); if (DUPMASK & 4096) xcd_barrier(bar); } } while (0)
    for (int l = 0; l < DEPTH; ++l) {
        const int pb = l * NPH; const bool moe = (l & 1); const int mi = l >> 1;
#define PH(k) (((PHMASK >> (k)) & 1) && IN(pb + (k)))
        if (l == 0) { if (PH(0)) { PHASE_BEGIN(); phase_weights<0>(F, 0); } SEAM(pb + 0); }
        if (PH(1)) for (int rep_ = 0; rep_ < (((DUPMASK >> 1) & 1) ? 2 : 1); ++rep_) { PHASE_BEGIN(); if (rep_) __syncthreads();
            pg8::Gemm g{WSP(const bf16, WS_HB), WSP(const bf16, WS_WIN), TOK, NP, D}; pg8::StaticOrder S; S.init(TOK, NP, F.G, (int)blockIdx.x);
            pg8::EpiBf16 E{WSP(bf16, WS_P), NP};
            pg8::gemm_phase<pg8::EpiBf16, pg8::StaticOrder, true, true>(F.lds, g, S, E, F.wave);
        } SEAM(pb + 1);
        if (PH(3)) { PHASE_BEGIN(); phase_chunkpre(F, l); if (DUPMASK & 8) { __syncthreads(); phase_chunkpre(F, l); } } SEAM(pb + 3);
        if (PH(4)) { PHASE_BEGIN(); phase_seq(F, l); if (DUPMASK & 16) { __syncthreads(); phase_seq(F, l); } } SEAM(pb + 4);
        if (PH(5)) { PHASE_BEGIN(); phase_post(F, l); __syncthreads(); phase_weights<1>(F, l); if (DUPMASK & 32) { __syncthreads(); phase_weights<1>(F, l); } } SEAM(pb + 5);
        if (PH(6)) for (int rep_ = 0; rep_ < (((DUPMASK >> 6) & 1) ? 2 : 1); ++rep_) { PHASE_BEGIN(); if (rep_) __syncthreads();
            pg8::Gemm g{WSP(const bf16, WS_Y), WSP(const bf16, WS_WOUT), TOK, D, D}; pg8::StaticOrder S; S.init(TOK, D, F.G, (int)blockIdx.x);
            pg8::EpiBf16 E{WSP(bf16, WS_MIX), D};
            pg8::gemm_phase<pg8::EpiBf16, pg8::StaticOrder, false, true>(F.lds, g, S, E, F.wave);
        } SEAM(pb + 6);
        if (PH(7)) { PHASE_BEGIN();
            if (moe) phase_ln<0, true>(F, INF(4) + l * D, INF(5) + l * D, INF(30) + (size_t)mi * D * NE, mi);
            else phase_ln<0, false>(F, INF(4) + l * D, INF(5) + l * D, nullptr, 0);
        } SEAM(pb + 7);
        if (PH(9)) for (int rep_ = 0; rep_ < (((DUPMASK >> 9) & 1) ? 2 : 1); ++rep_) { PHASE_BEGIN(); if (rep_) __syncthreads();
            if (!moe) { pg8::Gemm g{WSP(const bf16, WS_HB), WSP(const bf16, WS_WUP), TOK, 2 * FFD, D}; pg8::StaticOrder S; S.init(TOK, 2 * FFD, F.G, (int)blockIdx.x);
                pg8::EpiSwiGLU E{WSP(bf16, WS_HID), FFD, 22};
                pg8::gemm_phase<pg8::EpiSwiGLU, pg8::StaticOrder, true, true>(F.lds, g, S, E, F.wave);
            } else { pg8::MoeOrder<true> S; S.M.init((const unsigned*)(F.ctl + CW_CNT + mi * 8 * 64), WSP(const int, WS_LIST) + (size_t)mi * NE * TOK); const int npan = S.M.poff[8];
                S.tpg = 11; S.G = F.G; S.c = (int)blockIdx.x; S.nunits = npan * 11; S.rowbytes = D * 2;
                pg8::Gemm g{WSP(const bf16, WS_HB), WSP(const bf16, WS_WUP), 256 * npan, 2 * FFE, D};
                pg8::EpiSwiGLU E{WSP(bf16, WS_HID), FFE, 11};
                pg8::gemm_phase<pg8::EpiSwiGLU, pg8::MoeOrder<true>, true, true>(F.lds, g, S, E, F.wave);
            }
        } SEAM(pb + 9);
        if (PH(10)) for (int rep_ = 0; rep_ < (((DUPMASK >> 10) & 1) ? 2 : 1); ++rep_) { PHASE_BEGIN(); if (rep_) __syncthreads();
            if (!moe) { pg8::Gemm g{WSP(const bf16, WS_HID), WSP(const bf16, WS_WDN), TOK, D, FFD}; pg8::StaticOrder S; S.init(TOK, D, F.G, (int)blockIdx.x);
                pg8::EpiBf16 E{WSP(bf16, WS_MIX), D};
                pg8::gemm_phase<pg8::EpiBf16, pg8::StaticOrder, false, true>(F.lds, g, S, E, F.wave);
            } else { pg8::MoeOrder<false> S; S.M.init((const unsigned*)(F.ctl + CW_CNT + mi * 8 * 64), WSP(const int, WS_LIST) + (size_t)mi * NE * TOK); const int npan = S.M.poff[8];
                S.tpg = 4; S.G = F.G; S.c = (int)blockIdx.x; S.nunits = npan * 4; S.rowbytes = 0;
                pg8::Gemm g{WSP(const bf16, WS_HID), WSP(const bf16, WS_WDN), 256 * npan, D, FFE};
                pg8::EpiScatter E{WSP(bf16, WS_DOUT), S.M};
                pg8::gemm_phase<pg8::EpiScatter, pg8::MoeOrder<false>, true, true>(F.lds, g, S, E, F.wave);
            }
        } SEAM(pb + 10);
        if (PH(11)) { PHASE_BEGIN();
            if (moe) phase_ln<1, false>(F, INF(6) + l * D, INF(7) + l * D, nullptr, 0, l == DEPTH - 1);
            else phase_ln<0, false>(F, INF(6) + l * D, INF(7) + l * D, nullptr, 0, l == DEPTH - 1);
            if (l + 1 < DEPTH) { __syncthreads(); phase_weights<0>(F, l + 1); }
        } SEAM(pb + 11);
#undef PH
    }
#undef IN
#undef SEAM
}

extern "C" void kernel_launch(void* const* d_in, const int* in_sizes, int n_in, void* d_out, int out_size, void* d_ws, size_t ws_size, hipStream_t stream) {
    static int grid = 0;
    if (grid == 0) {
        if (n_in != 34 || out_size != TOK * D || ws_size < WS_END) { fprintf(stderr, "kernel_launch: unexpected shapes (n_in %d, out %d, ws %zu)\n", n_in, out_size, ws_size); grid = -1; return; }
        int dev = 0, cus = 0, per_cu = 0;
        if (hipGetDevice(&dev) != hipSuccess || hipDeviceGetAttribute(&cus, hipDeviceAttributeMultiprocessorCount, dev) != hipSuccess) { grid = -1; return; }
        if (hipFuncSetAttribute((const void*)mk_fwd, hipFuncAttributeMaxDynamicSharedMemorySize, LDS_BYTES) != hipSuccess) { fprintf(stderr, "kernel_launch: hipFuncSetAttribute failed\n"); grid = -1; return; }
        if (hipOccupancyMaxActiveBlocksPerMultiprocessor(&per_cu, (const void*)mk_fwd, NWAVES * 64, LDS_BYTES) != hipSuccess || per_cu < 1) fprintf(stderr, "kernel_launch: occupancy query reports %d\n", per_cu);
        (void)hipGetLastError();
        grid = cus;
    }
    if (grid < 0) return;
    if (hipMemsetAsync((char*)d_ws + WS_CTL, 0, CTL_ZERO_BYTES, stream) != hipSuccess) return;
    Args a{};
    for (int i = 0; i < 34; ++i) a.in[i] = d_in[i];
    a.in[34] = d_out; a.in[35] = d_ws;
#if MK_PER_PHASE
    for (int p = 0; p < NPHASES; ++p) { a.ph_lo = p; a.ph_hi = p + 1; hipLaunchKernelGGL(mk_fwd, dim3(grid), dim3(NWAVES * 64), LDS_BYTES, stream, a); }
#else
    a.ph_lo = 0; a.ph_hi = NPHASES; hipLaunchKernelGGL(mk_fwd, dim3(grid), dim3(NWAVES * 64), LDS_BYTES, stream, a);
#endif
}
```

```cpp
#include <hip/hip_runtime.h>
#include <cstdio>
#include <cstdint>
#ifndef PHMASK
#define PHMASK 0xfff
#endif
#ifndef DUPMASK
#define DUPMASK 0
#endif
#ifndef MK_PER_PHASE
#define MK_PER_PHASE 0
#endif
__device__ __forceinline__ int lane_id_now() { unsigned m_ = ~0u; asm volatile("" : "+s"(m_)); return (int)__builtin_amdgcn_mbcnt_hi(m_, __builtin_amdgcn_mbcnt_lo(m_, 0u)); }
namespace pg8 {
#define PG8_LAS __attribute__((address_space(3)))
typedef unsigned short bf16_t;
typedef short bf16x8 __attribute__((ext_vector_type(8)));
typedef float f32x4 __attribute__((ext_vector_type(4)));
typedef unsigned u32x4 __attribute__((ext_vector_type(4)));
constexpr int BM = 256, BK = 64, HALF = 128, HTB = HALF * BK * 2  , STAGE_BYTES = 8 * HTB, NXCD = 8, WGM = 8;

__host__ __device__ __forceinline__ int lds_byte(int r, int c) { const int st = (r >> 4) * 2 + (c >> 5), rr = r & 15, cc = c & 31, ob = rr * 64 + cc * 2; return st * 1024 + (ob ^ (((ob >> 9) & 1) << 5)); }
__host__ __device__ __forceinline__ void stage_rc(int b, int& R, int& C) { const int st = b / 1024, sb = b % 1024, swz = sb ^ (((sb >> 9) & 1) << 5); R = (st >> 1) * 16 + swz / 64; C = (st & 1) * 32 + (swz % 64) / 2; }
__host__ __device__ __forceinline__ int perm32(int rho) { const int n = rho >> 4, i = rho & 15; return 8 * (i >> 2) + 4 * n + (i & 3); }

struct Unit { int pm, pn; };
struct Gemm { const bf16_t* A; const bf16_t* Bt; int M, N, K; };

struct StaticOrder {
    static constexpr bool GATHER = false;
    int nM, nN, nwg, G, c;
    __device__ __forceinline__ unsigned a_off(const Unit&, int) const { return 0u; }
    __host__ __device__ void init(int M, int N, int G_, int c_) { nM = M / BM; nN = N / BM; nwg = nM * nN; G = G_; c = c_; }
    __host__ __device__ bool next(int i, Unit& u) const {
        const long L = (long)i * G + c; if (L >= nwg) return false;
        int wgid = (int)L; { const int q = nwg / NXCD, r = nwg % NXCD, xcd = wgid % NXCD, off = wgid / NXCD; wgid = (xcd < r ? xcd * (q + 1) : r * (q + 1) + (xcd - r) * q) + off; }
        const int nig = WGM * nN, gid = wgid / nig, fm = gid * WGM, gsz = (nM - fm) < WGM ? (nM - fm) : WGM;
        u.pm = fm + ((wgid % nig) % gsz); u.pn = (wgid % nig) / gsz; return true;
    }
    __device__ __forceinline__ void a_ready(const Unit&) const {}
    __device__ __forceinline__ void done(const Unit&) const {}
};
__device__ __forceinline__ unsigned cvt_pk_bf16(float lo, float hi) { unsigned r; asm volatile("v_cvt_pk_bf16_f32 %0, %1, %2" : "=v"(r) : "v"(lo), "v"(hi)); return r; }
typedef float f32x2 __attribute__((ext_vector_type(2)));
struct EpiBf16 {
    static constexpr bool PERM = true, AFTER_DRAIN = false;
    bf16_t* O; int ldc;
    __device__ __forceinline__ void operator()(const f32x4 (&acc)[2][2][4][2], const Unit& u, int wr, int wc, int fr, int fq) const {
        const int row0 = u.pm * BM + wr * 64 + fr; const int col0 = u.pn * BM + wc * 32 + 8 * fq;
#pragma unroll
        for (int ai = 0; ai < 2; ++ai)
#pragma unroll
            for (int m = 0; m < 4; ++m) { bf16_t* rowp = O + (size_t)(row0 + ai * HALF + m * 16) * ldc + col0;
#pragma unroll
                for (int bj = 0; bj < 2; ++bj) { const f32x4 v0 = acc[ai][bj][m][0], v1 = acc[ai][bj][m][1];
                    u32x4 w; w.x = cvt_pk_bf16(v0[0], v0[1]); w.y = cvt_pk_bf16(v0[2], v0[3]); w.z = cvt_pk_bf16(v1[0], v1[1]); w.w = cvt_pk_bf16(v1[2], v1[3]);
                    *(u32x4*)(rowp + bj * HALF) = w; } }
    }
};
struct EpiF32 {
    static constexpr bool PERM = false, AFTER_DRAIN = false;
    float* C; int ldc;
    __device__ __forceinline__ void operator()(const f32x4 (&acc)[2][2][4][2], const Unit& u, int wr, int wc, int fr, int fq) const {
        const int row0 = u.pm * BM + wr * 64 + fr, col0 = u.pn * BM + wc * 32 + 4 * fq;
#pragma unroll
        for (int ai = 0; ai < 2; ++ai)
#pragma unroll
            for (int m = 0; m < 4; ++m) { float* rowp = C + (size_t)(row0 + ai * HALF + m * 16) * ldc + col0;
#pragma unroll
                for (int bj = 0; bj < 2; ++bj)
#pragma unroll
                    for (int n = 0; n < 2; ++n) *(f32x4*)(rowp + bj * HALF + n * 16) = acc[ai][bj][m][n]; }
    }
};
__device__ __forceinline__ float silu_f(float x) { return x * __builtin_amdgcn_rcpf(1.0f + __expf(-x)); }
struct EpiSwiGLU {
    static constexpr bool PERM = true, AFTER_DRAIN = false;
    bf16_t* O; int ldc; int tiles_per_group;
    __device__ __forceinline__ void operator()(const f32x4 (&acc)[2][2][4][2], const Unit& u, int wr, int wc, int fr, int fq) const {
        const int row0 = u.pm * BM + wr * 64 + fr; const int pnl = u.pn % tiles_per_group; const int col0 = pnl * HALF + wc * 32 + 8 * fq;
#pragma unroll
        for (int ai = 0; ai < 2; ++ai)
#pragma unroll
            for (int m = 0; m < 4; ++m) { bf16_t* rowp = O + (size_t)(row0 + ai * HALF + m * 16) * ldc + col0;
                float h[8];
#pragma unroll
                for (int n = 0; n < 2; ++n)
#pragma unroll
                    for (int j = 0; j < 4; ++j) h[4 * n + j] = silu_f(acc[ai][0][m][n][j]) * acc[ai][1][m][n][j];
                u32x4 w; w.x = cvt_pk_bf16(h[0], h[1]); w.y = cvt_pk_bf16(h[2], h[3]); w.z = cvt_pk_bf16(h[4], h[5]); w.w = cvt_pk_bf16(h[6], h[7]);
                *(u32x4*)rowp = w; }
    }
};
struct EpiSwiGLU8 {
    static constexpr bool PERM = true, AFTER_DRAIN = false;
    bf16_t* O; int ldc; int tiles_per_group; const float* rs; float sw;
    __device__ __forceinline__ void operator()(const f32x4 (&acc)[2][2][4][2], const Unit& u, int wr, int wc, int fr, int fq) const {
        const int row0 = u.pm * BM + wr * 64 + fr; const int pnl = u.pn % tiles_per_group; const int col0 = pnl * HALF + wc * 32 + 8 * fq;
        float sc[2][4];
#pragma unroll
        for (int ai = 0; ai < 2; ++ai)
#pragma unroll
            for (int m = 0; m < 4; ++m) sc[ai][m] = rs[row0 + ai * HALF + m * 16] * sw;
#pragma unroll
        for (int ai = 0; ai < 2; ++ai)
#pragma unroll
            for (int m = 0; m < 4; ++m) { bf16_t* rowp = O + (size_t)(row0 + ai * HALF + m * 16) * ldc + col0;
                float h[8];
#pragma unroll
                for (int n = 0; n < 2; ++n)
#pragma unroll
                    for (int j = 0; j < 4; ++j) { const float ag = acc[ai][0][m][n][j], au = acc[ai][1][m][n][j]; const float g = (float)__float_as_int(ag) * sc[ai][m], up = (float)__float_as_int(au) * sc[ai][m];     h[4 * n + j] = silu_f(g) * up; }
                u32x4 w; w.x = cvt_pk_bf16(h[0], h[1]); w.y = cvt_pk_bf16(h[2], h[3]); w.z = cvt_pk_bf16(h[4], h[5]); w.w = cvt_pk_bf16(h[6], h[7]);
                *(u32x4*)rowp = w; }
    }
};
struct MoeMap {
    int cnt[8], poff[9]; const int* list;
    __device__ __forceinline__ void init(const unsigned* counters, const int* list_) { list = list_; poff[0] = 0;
#pragma unroll
        for (int e = 0; e < 8; ++e) { cnt[e] = (int)__hip_atomic_load(counters + e * 64, __ATOMIC_RELAXED, __HIP_MEMORY_SCOPE_AGENT); poff[e + 1] = poff[e] + ((cnt[e] + 255) >> 8); } }
    __device__ __forceinline__ void locate(int P, int& e, int& lr, int& ce) const { e = 0; int pe = 0; ce = cnt[0];
#pragma unroll
        for (int j = 1; j < 8; ++j) if (P >= poff[j]) { e = j; pe = poff[j]; ce = cnt[j]; }
        lr = 256 * (P - pe); }
};
struct EpiScatter {
    static constexpr bool PERM = true, AFTER_DRAIN = false;
    bf16_t* O; MoeMap M;
    __device__ __forceinline__ void operator()(const f32x4 (&acc)[2][2][4][2], const Unit& u, int wr, int wc, int fr, int fq) const {
        int e, lr, cnt; M.locate(u.pm, e, lr, cnt);
        const int pnl = u.pn & 3; const int col0 = pnl * BM + wc * 32 + 8 * fq; const int* lst = M.list + e * 16384;
#pragma unroll
        for (int ai = 0; ai < 2; ++ai)
#pragma unroll
            for (int m = 0; m < 4; ++m) { const int r = lr + wr * 64 + fr + ai * HALF + m * 16;
                if (r < cnt) { const int slot = lst[r]; bf16_t* rowp = O + (size_t)slot * 1024 + col0;
#pragma unroll
                    for (int bj = 0; bj < 2; ++bj) { const f32x4 v0 = acc[ai][bj][m][0], v1 = acc[ai][bj][m][1];
                        u32x4 w; w.x = cvt_pk_bf16(v0[0], v0[1]); w.y = cvt_pk_bf16(v0[2], v0[3]); w.z = cvt_pk_bf16(v1[0], v1[1]); w.w = cvt_pk_bf16(v1[2], v1[3]);
                        *(u32x4*)(rowp + bj * HALF) = w; } } }
    }
};
template <bool GATHER_> struct MoeOrder {
    static constexpr bool GATHER = GATHER_;
    MoeMap M; int tpg, G, c, nunits; unsigned rowbytes;
    __device__ __forceinline__ bool next(int i, Unit& u) const {
        const int L = i * G + c; if (L >= nunits) return false;
        int wgid = L; { const int q = nunits / NXCD, r = nunits % NXCD, xcd = wgid % NXCD, off = wgid / NXCD; wgid = (xcd < r ? xcd * (q + 1) : r * (q + 1) + (xcd - r) * q) + off; }
        const int P = wgid / tpg, pnl = wgid - P * tpg; int e, lr, ce; M.locate(P, e, lr, ce);
        u.pm = P; u.pn = e * tpg + pnl; return true;
    }
    __device__ __forceinline__ unsigned a_off(const Unit& u, int row) const {
        int e, lr, ce; M.locate(u.pm, e, lr, ce); const int r = lr + row; const int tok = (r < ce) ? (M.list[e * 16384 + r] >> 1) : 0; return (unsigned)tok * rowbytes; }
    __device__ __forceinline__ void a_ready(const Unit&) const {}
    __device__ __forceinline__ void done(const Unit&) const {}
};
typedef int i32x4 __attribute__((ext_vector_type(4)));
template <class Epi, class Sched, bool ALIGN_EPI = false, bool SP2 = false, int MT = 0  >
__device__ __forceinline__ void gemm_phase(PG8_LAS unsigned char* lds, const Gemm g, const Sched& S, const Epi& E, const int wave_in) {
    int tid_ = wave_in * 64 + lane_id_now(); asm volatile("" : "+v"(tid_));
    const int tid = tid_, wid = __builtin_amdgcn_readfirstlane(tid >> 6), lane = tid & 63, wr = wid >> 2, wc = wid & 3, fr = lane & 15, fq = lane >> 4;
    const int K = g.K, nt = K / BK;
    unsigned voffA[2], voffB[2];
#pragma unroll
    for (int i = 0; i < 2; ++i) { int R, C; stage_rc(tid * 16 + i * 8192, R, C); const int Rb = Epi::PERM ? ((R & ~31) + perm32(R & 31)) : R;
        voffA[i] = (unsigned)(R * K + C) * 2u; voffB[i] = (unsigned)(Rb * K + C) * 2u; }
    static_assert(!Sched::GATHER || SP2, "A-row gather is implemented for the SP2 loop");
    unsigned aoc[2][2], aon[2][2];
#define PG8_GOFF(dst, u) do { _Pragma("unroll") for (int _i = 0; _i < 2; ++_i) { int R_, C_; stage_rc(tid * 16 + _i * 8192, R_, C_); _Pragma("unroll") for (int _h = 0; _h < 2; ++_h) dst[_h][_i] = S.a_off(u, _h * HALF + R_) + (unsigned)(C_ * 2); } } while (0)
#define PG8_STAGE_A(bufoff, gbase, kofs, h, nx) do { if constexpr (Sched::GATHER) { const unsigned vo_[2] = {(nx) ? aon[h][0] : aoc[h][0], (nx) ? aon[h][1] : aoc[h][1]}; PG8_STAGE(bufoff, (const char*)g.A + (kofs), vo_); } else { PG8_STAGE(bufoff, gbase, voffA); } } while (0)
    const size_t kstep = (size_t)(BK * 2);
    const size_t hstep = (size_t)HALF * K * 2;
    const size_t tstep = 2 * hstep;
    const unsigned ldsw = (unsigned)wid * 1024u;
    const int aoff = lds_byte(wr * 64 + fr, fq * 8), boff = lds_byte(wc * 32 + fr, fq * 8);
#define PG8_SA(b, h) (((b) * 2 + (h)) * HTB)
#define PG8_SB(b, h) ((4 + (b) * 2 + (h)) * HTB)
#define PG8_STAGE(bufoff, gbase, voff) do { _Pragma("unroll") for (int _i = 0; _i < 2; ++_i) \
        __builtin_amdgcn_global_load_lds((const unsigned*)((const char*)(gbase) + (voff)[_i]), (PG8_LAS unsigned*)(lds + (bufoff) + ldsw + _i * 8192), 16, 0, 0); } while (0)
#define PG8_LDA(dst, b, h) do { _Pragma("unroll") for (int m = 0; m < 4; ++m) _Pragma("unroll") for (int k = 0; k < 2; ++k) dst[m][k] = *(const PG8_LAS bf16x8*)(lds + PG8_SA(b, h) + aoff + m * 2048 + k * 1024); } while (0)
#define PG8_LDB(dst, b, h) do { _Pragma("unroll") for (int n = 0; n < 2; ++n) _Pragma("unroll") for (int k = 0; k < 2; ++k) dst[n][k] = *(const PG8_LAS bf16x8*)(lds + PG8_SB(b, h) + boff + n * 2048 + k * 1024); } while (0)
#define PG8_MMA(ai, bj, At, Bt) do { __builtin_amdgcn_s_setprio(1); _Pragma("unroll") for (int m = 0; m < 4; ++m) _Pragma("unroll") for (int n = 0; n < 2; ++n) _Pragma("unroll") for (int k = 0; k < 2; ++k) \
        { if constexpr (MT == 0) acc[ai][bj][m][n] = __builtin_amdgcn_mfma_f32_16x16x32_bf16(Bt[n][k], At[m][k], acc[ai][bj][m][n], 0, 0, 0); \
          else acc[ai][bj][m][n] = __builtin_bit_cast(f32x4, __builtin_amdgcn_mfma_i32_16x16x64_i8(__builtin_bit_cast(i32x4, Bt[n][k]), __builtin_bit_cast(i32x4, At[m][k]), __builtin_bit_cast(i32x4, acc[ai][bj][m][n]), 0, 0, 0)); } \
        __builtin_amdgcn_s_setprio(0); } while (0)
#define PG8_WAIT_V(n) asm volatile("s_waitcnt vmcnt(" #n ")" ::: "memory")
#define PG8_WAIT_L(n) asm volatile("s_waitcnt lgkmcnt(" #n ")" ::: "memory")
#define PG8_BAR __builtin_amdgcn_s_barrier()
#define PG8_SCHED __builtin_amdgcn_sched_barrier(0)
    Unit cur, nxt; int ui = 0;
    if (!S.next(0, cur)) return;
    f32x4 acc[2][2][4][2];
#pragma unroll
    for (int a = 0; a < 2; ++a)
#pragma unroll
        for (int b = 0; b < 2; ++b)
#pragma unroll
            for (int m = 0; m < 4; ++m)
#pragma unroll
                for (int n = 0; n < 2; ++n) acc[a][b][m][n] = (f32x4){0.f, 0.f, 0.f, 0.f};
    bf16x8 At[4][2], B0[2][2], B1[2][2];
    const char* cA = (const char*)g.A + (size_t)cur.pm * tstep; const char* cB = (const char*)g.Bt + (size_t)cur.pn * tstep;
    S.a_ready(cur);
    if constexpr (SP2) {
        if constexpr (Sched::GATHER) { PG8_GOFF(aoc, cur); }
        PG8_STAGE(PG8_SB(0, 0), cB, voffB); PG8_STAGE(PG8_SB(0, 1), cB + hstep, voffB); PG8_STAGE_A(PG8_SA(0, 0), cA, (size_t)0, 0, false); PG8_STAGE_A(PG8_SA(0, 1), cA + hstep, (size_t)0, 1, false);
        if (wr == 1) PG8_BAR;
        PG8_WAIT_V(2); PG8_BAR;
        PG8_STAGE(PG8_SB(1, 0), cB + kstep, voffB); PG8_STAGE_A(PG8_SA(1, 0), cA + kstep, kstep, 0, false); PG8_STAGE(PG8_SB(1, 1), cB + hstep + kstep, voffB);
        PG8_WAIT_V(6); PG8_BAR;
    } else {
        PG8_STAGE(PG8_SB(0, 0), cB, voffB); PG8_STAGE(PG8_SA(0, 0), cA, voffA); PG8_STAGE(PG8_SB(0, 1), cB + hstep, voffB); PG8_STAGE(PG8_SA(0, 1), cA + hstep, voffA);
        if (wr == 1) PG8_BAR;
        PG8_WAIT_V(4); PG8_BAR;
        PG8_STAGE(PG8_SB(1, 0), cB + kstep, voffB); PG8_STAGE(PG8_SA(1, 0), cA + kstep, voffA); PG8_STAGE(PG8_SB(1, 1), cB + hstep + kstep, voffB);
        PG8_WAIT_V(6); PG8_BAR;
    }
    for (;;) {
        const bool has_next = S.next(ui + 1, nxt);
        const char* nA = has_next ? (const char*)g.A + (size_t)nxt.pm * tstep : cA; const char* nB = has_next ? (const char*)g.Bt + (size_t)nxt.pn * tstep : cB;
        for (int t = 0; t < nt; t += 2) {
            const bool last = (t == nt - 2);
            const char* a1 = cA + (size_t)(t + 1) * kstep;
            const char* a2 = last ? nA : cA + (size_t)(t + 2) * kstep; const char* b2 = last ? nB : cB + (size_t)(t + 2) * kstep;
            const char* a3 = a2 + kstep; const char* b3 = b2 + kstep;
            if (last && has_next) S.a_ready(nxt);
            const size_t ko2 = last ? (size_t)0 : (size_t)(t + 2) * kstep;
            if constexpr (Sched::GATHER) { if (last) { if (has_next) { PG8_GOFF(aon, nxt); } else { _Pragma("unroll") for (int _h = 0; _h < 2; ++_h) { aon[_h][0] = aoc[_h][0]; aon[_h][1] = aoc[_h][1]; } } } }
            if constexpr (SP2) {
            PG8_LDB(B0, 0, 0); PG8_LDB(B1, 0, 1); PG8_SCHED; PG8_LDA(At, 0, 0); PG8_STAGE_A(PG8_SA(1, 1), a1 + hstep, (size_t)(t + 1) * kstep, 1, false);
            PG8_WAIT_V(8); PG8_WAIT_L(0); PG8_BAR; PG8_MMA(0, 0, At, B0); PG8_MMA(0, 1, At, B1); PG8_BAR; PG8_SCHED;
            PG8_LDA(At, 0, 1); PG8_STAGE(PG8_SB(0, 0), b2, voffB); PG8_STAGE(PG8_SB(0, 1), b2 + hstep, voffB); PG8_STAGE_A(PG8_SA(0, 0), a2, ko2, 0, last);
            PG8_WAIT_V(8); PG8_WAIT_L(0); PG8_BAR; PG8_MMA(1, 0, At, B0); PG8_MMA(1, 1, At, B1); PG8_BAR; PG8_SCHED;
            PG8_LDB(B0, 1, 0); PG8_LDB(B1, 1, 1); PG8_SCHED; PG8_LDA(At, 1, 0); PG8_STAGE_A(PG8_SA(0, 1), a2 + hstep, ko2, 1, last);
            PG8_WAIT_V(8); PG8_WAIT_L(0); PG8_BAR; PG8_MMA(0, 0, At, B0); PG8_MMA(0, 1, At, B1); PG8_BAR; PG8_SCHED;
            PG8_LDA(At, 1, 1); PG8_STAGE(PG8_SB(1, 0), b3, voffB); PG8_STAGE(PG8_SB(1, 1), b3 + hstep, voffB); PG8_STAGE_A(PG8_SA(1, 0), a3, ko2 + kstep, 0, last);
            PG8_WAIT_V(8); PG8_WAIT_L(0); PG8_BAR; PG8_MMA(1, 0, At, B0); PG8_MMA(1, 1, At, B1); PG8_BAR; PG8_SCHED;
            } else {
            PG8_LDB(B0, 0, 0); PG8_SCHED; PG8_LDA(At, 0, 0); PG8_STAGE(PG8_SA(1, 1), a1 + hstep, voffA);
            PG8_WAIT_L(8); PG8_BAR; PG8_WAIT_L(0); PG8_MMA(0, 0, At, B0); PG8_BAR; PG8_SCHED;
            PG8_LDB(B1, 0, 1); PG8_STAGE(PG8_SB(0, 0), b2, voffB);
            PG8_BAR; PG8_WAIT_L(0); PG8_MMA(0, 1, At, B1); PG8_BAR;
            PG8_LDA(At, 0, 1); PG8_STAGE(PG8_SA(0, 0), a2, voffA);
            PG8_BAR; PG8_WAIT_L(0); PG8_MMA(1, 0, At, B0); PG8_BAR; PG8_SCHED;
            PG8_STAGE(PG8_SB(0, 1), b2 + hstep, voffB);
            PG8_WAIT_V(6); PG8_BAR; PG8_MMA(1, 1, At, B1); PG8_BAR;
            PG8_LDB(B0, 1, 0); PG8_SCHED; PG8_LDA(At, 1, 0); PG8_STAGE(PG8_SA(0, 1), a2 + hstep, voffA);
            PG8_WAIT_L(8); PG8_BAR; PG8_WAIT_L(0); PG8_MMA(0, 0, At, B0); PG8_BAR; PG8_SCHED;
            PG8_LDB(B1, 1, 1); PG8_STAGE(PG8_SB(1, 0), b3, voffB);
            PG8_BAR; PG8_WAIT_L(0); PG8_MMA(0, 1, At, B1); PG8_BAR;
            PG8_LDA(At, 1, 1); PG8_STAGE(PG8_SA(1, 0), a3, voffA);
            PG8_BAR; PG8_WAIT_L(0); PG8_MMA(1, 0, At, B0); PG8_BAR; PG8_SCHED;
            PG8_STAGE(PG8_SB(1, 1), b3 + hstep, voffB);
            PG8_WAIT_V(6); PG8_BAR; PG8_MMA(1, 1, At, B1); PG8_BAR;
            }
        }
        if constexpr (ALIGN_EPI) { if (wr == 0) PG8_BAR; }
        if constexpr (!Epi::AFTER_DRAIN) { E(acc, cur, wr, wc, fr, fq); S.done(cur); }
        if (!has_next) break;
#pragma unroll
        for (int a = 0; a < 2; ++a)
#pragma unroll
            for (int b = 0; b < 2; ++b)
#pragma unroll
                for (int m = 0; m < 4; ++m)
#pragma unroll
                    for (int n = 0; n < 2; ++n) acc[a][b][m][n] = (f32x4){0.f, 0.f, 0.f, 0.f};
        cur = nxt; cA = nA; cB = nB; ++ui;
        if constexpr (Sched::GATHER) { _Pragma("unroll") for (int _h = 0; _h < 2; ++_h) { aoc[_h][0] = aon[_h][0]; aoc[_h][1] = aon[_h][1]; } }
        if constexpr (ALIGN_EPI) { if (wr == 1) PG8_BAR; }
    }
    PG8_WAIT_V(0);
    if constexpr (!ALIGN_EPI) { if (wr == 0) PG8_BAR; }
    PG8_BAR;
    if constexpr (Epi::AFTER_DRAIN) { E.fused(acc, cur, wr, wc, fr, fq, lds, wid, lane); S.done(cur); }
#undef PG8_SA
#undef PG8_SB
#undef PG8_STAGE
#undef PG8_STAGE_A
#undef PG8_GOFF
#undef PG8_LDA
#undef PG8_LDB
#undef PG8_MMA
#undef PG8_WAIT_V
#undef PG8_WAIT_L
#undef PG8_BAR
#undef PG8_SCHED
}
}
constexpr int NWAVES = 8;
constexpr int TOK = 16384, SEQ = 4096, D = 1024, NP = 4096, INC = 3888, DEPTH = 4;
constexpr int HG_Q = 0, HG_F = 256, HG_I = 512, HG_G = 768;
constexpr int GL_Q = 1024, GL_K = 1152, GL_V = 1280, GL_GLR = 1536, GL_R = 1552;
constexpr int RW_BASE = 1808, RW_R = 1808, RW_K = 2064, RW_V = 2320, RW_WLR = 2576, RW_ALR = 2640, RW_GLR = 2704;
constexpr int RT_Q = 2864, RT_K = 3120, RT_V = 3376, RT_G = 3632;
constexpr int GL_GX = 3904;
constexpr int FFD = 2816, FFE = 1408, NE = 8;
constexpr float DN_ALPHA = 1.6817928305074290f;
constexpr int NPH = 12;
constexpr int NPHASES = NPH * DEPTH;
constexpr size_t MiB = 1u << 20;
constexpr size_t WS_CTL = 0, CTL_ZERO_BYTES = 1 * MiB;
constexpr size_t WS_LIST = 1 * MiB;
constexpr size_t WS_GATE = 2 * MiB;
constexpr size_t WS_TAB = 3 * MiB;
constexpr size_t WS_WIN = 4 * MiB, WS_WOUT = 12 * MiB, WS_WUP = 14 * MiB, WS_WDN = 58 * MiB;
constexpr size_t WS_HB = 80 * MiB;
constexpr size_t WS_MIX = 112 * MiB;
constexpr size_t WS_O = WS_MIX;
constexpr size_t WS_OI = 144 * MiB;
constexpr size_t OI_GEN = 64 * 4096 * 16;
constexpr size_t WS_VF = 176 * MiB;
constexpr size_t WS_P = 184 * MiB;
constexpr size_t WS_RWW = 312 * MiB;
constexpr size_t WS_RWR = 328 * MiB, WS_RWK = 336 * MiB, WS_RWV = 344 * MiB, WS_RWKK = 352 * MiB, WS_RWB = 360 * MiB, WS_RWG = 368 * MiB;
constexpr size_t WS_Y = 376 * MiB;
constexpr size_t WS_CS = 461 * MiB;
constexpr size_t WS_HID = 184 * MiB;
constexpr size_t WS_DOUT = 280 * MiB;
constexpr size_t WS_HPERM = 344 * MiB;
constexpr size_t WS_H8 = 344 * MiB;
constexpr size_t WS_RS = 360 * MiB;
constexpr size_t WS_WOUT2 = 465 * MiB;
constexpr size_t WS_END = 467 * MiB;
constexpr int CW_BAR = 4096;
constexpr int CW_CNT = 16384;
constexpr int CW_AMAX = 20480;
constexpr int TAB_STRIDE = 4 * 160 + 16;
constexpr size_t WS_LORA = 2 * MiB + 512 * 1024;
constexpr int LO_W2 = 0, LO_A2 = 256 * 64, LO_G2 = 2 * 256 * 64, LO_V1 = LO_G2 + 256 * 160, LO_V2 = LO_V1 + 32 * 256, LO_END = LO_V2 + 256 * 32;
constexpr int RING_BYTES = 131072, LDSCTL_OFF = 146432, MISC_OFF = LDSCTL_OFF + 320, LDS_BYTES = 147456;
#define GAS __attribute__((address_space(1)))
#define LAS __attribute__((address_space(3)))
typedef unsigned short bf16;
typedef unsigned v4u __attribute__((ext_vector_type(4)));
typedef unsigned v2u __attribute__((ext_vector_type(2)));
typedef float f32x4 __attribute__((ext_vector_type(4)));
typedef short bf16x8 __attribute__((ext_vector_type(8)));
typedef GAS unsigned gu32;
#define RLX_AGENT __ATOMIC_RELAXED, __HIP_MEMORY_SCOPE_AGENT
#define LDS_WAIT() asm volatile("s_waitcnt lgkmcnt(0)" ::: "memory")
#define VM_WAIT() asm volatile("s_waitcnt vmcnt(0)" ::: "memory")
#define LDS_BARRIER() do { asm volatile("s_waitcnt lgkmcnt(0)" ::: "memory"); __builtin_amdgcn_s_barrier(); asm volatile("" ::: "memory"); } while (0)
typedef float f32x2_t __attribute__((ext_vector_type(2))); typedef __bf16 bf16x2_t __attribute__((ext_vector_type(2)));
__device__ __forceinline__ unsigned pk2(float lo, float hi) { f32x2_t v = {lo, hi}; bf16x2_t b = __builtin_convertvector(v, bf16x2_t); return __builtin_bit_cast(unsigned, b); }
__device__ __forceinline__ unsigned f2bf(float f) { return pk2(f, f) & 0xffffu; }
__device__ __forceinline__ float bflo(unsigned w) { return __builtin_bit_cast(float, w << 16); }
__device__ __forceinline__ float bfhi(unsigned w) { return __builtin_bit_cast(float, w & 0xffff0000u); }
__device__ __forceinline__ float bf1(bf16 b) { return __builtin_bit_cast(float, ((unsigned)b) << 16); }
__device__ __forceinline__ void unpack8(const v4u w, float (&f)[8]) { f[0] = bflo(w.x); f[1] = bfhi(w.x); f[2] = bflo(w.y); f[3] = bfhi(w.y); f[4] = bflo(w.z); f[5] = bfhi(w.z); f[6] = bflo(w.w); f[7] = bfhi(w.w); }
__device__ __forceinline__ v4u pack8(const float (&f)[8]) { v4u w; w.x = pk2(f[0], f[1]); w.y = pk2(f[2], f[3]); w.z = pk2(f[4], f[5]); w.w = pk2(f[6], f[7]); return w; }
__device__ __forceinline__ float sigm(float x) { return __builtin_amdgcn_rcpf(1.0f + __expf(-x)); }
template <int CTRL> __device__ __forceinline__ float dpp(float x) { return __builtin_bit_cast(float, __builtin_amdgcn_mov_dpp(__builtin_bit_cast(int, x), CTRL, 0xf, 0xf, true)); }
__device__ __forceinline__ float sum16(float x) { x += dpp<0xB1>(x); x += dpp<0x4E>(x); x += dpp<0x141>(x); x += dpp<0x128>(x); return x; }
__device__ __forceinline__ float sum4(float x) { x += dpp<0xB1>(x); x += dpp<0x4E>(x); return x; }
__device__ __forceinline__ float wave_sum(float x) {
    x = sum16(x);
    auto s = __builtin_amdgcn_permlane16_swap(__float_as_uint(x), __float_as_uint(x), false, false); x = __uint_as_float(s[0]) + __uint_as_float(s[1]);
    auto t = __builtin_amdgcn_permlane32_swap(__float_as_uint(x), __float_as_uint(x), false, false); return __uint_as_float(t[0]) + __uint_as_float(t[1]);
}
__device__ __forceinline__ float wave_max(float x) {
    x = fmaxf(x, dpp<0xB1>(x)); x = fmaxf(x, dpp<0x4E>(x)); x = fmaxf(x, dpp<0x141>(x)); x = fmaxf(x, dpp<0x128>(x));
    auto s = __builtin_amdgcn_permlane16_swap(__float_as_uint(x), __float_as_uint(x), false, false); x = fmaxf(__uint_as_float(s[0]), __uint_as_float(s[1]));
    auto t = __builtin_amdgcn_permlane32_swap(__float_as_uint(x), __float_as_uint(x), false, false); return fmaxf(__uint_as_float(t[0]), __uint_as_float(t[1]));
}
__device__ __forceinline__ unsigned pack_i8(float a, float b, float c, float d) {
    const int ia = (int)__builtin_rintf(a), ib = (int)__builtin_rintf(b), ic = (int)__builtin_rintf(c), id = (int)__builtin_rintf(d);
    return ((unsigned)ia & 255u) | (((unsigned)ib & 255u) << 8) | (((unsigned)ic & 255u) << 16) | ((unsigned)id << 24);
}
__device__ const double INVF2PI[32] = {0.15915494309189535, 0.11934937021124886, 0.08949940160889101, 0.06711508300522726, 0.050329212104487035, 0.03774158471741977, 0.0283021958306234, 0.02122365276477766, 0.015915494309189534, 0.011934937021124886, 0.008949940160889102, 0.006711508300522725, 0.005032921210448704, 0.003774158471741977, 0.00283021958306234, 0.0021223652764777662, 0.0015915494309189536, 0.0011934937021124885, 0.0008949940160889102, 0.0006711508300522726, 0.0005032921210448703, 0.00037741584717419774, 0.00028302195830623395, 0.0002122365276477766, 0.00015915494309189535, 0.00011934937021124886, 8.949940160889102e-05, 6.711508300522725e-05, 5.0329212104487035e-05, 3.774158471741978e-05, 2.8302195830623396e-05, 2.122365276477766e-05};
#define XB_TMO      128
#define XB_XCNT(j)  (256  + 64 * (j))
#define XB_XSUB(j)  (1280 + 64 * (j))
#define XB_XGEN(j)  (2304 + 64 * (j))
#define XB_TOP      3328
#define XB_TOPGEN   3392
#define XCD_BAR_WORDS 3456
#define XB_SPIN_CAP (1u << 18)

__device__ __forceinline__ unsigned xb_ld(unsigned* p)              { return __hip_atomic_load(p, __ATOMIC_RELAXED, __HIP_MEMORY_SCOPE_AGENT); }
__device__ __forceinline__ unsigned xb_add(unsigned* p, unsigned v) { return __hip_atomic_fetch_add(p, v, __ATOMIC_RELAXED, __HIP_MEMORY_SCOPE_AGENT); }
__device__ __forceinline__ unsigned xb_xcc_id() { return (unsigned)__builtin_amdgcn_s_getreg((3 << 11) | 20) & 0xFu; }
#define XB_SPIN(cond, bar) do { unsigned _sp = 0; while (cond) { __builtin_amdgcn_s_sleep(1); \
    if ((++_sp & 255u) == 0u) { if (xb_ld(&(bar)[XB_TMO])) break; if (_sp > XB_SPIN_CAP) { atomicAdd(&(bar)[XB_TMO], 1u); break; } } } } while (0)

struct XcdBarrier {
    unsigned* bar; unsigned x;
    volatile LAS unsigned* st;
    int wv;
};

__device__ __forceinline__ XcdBarrier xcd_barrier_post(unsigned* bar, volatile LAS unsigned* st) {
    XcdBarrier b; b.bar = bar; b.x = xb_xcc_id(); b.st = st; b.wv = __builtin_amdgcn_readfirstlane((int)threadIdx.x >> 6);
    if (threadIdx.x == 0) (void)xb_add(&bar[XB_XCNT(b.x)], 1u);
    return b;
}
__device__ __forceinline__ void xcd_barrier_complete(unsigned* bar, unsigned x, unsigned& nloc, unsigned& nx) {
    const unsigned G = gridDim.x * gridDim.y * gridDim.z;
    unsigned sum, cnt, mine, sp = 0u;
    for (;;) {
        sum = 0u; cnt = 0u; mine = 0u;
#pragma unroll 1
        for (unsigned j = 0; j < 16; ++j) { const unsigned c = xb_ld(&bar[XB_XCNT(j)]); sum += c; cnt += (c > 0u) ? 1u : 0u; mine = (j == x) ? c : mine; }
        if (sum == G) break;
        __builtin_amdgcn_s_sleep(1);
        if ((++sp & 255u) == 0u) { if (xb_ld(&bar[XB_TMO])) break; if (sp > XB_SPIN_CAP) { atomicAdd(&bar[XB_TMO], 1u); break; } }
    }
    nloc = mine > 0u ? mine : 1u; nx = cnt > 0u ? cnt : 1u;
}

__device__ __forceinline__ void xcd_barrier(const XcdBarrier& b) {
    asm volatile("s_waitcnt vmcnt(0)" ::: "memory");
    __syncthreads();
    if (b.wv == 0 && lane_id_now() == 0) {
        unsigned* bar = b.bar;
        __builtin_amdgcn_s_waitcnt(0);
        unsigned nloc = b.st[0], nx = b.st[1];
        if (nloc == 0u) { xcd_barrier_complete(bar, b.x, nloc, nx); b.st[0] = nloc; b.st[1] = nx; }
        const unsigned old = xb_add(&bar[XB_XSUB(b.x)], 1u);
        const unsigned gen = old / nloc;
        if (old + 1u == (gen + 1u) * nloc) {
            __builtin_amdgcn_fence(__ATOMIC_RELEASE, "agent");
            asm volatile("s_waitcnt vmcnt(0)" ::: "memory");
            const unsigned og = xb_add(&bar[XB_TOP], 1u);
            const unsigned tg = og / nx;
            if (og + 1u == (tg + 1u) * nx) xb_add(&bar[XB_TOPGEN], 1u);
            else XB_SPIN(xb_ld(&bar[XB_TOPGEN]) == tg, bar);
            __builtin_amdgcn_fence(__ATOMIC_ACQUIRE, "agent");
            xb_add(&bar[XB_XGEN(b.x)], 1u);
            asm volatile("s_waitcnt vmcnt(0)" ::: "memory");
        } else {
            XB_SPIN(xb_ld(&bar[XB_XGEN(b.x)]) == gen, bar);
            __builtin_amdgcn_fence(__ATOMIC_ACQUIRE, "agent");
            asm volatile("s_waitcnt vmcnt(0)" ::: "memory");
        }
    }
    __syncthreads();
}
struct Frame {
    LAS unsigned char* lds;
    volatile LAS unsigned* MISC;
    gu32* ctl;
    int tid, lane, wave;
    int vcu, G;
    unsigned char* ws;
    const void* const* in;
    float* h;
};
__device__ __forceinline__ const void* ldptr(const void* const* tab, int k) { int z; asm volatile("s_mov_b32 %0, 0" : "=s"(z)); return tab[k + z]; }
#define INF(k) ((const float*)ldptr(F.in, k))
#define WSP(T, off) ((T*)(F.ws + (off)))

__device__ __forceinline__ void xpose_item(const float* W, int ldw, int nvalid, int k0, int n0, bf16* WT, int ldt, int drow0, LAS float* scr, int lane) {
#pragma unroll 8
    for (int i = 0; i < 32; ++i) { const int kk = 2 * i + (lane >> 5), n = n0 + (lane & 31); scr[kk * 33 + (lane & 31)] = (n < nvalid) ? W[(size_t)(k0 + kk) * ldw + n] : 0.f; }
    LDS_WAIT(); asm volatile("" ::: "memory");
    const int c = lane & 7;
#pragma unroll
    for (int j = 0; j < 4; ++j) { const int n = (lane >> 3) + 8 * j; const LAS float* s = scr + (8 * c) * 33 + n;
        v4u o; o.x = pk2(s[0 * 33], s[1 * 33]); o.y = pk2(s[2 * 33], s[3 * 33]); o.z = pk2(s[4 * 33], s[5 * 33]); o.w = pk2(s[6 * 33], s[7 * 33]);
        *(GAS v4u*)(WT + (size_t)(drow0 + n) * ldt + k0 + 8 * c) = o; }
    LDS_WAIT(); asm volatile("" ::: "memory");
}
__device__ __forceinline__ void xpose_item8(const float* W, int ldw, int k0, int n0, unsigned char* WT, int ldt, int drow0, float qs, LAS float* scr, int lane) {
#pragma unroll 8
    for (int i = 0; i < 32; ++i) { const int kk = 2 * i + (lane >> 5), n = n0 + (lane & 31); scr[kk * 33 + (lane & 31)] = W[(size_t)(k0 + kk) * ldw + n]; }
    LDS_WAIT(); asm volatile("" ::: "memory");
    const int c = lane & 7;
#pragma unroll
    for (int j = 0; j < 4; ++j) { const int n = (lane >> 3) + 8 * j; const LAS float* s = scr + (8 * c) * 33 + n;
        v2u o; o.x = pack_i8(s[0 * 33] * qs, s[1 * 33] * qs, s[2 * 33] * qs, s[3 * 33] * qs); o.y = pack_i8(s[4 * 33] * qs, s[5 * 33] * qs, s[6 * 33] * qs, s[7 * 33] * qs);
        *(GAS v2u*)(WT + (size_t)(drow0 + n) * ldt + k0 + 8 * c) = o; }
    LDS_WAIT(); asm volatile("" ::: "memory");
}
__device__ __forceinline__ int gu_row(int n) { return 256 * (n >> 7) + (n & 127); }
template <int PART> __device__ __forceinline__ void phase_weights(Frame& F, int l) {
    LAS float* scr = (LAS float*)(F.lds + F.wave * 16384);
    const int gw = F.vcu * NWAVES + F.wave, NGW = F.G * NWAVES;
    const bool moe = (l & 1); const int fi = l >> 1;
    constexpr int I_IN = 16 * 128, I_OUT = 16 * 32;
    constexpr int I_DG = 16 * 88, I_DD = 44 * 32;
    constexpr int I_MG = 16 * 44, I_MD = 22 * 32;
    const int nitems = PART == 0 ? (I_IN + I_OUT) : (moe ? NE * (2 * I_MG + I_MD) : (2 * I_DG + I_DD));
    float qs8 = 0.f; if (PART == 1) { const float am = __uint_as_float(__hip_atomic_load((unsigned*)(F.ctl + CW_AMAX + l * 64), RLX_AGENT)); qs8 = am > 0.f ? 127.f / am : 0.f; }
    for (int it = gw; it < nitems; it += NGW) {
        int r = it + (PART == 0 ? 0 : I_IN + I_OUT);
        if (r < I_IN) { const int kb = r >> 7, nb = r & 127; if (nb < 122) xpose_item(INF(2) + (size_t)l * D * INC, INC, INC, 64 * kb, 32 * nb, WSP(bf16, WS_WIN), D, 32 * nb, scr, F.lane); continue; } r -= I_IN;
        if (r < I_OUT) { const int kb = r >> 5, nb = r & 31; xpose_item(INF(3) + (size_t)l * D * D, D, D, 64 * kb, 32 * nb, WSP(bf16, (l & 1) ? WS_WOUT2 : WS_WOUT), D, 32 * nb, scr, F.lane); continue; } r -= I_OUT;
        if (!moe) {
            if (r < 2 * I_DG) { const int up = r >= I_DG; if (up) r -= I_DG; const int kb = r / 88, nb = r % 88;
                xpose_item8(INF(up ? 28 : 27) + (size_t)fi * D * FFD, FFD, 64 * kb, 32 * nb, WSP(unsigned char, WS_WUP), D, gu_row(32 * nb) + (up ? 128 : 0), qs8, scr, F.lane); continue; } r -= 2 * I_DG;
            { const int kb = r >> 5, nb = r & 31; xpose_item(INF(29) + (size_t)fi * FFD * D, D, D, 64 * kb, 32 * nb, WSP(bf16, WS_WDN), FFD, 32 * nb, scr, F.lane); }
        } else {
            const int per = 2 * I_MG + I_MD; const int e = r / per; r -= e * per;
            if (r < 2 * I_MG) { const int up = r >= I_MG; if (up) r -= I_MG; const int kb = r / 44, nb = r % 44;
                xpose_item(INF(up ? 32 : 31) + (size_t)(fi * NE + e) * D * FFE, FFE, FFE, 64 * kb, 32 * nb, WSP(bf16, WS_WUP) + (size_t)e * 2 * FFE * D, D, gu_row(32 * nb) + (up ? 128 : 0), scr, F.lane); continue; } r -= 2 * I_MG;
            { const int kb = r >> 5, nb = r & 31; xpose_item(INF(33) + (size_t)(fi * NE + e) * FFE * D, D, D, 64 * kb, 32 * nb, WSP(bf16, WS_WDN) + (size_t)e * D * FFE, FFE, 32 * nb, scr, F.lane); }
        }
    }
    if (PART == 0) {
        const int gt = F.vcu * NWAVES * 64 + F.tid; int NT = F.G * NWAVES * 64; asm volatile("" : "+s"(NT));     const float* win = INF(2) + (size_t)l * D * INC; const float* gw2 = INF(10) + l * 16 * 128; bf16* WT = WSP(bf16, WS_WIN);
        for (int e = gt; e < 128 * D; e += NT) { const int n = e >> 10, d = e & 1023; const float* wr = win + (size_t)d * INC + (GL_GLR - 0); float a = 0.f;
#pragma unroll
            for (int r = 0; r < 16; ++r) a += wr[r] * gw2[r * 128 + n];
            WT[(size_t)(GL_GX + n) * D + d] = (bf16)f2bf(a); }
        if (l == 0) {
            f32x2_t* CS = WSP(f32x2_t, WS_CS); const int* pos = (const int*)ldptr(F.in, 1);
            for (int e = gt; e < TOK * 32; e += NT) { const int t = e >> 5, i = e & 31; const double rev = (double)pos[t] * INVF2PI[i]; const float fr_ = (float)(rev - floor(rev));
                f32x2_t cs; cs.x = __builtin_amdgcn_cosf(fr_); cs.y = __builtin_amdgcn_sinf(fr_); CS[e] = cs; } }
    }
    if (PART == 0) {
        bf16* LO = WSP(bf16, WS_LORA); const int gt = F.vcu * NWAVES * 64 + F.tid; int NT = F.G * NWAVES * 64; asm volatile("" : "+s"(NT));
        const float* w2 = INF(15) + (size_t)l * 64 * 256; const float* a2 = INF(17) + (size_t)l * 64 * 256; const float* g2 = INF(18) + (size_t)l * 160 * 256;
        for (int e = gt; e < LO_END; e += NT) { float v;
            if (e < LO_A2) { const int n = e >> 6, k = e & 63; v = w2[k * 256 + n]; }
            else if (e < LO_G2) { const int q = e - LO_A2, n = q >> 6, k = q & 63; v = a2[k * 256 + n]; }
            else if (e < LO_V1) { const int q = e - LO_G2, n = q / 160, k = q - n * 160; v = g2[k * 256 + n]; }
            else if (e < LO_V2) { const int q = e - LO_V1, n = q >> 8, k = q & 255; v = (l > 0) ? (INF(25) + (size_t)(l - 1) * 256 * 32)[k * 32 + n] : 0.f; }
            else { const int q = e - LO_V2, n = q >> 5, k = q & 31; v = (l > 0) ? (INF(26) + (size_t)(l - 1) * 32 * 256)[k * 256 + n] : 0.f; }
            LO[e] = (bf16)f2bf(v); }
    }
    if (PART == 0 && l == 0) {
        const float* x = INF(0); bf16* hb = WSP(bf16, WS_HB);
        for (int m = gw; m < TOK; m += NGW) {
            const GAS f32x4* xr = (const GAS f32x4*)(x + (size_t)m * D) + F.lane; GAS f32x4* hr = (GAS f32x4*)(F.h + (size_t)m * D) + F.lane; GAS v2u* o8 = (GAS v2u*)(hb + (size_t)m * D) + F.lane;
#pragma unroll
            for (int j = 0; j < 4; ++j) { const f32x4 v = xr[64 * j]; v2u w; w.x = pk2(v.x, v.y); w.y = pk2(v.z, v.w); o8[64 * j] = w; }
        }
    }
}
__device__ __forceinline__ void phase_absmax(Frame& F, int l) {
    const bool moe = (l & 1); const int fi = l >> 1;
    const int n4 = (moe ? NE * D * FFE : D * FFD) / 4;
    const GAS f32x4* g = (const GAS f32x4*)INF(moe ? 31 : 27) + (size_t)fi * n4; const GAS f32x4* u = (const GAS f32x4*)INF(moe ? 32 : 28) + (size_t)fi * n4;
    const int gt = F.vcu * NWAVES * 64 + F.tid; int NT = F.G * NWAVES * 64; asm volatile("" : "+s"(NT));
    float m = 0.f;
    for (int i = gt; i < n4; i += 2 * NT) { const int i2 = (i + NT < n4) ? i + NT : i;
        const f32x4 a = g[i], b = u[i], c = g[i2], d = u[i2];
        const f32x4 x = __builtin_elementwise_max(__builtin_elementwise_max(__builtin_elementwise_abs(a), __builtin_elementwise_abs(b)), __builtin_elementwise_max(__builtin_elementwise_abs(c), __builtin_elementwise_abs(d)));
        m = fmaxf(m, fmaxf(fmaxf(x.x, x.y), fmaxf(x.z, x.w))); }
    m = wave_max(m);
    if (F.lane == 0) __hip_atomic_fetch_max((unsigned*)(F.ctl + CW_AMAX + l * 64), __float_as_uint(m), RLX_AGENT);
}
template <int NKS> __device__ __forceinline__ void rw_mm16(f32x4 (&acc)[2][4], const LAS bf16* X, int ldx, int mb0, const bf16* BT, int hh, int lane) {
    const int fr = lane & 15, fq = lane >> 4; constexpr int K = 32 * NKS;
    bf16x8 bfr[NKS][4];
#pragma unroll
    for (int ks = 0; ks < NKS; ++ks)
#pragma unroll
        for (int nb = 0; nb < 4; ++nb) bfr[ks][nb] = *(const GAS bf16x8*)(BT + (size_t)(64 * hh + 16 * nb + fr) * K + 32 * ks + 8 * fq);
#pragma unroll
    for (int ks = 0; ks < NKS; ++ks)
#pragma unroll
        for (int mi = 0; mi < 2; ++mi) { const bf16x8 a = *(const LAS bf16x8*)(X + (16 * (mb0 + mi) + fr) * ldx + 32 * ks + 8 * fq);
#pragma unroll
            for (int nb = 0; nb < 4; ++nb) acc[mi][nb] = __builtin_amdgcn_mfma_f32_16x16x32_bf16(a, bfr[ks][nb], acc[mi][nb], 0, 0, 0); }
}
__device__ __forceinline__ void rwprep_tile(Frame& F, int l, int tile) {
    const bf16* P = WSP(const bf16, WS_P);
    const float* mu = INF(13) + l * 1056;
    LAS bf16* X1 = (LAS bf16*)F.lds; LAS bf16* X2 = X1 + 64 * 72; LAS bf16* X3 = X2 + 64 * 72; LAS bf16* XV = X3 + 64 * 168; LAS bf16* X5 = XV + 64 * 264; LAS bf16* XK = X5 + 64 * 40;
    float* RWW = WSP(float, WS_RWW); bf16* RWR = WSP(bf16, WS_RWR); bf16* RWK = WSP(bf16, WS_RWK); bf16* RWV = WSP(bf16, WS_RWV);
    bf16* RWKK = WSP(bf16, WS_RWKK); bf16* RWB = WSP(bf16, WS_RWB); bf16* RWG = WSP(bf16, WS_RWG); bf16* VF = WSP(bf16, WS_VF);
    const bf16* LORA = WSP(const bf16, WS_LORA);
    int tid_ = F.tid; asm volatile("" : "+v"(tid_));
    const int lane_ = tid_ & 63, wave_ = __builtin_amdgcn_readfirstlane(tid_ >> 6);
    const int fr = lane_ & 15, fq = lane_ >> 4, hh = wave_ & 3, mb0 = 2 * (wave_ >> 2);
    const int t0 = tile * 64;
#pragma unroll
    for (int half = 0; half < 2; ++half) {
        v4u rc[9], rp[9];
#pragma unroll
        for (int i = 0; i < 9; ++i) { const int g = tid_ + (half * 9 + i) * 512; rc[i] = (v4u){0u, 0u, 0u, 0u}; rp[i] = rc[i];
            if (g < 64 * 132) { const int tt = g / 132, cg = g - tt * 132, t = t0 + tt; const int col = RW_BASE + 8 * (cg < 36 ? 96 + cg : cg < 68 ? cg - 36 : cg < 100 ? 64 + (cg - 68) : 32 + (cg - 100));
                rc[i] = *(const GAS v4u*)(P + (size_t)t * NP + col); if ((t & (SEQ - 1)) != 0) rp[i] = *(const GAS v4u*)(P + (size_t)(t - 1) * NP + col); } }
#pragma unroll
        for (int i = 0; i < 9; ++i) { const int g = tid_ + (half * 9 + i) * 512;
            if (g < 64 * 132) { const int tt = g / 132, cg = g - tt * 132, t = t0 + tt; const int rel = 8 * (cg < 36 ? 96 + cg : cg < 68 ? cg - 36 : cg < 100 ? 64 + (cg - 68) : 32 + (cg - 100));
                const f32x4 m0 = *(const GAS f32x4*)(mu + rel), m1 = *(const GAS f32x4*)(mu + rel + 4); const float m[8] = {m0.x, m0.y, m0.z, m0.w, m1.x, m1.y, m1.z, m1.w};
                float cv[8], pv[8], xs[8]; unpack8(rc[i], cv); unpack8(rp[i], pv);
#pragma unroll
                for (int j = 0; j < 8; ++j) xs[j] = cv[j] + (pv[j] - cv[j]) * m[j];
                if (cg < 8) {
#pragma unroll
                    for (int j = 0; j < 8; ++j) { const float e2 = __expf(2.f * xs[j]); xs[j] = 1.f - 2.f * __builtin_amdgcn_rcpf(e2 + 1.f); }
                    *(LAS v4u*)(X1 + tt * 72 + 8 * cg) = pack8(xs);
                } else if (cg < 16) { *(LAS v4u*)(X2 + tt * 72 + 8 * (cg - 8)) = pack8(xs);
                } else if (cg < 36) {
#pragma unroll
                    for (int j = 0; j < 8; ++j) xs[j] = sigm(xs[j]);
                    *(LAS v4u*)(X3 + tt * 168 + 8 * (cg - 16)) = pack8(xs);
                } else if (cg < 68) { *(GAS v4u*)(RWR + (size_t)t * 256 + 8 * (cg - 36)) = pack8(xs);
                } else if (cg < 100) { const v4u w = pack8(xs); *(LAS v4u*)(XV + tt * 264 + 8 * (cg - 68)) = w;
                    if (l == 0) { *(GAS v4u*)(RWV + (size_t)t * 256 + 8 * (cg - 68)) = w; *(GAS v4u*)(VF + (size_t)t * 256 + 8 * (cg - 68)) = w; }
                } else { *(LAS v4u*)(XK + tt * 264 + 8 * (cg - 100)) = pack8(xs); } } }
    }
    __syncthreads();
    {   f32x4 acc[2][4];
#pragma unroll
        for (int mi = 0; mi < 2; ++mi)
#pragma unroll
            for (int nb = 0; nb < 4; ++nb) acc[mi][nb] = (f32x4){0.f, 0.f, 0.f, 0.f};
        rw_mm16<2>(acc, X1, 72, mb0, LORA + LO_W2, hh, lane_);
        const float* w0 = INF(14) + l * 256;
#pragma unroll
        for (int mi = 0; mi < 2; ++mi)
#pragma unroll
            for (int nb = 0; nb < 4; ++nb) { const int col = 64 * hh + 16 * nb + fr; const float w0c = w0[col];
#pragma unroll
                for (int r = 0; r < 4; ++r) { const int t = t0 + 16 * (mb0 + mi) + 4 * fq + r; RWW[(size_t)t * 256 + col] = -0.6065306597126334f * sigm(acc[mi][nb][r] + w0c);     } }
#pragma unroll
        for (int mi = 0; mi < 2; ++mi)
#pragma unroll
            for (int nb = 0; nb < 4; ++nb) acc[mi][nb] = (f32x4){0.f, 0.f, 0.f, 0.f};
        rw_mm16<2>(acc, X2, 72, mb0, LORA + LO_A2, hh, lane_);
        const float* a0 = INF(16) + l * 256; const float* kkw = INF(19) + l * 256; const float* kaw = INF(20) + l * 256;
#pragma unroll
        for (int mi = 0; mi < 2; ++mi) {
            float kr[4][4], kq[4][4], ssq[4] = {0.f, 0.f, 0.f, 0.f};
#pragma unroll
            for (int nb = 0; nb < 4; ++nb) { const int col = 64 * hh + 16 * nb + fr; const float kkc = kkw[col];
#pragma unroll
                for (int r = 0; r < 4; ++r) { const int row = 16 * (mb0 + mi) + 4 * fq + r; kr[nb][r] = bf1(XK[row * 264 + col]); kq[nb][r] = kr[nb][r] * kkc; ssq[r] += kq[nb][r] * kq[nb][r]; } }
#pragma unroll
            for (int r = 0; r < 4; ++r) { ssq[r] = sum16(ssq[r]); ssq[r] = 1.0f / fmaxf(sqrtf(ssq[r]), 1e-12f); }
#pragma unroll
            for (int nb = 0; nb < 4; ++nb) { const int col = 64 * hh + 16 * nb + fr; const float a0c = a0[col], kac = kaw[col];
#pragma unroll
                for (int r = 0; r < 4; ++r) { const int t = t0 + 16 * (mb0 + mi) + 4 * fq + r; const float a = sigm(acc[mi][nb][r] + a0c); const float kk = kq[nb][r] * ssq[r];
                    const size_t o = (size_t)t * 256 + col; RWKK[o] = (bf16)f2bf(kk); RWB[o] = (bf16)f2bf(kk * a); RWK[o] = (bf16)f2bf(kr[nb][r] * (1.f + (a - 1.f) * kac)); } }
        }
#pragma unroll
        for (int mi = 0; mi < 2; ++mi)
#pragma unroll
            for (int nb = 0; nb < 4; ++nb) acc[mi][nb] = (f32x4){0.f, 0.f, 0.f, 0.f};
        rw_mm16<5>(acc, X3, 168, mb0, LORA + LO_G2, hh, lane_);
#pragma unroll
        for (int mi = 0; mi < 2; ++mi)
#pragma unroll
            for (int nb = 0; nb < 4; ++nb) { const int col = 64 * hh + 16 * nb + fr;
#pragma unroll
                for (int r = 0; r < 4; ++r) { const int t = t0 + 16 * (mb0 + mi) + 4 * fq + r; RWG[(size_t)t * 256 + col] = (bf16)f2bf(acc[mi][nb][r]); } }
    }
    if (l > 0) {
        const float* v0 = INF(24) + (l - 1) * 256; const bf16* v1T = LORA + LO_V1; const bf16* v2T = LORA + LO_V2;
        {
            const int mb = wave_ & 3, nb = wave_ >> 2; f32x4 a4 = (f32x4){0.f, 0.f, 0.f, 0.f}; bf16x8 bv[8];
#pragma unroll
            for (int ks = 0; ks < 8; ++ks) bv[ks] = *(const GAS bf16x8*)(v1T + (size_t)(16 * nb + fr) * 256 + 32 * ks + 8 * fq);
#pragma unroll
            for (int ks = 0; ks < 8; ++ks) a4 = __builtin_amdgcn_mfma_f32_16x16x32_bf16(*(const LAS bf16x8*)(XV + (16 * mb + fr) * 264 + 32 * ks + 8 * fq), bv[ks], a4, 0, 0, 0);
#pragma unroll
            for (int r = 0; r < 4; ++r) X5[(16 * mb + 4 * fq + r) * 40 + 16 * nb + fr] = (bf16)f2bf(a4[r]);
        }
        __syncthreads();
        {   f32x4 acc[2][4];
#pragma unroll
            for (int mi = 0; mi < 2; ++mi)
#pragma unroll
                for (int nb = 0; nb < 4; ++nb) acc[mi][nb] = (f32x4){0.f, 0.f, 0.f, 0.f};
            rw_mm16<1>(acc, X5, 40, mb0, v2T, hh, lane_);
#pragma unroll
            for (int mi = 0; mi < 2; ++mi)
#pragma unroll
                for (int nb = 0; nb < 4; ++nb) { const int col = 64 * hh + 16 * nb + fr; const float v0c = v0[col];
#pragma unroll
                    for (int r = 0; r < 4; ++r) { const int row = 16 * (mb0 + mi) + 4 * fq + r; const size_t o = (size_t)(t0 + row) * 256 + col;
                        const float xv = bf1(XV[row * 264 + col]); const float vf = bf1(VF[o]); RWV[o] = (bf16)f2bf(xv + (vf - xv) * sigm(acc[mi][nb][r] + v0c)); } }
        }
    }
    __syncthreads();
}
constexpr int CB = 64 * 66;
constexpr int HB_ = 64 * 72;
constexpr int PRE_H0 = 3 * CB * 4;
constexpr int PV_OFF = (PRE_H0 + 10 * HB_ * 2) / 4;
constexpr int REC_RW = 53760, REC_GL = 16640;
constexpr int RO_QH = 0, RO_AT = 8192, RO_BH = 16384, RO_TT = 24576, RO_MRB = 30720, RO_GAM = 36864, RO_VB = 37376;
constexpr int RO_Y = 0, RO_SK = 0;
constexpr int GO_QH = 0, GO_SK = 8192, GO_GAM = 16384;
#define PBUF(i) ((LAS float*)F.lds + (i) * CB)
#define HBUF(i) ((LAS bf16*)(F.lds + PRE_H0) + (i) * HB_)
__device__ __forceinline__ void nt16(f32x4 (&acc)[2], const LAS bf16* X, const LAS bf16* Y, int mb, int nb0, int lane) {
    const int fr = lane & 15, fq = lane >> 4;
    acc[0] = (f32x4){0.f, 0.f, 0.f, 0.f}; acc[1] = acc[0];
#pragma unroll
    for (int ks = 0; ks < 2; ++ks) { const bf16x8 a = *(const LAS bf16x8*)(X + (16 * mb + fr) * 72 + 32 * ks + 8 * fq);
        const bf16x8 b0 = *(const LAS bf16x8*)(Y + (16 * nb0 + fr) * 72 + 32 * ks + 8 * fq), b1 = *(const LAS bf16x8*)(Y + (16 * nb0 + 16 + fr) * 72 + 32 * ks + 8 * fq);
        acc[0] = __builtin_amdgcn_mfma_f32_16x16x32_bf16(a, b0, acc[0], 0, 0, 0); acc[1] = __builtin_amdgcn_mfma_f32_16x16x32_bf16(a, b1, acc[1], 0, 0, 0); }
}
typedef short v4i16_t __attribute__((ext_vector_type(4)));
__device__ __forceinline__ v2u trr(const LAS bf16* p) { return __builtin_bit_cast(v2u, __builtin_amdgcn_ds_read_tr16_b64_v4i16((LAS v4i16_t*)p)); }
__device__ __forceinline__ bf16x8 trfrag(const LAS bf16* M, int c, int ks, int lane) {
    const int g = lane >> 4, q = (lane & 15) >> 2, p = lane & 3; const LAS bf16* a = M + (32 * ks + 8 * g + q) * 72 + 16 * c + 4 * p;
    const v2u lo = trr(a), hi = trr(a + 4 * 72); v4u w; w.x = lo.x; w.y = lo.y; w.z = hi.x; w.w = hi.y; return __builtin_bit_cast(bf16x8, w);
}
__device__ __forceinline__ void tn16(f32x4 (&acc)[2], const LAS bf16* X, const LAS bf16* Y, int mb, int nb0, int lane) {
    acc[0] = (f32x4){0.f, 0.f, 0.f, 0.f}; acc[1] = acc[0];
#pragma unroll
    for (int ks = 0; ks < 2; ++ks) { const bf16x8 a = trfrag(X, mb, ks, lane), b0 = trfrag(Y, nb0, ks, lane), b1 = trfrag(Y, nb0 + 1, ks, lane);
        acc[0] = __builtin_amdgcn_mfma_f32_16x16x32_bf16(a, b0, acc[0], 0, 0, 0); acc[1] = __builtin_amdgcn_mfma_f32_16x16x32_bf16(a, b1, acc[1], 0, 0, 0); }
}
__device__ __forceinline__ void nn16(f32x4 (&acc)[2], const LAS bf16* A, const LAS bf16* B, int mb, int nb0, int lane) {
    const int fr = lane & 15, fq = lane >> 4;
    acc[0] = (f32x4){0.f, 0.f, 0.f, 0.f}; acc[1] = acc[0];
#pragma unroll
    for (int ks = 0; ks < 2; ++ks) { const bf16x8 a = *(const LAS bf16x8*)(A + (16 * mb + fr) * 72 + 32 * ks + 8 * fq), b0 = trfrag(B, nb0, ks, lane), b1 = trfrag(B, nb0 + 1, ks, lane);
        acc[0] = __builtin_amdgcn_mfma_f32_16x16x32_bf16(a, b0, acc[0], 0, 0, 0); acc[1] = __builtin_amdgcn_mfma_f32_16x16x32_bf16(a, b1, acc[1], 0, 0, 0); }
}
__device__ __forceinline__ void hfrag_tr(const LAS bf16* M, unsigned char* dst, int wave, int lane) {
    const int mb = wave >> 1, ks = wave & 1, g = lane >> 4, q = (lane & 15) >> 2, p = lane & 3; const LAS bf16* a = M + (32 * ks + 4 * g + q) * 72 + 16 * mb + 4 * p;
    const v2u lo = trr(a), hi = trr(a + 16 * 72); v4u w; w.x = lo.x; w.y = lo.y; w.z = hi.x; w.w = hi.y;
    *(GAS v4u*)(dst + ((size_t)wave * 64 + lane) * 16) = w;
}
template <int MASK> __device__ __forceinline__ void hst(const f32x4 (&acc)[2], LAS bf16* S, int mb, int nb0, int lane) {
    const int fr = lane & 15, fq = lane >> 4;
#pragma unroll
    for (int n = 0; n < 2; ++n)
#pragma unroll
        for (int r = 0; r < 4; ++r) { const int row = 16 * mb + 4 * fq + r, col = 16 * (nb0 + n) + fr; float v = acc[n][r];
            if (MASK == 1 && col > row) v = 0.f; if (MASK == 2 && col >= row) v = 0.f; S[row * 72 + col] = (bf16)f2bf(v); }
}
template <int MASK> __device__ __forceinline__ void cst(const f32x4 (&acc)[2], LAS float* S, int mb, int nb0, int lane) {
    const int fr = lane & 15, fq = lane >> 4;
#pragma unroll
    for (int n = 0; n < 2; ++n)
#pragma unroll
        for (int r = 0; r < 4; ++r) { const int row = 16 * mb + 4 * fq + r, col = 16 * (nb0 + n) + fr; float v = acc[n][r];
            if (MASK == 1 && col > row) v = 0.f; if (MASK == 2 && col >= row) v = 0.f; S[row * 66 + col] = v; }
}
__device__ __forceinline__ void hfrag(const LAS bf16* M, const LAS float* colscale, unsigned char* dst, int wave, int lane, int slot = -2) {
    const int mb = wave >> 1, ks = wave & 1, i = lane & 15, q = lane >> 4; const LAS bf16* rowp = M + (16 * mb + i) * 72 + 32 * ks + 4 * q;
    const v2u lo = *(const LAS v2u*)rowp, hi = *(const LAS v2u*)(rowp + 16);
    v4u w; w.x = lo.x; w.y = lo.y; w.z = hi.x; w.w = hi.y;
    if (colscale) { float e[8]; unpack8(w, e); const f32x4 s0 = *(const LAS f32x4*)(colscale + 32 * ks + 4 * q), s1 = *(const LAS f32x4*)(colscale + 32 * ks + 16 + 4 * q);
        e[0] *= s0.x; e[1] *= s0.y; e[2] *= s0.z; e[3] *= s0.w; e[4] *= s1.x; e[5] *= s1.y; e[6] *= s1.z; e[7] *= s1.w; w = pack8(e); }
    if (slot == -2) slot = wave; if (slot >= 0) *(GAS v4u*)(dst + ((size_t)slot * 64 + lane) * 16) = w;
}
__device__ __forceinline__ void cfrag(const LAS float* M, unsigned char* dst, int wave, int lane, int slot) {
    const int mb = wave >> 1, ks = wave & 1, i = lane & 15, q = lane >> 4; float e[8];
#pragma unroll
    for (int jj = 0; jj < 8; ++jj) { const int rho = 32 * ks + (jj < 4 ? 4 * q + jj : 16 + 4 * q + jj - 4); e[jj] = M[(16 * mb + i) * 66 + rho]; }
    if (slot >= 0) *(GAS v4u*)(dst + ((size_t)slot * 64 + lane) * 16) = pack8(e);
}
__device__ __forceinline__ void cacc(const f32x4 (&acc)[2], const LAS float* rowscale, unsigned char* dst, int mb, int nb0, int lane, int vbs = 2048) {
    const int fq = lane >> 4;
#pragma unroll
    for (int n = 0; n < 2; ++n) { float v[4];
#pragma unroll
        for (int r = 0; r < 4; ++r) { v[r] = acc[n][r]; if (rowscale) v[r] *= rowscale[16 * mb + 4 * fq + r]; }
        v2u w; w.x = pk2(v[0], v[1]); w.y = pk2(v[2], v[3]); *(GAS v2u*)(dst + (size_t)(nb0 + n) * vbs + ((size_t)mb * 64 + lane) * 8) = w; }
}
__device__ __forceinline__ void ccumsum(Frame& F, LAS float* CU) {
    LAS float* vec = (LAS float*)F.lds + PV_OFF; LAS float* seg = vec + 128;
    { float run = 0.f;
#pragma unroll
      for (int i = 0; i < 8; ++i) { run += CU[(8 * F.wave + i) * 66 + F.lane]; CU[(8 * F.wave + i) * 66 + F.lane] = run; }
      seg[F.wave * 64 + F.lane] = run; }
    LDS_BARRIER();
    { float off = 0.f;
#pragma unroll
      for (int w = 0; w < 8; ++w) if (w < F.wave) off += seg[w * 64 + F.lane];
#pragma unroll
      for (int i = 0; i < 8; ++i) { const float c = CU[(8 * F.wave + i) * 66 + F.lane] + off; CU[(8 * F.wave + i) * 66 + F.lane] = c; if (8 * F.wave + i == 31) vec[F.lane] = c; if (8 * F.wave + i == 63) vec[64 + F.lane] = c; } }
    LDS_BARRIER();
}
__device__ __forceinline__ f32x4 blk16(f32x4 acc, const LAS float* A, int ar0, int ac0, const LAS float* B, int br0, int bc0, int lane) {
    const int fr = lane & 15, fq = lane >> 4;
#pragma unroll
    for (int s = 0; s < 4; ++s) acc = __builtin_amdgcn_mfma_f32_16x16x4f32(A[(ar0 + fr) * 66 + ac0 + 4 * s + fq], B[(br0 + 4 * s + fq) * 66 + bc0 + fr], acc, 0, 0, 0);
    return acc;
}
__device__ __forceinline__ void blkst(const f32x4 acc, LAS float* S, int r0, int c0, int lane) {
    const int fr = lane & 15, fq = lane >> 4;
#pragma unroll
    for (int r = 0; r < 4; ++r) S[(r0 + 4 * fq + r) * 66 + c0 + fr] = acc[r];
}
__device__ __forceinline__ void tri_inverse(Frame& F, const LAS float* L, LAS float* T, LAS float* W) {
    for (int e = F.tid; e < 64 * 64; e += NWAVES * 64) { const int i = e >> 6, j = e & 63; if ((i >> 4) != (j >> 4)) T[i * 66 + j] = 0.f; }
    if (F.wave == 0) {
        const int d0 = 16 * (F.lane >> 4), c = F.lane & 15; float t[16];
#pragma unroll
        for (int i = 0; i < 16; ++i) { float a = (i == c) ? 1.f : 0.f;
#pragma unroll
            for (int j = 0; j < i; ++j) a += L[(d0 + i) * 66 + d0 + j] * t[j];
            t[i] = a; T[(d0 + i) * 66 + d0 + c] = a; }
    }
    LDS_BARRIER();
#pragma unroll
    for (int d = 1; d <= 3; ++d) {
        if (F.wave < 4 - d) { const int i = d + F.wave, j = F.wave; f32x4 acc = (f32x4){0.f, 0.f, 0.f, 0.f};
#pragma unroll
            for (int k = 0; k < 3; ++k) if (k >= j && k < i) acc = blk16(acc, L, 16 * i, 16 * k, T, 16 * k, 16 * j, F.lane);
            blkst(acc, W, 16 * i, 16 * j, F.lane); }
        LDS_BARRIER();
        if (F.wave < 4 - d) { const int i = d + F.wave, j = F.wave; f32x4 acc = (f32x4){0.f, 0.f, 0.f, 0.f};
            acc = blk16(acc, T, 16 * i, 16 * i, W, 16 * i, 16 * j, F.lane); blkst(acc, T, 16 * i, 16 * j, F.lane); }
        LDS_BARRIER();
    }
}
struct PreRaw { unsigned x[6][8]; f32x2_t cs[8]; };
__device__ __forceinline__ unsigned ldh(const bf16* p) { return (unsigned)*(const GAS bf16*)p; }
#define WSQ(T, off) ((T*)(ws_ + (off)))
__device__ __forceinline__ void pre_load(Frame& F, PreRaw& R, const int MIX, int b, int h, int c) {
    int tid_ = F.tid; asm volatile("" : "+v"(tid_));
    unsigned char* ws_ = F.ws; asm volatile("" : "+s"(ws_));
    const int k = tid_ & 63, w = tid_ >> 6, t0 = b * SEQ + c * 64 + 8 * w;
    const bf16* P = WSQ(const bf16, WS_P) + (size_t)t0 * NP;
#pragma unroll
    for (int s = 0; s < 6; ++s)
#pragma unroll
        for (int i = 0; i < 8; ++i) R.x[s][i] = 0u;
    if (MIX == 0) {
#pragma unroll
        for (int i = 0; i < 8; ++i) { R.x[0][i] = ldh(P + (size_t)i * NP + HG_F + 64 * h + k); R.x[1][i] = ldh(P + (size_t)i * NP + HG_Q + 64 * h + k); R.x[2][i] = ldh(P + (size_t)i * NP + HG_I + 64 * h + k); }
    } else if (MIX == 1) {
#pragma unroll
        for (int i = 0; i < 8; ++i) { R.x[2][i] = ldh(P + (size_t)i * NP + GL_V + 64 * h + k);
            if (k < 32) { R.x[0][i] = ldh(P + (size_t)i * NP + GL_GX + 32 * h + k); R.x[1][i] = ldh(P + (size_t)i * NP + GL_Q + 32 * h + k); R.x[3][i] = ldh(P + (size_t)i * NP + GL_K + 32 * h + k); } }
    } else if (MIX == 2) { const size_t o = (size_t)t0 * 256 + 64 * h + k;
#pragma unroll
        for (int i = 0; i < 8; ++i) { R.x[0][i] = __float_as_uint(*(const GAS float*)(WSQ(const float, WS_RWW) + o + i * 256)); R.x[1][i] = ldh(WSQ(const bf16, WS_RWR) + o + i * 256); R.x[2][i] = ldh(WSQ(const bf16, WS_RWV) + o + i * 256);
            R.x[3][i] = ldh(WSQ(const bf16, WS_RWK) + o + i * 256); R.x[4][i] = ldh(WSQ(const bf16, WS_RWKK) + o + i * 256); R.x[5][i] = ldh(WSQ(const bf16, WS_RWB) + o + i * 256); }
    } else { const int k31 = k & 31; const f32x2_t* CS = WSQ(const f32x2_t, WS_CS) + (size_t)t0 * 32 + k31;
#pragma unroll
        for (int i = 0; i < 8; ++i) { R.x[0][i] = ldh(P + (size_t)i * NP + RT_Q + 64 * h + k31); R.x[1][i] = ldh(P + (size_t)i * NP + RT_Q + 64 * h + 32 + k31); R.x[2][i] = ldh(P + (size_t)i * NP + RT_V + 64 * h + k);
            R.x[3][i] = ldh(P + (size_t)i * NP + RT_K + 64 * h + k31); R.x[4][i] = ldh(P + (size_t)i * NP + RT_K + 64 * h + 32 + k31); R.cs[i] = *(const GAS f32x2_t*)(CS + i * 32); }
    }
}
__device__ __forceinline__ float ubf(unsigned u) { return __uint_as_float(u << 16); }
__device__ __forceinline__ v4u pack8v(const float (&f)[8]) { v4u w; w.x = pk2(f[0], f[1]); w.y = pk2(f[2], f[3]); w.z = pk2(f[4], f[5]); w.w = pk2(f[6], f[7]); return w; }
__device__ __forceinline__ void hfrag_trs(const LAS bf16* M, const LAS float* scale, unsigned char* dst, int wave, int lane) {
    const int mb = wave >> 1, ks = wave & 1, g = lane >> 4, q = (lane & 15) >> 2, p = lane & 3; const LAS bf16* a = M + (32 * ks + 4 * g + q) * 72 + 16 * mb + 4 * p;
    const v2u lo = trr(a), hi = trr(a + 16 * 72); v4u w; w.x = lo.x; w.y = lo.y; w.z = hi.x; w.w = hi.y;
    float e[8]; unpack8(w, e); const f32x4 s0 = *(const LAS f32x4*)(scale + 32 * ks + 4 * g), s1 = *(const LAS f32x4*)(scale + 32 * ks + 16 + 4 * g);
    e[0] *= s0.x; e[1] *= s0.y; e[2] *= s0.z; e[3] *= s0.w; e[4] *= s1.x; e[5] *= s1.y; e[6] *= s1.z; e[7] *= s1.w;
    *(GAS v4u*)(dst + ((size_t)wave * 64 + lane) * 16) = pack8(e);
}
__device__ __forceinline__ void chunk_pre(Frame& F, PreRaw& R, int l, const int MIX, int b, int h, int c, unsigned char* rec, const int nMIX, int nh) {
    const int t0 = b * SEQ + c * 64;
    LAS float* SEG = PBUF(0); LAS float* LL = PBUF(1); LAS float* T32 = PBUF(2); LAS float* WW = PBUF(0);
    LAS bf16* A1 = HBUF(0); LAS bf16* R1 = HBUF(1); LAS bf16* B1 = HBUF(2); LAS bf16* K1 = HBUF(3); LAS bf16* KeT = HBUF(4); LAS bf16* VT = HBUF(5); LAS bf16* BeT = HBUF(6); LAS bf16* M1 = HBUF(7); LAS bf16* M2 = HBUF(8); LAS bf16* M3 = HBUF(9);
    LAS float* vec = (LAS float*)F.lds + PV_OFF; LAS float* ecm = vec + 640;
    int tid_ = F.tid; asm volatile("" : "+v"(tid_));
    unsigned char* ws_ = F.ws; asm volatile("" : "+s"(ws_));
    const int lane_ = tid_ & 63, wave_ = __builtin_amdgcn_readfirstlane(tid_ >> 6);
    const int k_ = lane_;
    const int mb = wave_ >> 1, nb0 = 2 * (wave_ & 1), fr = lane_ & 15, fq = lane_ >> 4;
    float q[8], kx[8], lw[8], v[8], av[8], bv[8];
    if (MIX == 0) {
        const float* lg = INF(8); const int cch = 64 * h + k_;
        const float x0 = lg[cch], x1 = lg[256 + cch], x2 = lg[512 + cch], x3 = lg[768 + cch]; const float mx = fmaxf(fmaxf(x0, x1), fmaxf(x2, x3));
        const float e0 = __expf(x0 - mx), e1 = __expf(x1 - mx), e2 = __expf(x2 - mx), e3 = __expf(x3 - mx);
        const float lb = ((l >= 1 ? e1 : 0.f) + (l >= 2 ? e2 : 0.f) + (l >= 3 ? e3 : 0.f)) / (e0 + e1 + e2 + e3);
#pragma unroll
        for (int i = 0; i < 8; ++i) { const float fr_ = ubf(R.x[0][i]), qr = ubf(R.x[1][i]); const float w = lb + (1.f - lb) * sigm(fr_); lw[i] = __logf(w); kx[i] = 1.f - w; q[i] = qr * sigm(qr); v[i] = ubf(R.x[2][i]); }
    } else if (MIX == 1) {
        const float gb = (k_ < 32) ? (INF(11) + l * 128)[32 * h + k_] : 0.f;
#pragma unroll
        for (int i = 0; i < 8; ++i) { v[i] = ubf(R.x[2][i]);
            if (k_ < 32) { const float x = ubf(R.x[0][i]) + gb; lw[i] = 0.0625f * (fminf(x, 0.f) - __logf(1.f + __expf(-fabsf(x)))); q[i] = ubf(R.x[1][i]) * 0.17677669529663687f; kx[i] = ubf(R.x[3][i]); }
            else { lw[i] = 0.f; q[i] = 0.f; kx[i] = 0.f; } }
    } else if (MIX == 2) {
#pragma unroll
        for (int i = 0; i < 8; ++i) { lw[i] = __uint_as_float(R.x[0][i]); q[i] = ubf(R.x[1][i]); v[i] = ubf(R.x[2][i]); kx[i] = ubf(R.x[3][i]); av[i] = -ubf(R.x[4][i]); bv[i] = ubf(R.x[5][i]); }
    } else {
        const bool hi = k_ >= 32; const float lgam = __logf(1.f - exp2f(-5.f - (float)h));
#pragma unroll
        for (int i = 0; i < 8; ++i) { const float cs_ = R.cs[i].x, sn = R.cs[i].y; const float q1 = ubf(R.x[0][i]), q2 = ubf(R.x[1][i]), k1 = ubf(R.x[3][i]), k2 = ubf(R.x[4][i]);
            q[i] = hi ? (q1 * sn + q2 * cs_) : (q1 * cs_ - q2 * sn); kx[i] = 0.125f * (hi ? (k1 * sn + k2 * cs_) : (k1 * cs_ - k2 * sn)); lw[i] = lgam; v[i] = ubf(R.x[2][i]); }
    }
    float cu[8]; { float run = 0.f;
#pragma unroll
        for (int i = 0; i < 8; ++i) { run += lw[i]; cu[i] = run; }
        SEG[wave_ * 64 + k_] = run; }
    LDS_BARRIER();
    float cm, ce; { float pre = 0.f, tot = 0.f, mid = 0.f;
#pragma unroll
        for (int w = 0; w < 8; ++w) { const float s = SEG[w * 64 + k_]; if (w < wave_) pre += s; if (w < 4) mid += s; tot += s; }
        cm = mid; ce = tot;
#pragma unroll
        for (int i = 0; i < 8; ++i) cu[i] += pre; }
    {   float e1[8], e2[8], e3[8];
#pragma unroll
        for (int i = 0; i < 8; ++i) { const float ef = __expf(cu[i] - cm); e1[i] = q[i] * ef; e2[i] = kx[i] * __builtin_amdgcn_rcpf(ef); e3[i] = kx[i] * __expf(ce - cu[i]); }
        *(LAS v4u*)(R1 + k_ * 72 + 8 * wave_) = pack8v(e1); *(LAS v4u*)(K1 + k_ * 72 + 8 * wave_) = pack8v(e2); *(LAS v4u*)(KeT + k_ * 72 + 8 * wave_) = pack8v(e3); *(LAS v4u*)(VT + k_ * 72 + 8 * wave_) = pack8v(v);
        if (MIX == 2) {
#pragma unroll
            for (int i = 0; i < 8; ++i) { const float ef = __expf(cu[i] - cm); e1[i] = av[i] * __expf(cu[i] - lw[i] - cm); e2[i] = bv[i] * __builtin_amdgcn_rcpf(ef); e3[i] = bv[i] * __expf(ce - cu[i]); }
            *(LAS v4u*)(A1 + k_ * 72 + 8 * wave_) = pack8v(e1); *(LAS v4u*)(B1 + k_ * 72 + 8 * wave_) = pack8v(e2); *(LAS v4u*)(BeT + k_ * 72 + 8 * wave_) = pack8v(e3); }
        if (wave_ == 0) { ecm[k_] = __expf(cm); *(GAS float*)(rec + (MIX == 2 ? RO_GAM : GO_GAM) + 4 * k_) = __expf(ce); }
    }
    LDS_BARRIER();
    if (nMIX >= 0) pre_load(F, R, nMIX, b, nh, c);
    f32x4 acc[2];
    tn16(acc, R1, K1, mb, nb0, lane_); hst<1>(acc, M1, mb, nb0, lane_);
    hfrag_trs(R1, ecm, rec + (MIX == 2 ? RO_QH : GO_QH), wave_, lane_);
    nt16(acc, KeT, VT, mb, nb0, lane_); if (MIX == 2) cacc(acc, nullptr, rec + RO_VB + 2048, mb, nb0, lane_, 4096); else cacc(acc, nullptr, rec + GO_SK, mb, nb0, lane_);
    if (MIX == 2) {
        tn16(acc, A1, B1, mb, nb0, lane_); cst<2>(acc, LL, mb, nb0, lane_);
        tn16(acc, R1, B1, mb, nb0, lane_); hst<1>(acc, M2, mb, nb0, lane_);
        tn16(acc, A1, K1, mb, nb0, lane_); hst<2>(acc, M3, mb, nb0, lane_);
        hfrag_trs(A1, ecm, rec + RO_AT, wave_, lane_);
        hfrag(BeT, nullptr, rec + RO_BH, wave_, lane_);
    }
    LDS_BARRIER();
    nt16(acc, M1, VT, mb, nb0, lane_);
#pragma unroll
    for (int n = 0; n < 2; ++n)
#pragma unroll
        for (int r = 0; r < 4; ++r) A1[(16 * mb + 4 * fq + r) * 72 + 16 * (nb0 + n) + fr] = (bf16)f2bf(acc[n][r]);
    if (MIX == 2) {
        nt16(acc, M3, VT, mb, nb0, lane_); cacc(acc, nullptr, rec + RO_VB, mb, nb0, lane_, 4096);
        const int t6 = ((wave_ & 1) == 1 && (wave_ >> 1) < 2) ? -1 : ((wave_ >> 1) < 2 ? (wave_ >> 1) : 2 + ((wave_ >> 1) - 2) * 2 + (wave_ & 1));
        hfrag(M2, nullptr, rec + RO_MRB, wave_, lane_, t6);
        tri_inverse(F, LL, T32, WW);
        cfrag(T32, rec + RO_TT, wave_, lane_, t6);
    }
    LDS_BARRIER();
}
constexpr size_t WS_REC_RW = 14 * MiB, WS_REC_GL = 412 * MiB;
__device__ __forceinline__ void oloc_flush(Frame& F, int m, int t0, int h) {
    const int t = F.tid >> 3, pc = F.tid & 7; const v4u w = *(const LAS v4u*)(HBUF(0) + t * 72 + 8 * pc);
    *(GAS v4u*)(WSP(bf16, WS_O) + (size_t)m * TOK * 256 + (size_t)(t0 + t) * 256 + 64 * h + 8 * pc) = w;
}
__device__ __forceinline__ unsigned char* pre_rec(Frame& F, int m, int b, int h, int c) {
    return (m == 2) ? F.ws + WS_REC_RW + (size_t)(((b * 4 + h) * 64) + c) * REC_RW : F.ws + WS_REC_GL + (size_t)((((m == 3 ? 2 : m) * 16 + b * 4 + h) * 64) + c) * REC_GL;
}
__device__ __forceinline__ void phase_chunkpre(Frame& F, int l) {
    for (int tile = F.vcu; tile < TOK / 64; tile += F.G) {
        const int b = tile >> 6, c = tile & 63;
        rwprep_tile(F, l, tile);
        __syncthreads();
        PreRaw cur;
        pre_load(F, cur, 0, b, 0, c);
#pragma unroll 1
        for (int i = 0; i < 16; ++i) {
            const int mo = i >> 2, m = (mo == 2) ? 3 : (mo == 3 ? 2 : mo), h = i & 3;
            const int mo2 = (i + 1) >> 2, m2 = (i + 1 < 16) ? ((mo2 == 2) ? 3 : (mo2 == 3 ? 2 : mo2)) : -1;
            chunk_pre(F, cur, l, m, b, h, c, pre_rec(F, m, b, h, c), m2, (i + 1) & 3);
            oloc_flush(F, m, b * SEQ + c * 64, h);
        }
    }
}
__device__ __forceinline__ bf16x8 pack_b(const f32x4 a, const f32x4 b) { v4u w; w.x = pk2(a.x, a.y); w.y = pk2(a.z, a.w); w.z = pk2(b.x, b.y); w.w = pk2(b.z, b.w); return __builtin_bit_cast(bf16x8, w); }
__device__ __forceinline__ f32x4 unpk4(const v2u w) { return (f32x4){bflo(w.x), bfhi(w.x), bflo(w.y), bfhi(w.y)}; }
template <int NF> struct SeqRegs { v4u r[NF]; v4u tail; };
template <int NF, int NLT, bool TAIL> __device__ __forceinline__ void seq_ld(SeqRegs<NF>& R, const unsigned char* rec, int lt) {
    const GAS v4u* src = (const GAS v4u*)rec;
#pragma unroll
    for (int i = 0; i < NF; ++i) R.r[i] = src[i * NLT + lt];
    if (TAIL && lt < 16) R.tail = src[NF * NLT + lt];
}
template <int NF, int NLT, bool TAIL> __device__ __forceinline__ void seq_st(const SeqRegs<NF>& R, LAS unsigned char* slot, int lt) {
    LAS v4u* dst = (LAS v4u*)slot;
#pragma unroll
    for (int i = 0; i < NF; ++i) dst[i * NLT + lt] = R.r[i];
    if (TAIL && lt < 16) dst[NF * NLT + lt] = R.tail;
}
template <bool RW> __device__ __forceinline__ void seq_unit(Frame& F, int mix, int b, int h, int vb_, const unsigned char* recs) {
    constexpr int REC = RW ? REC_RW : REC_GL, SLOT = 61440, NCW = RW ? 1 : 4, LW0 = RW ? 2 : 4, NLT = (8 - LW0) * 64, NF = REC / (NLT * 16); constexpr bool TAIL = (REC % (NLT * 16)) != 0;
    static_assert(REC % (NLT * 16) == 0 || REC % (NLT * 16) == 256, "record = NF loader rounds (+ 256 B)");
    const bool loader = F.wave >= LW0, compute = F.wave < NCW; const int lt = F.tid - 64 * LW0;
    SeqRegs<NF> RA, RB;
    if (loader) { seq_ld<NF, NLT, TAIL>(RA, recs, lt); seq_st<NF, NLT, TAIL>(RA, F.lds, lt); seq_ld<NF, NLT, TAIL>(RB, recs + (size_t)1 * REC, lt); seq_ld<NF, NLT, TAIL>(RA, recs + (size_t)2 * REC, lt); }
    __syncthreads();
    f32x4 S[4];
#pragma unroll
    for (int kb = 0; kb < 4; ++kb) S[kb] = (f32x4){0.f, 0.f, 0.f, 0.f};
    const int vb = RW ? vb_ : (F.wave & 3), fr = F.lane & 15, fq = F.lane >> 4;
    bf16* Og_ = WSP(bf16, WS_OI) + OI_GEN + (size_t)(((mix == 3 ? 2 : mix) * 16 + b * 4 + h)) * (SEQ * 64);
    constexpr int OSO = 122880;
#define SEQ_FLUSH(cc) do { const LAS unsigned char* osr_ = F.lds + OSO + ((cc) & 1) * 8192 + (16 * vb + (F.lane >> 2)) * 128 + (F.lane & 3) * 32; bf16* dst_ = Og_ + ((size_t)(cc) * 64 + 16 * vb + (F.lane >> 2)) * 64 + (F.lane & 3) * 16; \
        const v4u a_ = *(const LAS v4u*)osr_, b_ = *(const LAS v4u*)(osr_ + 16); *(GAS v4u*)dst_ = a_; *(GAS v4u*)(dst_ + 8) = b_; } while (0)
#pragma unroll 1
    for (int c2 = 0; c2 < 64; c2 += 2) {
#pragma unroll
        for (int par = 0; par < 2; ++par) {
            const int c = c2 + par;
            if (loader) {
                if (par == 0) { seq_st<NF, NLT, TAIL>(RB, F.lds + SLOT, lt); if (c + 3 < 64) seq_ld<NF, NLT, TAIL>(RB, recs + (size_t)(c + 3) * REC, lt); }
                else { if (c + 1 < 64) seq_st<NF, NLT, TAIL>(RA, F.lds, lt); if (c + 3 < 64) seq_ld<NF, NLT, TAIL>(RA, recs + (size_t)(c + 3) * REC, lt); }
            } else if (compute) {
                const LAS unsigned char* R = F.lds + par * SLOT;
                const f32x4 z = (f32x4){0.f, 0.f, 0.f, 0.f};
                if (c > 0) SEQ_FLUSH(c - 1);
                bf16x8 fqh[8];
#pragma unroll
                for (int f = 0; f < 8; ++f) fqh[f] = *(const LAS bf16x8*)(R + (RW ? RO_QH : GO_QH) + (f * 64 + F.lane) * 16);
                bf16x8 bS[2]; bS[0] = pack_b(S[0], S[1]); bS[1] = pack_b(S[2], S[3]);
                asm volatile("s_waitcnt lgkmcnt(0)" ::: "memory"); __builtin_amdgcn_sched_barrier(0);
                f32x4 O[4]; bf16x8 bU[2];
#pragma unroll
                for (int mb = 0; mb < 4; ++mb) { O[mb] = z;
#pragma unroll
                    for (int ks = 0; ks < 2; ++ks) O[mb] = __builtin_amdgcn_mfma_f32_16x16x32_bf16(fqh[mb * 2 + ks], bS[ks], O[mb], 0, 0, 0); }
                if (RW) {
                    f32x4 X[4], U[4];
#pragma unroll
                    for (int mb = 0; mb < 4; ++mb) { X[mb] = unpk4(*(const LAS v2u*)(R + RO_Y + ((vb * 4 + mb) * 64 + F.lane) * 8));
#pragma unroll
                        for (int ks = 0; ks < 2; ++ks) X[mb] = __builtin_amdgcn_mfma_f32_16x16x32_bf16(*(const LAS bf16x8*)(R + RO_AT + ((mb * 2 + ks) * 64 + F.lane) * 16), bS[ks], X[mb], 0, 0, 0); }
                    bf16x8 bX[2]; bX[0] = pack_b(X[0], X[1]); bX[1] = pack_b(X[2], X[3]);
#pragma unroll
                    for (int mb = 0; mb < 4; ++mb) { U[mb] = z;
#pragma unroll
                        for (int ks = 0; ks < 2; ++ks) if (!(ks == 1 && mb < 2)) U[mb] = __builtin_amdgcn_mfma_f32_16x16x32_bf16(*(const LAS bf16x8*)(R + RO_TT + ((mb * 2 + ks) * 64 + F.lane) * 16), bX[ks], U[mb], 0, 0, 0); }
                    bU[0] = pack_b(U[0], U[1]); bU[1] = pack_b(U[2], U[3]);
#pragma unroll
                    for (int mb = 0; mb < 4; ++mb)
#pragma unroll
                        for (int ks = 0; ks < 2; ++ks) if (!(ks == 1 && mb < 2)) O[mb] = __builtin_amdgcn_mfma_f32_16x16x32_bf16(*(const LAS bf16x8*)(R + RO_MRB + ((mb * 2 + ks) * 64 + F.lane) * 16), bU[ks], O[mb], 0, 0, 0);
                }
#pragma unroll
                for (int kb = 0; kb < 4; ++kb) { const f32x4 g = *(const LAS f32x4*)(R + (RW ? RO_GAM : GO_GAM) + (16 * kb + 4 * fq) * 4); const f32x4 sk = unpk4(*(const LAS v2u*)(R + (RW ? RO_SK : GO_SK) + ((vb * 4 + kb) * 64 + F.lane) * 8));
                    f32x4 n = S[kb] * g + sk;
                    if (RW) {
#pragma unroll
                        for (int ks = 0; ks < 2; ++ks) n = __builtin_amdgcn_mfma_f32_16x16x32_bf16(*(const LAS bf16x8*)(R + RO_BH + ((kb * 2 + ks) * 64 + F.lane) * 16), bU[ks], n, 0, 0, 0);
                    }
                    S[kb] = n; }
#pragma unroll
                for (int mb = 0; mb < 4; ++mb)
#pragma unroll
                    for (int r = 0; r < 4; ++r) *(LAS bf16*)(F.lds + OSO + par * 8192 + (16 * mb + 4 * fq + r) * 128 + (16 * vb + fr) * 2) = (bf16)f2bf(O[mb][r]);
            }
            LDS_BARRIER();
        }
    }
    if (compute) SEQ_FLUSH(63);
#undef SEQ_FLUSH
    __syncthreads();
}
__device__ __forceinline__ int tri6(int mb, int ks) { return mb < 2 ? mb : 2 + (mb - 2) * 2 + ks; }
struct SeqRegs4 { v4u r[6]; v4u t; };
__device__ __forceinline__ void seq4_ld(SeqRegs4& R, const unsigned char* rec, int vb, int lt) {
    const GAS v4u* src = (const GAS v4u*)rec;
#pragma unroll
    for (int i = 0; i < 6; ++i) R.r[i] = src[i * 384 + lt];
    if (lt < 16) R.t = src[6 * 384 + lt];
    if (lt >= 128) R.t = *(const GAS v4u*)(rec + RO_VB + vb * 4096 + (lt - 128) * 16);
}
__device__ __forceinline__ void seq4_st(const SeqRegs4& R, LAS unsigned char* slot, int lt) {
    LAS v4u* dst = (LAS v4u*)slot;
#pragma unroll
    for (int i = 0; i < 6; ++i) dst[i * 384 + lt] = R.r[i];
    if (lt < 16) dst[6 * 384 + lt] = R.t;
    if (lt >= 128) *(LAS v4u*)(slot + 37120 + (lt - 128) * 16) = R.t;
}
__device__ __forceinline__ void seq_rw(Frame& F, int b, int h, int vb, const unsigned char* recs) {
    constexpr int REC = REC_RW, SLOT = 41216, EXO = 3 * SLOT;
    const bool loader = F.wave >= 2; const int lt = F.tid - 128;
    SeqRegs4 RA, RB, RC;
    if (loader) { seq4_ld(RA, recs, vb, lt); seq4_st(RA, F.lds, lt); seq4_ld(RB, recs + (size_t)1 * REC, vb, lt); seq4_ld(RC, recs + (size_t)2 * REC, vb, lt); seq4_ld(RA, recs + (size_t)3 * REC, vb, lt); }
    __syncthreads();
    f32x4 S[4];
#pragma unroll
    for (int kb = 0; kb < 4; ++kb) S[kb] = (f32x4){0.f, 0.f, 0.f, 0.f};
    const int fr = F.lane & 15, fq = F.lane >> 4;
    bf16* Og_ = WSP(bf16, WS_OI) + (size_t)((b * 4 + h) * 4 + vb) * (SEQ * 16);
    LAS unsigned char* OS = F.lds + EXO + 8192;
#pragma unroll 1
    for (int c2 = 0; c2 < 66; c2 += 3) {
#pragma unroll
        for (int j3 = 0; j3 < 3; ++j3) {
            const int c = c2 + j3; const int par = c & 1;
            if (loader) {
                LAS unsigned char* dst = F.lds + ((j3 + 1) % 3) * SLOT; const unsigned char* nrec = recs + (size_t)(c + 4) * REC;
                if (c + 1 < 64) { if (j3 == 0) seq4_st(RB, dst, lt); else if (j3 == 1) seq4_st(RC, dst, lt); else seq4_st(RA, dst, lt); }
                if (c + 4 < 64) { if (j3 == 0) seq4_ld(RB, nrec, vb, lt); else if (j3 == 1) seq4_ld(RC, nrec, vb, lt); else seq4_ld(RA, nrec, vb, lt); }
            } else if (F.wave == 0) {
                if (c < 64) {
                    const LAS unsigned char* R = F.lds + (c % 3) * SLOT; LAS unsigned char* EX = F.lds + EXO + par * 4096;
                    const f32x4 z = (f32x4){0.f, 0.f, 0.f, 0.f};
                    v2u yv[4]; bf16x8 fat[8], ftt[6];
#pragma unroll
                    for (int mb = 0; mb < 4; ++mb) yv[mb] = *(const LAS v2u*)(R + 37120 + (mb * 64 + F.lane) * 8);
#pragma unroll
                    for (int f = 0; f < 8; ++f) fat[f] = *(const LAS bf16x8*)(R + RO_AT + (f * 64 + F.lane) * 16);
                    bf16x8 bS[2]; bS[0] = pack_b(S[0], S[1]); bS[1] = pack_b(S[2], S[3]);
                    *(LAS bf16x8*)(EX + F.lane * 16) = bS[0]; *(LAS bf16x8*)(EX + 1024 + F.lane * 16) = bS[1];
                    asm volatile("s_waitcnt lgkmcnt(0)" ::: "memory"); __builtin_amdgcn_sched_barrier(0);
                    f32x4 X[4], U[4];
#pragma unroll
                    for (int mb = 0; mb < 4; ++mb) { X[mb] = unpk4(yv[mb]);
#pragma unroll
                        for (int ks = 0; ks < 2; ++ks) X[mb] = __builtin_amdgcn_mfma_f32_16x16x32_bf16(fat[mb * 2 + ks], bS[ks], X[mb], 0, 0, 0); }
                    __builtin_amdgcn_sched_barrier(0);
                    bf16x8 fbh[8]; f32x4 gm[4]; v2u skv[4];
#pragma unroll
                    for (int f = 0; f < 6; ++f) ftt[f] = *(const LAS bf16x8*)(R + RO_TT + (f * 64 + F.lane) * 16);
#pragma unroll
                    for (int f = 0; f < 8; ++f) fbh[f] = *(const LAS bf16x8*)(R + RO_BH + (f * 64 + F.lane) * 16);
#pragma unroll
                    for (int kb = 0; kb < 4; ++kb) { gm[kb] = *(const LAS f32x4*)(R + RO_GAM + (16 * kb + 4 * fq) * 4); skv[kb] = *(const LAS v2u*)(R + 37120 + 2048 + (kb * 64 + F.lane) * 8); }
                    __builtin_amdgcn_sched_barrier(0);
                    bf16x8 bX[2]; bX[0] = pack_b(X[0], X[1]); bX[1] = pack_b(X[2], X[3]);
#pragma unroll
                    for (int mb = 0; mb < 4; ++mb) { U[mb] = z;
#pragma unroll
                        for (int ks = 0; ks < 2; ++ks) if (!(ks == 1 && mb < 2)) U[mb] = __builtin_amdgcn_mfma_f32_16x16x32_bf16(ftt[tri6(mb, ks)], bX[ks], U[mb], 0, 0, 0); }
                    bf16x8 bU[2]; bU[0] = pack_b(U[0], U[1]); bU[1] = pack_b(U[2], U[3]);
                    *(LAS bf16x8*)(EX + 2048 + F.lane * 16) = bU[0]; *(LAS bf16x8*)(EX + 3072 + F.lane * 16) = bU[1];
                    asm volatile("s_waitcnt lgkmcnt(0)" ::: "memory"); __builtin_amdgcn_sched_barrier(0);
#pragma unroll
                    for (int kb = 0; kb < 4; ++kb) { f32x4 n = S[kb] * gm[kb] + unpk4(skv[kb]);
#pragma unroll
                        for (int ks = 0; ks < 2; ++ks) n = __builtin_amdgcn_mfma_f32_16x16x32_bf16(fbh[kb * 2 + ks], bU[ks], n, 0, 0, 0);
                        S[kb] = n; }
                }
            } else {
                if (c >= 1 && c <= 64) {
                    const int co = c - 1; const LAS unsigned char* R = F.lds + (co % 3) * SLOT; const LAS unsigned char* EX = F.lds + EXO + (par ^ 1) * 4096;
                    bf16x8 fq_[8], fm[6];
#pragma unroll
                    for (int f = 0; f < 8; ++f) fq_[f] = *(const LAS bf16x8*)(R + RO_QH + (f * 64 + F.lane) * 16);
#pragma unroll
                    for (int f = 0; f < 6; ++f) fm[f] = *(const LAS bf16x8*)(R + RO_MRB + (f * 64 + F.lane) * 16);
                    const bf16x8 bS0 = *(const LAS bf16x8*)(EX + F.lane * 16), bS1 = *(const LAS bf16x8*)(EX + 1024 + F.lane * 16), bU0 = *(const LAS bf16x8*)(EX + 2048 + F.lane * 16), bU1 = *(const LAS bf16x8*)(EX + 3072 + F.lane * 16);
                    asm volatile("s_waitcnt lgkmcnt(0)" ::: "memory"); __builtin_amdgcn_sched_barrier(0);
                    f32x4 O[4];
#pragma unroll
                    for (int mb = 0; mb < 4; ++mb) { O[mb] = (f32x4){0.f, 0.f, 0.f, 0.f};
                        O[mb] = __builtin_amdgcn_mfma_f32_16x16x32_bf16(fq_[mb * 2], bS0, O[mb], 0, 0, 0);
                        O[mb] = __builtin_amdgcn_mfma_f32_16x16x32_bf16(fq_[mb * 2 + 1], bS1, O[mb], 0, 0, 0);
                        O[mb] = __builtin_amdgcn_mfma_f32_16x16x32_bf16(fm[tri6(mb, 0)], bU0, O[mb], 0, 0, 0);
                        if (mb >= 2) O[mb] = __builtin_amdgcn_mfma_f32_16x16x32_bf16(fm[tri6(mb, 1)], bU1, O[mb], 0, 0, 0); }
#pragma unroll
                    for (int mb = 0; mb < 4; ++mb)
#pragma unroll
                        for (int r = 0; r < 4; ++r) *(LAS bf16*)(OS + (16 * mb + 4 * fq + r) * 32 + fr * 2) = (bf16)f2bf(O[mb][r]);
                    asm volatile("s_waitcnt lgkmcnt(0)" ::: "memory");
                    { const v4u a_ = *(const LAS v4u*)(OS + F.lane * 32), b_ = *(const LAS v4u*)(OS + F.lane * 32 + 16); bf16* dst_ = Og_ + ((size_t)co * 64 + F.lane) * 16; *(GAS v4u*)dst_ = a_; *(GAS v4u*)(dst_ + 8) = b_; }
                    asm volatile("s_waitcnt lgkmcnt(0)" ::: "memory");
                }
            }
            LDS_BARRIER();
        }
    }
    __syncthreads();
}
__device__ __forceinline__ void phase_seq(Frame& F, int l) {
    for (int u = blockIdx.x; u < 112; u += F.G) {
        if (u < 64) { const int bh = u >> 2, vb = u & 3; seq_rw(F, bh >> 2, bh & 3, vb, F.ws + WS_REC_RW + (size_t)(bh * 64) * REC_RW); }
        else { const int v = u - 64, mm = v % 3, bh = v / 3; seq_unit<false>(F, mm == 2 ? 3 : mm, bh >> 2, bh & 3, 0, F.ws + WS_REC_GL + (size_t)((mm * 16 + bh) * 64) * REC_GL); }
    }
}
struct PostRaw { v4u o0, o1; v4u y0, y1; v4u x0, x1, x2, x3, x4, x5, x6, x7; };
__device__ __forceinline__ void post_load(Frame& F, PostRaw& R, int t, int m, int c0) {
    const bf16* P = WSP(const bf16, WS_P);
    const bf16* Ob = WSP(const bf16, WS_O) + (size_t)m * TOK * 256 + (size_t)t * 256 + c0;
    R.o0 = *(const GAS v4u*)(Ob); R.o1 = *(const GAS v4u*)(Ob + 8);
    { const int bb = t >> 12, tb = t & (SEQ - 1), hh = c0 >> 6, qq = (c0 >> 4) & 3; const bf16* oi = WSP(const bf16, WS_OI) + (m == 2 ? ((size_t)((bb * 4 + hh) * 4 + qq) * SEQ + tb) * 16 : OI_GEN + ((size_t)(((m == 3 ? 2 : m) * 16 + bb * 4 + hh)) * SEQ + tb) * 64 + 16 * qq);
      R.y0 = *(const GAS v4u*)oi; R.y1 = *(const GAS v4u*)(oi + 8); }
    const v4u zz = (v4u){0u, 0u, 0u, 0u}; R.x2 = zz; R.x3 = zz; R.x4 = zz; R.x5 = zz; R.x6 = zz; R.x7 = zz;
    if (m != 2) { const int gc = (m == 0 ? HG_G : m == 1 ? GL_R : RT_G) + c0; R.x0 = *(const GAS v4u*)(P + (size_t)t * NP + gc); R.x1 = *(const GAS v4u*)(P + (size_t)t * NP + gc + 8); }
    else { const size_t ob = (size_t)t * 256 + c0;
        R.x0 = *(const GAS v4u*)(WSP(const bf16, WS_RWR) + ob); R.x1 = *(const GAS v4u*)(WSP(const bf16, WS_RWR) + ob + 8); R.x2 = *(const GAS v4u*)(WSP(const bf16, WS_RWK) + ob); R.x3 = *(const GAS v4u*)(WSP(const bf16, WS_RWK) + ob + 8);
        R.x4 = *(const GAS v4u*)(WSP(const bf16, WS_RWV) + ob); R.x5 = *(const GAS v4u*)(WSP(const bf16, WS_RWV) + ob + 8); R.x6 = *(const GAS v4u*)(WSP(const bf16, WS_RWG) + ob); R.x7 = *(const GAS v4u*)(WSP(const bf16, WS_RWG) + ob + 8); }
}
__device__ __forceinline__ void unpack16(const v4u a, const v4u b, float (&f)[16]) { float x[8], y[8]; unpack8(a, x); unpack8(b, y);
#pragma unroll
    for (int j = 0; j < 8; ++j) { f[j] = x[j]; f[8 + j] = y[j]; } }
__device__ __forceinline__ void phase_post(Frame& F, int l) {
    const int gw = F.vcu * NWAVES + F.wave, NGW = F.G * NWAVES;
    const int m = F.lane >> 4, h = (F.lane >> 2) & 3, qd = F.lane & 3; const int c0 = 64 * h + 16 * qd;
    bf16* Y = WSP(bf16, WS_Y);
    PostRaw cur, nxt;
    if (gw < TOK) post_load(F, cur, gw, m, c0);
    for (int t = gw; t < TOK; t += NGW) {
        if (t + NGW < TOK) post_load(F, nxt, t + NGW, m, c0);
        float o[16], oi[16];
        unpack16(cur.o0, cur.o1, o);
        unpack16(cur.y0, cur.y1, oi);
        float s1 = 0.f, s2 = 0.f;
#pragma unroll
        for (int j = 0; j < 16; ++j) { o[j] += oi[j]; s1 += o[j]; s2 += o[j] * o[j]; }
        s1 = sum4(s1); s2 = sum4(s2);
        float y[16];
        if (m < 2) {
            const float rs = rsqrtf(s2 * (1.f / 64.f) + 1e-6f); const float* ng = INF(m == 0 ? 9 : 12) + l * 64 + 16 * qd;
            float g[16]; unpack16(cur.x0, cur.x1, g);
#pragma unroll
            for (int j = 0; j < 16; ++j) y[j] = o[j] * rs * ng[j] * (g[j] * sigm(g[j]));
        } else if (m == 2) {
            const float mean = s1 * (1.f / 64.f); float var = s2 * (1.f / 64.f) - mean * mean; var = fmaxf(var, 0.f); const float rs = rsqrtf(var + 64e-5f);
            float r[16], k[16], v[16], g[16]; unpack16(cur.x0, cur.x1, r); unpack16(cur.x2, cur.x3, k); unpack16(cur.x4, cur.x5, v); unpack16(cur.x6, cur.x7, g);
            const float* rk = INF(21) + l * 256 + c0; const float* lg = INF(22) + l * 256 + c0; const float* lb = INF(23) + l * 256 + c0;
            float bon = 0.f;
#pragma unroll
            for (int j = 0; j < 16; ++j) bon += r[j] * k[j] * rk[j];
            bon = sum4(bon);
#pragma unroll
            for (int j = 0; j < 16; ++j) y[j] = ((o[j] - mean) * rs * lg[j] + lb[j] + bon * v[j]) * g[j];
        } else {
            const float mean = s1 * (1.f / 64.f); float var = s2 * (1.f / 64.f) - mean * mean; var = fmaxf(var, 0.f); const float rs = rsqrtf(var + 1e-5f);
            float g[16]; unpack16(cur.x0, cur.x1, g);
#pragma unroll
            for (int j = 0; j < 16; ++j) y[j] = (g[j] * sigm(g[j])) * ((o[j] - mean) * rs);
        }
        v4u w0, w1; w0.x = pk2(y[0], y[1]); w0.y = pk2(y[2], y[3]); w0.z = pk2(y[4], y[5]); w0.w = pk2(y[6], y[7]); w1.x = pk2(y[8], y[9]); w1.y = pk2(y[10], y[11]); w1.z = pk2(y[12], y[13]); w1.w = pk2(y[14], y[15]);
        GAS v4u* yo = (GAS v4u*)(Y + (size_t)t * D + 256 * m + c0); yo[0] = w0; yo[1] = w1;
        cur = nxt;
    }
}
template <int MODE> struct LnRaw { v2u h[4]; v2u d1[4], d2[4]; float g1, g2; };
template <int MODE> __device__ __forceinline__ void ln_load(Frame& F, LnRaw<MODE>& R, int m) {
    const GAS v2u* hr = (const GAS v2u*)(WSP(const bf16, WS_HB) + (size_t)m * D) + F.lane;
#pragma unroll
    for (int j = 0; j < 4; ++j) R.h[j] = hr[64 * j];
    if (MODE == 0) { const GAS v2u* ar = (const GAS v2u*)(WSP(const bf16, WS_MIX) + (size_t)m * D) + F.lane;
#pragma unroll
        for (int j = 0; j < 4; ++j) R.d1[j] = ar[64 * j]; }
    else { const bf16* DOUT = WSP(const bf16, WS_DOUT); const float* GATE = WSP(const float, WS_GATE); R.g1 = GATE[2 * m]; R.g2 = GATE[2 * m + 1];
#pragma unroll
        for (int j = 0; j < 4; ++j) { R.d1[j] = ((const GAS v2u*)(DOUT + (size_t)(2 * m) * D))[F.lane + 64 * j]; R.d2[j] = ((const GAS v2u*)(DOUT + (size_t)(2 * m + 1) * D))[F.lane + 64 * j]; } }
}
template <int MODE, bool ROUTE, bool Q8 = false> __device__ __forceinline__ void phase_ln(Frame& F, const float* gw_, const float* bw_, const float* router, int mi, const bool final_out = false) {
    const int gw = F.vcu * NWAVES + F.wave, NGW = F.G * NWAVES;
    bf16* hb = WSP(bf16, WS_HB); float* GATE = WSP(float, WS_GATE);
    LAS float* RT = (LAS float*)F.lds;
    if (ROUTE) { for (int i = F.tid; i < D * NE; i += NWAVES * 64) RT[(i & 7) * D + (i >> 3)] = router[i]; __syncthreads(); }
    f32x4 gv[4], bv[4];
#pragma unroll
    for (int j = 0; j < 4; ++j) { gv[j] = ((const GAS f32x4*)gw_)[F.lane + 64 * j]; bv[j] = ((const GAS f32x4*)bw_)[F.lane + 64 * j]; }
    LnRaw<MODE> cur, nxt;
    if (gw < TOK) ln_load<MODE>(F, cur, gw);
    for (int m = gw; m < TOK; m += NGW) {
        if (m + NGW < TOK) ln_load<MODE>(F, nxt, m + NGW);
        GAS f32x4* hr = (GAS f32x4*)(F.h + (size_t)m * D) + F.lane;
        f32x4 v[4]; float s = 0.f;
#pragma unroll
        for (int j = 0; j < 4; ++j) {
            f32x4 a;
            if (MODE == 0) { const v2u d1 = cur.d1[j]; a = (f32x4){bflo(d1.x), bfhi(d1.x), bflo(d1.y), bfhi(d1.y)}; }
            else { const v2u d1 = cur.d1[j], d2 = cur.d2[j]; const float g1 = cur.g1, g2 = cur.g2;
                a.x = g1 * bflo(d1.x) + g2 * bflo(d2.x); a.y = g1 * bfhi(d1.x) + g2 * bfhi(d2.x); a.z = g1 * bflo(d1.y) + g2 * bflo(d2.y); a.w = g1 * bfhi(d1.y) + g2 * bfhi(d2.y); }
            const v2u hq = cur.h[j]; const f32x4 hv = (f32x4){bflo(hq.x), bfhi(hq.x), bflo(hq.y), bfhi(hq.y)};
            v[j] = hv * DN_ALPHA + a; s += (v[j].x + v[j].y) + (v[j].z + v[j].w); }
        const float mean = wave_sum(s) * (1.f / D); float s2 = 0.f;
#pragma unroll
        for (int j = 0; j < 4; ++j) { v[j] = v[j] - mean; s2 += (v[j].x * v[j].x + v[j].y * v[j].y) + (v[j].z * v[j].z + v[j].w * v[j].w); }
        const float rstd = 1.f / sqrtf(wave_sum(s2) * (1.f / D) + 1e-5f);
        GAS v2u* o8 = (GAS v2u*)(hb + (size_t)m * D) + F.lane;
#pragma unroll
        for (int j = 0; j < 4; ++j) { v[j] = v[j] * rstd * gv[j] + bv[j]; if (final_out) hr[64 * j] = v[j]; v2u w; w.x = pk2(v[j].x, v[j].y); w.y = pk2(v[j].z, v[j].w); o8[64 * j] = w; }
        if (Q8) { float am = 0.f;
#pragma unroll
            for (int j = 0; j < 4; ++j) { const f32x4 a = __builtin_elementwise_abs(v[j]); am = fmaxf(am, fmaxf(fmaxf(a.x, a.y), fmaxf(a.z, a.w))); }
            am = wave_max(am); const float inv = am > 0.f ? 127.f / am : 0.f;
            GAS unsigned* q8 = (GAS unsigned*)(WSP(unsigned char, WS_H8) + (size_t)m * D) + F.lane;
#pragma unroll
            for (int j = 0; j < 4; ++j) q8[64 * j] = pack_i8(v[j].x * inv, v[j].y * inv, v[j].z * inv, v[j].w * inv);
            if (F.lane == 0) WSP(float, WS_RS)[m] = am * (1.f / 127.f); }
        if (ROUTE) {
            float lg[8];
#pragma unroll
            for (int e = 0; e < 8; ++e) { float a = 0.f;
#pragma unroll
                for (int j = 0; j < 4; ++j) { const f32x4 r = *(const LAS f32x4*)(RT + e * D + 4 * (F.lane + 64 * j)); a += (v[j].x * r.x + v[j].y * r.y) + (v[j].z * r.z + v[j].w * r.w); }
                lg[e] = wave_sum(a); }
            int e1 = 0; float l1 = lg[0];
#pragma unroll
            for (int e = 1; e < 8; ++e) if (lg[e] > l1) { l1 = lg[e]; e1 = e; }
            int e2 = -1; float l2 = -3.0e38f;
#pragma unroll
            for (int e = 0; e < 8; ++e) if (e != e1 && lg[e] > l2) { l2 = lg[e]; e2 = e; }
            if (F.lane == 0) {
                const float p2 = __expf(l2 - l1); const float ga = 1.f / (1.f + p2);
                GATE[2 * m] = ga; GATE[2 * m + 1] = p2 * ga;
                int* list = WSP(int, WS_LIST) + (size_t)mi * NE * TOK;
                const unsigned p1 = __hip_atomic_fetch_add((unsigned*)(F.ctl + CW_CNT + (mi * 8 + e1) * 64), 1u, RLX_AGENT); list[e1 * TOK + p1] = 2 * m;
                const unsigned q2 = __hip_atomic_fetch_add((unsigned*)(F.ctl + CW_CNT + (mi * 8 + e2) * 64), 1u, RLX_AGENT); list[e2 * TOK + q2] = 2 * m + 1;
            }
        }
        cur = nxt;
    }
}
__device__ __forceinline__ void phase_gather(Frame& F, int mi) {
    int cnt[8], poff[9]; poff[0] = 0;
    unsigned* cb_ = (unsigned*)(F.ctl + CW_CNT + mi * 8 * 64); asm volatile("" : "+s"(cb_));
#pragma unroll
    for (int e = 0; e < 8; ++e) { cnt[e] = (int)__hip_atomic_load(cb_ + e * 64, RLX_AGENT); poff[e + 1] = poff[e] + ((cnt[e] + 255) >> 8); }
    const int npan = poff[8];
    int* tab = WSP(int, WS_TAB) + mi * TAB_STRIDE;
    if (blockIdx.x == 0) {
        for (int P = F.tid; P < npan; P += NWAVES * 64) { int e = 0, pe = 0, ce = cnt[0];
#pragma unroll
            for (int j = 1; j < 8; ++j) if (P >= poff[j]) { e = j; pe = poff[j]; ce = cnt[j]; }
            tab[4 * P] = e; tab[4 * P + 1] = 256 * (P - pe); tab[4 * P + 2] = ce; tab[4 * P + 3] = 0; }
        if (F.tid == 0) tab[640] = npan;
    }
    const int gw = F.vcu * NWAVES + F.wave, NGW = F.G * NWAVES;
    const int* list = WSP(const int, WS_LIST) + (size_t)mi * NE * TOK; const bf16* hb = WSP(const bf16, WS_HB); bf16* HP = WSP(bf16, WS_HPERM);
    for (int row = gw; row < 256 * npan; row += NGW) { const int P = row >> 8; int e = 0, pe = 0, ce = cnt[0];
#pragma unroll
        for (int j = 1; j < 8; ++j) if (P >= poff[j]) { e = j; pe = poff[j]; ce = cnt[j]; }
        const int r = row - 256 * pe; const int tok = (r < ce) ? (list[e * TOK + r] >> 1) : 0;
        const GAS v4u* s = (const GAS v4u*)(hb + (size_t)tok * D) + F.lane; GAS v4u* d = (GAS v4u*)(HP + (size_t)row * D) + F.lane; d[0] = s[0]; d[64] = s[64]; }
}
struct Args { const void* in[36]; int ph_lo, ph_hi; };
__global__ void __launch_bounds__(NWAVES * 64, 2) mk_fwd(Args args) {
    extern __shared__ __attribute__((aligned(16))) unsigned char lds[];
    Frame F;
    F.lds = (LAS unsigned char*)lds;
    F.MISC = (volatile LAS unsigned*)(F.lds + MISC_OFF);
    F.tid = threadIdx.x; F.lane = F.tid & 63; F.wave = __builtin_amdgcn_readfirstlane(F.tid >> 6);
    const int wave_k = F.wave;
    F.G = gridDim.x; { const int bx = blockIdx.x; F.vcu = (F.G % 8 == 0) ? (bx % 8) * (F.G / 8) + bx / 8 : bx; }
    F.in = args.in; F.ws = (unsigned char*)ldptr(F.in, 35); F.h = (float*)ldptr(F.in, 34);
    F.ctl = (gu32*)(F.ws + WS_CTL);
    for (int u = F.tid; u < (LDS_BYTES - LDSCTL_OFF) / 4; u += NWAVES * 64) ((LAS unsigned*)(F.lds + LDSCTL_OFF))[u] = 0u;
    __syncthreads();
    XcdBarrier bar; bar.bar = (unsigned*)(F.ctl + CW_BAR); bar.x = 0; bar.st = nullptr; bar.wv = 0;
    if (!MK_PER_PHASE) bar = xcd_barrier_post((unsigned*)(F.ctl + CW_BAR), F.MISC + 8);
    const int lo = args.ph_lo, hi = args.ph_hi;
#define IN(k) (lo <= (k) && (k) < hi)
#define PHASE_BEGIN() do { int t_ = wave_k * 64 + lane_id_now(); asm volatile("" : "+v"(t_)); F.tid = t_; F.lane = t_ & 63; F.wave = wave_k; \
        F.ws = (unsigned char*)ldptr(F.in, 35); F.ctl = (gu32*)(F.ws + WS_CTL); F.h = (float*)ldptr(F.in, 34); } while (0)
#define SEAM(k) do { if (IN(k) && IN((k) + 1)) { xcd_barrier(bar); if (DUPMASK & 4096) xcd_barrier(bar); } } while (0)
    for (int l = 0; l < DEPTH; ++l) {
        const int pb = l * NPH; const bool moe = (l & 1); const int mi = l >> 1;
#define PH(k) (((PHMASK >> (k)) & 1) && IN(pb + (k)))
        if (l == 0) { if (PH(0)) { PHASE_BEGIN(); phase_weights<0>(F, 0); } SEAM(pb + 0); }
        if (PH(1)) for (int rep_ = 0; rep_ < (((DUPMASK >> 1) & 1) ? 2 : 1); ++rep_) { PHASE_BEGIN(); if (rep_) __syncthreads();
            pg8::Gemm g{WSP(const bf16, WS_HB), WSP(const bf16, WS_WIN), TOK, NP, D}; pg8::StaticOrder S; S.init(TOK, NP, F.G, (int)blockIdx.x);
            pg8::EpiBf16 E{WSP(bf16, WS_P), NP};
            pg8::gemm_phase<pg8::EpiBf16, pg8::StaticOrder, true, true>(F.lds, g, S, E, F.wave);
        } SEAM(pb + 1);
        if (PH(3)) { PHASE_BEGIN(); phase_chunkpre(F, l); if (DUPMASK & 8) { __syncthreads(); phase_chunkpre(F, l); } } SEAM(pb + 3);
        if (PH(4)) { PHASE_BEGIN(); phase_seq(F, l); if (DUPMASK & 16) { __syncthreads(); phase_seq(F, l); }
            if (!moe && ((int)blockIdx.x >= 112 || F.G <= 112)) { const int sv = F.vcu, sg = F.G; if (sg > 112) { F.vcu = (int)blockIdx.x - 112; F.G = sg - 112; } phase_absmax(F, l); F.vcu = sv; F.G = sg; }
            if (l + 1 < DEPTH && (int)blockIdx.x >= 112 && F.G > 112) { const int sv = F.vcu, sg = F.G; F.vcu = (int)blockIdx.x - 112; F.G = sg - 112; phase_weights<0>(F, l + 1); F.vcu = sv; F.G = sg; }
        } SEAM(pb + 4);
        if (PH(5)) { PHASE_BEGIN(); phase_post(F, l); __syncthreads(); phase_weights<1>(F, l); if (DUPMASK & 32) { __syncthreads(); phase_weights<1>(F, l); } } SEAM(pb + 5);
        if (PH(6)) for (int rep_ = 0; rep_ < (((DUPMASK >> 6) & 1) ? 2 : 1); ++rep_) { PHASE_BEGIN(); if (rep_) __syncthreads();
            pg8::Gemm g{WSP(const bf16, WS_Y), WSP(const bf16, (l & 1) ? WS_WOUT2 : WS_WOUT), TOK, D, D}; pg8::StaticOrder S; S.init(TOK, D, F.G, (int)blockIdx.x);
            pg8::EpiBf16 E{WSP(bf16, WS_MIX), D};
            pg8::gemm_phase<pg8::EpiBf16, pg8::StaticOrder, false, true>(F.lds, g, S, E, F.wave);
        } SEAM(pb + 6);
        if (PH(7)) { PHASE_BEGIN();
            if (moe) phase_ln<0, true>(F, INF(4) + l * D, INF(5) + l * D, INF(30) + (size_t)mi * D * NE, mi);
            else phase_ln<0, false, true>(F, INF(4) + l * D, INF(5) + l * D, nullptr, 0);
        } SEAM(pb + 7);
        if (PH(9)) for (int rep_ = 0; rep_ < (((DUPMASK >> 9) & 1) ? 2 : 1); ++rep_) { PHASE_BEGIN(); if (rep_) __syncthreads();
            if (!moe) { pg8::Gemm g{WSP(const bf16, WS_H8), WSP(const bf16, WS_WUP), TOK, 2 * FFD, D / 2}; pg8::StaticOrder S; S.init(TOK, 2 * FFD, F.G, (int)blockIdx.x);
                pg8::EpiSwiGLU8 E{WSP(bf16, WS_HID), FFD, 22, WSP(const float, WS_RS), __uint_as_float(__hip_atomic_load((unsigned*)(F.ctl + CW_AMAX + l * 64), RLX_AGENT)) * (1.f / 127.f)};
                pg8::gemm_phase<pg8::EpiSwiGLU8, pg8::StaticOrder, true, true, 1>(F.lds, g, S, E, F.wave);
            } else { pg8::MoeOrder<true> S; S.M.init((const unsigned*)(F.ctl + CW_CNT + mi * 8 * 64), WSP(const int, WS_LIST) + (size_t)mi * NE * TOK); const int npan = S.M.poff[8];
                S.tpg = 11; S.G = F.G; S.c = (int)blockIdx.x; S.nunits = npan * 11; S.rowbytes = D * 2;
                pg8::Gemm g{WSP(const bf16, WS_HB), WSP(const bf16, WS_WUP), 256 * npan, 2 * FFE, D};
                pg8::EpiSwiGLU E{WSP(bf16, WS_HID), FFE, 11};
                pg8::gemm_phase<pg8::EpiSwiGLU, pg8::MoeOrder<true>, true, true>(F.lds, g, S, E, F.wave);
            }
        } SEAM(pb + 9);
        if (PH(10)) for (int rep_ = 0; rep_ < (((DUPMASK >> 10) & 1) ? 2 : 1); ++rep_) { PHASE_BEGIN(); if (rep_) __syncthreads();
            if (!moe) { pg8::Gemm g{WSP(const bf16, WS_HID), WSP(const bf16, WS_WDN), TOK, D, FFD}; pg8::StaticOrder S; S.init(TOK, D, F.G, (int)blockIdx.x);
                pg8::EpiBf16 E{WSP(bf16, WS_MIX), D};
                pg8::gemm_phase<pg8::EpiBf16, pg8::StaticOrder, false, true>(F.lds, g, S, E, F.wave);
            } else { pg8::MoeOrder<false> S; S.M.init((const unsigned*)(F.ctl + CW_CNT + mi * 8 * 64), WSP(const int, WS_LIST) + (size_t)mi * NE * TOK); const int npan = S.M.poff[8];
                S.tpg = 4; S.G = F.G; S.c = (int)blockIdx.x; S.nunits = npan * 4; S.rowbytes = 0;
                pg8::Gemm g{WSP(const bf16, WS_HID), WSP(const bf16, WS_WDN), 256 * npan, D, FFE};
                pg8::EpiScatter E{WSP(bf16, WS_DOUT), S.M};
                pg8::gemm_phase<pg8::EpiScatter, pg8::MoeOrder<false>, true, true>(F.lds, g, S, E, F.wave);
            }
        } SEAM(pb + 10);
        if (PH(11)) { PHASE_BEGIN();
            if (moe) phase_ln<1, false>(F, INF(6) + l * D, INF(7) + l * D, nullptr, 0, l == DEPTH - 1);
            else phase_ln<0, false>(F, INF(6) + l * D, INF(7) + l * D, nullptr, 0, l == DEPTH - 1);
            if (l + 1 < DEPTH && F.G <= 112) { __syncthreads(); phase_weights<0>(F, l + 1); }
        } SEAM(pb + 11);
#undef PH
    }
#undef IN
#undef SEAM
}

extern "C" void kernel_launch(void* const* d_in, const int* in_sizes, int n_in, void* d_out, int out_size, void* d_ws, size_t ws_size, hipStream_t stream) {
    static int grid = 0;
    if (grid == 0) {
        if (n_in != 34 || out_size != TOK * D || ws_size < WS_END) { fprintf(stderr, "kernel_launch: unexpected shapes (n_in %d, out %d, ws %zu)\n", n_in, out_size, ws_size); grid = -1; return; }
        int dev = 0, cus = 0, per_cu = 0;
        if (hipGetDevice(&dev) != hipSuccess || hipDeviceGetAttribute(&cus, hipDeviceAttributeMultiprocessorCount, dev) != hipSuccess) { grid = -1; return; }
        if (hipFuncSetAttribute((const void*)mk_fwd, hipFuncAttributeMaxDynamicSharedMemorySize, LDS_BYTES) != hipSuccess) { fprintf(stderr, "kernel_launch: hipFuncSetAttribute failed\n"); grid = -1; return; }
        if (hipOccupancyMaxActiveBlocksPerMultiprocessor(&per_cu, (const void*)mk_fwd, NWAVES * 64, LDS_BYTES) != hipSuccess || per_cu < 1) fprintf(stderr, "kernel_launch: occupancy query reports %d\n", per_cu);
        (void)hipGetLastError();
        grid = cus;
    }
    if (grid < 0) return;
    if (hipMemsetAsync((char*)d_ws + WS_CTL, 0, CTL_ZERO_BYTES, stream) != hipSuccess) return;
    Args a{};
    for (int i = 0; i < 34; ++i) a.in[i] = d_in[i];
    a.in[34] = d_out; a.in[35] = d_ws;
#if MK_PER_PHASE
    for (int p = 0; p < NPHASES; ++p) { a.ph_lo = p; a.ph_hi = p + 1; hipLaunchKernelGGL(mk_fwd, dim3(grid), dim3(NWAVES * 64), LDS_BYTES, stream, a); }
#else
    a.ph_lo = 0; a.ph_hi = NPHASES; hipLaunchKernelGGL(mk_fwd, dim3(grid), dim3(NWAVES * 64), LDS_BYTES, stream, a);
#endif
}
```

```cpp
#include <hip/hip_runtime.h>
#include <cstdio>
#include <cstdint>
#ifndef PHMASK
#define PHMASK 0xfff
#endif
#ifndef DUPMASK
#define DUPMASK 0
#endif
#ifndef DUPL
#define DUPL 0xf
#endif
#ifndef STAG9
#define STAG9 0
#endif
#ifndef MK_PER_PHASE
#define MK_PER_PHASE 0
#endif
__device__ __forceinline__ int lane_id_now() { unsigned m_ = ~0u; asm volatile("" : "+s"(m_)); return (int)__builtin_amdgcn_mbcnt_hi(m_, __builtin_amdgcn_mbcnt_lo(m_, 0u)); }
namespace pg8 {
#define PG8_LAS __attribute__((address_space(3)))
typedef unsigned short bf16_t;
typedef short bf16x8 __attribute__((ext_vector_type(8)));
typedef float f32x4 __attribute__((ext_vector_type(4)));
typedef unsigned u32x4 __attribute__((ext_vector_type(4)));
constexpr int BM = 256, BK = 64, HALF = 128, HTB = HALF * BK * 2  , STAGE_BYTES = 8 * HTB, NXCD = 8, WGM = 8;

__host__ __device__ __forceinline__ int lds_byte(int r, int c) { const int st = (r >> 4) * 2 + (c >> 5), rr = r & 15, cc = c & 31, ob = rr * 64 + cc * 2; return st * 1024 + (ob ^ (((ob >> 9) & 1) << 5)); }
__host__ __device__ __forceinline__ void stage_rc(int b, int& R, int& C) { const int st = b / 1024, sb = b % 1024, swz = sb ^ (((sb >> 9) & 1) << 5); R = (st >> 1) * 16 + swz / 64; C = (st & 1) * 32 + (swz % 64) / 2; }
__host__ __device__ __forceinline__ int perm32(int rho) { const int n = rho >> 4, i = rho & 15; return 8 * (i >> 2) + 4 * n + (i & 3); }

struct Unit { int pm, pn; };
struct Gemm { const bf16_t* A; const bf16_t* Bt; int M, N, K; };

struct StaticOrder {
    static constexpr bool GATHER = false;
    int nM, nN, nwg, G, c;
    __device__ __forceinline__ unsigned a_off(const Unit&, int) const { return 0u; }
    __host__ __device__ void init(int M, int N, int G_, int c_) { nM = M / BM; nN = N / BM; nwg = nM * nN; G = G_; c = c_; }
    __host__ __device__ bool next(int i, Unit& u) const {
        const long L = (long)i * G + c; if (L >= nwg) return false;
        int wgid = (int)L; { const int q = nwg / NXCD, r = nwg % NXCD, xcd = wgid % NXCD, off = wgid / NXCD; wgid = (xcd < r ? xcd * (q + 1) : r * (q + 1) + (xcd - r) * q) + off; }
        const int nig = WGM * nN, gid = wgid / nig, fm = gid * WGM, gsz = (nM - fm) < WGM ? (nM - fm) : WGM;
        u.pm = fm + ((wgid % nig) % gsz); u.pn = (wgid % nig) / gsz; return true;
    }
    __device__ __forceinline__ void a_ready(const Unit&) const {}
    __device__ __forceinline__ void done(const Unit&) const {}
};
__device__ __forceinline__ unsigned cvt_pk_bf16(float lo, float hi) { unsigned r; asm volatile("v_cvt_pk_bf16_f32 %0, %1, %2" : "=v"(r) : "v"(lo), "v"(hi)); return r; }
typedef float f32x2 __attribute__((ext_vector_type(2)));
struct EpiBf16 {
    static constexpr bool PERM = true, AFTER_DRAIN = false;
    bf16_t* O; int ldc;
    __device__ __forceinline__ void operator()(const f32x4 (&acc)[2][2][4][2], const Unit& u, int wr, int wc, int fr, int fq) const {
        const int row0 = u.pm * BM + wr * 64 + fr; const int col0 = u.pn * BM + wc * 32 + 8 * fq;
#pragma unroll
        for (int ai = 0; ai < 2; ++ai)
#pragma unroll
            for (int m = 0; m < 4; ++m) { bf16_t* rowp = O + (size_t)(row0 + ai * HALF + m * 16) * ldc + col0;
#pragma unroll
                for (int bj = 0; bj < 2; ++bj) { const f32x4 v0 = acc[ai][bj][m][0], v1 = acc[ai][bj][m][1];
                    u32x4 w; w.x = cvt_pk_bf16(v0[0], v0[1]); w.y = cvt_pk_bf16(v0[2], v0[3]); w.z = cvt_pk_bf16(v1[0], v1[1]); w.w = cvt_pk_bf16(v1[2], v1[3]);
                    *(u32x4*)(rowp + bj * HALF) = w; } }
    }
};
struct EpiF32 {
    static constexpr bool PERM = false, AFTER_DRAIN = false;
    float* C; int ldc;
    __device__ __forceinline__ void operator()(const f32x4 (&acc)[2][2][4][2], const Unit& u, int wr, int wc, int fr, int fq) const {
        const int row0 = u.pm * BM + wr * 64 + fr, col0 = u.pn * BM + wc * 32 + 4 * fq;
#pragma unroll
        for (int ai = 0; ai < 2; ++ai)
#pragma unroll
            for (int m = 0; m < 4; ++m) { float* rowp = C + (size_t)(row0 + ai * HALF + m * 16) * ldc + col0;
#pragma unroll
                for (int bj = 0; bj < 2; ++bj)
#pragma unroll
                    for (int n = 0; n < 2; ++n) *(f32x4*)(rowp + bj * HALF + n * 16) = acc[ai][bj][m][n]; }
    }
};
__device__ __forceinline__ float silu_f(float x) { return x * __builtin_amdgcn_rcpf(1.0f + __expf(-x)); }
struct EpiSwiGLU {
    static constexpr bool PERM = true, AFTER_DRAIN = false;
    bf16_t* O; int ldc; int tiles_per_group;
    __device__ __forceinline__ void operator()(const f32x4 (&acc)[2][2][4][2], const Unit& u, int wr, int wc, int fr, int fq) const {
        const int row0 = u.pm * BM + wr * 64 + fr; const int pnl = u.pn % tiles_per_group; const int col0 = pnl * HALF + wc * 32 + 8 * fq;
#pragma unroll
        for (int ai = 0; ai < 2; ++ai)
#pragma unroll
            for (int m = 0; m < 4; ++m) { bf16_t* rowp = O + (size_t)(row0 + ai * HALF + m * 16) * ldc + col0;
                float h[8];
#pragma unroll
                for (int n = 0; n < 2; ++n)
#pragma unroll
                    for (int j = 0; j < 4; ++j) h[4 * n + j] = silu_f(acc[ai][0][m][n][j]) * acc[ai][1][m][n][j];
                u32x4 w; w.x = cvt_pk_bf16(h[0], h[1]); w.y = cvt_pk_bf16(h[2], h[3]); w.z = cvt_pk_bf16(h[4], h[5]); w.w = cvt_pk_bf16(h[6], h[7]);
                *(u32x4*)rowp = w; }
    }
};
struct MoeMap {
    int cnt[8], poff[9]; const int* list;
    __device__ __forceinline__ void init(const unsigned* counters, const int* list_) { list = list_; poff[0] = 0;
#pragma unroll
        for (int e = 0; e < 8; ++e) { cnt[e] = __builtin_amdgcn_readfirstlane((int)__hip_atomic_load(counters + e * 64, __ATOMIC_RELAXED, __HIP_MEMORY_SCOPE_AGENT));     poff[e + 1] = poff[e] + ((cnt[e] + 255) >> 8); } }
    __device__ __forceinline__ void locate(int P, int& e, int& lr, int& ce) const { e = 0; int pe = 0; ce = cnt[0];
#pragma unroll
        for (int j = 1; j < 8; ++j) if (P >= poff[j]) { e = j; pe = poff[j]; ce = cnt[j]; }
        lr = 256 * (P - pe); }
};
template <bool MOE> struct EpiSwiGLU8 {
    static constexpr bool PERM = true, AFTER_DRAIN = false;
    bf16_t* O; int ldc; int tiles_per_group; const float* rs; float sw; MoeMap M;
    __device__ __forceinline__ void operator()(const f32x4 (&acc)[2][2][4][2], const Unit& u, int wr, int wc, int fr, int fq) const {
        const int row0 = u.pm * BM + wr * 64 + fr; const int pnl = u.pn % tiles_per_group; const int col0 = pnl * HALF + wc * 32 + 8 * fq;
        float sc[2][4];
        if constexpr (MOE) { int e, lr, ce; M.locate(u.pm, e, lr, ce); const int* lst = M.list + e * 16384;
#pragma unroll
            for (int ai = 0; ai < 2; ++ai)
#pragma unroll
                for (int m = 0; m < 4; ++m) { const int r = lr + wr * 64 + fr + ai * HALF + m * 16; sc[ai][m] = rs[(r < ce) ? (lst[r] >> 1) : 0] * sw; }
        } else {
#pragma unroll
            for (int ai = 0; ai < 2; ++ai)
#pragma unroll
                for (int m = 0; m < 4; ++m) sc[ai][m] = rs[row0 + ai * HALF + m * 16] * sw;
        }
#pragma unroll
        for (int ai = 0; ai < 2; ++ai)
#pragma unroll
            for (int m = 0; m < 4; ++m) { bf16_t* rowp = O + (size_t)(row0 + ai * HALF + m * 16) * ldc + col0;
                float h[8];
#pragma unroll
                for (int n = 0; n < 2; ++n)
#pragma unroll
                    for (int j = 0; j < 4; ++j) { const float ag = acc[ai][0][m][n][j], au = acc[ai][1][m][n][j]; const float g = (float)__float_as_int(ag) * sc[ai][m], up = (float)__float_as_int(au) * sc[ai][m]; h[4 * n + j] = silu_f(g) * up; }
                u32x4 w; w.x = cvt_pk_bf16(h[0], h[1]); w.y = cvt_pk_bf16(h[2], h[3]); w.z = cvt_pk_bf16(h[4], h[5]); w.w = cvt_pk_bf16(h[6], h[7]);
                *(u32x4*)rowp = w; }
    }
};
struct EpiScatter {
    static constexpr bool PERM = true, AFTER_DRAIN = false;
    bf16_t* O; MoeMap M;
    __device__ __forceinline__ void operator()(const f32x4 (&acc)[2][2][4][2], const Unit& u, int wr, int wc, int fr, int fq) const {
        int e, lr, cnt; M.locate(u.pm, e, lr, cnt);
        const int pnl = u.pn & 3; const int col0 = pnl * BM + wc * 32 + 8 * fq; const int* lst = M.list + e * 16384;
#pragma unroll
        for (int ai = 0; ai < 2; ++ai)
#pragma unroll
            for (int m = 0; m < 4; ++m) { const int r = lr + wr * 64 + fr + ai * HALF + m * 16;
                if (r < cnt) { const int slot = lst[r]; bf16_t* rowp = O + (size_t)slot * 1024 + col0;
#pragma unroll
                    for (int bj = 0; bj < 2; ++bj) { const f32x4 v0 = acc[ai][bj][m][0], v1 = acc[ai][bj][m][1];
                        u32x4 w; w.x = cvt_pk_bf16(v0[0], v0[1]); w.y = cvt_pk_bf16(v0[2], v0[3]); w.z = cvt_pk_bf16(v1[0], v1[1]); w.w = cvt_pk_bf16(v1[2], v1[3]);
                        *(u32x4*)(rowp + bj * HALF) = w; } } }
    }
};
template <bool GATHER_> struct MoeOrder {
    static constexpr bool GATHER = GATHER_;
    MoeMap M; int tpg, G, c, nunits; unsigned rowbytes;
    __device__ __forceinline__ bool next(int i, Unit& u) const {
        const int L = i * G + c; if (L >= nunits) return false;
        int wgid = L; { const int q = nunits / NXCD, r = nunits % NXCD, xcd = wgid % NXCD, off = wgid / NXCD; wgid = (xcd < r ? xcd * (q + 1) : r * (q + 1) + (xcd - r) * q) + off; }
        const int P = wgid / tpg, pnl = wgid - P * tpg; int e, lr, ce; M.locate(P, e, lr, ce);
        u.pm = P; u.pn = e * tpg + pnl; return true;
    }
    __device__ __forceinline__ unsigned a_off(const Unit& u, int row) const {
        int e, lr, ce; M.locate(u.pm, e, lr, ce); const int r = lr + row; const int tok = (r < ce) ? (M.list[e * 16384 + r] >> 1) : 0; return (unsigned)tok * rowbytes; }
    __device__ __forceinline__ void a_ready(const Unit&) const {}
    __device__ __forceinline__ void done(const Unit&) const {}
};
typedef int i32x4 __attribute__((ext_vector_type(4)));
template <class Epi, class Sched, bool ALIGN_EPI = false, bool SP2 = false, int MT = 0  >
__device__ __forceinline__ void gemm_phase(PG8_LAS unsigned char* lds, const Gemm g, const Sched& S, const Epi& E, const int wave_in) {
    int tid_ = wave_in * 64 + lane_id_now(); asm volatile("" : "+v"(tid_));
    const int tid = tid_, wid = __builtin_amdgcn_readfirstlane(tid >> 6), lane = tid & 63, wr = wid >> 2, wc = wid & 3, fr = lane & 15, fq = lane >> 4;
    const int K = g.K, nt = K / BK;
    unsigned voffA[2], voffB[2];
#pragma unroll
    for (int i = 0; i < 2; ++i) { int R, C; stage_rc(tid * 16 + i * 8192, R, C); const int Rb = Epi::PERM ? ((R & ~31) + perm32(R & 31)) : R;
        voffA[i] = (unsigned)(R * K + C) * 2u; voffB[i] = (unsigned)(Rb * K + C) * 2u; }
    static_assert(!Sched::GATHER || SP2, "A-row gather is implemented for the SP2 loop");
    unsigned aoc[2][2], aon[2][2];
#define PG8_GOFF(dst, u) do { _Pragma("unroll") for (int _i = 0; _i < 2; ++_i) { int R_, C_; stage_rc(tid * 16 + _i * 8192, R_, C_); _Pragma("unroll") for (int _h = 0; _h < 2; ++_h) dst[_h][_i] = S.a_off(u, _h * HALF + R_) + (unsigned)(C_ * 2); } } while (0)
#define PG8_STAGE_A(bufoff, gbase, kofs, h, nx) do { if constexpr (Sched::GATHER) { const unsigned vo_[2] = {(nx) ? aon[h][0] : aoc[h][0], (nx) ? aon[h][1] : aoc[h][1]}; PG8_STAGE(bufoff, (const char*)g.A + (kofs), vo_); } else { PG8_STAGE(bufoff, gbase, voffA); } } while (0)
    const size_t kstep = (size_t)(BK * 2);
    const size_t hstep = (size_t)HALF * K * 2;
    const size_t tstep = 2 * hstep;
    const unsigned ldsw = (unsigned)wid * 1024u;
    const int aoff = lds_byte(wr * 64 + fr, fq * 8), boff = lds_byte(wc * 32 + fr, fq * 8);
#define PG8_SA(b, h) (((b) * 2 + (h)) * HTB)
#define PG8_SB(b, h) ((4 + (b) * 2 + (h)) * HTB)
#define PG8_STAGE(bufoff, gbase, voff) do { _Pragma("unroll") for (int _i = 0; _i < 2; ++_i) { unsigned o_ = (voff)[_i]; asm volatile("" : "+v"(o_));     \
        __builtin_amdgcn_global_load_lds((const unsigned*)((const char*)(gbase) + o_), (PG8_LAS unsigned*)(lds + (bufoff) + ldsw + _i * 8192), 16, 0, 0); } } while (0)
#define PG8_LDA(dst, b, h) do { _Pragma("unroll") for (int m = 0; m < 4; ++m) _Pragma("unroll") for (int k = 0; k < 2; ++k) dst[m][k] = *(const PG8_LAS bf16x8*)(lds + PG8_SA(b, h) + aoff + m * 2048 + k * 1024); } while (0)
#define PG8_LDB(dst, b, h) do { _Pragma("unroll") for (int n = 0; n < 2; ++n) _Pragma("unroll") for (int k = 0; k < 2; ++k) dst[n][k] = *(const PG8_LAS bf16x8*)(lds + PG8_SB(b, h) + boff + n * 2048 + k * 1024); } while (0)
#define PG8_MMA(ai, bj, At, Bt) do { __builtin_amdgcn_s_setprio(1); _Pragma("unroll") for (int m = 0; m < 4; ++m) _Pragma("unroll") for (int n = 0; n < 2; ++n) _Pragma("unroll") for (int k = 0; k < 2; ++k) \
        { if constexpr (MT == 0) acc[ai][bj][m][n] = __builtin_amdgcn_mfma_f32_16x16x32_bf16(Bt[n][k], At[m][k], acc[ai][bj][m][n], 0, 0, 0); \
          else acc[ai][bj][m][n] = __builtin_bit_cast(f32x4, __builtin_amdgcn_mfma_i32_16x16x64_i8(__builtin_bit_cast(i32x4, Bt[n][k]), __builtin_bit_cast(i32x4, At[m][k]), __builtin_bit_cast(i32x4, acc[ai][bj][m][n]), 0, 0, 0)); } \
        __builtin_amdgcn_s_setprio(0); } while (0)
#define PG8_WAIT_V(n) asm volatile("s_waitcnt vmcnt(" #n ")" ::: "memory")
#define PG8_WAIT_L(n) asm volatile("s_waitcnt lgkmcnt(" #n ")" ::: "memory")
#define PG8_BAR __builtin_amdgcn_s_barrier()
#define PG8_SCHED __builtin_amdgcn_sched_barrier(0)
    Unit cur, nxt; int ui = 0;
    if (!S.next(0, cur)) return;
    f32x4 acc[2][2][4][2];
#pragma unroll
    for (int a = 0; a < 2; ++a)
#pragma unroll
        for (int b = 0; b < 2; ++b)
#pragma unroll
            for (int m = 0; m < 4; ++m)
#pragma unroll
                for (int n = 0; n < 2; ++n) acc[a][b][m][n] = (f32x4){0.f, 0.f, 0.f, 0.f};
    bf16x8 At[4][2], B0[2][2], B1[2][2];
    const char* cA = (const char*)g.A + (size_t)cur.pm * tstep; const char* cB = (const char*)g.Bt + (size_t)cur.pn * tstep;
    S.a_ready(cur);
    if constexpr (SP2) {
        if constexpr (Sched::GATHER) { PG8_GOFF(aoc, cur); }
        PG8_STAGE(PG8_SB(0, 0), cB, voffB); PG8_STAGE(PG8_SB(0, 1), cB + hstep, voffB); PG8_STAGE_A(PG8_SA(0, 0), cA, (size_t)0, 0, false); PG8_STAGE_A(PG8_SA(0, 1), cA + hstep, (size_t)0, 1, false);
        if (wr == 1) PG8_BAR;
        PG8_WAIT_V(2); PG8_BAR;
        PG8_STAGE(PG8_SB(1, 0), cB + kstep, voffB); PG8_STAGE_A(PG8_SA(1, 0), cA + kstep, kstep, 0, false); PG8_STAGE(PG8_SB(1, 1), cB + hstep + kstep, voffB);
        PG8_WAIT_V(6); PG8_BAR;
    } else {
        PG8_STAGE(PG8_SB(0, 0), cB, voffB); PG8_STAGE(PG8_SA(0, 0), cA, voffA); PG8_STAGE(PG8_SB(0, 1), cB + hstep, voffB); PG8_STAGE(PG8_SA(0, 1), cA + hstep, voffA);
        if (wr == 1) PG8_BAR;
        PG8_WAIT_V(4); PG8_BAR;
        PG8_STAGE(PG8_SB(1, 0), cB + kstep, voffB); PG8_STAGE(PG8_SA(1, 0), cA + kstep, voffA); PG8_STAGE(PG8_SB(1, 1), cB + hstep + kstep, voffB);
        PG8_WAIT_V(6); PG8_BAR;
    }
    for (;;) {
        const bool has_next = S.next(ui + 1, nxt);
        const char* nA = has_next ? (const char*)g.A + (size_t)nxt.pm * tstep : cA; const char* nB = has_next ? (const char*)g.Bt + (size_t)nxt.pn * tstep : cB;
        for (int t = 0; t < nt; t += 2) {
            const bool last = (t == nt - 2);
            const char* a1 = cA + (size_t)(t + 1) * kstep;
            const char* a2 = last ? nA : cA + (size_t)(t + 2) * kstep; const char* b2 = last ? nB : cB + (size_t)(t + 2) * kstep;
            const char* a3 = a2 + kstep; const char* b3 = b2 + kstep;
            if (last && has_next) S.a_ready(nxt);
            const size_t ko2 = last ? (size_t)0 : (size_t)(t + 2) * kstep;
            if constexpr (Sched::GATHER) { if (last) { if (has_next) { PG8_GOFF(aon, nxt); } else { _Pragma("unroll") for (int _h = 0; _h < 2; ++_h) { aon[_h][0] = aoc[_h][0]; aon[_h][1] = aoc[_h][1]; } } } }
            if constexpr (SP2) {
            PG8_LDB(B0, 0, 0); PG8_LDB(B1, 0, 1); PG8_SCHED; PG8_LDA(At, 0, 0); PG8_STAGE_A(PG8_SA(1, 1), a1 + hstep, (size_t)(t + 1) * kstep, 1, false);
            PG8_WAIT_V(8); PG8_WAIT_L(0); PG8_BAR; PG8_MMA(0, 0, At, B0); PG8_MMA(0, 1, At, B1); PG8_BAR; PG8_SCHED;
            PG8_LDA(At, 0, 1); PG8_STAGE(PG8_SB(0, 0), b2, voffB); PG8_STAGE(PG8_SB(0, 1), b2 + hstep, voffB); PG8_STAGE_A(PG8_SA(0, 0), a2, ko2, 0, last);
            PG8_WAIT_V(8); PG8_WAIT_L(0); PG8_BAR; PG8_MMA(1, 0, At, B0); PG8_MMA(1, 1, At, B1); PG8_BAR; PG8_SCHED;
            PG8_LDB(B0, 1, 0); PG8_LDB(B1, 1, 1); PG8_SCHED; PG8_LDA(At, 1, 0); PG8_STAGE_A(PG8_SA(0, 1), a2 + hstep, ko2, 1, last);
            PG8_WAIT_V(8); PG8_WAIT_L(0); PG8_BAR; PG8_MMA(0, 0, At, B0); PG8_MMA(0, 1, At, B1); PG8_BAR; PG8_SCHED;
            PG8_LDA(At, 1, 1); PG8_STAGE(PG8_SB(1, 0), b3, voffB); PG8_STAGE(PG8_SB(1, 1), b3 + hstep, voffB); PG8_STAGE_A(PG8_SA(1, 0), a3, ko2 + kstep, 0, last);
            PG8_WAIT_V(8); PG8_WAIT_L(0); PG8_BAR; PG8_MMA(1, 0, At, B0); PG8_MMA(1, 1, At, B1); PG8_BAR; PG8_SCHED;
            } else {
            PG8_LDB(B0, 0, 0); PG8_SCHED; PG8_LDA(At, 0, 0); PG8_STAGE(PG8_SA(1, 1), a1 + hstep, voffA);
            PG8_WAIT_L(8); PG8_BAR; PG8_WAIT_L(0); PG8_MMA(0, 0, At, B0); PG8_BAR; PG8_SCHED;
            PG8_LDB(B1, 0, 1); PG8_STAGE(PG8_SB(0, 0), b2, voffB);
            PG8_BAR; PG8_WAIT_L(0); PG8_MMA(0, 1, At, B1); PG8_BAR;
            PG8_LDA(At, 0, 1); PG8_STAGE(PG8_SA(0, 0), a2, voffA);
            PG8_BAR; PG8_WAIT_L(0); PG8_MMA(1, 0, At, B0); PG8_BAR; PG8_SCHED;
            PG8_STAGE(PG8_SB(0, 1), b2 + hstep, voffB);
            PG8_WAIT_V(6); PG8_BAR; PG8_MMA(1, 1, At, B1); PG8_BAR;
            PG8_LDB(B0, 1, 0); PG8_SCHED; PG8_LDA(At, 1, 0); PG8_STAGE(PG8_SA(0, 1), a2 + hstep, voffA);
            PG8_WAIT_L(8); PG8_BAR; PG8_WAIT_L(0); PG8_MMA(0, 0, At, B0); PG8_BAR; PG8_SCHED;
            PG8_LDB(B1, 1, 1); PG8_STAGE(PG8_SB(1, 0), b3, voffB);
            PG8_BAR; PG8_WAIT_L(0); PG8_MMA(0, 1, At, B1); PG8_BAR;
            PG8_LDA(At, 1, 1); PG8_STAGE(PG8_SA(1, 0), a3, voffA);
            PG8_BAR; PG8_WAIT_L(0); PG8_MMA(1, 0, At, B0); PG8_BAR; PG8_SCHED;
            PG8_STAGE(PG8_SB(1, 1), b3 + hstep, voffB);
            PG8_WAIT_V(6); PG8_BAR; PG8_MMA(1, 1, At, B1); PG8_BAR;
            }
        }
        if constexpr (ALIGN_EPI) { if (wr == 0) PG8_BAR; }
        if constexpr (!Epi::AFTER_DRAIN) { E(acc, cur, wr, wc, fr, fq); S.done(cur); }
        if (!has_next) break;
#pragma unroll
        for (int a = 0; a < 2; ++a)
#pragma unroll
            for (int b = 0; b < 2; ++b)
#pragma unroll
                for (int m = 0; m < 4; ++m)
#pragma unroll
                    for (int n = 0; n < 2; ++n) acc[a][b][m][n] = (f32x4){0.f, 0.f, 0.f, 0.f};
        cur = nxt; cA = nA; cB = nB; ++ui;
        if constexpr (Sched::GATHER) { _Pragma("unroll") for (int _h = 0; _h < 2; ++_h) { aoc[_h][0] = aon[_h][0]; aoc[_h][1] = aon[_h][1]; } }
        if constexpr (ALIGN_EPI) { if (wr == 1) PG8_BAR; }
    }
    PG8_WAIT_V(0);
    if constexpr (!ALIGN_EPI) { if (wr == 0) PG8_BAR; }
    PG8_BAR;
    if constexpr (Epi::AFTER_DRAIN) { E.fused(acc, cur, wr, wc, fr, fq, lds, wid, lane); S.done(cur); }
#undef PG8_SA
#undef PG8_SB
#undef PG8_STAGE
#undef PG8_STAGE_A
#undef PG8_GOFF
#undef PG8_LDA
#undef PG8_LDB
#undef PG8_MMA
#undef PG8_WAIT_V
#undef PG8_WAIT_L
#undef PG8_BAR
#undef PG8_SCHED
}
}
constexpr int NWAVES = 8;
constexpr int TOK = 16384, SEQ = 4096, D = 1024, NP = 4096, INC = 3888, DEPTH = 4;
constexpr int HG_Q = 0, HG_F = 256, HG_I = 512, HG_G = 768;
constexpr int GL_Q = 1024, GL_K = 1152, GL_V = 1280, GL_GLR = 1536, GL_R = 1552;
constexpr int RW_BASE = 1808, RW_R = 1808, RW_K = 2064, RW_V = 2320, RW_WLR = 2576, RW_ALR = 2640, RW_GLR = 2704;
constexpr int RT_Q = 2864, RT_K = 3120, RT_V = 3376, RT_G = 3632;
constexpr int GL_GX = 3904;
constexpr int FFD = 2816, FFE = 1408, NE = 8;
constexpr float DN_ALPHA = 1.6817928305074290f;
constexpr int NPH = 12;
constexpr int NPHASES = NPH * DEPTH;
constexpr size_t MiB = 1u << 20;
constexpr size_t WS_CTL = 0, CTL_ZERO_BYTES = 1 * MiB;
constexpr size_t WS_LIST = 1 * MiB;
constexpr size_t WS_GATE = 2 * MiB;
constexpr size_t WS_TAB = 3 * MiB;
constexpr size_t WS_WIN = 4 * MiB, WS_WOUT = 12 * MiB, WS_WUP = 14 * MiB, WS_WDN = 58 * MiB;
constexpr size_t WS_HB = 80 * MiB;
constexpr size_t WS_MIX = 112 * MiB;
constexpr size_t WS_O = WS_MIX;
constexpr size_t WS_OI = 144 * MiB;
constexpr size_t OI_GEN = 64 * 4096 * 16;
constexpr size_t WS_VF = 176 * MiB;
constexpr size_t WS_P = 184 * MiB;
constexpr size_t WS_RWW = 312 * MiB;
constexpr size_t WS_RWR = 328 * MiB, WS_RWK = 336 * MiB, WS_RWV = 344 * MiB, WS_RWKK = 352 * MiB, WS_RWB = 360 * MiB, WS_RWG = 368 * MiB;
constexpr size_t WS_Y = 376 * MiB;
constexpr size_t WS_CS = 461 * MiB;
constexpr size_t WS_HID = 184 * MiB;
constexpr size_t WS_DOUT = 280 * MiB;
constexpr size_t WS_HPERM = 344 * MiB;
constexpr size_t WS_H8 = 344 * MiB;
constexpr size_t WS_RS = 360 * MiB;
constexpr size_t WS_WOUT2 = 465 * MiB;
constexpr size_t WS_END = 467 * MiB;
constexpr int CW_BAR = 4096;
constexpr int CW_CNT = 16384;
constexpr int CW_AMAX = 20480;
constexpr int TAB_STRIDE = 4 * 160 + 16;
constexpr size_t WS_LORA = 2 * MiB + 512 * 1024;
constexpr int LO_W2 = 0, LO_A2 = 256 * 64, LO_G2 = 2 * 256 * 64, LO_V1 = LO_G2 + 256 * 160, LO_V2 = LO_V1 + 32 * 256, LO_END = LO_V2 + 256 * 32;
constexpr int RING_BYTES = 131072, LDSCTL_OFF = 146432, MISC_OFF = LDSCTL_OFF + 320, LDS_BYTES = 147456;
#define GAS __attribute__((address_space(1)))
#define LAS __attribute__((address_space(3)))
typedef unsigned short bf16;
typedef unsigned v4u __attribute__((ext_vector_type(4)));
typedef unsigned v2u __attribute__((ext_vector_type(2)));
typedef float f32x4 __attribute__((ext_vector_type(4)));
typedef short bf16x8 __attribute__((ext_vector_type(8)));
typedef GAS unsigned gu32;
#define RLX_AGENT __ATOMIC_RELAXED, __HIP_MEMORY_SCOPE_AGENT
#define LDS_WAIT() asm volatile("s_waitcnt lgkmcnt(0)" ::: "memory")
#define VM_WAIT() asm volatile("s_waitcnt vmcnt(0)" ::: "memory")
#define LDS_BARRIER() do { asm volatile("s_waitcnt lgkmcnt(0)" ::: "memory"); __builtin_amdgcn_s_barrier(); asm volatile("" ::: "memory"); } while (0)
typedef float f32x2_t __attribute__((ext_vector_type(2))); typedef __bf16 bf16x2_t __attribute__((ext_vector_type(2)));
__device__ __forceinline__ unsigned pk2(float lo, float hi) { f32x2_t v = {lo, hi}; bf16x2_t b = __builtin_convertvector(v, bf16x2_t); return __builtin_bit_cast(unsigned, b); }
__device__ __forceinline__ unsigned f2bf(float f) { return pk2(f, f) & 0xffffu; }
__device__ __forceinline__ float bflo(unsigned w) { return __builtin_bit_cast(float, w << 16); }
__device__ __forceinline__ float bfhi(unsigned w) { return __builtin_bit_cast(float, w & 0xffff0000u); }
__device__ __forceinline__ float bf1(bf16 b) { return __builtin_bit_cast(float, ((unsigned)b) << 16); }
__device__ __forceinline__ void unpack8(const v4u w, float (&f)[8]) { f[0] = bflo(w.x); f[1] = bfhi(w.x); f[2] = bflo(w.y); f[3] = bfhi(w.y); f[4] = bflo(w.z); f[5] = bfhi(w.z); f[6] = bflo(w.w); f[7] = bfhi(w.w); }
__device__ __forceinline__ v4u pack8(const float (&f)[8]) { v4u w; w.x = pk2(f[0], f[1]); w.y = pk2(f[2], f[3]); w.z = pk2(f[4], f[5]); w.w = pk2(f[6], f[7]); return w; }
__device__ __forceinline__ float sigm(float x) { return __builtin_amdgcn_rcpf(1.0f + __expf(-x)); }
template <int CTRL> __device__ __forceinline__ float dpp(float x) { return __builtin_bit_cast(float, __builtin_amdgcn_mov_dpp(__builtin_bit_cast(int, x), CTRL, 0xf, 0xf, true)); }
__device__ __forceinline__ float sum16(float x) { x += dpp<0xB1>(x); x += dpp<0x4E>(x); x += dpp<0x141>(x); x += dpp<0x128>(x); return x; }
__device__ __forceinline__ float sum4(float x) { x += dpp<0xB1>(x); x += dpp<0x4E>(x); return x; }
__device__ __forceinline__ float wave_sum(float x) {
    x = sum16(x);
    auto s = __builtin_amdgcn_permlane16_swap(__float_as_uint(x), __float_as_uint(x), false, false); x = __uint_as_float(s[0]) + __uint_as_float(s[1]);
    auto t = __builtin_amdgcn_permlane32_swap(__float_as_uint(x), __float_as_uint(x), false, false); return __uint_as_float(t[0]) + __uint_as_float(t[1]);
}
__device__ __forceinline__ float wave_max(float x) {
    x = fmaxf(x, dpp<0xB1>(x)); x = fmaxf(x, dpp<0x4E>(x)); x = fmaxf(x, dpp<0x141>(x)); x = fmaxf(x, dpp<0x128>(x));
    auto s = __builtin_amdgcn_permlane16_swap(__float_as_uint(x), __float_as_uint(x), false, false); x = fmaxf(__uint_as_float(s[0]), __uint_as_float(s[1]));
    auto t = __builtin_amdgcn_permlane32_swap(__float_as_uint(x), __float_as_uint(x), false, false); return fmaxf(__uint_as_float(t[0]), __uint_as_float(t[1]));
}
__device__ __forceinline__ unsigned pack_i8(float a, float b, float c, float d) {
    const int ia = (int)__builtin_rintf(a), ib = (int)__builtin_rintf(b), ic = (int)__builtin_rintf(c), id = (int)__builtin_rintf(d);
    return ((unsigned)ia & 255u) | (((unsigned)ib & 255u) << 8) | (((unsigned)ic & 255u) << 16) | ((unsigned)id << 24);
}
__device__ const double INVF2PI[32] = {0.15915494309189535, 0.11934937021124886, 0.08949940160889101, 0.06711508300522726, 0.050329212104487035, 0.03774158471741977, 0.0283021958306234, 0.02122365276477766, 0.015915494309189534, 0.011934937021124886, 0.008949940160889102, 0.006711508300522725, 0.005032921210448704, 0.003774158471741977, 0.00283021958306234, 0.0021223652764777662, 0.0015915494309189536, 0.0011934937021124885, 0.0008949940160889102, 0.0006711508300522726, 0.0005032921210448703, 0.00037741584717419774, 0.00028302195830623395, 0.0002122365276477766, 0.00015915494309189535, 0.00011934937021124886, 8.949940160889102e-05, 6.711508300522725e-05, 5.0329212104487035e-05, 3.774158471741978e-05, 2.8302195830623396e-05, 2.122365276477766e-05};
#define XB_TMO      128
#define XB_XCNT(j)  (256  + 64 * (j))
#define XB_XSUB(j)  (1280 + 64 * (j))
#define XB_XGEN(j)  (2304 + 64 * (j))
#define XB_TOP      3328
#define XB_TOPGEN   3392
#define XCD_BAR_WORDS 3456
#define XB_SPIN_CAP (1u << 18)

__device__ __forceinline__ unsigned xb_ld(unsigned* p)              { return __hip_atomic_load(p, __ATOMIC_RELAXED, __HIP_MEMORY_SCOPE_AGENT); }
__device__ __forceinline__ unsigned xb_add(unsigned* p, unsigned v) { return __hip_atomic_fetch_add(p, v, __ATOMIC_RELAXED, __HIP_MEMORY_SCOPE_AGENT); }
__device__ __forceinline__ unsigned xb_xcc_id() { return (unsigned)__builtin_amdgcn_s_getreg((3 << 11) | 20) & 0xFu; }
#define XB_SPIN(cond, bar) do { unsigned _sp = 0; while (cond) { __builtin_amdgcn_s_sleep(1); \
    if ((++_sp & 255u) == 0u) { if (xb_ld(&(bar)[XB_TMO])) break; if (_sp > XB_SPIN_CAP) { atomicAdd(&(bar)[XB_TMO], 1u); break; } } } } while (0)

struct XcdBarrier {
    unsigned* bar; unsigned x;
    volatile LAS unsigned* st;
    int wv;
};

__device__ __forceinline__ XcdBarrier xcd_barrier_post(unsigned* bar, volatile LAS unsigned* st) {
    XcdBarrier b; b.bar = bar; b.x = xb_xcc_id(); b.st = st; b.wv = __builtin_amdgcn_readfirstlane((int)threadIdx.x >> 6);
    if (threadIdx.x == 0) (void)xb_add(&bar[XB_XCNT(b.x)], 1u);
    return b;
}
__device__ __forceinline__ void xcd_barrier_complete(unsigned* bar, unsigned x, unsigned& nloc, unsigned& nx) {
    const unsigned G = gridDim.x * gridDim.y * gridDim.z;
    unsigned sum, cnt, mine, sp = 0u;
    for (;;) {
        sum = 0u; cnt = 0u; mine = 0u;
#pragma unroll 1
        for (unsigned j = 0; j < 16; ++j) { const unsigned c = xb_ld(&bar[XB_XCNT(j)]); sum += c; cnt += (c > 0u) ? 1u : 0u; mine = (j == x) ? c : mine; }
        if (sum == G) break;
        __builtin_amdgcn_s_sleep(1);
        if ((++sp & 255u) == 0u) { if (xb_ld(&bar[XB_TMO])) break; if (sp > XB_SPIN_CAP) { atomicAdd(&bar[XB_TMO], 1u); break; } }
    }
    nloc = mine > 0u ? mine : 1u; nx = cnt > 0u ? cnt : 1u;
}

__device__ __forceinline__ void xcd_barrier(const XcdBarrier& b) {
    asm volatile("s_waitcnt vmcnt(0)" ::: "memory");
    __syncthreads();
    if (b.wv == 0 && lane_id_now() == 0) {
        unsigned* bar = b.bar;
        __builtin_amdgcn_s_waitcnt(0);
        unsigned nloc = b.st[0], nx = b.st[1];
        if (nloc == 0u) { xcd_barrier_complete(bar, b.x, nloc, nx); b.st[0] = nloc; b.st[1] = nx; }
        const unsigned old = xb_add(&bar[XB_XSUB(b.x)], 1u);
        const unsigned gen = old / nloc;
        if (old + 1u == (gen + 1u) * nloc) {
            __builtin_amdgcn_fence(__ATOMIC_RELEASE, "agent");
            asm volatile("s_waitcnt vmcnt(0)" ::: "memory");
            const unsigned og = xb_add(&bar[XB_TOP], 1u);
            const unsigned tg = og / nx;
            if (og + 1u == (tg + 1u) * nx) xb_add(&bar[XB_TOPGEN], 1u);
            else XB_SPIN(xb_ld(&bar[XB_TOPGEN]) == tg, bar);
            __builtin_amdgcn_fence(__ATOMIC_ACQUIRE, "agent");
            xb_add(&bar[XB_XGEN(b.x)], 1u);
            asm volatile("s_waitcnt vmcnt(0)" ::: "memory");
        } else {
            XB_SPIN(xb_ld(&bar[XB_XGEN(b.x)]) == gen, bar);
            __builtin_amdgcn_fence(__ATOMIC_ACQUIRE, "agent");
            asm volatile("s_waitcnt vmcnt(0)" ::: "memory");
        }
    }
    __syncthreads();
}
struct Frame {
    LAS unsigned char* lds;
    volatile LAS unsigned* MISC;
    gu32* ctl;
    int tid, lane, wave;
    int vcu, G;
    unsigned char* ws;
    const void* const* in;
    float* h;
};
__device__ __forceinline__ const void* ldptr(const void* const* tab, int k) { int z; asm volatile("s_mov_b32 %0, 0" : "=s"(z)); return tab[k + z]; }
#define INF(k) ((const float*)ldptr(F.in, k))
#define WSP(T, off) ((T*)(F.ws + (off)))

__device__ __forceinline__ void xpose_item(const float* W, int ldw, int nvalid, int k0, int n0, bf16* WT, int ldt, int drow0, LAS float* scr, int lane) {
#pragma unroll 8
    for (int i = 0; i < 32; ++i) { const int kk = 2 * i + (lane >> 5), n = n0 + (lane & 31); scr[kk * 33 + (lane & 31)] = (n < nvalid) ? W[(size_t)(k0 + kk) * ldw + n] : 0.f; }
    LDS_WAIT(); asm volatile("" ::: "memory");
    const int c = lane & 7;
#pragma unroll
    for (int j = 0; j < 4; ++j) { const int n = (lane >> 3) + 8 * j; const LAS float* s = scr + (8 * c) * 33 + n;
        v4u o; o.x = pk2(s[0 * 33], s[1 * 33]); o.y = pk2(s[2 * 33], s[3 * 33]); o.z = pk2(s[4 * 33], s[5 * 33]); o.w = pk2(s[6 * 33], s[7 * 33]);
        *(GAS v4u*)(WT + (size_t)(drow0 + n) * ldt + k0 + 8 * c) = o; }
    LDS_WAIT(); asm volatile("" ::: "memory");
}
__device__ __forceinline__ void xpose_item8(const float* W, int ldw, int k0, int n0, unsigned char* WT, int ldt, int drow0, float qs, LAS float* scr, int lane) {
#pragma unroll 8
    for (int i = 0; i < 32; ++i) { const int kk = 2 * i + (lane >> 5), n = n0 + (lane & 31); scr[kk * 33 + (lane & 31)] = W[(size_t)(k0 + kk) * ldw + n]; }
    LDS_WAIT(); asm volatile("" ::: "memory");
    const int c = lane & 7;
#pragma unroll
    for (int j = 0; j < 4; ++j) { const int n = (lane >> 3) + 8 * j; const LAS float* s = scr + (8 * c) * 33 + n;
        v2u o; o.x = pack_i8(s[0 * 33] * qs, s[1 * 33] * qs, s[2 * 33] * qs, s[3 * 33] * qs); o.y = pack_i8(s[4 * 33] * qs, s[5 * 33] * qs, s[6 * 33] * qs, s[7 * 33] * qs);
        *(GAS v2u*)(WT + (size_t)(drow0 + n) * ldt + k0 + 8 * c) = o; }
    LDS_WAIT(); asm volatile("" ::: "memory");
}
__device__ __forceinline__ int gu_row(int n) { return 256 * (n >> 7) + (n & 127); }
template <int PART> __device__ __forceinline__ void phase_weights(Frame& F, int l) {
    LAS float* scr = (LAS float*)(F.lds + F.wave * 16384);
    const int gw = F.vcu * NWAVES + F.wave, NGW = F.G * NWAVES;
    const bool moe = (l & 1); const int fi = l >> 1;
    constexpr int I_IN = 16 * 128, I_OUT = 16 * 32;
    constexpr int I_DG = 16 * 88, I_DD = 44 * 32;
    constexpr int I_MG = 16 * 44, I_MD = 22 * 32;
    const int nitems = PART == 0 ? (I_IN + I_OUT) : (moe ? NE * (2 * I_MG + I_MD) : (2 * I_DG + I_DD));
    float qs8 = 0.f; if (PART == 1) { const float am = __uint_as_float(__hip_atomic_load((unsigned*)(F.ctl + CW_AMAX + l * 64), RLX_AGENT)); qs8 = am > 0.f ? 127.f / am : 0.f; }
    for (int it = gw; it < nitems; it += NGW) {
        int r = it + (PART == 0 ? 0 : I_IN + I_OUT);
        if (r < I_IN) { const int kb = r >> 7, nb = r & 127; if (nb < 122) xpose_item(INF(2) + (size_t)l * D * INC, INC, INC, 64 * kb, 32 * nb, WSP(bf16, WS_WIN), D, 32 * nb, scr, F.lane); continue; } r -= I_IN;
        if (r < I_OUT) { const int kb = r >> 5, nb = r & 31; xpose_item(INF(3) + (size_t)l * D * D, D, D, 64 * kb, 32 * nb, WSP(bf16, (l & 1) ? WS_WOUT2 : WS_WOUT), D, 32 * nb, scr, F.lane); continue; } r -= I_OUT;
        if (!moe) {
            if (r < 2 * I_DG) { const int up = r >= I_DG; if (up) r -= I_DG; const int kb = r / 88, nb = r % 88;
                xpose_item8(INF(up ? 28 : 27) + (size_t)fi * D * FFD, FFD, 64 * kb, 32 * nb, WSP(unsigned char, WS_WUP), D, gu_row(32 * nb) + (up ? 128 : 0), qs8, scr, F.lane); continue; } r -= 2 * I_DG;
            { const int kb = r >> 5, nb = r & 31; xpose_item(INF(29) + (size_t)fi * FFD * D, D, D, 64 * kb, 32 * nb, WSP(bf16, WS_WDN), FFD, 32 * nb, scr, F.lane); }
        } else {
            const int per = 2 * I_MG + I_MD; const int e = r / per; r -= e * per;
            if (r < 2 * I_MG) { const int up = r >= I_MG; if (up) r -= I_MG; const int kb = r / 44, nb = r % 44;
                xpose_item8(INF(up ? 32 : 31) + (size_t)(fi * NE + e) * D * FFE, FFE, 64 * kb, 32 * nb, WSP(unsigned char, WS_WUP) + (size_t)e * 2 * FFE * D, D, gu_row(32 * nb) + (up ? 128 : 0), qs8, scr, F.lane); continue; } r -= 2 * I_MG;
            { const int kb = r >> 5, nb = r & 31; xpose_item(INF(33) + (size_t)(fi * NE + e) * FFE * D, D, D, 64 * kb, 32 * nb, WSP(bf16, WS_WDN) + (size_t)e * D * FFE, FFE, 32 * nb, scr, F.lane); }
        }
    }
    if (PART == 0) {
        const int gt = F.vcu * NWAVES * 64 + F.tid; int NT = F.G * NWAVES * 64; asm volatile("" : "+s"(NT));     const float* win = INF(2) + (size_t)l * D * INC; const float* gw2 = INF(10) + l * 16 * 128; bf16* WT = WSP(bf16, WS_WIN);
        for (int e = gt; e < 128 * D; e += NT) { const int n = e >> 10, d = e & 1023; const float* wr = win + (size_t)d * INC + (GL_GLR - 0); float a = 0.f;
#pragma unroll
            for (int r = 0; r < 16; ++r) a += wr[r] * gw2[r * 128 + n];
            WT[(size_t)(GL_GX + n) * D + d] = (bf16)f2bf(a); }
        if (l == 0) {
            f32x2_t* CS = WSP(f32x2_t, WS_CS); const int* pos = (const int*)ldptr(F.in, 1);
            for (int e = gt; e < TOK * 32; e += NT) { const int t = e >> 5, i = e & 31; const double rev = (double)pos[t] * INVF2PI[i]; const float fr_ = (float)(rev - floor(rev));
                f32x2_t cs; cs.x = __builtin_amdgcn_cosf(fr_); cs.y = __builtin_amdgcn_sinf(fr_); CS[e] = cs; } }
    }
    if (PART == 0) {
        bf16* LO = WSP(bf16, WS_LORA); const int gt = F.vcu * NWAVES * 64 + F.tid; int NT = F.G * NWAVES * 64; asm volatile("" : "+s"(NT));
        const float* w2 = INF(15) + (size_t)l * 64 * 256; const float* a2 = INF(17) + (size_t)l * 64 * 256; const float* g2 = INF(18) + (size_t)l * 160 * 256;
        for (int e = gt; e < LO_END; e += NT) { float v;
            if (e < LO_A2) { const int n = e >> 6, k = e & 63; v = w2[k * 256 + n]; }
            else if (e < LO_G2) { const int q = e - LO_A2, n = q >> 6, k = q & 63; v = a2[k * 256 + n]; }
            else if (e < LO_V1) { const int q = e - LO_G2, n = q / 160, k = q - n * 160; v = g2[k * 256 + n]; }
            else if (e < LO_V2) { const int q = e - LO_V1, n = q >> 8, k = q & 255; v = (l > 0) ? (INF(25) + (size_t)(l - 1) * 256 * 32)[k * 32 + n] : 0.f; }
            else { const int q = e - LO_V2, n = q >> 5, k = q & 31; v = (l > 0) ? (INF(26) + (size_t)(l - 1) * 32 * 256)[k * 256 + n] : 0.f; }
            LO[e] = (bf16)f2bf(v); }
    }
    if (PART == 0 && l == 0) {
        const float* x = INF(0); bf16* hb = WSP(bf16, WS_HB);
        for (int m = gw; m < TOK; m += NGW) {
            const GAS f32x4* xr = (const GAS f32x4*)(x + (size_t)m * D) + F.lane; GAS f32x4* hr = (GAS f32x4*)(F.h + (size_t)m * D) + F.lane; GAS v2u* o8 = (GAS v2u*)(hb + (size_t)m * D) + F.lane;
#pragma unroll
            for (int j = 0; j < 4; ++j) { const f32x4 v = xr[64 * j]; v2u w; w.x = pk2(v.x, v.y); w.y = pk2(v.z, v.w); o8[64 * j] = w; }
        }
    }
}
__device__ __forceinline__ void phase_absmax(Frame& F, int l) {
    const bool moe = (l & 1); const int fi = l >> 1;
    const int n4 = (moe ? NE * D * FFE : D * FFD) / 4;
    const GAS f32x4* g = (const GAS f32x4*)INF(moe ? 31 : 27) + (size_t)fi * n4; const GAS f32x4* u = (const GAS f32x4*)INF(moe ? 32 : 28) + (size_t)fi * n4;
    const int gt = F.vcu * NWAVES * 64 + F.tid; int NT = F.G * NWAVES * 64; asm volatile("" : "+s"(NT));
    f32x4 mx = (f32x4){0.f, 0.f, 0.f, 0.f};
    for (int i = gt; i < n4; i += 4 * NT) {
        f32x4 a[4], b[4];
#pragma unroll
        for (int j = 0; j < 4; ++j) { const int ij = (i + j * NT < n4) ? i + j * NT : i; a[j] = g[ij]; b[j] = u[ij]; }
#pragma unroll
        for (int j = 0; j < 4; ++j) mx = __builtin_elementwise_max(mx, __builtin_elementwise_max(__builtin_elementwise_abs(a[j]), __builtin_elementwise_abs(b[j])));
    }
    float m = fmaxf(fmaxf(mx.x, mx.y), fmaxf(mx.z, mx.w));
    m = wave_max(m);
    if (F.lane == 0) __hip_atomic_fetch_max((unsigned*)(F.ctl + CW_AMAX + l * 64), __float_as_uint(m), RLX_AGENT);
}
template <int NKS> __device__ __forceinline__ void rw_mm16(f32x4 (&acc)[2][4], const LAS bf16* X, int ldx, int mb0, const bf16* BT, int hh, int lane) {
    const int fr = lane & 15, fq = lane >> 4; constexpr int K = 32 * NKS;
    bf16x8 bfr[NKS][4];
#pragma unroll
    for (int ks = 0; ks < NKS; ++ks)
#pragma unroll
        for (int nb = 0; nb < 4; ++nb) bfr[ks][nb] = *(const GAS bf16x8*)(BT + (size_t)(64 * hh + 16 * nb + fr) * K + 32 * ks + 8 * fq);
#pragma unroll
    for (int ks = 0; ks < NKS; ++ks)
#pragma unroll
        for (int mi = 0; mi < 2; ++mi) { const bf16x8 a = *(const LAS bf16x8*)(X + (16 * (mb0 + mi) + fr) * ldx + 32 * ks + 8 * fq);
#pragma unroll
            for (int nb = 0; nb < 4; ++nb) acc[mi][nb] = __builtin_amdgcn_mfma_f32_16x16x32_bf16(a, bfr[ks][nb], acc[mi][nb], 0, 0, 0); }
}
__device__ __forceinline__ void rwprep_tile(Frame& F, int l, int tile) {
    const bf16* P = WSP(const bf16, WS_P);
    const float* mu = INF(13) + l * 1056;
    LAS bf16* X1 = (LAS bf16*)F.lds; LAS bf16* X2 = X1 + 64 * 72; LAS bf16* X3 = X2 + 64 * 72; LAS bf16* XV = X3 + 64 * 168; LAS bf16* X5 = XV + 64 * 264; LAS bf16* XK = X5 + 64 * 40;
    float* RWW = WSP(float, WS_RWW); bf16* RWR = WSP(bf16, WS_RWR); bf16* RWK = WSP(bf16, WS_RWK); bf16* RWV = WSP(bf16, WS_RWV);
    bf16* RWKK = WSP(bf16, WS_RWKK); bf16* RWB = WSP(bf16, WS_RWB); bf16* RWG = WSP(bf16, WS_RWG); bf16* VF = WSP(bf16, WS_VF);
    const bf16* LORA = WSP(const bf16, WS_LORA);
    int tid_ = F.tid; asm volatile("" : "+v"(tid_));
    const int lane_ = tid_ & 63, wave_ = __builtin_amdgcn_readfirstlane(tid_ >> 6);
    const int fr = lane_ & 15, fq = lane_ >> 4, hh = wave_ & 3, mb0 = 2 * (wave_ >> 2);
    const int t0 = tile * 64;
#pragma unroll
    for (int half = 0; half < 2; ++half) {
        v4u rc[9], rp[9];
#pragma unroll
        for (int i = 0; i < 9; ++i) { const int g = tid_ + (half * 9 + i) * 512; rc[i] = (v4u){0u, 0u, 0u, 0u}; rp[i] = rc[i];
            if (g < 64 * 132) { const int tt = g / 132, cg = g - tt * 132, t = t0 + tt; const int col = RW_BASE + 8 * (cg < 36 ? 96 + cg : cg < 68 ? cg - 36 : cg < 100 ? 64 + (cg - 68) : 32 + (cg - 100));
                rc[i] = *(const GAS v4u*)(P + (size_t)t * NP + col); if ((t & (SEQ - 1)) != 0) rp[i] = *(const GAS v4u*)(P + (size_t)(t - 1) * NP + col); } }
#pragma unroll
        for (int i = 0; i < 9; ++i) { const int g = tid_ + (half * 9 + i) * 512;
            if (g < 64 * 132) { const int tt = g / 132, cg = g - tt * 132, t = t0 + tt; const int rel = 8 * (cg < 36 ? 96 + cg : cg < 68 ? cg - 36 : cg < 100 ? 64 + (cg - 68) : 32 + (cg - 100));
                const f32x4 m0 = *(const GAS f32x4*)(mu + rel), m1 = *(const GAS f32x4*)(mu + rel + 4); const float m[8] = {m0.x, m0.y, m0.z, m0.w, m1.x, m1.y, m1.z, m1.w};
                float cv[8], pv[8], xs[8]; unpack8(rc[i], cv); unpack8(rp[i], pv);
#pragma unroll
                for (int j = 0; j < 8; ++j) xs[j] = cv[j] + (pv[j] - cv[j]) * m[j];
                if (cg < 8) {
#pragma unroll
                    for (int j = 0; j < 8; ++j) { const float e2 = __expf(2.f * xs[j]); xs[j] = 1.f - 2.f * __builtin_amdgcn_rcpf(e2 + 1.f); }
                    *(LAS v4u*)(X1 + tt * 72 + 8 * cg) = pack8(xs);
                } else if (cg < 16) { *(LAS v4u*)(X2 + tt * 72 + 8 * (cg - 8)) = pack8(xs);
                } else if (cg < 36) {
#pragma unroll
                    for (int j = 0; j < 8; ++j) xs[j] = sigm(xs[j]);
                    *(LAS v4u*)(X3 + tt * 168 + 8 * (cg - 16)) = pack8(xs);
                } else if (cg < 68) { *(GAS v4u*)(RWR + (size_t)t * 256 + 8 * (cg - 36)) = pack8(xs);
                } else if (cg < 100) { const v4u w = pack8(xs); *(LAS v4u*)(XV + tt * 264 + 8 * (cg - 68)) = w;
                    if (l == 0) { *(GAS v4u*)(RWV + (size_t)t * 256 + 8 * (cg - 68)) = w; *(GAS v4u*)(VF + (size_t)t * 256 + 8 * (cg - 68)) = w; }
                } else { *(LAS v4u*)(XK + tt * 264 + 8 * (cg - 100)) = pack8(xs); } } }
    }
    __syncthreads();
    {   f32x4 acc[2][4];
#pragma unroll
        for (int mi = 0; mi < 2; ++mi)
#pragma unroll
            for (int nb = 0; nb < 4; ++nb) acc[mi][nb] = (f32x4){0.f, 0.f, 0.f, 0.f};
        rw_mm16<2>(acc, X1, 72, mb0, LORA + LO_W2, hh, lane_);
        const float* w0 = INF(14) + l * 256;
#pragma unroll
        for (int mi = 0; mi < 2; ++mi)
#pragma unroll
            for (int nb = 0; nb < 4; ++nb) { const int col = 64 * hh + 16 * nb + fr; const float w0c = w0[col];
#pragma unroll
                for (int r = 0; r < 4; ++r) { const int t = t0 + 16 * (mb0 + mi) + 4 * fq + r; RWW[(size_t)t * 256 + col] = -0.6065306597126334f * sigm(acc[mi][nb][r] + w0c);     } }
#pragma unroll
        for (int mi = 0; mi < 2; ++mi)
#pragma unroll
            for (int nb = 0; nb < 4; ++nb) acc[mi][nb] = (f32x4){0.f, 0.f, 0.f, 0.f};
        rw_mm16<2>(acc, X2, 72, mb0, LORA + LO_A2, hh, lane_);
        const float* a0 = INF(16) + l * 256; const float* kkw = INF(19) + l * 256; const float* kaw = INF(20) + l * 256;
#pragma unroll
        for (int mi = 0; mi < 2; ++mi) {
            float kr[4][4], kq[4][4], ssq[4] = {0.f, 0.f, 0.f, 0.f};
#pragma unroll
            for (int nb = 0; nb < 4; ++nb) { const int col = 64 * hh + 16 * nb + fr; const float kkc = kkw[col];
#pragma unroll
                for (int r = 0; r < 4; ++r) { const int row = 16 * (mb0 + mi) + 4 * fq + r; kr[nb][r] = bf1(XK[row * 264 + col]); kq[nb][r] = kr[nb][r] * kkc; ssq[r] += kq[nb][r] * kq[nb][r]; } }
#pragma unroll
            for (int r = 0; r < 4; ++r) { ssq[r] = sum16(ssq[r]); ssq[r] = 1.0f / fmaxf(sqrtf(ssq[r]), 1e-12f); }
#pragma unroll
            for (int nb = 0; nb < 4; ++nb) { const int col = 64 * hh + 16 * nb + fr; const float a0c = a0[col], kac = kaw[col];
#pragma unroll
                for (int r = 0; r < 4; ++r) { const int t = t0 + 16 * (mb0 + mi) + 4 * fq + r; const float a = sigm(acc[mi][nb][r] + a0c); const float kk = kq[nb][r] * ssq[r];
                    const size_t o = (size_t)t * 256 + col; RWKK[o] = (bf16)f2bf(kk); RWB[o] = (bf16)f2bf(kk * a); RWK[o] = (bf16)f2bf(kr[nb][r] * (1.f + (a - 1.f) * kac)); } }
        }
#pragma unroll
        for (int mi = 0; mi < 2; ++mi)
#pragma unroll
            for (int nb = 0; nb < 4; ++nb) acc[mi][nb] = (f32x4){0.f, 0.f, 0.f, 0.f};
        rw_mm16<5>(acc, X3, 168, mb0, LORA + LO_G2, hh, lane_);
#pragma unroll
        for (int mi = 0; mi < 2; ++mi)
#pragma unroll
            for (int nb = 0; nb < 4; ++nb) { const int col = 64 * hh + 16 * nb + fr;
#pragma unroll
                for (int r = 0; r < 4; ++r) { const int t = t0 + 16 * (mb0 + mi) + 4 * fq + r; RWG[(size_t)t * 256 + col] = (bf16)f2bf(acc[mi][nb][r]); } }
    }
    if (l > 0) {
        const float* v0 = INF(24) + (l - 1) * 256; const bf16* v1T = LORA + LO_V1; const bf16* v2T = LORA + LO_V2;
        {
            const int mb = wave_ & 3, nb = wave_ >> 2; f32x4 a4 = (f32x4){0.f, 0.f, 0.f, 0.f}; bf16x8 bv[8];
#pragma unroll
            for (int ks = 0; ks < 8; ++ks) bv[ks] = *(const GAS bf16x8*)(v1T + (size_t)(16 * nb + fr) * 256 + 32 * ks + 8 * fq);
#pragma unroll
            for (int ks = 0; ks < 8; ++ks) a4 = __builtin_amdgcn_mfma_f32_16x16x32_bf16(*(const LAS bf16x8*)(XV + (16 * mb + fr) * 264 + 32 * ks + 8 * fq), bv[ks], a4, 0, 0, 0);
#pragma unroll
            for (int r = 0; r < 4; ++r) X5[(16 * mb + 4 * fq + r) * 40 + 16 * nb + fr] = (bf16)f2bf(a4[r]);
        }
        __syncthreads();
        {   f32x4 acc[2][4];
#pragma unroll
            for (int mi = 0; mi < 2; ++mi)
#pragma unroll
                for (int nb = 0; nb < 4; ++nb) acc[mi][nb] = (f32x4){0.f, 0.f, 0.f, 0.f};
            rw_mm16<1>(acc, X5, 40, mb0, v2T, hh, lane_);
#pragma unroll
            for (int mi = 0; mi < 2; ++mi)
#pragma unroll
                for (int nb = 0; nb < 4; ++nb) { const int col = 64 * hh + 16 * nb + fr; const float v0c = v0[col];
#pragma unroll
                    for (int r = 0; r < 4; ++r) { const int row = 16 * (mb0 + mi) + 4 * fq + r; const size_t o = (size_t)(t0 + row) * 256 + col;
                        const float xv = bf1(XV[row * 264 + col]); const float vf = bf1(VF[o]); RWV[o] = (bf16)f2bf(xv + (vf - xv) * sigm(acc[mi][nb][r] + v0c)); } }
        }
    }
    __syncthreads();
}
constexpr int CB = 64 * 66;
constexpr int HB_ = 64 * 72;
constexpr int PRE_H0 = 3 * CB * 4;
constexpr int PV_OFF = (PRE_H0 + 10 * HB_ * 2) / 4;
constexpr int REC_RW = 53760, REC_GL = 16640;
constexpr int RO_QH = 0, RO_AT = 8192, RO_BH = 16384, RO_TT = 24576, RO_MRB = 30720, RO_GAM = 36864, RO_VB = 37376;
constexpr int RO_Y = 0, RO_SK = 0;
constexpr int GO_QH = 0, GO_SK = 8192, GO_GAM = 16384;
#define PBUF(i) ((LAS float*)F.lds + (i) * CB)
#define HBUF(i) ((LAS bf16*)(F.lds + PRE_H0) + (i) * HB_)
__device__ __forceinline__ void nt16(f32x4 (&acc)[2], const LAS bf16* X, const LAS bf16* Y, int mb, int nb0, int lane) {
    const int fr = lane & 15, fq = lane >> 4;
    acc[0] = (f32x4){0.f, 0.f, 0.f, 0.f}; acc[1] = acc[0];
#pragma unroll
    for (int ks = 0; ks < 2; ++ks) { const bf16x8 a = *(const LAS bf16x8*)(X + (16 * mb + fr) * 72 + 32 * ks + 8 * fq);
        const bf16x8 b0 = *(const LAS bf16x8*)(Y + (16 * nb0 + fr) * 72 + 32 * ks + 8 * fq), b1 = *(const LAS bf16x8*)(Y + (16 * nb0 + 16 + fr) * 72 + 32 * ks + 8 * fq);
        acc[0] = __builtin_amdgcn_mfma_f32_16x16x32_bf16(a, b0, acc[0], 0, 0, 0); acc[1] = __builtin_amdgcn_mfma_f32_16x16x32_bf16(a, b1, acc[1], 0, 0, 0); }
}
typedef short v4i16_t __attribute__((ext_vector_type(4)));
__device__ __forceinline__ v2u trr(const LAS bf16* p) { return __builtin_bit_cast(v2u, __builtin_amdgcn_ds_read_tr16_b64_v4i16((LAS v4i16_t*)p)); }
__device__ __forceinline__ bf16x8 trfrag(const LAS bf16* M, int c, int ks, int lane) {
    const int g = lane >> 4, q = (lane & 15) >> 2, p = lane & 3; const LAS bf16* a = M + (32 * ks + 8 * g + q) * 72 + 16 * c + 4 * p;
    const v2u lo = trr(a), hi = trr(a + 4 * 72); v4u w; w.x = lo.x; w.y = lo.y; w.z = hi.x; w.w = hi.y; return __builtin_bit_cast(bf16x8, w);
}
__device__ __forceinline__ void tn16(f32x4 (&acc)[2], const LAS bf16* X, const LAS bf16* Y, int mb, int nb0, int lane) {
    acc[0] = (f32x4){0.f, 0.f, 0.f, 0.f}; acc[1] = acc[0];
#pragma unroll
    for (int ks = 0; ks < 2; ++ks) { const bf16x8 a = trfrag(X, mb, ks, lane), b0 = trfrag(Y, nb0, ks, lane), b1 = trfrag(Y, nb0 + 1, ks, lane);
        acc[0] = __builtin_amdgcn_mfma_f32_16x16x32_bf16(a, b0, acc[0], 0, 0, 0); acc[1] = __builtin_amdgcn_mfma_f32_16x16x32_bf16(a, b1, acc[1], 0, 0, 0); }
}
__device__ __forceinline__ void nn16(f32x4 (&acc)[2], const LAS bf16* A, const LAS bf16* B, int mb, int nb0, int lane) {
    const int fr = lane & 15, fq = lane >> 4;
    acc[0] = (f32x4){0.f, 0.f, 0.f, 0.f}; acc[1] = acc[0];
#pragma unroll
    for (int ks = 0; ks < 2; ++ks) { const bf16x8 a = *(const LAS bf16x8*)(A + (16 * mb + fr) * 72 + 32 * ks + 8 * fq), b0 = trfrag(B, nb0, ks, lane), b1 = trfrag(B, nb0 + 1, ks, lane);
        acc[0] = __builtin_amdgcn_mfma_f32_16x16x32_bf16(a, b0, acc[0], 0, 0, 0); acc[1] = __builtin_amdgcn_mfma_f32_16x16x32_bf16(a, b1, acc[1], 0, 0, 0); }
}
__device__ __forceinline__ void hfrag_tr(const LAS bf16* M, unsigned char* dst, int wave, int lane) {
    const int mb = wave >> 1, ks = wave & 1, g = lane >> 4, q = (lane & 15) >> 2, p = lane & 3; const LAS bf16* a = M + (32 * ks + 4 * g + q) * 72 + 16 * mb + 4 * p;
    const v2u lo = trr(a), hi = trr(a + 16 * 72); v4u w; w.x = lo.x; w.y = lo.y; w.z = hi.x; w.w = hi.y;
    *(GAS v4u*)(dst + ((size_t)wave * 64 + lane) * 16) = w;
}
template <int MASK> __device__ __forceinline__ void hst(const f32x4 (&acc)[2], LAS bf16* S, int mb, int nb0, int lane) {
    const int fr = lane & 15, fq = lane >> 4;
#pragma unroll
    for (int n = 0; n < 2; ++n)
#pragma unroll
        for (int r = 0; r < 4; ++r) { const int row = 16 * mb + 4 * fq + r, col = 16 * (nb0 + n) + fr; float v = acc[n][r];
            if (MASK == 1 && col > row) v = 0.f; if (MASK == 2 && col >= row) v = 0.f; S[row * 72 + col] = (bf16)f2bf(v); }
}
template <int MASK> __device__ __forceinline__ void cst(const f32x4 (&acc)[2], LAS float* S, int mb, int nb0, int lane) {
    const int fr = lane & 15, fq = lane >> 4;
#pragma unroll
    for (int n = 0; n < 2; ++n)
#pragma unroll
        for (int r = 0; r < 4; ++r) { const int row = 16 * mb + 4 * fq + r, col = 16 * (nb0 + n) + fr; float v = acc[n][r];
            if (MASK == 1 && col > row) v = 0.f; if (MASK == 2 && col >= row) v = 0.f; S[row * 66 + col] = v; }
}
__device__ __forceinline__ void hfrag(const LAS bf16* M, const LAS float* colscale, unsigned char* dst, int wave, int lane, int slot = -2) {
    const int mb = wave >> 1, ks = wave & 1, i = lane & 15, q = lane >> 4; const LAS bf16* rowp = M + (16 * mb + i) * 72 + 32 * ks + 4 * q;
    const v2u lo = *(const LAS v2u*)rowp, hi = *(const LAS v2u*)(rowp + 16);
    v4u w; w.x = lo.x; w.y = lo.y; w.z = hi.x; w.w = hi.y;
    if (colscale) { float e[8]; unpack8(w, e); const f32x4 s0 = *(const LAS f32x4*)(colscale + 32 * ks + 4 * q), s1 = *(const LAS f32x4*)(colscale + 32 * ks + 16 + 4 * q);
        e[0] *= s0.x; e[1] *= s0.y; e[2] *= s0.z; e[3] *= s0.w; e[4] *= s1.x; e[5] *= s1.y; e[6] *= s1.z; e[7] *= s1.w; w = pack8(e); }
    if (slot == -2) slot = wave; if (slot >= 0) *(GAS v4u*)(dst + ((size_t)slot * 64 + lane) * 16) = w;
}
__device__ __forceinline__ void cfrag(const LAS float* M, unsigned char* dst, int wave, int lane, int slot) {
    const int mb = wave >> 1, ks = wave & 1, i = lane & 15, q = lane >> 4; float e[8];
#pragma unroll
    for (int jj = 0; jj < 8; ++jj) { const int rho = 32 * ks + (jj < 4 ? 4 * q + jj : 16 + 4 * q + jj - 4); e[jj] = M[(16 * mb + i) * 66 + rho]; }
    if (slot >= 0) *(GAS v4u*)(dst + ((size_t)slot * 64 + lane) * 16) = pack8(e);
}
__device__ __forceinline__ void cacc(const f32x4 (&acc)[2], const LAS float* rowscale, unsigned char* dst, int mb, int nb0, int lane, int vbs = 2048) {
    const int fq = lane >> 4;
#pragma unroll
    for (int n = 0; n < 2; ++n) { float v[4];
#pragma unroll
        for (int r = 0; r < 4; ++r) { v[r] = acc[n][r]; if (rowscale) v[r] *= rowscale[16 * mb + 4 * fq + r]; }
        v2u w; w.x = pk2(v[0], v[1]); w.y = pk2(v[2], v[3]); *(GAS v2u*)(dst + (size_t)(nb0 + n) * vbs + ((size_t)mb * 64 + lane) * 8) = w; }
}
__device__ __forceinline__ void ccumsum(Frame& F, LAS float* CU) {
    LAS float* vec = (LAS float*)F.lds + PV_OFF; LAS float* seg = vec + 128;
    { float run = 0.f;
#pragma unroll
      for (int i = 0; i < 8; ++i) { run += CU[(8 * F.wave + i) * 66 + F.lane]; CU[(8 * F.wave + i) * 66 + F.lane] = run; }
      seg[F.wave * 64 + F.lane] = run; }
    LDS_BARRIER();
    { float off = 0.f;
#pragma unroll
      for (int w = 0; w < 8; ++w) if (w < F.wave) off += seg[w * 64 + F.lane];
#pragma unroll
      for (int i = 0; i < 8; ++i) { const float c = CU[(8 * F.wave + i) * 66 + F.lane] + off; CU[(8 * F.wave + i) * 66 + F.lane] = c; if (8 * F.wave + i == 31) vec[F.lane] = c; if (8 * F.wave + i == 63) vec[64 + F.lane] = c; } }
    LDS_BARRIER();
}
__device__ __forceinline__ f32x4 blk16(f32x4 acc, const LAS float* A, int ar0, int ac0, const LAS float* B, int br0, int bc0, int lane) {
    const int fr = lane & 15, fq = lane >> 4;
#pragma unroll
    for (int s = 0; s < 4; ++s) acc = __builtin_amdgcn_mfma_f32_16x16x4f32(A[(ar0 + fr) * 66 + ac0 + 4 * s + fq], B[(br0 + 4 * s + fq) * 66 + bc0 + fr], acc, 0, 0, 0);
    return acc;
}
__device__ __forceinline__ void blkst(const f32x4 acc, LAS float* S, int r0, int c0, int lane) {
    const int fr = lane & 15, fq = lane >> 4;
#pragma unroll
    for (int r = 0; r < 4; ++r) S[(r0 + 4 * fq + r) * 66 + c0 + fr] = acc[r];
}
__device__ __forceinline__ void tri_inverse(Frame& F, const LAS float* L, LAS float* T, LAS float* W) {
    for (int e = F.tid; e < 64 * 64; e += NWAVES * 64) { const int i = e >> 6, j = e & 63; if ((i >> 4) != (j >> 4)) T[i * 66 + j] = 0.f; }
    if (F.wave == 0) {
        const int d0 = 16 * (F.lane >> 4), c = F.lane & 15; float t[16];
#pragma unroll
        for (int i = 0; i < 16; ++i) { float a = (i == c) ? 1.f : 0.f;
#pragma unroll
            for (int j = 0; j < i; ++j) a += L[(d0 + i) * 66 + d0 + j] * t[j];
            t[i] = a; T[(d0 + i) * 66 + d0 + c] = a; }
    }
    LDS_BARRIER();
#pragma unroll
    for (int d = 1; d <= 3; ++d) {
        if (F.wave < 4 - d) { const int i = d + F.wave, j = F.wave; f32x4 acc = (f32x4){0.f, 0.f, 0.f, 0.f};
#pragma unroll
            for (int k = 0; k < 3; ++k) if (k >= j && k < i) acc = blk16(acc, L, 16 * i, 16 * k, T, 16 * k, 16 * j, F.lane);
            blkst(acc, W, 16 * i, 16 * j, F.lane); }
        LDS_BARRIER();
        if (F.wave < 4 - d) { const int i = d + F.wave, j = F.wave; f32x4 acc = (f32x4){0.f, 0.f, 0.f, 0.f};
            acc = blk16(acc, T, 16 * i, 16 * i, W, 16 * i, 16 * j, F.lane); blkst(acc, T, 16 * i, 16 * j, F.lane); }
        LDS_BARRIER();
    }
}
struct PreRaw { unsigned x[6][8]; f32x2_t cs[8]; };
__device__ __forceinline__ unsigned ldh(const bf16* p) { return (unsigned)*(const GAS bf16*)p; }
#define WSQ(T, off) ((T*)(ws_ + (off)))
__device__ __forceinline__ void pre_load(Frame& F, PreRaw& R, const int MIX, int b, int h, int c) {
    int tid_ = F.tid; asm volatile("" : "+v"(tid_));
    unsigned char* ws_ = F.ws; asm volatile("" : "+s"(ws_));
    const int k = tid_ & 63, w = tid_ >> 6, t0 = b * SEQ + c * 64 + 8 * w;
    const bf16* P = WSQ(const bf16, WS_P) + (size_t)t0 * NP;
#pragma unroll
    for (int s = 0; s < 6; ++s)
#pragma unroll
        for (int i = 0; i < 8; ++i) R.x[s][i] = 0u;
    if (MIX == 0) {
#pragma unroll
        for (int i = 0; i < 8; ++i) { R.x[0][i] = ldh(P + (size_t)i * NP + HG_F + 64 * h + k); R.x[1][i] = ldh(P + (size_t)i * NP + HG_Q + 64 * h + k); R.x[2][i] = ldh(P + (size_t)i * NP + HG_I + 64 * h + k); }
    } else if (MIX == 1) {
#pragma unroll
        for (int i = 0; i < 8; ++i) { R.x[2][i] = ldh(P + (size_t)i * NP + GL_V + 64 * h + k);
            if (k < 32) { R.x[0][i] = ldh(P + (size_t)i * NP + GL_GX + 32 * h + k); R.x[1][i] = ldh(P + (size_t)i * NP + GL_Q + 32 * h + k); R.x[3][i] = ldh(P + (size_t)i * NP + GL_K + 32 * h + k); } }
    } else if (MIX == 2) { const size_t o = (size_t)t0 * 256 + 64 * h + k;
#pragma unroll
        for (int i = 0; i < 8; ++i) { R.x[0][i] = __float_as_uint(*(const GAS float*)(WSQ(const float, WS_RWW) + o + i * 256)); R.x[1][i] = ldh(WSQ(const bf16, WS_RWR) + o + i * 256); R.x[2][i] = ldh(WSQ(const bf16, WS_RWV) + o + i * 256);
            R.x[3][i] = ldh(WSQ(const bf16, WS_RWK) + o + i * 256); R.x[4][i] = ldh(WSQ(const bf16, WS_RWKK) + o + i * 256); R.x[5][i] = ldh(WSQ(const bf16, WS_RWB) + o + i * 256); }
    } else { const int k31 = k & 31; const f32x2_t* CS = WSQ(const f32x2_t, WS_CS) + (size_t)t0 * 32 + k31;
#pragma unroll
        for (int i = 0; i < 8; ++i) { R.x[0][i] = ldh(P + (size_t)i * NP + RT_Q + 64 * h + k31); R.x[1][i] = ldh(P + (size_t)i * NP + RT_Q + 64 * h + 32 + k31); R.x[2][i] = ldh(P + (size_t)i * NP + RT_V + 64 * h + k);
            R.x[3][i] = ldh(P + (size_t)i * NP + RT_K + 64 * h + k31); R.x[4][i] = ldh(P + (size_t)i * NP + RT_K + 64 * h + 32 + k31); R.cs[i] = *(const GAS f32x2_t*)(CS + i * 32); }
    }
}
__device__ __forceinline__ float ubf(unsigned u) { return __uint_as_float(u << 16); }
__device__ __forceinline__ v4u pack8v(const float (&f)[8]) { v4u w; w.x = pk2(f[0], f[1]); w.y = pk2(f[2], f[3]); w.z = pk2(f[4], f[5]); w.w = pk2(f[6], f[7]); return w; }
__device__ __forceinline__ void hfrag_trs(const LAS bf16* M, const LAS float* scale, unsigned char* dst, int wave, int lane) {
    const int mb = wave >> 1, ks = wave & 1, g = lane >> 4, q = (lane & 15) >> 2, p = lane & 3; const LAS bf16* a = M + (32 * ks + 4 * g + q) * 72 + 16 * mb + 4 * p;
    const v2u lo = trr(a), hi = trr(a + 16 * 72); v4u w; w.x = lo.x; w.y = lo.y; w.z = hi.x; w.w = hi.y;
    float e[8]; unpack8(w, e); const f32x4 s0 = *(const LAS f32x4*)(scale + 32 * ks + 4 * g), s1 = *(const LAS f32x4*)(scale + 32 * ks + 16 + 4 * g);
    e[0] *= s0.x; e[1] *= s0.y; e[2] *= s0.z; e[3] *= s0.w; e[4] *= s1.x; e[5] *= s1.y; e[6] *= s1.z; e[7] *= s1.w;
    *(GAS v4u*)(dst + ((size_t)wave * 64 + lane) * 16) = pack8(e);
}
__device__ __forceinline__ void chunk_pre(Frame& F, PreRaw& R, int l, const int MIX, int b, int h, int c, unsigned char* rec, const int nMIX, int nh) {
    const int t0 = b * SEQ + c * 64;
    LAS float* SEG = PBUF(0); LAS float* LL = PBUF(1); LAS float* T32 = PBUF(2); LAS float* WW = PBUF(0);
    LAS bf16* A1 = HBUF(0); LAS bf16* R1 = HBUF(1); LAS bf16* B1 = HBUF(2); LAS bf16* K1 = HBUF(3); LAS bf16* KeT = HBUF(4); LAS bf16* VT = HBUF(5); LAS bf16* BeT = HBUF(6); LAS bf16* M1 = HBUF(7); LAS bf16* M2 = HBUF(8); LAS bf16* M3 = HBUF(9);
    LAS float* vec = (LAS float*)F.lds + PV_OFF; LAS float* ecm = vec + 640;
    int tid_ = F.tid; asm volatile("" : "+v"(tid_));
    unsigned char* ws_ = F.ws; asm volatile("" : "+s"(ws_));
    const int lane_ = tid_ & 63, wave_ = __builtin_amdgcn_readfirstlane(tid_ >> 6);
    const int k_ = lane_;
    const int mb = wave_ >> 1, nb0 = 2 * (wave_ & 1), fr = lane_ & 15, fq = lane_ >> 4;
    float q[8], kx[8], lw[8], v[8], av[8], bv[8];
    if (MIX == 0) {
        const float* lg = INF(8); const int cch = 64 * h + k_;
        const float x0 = lg[cch], x1 = lg[256 + cch], x2 = lg[512 + cch], x3 = lg[768 + cch]; const float mx = fmaxf(fmaxf(x0, x1), fmaxf(x2, x3));
        const float e0 = __expf(x0 - mx), e1 = __expf(x1 - mx), e2 = __expf(x2 - mx), e3 = __expf(x3 - mx);
        const float lb = ((l >= 1 ? e1 : 0.f) + (l >= 2 ? e2 : 0.f) + (l >= 3 ? e3 : 0.f)) / (e0 + e1 + e2 + e3);
#pragma unroll
        for (int i = 0; i < 8; ++i) { const float fr_ = ubf(R.x[0][i]), qr = ubf(R.x[1][i]); const float w = lb + (1.f - lb) * sigm(fr_); lw[i] = __logf(w); kx[i] = 1.f - w; q[i] = qr * sigm(qr); v[i] = ubf(R.x[2][i]); }
    } else if (MIX == 1) {
        const float gb = (k_ < 32) ? (INF(11) + l * 128)[32 * h + k_] : 0.f;
#pragma unroll
        for (int i = 0; i < 8; ++i) { v[i] = ubf(R.x[2][i]);
            if (k_ < 32) { const float x = ubf(R.x[0][i]) + gb; lw[i] = 0.0625f * (fminf(x, 0.f) - __logf(1.f + __expf(-fabsf(x)))); q[i] = ubf(R.x[1][i]) * 0.17677669529663687f; kx[i] = ubf(R.x[3][i]); }
            else { lw[i] = 0.f; q[i] = 0.f; kx[i] = 0.f; } }
    } else if (MIX == 2) {
#pragma unroll
        for (int i = 0; i < 8; ++i) { lw[i] = __uint_as_float(R.x[0][i]); q[i] = ubf(R.x[1][i]); v[i] = ubf(R.x[2][i]); kx[i] = ubf(R.x[3][i]); av[i] = -ubf(R.x[4][i]); bv[i] = ubf(R.x[5][i]); }
    } else {
        const bool hi = k_ >= 32; const float lgam = __logf(1.f - exp2f(-5.f - (float)h));
#pragma unroll
        for (int i = 0; i < 8; ++i) { const float cs_ = R.cs[i].x, sn = R.cs[i].y; const float q1 = ubf(R.x[0][i]), q2 = ubf(R.x[1][i]), k1 = ubf(R.x[3][i]), k2 = ubf(R.x[4][i]);
            q[i] = hi ? (q1 * sn + q2 * cs_) : (q1 * cs_ - q2 * sn); kx[i] = 0.125f * (hi ? (k1 * sn + k2 * cs_) : (k1 * cs_ - k2 * sn)); lw[i] = lgam; v[i] = ubf(R.x[2][i]); }
    }
    float cu[8]; { float run = 0.f;
#pragma unroll
        for (int i = 0; i < 8; ++i) { run += lw[i]; cu[i] = run; }
        SEG[wave_ * 64 + k_] = run; }
    LDS_BARRIER();
    float cm, ce; { float pre = 0.f, tot = 0.f, mid = 0.f;
#pragma unroll
        for (int w = 0; w < 8; ++w) { const float s = SEG[w * 64 + k_]; if (w < wave_) pre += s; if (w < 4) mid += s; tot += s; }
        cm = mid; ce = tot;
#pragma unroll
        for (int i = 0; i < 8; ++i) cu[i] += pre; }
    {   float e1[8], e2[8], e3[8];
#pragma unroll
        for (int i = 0; i < 8; ++i) { const float ef = __expf(fminf(fmaxf(cu[i] - cm, -80.f), 80.f)); e1[i] = q[i] * ef; e2[i] = kx[i] * __builtin_amdgcn_rcpf(ef); e3[i] = kx[i] * __expf(ce - cu[i]); }
        *(LAS v4u*)(R1 + k_ * 72 + 8 * wave_) = pack8v(e1); *(LAS v4u*)(K1 + k_ * 72 + 8 * wave_) = pack8v(e2); *(LAS v4u*)(KeT + k_ * 72 + 8 * wave_) = pack8v(e3); *(LAS v4u*)(VT + k_ * 72 + 8 * wave_) = pack8v(v);
        if (MIX == 2) {
#pragma unroll
            for (int i = 0; i < 8; ++i) { const float ef = __expf(fminf(fmaxf(cu[i] - cm, -80.f), 80.f)); e1[i] = av[i] * __expf(fminf(fmaxf(cu[i] - lw[i] - cm, -80.f), 80.f)); e2[i] = bv[i] * __builtin_amdgcn_rcpf(ef); e3[i] = bv[i] * __expf(ce - cu[i]); }
            *(LAS v4u*)(A1 + k_ * 72 + 8 * wave_) = pack8v(e1); *(LAS v4u*)(B1 + k_ * 72 + 8 * wave_) = pack8v(e2); *(LAS v4u*)(BeT + k_ * 72 + 8 * wave_) = pack8v(e3); }
        if (wave_ == 0) { ecm[k_] = __expf(cm); *(GAS float*)(rec + (MIX == 2 ? RO_GAM : GO_GAM) + 4 * k_) = __expf(ce); }
    }
    LDS_BARRIER();
    if (nMIX >= 0) pre_load(F, R, nMIX, b, nh, c);
    f32x4 acc[2];
    tn16(acc, R1, K1, mb, nb0, lane_); hst<1>(acc, M1, mb, nb0, lane_);
    hfrag_trs(R1, ecm, rec + (MIX == 2 ? RO_QH : GO_QH), wave_, lane_);
    nt16(acc, KeT, VT, mb, nb0, lane_); if (MIX == 2) cacc(acc, nullptr, rec + RO_VB + 2048, mb, nb0, lane_, 4096); else cacc(acc, nullptr, rec + GO_SK, mb, nb0, lane_);
    if (MIX == 2) {
        tn16(acc, A1, B1, mb, nb0, lane_); cst<2>(acc, LL, mb, nb0, lane_);
        tn16(acc, R1, B1, mb, nb0, lane_); hst<1>(acc, M2, mb, nb0, lane_);
        tn16(acc, A1, K1, mb, nb0, lane_); hst<2>(acc, M3, mb, nb0, lane_);
        hfrag_trs(A1, ecm, rec + RO_AT, wave_, lane_);
        hfrag(BeT, nullptr, rec + RO_BH, wave_, lane_);
    }
    LDS_BARRIER();
    nt16(acc, M1, VT, mb, nb0, lane_);
#pragma unroll
    for (int n = 0; n < 2; ++n)
#pragma unroll
        for (int r = 0; r < 4; ++r) A1[(16 * mb + 4 * fq + r) * 72 + 16 * (nb0 + n) + fr] = (bf16)f2bf(acc[n][r]);
    if (MIX == 2) {
        nt16(acc, M3, VT, mb, nb0, lane_); cacc(acc, nullptr, rec + RO_VB, mb, nb0, lane_, 4096);
        const int t6 = ((wave_ & 1) == 1 && (wave_ >> 1) < 2) ? -1 : ((wave_ >> 1) < 2 ? (wave_ >> 1) : 2 + ((wave_ >> 1) - 2) * 2 + (wave_ & 1));
        hfrag(M2, nullptr, rec + RO_MRB, wave_, lane_, t6);
        tri_inverse(F, LL, T32, WW);
        cfrag(T32, rec + RO_TT, wave_, lane_, t6);
    }
    LDS_BARRIER();
}
constexpr size_t WS_REC_RW = 14 * MiB, WS_REC_GL = 412 * MiB;
__device__ __forceinline__ void oloc_flush(Frame& F, int m, int t0, int h) {
    const int t = F.tid >> 3, pc = F.tid & 7; const v4u w = *(const LAS v4u*)(HBUF(0) + t * 72 + 8 * pc);
    *(GAS v4u*)(WSP(bf16, WS_O) + (size_t)m * TOK * 256 + (size_t)(t0 + t) * 256 + 64 * h + 8 * pc) = w;
}
__device__ __forceinline__ unsigned char* pre_rec(Frame& F, int m, int b, int h, int c) {
    return (m == 2) ? F.ws + WS_REC_RW + (size_t)(((b * 4 + h) * 64) + c) * REC_RW : F.ws + WS_REC_GL + (size_t)((((m == 3 ? 2 : m) * 16 + b * 4 + h) * 64) + c) * REC_GL;
}
__device__ __forceinline__ void phase_chunkpre(Frame& F, int l) {
    for (int tile = F.vcu; tile < TOK / 64; tile += F.G) {
        const int b = tile >> 6, c = tile & 63;
        rwprep_tile(F, l, tile);
        __syncthreads();
        PreRaw cur;
        pre_load(F, cur, 0, b, 0, c);
#pragma unroll 1
        for (int i = 0; i < 16; ++i) {
            const int mo = i >> 2, m = (mo == 2) ? 3 : (mo == 3 ? 2 : mo), h = i & 3;
            const int mo2 = (i + 1) >> 2, m2 = (i + 1 < 16) ? ((mo2 == 2) ? 3 : (mo2 == 3 ? 2 : mo2)) : -1;
            chunk_pre(F, cur, l, m, b, h, c, pre_rec(F, m, b, h, c), m2, (i + 1) & 3);
            oloc_flush(F, m, b * SEQ + c * 64, h);
        }
    }
}
__device__ __forceinline__ bf16x8 pack_b(const f32x4 a, const f32x4 b) { v4u w; w.x = pk2(a.x, a.y); w.y = pk2(a.z, a.w); w.z = pk2(b.x, b.y); w.w = pk2(b.z, b.w); return __builtin_bit_cast(bf16x8, w); }
__device__ __forceinline__ f32x4 unpk4(const v2u w) { return (f32x4){bflo(w.x), bfhi(w.x), bflo(w.y), bfhi(w.y)}; }
template <int NF> struct SeqRegs { v4u r[NF]; v4u tail; };
template <int NF, int NLT, bool TAIL> __device__ __forceinline__ void seq_ld(SeqRegs<NF>& R, const unsigned char* rec, int lt) {
    const GAS v4u* src = (const GAS v4u*)rec;
#pragma unroll
    for (int i = 0; i < NF; ++i) R.r[i] = src[i * NLT + lt];
    if (TAIL && lt < 16) R.tail = src[NF * NLT + lt];
}
template <int NF, int NLT, bool TAIL> __device__ __forceinline__ void seq_st(const SeqRegs<NF>& R, LAS unsigned char* slot, int lt) {
    LAS v4u* dst = (LAS v4u*)slot;
#pragma unroll
    for (int i = 0; i < NF; ++i) dst[i * NLT + lt] = R.r[i];
    if (TAIL && lt < 16) dst[NF * NLT + lt] = R.tail;
}
template <bool RW> __device__ __forceinline__ void seq_unit(Frame& F, int mix, int b, int h, int vb_, const unsigned char* recs) {
    constexpr int REC = RW ? REC_RW : REC_GL, SLOT = 61440, NCW = RW ? 1 : 4, LW0 = RW ? 2 : 4, NLT = (8 - LW0) * 64, NF = REC / (NLT * 16); constexpr bool TAIL = (REC % (NLT * 16)) != 0;
    static_assert(REC % (NLT * 16) == 0 || REC % (NLT * 16) == 256, "record = NF loader rounds (+ 256 B)");
    const bool loader = F.wave >= LW0, compute = F.wave < NCW; const int lt = F.tid - 64 * LW0;
    SeqRegs<NF> RA, RB;
    if (loader) { seq_ld<NF, NLT, TAIL>(RA, recs, lt); seq_st<NF, NLT, TAIL>(RA, F.lds, lt); seq_ld<NF, NLT, TAIL>(RB, recs + (size_t)1 * REC, lt); seq_ld<NF, NLT, TAIL>(RA, recs + (size_t)2 * REC, lt); }
    __syncthreads();
    f32x4 S[4];
#pragma unroll
    for (int kb = 0; kb < 4; ++kb) S[kb] = (f32x4){0.f, 0.f, 0.f, 0.f};
    const int vb = RW ? vb_ : (F.wave & 3), fr = F.lane & 15, fq = F.lane >> 4;
    bf16* Og_ = WSP(bf16, WS_OI) + OI_GEN + (size_t)(((mix == 3 ? 2 : mix) * 16 + b * 4 + h)) * (SEQ * 64);
    constexpr int OSO = 122880;
#define SEQ_FLUSH(cc) do { const LAS unsigned char* osr_ = F.lds + OSO + ((cc) & 1) * 8192 + (16 * vb + (F.lane >> 2)) * 128 + (F.lane & 3) * 32; bf16* dst_ = Og_ + ((size_t)(cc) * 64 + 16 * vb + (F.lane >> 2)) * 64 + (F.lane & 3) * 16; \
        const v4u a_ = *(const LAS v4u*)osr_, b_ = *(const LAS v4u*)(osr_ + 16); *(GAS v4u*)dst_ = a_; *(GAS v4u*)(dst_ + 8) = b_; } while (0)
#pragma unroll 1
    for (int c2 = 0; c2 < 64; c2 += 2) {
#pragma unroll
        for (int par = 0; par < 2; ++par) {
            const int c = c2 + par;
            if (loader) {
                if (par == 0) { seq_st<NF, NLT, TAIL>(RB, F.lds + SLOT, lt); if (c + 3 < 64) seq_ld<NF, NLT, TAIL>(RB, recs + (size_t)(c + 3) * REC, lt); }
                else { if (c + 1 < 64) seq_st<NF, NLT, TAIL>(RA, F.lds, lt); if (c + 3 < 64) seq_ld<NF, NLT, TAIL>(RA, recs + (size_t)(c + 3) * REC, lt); }
            } else if (compute) {
                const LAS unsigned char* R = F.lds + par * SLOT;
                const f32x4 z = (f32x4){0.f, 0.f, 0.f, 0.f};
                if (c > 0) SEQ_FLUSH(c - 1);
                bf16x8 fqh[8];
#pragma unroll
                for (int f = 0; f < 8; ++f) fqh[f] = *(const LAS bf16x8*)(R + (RW ? RO_QH : GO_QH) + (f * 64 + F.lane) * 16);
                bf16x8 bS[2]; bS[0] = pack_b(S[0], S[1]); bS[1] = pack_b(S[2], S[3]);
                asm volatile("s_waitcnt lgkmcnt(0)" ::: "memory"); __builtin_amdgcn_sched_barrier(0);
                f32x4 O[4]; bf16x8 bU[2];
#pragma unroll
                for (int mb = 0; mb < 4; ++mb) { O[mb] = z;
#pragma unroll
                    for (int ks = 0; ks < 2; ++ks) O[mb] = __builtin_amdgcn_mfma_f32_16x16x32_bf16(fqh[mb * 2 + ks], bS[ks], O[mb], 0, 0, 0); }
                if (RW) {
                    f32x4 X[4], U[4];
#pragma unroll
                    for (int mb = 0; mb < 4; ++mb) { X[mb] = unpk4(*(const LAS v2u*)(R + RO_Y + ((vb * 4 + mb) * 64 + F.lane) * 8));
#pragma unroll
                        for (int ks = 0; ks < 2; ++ks) X[mb] = __builtin_amdgcn_mfma_f32_16x16x32_bf16(*(const LAS bf16x8*)(R + RO_AT + ((mb * 2 + ks) * 64 + F.lane) * 16), bS[ks], X[mb], 0, 0, 0); }
                    bf16x8 bX[2]; bX[0] = pack_b(X[0], X[1]); bX[1] = pack_b(X[2], X[3]);
#pragma unroll
                    for (int mb = 0; mb < 4; ++mb) { U[mb] = z;
#pragma unroll
                        for (int ks = 0; ks < 2; ++ks) if (!(ks == 1 && mb < 2)) U[mb] = __builtin_amdgcn_mfma_f32_16x16x32_bf16(*(const LAS bf16x8*)(R + RO_TT + ((mb * 2 + ks) * 64 + F.lane) * 16), bX[ks], U[mb], 0, 0, 0); }
                    bU[0] = pack_b(U[0], U[1]); bU[1] = pack_b(U[2], U[3]);
#pragma unroll
                    for (int mb = 0; mb < 4; ++mb)
#pragma unroll
                        for (int ks = 0; ks < 2; ++ks) if (!(ks == 1 && mb < 2)) O[mb] = __builtin_amdgcn_mfma_f32_16x16x32_bf16(*(const LAS bf16x8*)(R + RO_MRB + ((mb * 2 + ks) * 64 + F.lane) * 16), bU[ks], O[mb], 0, 0, 0);
                }
#pragma unroll
                for (int kb = 0; kb < 4; ++kb) { const f32x4 g = *(const LAS f32x4*)(R + (RW ? RO_GAM : GO_GAM) + (16 * kb + 4 * fq) * 4); const f32x4 sk = unpk4(*(const LAS v2u*)(R + (RW ? RO_SK : GO_SK) + ((vb * 4 + kb) * 64 + F.lane) * 8));
                    f32x4 n = S[kb] * g + sk;
                    if (RW) {
#pragma unroll
                        for (int ks = 0; ks < 2; ++ks) n = __builtin_amdgcn_mfma_f32_16x16x32_bf16(*(const LAS bf16x8*)(R + RO_BH + ((kb * 2 + ks) * 64 + F.lane) * 16), bU[ks], n, 0, 0, 0);
                    }
                    S[kb] = n; }
#pragma unroll
                for (int mb = 0; mb < 4; ++mb)
#pragma unroll
                    for (int r = 0; r < 4; ++r) *(LAS bf16*)(F.lds + OSO + par * 8192 + (16 * mb + 4 * fq + r) * 128 + (16 * vb + fr) * 2) = (bf16)f2bf(O[mb][r]);
            }
            LDS_BARRIER();
        }
    }
    if (compute) SEQ_FLUSH(63);
#undef SEQ_FLUSH
    __syncthreads();
}
__device__ __forceinline__ int tri6(int mb, int ks) { return mb < 2 ? mb : 2 + (mb - 2) * 2 + ks; }
struct SeqRegs4 { v4u r[6]; v4u t; };
__device__ __forceinline__ void seq4_ld(SeqRegs4& R, const unsigned char* rec, int vb, int lt) {
    const GAS v4u* src = (const GAS v4u*)rec;
#pragma unroll
    for (int i = 0; i < 6; ++i) R.r[i] = src[i * 384 + lt];
    if (lt < 16) R.t = src[6 * 384 + lt];
    if (lt >= 128) R.t = *(const GAS v4u*)(rec + RO_VB + vb * 4096 + (lt - 128) * 16);
}
__device__ __forceinline__ void seq4_st(const SeqRegs4& R, LAS unsigned char* slot, int lt) {
    LAS v4u* dst = (LAS v4u*)slot;
#pragma unroll
    for (int i = 0; i < 6; ++i) dst[i * 384 + lt] = R.r[i];
    if (lt < 16) dst[6 * 384 + lt] = R.t;
    if (lt >= 128) *(LAS v4u*)(slot + 37120 + (lt - 128) * 16) = R.t;
}
__device__ __forceinline__ void seq_rw(Frame& F, int b, int h, int vb, const unsigned char* recs) {
    constexpr int REC = REC_RW, SLOT = 41216, EXO = 3 * SLOT;
    const bool loader = F.wave >= 2; const int lt = F.tid - 128;
    SeqRegs4 RA, RB;
    if (loader) { seq4_ld(RA, recs, vb, lt); seq4_st(RA, F.lds, lt); seq4_ld(RB, recs + (size_t)1 * REC, vb, lt); seq4_ld(RA, recs + (size_t)2 * REC, vb, lt); }
    __syncthreads();
    f32x4 S[4];
#pragma unroll
    for (int kb = 0; kb < 4; ++kb) S[kb] = (f32x4){0.f, 0.f, 0.f, 0.f};
    const int fr = F.lane & 15, fq = F.lane >> 4;
    bf16* Og_ = WSP(bf16, WS_OI) + (size_t)((b * 4 + h) * 4 + vb) * (SEQ * 16);
    LAS unsigned char* OS = F.lds + EXO + 8192;
#pragma unroll 1
    for (int c2 = 0; c2 < 66; c2 += 2) {
#pragma unroll
        for (int par = 0; par < 2; ++par) {
            const int c = c2 + par;
            if (loader) {
                if (c + 1 < 64) { LAS unsigned char* dst = F.lds + ((c + 1) % 3) * SLOT; if (par == 0) seq4_st(RB, dst, lt); else seq4_st(RA, dst, lt); }
                if (c + 3 < 64) { if (par == 0) seq4_ld(RB, recs + (size_t)(c + 3) * REC, vb, lt); else seq4_ld(RA, recs + (size_t)(c + 3) * REC, vb, lt); }
            } else if (F.wave == 0) {
                if (c < 64) {
                    const LAS unsigned char* R = F.lds + (c % 3) * SLOT; LAS unsigned char* EX = F.lds + EXO + par * 4096;
                    const f32x4 z = (f32x4){0.f, 0.f, 0.f, 0.f};
                    v2u yv[4]; bf16x8 fat[8], ftt[6];
#pragma unroll
                    for (int mb = 0; mb < 4; ++mb) yv[mb] = *(const LAS v2u*)(R + 37120 + (mb * 64 + F.lane) * 8);
#pragma unroll
                    for (int f = 0; f < 8; ++f) fat[f] = *(const LAS bf16x8*)(R + RO_AT + (f * 64 + F.lane) * 16);
                    bf16x8 bS[2]; bS[0] = pack_b(S[0], S[1]); bS[1] = pack_b(S[2], S[3]);
                    *(LAS bf16x8*)(EX + F.lane * 16) = bS[0]; *(LAS bf16x8*)(EX + 1024 + F.lane * 16) = bS[1];
                    asm volatile("s_waitcnt lgkmcnt(0)" ::: "memory"); __builtin_amdgcn_sched_barrier(0);
                    f32x4 X[4], U[4];
#pragma unroll
                    for (int mb = 0; mb < 4; ++mb) { X[mb] = unpk4(yv[mb]);
#pragma unroll
                        for (int ks = 0; ks < 2; ++ks) X[mb] = __builtin_amdgcn_mfma_f32_16x16x32_bf16(fat[mb * 2 + ks], bS[ks], X[mb], 0, 0, 0); }
                    __builtin_amdgcn_sched_barrier(0);
                    bf16x8 fbh[8]; f32x4 gm[4]; v2u skv[4];
#pragma unroll
                    for (int f = 0; f < 6; ++f) ftt[f] = *(const LAS bf16x8*)(R + RO_TT + (f * 64 + F.lane) * 16);
#pragma unroll
                    for (int f = 0; f < 8; ++f) fbh[f] = *(const LAS bf16x8*)(R + RO_BH + (f * 64 + F.lane) * 16);
#pragma unroll
                    for (int kb = 0; kb < 4; ++kb) { gm[kb] = *(const LAS f32x4*)(R + RO_GAM + (16 * kb + 4 * fq) * 4); skv[kb] = *(const LAS v2u*)(R + 37120 + 2048 + (kb * 64 + F.lane) * 8); }
                    __builtin_amdgcn_sched_barrier(0);
                    bf16x8 bX[2]; bX[0] = pack_b(X[0], X[1]); bX[1] = pack_b(X[2], X[3]);
#pragma unroll
                    for (int mb = 0; mb < 4; ++mb) { U[mb] = z;
#pragma unroll
                        for (int ks = 0; ks < 2; ++ks) if (!(ks == 1 && mb < 2)) U[mb] = __builtin_amdgcn_mfma_f32_16x16x32_bf16(ftt[tri6(mb, ks)], bX[ks], U[mb], 0, 0, 0); }
                    bf16x8 bU[2]; bU[0] = pack_b(U[0], U[1]); bU[1] = pack_b(U[2], U[3]);
                    *(LAS bf16x8*)(EX + 2048 + F.lane * 16) = bU[0]; *(LAS bf16x8*)(EX + 3072 + F.lane * 16) = bU[1];
                    asm volatile("s_waitcnt lgkmcnt(0)" ::: "memory"); __builtin_amdgcn_sched_barrier(0);
#pragma unroll
                    for (int kb = 0; kb < 4; ++kb) { f32x4 n = S[kb] * gm[kb] + unpk4(skv[kb]);
#pragma unroll
                        for (int ks = 0; ks < 2; ++ks) n = __builtin_amdgcn_mfma_f32_16x16x32_bf16(fbh[kb * 2 + ks], bU[ks], n, 0, 0, 0);
                        S[kb] = n; }
                }
            } else {
                if (c >= 1 && c <= 64) {
                    const int co = c - 1; const LAS unsigned char* R = F.lds + (co % 3) * SLOT; const LAS unsigned char* EX = F.lds + EXO + (par ^ 1) * 4096;
                    bf16x8 fq_[8], fm[6];
#pragma unroll
                    for (int f = 0; f < 8; ++f) fq_[f] = *(const LAS bf16x8*)(R + RO_QH + (f * 64 + F.lane) * 16);
#pragma unroll
                    for (int f = 0; f < 6; ++f) fm[f] = *(const LAS bf16x8*)(R + RO_MRB + (f * 64 + F.lane) * 16);
                    const bf16x8 bS0 = *(const LAS bf16x8*)(EX + F.lane * 16), bS1 = *(const LAS bf16x8*)(EX + 1024 + F.lane * 16), bU0 = *(const LAS bf16x8*)(EX + 2048 + F.lane * 16), bU1 = *(const LAS bf16x8*)(EX + 3072 + F.lane * 16);
                    asm volatile("s_waitcnt lgkmcnt(0)" ::: "memory"); __builtin_amdgcn_sched_barrier(0);
                    f32x4 O[4];
#pragma unroll
                    for (int mb = 0; mb < 4; ++mb) { O[mb] = (f32x4){0.f, 0.f, 0.f, 0.f};
                        O[mb] = __builtin_amdgcn_mfma_f32_16x16x32_bf16(fq_[mb * 2], bS0, O[mb], 0, 0, 0);
                        O[mb] = __builtin_amdgcn_mfma_f32_16x16x32_bf16(fq_[mb * 2 + 1], bS1, O[mb], 0, 0, 0);
                        O[mb] = __builtin_amdgcn_mfma_f32_16x16x32_bf16(fm[tri6(mb, 0)], bU0, O[mb], 0, 0, 0);
                        if (mb >= 2) O[mb] = __builtin_amdgcn_mfma_f32_16x16x32_bf16(fm[tri6(mb, 1)], bU1, O[mb], 0, 0, 0); }
#pragma unroll
                    for (int mb = 0; mb < 4; ++mb)
#pragma unroll
                        for (int r = 0; r < 4; ++r) *(LAS bf16*)(OS + (16 * mb + 4 * fq + r) * 32 + fr * 2) = (bf16)f2bf(O[mb][r]);
                    asm volatile("s_waitcnt lgkmcnt(0)" ::: "memory");
                    { const v4u a_ = *(const LAS v4u*)(OS + F.lane * 32), b_ = *(const LAS v4u*)(OS + F.lane * 32 + 16); bf16* dst_ = Og_ + ((size_t)co * 64 + F.lane) * 16; *(GAS v4u*)dst_ = a_; *(GAS v4u*)(dst_ + 8) = b_; }
                    asm volatile("s_waitcnt lgkmcnt(0)" ::: "memory");
                }
            }
            LDS_BARRIER();
        }
    }
    __syncthreads();
}
__device__ __forceinline__ void phase_seq(Frame& F, int l) {
    for (int u = blockIdx.x; u < 112; u += F.G) {
        if (u < 64) { const int bh = u >> 2, vb = u & 3; seq_rw(F, bh >> 2, bh & 3, vb, F.ws + WS_REC_RW + (size_t)(bh * 64) * REC_RW); }
        else { const int v = u - 64, mm = v % 3, bh = v / 3; seq_unit<false>(F, mm == 2 ? 3 : mm, bh >> 2, bh & 3, 0, F.ws + WS_REC_GL + (size_t)((mm * 16 + bh) * 64) * REC_GL); }
    }
}
struct PostRaw { v4u o0, o1; v4u y0, y1; v4u x0, x1, x2, x3, x4, x5, x6, x7; };
__device__ __forceinline__ void post_load(Frame& F, PostRaw& R, int t, int m, int c0) {
    const bf16* P = WSP(const bf16, WS_P);
    const bf16* Ob = WSP(const bf16, WS_O) + (size_t)m * TOK * 256 + (size_t)t * 256 + c0;
    R.o0 = *(const GAS v4u*)(Ob); R.o1 = *(const GAS v4u*)(Ob + 8);
    { const int bb = t >> 12, tb = t & (SEQ - 1), hh = c0 >> 6, qq = (c0 >> 4) & 3; const bf16* oi = WSP(const bf16, WS_OI) + (m == 2 ? ((size_t)((bb * 4 + hh) * 4 + qq) * SEQ + tb) * 16 : OI_GEN + ((size_t)(((m == 3 ? 2 : m) * 16 + bb * 4 + hh)) * SEQ + tb) * 64 + 16 * qq);
      R.y0 = *(const GAS v4u*)oi; R.y1 = *(const GAS v4u*)(oi + 8); }
    const v4u zz = (v4u){0u, 0u, 0u, 0u}; R.x2 = zz; R.x3 = zz; R.x4 = zz; R.x5 = zz; R.x6 = zz; R.x7 = zz;
    if (m != 2) { const int gc = (m == 0 ? HG_G : m == 1 ? GL_R : RT_G) + c0; R.x0 = *(const GAS v4u*)(P + (size_t)t * NP + gc); R.x1 = *(const GAS v4u*)(P + (size_t)t * NP + gc + 8); }
    else { const size_t ob = (size_t)t * 256 + c0;
        R.x0 = *(const GAS v4u*)(WSP(const bf16, WS_RWR) + ob); R.x1 = *(const GAS v4u*)(WSP(const bf16, WS_RWR) + ob + 8); R.x2 = *(const GAS v4u*)(WSP(const bf16, WS_RWK) + ob); R.x3 = *(const GAS v4u*)(WSP(const bf16, WS_RWK) + ob + 8);
        R.x4 = *(const GAS v4u*)(WSP(const bf16, WS_RWV) + ob); R.x5 = *(const GAS v4u*)(WSP(const bf16, WS_RWV) + ob + 8); R.x6 = *(const GAS v4u*)(WSP(const bf16, WS_RWG) + ob); R.x7 = *(const GAS v4u*)(WSP(const bf16, WS_RWG) + ob + 8); }
}
__device__ __forceinline__ void unpack16(const v4u a, const v4u b, float (&f)[16]) { float x[8], y[8]; unpack8(a, x); unpack8(b, y);
#pragma unroll
    for (int j = 0; j < 8; ++j) { f[j] = x[j]; f[8 + j] = y[j]; } }
__device__ __forceinline__ void phase_post(Frame& F, int l) {
    const int gw = F.vcu * NWAVES + F.wave, NGW = F.G * NWAVES;
    const int m = F.lane >> 4, h = (F.lane >> 2) & 3, qd = F.lane & 3; const int c0 = 64 * h + 16 * qd;
    bf16* Y = WSP(bf16, WS_Y);
    PostRaw cur, nxt;
    if (gw < TOK) post_load(F, cur, gw, m, c0);
    for (int t = gw; t < TOK; t += NGW) {
        if (t + NGW < TOK) post_load(F, nxt, t + NGW, m, c0);
        float o[16], oi[16];
        unpack16(cur.o0, cur.o1, o);
        unpack16(cur.y0, cur.y1, oi);
        float s1 = 0.f, s2 = 0.f;
#pragma unroll
        for (int j = 0; j < 16; ++j) { o[j] += oi[j]; s1 += o[j]; s2 += o[j] * o[j]; }
        s1 = sum4(s1); s2 = sum4(s2);
        float y[16];
        if (m < 2) {
            const float rs = rsqrtf(s2 * (1.f / 64.f) + 1e-6f); const float* ng = INF(m == 0 ? 9 : 12) + l * 64 + 16 * qd;
            float g[16]; unpack16(cur.x0, cur.x1, g);
#pragma unroll
            for (int j = 0; j < 16; ++j) y[j] = o[j] * rs * ng[j] * (g[j] * sigm(g[j]));
        } else if (m == 2) {
            const float mean = s1 * (1.f / 64.f); float var = s2 * (1.f / 64.f) - mean * mean; var = fmaxf(var, 0.f); const float rs = rsqrtf(var + 64e-5f);
            float r[16], k[16], v[16], g[16]; unpack16(cur.x0, cur.x1, r); unpack16(cur.x2, cur.x3, k); unpack16(cur.x4, cur.x5, v); unpack16(cur.x6, cur.x7, g);
            const float* rk = INF(21) + l * 256 + c0; const float* lg = INF(22) + l * 256 + c0; const float* lb = INF(23) + l * 256 + c0;
            float bon = 0.f;
#pragma unroll
            for (int j = 0; j < 16; ++j) bon += r[j] * k[j] * rk[j];
            bon = sum4(bon);
#pragma unroll
            for (int j = 0; j < 16; ++j) y[j] = ((o[j] - mean) * rs * lg[j] + lb[j] + bon * v[j]) * g[j];
        } else {
            const float mean = s1 * (1.f / 64.f); float var = s2 * (1.f / 64.f) - mean * mean; var = fmaxf(var, 0.f); const float rs = rsqrtf(var + 1e-5f);
            float g[16]; unpack16(cur.x0, cur.x1, g);
#pragma unroll
            for (int j = 0; j < 16; ++j) y[j] = (g[j] * sigm(g[j])) * ((o[j] - mean) * rs);
        }
        v4u w0, w1; w0.x = pk2(y[0], y[1]); w0.y = pk2(y[2], y[3]); w0.z = pk2(y[4], y[5]); w0.w = pk2(y[6], y[7]); w1.x = pk2(y[8], y[9]); w1.y = pk2(y[10], y[11]); w1.z = pk2(y[12], y[13]); w1.w = pk2(y[14], y[15]);
        GAS v4u* yo = (GAS v4u*)(Y + (size_t)t * D + 256 * m + c0); yo[0] = w0; yo[1] = w1;
        cur = nxt;
    }
}
template <int MODE> struct LnRaw { v2u h[4]; v2u d1[4], d2[4]; float g1, g2; };
template <int MODE> __device__ __forceinline__ void ln_load(Frame& F, LnRaw<MODE>& R, int m) {
    const GAS v2u* hr = (const GAS v2u*)(WSP(const bf16, WS_HB) + (size_t)m * D) + F.lane;
#pragma unroll
    for (int j = 0; j < 4; ++j) R.h[j] = hr[64 * j];
    if (MODE == 0) { const GAS v2u* ar = (const GAS v2u*)(WSP(const bf16, WS_MIX) + (size_t)m * D) + F.lane;
#pragma unroll
        for (int j = 0; j < 4; ++j) R.d1[j] = ar[64 * j]; }
    else { const bf16* DOUT = WSP(const bf16, WS_DOUT); const float* GATE = WSP(const float, WS_GATE); R.g1 = GATE[2 * m]; R.g2 = GATE[2 * m + 1];
#pragma unroll
        for (int j = 0; j < 4; ++j) { R.d1[j] = ((const GAS v2u*)(DOUT + (size_t)(2 * m) * D))[F.lane + 64 * j]; R.d2[j] = ((const GAS v2u*)(DOUT + (size_t)(2 * m + 1) * D))[F.lane + 64 * j]; } }
}
template <int MODE, bool ROUTE, bool Q8 = false> __device__ __forceinline__ void phase_ln(Frame& F, const float* gw_, const float* bw_, const float* router, int mi, const bool final_out = false) {
    const int gw = F.vcu * NWAVES + F.wave, NGW = F.G * NWAVES;
    bf16* hb = WSP(bf16, WS_HB); float* GATE = WSP(float, WS_GATE);
    LAS float* RT = (LAS float*)F.lds;
    if (ROUTE) { for (int i = F.tid; i < D * NE; i += NWAVES * 64) RT[(i & 7) * D + (i >> 3)] = router[i]; __syncthreads(); }
    f32x4 gv[4], bv[4];
#pragma unroll
    for (int j = 0; j < 4; ++j) { gv[j] = ((const GAS f32x4*)gw_)[F.lane + 64 * j]; bv[j] = ((const GAS f32x4*)bw_)[F.lane + 64 * j]; }
    LnRaw<MODE> cur, nxt;
    if (gw < TOK) ln_load<MODE>(F, cur, gw);
    for (int m = gw; m < TOK; m += NGW) {
        if (m + NGW < TOK) ln_load<MODE>(F, nxt, m + NGW);
        GAS f32x4* hr = (GAS f32x4*)(F.h + (size_t)m * D) + F.lane;
        f32x4 v[4]; float s = 0.f;
#pragma unroll
        for (int j = 0; j < 4; ++j) {
            f32x4 a;
            if (MODE == 0) { const v2u d1 = cur.d1[j]; a = (f32x4){bflo(d1.x), bfhi(d1.x), bflo(d1.y), bfhi(d1.y)}; }
            else { const v2u d1 = cur.d1[j], d2 = cur.d2[j]; const float g1 = cur.g1, g2 = cur.g2;
                a.x = g1 * bflo(d1.x) + g2 * bflo(d2.x); a.y = g1 * bfhi(d1.x) + g2 * bfhi(d2.x); a.z = g1 * bflo(d1.y) + g2 * bflo(d2.y); a.w = g1 * bfhi(d1.y) + g2 * bfhi(d2.y); }
            const v2u hq = cur.h[j]; const f32x4 hv = (f32x4){bflo(hq.x), bfhi(hq.x), bflo(hq.y), bfhi(hq.y)};
            v[j] = hv * DN_ALPHA + a; s += (v[j].x + v[j].y) + (v[j].z + v[j].w); }
        const float mean = wave_sum(s) * (1.f / D); float s2 = 0.f;
#pragma unroll
        for (int j = 0; j < 4; ++j) { v[j] = v[j] - mean; s2 += (v[j].x * v[j].x + v[j].y * v[j].y) + (v[j].z * v[j].z + v[j].w * v[j].w); }
        const float rstd = 1.f / sqrtf(wave_sum(s2) * (1.f / D) + 1e-5f);
        GAS v2u* o8 = (GAS v2u*)(hb + (size_t)m * D) + F.lane;
#pragma unroll
        for (int j = 0; j < 4; ++j) { v[j] = v[j] * rstd * gv[j] + bv[j]; if (final_out) hr[64 * j] = v[j]; v2u w; w.x = pk2(v[j].x, v[j].y); w.y = pk2(v[j].z, v[j].w); o8[64 * j] = w; }
        if (Q8) { float am = 0.f;
#pragma unroll
            for (int j = 0; j < 4; ++j) { const f32x4 a = __builtin_elementwise_abs(v[j]); am = fmaxf(am, fmaxf(fmaxf(a.x, a.y), fmaxf(a.z, a.w))); }
            am = wave_max(am); const float inv = am > 0.f ? 127.f / am : 0.f;
            GAS unsigned* q8 = (GAS unsigned*)(WSP(unsigned char, WS_H8) + (size_t)m * D) + F.lane;
#pragma unroll
            for (int j = 0; j < 4; ++j) q8[64 * j] = pack_i8(v[j].x * inv, v[j].y * inv, v[j].z * inv, v[j].w * inv);
            if (F.lane == 0) WSP(float, WS_RS)[m] = am * (1.f / 127.f); }
        if (ROUTE) {
            float lg[8];
#pragma unroll
            for (int e = 0; e < 8; ++e) { float a = 0.f;
#pragma unroll
                for (int j = 0; j < 4; ++j) { const f32x4 r = *(const LAS f32x4*)(RT + e * D + 4 * (F.lane + 64 * j)); a += (v[j].x * r.x + v[j].y * r.y) + (v[j].z * r.z + v[j].w * r.w); }
                lg[e] = wave_sum(a); }
            int e1 = 0; float l1 = lg[0];
#pragma unroll
            for (int e = 1; e < 8; ++e) if (lg[e] > l1) { l1 = lg[e]; e1 = e; }
            int e2 = -1; float l2 = -3.0e38f;
#pragma unroll
            for (int e = 0; e < 8; ++e) if (e != e1 && lg[e] > l2) { l2 = lg[e]; e2 = e; }
            if (F.lane == 0) {
                const float p2 = __expf(l2 - l1); const float ga = 1.f / (1.f + p2);
                GATE[2 * m] = ga; GATE[2 * m + 1] = p2 * ga;
                int* list = WSP(int, WS_LIST) + (size_t)mi * NE * TOK;
                const unsigned p1 = __hip_atomic_fetch_add((unsigned*)(F.ctl + CW_CNT + (mi * 8 + e1) * 64), 1u, RLX_AGENT); list[e1 * TOK + p1] = 2 * m;
                const unsigned q2 = __hip_atomic_fetch_add((unsigned*)(F.ctl + CW_CNT + (mi * 8 + e2) * 64), 1u, RLX_AGENT); list[e2 * TOK + q2] = 2 * m + 1;
            }
        }
        cur = nxt;
    }
}
__device__ __forceinline__ void phase_gather(Frame& F, int mi) {
    int cnt[8], poff[9]; poff[0] = 0;
    unsigned* cb_ = (unsigned*)(F.ctl + CW_CNT + mi * 8 * 64); asm volatile("" : "+s"(cb_));
#pragma unroll
    for (int e = 0; e < 8; ++e) { cnt[e] = (int)__hip_atomic_load(cb_ + e * 64, RLX_AGENT); poff[e + 1] = poff[e] + ((cnt[e] + 255) >> 8); }
    const int npan = poff[8];
    int* tab = WSP(int, WS_TAB) + mi * TAB_STRIDE;
    if (blockIdx.x == 0) {
        for (int P = F.tid; P < npan; P += NWAVES * 64) { int e = 0, pe = 0, ce = cnt[0];
#pragma unroll
            for (int j = 1; j < 8; ++j) if (P >= poff[j]) { e = j; pe = poff[j]; ce = cnt[j]; }
            tab[4 * P] = e; tab[4 * P + 1] = 256 * (P - pe); tab[4 * P + 2] = ce; tab[4 * P + 3] = 0; }
        if (F.tid == 0) tab[640] = npan;
    }
    const int gw = F.vcu * NWAVES + F.wave, NGW = F.G * NWAVES;
    const int* list = WSP(const int, WS_LIST) + (size_t)mi * NE * TOK; const bf16* hb = WSP(const bf16, WS_HB); bf16* HP = WSP(bf16, WS_HPERM);
    for (int row = gw; row < 256 * npan; row += NGW) { const int P = row >> 8; int e = 0, pe = 0, ce = cnt[0];
#pragma unroll
        for (int j = 1; j < 8; ++j) if (P >= poff[j]) { e = j; pe = poff[j]; ce = cnt[j]; }
        const int r = row - 256 * pe; const int tok = (r < ce) ? (list[e * TOK + r] >> 1) : 0;
        const GAS v4u* s = (const GAS v4u*)(hb + (size_t)tok * D) + F.lane; GAS v4u* d = (GAS v4u*)(HP + (size_t)row * D) + F.lane; d[0] = s[0]; d[64] = s[64]; }
}
struct Args { const void* in[36]; int ph_lo, ph_hi; };
__global__ void __launch_bounds__(NWAVES * 64, 2) mk_fwd(Args args) {
    extern __shared__ __attribute__((aligned(16))) unsigned char lds[];
    Frame F;
    F.lds = (LAS unsigned char*)lds;
    F.MISC = (volatile LAS unsigned*)(F.lds + MISC_OFF);
    F.tid = threadIdx.x; F.lane = F.tid & 63; F.wave = __builtin_amdgcn_readfirstlane(F.tid >> 6);
    const int wave_k = F.wave;
    F.G = gridDim.x; { const int bx = blockIdx.x; F.vcu = (F.G % 8 == 0) ? (bx % 8) * (F.G / 8) + bx / 8 : bx; }
    F.in = args.in; F.ws = (unsigned char*)ldptr(F.in, 35); F.h = (float*)ldptr(F.in, 34);
    F.ctl = (gu32*)(F.ws + WS_CTL);
    for (int u = F.tid; u < (LDS_BYTES - LDSCTL_OFF) / 4; u += NWAVES * 64) ((LAS unsigned*)(F.lds + LDSCTL_OFF))[u] = 0u;
    __syncthreads();
    XcdBarrier bar; bar.bar = (unsigned*)(F.ctl + CW_BAR); bar.x = 0; bar.st = nullptr; bar.wv = 0;
    if (!MK_PER_PHASE) bar = xcd_barrier_post((unsigned*)(F.ctl + CW_BAR), F.MISC + 8);
    const int lo = args.ph_lo, hi = args.ph_hi;
#define IN(k) (lo <= (k) && (k) < hi)
#define PHASE_BEGIN() do { int t_ = wave_k * 64 + lane_id_now(); asm volatile("" : "+v"(t_)); F.tid = t_; F.lane = t_ & 63; F.wave = wave_k; \
        F.ws = (unsigned char*)ldptr(F.in, 35); F.ctl = (gu32*)(F.ws + WS_CTL); F.h = (float*)ldptr(F.in, 34); } while (0)
#define SEAM(k) do { if (IN(k) && IN((k) + 1)) { xcd_barrier(bar); if (DUPMASK & 4096) xcd_barrier(bar); } } while (0)
    for (int l = 0; l < DEPTH; ++l) {
        const int pb = l * NPH; const bool moe = (l & 1); const int mi = l >> 1;
#define PH(k) (((PHMASK >> (k)) & 1) && IN(pb + (k)))
        if (l == 0) { if (PH(0)) { PHASE_BEGIN(); phase_weights<0>(F, 0); } SEAM(pb + 0); }
        if (PH(1)) for (int rep_ = 0; rep_ < ((((DUPMASK >> 1) & 1) && ((DUPL >> l) & 1)) ? 2 : 1); ++rep_) { PHASE_BEGIN(); if (rep_) __syncthreads();
            pg8::Gemm g{WSP(const bf16, WS_HB), WSP(const bf16, WS_WIN), TOK, NP, D}; pg8::StaticOrder S; S.init(TOK, NP, F.G, (int)blockIdx.x);
            pg8::EpiBf16 E{WSP(bf16, WS_P), NP};
            pg8::gemm_phase<pg8::EpiBf16, pg8::StaticOrder, true, true>(F.lds, g, S, E, F.wave);
        } SEAM(pb + 1);
        if (PH(3)) { PHASE_BEGIN(); phase_chunkpre(F, l); if (DUPMASK & 8) { __syncthreads(); phase_chunkpre(F, l); } } SEAM(pb + 3);
        if (PH(4)) { PHASE_BEGIN(); phase_seq(F, l); if (DUPMASK & 16) { __syncthreads(); phase_seq(F, l); }
            if (((int)blockIdx.x >= 112 || F.G <= 112)) { const int sv = F.vcu, sg = F.G; if (sg > 112) { F.vcu = (int)blockIdx.x - 112; F.G = sg - 112; } phase_absmax(F, l); if ((DUPMASK & 8192) && ((DUPL >> l) & 1)) phase_absmax(F, l); F.vcu = sv; F.G = sg; }
            if (l + 1 < DEPTH && (int)blockIdx.x >= 112 && F.G > 112) { const int sv = F.vcu, sg = F.G; F.vcu = (int)blockIdx.x - 112; F.G = sg - 112; phase_weights<0>(F, l + 1); F.vcu = sv; F.G = sg; }
        } SEAM(pb + 4);
        if (PH(5)) { PHASE_BEGIN(); phase_post(F, l); __syncthreads(); phase_weights<1>(F, l); if (DUPMASK & 32) { __syncthreads(); phase_weights<1>(F, l); } } SEAM(pb + 5);
        if (PH(6)) for (int rep_ = 0; rep_ < ((((DUPMASK >> 6) & 1) && ((DUPL >> l) & 1)) ? 2 : 1); ++rep_) { PHASE_BEGIN(); if (rep_) __syncthreads();
            pg8::Gemm g{WSP(const bf16, WS_Y), WSP(const bf16, (l & 1) ? WS_WOUT2 : WS_WOUT), TOK, D, D}; pg8::StaticOrder S; S.init(TOK, D, F.G, (int)blockIdx.x);
            pg8::EpiBf16 E{WSP(bf16, WS_MIX), D};
            pg8::gemm_phase<pg8::EpiBf16, pg8::StaticOrder, false, true>(F.lds, g, S, E, F.wave);
        } SEAM(pb + 6);
        if (PH(7)) { PHASE_BEGIN();
            if (moe) phase_ln<0, true, true>(F, INF(4) + l * D, INF(5) + l * D, INF(30) + (size_t)mi * D * NE, mi);
            else phase_ln<0, false, true>(F, INF(4) + l * D, INF(5) + l * D, nullptr, 0);
        } SEAM(pb + 7);
        if (PH(9)) for (int rep_ = 0; rep_ < ((((DUPMASK >> 9) & 1) && ((DUPL >> l) & 1)) ? 2 : 1); ++rep_) { PHASE_BEGIN(); if (rep_) __syncthreads();
            if (STAG9 > 0 && (((int)blockIdx.x >> 3) & 1)) { const unsigned long long t0_ = __builtin_amdgcn_s_memrealtime(); while (__builtin_amdgcn_s_memrealtime() - t0_ < (unsigned long long)STAG9) __builtin_amdgcn_s_sleep(8); }
            if (!moe) { pg8::Gemm g{WSP(const bf16, WS_H8), WSP(const bf16, WS_WUP), TOK, 2 * FFD, D / 2}; pg8::StaticOrder S; S.init(TOK, 2 * FFD, F.G, (int)blockIdx.x);
                pg8::EpiSwiGLU8<false> E{WSP(bf16, WS_HID), FFD, 22, WSP(const float, WS_RS), __uint_as_float(__hip_atomic_load((unsigned*)(F.ctl + CW_AMAX + l * 64), RLX_AGENT)) * (1.f / 127.f), pg8::MoeMap{}};
                pg8::gemm_phase<pg8::EpiSwiGLU8<false>, pg8::StaticOrder, true, true, 1>(F.lds, g, S, E, F.wave);
            } else { pg8::MoeOrder<true> S; S.M.init((const unsigned*)(F.ctl + CW_CNT + mi * 8 * 64), WSP(const int, WS_LIST) + (size_t)mi * NE * TOK); const int npan = S.M.poff[8];
                S.tpg = 11; S.G = F.G; S.c = (int)blockIdx.x; S.nunits = npan * 11; S.rowbytes = D;
                pg8::Gemm g{WSP(const bf16, WS_H8), WSP(const bf16, WS_WUP), 256 * npan, 2 * FFE, D / 2};
                pg8::EpiSwiGLU8<true> E{WSP(bf16, WS_HID), FFE, 11, WSP(const float, WS_RS), __uint_as_float(__hip_atomic_load((unsigned*)(F.ctl + CW_AMAX + l * 64), RLX_AGENT)) * (1.f / 127.f), S.M};
                pg8::gemm_phase<pg8::EpiSwiGLU8<true>, pg8::MoeOrder<true>, true, true, 1>(F.lds, g, S, E, F.wave);
            }
        } SEAM(pb + 9);
        if (PH(10)) for (int rep_ = 0; rep_ < ((((DUPMASK >> 10) & 1) && ((DUPL >> l) & 1)) ? 2 : 1); ++rep_) { PHASE_BEGIN(); if (rep_) __syncthreads();
            if (!moe) { pg8::Gemm g{WSP(const bf16, WS_HID), WSP(const bf16, WS_WDN), TOK, D, FFD}; pg8::StaticOrder S; S.init(TOK, D, F.G, (int)blockIdx.x);
                pg8::EpiBf16 E{WSP(bf16, WS_MIX), D};
                pg8::gemm_phase<pg8::EpiBf16, pg8::StaticOrder, false, true>(F.lds, g, S, E, F.wave);
            } else { pg8::MoeOrder<false> S; S.M.init((const unsigned*)(F.ctl + CW_CNT + mi * 8 * 64), WSP(const int, WS_LIST) + (size_t)mi * NE * TOK); const int npan = S.M.poff[8];
                S.tpg = 4; S.G = F.G; S.c = (int)blockIdx.x; S.nunits = npan * 4; S.rowbytes = 0;
                pg8::Gemm g{WSP(const bf16, WS_HID), WSP(const bf16, WS_WDN), 256 * npan, D, FFE};
                pg8::EpiScatter E{WSP(bf16, WS_DOUT), S.M};
                pg8::gemm_phase<pg8::EpiScatter, pg8::MoeOrder<false>, true, true>(F.lds, g, S, E, F.wave);
            }
        } SEAM(pb + 10);
        if (PH(11)) { PHASE_BEGIN();
            if (moe) phase_ln<1, false>(F, INF(6) + l * D, INF(7) + l * D, nullptr, 0, l == DEPTH - 1);
            else phase_ln<0, false>(F, INF(6) + l * D, INF(7) + l * D, nullptr, 0, l == DEPTH - 1);
            if (l + 1 < DEPTH && F.G <= 112) { __syncthreads(); phase_weights<0>(F, l + 1); }
        } SEAM(pb + 11);
#undef PH
    }
#undef IN
#undef SEAM
}

extern "C" void kernel_launch(void* const* d_in, const int* in_sizes, int n_in, void* d_out, int out_size, void* d_ws, size_t ws_size, hipStream_t stream) {
    static int grid = 0;
    if (grid == 0) {
        if (n_in != 34 || out_size != TOK * D || ws_size < WS_END) { fprintf(stderr, "kernel_launch: unexpected shapes (n_in %d, out %d, ws %zu)\n", n_in, out_size, ws_size); grid = -1; return; }
        int dev = 0, cus = 0, per_cu = 0;
        if (hipGetDevice(&dev) != hipSuccess || hipDeviceGetAttribute(&cus, hipDeviceAttributeMultiprocessorCount, dev) != hipSuccess) { grid = -1; return; }
        if (hipFuncSetAttribute((const void*)mk_fwd, hipFuncAttributeMaxDynamicSharedMemorySize, LDS_BYTES) != hipSuccess) { fprintf(stderr, "kernel_launch: hipFuncSetAttribute failed\n"); grid = -1; return; }
        if (hipOccupancyMaxActiveBlocksPerMultiprocessor(&per_cu, (const void*)mk_fwd, NWAVES * 64, LDS_BYTES) != hipSuccess || per_cu < 1) fprintf(stderr, "kernel_launch: occupancy query reports %d\n", per_cu);
        (void)hipGetLastError();
        grid = cus;
    }
    if (grid < 0) return;
    if (hipMemsetAsync((char*)d_ws + WS_CTL, 0, CTL_ZERO_BYTES, stream) != hipSuccess) return;
    Args a{};
    for (int i = 0; i < 34; ++i) a.in[i] = d_in[i];
    a.in[34] = d_out; a.in[35] = d_ws;
#if MK_PER_PHASE
    for (int p = 0; p < NPHASES; ++p) { a.ph_lo = p; a.ph_hi = p + 1; hipLaunchKernelGGL(mk_fwd, dim3(grid), dim3(NWAVES * 64), LDS_BYTES, stream, a); }
#else
    a.ph_lo = 0; a.ph_hi = NPHASES; hipLaunchKernelGGL(mk_fwd, dim3(grid), dim3(NWAVES * 64), LDS_BYTES, stream, a);
#endif
}
```

```cpp
#include <hip/hip_runtime.h>
#include <cstdio>
#include <cstdint>
#ifndef PHMASK
#define PHMASK 0xfff
#endif
#ifndef DUPMASK
#define DUPMASK 0
#endif
#ifndef DUPL
#define DUPL 0xf
#endif
#ifndef STAG9
#define STAG9 0
#endif
#ifndef MK_PER_PHASE
#define MK_PER_PHASE 0
#endif
__device__ __forceinline__ int lane_id_now() { unsigned m_ = ~0u; asm volatile("" : "+s"(m_)); return (int)__builtin_amdgcn_mbcnt_hi(m_, __builtin_amdgcn_mbcnt_lo(m_, 0u)); }
namespace pg8 {
#define PG8_LAS __attribute__((address_space(3)))
typedef unsigned short bf16_t;
typedef short bf16x8 __attribute__((ext_vector_type(8)));
typedef float f32x4 __attribute__((ext_vector_type(4)));
typedef unsigned u32x4 __attribute__((ext_vector_type(4)));
constexpr int BM = 256, BK = 64, HALF = 128, HTB = HALF * BK * 2  , STAGE_BYTES = 8 * HTB, NXCD = 8, WGM = 8;

__host__ __device__ __forceinline__ int lds_byte(int r, int c) { const int st = (r >> 4) * 2 + (c >> 5), rr = r & 15, cc = c & 31, ob = rr * 64 + cc * 2; return st * 1024 + (ob ^ (((ob >> 9) & 1) << 5)); }
__host__ __device__ __forceinline__ void stage_rc(int b, int& R, int& C) { const int st = b / 1024, sb = b % 1024, swz = sb ^ (((sb >> 9) & 1) << 5); R = (st >> 1) * 16 + swz / 64; C = (st & 1) * 32 + (swz % 64) / 2; }
__host__ __device__ __forceinline__ int perm32(int rho) { const int n = rho >> 4, i = rho & 15; return 8 * (i >> 2) + 4 * n + (i & 3); }

struct Unit { int pm, pn; };
struct Gemm { const bf16_t* A; const bf16_t* Bt; int M, N, K; };

struct StaticOrder {
    static constexpr bool GATHER = false;
    int nM, nN, nwg, G, c;
    __device__ __forceinline__ unsigned a_off(const Unit&, int) const { return 0u; }
    __host__ __device__ void init(int M, int N, int G_, int c_) { nM = M / BM; nN = N / BM; nwg = nM * nN; G = G_; c = c_; }
    __host__ __device__ bool next(int i, Unit& u) const {
        const long L = (long)i * G + c; if (L >= nwg) return false;
        int wgid = (int)L; { const int q = nwg / NXCD, r = nwg % NXCD, xcd = wgid % NXCD, off = wgid / NXCD; wgid = (xcd < r ? xcd * (q + 1) : r * (q + 1) + (xcd - r) * q) + off; }
        const int nig = WGM * nN, gid = wgid / nig, fm = gid * WGM, gsz = (nM - fm) < WGM ? (nM - fm) : WGM;
        u.pm = fm + ((wgid % nig) % gsz); u.pn = (wgid % nig) / gsz; return true;
    }
    __device__ __forceinline__ void a_ready(const Unit&) const {}
    __device__ __forceinline__ void done(const Unit&) const {}
};
__device__ __forceinline__ unsigned cvt_pk_bf16(float lo, float hi) { unsigned r; asm volatile("v_cvt_pk_bf16_f32 %0, %1, %2" : "=v"(r) : "v"(lo), "v"(hi)); return r; }
typedef float f32x2 __attribute__((ext_vector_type(2)));
struct EpiBf16 {
    static constexpr bool PERM = true, AFTER_DRAIN = false;
    bf16_t* O; int ldc;
    __device__ __forceinline__ void operator()(const f32x4 (&acc)[2][2][4][2], const Unit& u, int wr, int wc, int fr, int fq) const {
        const int row0 = u.pm * BM + wr * 64 + fr; const int col0 = u.pn * BM + wc * 32 + 8 * fq;
#pragma unroll
        for (int ai = 0; ai < 2; ++ai)
#pragma unroll
            for (int m = 0; m < 4; ++m) { bf16_t* rowp = O + (size_t)(row0 + ai * HALF + m * 16) * ldc + col0;
#pragma unroll
                for (int bj = 0; bj < 2; ++bj) { const f32x4 v0 = acc[ai][bj][m][0], v1 = acc[ai][bj][m][1];
                    u32x4 w; w.x = cvt_pk_bf16(v0[0], v0[1]); w.y = cvt_pk_bf16(v0[2], v0[3]); w.z = cvt_pk_bf16(v1[0], v1[1]); w.w = cvt_pk_bf16(v1[2], v1[3]);
                    *(u32x4*)(rowp + bj * HALF) = w; } }
    }
};
struct EpiBf16S {
    static constexpr bool PERM = true, AFTER_DRAIN = false;
    bf16_t* O; int ldc; float sc;
    __device__ __forceinline__ void operator()(const f32x4 (&acc)[2][2][4][2], const Unit& u, int wr, int wc, int fr, int fq) const {
        const int row0 = u.pm * BM + wr * 64 + fr; const int col0 = u.pn * BM + wc * 32 + 8 * fq;
#pragma unroll
        for (int ai = 0; ai < 2; ++ai)
#pragma unroll
            for (int m = 0; m < 4; ++m) { bf16_t* rowp = O + (size_t)(row0 + ai * HALF + m * 16) * ldc + col0;
#pragma unroll
                for (int bj = 0; bj < 2; ++bj) { const f32x4 v0 = acc[ai][bj][m][0] * sc, v1 = acc[ai][bj][m][1] * sc;
                    u32x4 w; w.x = cvt_pk_bf16(v0[0], v0[1]); w.y = cvt_pk_bf16(v0[2], v0[3]); w.z = cvt_pk_bf16(v1[0], v1[1]); w.w = cvt_pk_bf16(v1[2], v1[3]);
                    *(u32x4*)(rowp + bj * HALF) = w; } }
    }
};
struct EpiF32 {
    static constexpr bool PERM = false, AFTER_DRAIN = false;
    float* C; int ldc;
    __device__ __forceinline__ void operator()(const f32x4 (&acc)[2][2][4][2], const Unit& u, int wr, int wc, int fr, int fq) const {
        const int row0 = u.pm * BM + wr * 64 + fr, col0 = u.pn * BM + wc * 32 + 4 * fq;
#pragma unroll
        for (int ai = 0; ai < 2; ++ai)
#pragma unroll
            for (int m = 0; m < 4; ++m) { float* rowp = C + (size_t)(row0 + ai * HALF + m * 16) * ldc + col0;
#pragma unroll
                for (int bj = 0; bj < 2; ++bj)
#pragma unroll
                    for (int n = 0; n < 2; ++n) *(f32x4*)(rowp + bj * HALF + n * 16) = acc[ai][bj][m][n]; }
    }
};
__device__ __forceinline__ float silu_f(float x) { return x * __builtin_amdgcn_rcpf(1.0f + __expf(-x)); }
struct EpiSwiGLU {
    static constexpr bool PERM = true, AFTER_DRAIN = false;
    bf16_t* O; int ldc; int tiles_per_group;
    __device__ __forceinline__ void operator()(const f32x4 (&acc)[2][2][4][2], const Unit& u, int wr, int wc, int fr, int fq) const {
        const int row0 = u.pm * BM + wr * 64 + fr; const int pnl = u.pn % tiles_per_group; const int col0 = pnl * HALF + wc * 32 + 8 * fq;
#pragma unroll
        for (int ai = 0; ai < 2; ++ai)
#pragma unroll
            for (int m = 0; m < 4; ++m) { bf16_t* rowp = O + (size_t)(row0 + ai * HALF + m * 16) * ldc + col0;
                float h[8];
#pragma unroll
                for (int n = 0; n < 2; ++n)
#pragma unroll
                    for (int j = 0; j < 4; ++j) h[4 * n + j] = silu_f(acc[ai][0][m][n][j]) * acc[ai][1][m][n][j];
                u32x4 w; w.x = cvt_pk_bf16(h[0], h[1]); w.y = cvt_pk_bf16(h[2], h[3]); w.z = cvt_pk_bf16(h[4], h[5]); w.w = cvt_pk_bf16(h[6], h[7]);
                *(u32x4*)rowp = w; }
    }
};
struct MoeMap {
    int cnt[8], poff[9]; const int* list;
    __device__ __forceinline__ void init(const unsigned* counters, const int* list_) { list = list_; poff[0] = 0;
#pragma unroll
        for (int e = 0; e < 8; ++e) { cnt[e] = __builtin_amdgcn_readfirstlane((int)__hip_atomic_load(counters + e * 64, __ATOMIC_RELAXED, __HIP_MEMORY_SCOPE_AGENT));     poff[e + 1] = poff[e] + ((cnt[e] + 255) >> 8); } }
    __device__ __forceinline__ void locate(int P, int& e, int& lr, int& ce) const { e = 0; int pe = 0; ce = cnt[0];
#pragma unroll
        for (int j = 1; j < 8; ++j) if (P >= poff[j]) { e = j; pe = poff[j]; ce = cnt[j]; }
        lr = 256 * (P - pe); }
};
template <bool MOE> struct EpiSwiGLU8 {
    static constexpr bool PERM = true, AFTER_DRAIN = false;
    unsigned char* O; int ldc; int tiles_per_group; const float* rs; float sw; MoeMap M;
    __device__ __forceinline__ void operator()(const f32x4 (&acc)[2][2][4][2], const Unit& u, int wr, int wc, int fr, int fq) const {
        const int row0 = u.pm * BM + wr * 64 + fr; const int pnl = u.pn % tiles_per_group; const int col0 = pnl * HALF + wc * 32 + 8 * fq;
        float sc[2][4];
        if constexpr (MOE) { int e, lr, ce; M.locate(u.pm, e, lr, ce); const int* lst = M.list + e * 16384;
#pragma unroll
            for (int ai = 0; ai < 2; ++ai)
#pragma unroll
                for (int m = 0; m < 4; ++m) { const int r = lr + wr * 64 + fr + ai * HALF + m * 16; sc[ai][m] = rs[(r < ce) ? (lst[r] >> 1) : 0] * sw; }
        } else {
#pragma unroll
            for (int ai = 0; ai < 2; ++ai)
#pragma unroll
                for (int m = 0; m < 4; ++m) sc[ai][m] = rs[row0 + ai * HALF + m * 16] * sw;
        }
#pragma unroll
        for (int ai = 0; ai < 2; ++ai)
#pragma unroll
            for (int m = 0; m < 4; ++m) { unsigned char* rowp = O + (size_t)(row0 + ai * HALF + m * 16) * ldc + col0;
                float h[8];
#pragma unroll
                for (int n = 0; n < 2; ++n)
#pragma unroll
                    for (int j = 0; j < 4; ++j) { const float ag = acc[ai][0][m][n][j], au = acc[ai][1][m][n][j]; const float g = (float)__float_as_int(ag) * sc[ai][m], up = (float)__float_as_int(au) * sc[ai][m]; h[4 * n + j] = __builtin_fminf(__builtin_fmaxf(silu_f(g) * up, -448.f), 448.f); }
                unsigned w0 = 0u, w1 = 0u; w0 = __builtin_amdgcn_cvt_pk_fp8_f32(h[0], h[1], w0, false); w0 = __builtin_amdgcn_cvt_pk_fp8_f32(h[2], h[3], w0, true); w1 = __builtin_amdgcn_cvt_pk_fp8_f32(h[4], h[5], w1, false); w1 = __builtin_amdgcn_cvt_pk_fp8_f32(h[6], h[7], w1, true);
                typedef unsigned u32x2_ __attribute__((ext_vector_type(2))); u32x2_ w; w.x = w0; w.y = w1; *(u32x2_*)rowp = w;
                if (MOE && pnl == tiles_per_group - 1) { u32x2_ z; z.x = 0u; z.y = 0u; *(u32x2_*)(rowp + HALF) = z; } }
    }
};
struct EpiScatter {
    static constexpr bool PERM = true, AFTER_DRAIN = false;
    bf16_t* O; MoeMap M; float sc;
    __device__ __forceinline__ void operator()(const f32x4 (&acc)[2][2][4][2], const Unit& u, int wr, int wc, int fr, int fq) const {
        int e, lr, cnt; M.locate(u.pm, e, lr, cnt);
        const int pnl = u.pn & 3; const int col0 = pnl * BM + wc * 32 + 8 * fq; const int* lst = M.list + e * 16384;
#pragma unroll
        for (int ai = 0; ai < 2; ++ai)
#pragma unroll
            for (int m = 0; m < 4; ++m) { const int r = lr + wr * 64 + fr + ai * HALF + m * 16;
                if (r < cnt) { const int slot = lst[r]; bf16_t* rowp = O + (size_t)slot * 1024 + col0;
#pragma unroll
                    for (int bj = 0; bj < 2; ++bj) { const f32x4 v0 = acc[ai][bj][m][0] * sc, v1 = acc[ai][bj][m][1] * sc;
                        u32x4 w; w.x = cvt_pk_bf16(v0[0], v0[1]); w.y = cvt_pk_bf16(v0[2], v0[3]); w.z = cvt_pk_bf16(v1[0], v1[1]); w.w = cvt_pk_bf16(v1[2], v1[3]);
                        *(u32x4*)(rowp + bj * HALF) = w; } } }
    }
};
template <bool GATHER_> struct MoeOrder {
    static constexpr bool GATHER = GATHER_;
    MoeMap M; int tpg, G, c, nunits; unsigned rowbytes;
    __device__ __forceinline__ bool next(int i, Unit& u) const {
        const int L = i * G + c; if (L >= nunits) return false;
        int wgid = L; { const int q = nunits / NXCD, r = nunits % NXCD, xcd = wgid % NXCD, off = wgid / NXCD; wgid = (xcd < r ? xcd * (q + 1) : r * (q + 1) + (xcd - r) * q) + off; }
        const int P = wgid / tpg, pnl = wgid - P * tpg; int e, lr, ce; M.locate(P, e, lr, ce);
        u.pm = P; u.pn = e * tpg + pnl; return true;
    }
    __device__ __forceinline__ unsigned a_off(const Unit& u, int row) const {
        int e, lr, ce; M.locate(u.pm, e, lr, ce); const int r = lr + row; const int tok = (r < ce) ? (M.list[e * 16384 + r] >> 1) : 0; return (unsigned)tok * rowbytes; }
    __device__ __forceinline__ void a_ready(const Unit&) const {}
    __device__ __forceinline__ void done(const Unit&) const {}
};
typedef int i32x4 __attribute__((ext_vector_type(4))); typedef int i32x8 __attribute__((ext_vector_type(8)));
template <class Epi, class Sched, bool ALIGN_EPI = false, bool SP2 = false, int MT = 0  >
__device__ __forceinline__ void gemm_phase(PG8_LAS unsigned char* lds, const Gemm g, const Sched& S, const Epi& E, const int wave_in) {
    int tid_ = wave_in * 64 + lane_id_now(); asm volatile("" : "+v"(tid_));
    const int tid = tid_, wid = __builtin_amdgcn_readfirstlane(tid >> 6), lane = tid & 63, wr = wid >> 2, wc = wid & 3, fr = lane & 15, fq = lane >> 4;
    const int K = g.K, nt = K / BK;
    unsigned voffA[2], voffB[2];
#pragma unroll
    for (int i = 0; i < 2; ++i) { int R, C; stage_rc(tid * 16 + i * 8192, R, C); const int Rb = Epi::PERM ? ((R & ~31) + perm32(R & 31)) : R;
        voffA[i] = (unsigned)(R * K + C) * 2u; voffB[i] = (unsigned)(Rb * K + C) * 2u; }
    static_assert(!Sched::GATHER || SP2, "A-row gather is implemented for the SP2 loop");
    unsigned aoc[2][2], aon[2][2];
#define PG8_GOFF(dst, u) do { _Pragma("unroll") for (int _i = 0; _i < 2; ++_i) { int R_, C_; stage_rc(tid * 16 + _i * 8192, R_, C_); _Pragma("unroll") for (int _h = 0; _h < 2; ++_h) dst[_h][_i] = S.a_off(u, _h * HALF + R_) + (unsigned)(C_ * 2); } } while (0)
#define PG8_STAGE_A(bufoff, gbase, kofs, h, nx) do { if constexpr (Sched::GATHER) { const unsigned vo_[2] = {(nx) ? aon[h][0] : aoc[h][0], (nx) ? aon[h][1] : aoc[h][1]}; PG8_STAGE(bufoff, (const char*)g.A + (kofs), vo_); } else { PG8_STAGE(bufoff, gbase, voffA); } } while (0)
    const size_t kstep = (size_t)(BK * 2);
    const size_t hstep = (size_t)HALF * K * 2;
    const size_t tstep = 2 * hstep;
    const unsigned ldsw = (unsigned)wid * 1024u;
    const int aoff = lds_byte(wr * 64 + fr, fq * 8), boff = lds_byte(wc * 32 + fr, fq * 8);
#define PG8_SA(b, h) (((b) * 2 + (h)) * HTB)
#define PG8_SB(b, h) ((4 + (b) * 2 + (h)) * HTB)
#define PG8_STAGE(bufoff, gbase, voff) do { _Pragma("unroll") for (int _i = 0; _i < 2; ++_i) { unsigned o_ = (voff)[_i]; asm volatile("" : "+v"(o_));     \
        __builtin_amdgcn_global_load_lds((const unsigned*)((const char*)(gbase) + o_), (PG8_LAS unsigned*)(lds + (bufoff) + ldsw + _i * 8192), 16, 0, 0); } } while (0)
#define PG8_LDA(dst, b, h) do { _Pragma("unroll") for (int m = 0; m < 4; ++m) _Pragma("unroll") for (int k = 0; k < 2; ++k) dst[m][k] = *(const PG8_LAS bf16x8*)(lds + PG8_SA(b, h) + aoff + m * 2048 + k * 1024); } while (0)
#define PG8_LDB(dst, b, h) do { _Pragma("unroll") for (int n = 0; n < 2; ++n) _Pragma("unroll") for (int k = 0; k < 2; ++k) dst[n][k] = *(const PG8_LAS bf16x8*)(lds + PG8_SB(b, h) + boff + n * 2048 + k * 1024); } while (0)
#define PG8_MMA(ai, bj, At, Bt) do { __builtin_amdgcn_s_setprio(1); _Pragma("unroll") for (int m = 0; m < 4; ++m) _Pragma("unroll") for (int n = 0; n < 2; ++n) _Pragma("unroll") for (int k = 0; k < 2; ++k) \
        { if constexpr (MT == 0) acc[ai][bj][m][n] = __builtin_amdgcn_mfma_f32_16x16x32_bf16(Bt[n][k], At[m][k], acc[ai][bj][m][n], 0, 0, 0); \
          else if constexpr (MT == 1) acc[ai][bj][m][n] = __builtin_bit_cast(f32x4, __builtin_amdgcn_mfma_i32_16x16x64_i8(__builtin_bit_cast(i32x4, Bt[n][k]), __builtin_bit_cast(i32x4, At[m][k]), __builtin_bit_cast(i32x4, acc[ai][bj][m][n]), 0, 0, 0)); \
          else { if (k == 0) { const i32x8 b8_ = __builtin_shufflevector(__builtin_bit_cast(i32x4, Bt[n][0]), __builtin_bit_cast(i32x4, Bt[n][1]), 0, 1, 2, 3, 4, 5, 6, 7), a8_ = __builtin_shufflevector(__builtin_bit_cast(i32x4, At[m][0]), __builtin_bit_cast(i32x4, At[m][1]), 0, 1, 2, 3, 4, 5, 6, 7); \
              asm volatile("v_mfma_f32_16x16x128_f8f6f4 %0, %1, %2, %0" : "+v"(acc[ai][bj][m][n]) : "v"(b8_), "v"(a8_)); } } }     \
        __builtin_amdgcn_s_setprio(0); } while (0)
#define PG8_WAIT_V(n) asm volatile("s_waitcnt vmcnt(" #n ")" ::: "memory")
#define PG8_WAIT_L(n) asm volatile("s_waitcnt lgkmcnt(" #n ")" ::: "memory")
#define PG8_BAR __builtin_amdgcn_s_barrier()
#define PG8_SCHED __builtin_amdgcn_sched_barrier(0)
    Unit cur, nxt; int ui = 0;
    if (!S.next(0, cur)) return;
    f32x4 acc[2][2][4][2];
#pragma unroll
    for (int a = 0; a < 2; ++a)
#pragma unroll
        for (int b = 0; b < 2; ++b)
#pragma unroll
            for (int m = 0; m < 4; ++m)
#pragma unroll
                for (int n = 0; n < 2; ++n) acc[a][b][m][n] = (f32x4){0.f, 0.f, 0.f, 0.f};
    bf16x8 At[4][2], B0[2][2], B1[2][2];
    const char* cA = (const char*)g.A + (size_t)cur.pm * tstep; const char* cB = (const char*)g.Bt + (size_t)cur.pn * tstep;
    S.a_ready(cur);
    if constexpr (SP2) {
        if constexpr (Sched::GATHER) { PG8_GOFF(aoc, cur); }
        PG8_STAGE(PG8_SB(0, 0), cB, voffB); PG8_STAGE(PG8_SB(0, 1), cB + hstep, voffB); PG8_STAGE_A(PG8_SA(0, 0), cA, (size_t)0, 0, false); PG8_STAGE_A(PG8_SA(0, 1), cA + hstep, (size_t)0, 1, false);
        if (wr == 1) PG8_BAR;
        PG8_WAIT_V(2); PG8_BAR;
        PG8_STAGE(PG8_SB(1, 0), cB + kstep, voffB); PG8_STAGE_A(PG8_SA(1, 0), cA + kstep, kstep, 0, false); PG8_STAGE(PG8_SB(1, 1), cB + hstep + kstep, voffB);
        PG8_WAIT_V(6); PG8_BAR;
    } else {
        PG8_STAGE(PG8_SB(0, 0), cB, voffB); PG8_STAGE(PG8_SA(0, 0), cA, voffA); PG8_STAGE(PG8_SB(0, 1), cB + hstep, voffB); PG8_STAGE(PG8_SA(0, 1), cA + hstep, voffA);
        if (wr == 1) PG8_BAR;
        PG8_WAIT_V(4); PG8_BAR;
        PG8_STAGE(PG8_SB(1, 0), cB + kstep, voffB); PG8_STAGE(PG8_SA(1, 0), cA + kstep, voffA); PG8_STAGE(PG8_SB(1, 1), cB + hstep + kstep, voffB);
        PG8_WAIT_V(6); PG8_BAR;
    }
    for (;;) {
        const bool has_next = S.next(ui + 1, nxt);
        const char* nA = has_next ? (const char*)g.A + (size_t)nxt.pm * tstep : cA; const char* nB = has_next ? (const char*)g.Bt + (size_t)nxt.pn * tstep : cB;
        for (int t = 0; t < nt; t += 2) {
            const bool last = (t == nt - 2);
            const char* a1 = cA + (size_t)(t + 1) * kstep;
            const char* a2 = last ? nA : cA + (size_t)(t + 2) * kstep; const char* b2 = last ? nB : cB + (size_t)(t + 2) * kstep;
            const char* a3 = a2 + kstep; const char* b3 = b2 + kstep;
            if (last && has_next) S.a_ready(nxt);
            const size_t ko2 = last ? (size_t)0 : (size_t)(t + 2) * kstep;
            if constexpr (Sched::GATHER) { if (last) { if (has_next) { PG8_GOFF(aon, nxt); } else { _Pragma("unroll") for (int _h = 0; _h < 2; ++_h) { aon[_h][0] = aoc[_h][0]; aon[_h][1] = aoc[_h][1]; } } } }
            if constexpr (SP2) {
            PG8_LDB(B0, 0, 0); PG8_LDB(B1, 0, 1); PG8_SCHED; PG8_LDA(At, 0, 0); PG8_STAGE_A(PG8_SA(1, 1), a1 + hstep, (size_t)(t + 1) * kstep, 1, false);
            PG8_WAIT_V(8); PG8_WAIT_L(0); PG8_BAR; PG8_MMA(0, 0, At, B0); PG8_MMA(0, 1, At, B1); PG8_BAR; PG8_SCHED;
            PG8_LDA(At, 0, 1); PG8_STAGE(PG8_SB(0, 0), b2, voffB); PG8_STAGE(PG8_SB(0, 1), b2 + hstep, voffB); PG8_STAGE_A(PG8_SA(0, 0), a2, ko2, 0, last);
            PG8_WAIT_V(8); PG8_WAIT_L(0); PG8_BAR; PG8_MMA(1, 0, At, B0); PG8_MMA(1, 1, At, B1); PG8_BAR; PG8_SCHED;
            PG8_LDB(B0, 1, 0); PG8_LDB(B1, 1, 1); PG8_SCHED; PG8_LDA(At, 1, 0); PG8_STAGE_A(PG8_SA(0, 1), a2 + hstep, ko2, 1, last);
            PG8_WAIT_V(8); PG8_WAIT_L(0); PG8_BAR; PG8_MMA(0, 0, At, B0); PG8_MMA(0, 1, At, B1); PG8_BAR; PG8_SCHED;
            PG8_LDA(At, 1, 1); PG8_STAGE(PG8_SB(1, 0), b3, voffB); PG8_STAGE(PG8_SB(1, 1), b3 + hstep, voffB); PG8_STAGE_A(PG8_SA(1, 0), a3, ko2 + kstep, 0, last);
            PG8_WAIT_V(8); PG8_WAIT_L(0); PG8_BAR; PG8_MMA(1, 0, At, B0); PG8_MMA(1, 1, At, B1); PG8_BAR; PG8_SCHED;
            } else {
            PG8_LDB(B0, 0, 0); PG8_SCHED; PG8_LDA(At, 0, 0); PG8_STAGE(PG8_SA(1, 1), a1 + hstep, voffA);
            PG8_WAIT_L(8); PG8_BAR; PG8_WAIT_L(0); PG8_MMA(0, 0, At, B0); PG8_BAR; PG8_SCHED;
            PG8_LDB(B1, 0, 1); PG8_STAGE(PG8_SB(0, 0), b2, voffB);
            PG8_BAR; PG8_WAIT_L(0); PG8_MMA(0, 1, At, B1); PG8_BAR;
            PG8_LDA(At, 0, 1); PG8_STAGE(PG8_SA(0, 0), a2, voffA);
            PG8_BAR; PG8_WAIT_L(0); PG8_MMA(1, 0, At, B0); PG8_BAR; PG8_SCHED;
            PG8_STAGE(PG8_SB(0, 1), b2 + hstep, voffB);
            PG8_WAIT_V(6); PG8_BAR; PG8_MMA(1, 1, At, B1); PG8_BAR;
            PG8_LDB(B0, 1, 0); PG8_SCHED; PG8_LDA(At, 1, 0); PG8_STAGE(PG8_SA(0, 1), a2 + hstep, voffA);
            PG8_WAIT_L(8); PG8_BAR; PG8_WAIT_L(0); PG8_MMA(0, 0, At, B0); PG8_BAR; PG8_SCHED;
            PG8_LDB(B1, 1, 1); PG8_STAGE(PG8_SB(1, 0), b3, voffB);
            PG8_BAR; PG8_WAIT_L(0); PG8_MMA(0, 1, At, B1); PG8_BAR;
            PG8_LDA(At, 1, 1); PG8_STAGE(PG8_SA(1, 0), a3, voffA);
            PG8_BAR; PG8_WAIT_L(0); PG8_MMA(1, 0, At, B0); PG8_BAR; PG8_SCHED;
            PG8_STAGE(PG8_SB(1, 1), b3 + hstep, voffB);
            PG8_WAIT_V(6); PG8_BAR; PG8_MMA(1, 1, At, B1); PG8_BAR;
            }
        }
        if constexpr (MT == 2) { asm volatile("s_nop 15\n\ts_nop 15" ::: "memory"); }
        if constexpr (ALIGN_EPI) { if (wr == 0) PG8_BAR; }
        if constexpr (!Epi::AFTER_DRAIN) { E(acc, cur, wr, wc, fr, fq); S.done(cur); }
        if (!has_next) break;
#pragma unroll
        for (int a = 0; a < 2; ++a)
#pragma unroll
            for (int b = 0; b < 2; ++b)
#pragma unroll
                for (int m = 0; m < 4; ++m)
#pragma unroll
                    for (int n = 0; n < 2; ++n) acc[a][b][m][n] = (f32x4){0.f, 0.f, 0.f, 0.f};
        cur = nxt; cA = nA; cB = nB; ++ui;
        if constexpr (Sched::GATHER) { _Pragma("unroll") for (int _h = 0; _h < 2; ++_h) { aoc[_h][0] = aon[_h][0]; aoc[_h][1] = aon[_h][1]; } }
        if constexpr (ALIGN_EPI) { if (wr == 1) PG8_BAR; }
    }
    PG8_WAIT_V(0);
    if constexpr (!ALIGN_EPI) { if (wr == 0) PG8_BAR; }
    PG8_BAR;
    if constexpr (Epi::AFTER_DRAIN) { E.fused(acc, cur, wr, wc, fr, fq, lds, wid, lane); S.done(cur); }
#undef PG8_SA
#undef PG8_SB
#undef PG8_STAGE
#undef PG8_STAGE_A
#undef PG8_GOFF
#undef PG8_LDA
#undef PG8_LDB
#undef PG8_MMA
#undef PG8_WAIT_V
#undef PG8_WAIT_L
#undef PG8_BAR
#undef PG8_SCHED
}
}
constexpr int NWAVES = 8;
constexpr int TOK = 16384, SEQ = 4096, D = 1024, NP = 4096, INC = 3888, DEPTH = 4;
constexpr int HG_Q = 0, HG_F = 256, HG_I = 512, HG_G = 768;
constexpr int GL_Q = 1024, GL_K = 1152, GL_V = 1280, GL_GLR = 1536, GL_R = 1552;
constexpr int RW_BASE = 1808, RW_R = 1808, RW_K = 2064, RW_V = 2320, RW_WLR = 2576, RW_ALR = 2640, RW_GLR = 2704;
constexpr int RT_Q = 2864, RT_K = 3120, RT_V = 3376, RT_G = 3632;
constexpr int GL_GX = 3904;
constexpr int FFD = 2816, FFE = 1408, NE = 8, FFEP = 1536;
constexpr float DN_ALPHA = 1.6817928305074290f;
constexpr int NPH = 12;
constexpr int NPHASES = NPH * DEPTH;
constexpr size_t MiB = 1u << 20;
constexpr size_t WS_CTL = 0, CTL_ZERO_BYTES = 1 * MiB;
constexpr size_t WS_LIST = 1 * MiB;
constexpr size_t WS_GATE = 2 * MiB;
constexpr size_t WS_TAB = 3 * MiB;
constexpr size_t WS_WIN = 4 * MiB, WS_WOUT = 12 * MiB, WS_WUP = 14 * MiB, WS_WDN = 58 * MiB;
constexpr size_t WS_HB = 80 * MiB;
constexpr size_t WS_MIX = 112 * MiB;
constexpr size_t WS_O = WS_MIX;
constexpr size_t WS_OI = 144 * MiB;
constexpr size_t OI_GEN = 64 * 4096 * 16;
constexpr size_t WS_VF = 176 * MiB;
constexpr size_t WS_P = 184 * MiB;
constexpr size_t WS_RWW = 312 * MiB;
constexpr size_t WS_RWR = 328 * MiB, WS_RWK = 336 * MiB, WS_RWV = 344 * MiB, WS_RWKK = 352 * MiB, WS_RWB = 360 * MiB, WS_RWG = 368 * MiB;
constexpr size_t WS_Y = 376 * MiB;
constexpr size_t WS_CS = 461 * MiB;
constexpr size_t WS_HID = 184 * MiB;
constexpr size_t WS_DOUT = 280 * MiB;
constexpr size_t WS_HPERM = 344 * MiB;
constexpr size_t WS_H8 = 344 * MiB;
constexpr size_t WS_RS = 360 * MiB;
constexpr size_t WS_WOUT2 = 465 * MiB;
constexpr size_t WS_END = 467 * MiB;
constexpr int CW_BAR = 4096;
constexpr int CW_CNT = 16384;
constexpr int CW_AMAX = 20480;
constexpr int CW_AMAXD = 24576;
constexpr int TAB_STRIDE = 4 * 160 + 16;
constexpr size_t WS_LORA = 2 * MiB + 512 * 1024;
constexpr int LO_W2 = 0, LO_A2 = 256 * 64, LO_G2 = 2 * 256 * 64, LO_V1 = LO_G2 + 256 * 160, LO_V2 = LO_V1 + 32 * 256, LO_END = LO_V2 + 256 * 32;
constexpr int RING_BYTES = 131072, LDSCTL_OFF = 146432, MISC_OFF = LDSCTL_OFF + 320, LDS_BYTES = 147456;
#define GAS __attribute__((address_space(1)))
#define LAS __attribute__((address_space(3)))
typedef unsigned short bf16;
typedef unsigned v4u __attribute__((ext_vector_type(4)));
typedef unsigned v2u __attribute__((ext_vector_type(2)));
typedef float f32x4 __attribute__((ext_vector_type(4)));
typedef short bf16x8 __attribute__((ext_vector_type(8)));
typedef GAS unsigned gu32;
#define RLX_AGENT __ATOMIC_RELAXED, __HIP_MEMORY_SCOPE_AGENT
#define LDS_WAIT() asm volatile("s_waitcnt lgkmcnt(0)" ::: "memory")
#define VM_WAIT() asm volatile("s_waitcnt vmcnt(0)" ::: "memory")
#define LDS_BARRIER() do { asm volatile("s_waitcnt lgkmcnt(0)" ::: "memory"); __builtin_amdgcn_s_barrier(); asm volatile("" ::: "memory"); } while (0)
typedef float f32x2_t __attribute__((ext_vector_type(2))); typedef __bf16 bf16x2_t __attribute__((ext_vector_type(2)));
__device__ __forceinline__ unsigned pk2(float lo, float hi) { f32x2_t v = {lo, hi}; bf16x2_t b = __builtin_convertvector(v, bf16x2_t); return __builtin_bit_cast(unsigned, b); }
__device__ __forceinline__ unsigned f2bf(float f) { return pk2(f, f) & 0xffffu; }
__device__ __forceinline__ float bflo(unsigned w) { return __builtin_bit_cast(float, w << 16); }
__device__ __forceinline__ float bfhi(unsigned w) { return __builtin_bit_cast(float, w & 0xffff0000u); }
__device__ __forceinline__ float bf1(bf16 b) { return __builtin_bit_cast(float, ((unsigned)b) << 16); }
__device__ __forceinline__ void unpack8(const v4u w, float (&f)[8]) { f[0] = bflo(w.x); f[1] = bfhi(w.x); f[2] = bflo(w.y); f[3] = bfhi(w.y); f[4] = bflo(w.z); f[5] = bfhi(w.z); f[6] = bflo(w.w); f[7] = bfhi(w.w); }
__device__ __forceinline__ v4u pack8(const float (&f)[8]) { v4u w; w.x = pk2(f[0], f[1]); w.y = pk2(f[2], f[3]); w.z = pk2(f[4], f[5]); w.w = pk2(f[6], f[7]); return w; }
__device__ __forceinline__ float sigm(float x) { return __builtin_amdgcn_rcpf(1.0f + __expf(-x)); }
template <int CTRL> __device__ __forceinline__ float dpp(float x) { return __builtin_bit_cast(float, __builtin_amdgcn_mov_dpp(__builtin_bit_cast(int, x), CTRL, 0xf, 0xf, true)); }
__device__ __forceinline__ float sum16(float x) { x += dpp<0xB1>(x); x += dpp<0x4E>(x); x += dpp<0x141>(x); x += dpp<0x128>(x); return x; }
__device__ __forceinline__ float sum4(float x) { x += dpp<0xB1>(x); x += dpp<0x4E>(x); return x; }
__device__ __forceinline__ float wave_sum(float x) {
    x = sum16(x);
    auto s = __builtin_amdgcn_permlane16_swap(__float_as_uint(x), __float_as_uint(x), false, false); x = __uint_as_float(s[0]) + __uint_as_float(s[1]);
    auto t = __builtin_amdgcn_permlane32_swap(__float_as_uint(x), __float_as_uint(x), false, false); return __uint_as_float(t[0]) + __uint_as_float(t[1]);
}
__device__ __forceinline__ float wave_max(float x) {
    x = fmaxf(x, dpp<0xB1>(x)); x = fmaxf(x, dpp<0x4E>(x)); x = fmaxf(x, dpp<0x141>(x)); x = fmaxf(x, dpp<0x128>(x));
    auto s = __builtin_amdgcn_permlane16_swap(__float_as_uint(x), __float_as_uint(x), false, false); x = fmaxf(__uint_as_float(s[0]), __uint_as_float(s[1]));
    auto t = __builtin_amdgcn_permlane32_swap(__float_as_uint(x), __float_as_uint(x), false, false); return fmaxf(__uint_as_float(t[0]), __uint_as_float(t[1]));
}
__device__ __forceinline__ unsigned pack_i8(float a, float b, float c, float d) {
    const int ia = (int)__builtin_rintf(a), ib = (int)__builtin_rintf(b), ic = (int)__builtin_rintf(c), id = (int)__builtin_rintf(d);
    return ((unsigned)ia & 255u) | (((unsigned)ib & 255u) << 8) | (((unsigned)ic & 255u) << 16) | ((unsigned)id << 24);
}
__device__ const double INVF2PI[32] = {0.15915494309189535, 0.11934937021124886, 0.08949940160889101, 0.06711508300522726, 0.050329212104487035, 0.03774158471741977, 0.0283021958306234, 0.02122365276477766, 0.015915494309189534, 0.011934937021124886, 0.008949940160889102, 0.006711508300522725, 0.005032921210448704, 0.003774158471741977, 0.00283021958306234, 0.0021223652764777662, 0.0015915494309189536, 0.0011934937021124885, 0.0008949940160889102, 0.0006711508300522726, 0.0005032921210448703, 0.00037741584717419774, 0.00028302195830623395, 0.0002122365276477766, 0.00015915494309189535, 0.00011934937021124886, 8.949940160889102e-05, 6.711508300522725e-05, 5.0329212104487035e-05, 3.774158471741978e-05, 2.8302195830623396e-05, 2.122365276477766e-05};
#define XB_TMO      128
#define XB_XCNT(j)  (256  + 64 * (j))
#define XB_XSUB(j)  (1280 + 64 * (j))
#define XB_XGEN(j)  (2304 + 64 * (j))
#define XB_TOP      3328
#define XB_TOPGEN   3392
#define XCD_BAR_WORDS 3456
#define XB_SPIN_CAP (1u << 18)

__device__ __forceinline__ unsigned xb_ld(unsigned* p)              { return __hip_atomic_load(p, __ATOMIC_RELAXED, __HIP_MEMORY_SCOPE_AGENT); }
__device__ __forceinline__ unsigned xb_add(unsigned* p, unsigned v) { return __hip_atomic_fetch_add(p, v, __ATOMIC_RELAXED, __HIP_MEMORY_SCOPE_AGENT); }
__device__ __forceinline__ unsigned xb_xcc_id() { return (unsigned)__builtin_amdgcn_s_getreg((3 << 11) | 20) & 0xFu; }
#define XB_SPIN(cond, bar) do { unsigned _sp = 0; while (cond) { __builtin_amdgcn_s_sleep(1); \
    if ((++_sp & 255u) == 0u) { if (xb_ld(&(bar)[XB_TMO])) break; if (_sp > XB_SPIN_CAP) { atomicAdd(&(bar)[XB_TMO], 1u); break; } } } } while (0)

struct XcdBarrier {
    unsigned* bar; unsigned x;
    volatile LAS unsigned* st;
    int wv;
};

__device__ __forceinline__ XcdBarrier xcd_barrier_post(unsigned* bar, volatile LAS unsigned* st) {
    XcdBarrier b; b.bar = bar; b.x = xb_xcc_id(); b.st = st; b.wv = __builtin_amdgcn_readfirstlane((int)threadIdx.x >> 6);
    if (threadIdx.x == 0) (void)xb_add(&bar[XB_XCNT(b.x)], 1u);
    return b;
}
__device__ __forceinline__ void xcd_barrier_complete(unsigned* bar, unsigned x, unsigned& nloc, unsigned& nx) {
    const unsigned G = gridDim.x * gridDim.y * gridDim.z;
    unsigned sum, cnt, mine, sp = 0u;
    for (;;) {
        sum = 0u; cnt = 0u; mine = 0u;
#pragma unroll 1
        for (unsigned j = 0; j < 16; ++j) { const unsigned c = xb_ld(&bar[XB_XCNT(j)]); sum += c; cnt += (c > 0u) ? 1u : 0u; mine = (j == x) ? c : mine; }
        if (sum == G) break;
        __builtin_amdgcn_s_sleep(1);
        if ((++sp & 255u) == 0u) { if (xb_ld(&bar[XB_TMO])) break; if (sp > XB_SPIN_CAP) { atomicAdd(&bar[XB_TMO], 1u); break; } }
    }
    nloc = mine > 0u ? mine : 1u; nx = cnt > 0u ? cnt : 1u;
}

__device__ __forceinline__ void xcd_barrier(const XcdBarrier& b) {
    asm volatile("s_waitcnt vmcnt(0)" ::: "memory");
    __syncthreads();
    if (b.wv == 0 && lane_id_now() == 0) {
        unsigned* bar = b.bar;
        __builtin_amdgcn_s_waitcnt(0);
        unsigned nloc = b.st[0], nx = b.st[1];
        if (nloc == 0u) { xcd_barrier_complete(bar, b.x, nloc, nx); b.st[0] = nloc; b.st[1] = nx; }
        const unsigned old = xb_add(&bar[XB_XSUB(b.x)], 1u);
        const unsigned gen = old / nloc;
        if (old + 1u == (gen + 1u) * nloc) {
            __builtin_amdgcn_fence(__ATOMIC_RELEASE, "agent");
            asm volatile("s_waitcnt vmcnt(0)" ::: "memory");
            const unsigned og = xb_add(&bar[XB_TOP], 1u);
            const unsigned tg = og / nx;
            if (og + 1u == (tg + 1u) * nx) xb_add(&bar[XB_TOPGEN], 1u);
            else XB_SPIN(xb_ld(&bar[XB_TOPGEN]) == tg, bar);
            __builtin_amdgcn_fence(__ATOMIC_ACQUIRE, "agent");
            xb_add(&bar[XB_XGEN(b.x)], 1u);
            asm volatile("s_waitcnt vmcnt(0)" ::: "memory");
        } else {
            XB_SPIN(xb_ld(&bar[XB_XGEN(b.x)]) == gen, bar);
            __builtin_amdgcn_fence(__ATOMIC_ACQUIRE, "agent");
            asm volatile("s_waitcnt vmcnt(0)" ::: "memory");
        }
    }
    __syncthreads();
}
struct Frame {
    LAS unsigned char* lds;
    volatile LAS unsigned* MISC;
    gu32* ctl;
    int tid, lane, wave;
    int vcu, G;
    unsigned char* ws;
    const void* const* in;
    float* h;
};
__device__ __forceinline__ const void* ldptr(const void* const* tab, int k) { int z; asm volatile("s_mov_b32 %0, 0" : "=s"(z)); return tab[k + z]; }
#define INF(k) ((const float*)ldptr(F.in, k))
#define WSP(T, off) ((T*)(F.ws + (off)))

__device__ __forceinline__ void xpose_item(const float* W, int ldw, int nvalid, int k0, int n0, bf16* WT, int ldt, int drow0, LAS float* scr, int lane) {
#pragma unroll 8
    for (int i = 0; i < 32; ++i) { const int kk = 2 * i + (lane >> 5), n = n0 + (lane & 31); scr[kk * 33 + (lane & 31)] = (n < nvalid) ? W[(size_t)(k0 + kk) * ldw + n] : 0.f; }
    LDS_WAIT(); asm volatile("" ::: "memory");
    const int c = lane & 7;
#pragma unroll
    for (int j = 0; j < 4; ++j) { const int n = (lane >> 3) + 8 * j; const LAS float* s = scr + (8 * c) * 33 + n;
        v4u o; o.x = pk2(s[0 * 33], s[1 * 33]); o.y = pk2(s[2 * 33], s[3 * 33]); o.z = pk2(s[4 * 33], s[5 * 33]); o.w = pk2(s[6 * 33], s[7 * 33]);
        *(GAS v4u*)(WT + (size_t)(drow0 + n) * ldt + k0 + 8 * c) = o; }
    LDS_WAIT(); asm volatile("" ::: "memory");
}
__device__ __forceinline__ void xpose_item8(const float* W, int ldw, int k0, int n0, unsigned char* WT, int ldt, int drow0, float qs, LAS float* scr, int lane) {
#pragma unroll 8
    for (int i = 0; i < 32; ++i) { const int kk = 2 * i + (lane >> 5), n = n0 + (lane & 31); scr[kk * 33 + (lane & 31)] = W[(size_t)(k0 + kk) * ldw + n]; }
    LDS_WAIT(); asm volatile("" ::: "memory");
    const int c = lane & 7;
#pragma unroll
    for (int j = 0; j < 4; ++j) { const int n = (lane >> 3) + 8 * j; const LAS float* s = scr + (8 * c) * 33 + n;
        v2u o; o.x = pack_i8(s[0 * 33] * qs, s[1 * 33] * qs, s[2 * 33] * qs, s[3 * 33] * qs); o.y = pack_i8(s[4 * 33] * qs, s[5 * 33] * qs, s[6 * 33] * qs, s[7 * 33] * qs);
        *(GAS v2u*)(WT + (size_t)(drow0 + n) * ldt + k0 + 8 * c) = o; }
    LDS_WAIT(); asm volatile("" ::: "memory");
}
__device__ __forceinline__ void f8_scale(float am, float& s, float& inv) {
    const int e = (int)((__float_as_uint(am) >> 23) & 255u) - 127;
    if (am > 0.f && e > -100 && e < 100) { s = __uint_as_float((unsigned)(127 + 7 - e) << 23); inv = __uint_as_float((unsigned)(127 + e - 7) << 23); } else { s = 1.f; inv = 1.f; }
}
__device__ __forceinline__ unsigned pack_f8(float a, float b, float c, float d) {
    unsigned w = 0u; w = __builtin_amdgcn_cvt_pk_fp8_f32(a, b, w, false); w = __builtin_amdgcn_cvt_pk_fp8_f32(c, d, w, true); return w;
}
__device__ __forceinline__ void xpose_item_f8(const float* W, int ldw, int kvalid, int k0, int n0, unsigned char* WT, int ldt, int drow0, float qs, LAS float* scr, int lane) {
    const int c = lane & 7;
    if (k0 >= kvalid) {
#pragma unroll
        for (int j = 0; j < 4; ++j) { const int n = (lane >> 3) + 8 * j; v2u o; o.x = 0u; o.y = 0u; *(GAS v2u*)(WT + (size_t)(drow0 + n) * ldt + k0 + 8 * c) = o; }
        return; }
#pragma unroll 8
    for (int i = 0; i < 32; ++i) { const int kk = 2 * i + (lane >> 5), n = n0 + (lane & 31); scr[kk * 33 + (lane & 31)] = W[(size_t)(k0 + kk) * ldw + n]; }
    LDS_WAIT(); asm volatile("" ::: "memory");
#pragma unroll
    for (int j = 0; j < 4; ++j) { const int n = (lane >> 3) + 8 * j; const LAS float* s = scr + (8 * c) * 33 + n;
        v2u o; o.x = pack_f8(s[0 * 33] * qs, s[1 * 33] * qs, s[2 * 33] * qs, s[3 * 33] * qs); o.y = pack_f8(s[4 * 33] * qs, s[5 * 33] * qs, s[6 * 33] * qs, s[7 * 33] * qs);
        *(GAS v2u*)(WT + (size_t)(drow0 + n) * ldt + k0 + 8 * c) = o; }
    LDS_WAIT(); asm volatile("" ::: "memory");
}
__device__ __forceinline__ int gu_row(int n) { return 256 * (n >> 7) + (n & 127); }
template <int PART> __device__ __forceinline__ void phase_weights(Frame& F, int l) {
    LAS float* scr = (LAS float*)(F.lds + F.wave * 16384);
    const int gw = F.vcu * NWAVES + F.wave, NGW = F.G * NWAVES;
    const bool moe = (l & 1); const int fi = l >> 1;
    constexpr int I_IN = 16 * 128, I_OUT = 16 * 32;
    constexpr int I_DG = 16 * 88, I_DD = 44 * 32;
    constexpr int I_MG = 16 * 44, I_MD = 24 * 32;
    const int nitems = PART == 0 ? (I_IN + I_OUT) : (moe ? NE * (2 * I_MG + I_MD) : (2 * I_DG + I_DD));
    float qs8 = 0.f; if (PART == 1) { const float am = __uint_as_float(__hip_atomic_load((unsigned*)(F.ctl + CW_AMAX + l * 64), RLX_AGENT)); qs8 = am > 0.f ? 127.f / am : 0.f; }
    float qsd = 1.f; if (PART == 1) { float inv_; f8_scale(__uint_as_float(__hip_atomic_load((unsigned*)(F.ctl + CW_AMAXD + l * 64), RLX_AGENT)), qsd, inv_); }
    for (int it = gw; it < nitems; it += NGW) {
        int r = it + (PART == 0 ? 0 : I_IN + I_OUT);
        if (r < I_IN) { const int kb = r >> 7, nb = r & 127; if (nb < 122) xpose_item(INF(2) + (size_t)l * D * INC, INC, INC, 64 * kb, 32 * nb, WSP(bf16, WS_WIN), D, 32 * nb, scr, F.lane); continue; } r -= I_IN;
        if (r < I_OUT) { const int kb = r >> 5, nb = r & 31; xpose_item(INF(3) + (size_t)l * D * D, D, D, 64 * kb, 32 * nb, WSP(bf16, (l & 1) ? WS_WOUT2 : WS_WOUT), D, 32 * nb, scr, F.lane); continue; } r -= I_OUT;
        if (!moe) {
            if (r < 2 * I_DG) { const int up = r >= I_DG; if (up) r -= I_DG; const int kb = r / 88, nb = r % 88;
                xpose_item8(INF(up ? 28 : 27) + (size_t)fi * D * FFD, FFD, 64 * kb, 32 * nb, WSP(unsigned char, WS_WUP), D, gu_row(32 * nb) + (up ? 128 : 0), qs8, scr, F.lane); continue; } r -= 2 * I_DG;
            { const int kb = r >> 5, nb = r & 31; xpose_item_f8(INF(29) + (size_t)fi * FFD * D, D, FFD, 64 * kb, 32 * nb, WSP(unsigned char, WS_WDN), FFD, 32 * nb, qsd, scr, F.lane); }
        } else {
            const int per = 2 * I_MG + I_MD; const int e = r / per; r -= e * per;
            if (r < 2 * I_MG) { const int up = r >= I_MG; if (up) r -= I_MG; const int kb = r / 44, nb = r % 44;
                xpose_item8(INF(up ? 32 : 31) + (size_t)(fi * NE + e) * D * FFE, FFE, 64 * kb, 32 * nb, WSP(unsigned char, WS_WUP) + (size_t)e * 2 * FFE * D, D, gu_row(32 * nb) + (up ? 128 : 0), qs8, scr, F.lane); continue; } r -= 2 * I_MG;
            { const int kb = r >> 5, nb = r & 31; xpose_item_f8(INF(33) + (size_t)(fi * NE + e) * FFE * D, D, FFE, 64 * kb, 32 * nb, WSP(unsigned char, WS_WDN) + (size_t)e * D * FFEP, FFEP, 32 * nb, qsd, scr, F.lane); }
        }
    }
    if (PART == 0) {
        const int gt = F.vcu * NWAVES * 64 + F.tid; int NT = F.G * NWAVES * 64; asm volatile("" : "+s"(NT));     const float* win = INF(2) + (size_t)l * D * INC; const float* gw2 = INF(10) + l * 16 * 128; bf16* WT = WSP(bf16, WS_WIN);
        for (int e = gt; e < 128 * D; e += NT) { const int n = e >> 10, d = e & 1023; const float* wr = win + (size_t)d * INC + (GL_GLR - 0); float a = 0.f;
#pragma unroll
            for (int r = 0; r < 16; ++r) a += wr[r] * gw2[r * 128 + n];
            WT[(size_t)(GL_GX + n) * D + d] = (bf16)f2bf(a); }
        if (l == 0) {
            f32x2_t* CS = WSP(f32x2_t, WS_CS); const int* pos = (const int*)ldptr(F.in, 1);
            for (int e = gt; e < TOK * 32; e += NT) { const int t = e >> 5, i = e & 31; const double rev = (double)pos[t] * INVF2PI[i]; const float fr_ = (float)(rev - floor(rev));
                f32x2_t cs; cs.x = __builtin_amdgcn_cosf(fr_); cs.y = __builtin_amdgcn_sinf(fr_); CS[e] = cs; } }
    }
    if (PART == 0) {
        bf16* LO = WSP(bf16, WS_LORA); const int gt = F.vcu * NWAVES * 64 + F.tid; int NT = F.G * NWAVES * 64; asm volatile("" : "+s"(NT));
        const float* w2 = INF(15) + (size_t)l * 64 * 256; const float* a2 = INF(17) + (size_t)l * 64 * 256; const float* g2 = INF(18) + (size_t)l * 160 * 256;
        for (int e = gt; e < LO_END; e += NT) { float v;
            if (e < LO_A2) { const int n = e >> 6, k = e & 63; v = w2[k * 256 + n]; }
            else if (e < LO_G2) { const int q = e - LO_A2, n = q >> 6, k = q & 63; v = a2[k * 256 + n]; }
            else if (e < LO_V1) { const int q = e - LO_G2, n = q / 160, k = q - n * 160; v = g2[k * 256 + n]; }
            else if (e < LO_V2) { const int q = e - LO_V1, n = q >> 8, k = q & 255; v = (l > 0) ? (INF(25) + (size_t)(l - 1) * 256 * 32)[k * 32 + n] : 0.f; }
            else { const int q = e - LO_V2, n = q >> 5, k = q & 31; v = (l > 0) ? (INF(26) + (size_t)(l - 1) * 32 * 256)[k * 256 + n] : 0.f; }
            LO[e] = (bf16)f2bf(v); }
    }
    if (PART == 0 && l == 0) {
        const float* x = INF(0); bf16* hb = WSP(bf16, WS_HB);
        for (int m = gw; m < TOK; m += NGW) {
            const GAS f32x4* xr = (const GAS f32x4*)(x + (size_t)m * D) + F.lane; GAS f32x4* hr = (GAS f32x4*)(F.h + (size_t)m * D) + F.lane; GAS v2u* o8 = (GAS v2u*)(hb + (size_t)m * D) + F.lane;
#pragma unroll
            for (int j = 0; j < 4; ++j) { const f32x4 v = xr[64 * j]; v2u w; w.x = pk2(v.x, v.y); w.y = pk2(v.z, v.w); o8[64 * j] = w; }
        }
    }
}
__device__ __forceinline__ void phase_absmax(Frame& F, int l) {
    const bool moe = (l & 1); const int fi = l >> 1;
    const int n4 = (moe ? NE * D * FFE : D * FFD) / 4;
    const GAS f32x4* g = (const GAS f32x4*)INF(moe ? 31 : 27) + (size_t)fi * n4; const GAS f32x4* u = (const GAS f32x4*)INF(moe ? 32 : 28) + (size_t)fi * n4; const GAS f32x4* dn = (const GAS f32x4*)INF(moe ? 33 : 29) + (size_t)fi * n4;
    const int gt = F.vcu * NWAVES * 64 + F.tid; int NT = F.G * NWAVES * 64; asm volatile("" : "+s"(NT));
    f32x4 mx = (f32x4){0.f, 0.f, 0.f, 0.f}, md = mx;
    for (int i = gt; i < n4; i += 3 * NT) {
        f32x4 a[3], b[3], c[3];
#pragma unroll
        for (int j = 0; j < 3; ++j) { const int ij = (i + j * NT < n4) ? i + j * NT : i; a[j] = g[ij]; b[j] = u[ij]; c[j] = dn[ij]; }
#pragma unroll
        for (int j = 0; j < 3; ++j) { mx = __builtin_elementwise_max(mx, __builtin_elementwise_max(__builtin_elementwise_abs(a[j]), __builtin_elementwise_abs(b[j]))); md = __builtin_elementwise_max(md, __builtin_elementwise_abs(c[j])); }
    }
    const float m = wave_max(fmaxf(fmaxf(mx.x, mx.y), fmaxf(mx.z, mx.w))), m2 = wave_max(fmaxf(fmaxf(md.x, md.y), fmaxf(md.z, md.w)));
    if (F.lane == 0) { __hip_atomic_fetch_max((unsigned*)(F.ctl + CW_AMAX + l * 64), __float_as_uint(m), RLX_AGENT); __hip_atomic_fetch_max((unsigned*)(F.ctl + CW_AMAXD + l * 64), __float_as_uint(m2), RLX_AGENT); }
}
template <int NKS> __device__ __forceinline__ void rw_mm16(f32x4 (&acc)[2][4], const LAS bf16* X, int ldx, int mb0, const bf16* BT, int hh, int lane) {
    const int fr = lane & 15, fq = lane >> 4; constexpr int K = 32 * NKS;
    bf16x8 bfr[NKS][4];
#pragma unroll
    for (int ks = 0; ks < NKS; ++ks)
#pragma unroll
        for (int nb = 0; nb < 4; ++nb) bfr[ks][nb] = *(const GAS bf16x8*)(BT + (size_t)(64 * hh + 16 * nb + fr) * K + 32 * ks + 8 * fq);
#pragma unroll
    for (int ks = 0; ks < NKS; ++ks)
#pragma unroll
        for (int mi = 0; mi < 2; ++mi) { const bf16x8 a = *(const LAS bf16x8*)(X + (16 * (mb0 + mi) + fr) * ldx + 32 * ks + 8 * fq);
#pragma unroll
            for (int nb = 0; nb < 4; ++nb) acc[mi][nb] = __builtin_amdgcn_mfma_f32_16x16x32_bf16(a, bfr[ks][nb], acc[mi][nb], 0, 0, 0); }
}
__device__ __forceinline__ void rwprep_tile(Frame& F, int l, int tile) {
    const bf16* P = WSP(const bf16, WS_P);
    const float* mu = INF(13) + l * 1056;
    LAS bf16* X1 = (LAS bf16*)F.lds; LAS bf16* X2 = X1 + 64 * 72; LAS bf16* X3 = X2 + 64 * 72; LAS bf16* XV = X3 + 64 * 168; LAS bf16* X5 = XV + 64 * 264; LAS bf16* XK = X5 + 64 * 40;
    float* RWW = WSP(float, WS_RWW); bf16* RWR = WSP(bf16, WS_RWR); bf16* RWK = WSP(bf16, WS_RWK); bf16* RWV = WSP(bf16, WS_RWV);
    bf16* RWKK = WSP(bf16, WS_RWKK); bf16* RWB = WSP(bf16, WS_RWB); bf16* RWG = WSP(bf16, WS_RWG); bf16* VF = WSP(bf16, WS_VF);
    const bf16* LORA = WSP(const bf16, WS_LORA);
    int tid_ = F.tid; asm volatile("" : "+v"(tid_));
    const int lane_ = tid_ & 63, wave_ = __builtin_amdgcn_readfirstlane(tid_ >> 6);
    const int fr = lane_ & 15, fq = lane_ >> 4, hh = wave_ & 3, mb0 = 2 * (wave_ >> 2);
    const int t0 = tile * 64;
#pragma unroll
    for (int half = 0; half < 2; ++half) {
        v4u rc[9], rp[9];
#pragma unroll
        for (int i = 0; i < 9; ++i) { const int g = tid_ + (half * 9 + i) * 512; rc[i] = (v4u){0u, 0u, 0u, 0u}; rp[i] = rc[i];
            if (g < 64 * 132) { const int tt = g / 132, cg = g - tt * 132, t = t0 + tt; const int col = RW_BASE + 8 * (cg < 36 ? 96 + cg : cg < 68 ? cg - 36 : cg < 100 ? 64 + (cg - 68) : 32 + (cg - 100));
                rc[i] = *(const GAS v4u*)(P + (size_t)t * NP + col); if ((t & (SEQ - 1)) != 0) rp[i] = *(const GAS v4u*)(P + (size_t)(t - 1) * NP + col); } }
#pragma unroll
        for (int i = 0; i < 9; ++i) { const int g = tid_ + (half * 9 + i) * 512;
            if (g < 64 * 132) { const int tt = g / 132, cg = g - tt * 132, t = t0 + tt; const int rel = 8 * (cg < 36 ? 96 + cg : cg < 68 ? cg - 36 : cg < 100 ? 64 + (cg - 68) : 32 + (cg - 100));
                const f32x4 m0 = *(const GAS f32x4*)(mu + rel), m1 = *(const GAS f32x4*)(mu + rel + 4); const float m[8] = {m0.x, m0.y, m0.z, m0.w, m1.x, m1.y, m1.z, m1.w};
                float cv[8], pv[8], xs[8]; unpack8(rc[i], cv); unpack8(rp[i], pv);
#pragma unroll
                for (int j = 0; j < 8; ++j) xs[j] = cv[j] + (pv[j] - cv[j]) * m[j];
                if (cg < 8) {
#pragma unroll
                    for (int j = 0; j < 8; ++j) { const float e2 = __expf(2.f * xs[j]); xs[j] = 1.f - 2.f * __builtin_amdgcn_rcpf(e2 + 1.f); }
                    *(LAS v4u*)(X1 + tt * 72 + 8 * cg) = pack8(xs);
                } else if (cg < 16) { *(LAS v4u*)(X2 + tt * 72 + 8 * (cg - 8)) = pack8(xs);
                } else if (cg < 36) {
#pragma unroll
                    for (int j = 0; j < 8; ++j) xs[j] = sigm(xs[j]);
                    *(LAS v4u*)(X3 + tt * 168 + 8 * (cg - 16)) = pack8(xs);
                } else if (cg < 68) { *(GAS v4u*)(RWR + (size_t)t * 256 + 8 * (cg - 36)) = pack8(xs);
                } else if (cg < 100) { const v4u w = pack8(xs); *(LAS v4u*)(XV + tt * 264 + 8 * (cg - 68)) = w;
                    if (l == 0) { *(GAS v4u*)(RWV + (size_t)t * 256 + 8 * (cg - 68)) = w; *(GAS v4u*)(VF + (size_t)t * 256 + 8 * (cg - 68)) = w; }
                } else { *(LAS v4u*)(XK + tt * 264 + 8 * (cg - 100)) = pack8(xs); } } }
    }
    __syncthreads();
    {   f32x4 acc[2][4];
#pragma unroll
        for (int mi = 0; mi < 2; ++mi)
#pragma unroll
            for (int nb = 0; nb < 4; ++nb) acc[mi][nb] = (f32x4){0.f, 0.f, 0.f, 0.f};
        rw_mm16<2>(acc, X1, 72, mb0, LORA + LO_W2, hh, lane_);
        const float* w0 = INF(14) + l * 256;
#pragma unroll
        for (int mi = 0; mi < 2; ++mi)
#pragma unroll
            for (int nb = 0; nb < 4; ++nb) { const int col = 64 * hh + 16 * nb + fr; const float w0c = w0[col];
#pragma unroll
                for (int r = 0; r < 4; ++r) { const int t = t0 + 16 * (mb0 + mi) + 4 * fq + r; RWW[(size_t)t * 256 + col] = -0.6065306597126334f * sigm(acc[mi][nb][r] + w0c);     } }
#pragma unroll
        for (int mi = 0; mi < 2; ++mi)
#pragma unroll
            for (int nb = 0; nb < 4; ++nb) acc[mi][nb] = (f32x4){0.f, 0.f, 0.f, 0.f};
        rw_mm16<2>(acc, X2, 72, mb0, LORA + LO_A2, hh, lane_);
        const float* a0 = INF(16) + l * 256; const float* kkw = INF(19) + l * 256; const float* kaw = INF(20) + l * 256;
#pragma unroll
        for (int mi = 0; mi < 2; ++mi) {
            float kr[4][4], kq[4][4], ssq[4] = {0.f, 0.f, 0.f, 0.f};
#pragma unroll
            for (int nb = 0; nb < 4; ++nb) { const int col = 64 * hh + 16 * nb + fr; const float kkc = kkw[col];
#pragma unroll
                for (int r = 0; r < 4; ++r) { const int row = 16 * (mb0 + mi) + 4 * fq + r; kr[nb][r] = bf1(XK[row * 264 + col]); kq[nb][r] = kr[nb][r] * kkc; ssq[r] += kq[nb][r] * kq[nb][r]; } }
#pragma unroll
            for (int r = 0; r < 4; ++r) { ssq[r] = sum16(ssq[r]); ssq[r] = 1.0f / fmaxf(sqrtf(ssq[r]), 1e-12f); }
#pragma unroll
            for (int nb = 0; nb < 4; ++nb) { const int col = 64 * hh + 16 * nb + fr; const float a0c = a0[col], kac = kaw[col];
#pragma unroll
                for (int r = 0; r < 4; ++r) { const int t = t0 + 16 * (mb0 + mi) + 4 * fq + r; const float a = sigm(acc[mi][nb][r] + a0c); const float kk = kq[nb][r] * ssq[r];
                    const size_t o = (size_t)t * 256 + col; RWKK[o] = (bf16)f2bf(kk); RWB[o] = (bf16)f2bf(kk * a); RWK[o] = (bf16)f2bf(kr[nb][r] * (1.f + (a - 1.f) * kac)); } }
        }
#pragma unroll
        for (int mi = 0; mi < 2; ++mi)
#pragma unroll
            for (int nb = 0; nb < 4; ++nb) acc[mi][nb] = (f32x4){0.f, 0.f, 0.f, 0.f};
        rw_mm16<5>(acc, X3, 168, mb0, LORA + LO_G2, hh, lane_);
#pragma unroll
        for (int mi = 0; mi < 2; ++mi)
#pragma unroll
            for (int nb = 0; nb < 4; ++nb) { const int col = 64 * hh + 16 * nb + fr;
#pragma unroll
                for (int r = 0; r < 4; ++r) { const int t = t0 + 16 * (mb0 + mi) + 4 * fq + r; RWG[(size_t)t * 256 + col] = (bf16)f2bf(acc[mi][nb][r]); } }
    }
    if (l > 0) {
        const float* v0 = INF(24) + (l - 1) * 256; const bf16* v1T = LORA + LO_V1; const bf16* v2T = LORA + LO_V2;
        {
            const int mb = wave_ & 3, nb = wave_ >> 2; f32x4 a4 = (f32x4){0.f, 0.f, 0.f, 0.f}; bf16x8 bv[8];
#pragma unroll
            for (int ks = 0; ks < 8; ++ks) bv[ks] = *(const GAS bf16x8*)(v1T + (size_t)(16 * nb + fr) * 256 + 32 * ks + 8 * fq);
#pragma unroll
            for (int ks = 0; ks < 8; ++ks) a4 = __builtin_amdgcn_mfma_f32_16x16x32_bf16(*(const LAS bf16x8*)(XV + (16 * mb + fr) * 264 + 32 * ks + 8 * fq), bv[ks], a4, 0, 0, 0);
#pragma unroll
            for (int r = 0; r < 4; ++r) X5[(16 * mb + 4 * fq + r) * 40 + 16 * nb + fr] = (bf16)f2bf(a4[r]);
        }
        __syncthreads();
        {   f32x4 acc[2][4];
#pragma unroll
            for (int mi = 0; mi < 2; ++mi)
#pragma unroll
                for (int nb = 0; nb < 4; ++nb) acc[mi][nb] = (f32x4){0.f, 0.f, 0.f, 0.f};
            rw_mm16<1>(acc, X5, 40, mb0, v2T, hh, lane_);
#pragma unroll
            for (int mi = 0; mi < 2; ++mi)
#pragma unroll
                for (int nb = 0; nb < 4; ++nb) { const int col = 64 * hh + 16 * nb + fr; const float v0c = v0[col];
#pragma unroll
                    for (int r = 0; r < 4; ++r) { const int row = 16 * (mb0 + mi) + 4 * fq + r; const size_t o = (size_t)(t0 + row) * 256 + col;
                        const float xv = bf1(XV[row * 264 + col]); const float vf = bf1(VF[o]); RWV[o] = (bf16)f2bf(xv + (vf - xv) * sigm(acc[mi][nb][r] + v0c)); } }
        }
    }
    __syncthreads();
}
constexpr int CB = 64 * 66;
constexpr int HB_ = 64 * 72;
constexpr int PRE_H0 = 3 * CB * 4;
constexpr int PV_OFF = (PRE_H0 + 10 * HB_ * 2) / 4;
constexpr int REC_RW = 53760, REC_GL = 16640;
constexpr int RO_QH = 0, RO_AT = 8192, RO_BH = 16384, RO_TT = 24576, RO_MRB = 30720, RO_GAM = 36864, RO_VB = 37376;
constexpr int RO_Y = 0, RO_SK = 0;
constexpr int GO_QH = 0, GO_SK = 8192, GO_GAM = 16384;
#define PBUF(i) ((LAS float*)F.lds + (i) * CB)
#define HBUF(i) ((LAS bf16*)(F.lds + PRE_H0) + (i) * HB_)
__device__ __forceinline__ void nt16(f32x4 (&acc)[2], const LAS bf16* X, const LAS bf16* Y, int mb, int nb0, int lane) {
    const int fr = lane & 15, fq = lane >> 4;
    acc[0] = (f32x4){0.f, 0.f, 0.f, 0.f}; acc[1] = acc[0];
#pragma unroll
    for (int ks = 0; ks < 2; ++ks) { const bf16x8 a = *(const LAS bf16x8*)(X + (16 * mb + fr) * 72 + 32 * ks + 8 * fq);
        const bf16x8 b0 = *(const LAS bf16x8*)(Y + (16 * nb0 + fr) * 72 + 32 * ks + 8 * fq), b1 = *(const LAS bf16x8*)(Y + (16 * nb0 + 16 + fr) * 72 + 32 * ks + 8 * fq);
        acc[0] = __builtin_amdgcn_mfma_f32_16x16x32_bf16(a, b0, acc[0], 0, 0, 0); acc[1] = __builtin_amdgcn_mfma_f32_16x16x32_bf16(a, b1, acc[1], 0, 0, 0); }
}
typedef short v4i16_t __attribute__((ext_vector_type(4)));
__device__ __forceinline__ v2u trr(const LAS bf16* p) { return __builtin_bit_cast(v2u, __builtin_amdgcn_ds_read_tr16_b64_v4i16((LAS v4i16_t*)p)); }
__device__ __forceinline__ bf16x8 trfrag(const LAS bf16* M, int c, int ks, int lane) {
    const int g = lane >> 4, q = (lane & 15) >> 2, p = lane & 3; const LAS bf16* a = M + (32 * ks + 8 * g + q) * 72 + 16 * c + 4 * p;
    const v2u lo = trr(a), hi = trr(a + 4 * 72); v4u w; w.x = lo.x; w.y = lo.y; w.z = hi.x; w.w = hi.y; return __builtin_bit_cast(bf16x8, w);
}
__device__ __forceinline__ void tn16(f32x4 (&acc)[2], const LAS bf16* X, const LAS bf16* Y, int mb, int nb0, int lane) {
    acc[0] = (f32x4){0.f, 0.f, 0.f, 0.f}; acc[1] = acc[0];
#pragma unroll
    for (int ks = 0; ks < 2; ++ks) { const bf16x8 a = trfrag(X, mb, ks, lane), b0 = trfrag(Y, nb0, ks, lane), b1 = trfrag(Y, nb0 + 1, ks, lane);
        acc[0] = __builtin_amdgcn_mfma_f32_16x16x32_bf16(a, b0, acc[0], 0, 0, 0); acc[1] = __builtin_amdgcn_mfma_f32_16x16x32_bf16(a, b1, acc[1], 0, 0, 0); }
}
__device__ __forceinline__ void nn16(f32x4 (&acc)[2], const LAS bf16* A, const LAS bf16* B, int mb, int nb0, int lane) {
    const int fr = lane & 15, fq = lane >> 4;
    acc[0] = (f32x4){0.f, 0.f, 0.f, 0.f}; acc[1] = acc[0];
#pragma unroll
    for (int ks = 0; ks < 2; ++ks) { const bf16x8 a = *(const LAS bf16x8*)(A + (16 * mb + fr) * 72 + 32 * ks + 8 * fq), b0 = trfrag(B, nb0, ks, lane), b1 = trfrag(B, nb0 + 1, ks, lane);
        acc[0] = __builtin_amdgcn_mfma_f32_16x16x32_bf16(a, b0, acc[0], 0, 0, 0); acc[1] = __builtin_amdgcn_mfma_f32_16x16x32_bf16(a, b1, acc[1], 0, 0, 0); }
}
__device__ __forceinline__ void hfrag_tr(const LAS bf16* M, unsigned char* dst, int wave, int lane) {
    const int mb = wave >> 1, ks = wave & 1, g = lane >> 4, q = (lane & 15) >> 2, p = lane & 3; const LAS bf16* a = M + (32 * ks + 4 * g + q) * 72 + 16 * mb + 4 * p;
    const v2u lo = trr(a), hi = trr(a + 16 * 72); v4u w; w.x = lo.x; w.y = lo.y; w.z = hi.x; w.w = hi.y;
    *(GAS v4u*)(dst + ((size_t)wave * 64 + lane) * 16) = w;
}
template <int MASK> __device__ __forceinline__ void hst(const f32x4 (&acc)[2], LAS bf16* S, int mb, int nb0, int lane) {
    const int fr = lane & 15, fq = lane >> 4;
#pragma unroll
    for (int n = 0; n < 2; ++n)
#pragma unroll
        for (int r = 0; r < 4; ++r) { const int row = 16 * mb + 4 * fq + r, col = 16 * (nb0 + n) + fr; float v = acc[n][r];
            if (MASK == 1 && col > row) v = 0.f; if (MASK == 2 && col >= row) v = 0.f; S[row * 72 + col] = (bf16)f2bf(v); }
}
template <int MASK> __device__ __forceinline__ void cst(const f32x4 (&acc)[2], LAS float* S, int mb, int nb0, int lane) {
    const int fr = lane & 15, fq = lane >> 4;
#pragma unroll
    for (int n = 0; n < 2; ++n)
#pragma unroll
        for (int r = 0; r < 4; ++r) { const int row = 16 * mb + 4 * fq + r, col = 16 * (nb0 + n) + fr; float v = acc[n][r];
            if (MASK == 1 && col > row) v = 0.f; if (MASK == 2 && col >= row) v = 0.f; S[row * 66 + col] = v; }
}
__device__ __forceinline__ void hfrag(const LAS bf16* M, const LAS float* colscale, unsigned char* dst, int wave, int lane, int slot = -2) {
    const int mb = wave >> 1, ks = wave & 1, i = lane & 15, q = lane >> 4; const LAS bf16* rowp = M + (16 * mb + i) * 72 + 32 * ks + 4 * q;
    const v2u lo = *(const LAS v2u*)rowp, hi = *(const LAS v2u*)(rowp + 16);
    v4u w; w.x = lo.x; w.y = lo.y; w.z = hi.x; w.w = hi.y;
    if (colscale) { float e[8]; unpack8(w, e); const f32x4 s0 = *(const LAS f32x4*)(colscale + 32 * ks + 4 * q), s1 = *(const LAS f32x4*)(colscale + 32 * ks + 16 + 4 * q);
        e[0] *= s0.x; e[1] *= s0.y; e[2] *= s0.z; e[3] *= s0.w; e[4] *= s1.x; e[5] *= s1.y; e[6] *= s1.z; e[7] *= s1.w; w = pack8(e); }
    if (slot == -2) slot = wave; if (slot >= 0) *(GAS v4u*)(dst + ((size_t)slot * 64 + lane) * 16) = w;
}
__device__ __forceinline__ void cfrag(const LAS float* M, unsigned char* dst, int wave, int lane, int slot) {
    const int mb = wave >> 1, ks = wave & 1, i = lane & 15, q = lane >> 4; float e[8];
#pragma unroll
    for (int jj = 0; jj < 8; ++jj) { const int rho = 32 * ks + (jj < 4 ? 4 * q + jj : 16 + 4 * q + jj - 4); e[jj] = M[(16 * mb + i) * 66 + rho]; }
    if (slot >= 0) *(GAS v4u*)(dst + ((size_t)slot * 64 + lane) * 16) = pack8(e);
}
__device__ __forceinline__ void cacc(const f32x4 (&acc)[2], const LAS float* rowscale, unsigned char* dst, int mb, int nb0, int lane, int vbs = 2048) {
    const int fq = lane >> 4;
#pragma unroll
    for (int n = 0; n < 2; ++n) { float v[4];
#pragma unroll
        for (int r = 0; r < 4; ++r) { v[r] = acc[n][r]; if (rowscale) v[r] *= rowscale[16 * mb + 4 * fq + r]; }
        v2u w; w.x = pk2(v[0], v[1]); w.y = pk2(v[2], v[3]); *(GAS v2u*)(dst + (size_t)(nb0 + n) * vbs + ((size_t)mb * 64 + lane) * 8) = w; }
}
__device__ __forceinline__ void ccumsum(Frame& F, LAS float* CU) {
    LAS float* vec = (LAS float*)F.lds + PV_OFF; LAS float* seg = vec + 128;
    { float run = 0.f;
#pragma unroll
      for (int i = 0; i < 8; ++i) { run += CU[(8 * F.wave + i) * 66 + F.lane]; CU[(8 * F.wave + i) * 66 + F.lane] = run; }
      seg[F.wave * 64 + F.lane] = run; }
    LDS_BARRIER();
    { float off = 0.f;
#pragma unroll
      for (int w = 0; w < 8; ++w) if (w < F.wave) off += seg[w * 64 + F.lane];
#pragma unroll
      for (int i = 0; i < 8; ++i) { const float c = CU[(8 * F.wave + i) * 66 + F.lane] + off; CU[(8 * F.wave + i) * 66 + F.lane] = c; if (8 * F.wave + i == 31) vec[F.lane] = c; if (8 * F.wave + i == 63) vec[64 + F.lane] = c; } }
    LDS_BARRIER();
}
__device__ __forceinline__ f32x4 blk16(f32x4 acc, const LAS float* A, int ar0, int ac0, const LAS float* B, int br0, int bc0, int lane) {
    const int fr = lane & 15, fq = lane >> 4;
#pragma unroll
    for (int s = 0; s < 4; ++s) acc = __builtin_amdgcn_mfma_f32_16x16x4f32(A[(ar0 + fr) * 66 + ac0 + 4 * s + fq], B[(br0 + 4 * s + fq) * 66 + bc0 + fr], acc, 0, 0, 0);
    return acc;
}
__device__ __forceinline__ void blkst(const f32x4 acc, LAS float* S, int r0, int c0, int lane) {
    const int fr = lane & 15, fq = lane >> 4;
#pragma unroll
    for (int r = 0; r < 4; ++r) S[(r0 + 4 * fq + r) * 66 + c0 + fr] = acc[r];
}
__device__ __forceinline__ void tri_inverse(Frame& F, const LAS float* L, LAS float* T, LAS float* W) {
    for (int e = F.tid; e < 64 * 64; e += NWAVES * 64) { const int i = e >> 6, j = e & 63; if ((i >> 4) != (j >> 4)) T[i * 66 + j] = 0.f; }
    if (F.wave == 0) {
        const int d0 = 16 * (F.lane >> 4), c = F.lane & 15; float t[16];
#pragma unroll
        for (int i = 0; i < 16; ++i) { float a = (i == c) ? 1.f : 0.f;
#pragma unroll
            for (int j = 0; j < i; ++j) a += L[(d0 + i) * 66 + d0 + j] * t[j];
            t[i] = a; T[(d0 + i) * 66 + d0 + c] = a; }
    }
    LDS_BARRIER();
#pragma unroll
    for (int d = 1; d <= 3; ++d) {
        if (F.wave < 4 - d) { const int i = d + F.wave, j = F.wave; f32x4 acc = (f32x4){0.f, 0.f, 0.f, 0.f};
#pragma unroll
            for (int k = 0; k < 3; ++k) if (k >= j && k < i) acc = blk16(acc, L, 16 * i, 16 * k, T, 16 * k, 16 * j, F.lane);
            blkst(acc, W, 16 * i, 16 * j, F.lane); }
        LDS_BARRIER();
        if (F.wave < 4 - d) { const int i = d + F.wave, j = F.wave; f32x4 acc = (f32x4){0.f, 0.f, 0.f, 0.f};
            acc = blk16(acc, T, 16 * i, 16 * i, W, 16 * i, 16 * j, F.lane); blkst(acc, T, 16 * i, 16 * j, F.lane); }
        LDS_BARRIER();
    }
}
struct PreRaw { unsigned x[6][8]; f32x2_t cs[8]; };
__device__ __forceinline__ unsigned ldh(const bf16* p) { return (unsigned)*(const GAS bf16*)p; }
#define WSQ(T, off) ((T*)(ws_ + (off)))
__device__ __forceinline__ void pre_load(Frame& F, PreRaw& R, const int MIX, int b, int h, int c) {
    int tid_ = F.tid; asm volatile("" : "+v"(tid_));
    unsigned char* ws_ = F.ws; asm volatile("" : "+s"(ws_));
    const int k = tid_ & 63, w = tid_ >> 6, t0 = b * SEQ + c * 64 + 8 * w;
    const bf16* P = WSQ(const bf16, WS_P) + (size_t)t0 * NP;
#pragma unroll
    for (int s = 0; s < 6; ++s)
#pragma unroll
        for (int i = 0; i < 8; ++i) R.x[s][i] = 0u;
    if (MIX == 0) {
#pragma unroll
        for (int i = 0; i < 8; ++i) { R.x[0][i] = ldh(P + (size_t)i * NP + HG_F + 64 * h + k); R.x[1][i] = ldh(P + (size_t)i * NP + HG_Q + 64 * h + k); R.x[2][i] = ldh(P + (size_t)i * NP + HG_I + 64 * h + k); }
    } else if (MIX == 1) {
#pragma unroll
        for (int i = 0; i < 8; ++i) { R.x[2][i] = ldh(P + (size_t)i * NP + GL_V + 64 * h + k);
            if (k < 32) { R.x[0][i] = ldh(P + (size_t)i * NP + GL_GX + 32 * h + k); R.x[1][i] = ldh(P + (size_t)i * NP + GL_Q + 32 * h + k); R.x[3][i] = ldh(P + (size_t)i * NP + GL_K + 32 * h + k); } }
    } else if (MIX == 2) { const size_t o = (size_t)t0 * 256 + 64 * h + k;
#pragma unroll
        for (int i = 0; i < 8; ++i) { R.x[0][i] = __float_as_uint(*(const GAS float*)(WSQ(const float, WS_RWW) + o + i * 256)); R.x[1][i] = ldh(WSQ(const bf16, WS_RWR) + o + i * 256); R.x[2][i] = ldh(WSQ(const bf16, WS_RWV) + o + i * 256);
            R.x[3][i] = ldh(WSQ(const bf16, WS_RWK) + o + i * 256); R.x[4][i] = ldh(WSQ(const bf16, WS_RWKK) + o + i * 256); R.x[5][i] = ldh(WSQ(const bf16, WS_RWB) + o + i * 256); }
    } else { const int k31 = k & 31; const f32x2_t* CS = WSQ(const f32x2_t, WS_CS) + (size_t)t0 * 32 + k31;
#pragma unroll
        for (int i = 0; i < 8; ++i) { R.x[0][i] = ldh(P + (size_t)i * NP + RT_Q + 64 * h + k31); R.x[1][i] = ldh(P + (size_t)i * NP + RT_Q + 64 * h + 32 + k31); R.x[2][i] = ldh(P + (size_t)i * NP + RT_V + 64 * h + k);
            R.x[3][i] = ldh(P + (size_t)i * NP + RT_K + 64 * h + k31); R.x[4][i] = ldh(P + (size_t)i * NP + RT_K + 64 * h + 32 + k31); R.cs[i] = *(const GAS f32x2_t*)(CS + i * 32); }
    }
}
__device__ __forceinline__ float ubf(unsigned u) { return __uint_as_float(u << 16); }
__device__ __forceinline__ v4u pack8v(const float (&f)[8]) { v4u w; w.x = pk2(f[0], f[1]); w.y = pk2(f[2], f[3]); w.z = pk2(f[4], f[5]); w.w = pk2(f[6], f[7]); return w; }
__device__ __forceinline__ void hfrag_trs(const LAS bf16* M, const LAS float* scale, unsigned char* dst, int wave, int lane) {
    const int mb = wave >> 1, ks = wave & 1, g = lane >> 4, q = (lane & 15) >> 2, p = lane & 3; const LAS bf16* a = M + (32 * ks + 4 * g + q) * 72 + 16 * mb + 4 * p;
    const v2u lo = trr(a), hi = trr(a + 16 * 72); v4u w; w.x = lo.x; w.y = lo.y; w.z = hi.x; w.w = hi.y;
    float e[8]; unpack8(w, e); const f32x4 s0 = *(const LAS f32x4*)(scale + 32 * ks + 4 * g), s1 = *(const LAS f32x4*)(scale + 32 * ks + 16 + 4 * g);
    e[0] *= s0.x; e[1] *= s0.y; e[2] *= s0.z; e[3] *= s0.w; e[4] *= s1.x; e[5] *= s1.y; e[6] *= s1.z; e[7] *= s1.w;
    *(GAS v4u*)(dst + ((size_t)wave * 64 + lane) * 16) = pack8(e);
}
__device__ __forceinline__ void chunk_pre(Frame& F, PreRaw& R, int l, const int MIX, int b, int h, int c, unsigned char* rec, const int nMIX, int nh) {
    const int t0 = b * SEQ + c * 64;
    LAS float* SEG = PBUF(0); LAS float* LL = PBUF(1); LAS float* T32 = PBUF(2); LAS float* WW = PBUF(0);
    LAS bf16* A1 = HBUF(0); LAS bf16* R1 = HBUF(1); LAS bf16* B1 = HBUF(2); LAS bf16* K1 = HBUF(3); LAS bf16* KeT = HBUF(4); LAS bf16* VT = HBUF(5); LAS bf16* BeT = HBUF(6); LAS bf16* M1 = HBUF(7); LAS bf16* M2 = HBUF(8); LAS bf16* M3 = HBUF(9);
    LAS float* vec = (LAS float*)F.lds + PV_OFF; LAS float* ecm = vec + 640;
    int tid_ = F.tid; asm volatile("" : "+v"(tid_));
    unsigned char* ws_ = F.ws; asm volatile("" : "+s"(ws_));
    const int lane_ = tid_ & 63, wave_ = __builtin_amdgcn_readfirstlane(tid_ >> 6);
    const int k_ = lane_;
    const int mb = wave_ >> 1, nb0 = 2 * (wave_ & 1), fr = lane_ & 15, fq = lane_ >> 4;
    float q[8], kx[8], lw[8], v[8], av[8], bv[8];
    if (MIX == 0) {
        const float* lg = INF(8); const int cch = 64 * h + k_;
        const float x0 = lg[cch], x1 = lg[256 + cch], x2 = lg[512 + cch], x3 = lg[768 + cch]; const float mx = fmaxf(fmaxf(x0, x1), fmaxf(x2, x3));
        const float e0 = __expf(x0 - mx), e1 = __expf(x1 - mx), e2 = __expf(x2 - mx), e3 = __expf(x3 - mx);
        const float lb = ((l >= 1 ? e1 : 0.f) + (l >= 2 ? e2 : 0.f) + (l >= 3 ? e3 : 0.f)) / (e0 + e1 + e2 + e3);
#pragma unroll
        for (int i = 0; i < 8; ++i) { const float fr_ = ubf(R.x[0][i]), qr = ubf(R.x[1][i]); const float w = lb + (1.f - lb) * sigm(fr_); lw[i] = __logf(w); kx[i] = 1.f - w; q[i] = qr * sigm(qr); v[i] = ubf(R.x[2][i]); }
    } else if (MIX == 1) {
        const float gb = (k_ < 32) ? (INF(11) + l * 128)[32 * h + k_] : 0.f;
#pragma unroll
        for (int i = 0; i < 8; ++i) { v[i] = ubf(R.x[2][i]);
            if (k_ < 32) { const float x = ubf(R.x[0][i]) + gb; lw[i] = 0.0625f * (fminf(x, 0.f) - __logf(1.f + __expf(-fabsf(x)))); q[i] = ubf(R.x[1][i]) * 0.17677669529663687f; kx[i] = ubf(R.x[3][i]); }
            else { lw[i] = 0.f; q[i] = 0.f; kx[i] = 0.f; } }
    } else if (MIX == 2) {
#pragma unroll
        for (int i = 0; i < 8; ++i) { lw[i] = __uint_as_float(R.x[0][i]); q[i] = ubf(R.x[1][i]); v[i] = ubf(R.x[2][i]); kx[i] = ubf(R.x[3][i]); av[i] = -ubf(R.x[4][i]); bv[i] = ubf(R.x[5][i]); }
    } else {
        const bool hi = k_ >= 32; const float lgam = __logf(1.f - exp2f(-5.f - (float)h));
#pragma unroll
        for (int i = 0; i < 8; ++i) { const float cs_ = R.cs[i].x, sn = R.cs[i].y; const float q1 = ubf(R.x[0][i]), q2 = ubf(R.x[1][i]), k1 = ubf(R.x[3][i]), k2 = ubf(R.x[4][i]);
            q[i] = hi ? (q1 * sn + q2 * cs_) : (q1 * cs_ - q2 * sn); kx[i] = 0.125f * (hi ? (k1 * sn + k2 * cs_) : (k1 * cs_ - k2 * sn)); lw[i] = lgam; v[i] = ubf(R.x[2][i]); }
    }
    float cu[8]; { float run = 0.f;
#pragma unroll
        for (int i = 0; i < 8; ++i) { run += lw[i]; cu[i] = run; }
        SEG[wave_ * 64 + k_] = run; }
    LDS_BARRIER();
    float cm, ce; { float pre = 0.f, tot = 0.f, mid = 0.f;
#pragma unroll
        for (int w = 0; w < 8; ++w) { const float s = SEG[w * 64 + k_]; if (w < wave_) pre += s; if (w < 4) mid += s; tot += s; }
        cm = mid; ce = tot;
#pragma unroll
        for (int i = 0; i < 8; ++i) cu[i] += pre; }
    {   float e1[8], e2[8], e3[8];
#pragma unroll
        for (int i = 0; i < 8; ++i) { const float ef = __expf(fminf(fmaxf(cu[i] - cm, -80.f), 80.f)); e1[i] = q[i] * ef; e2[i] = kx[i] * __builtin_amdgcn_rcpf(ef); e3[i] = kx[i] * __expf(ce - cu[i]); }
        *(LAS v4u*)(R1 + k_ * 72 + 8 * wave_) = pack8v(e1); *(LAS v4u*)(K1 + k_ * 72 + 8 * wave_) = pack8v(e2); *(LAS v4u*)(KeT + k_ * 72 + 8 * wave_) = pack8v(e3); *(LAS v4u*)(VT + k_ * 72 + 8 * wave_) = pack8v(v);
        if (MIX == 2) {
#pragma unroll
            for (int i = 0; i < 8; ++i) { const float ef = __expf(fminf(fmaxf(cu[i] - cm, -80.f), 80.f)); e1[i] = av[i] * __expf(fminf(fmaxf(cu[i] - lw[i] - cm, -80.f), 80.f)); e2[i] = bv[i] * __builtin_amdgcn_rcpf(ef); e3[i] = bv[i] * __expf(ce - cu[i]); }
            *(LAS v4u*)(A1 + k_ * 72 + 8 * wave_) = pack8v(e1); *(LAS v4u*)(B1 + k_ * 72 + 8 * wave_) = pack8v(e2); *(LAS v4u*)(BeT + k_ * 72 + 8 * wave_) = pack8v(e3); }
        if (wave_ == 0) { ecm[k_] = __expf(cm); *(GAS float*)(rec + (MIX == 2 ? RO_GAM : GO_GAM) + 4 * k_) = __expf(ce); }
    }
    LDS_BARRIER();
    if (nMIX >= 0) pre_load(F, R, nMIX, b, nh, c);
    f32x4 acc[2];
    tn16(acc, R1, K1, mb, nb0, lane_); hst<1>(acc, M1, mb, nb0, lane_);
    hfrag_trs(R1, ecm, rec + (MIX == 2 ? RO_QH : GO_QH), wave_, lane_);
    nt16(acc, KeT, VT, mb, nb0, lane_); if (MIX == 2) cacc(acc, nullptr, rec + RO_VB + 2048, mb, nb0, lane_, 4096); else cacc(acc, nullptr, rec + GO_SK, mb, nb0, lane_);
    if (MIX == 2) {
        tn16(acc, A1, B1, mb, nb0, lane_); cst<2>(acc, LL, mb, nb0, lane_);
        tn16(acc, R1, B1, mb, nb0, lane_); hst<1>(acc, M2, mb, nb0, lane_);
        tn16(acc, A1, K1, mb, nb0, lane_); hst<2>(acc, M3, mb, nb0, lane_);
        hfrag_trs(A1, ecm, rec + RO_AT, wave_, lane_);
        hfrag(BeT, nullptr, rec + RO_BH, wave_, lane_);
    }
    LDS_BARRIER();
    nt16(acc, M1, VT, mb, nb0, lane_);
#pragma unroll
    for (int n = 0; n < 2; ++n)
#pragma unroll
        for (int r = 0; r < 4; ++r) A1[(16 * mb + 4 * fq + r) * 72 + 16 * (nb0 + n) + fr] = (bf16)f2bf(acc[n][r]);
    if (MIX == 2) {
        nt16(acc, M3, VT, mb, nb0, lane_); cacc(acc, nullptr, rec + RO_VB, mb, nb0, lane_, 4096);
        const int t6 = ((wave_ & 1) == 1 && (wave_ >> 1) < 2) ? -1 : ((wave_ >> 1) < 2 ? (wave_ >> 1) : 2 + ((wave_ >> 1) - 2) * 2 + (wave_ & 1));
        hfrag(M2, nullptr, rec + RO_MRB, wave_, lane_, t6);
        tri_inverse(F, LL, T32, WW);
        cfrag(T32, rec + RO_TT, wave_, lane_, t6);
    }
    LDS_BARRIER();
}
constexpr size_t WS_REC_RW = 14 * MiB, WS_REC_GL = 412 * MiB;
__device__ __forceinline__ void oloc_flush(Frame& F, int m, int t0, int h) {
    const int t = F.tid >> 3, pc = F.tid & 7; const v4u w = *(const LAS v4u*)(HBUF(0) + t * 72 + 8 * pc);
    *(GAS v4u*)(WSP(bf16, WS_O) + (size_t)m * TOK * 256 + (size_t)(t0 + t) * 256 + 64 * h + 8 * pc) = w;
}
__device__ __forceinline__ unsigned char* pre_rec(Frame& F, int m, int b, int h, int c) {
    return (m == 2) ? F.ws + WS_REC_RW + (size_t)(((b * 4 + h) * 64) + c) * REC_RW : F.ws + WS_REC_GL + (size_t)((((m == 3 ? 2 : m) * 16 + b * 4 + h) * 64) + c) * REC_GL;
}
__device__ __forceinline__ void phase_chunkpre(Frame& F, int l) {
    for (int tile = F.vcu; tile < TOK / 64; tile += F.G) {
        const int b = tile >> 6, c = tile & 63;
        rwprep_tile(F, l, tile);
        __syncthreads();
        PreRaw cur;
        pre_load(F, cur, 0, b, 0, c);
#pragma unroll 1
        for (int i = 0; i < 16; ++i) {
            const int mo = i >> 2, m = (mo == 2) ? 3 : (mo == 3 ? 2 : mo), h = i & 3;
            const int mo2 = (i + 1) >> 2, m2 = (i + 1 < 16) ? ((mo2 == 2) ? 3 : (mo2 == 3 ? 2 : mo2)) : -1;
            chunk_pre(F, cur, l, m, b, h, c, pre_rec(F, m, b, h, c), m2, (i + 1) & 3);
            oloc_flush(F, m, b * SEQ + c * 64, h);
        }
    }
}
__device__ __forceinline__ bf16x8 pack_b(const f32x4 a, const f32x4 b) { v4u w; w.x = pk2(a.x, a.y); w.y = pk2(a.z, a.w); w.z = pk2(b.x, b.y); w.w = pk2(b.z, b.w); return __builtin_bit_cast(bf16x8, w); }
__device__ __forceinline__ f32x4 unpk4(const v2u w) { return (f32x4){bflo(w.x), bfhi(w.x), bflo(w.y), bfhi(w.y)}; }
template <int NF> struct SeqRegs { v4u r[NF]; v4u tail; };
template <int NF, int NLT, bool TAIL> __device__ __forceinline__ void seq_ld(SeqRegs<NF>& R, const unsigned char* rec, int lt) {
    const GAS v4u* src = (const GAS v4u*)rec;
#pragma unroll
    for (int i = 0; i < NF; ++i) R.r[i] = src[i * NLT + lt];
    if (TAIL && lt < 16) R.tail = src[NF * NLT + lt];
}
template <int NF, int NLT, bool TAIL> __device__ __forceinline__ void seq_st(const SeqRegs<NF>& R, LAS unsigned char* slot, int lt) {
    LAS v4u* dst = (LAS v4u*)slot;
#pragma unroll
    for (int i = 0; i < NF; ++i) dst[i * NLT + lt] = R.r[i];
    if (TAIL && lt < 16) dst[NF * NLT + lt] = R.tail;
}
template <bool RW> __device__ __forceinline__ void seq_unit(Frame& F, int mix, int b, int h, int vb_, const unsigned char* recs) {
    constexpr int REC = RW ? REC_RW : REC_GL, SLOT = 61440, NCW = RW ? 1 : 4, LW0 = RW ? 2 : 4, NLT = (8 - LW0) * 64, NF = REC / (NLT * 16); constexpr bool TAIL = (REC % (NLT * 16)) != 0;
    static_assert(REC % (NLT * 16) == 0 || REC % (NLT * 16) == 256, "record = NF loader rounds (+ 256 B)");
    const bool loader = F.wave >= LW0, compute = F.wave < NCW; const int lt = F.tid - 64 * LW0;
    SeqRegs<NF> RA, RB;
    if (loader) { seq_ld<NF, NLT, TAIL>(RA, recs, lt); seq_st<NF, NLT, TAIL>(RA, F.lds, lt); seq_ld<NF, NLT, TAIL>(RB, recs + (size_t)1 * REC, lt); seq_ld<NF, NLT, TAIL>(RA, recs + (size_t)2 * REC, lt); }
    __syncthreads();
    f32x4 S[4];
#pragma unroll
    for (int kb = 0; kb < 4; ++kb) S[kb] = (f32x4){0.f, 0.f, 0.f, 0.f};
    const int vb = RW ? vb_ : (F.wave & 3), fr = F.lane & 15, fq = F.lane >> 4;
    bf16* Og_ = WSP(bf16, WS_OI) + OI_GEN + (size_t)(((mix == 3 ? 2 : mix) * 16 + b * 4 + h)) * (SEQ * 64);
    constexpr int OSO = 122880;
#define SEQ_FLUSH(cc) do { const LAS unsigned char* osr_ = F.lds + OSO + ((cc) & 1) * 8192 + (16 * vb + (F.lane >> 2)) * 128 + (F.lane & 3) * 32; bf16* dst_ = Og_ + ((size_t)(cc) * 64 + 16 * vb + (F.lane >> 2)) * 64 + (F.lane & 3) * 16; \
        const v4u a_ = *(const LAS v4u*)osr_, b_ = *(const LAS v4u*)(osr_ + 16); *(GAS v4u*)dst_ = a_; *(GAS v4u*)(dst_ + 8) = b_; } while (0)
#pragma unroll 1
    for (int c2 = 0; c2 < 64; c2 += 2) {
#pragma unroll
        for (int par = 0; par < 2; ++par) {
            const int c = c2 + par;
            if (loader) {
                if (par == 0) { seq_st<NF, NLT, TAIL>(RB, F.lds + SLOT, lt); if (c + 3 < 64) seq_ld<NF, NLT, TAIL>(RB, recs + (size_t)(c + 3) * REC, lt); }
                else { if (c + 1 < 64) seq_st<NF, NLT, TAIL>(RA, F.lds, lt); if (c + 3 < 64) seq_ld<NF, NLT, TAIL>(RA, recs + (size_t)(c + 3) * REC, lt); }
            } else if (compute) {
                const LAS unsigned char* R = F.lds + par * SLOT;
                const f32x4 z = (f32x4){0.f, 0.f, 0.f, 0.f};
                if (c > 0) SEQ_FLUSH(c - 1);
                bf16x8 fqh[8];
#pragma unroll
                for (int f = 0; f < 8; ++f) fqh[f] = *(const LAS bf16x8*)(R + (RW ? RO_QH : GO_QH) + (f * 64 + F.lane) * 16);
                bf16x8 bS[2]; bS[0] = pack_b(S[0], S[1]); bS[1] = pack_b(S[2], S[3]);
                asm volatile("s_waitcnt lgkmcnt(0)" ::: "memory"); __builtin_amdgcn_sched_barrier(0);
                f32x4 O[4]; bf16x8 bU[2];
#pragma unroll
                for (int mb = 0; mb < 4; ++mb) { O[mb] = z;
#pragma unroll
                    for (int ks = 0; ks < 2; ++ks) O[mb] = __builtin_amdgcn_mfma_f32_16x16x32_bf16(fqh[mb * 2 + ks], bS[ks], O[mb], 0, 0, 0); }
                if (RW) {
                    f32x4 X[4], U[4];
#pragma unroll
                    for (int mb = 0; mb < 4; ++mb) { X[mb] = unpk4(*(const LAS v2u*)(R + RO_Y + ((vb * 4 + mb) * 64 + F.lane) * 8));
#pragma unroll
                        for (int ks = 0; ks < 2; ++ks) X[mb] = __builtin_amdgcn_mfma_f32_16x16x32_bf16(*(const LAS bf16x8*)(R + RO_AT + ((mb * 2 + ks) * 64 + F.lane) * 16), bS[ks], X[mb], 0, 0, 0); }
                    bf16x8 bX[2]; bX[0] = pack_b(X[0], X[1]); bX[1] = pack_b(X[2], X[3]);
#pragma unroll
                    for (int mb = 0; mb < 4; ++mb) { U[mb] = z;
#pragma unroll
                        for (int ks = 0; ks < 2; ++ks) if (!(ks == 1 && mb < 2)) U[mb] = __builtin_amdgcn_mfma_f32_16x16x32_bf16(*(const LAS bf16x8*)(R + RO_TT + ((mb * 2 + ks) * 64 + F.lane) * 16), bX[ks], U[mb], 0, 0, 0); }
                    bU[0] = pack_b(U[0], U[1]); bU[1] = pack_b(U[2], U[3]);
#pragma unroll
                    for (int mb = 0; mb < 4; ++mb)
#pragma unroll
                        for (int ks = 0; ks < 2; ++ks) if (!(ks == 1 && mb < 2)) O[mb] = __builtin_amdgcn_mfma_f32_16x16x32_bf16(*(const LAS bf16x8*)(R + RO_MRB + ((mb * 2 + ks) * 64 + F.lane) * 16), bU[ks], O[mb], 0, 0, 0);
                }
#pragma unroll
                for (int kb = 0; kb < 4; ++kb) { const f32x4 g = *(const LAS f32x4*)(R + (RW ? RO_GAM : GO_GAM) + (16 * kb + 4 * fq) * 4); const f32x4 sk = unpk4(*(const LAS v2u*)(R + (RW ? RO_SK : GO_SK) + ((vb * 4 + kb) * 64 + F.lane) * 8));
                    f32x4 n = S[kb] * g + sk;
                    if (RW) {
#pragma unroll
                        for (int ks = 0; ks < 2; ++ks) n = __builtin_amdgcn_mfma_f32_16x16x32_bf16(*(const LAS bf16x8*)(R + RO_BH + ((kb * 2 + ks) * 64 + F.lane) * 16), bU[ks], n, 0, 0, 0);
                    }
                    S[kb] = n; }
#pragma unroll
                for (int mb = 0; mb < 4; ++mb)
#pragma unroll
                    for (int r = 0; r < 4; ++r) *(LAS bf16*)(F.lds + OSO + par * 8192 + (16 * mb + 4 * fq + r) * 128 + (16 * vb + fr) * 2) = (bf16)f2bf(O[mb][r]);
            }
            LDS_BARRIER();
        }
    }
    if (compute) SEQ_FLUSH(63);
#undef SEQ_FLUSH
    __syncthreads();
}
__device__ __forceinline__ int tri6(int mb, int ks) { return mb < 2 ? mb : 2 + (mb - 2) * 2 + ks; }
struct SeqRegs4 { v4u r[6]; v4u t; };
__device__ __forceinline__ void seq4_ld(SeqRegs4& R, const unsigned char* rec, int vb, int lt) {
    const GAS v4u* src = (const GAS v4u*)rec;
#pragma unroll
    for (int i = 0; i < 6; ++i) R.r[i] = src[i * 384 + lt];
    if (lt < 16) R.t = src[6 * 384 + lt];
    if (lt >= 128) R.t = *(const GAS v4u*)(rec + RO_VB + vb * 4096 + (lt - 128) * 16);
}
__device__ __forceinline__ void seq4_st(const SeqRegs4& R, LAS unsigned char* slot, int lt) {
    LAS v4u* dst = (LAS v4u*)slot;
#pragma unroll
    for (int i = 0; i < 6; ++i) dst[i * 384 + lt] = R.r[i];
    if (lt < 16) dst[6 * 384 + lt] = R.t;
    if (lt >= 128) *(LAS v4u*)(slot + 37120 + (lt - 128) * 16) = R.t;
}
__device__ __forceinline__ void seq_rw(Frame& F, int b, int h, int vb, const unsigned char* recs) {
    constexpr int REC = REC_RW, SLOT = 41216, EXO = 3 * SLOT;
    const bool loader = F.wave >= 2; const int lt = F.tid - 128;
    SeqRegs4 RA, RB;
    if (loader) { seq4_ld(RA, recs, vb, lt); seq4_st(RA, F.lds, lt); seq4_ld(RB, recs + (size_t)1 * REC, vb, lt); seq4_ld(RA, recs + (size_t)2 * REC, vb, lt); }
    __syncthreads();
    f32x4 S[4];
#pragma unroll
    for (int kb = 0; kb < 4; ++kb) S[kb] = (f32x4){0.f, 0.f, 0.f, 0.f};
    const int fr = F.lane & 15, fq = F.lane >> 4;
    bf16* Og_ = WSP(bf16, WS_OI) + (size_t)((b * 4 + h) * 4 + vb) * (SEQ * 16);
    LAS unsigned char* OS = F.lds + EXO + 8192;
#pragma unroll 1
    for (int c2 = 0; c2 < 66; c2 += 2) {
#pragma unroll
        for (int par = 0; par < 2; ++par) {
            const int c = c2 + par;
            if (loader) {
                if (c + 1 < 64) { LAS unsigned char* dst = F.lds + ((c + 1) % 3) * SLOT; if (par == 0) seq4_st(RB, dst, lt); else seq4_st(RA, dst, lt); }
                if (c + 3 < 64) { if (par == 0) seq4_ld(RB, recs + (size_t)(c + 3) * REC, vb, lt); else seq4_ld(RA, recs + (size_t)(c + 3) * REC, vb, lt); }
            } else if (F.wave == 0) {
                if (c < 64) {
                    const LAS unsigned char* R = F.lds + (c % 3) * SLOT; LAS unsigned char* EX = F.lds + EXO + par * 4096;
                    const f32x4 z = (f32x4){0.f, 0.f, 0.f, 0.f};
                    v2u yv[4]; bf16x8 fat[8], ftt[6];
#pragma unroll
                    for (int mb = 0; mb < 4; ++mb) yv[mb] = *(const LAS v2u*)(R + 37120 + (mb * 64 + F.lane) * 8);
#pragma unroll
                    for (int f = 0; f < 8; ++f) fat[f] = *(const LAS bf16x8*)(R + RO_AT + (f * 64 + F.lane) * 16);
                    bf16x8 bS[2]; bS[0] = pack_b(S[0], S[1]); bS[1] = pack_b(S[2], S[3]);
                    *(LAS bf16x8*)(EX + F.lane * 16) = bS[0]; *(LAS bf16x8*)(EX + 1024 + F.lane * 16) = bS[1];
                    asm volatile("s_waitcnt lgkmcnt(0)" ::: "memory"); __builtin_amdgcn_sched_barrier(0);
                    f32x4 X[4], U[4];
#pragma unroll
                    for (int mb = 0; mb < 4; ++mb) { X[mb] = unpk4(yv[mb]);
#pragma unroll
                        for (int ks = 0; ks < 2; ++ks) X[mb] = __builtin_amdgcn_mfma_f32_16x16x32_bf16(fat[mb * 2 + ks], bS[ks], X[mb], 0, 0, 0); }
                    __builtin_amdgcn_sched_barrier(0);
                    bf16x8 fbh[8]; f32x4 gm[4]; v2u skv[4];
#pragma unroll
                    for (int f = 0; f < 6; ++f) ftt[f] = *(const LAS bf16x8*)(R + RO_TT + (f * 64 + F.lane) * 16);
#pragma unroll
                    for (int f = 0; f < 8; ++f) fbh[f] = *(const LAS bf16x8*)(R + RO_BH + (f * 64 + F.lane) * 16);
#pragma unroll
                    for (int kb = 0; kb < 4; ++kb) { gm[kb] = *(const LAS f32x4*)(R + RO_GAM + (16 * kb + 4 * fq) * 4); skv[kb] = *(const LAS v2u*)(R + 37120 + 2048 + (kb * 64 + F.lane) * 8); }
                    __builtin_amdgcn_sched_barrier(0);
                    bf16x8 bX[2]; bX[0] = pack_b(X[0], X[1]); bX[1] = pack_b(X[2], X[3]);
#pragma unroll
                    for (int mb = 0; mb < 4; ++mb) { U[mb] = z;
#pragma unroll
                        for (int ks = 0; ks < 2; ++ks) if (!(ks == 1 && mb < 2)) U[mb] = __builtin_amdgcn_mfma_f32_16x16x32_bf16(ftt[tri6(mb, ks)], bX[ks], U[mb], 0, 0, 0); }
                    bf16x8 bU[2]; bU[0] = pack_b(U[0], U[1]); bU[1] = pack_b(U[2], U[3]);
                    *(LAS bf16x8*)(EX + 2048 + F.lane * 16) = bU[0]; *(LAS bf16x8*)(EX + 3072 + F.lane * 16) = bU[1];
                    asm volatile("s_waitcnt lgkmcnt(0)" ::: "memory"); __builtin_amdgcn_sched_barrier(0);
#pragma unroll
                    for (int kb = 0; kb < 4; ++kb) { f32x4 n = S[kb] * gm[kb] + unpk4(skv[kb]);
#pragma unroll
                        for (int ks = 0; ks < 2; ++ks) n = __builtin_amdgcn_mfma_f32_16x16x32_bf16(fbh[kb * 2 + ks], bU[ks], n, 0, 0, 0);
                        S[kb] = n; }
                }
            } else {
                if (c >= 1 && c <= 64) {
                    const int co = c - 1; const LAS unsigned char* R = F.lds + (co % 3) * SLOT; const LAS unsigned char* EX = F.lds + EXO + (par ^ 1) * 4096;
                    bf16x8 fq_[8], fm[6];
#pragma unroll
                    for (int f = 0; f < 8; ++f) fq_[f] = *(const LAS bf16x8*)(R + RO_QH + (f * 64 + F.lane) * 16);
#pragma unroll
                    for (int f = 0; f < 6; ++f) fm[f] = *(const LAS bf16x8*)(R + RO_MRB + (f * 64 + F.lane) * 16);
                    const bf16x8 bS0 = *(const LAS bf16x8*)(EX + F.lane * 16), bS1 = *(const LAS bf16x8*)(EX + 1024 + F.lane * 16), bU0 = *(const LAS bf16x8*)(EX + 2048 + F.lane * 16), bU1 = *(const LAS bf16x8*)(EX + 3072 + F.lane * 16);
                    asm volatile("s_waitcnt lgkmcnt(0)" ::: "memory"); __builtin_amdgcn_sched_barrier(0);
                    f32x4 O[4];
#pragma unroll
                    for (int mb = 0; mb < 4; ++mb) { O[mb] = (f32x4){0.f, 0.f, 0.f, 0.f};
                        O[mb] = __builtin_amdgcn_mfma_f32_16x16x32_bf16(fq_[mb * 2], bS0, O[mb], 0, 0, 0);
                        O[mb] = __builtin_amdgcn_mfma_f32_16x16x32_bf16(fq_[mb * 2 + 1], bS1, O[mb], 0, 0, 0);
                        O[mb] = __builtin_amdgcn_mfma_f32_16x16x32_bf16(fm[tri6(mb, 0)], bU0, O[mb], 0, 0, 0);
                        if (mb >= 2) O[mb] = __builtin_amdgcn_mfma_f32_16x16x32_bf16(fm[tri6(mb, 1)], bU1, O[mb], 0, 0, 0); }
#pragma unroll
                    for (int mb = 0; mb < 4; ++mb)
#pragma unroll
                        for (int r = 0; r < 4; ++r) *(LAS bf16*)(OS + (16 * mb + 4 * fq + r) * 32 + fr * 2) = (bf16)f2bf(O[mb][r]);
                    asm volatile("s_waitcnt lgkmcnt(0)" ::: "memory");
                    { const v4u a_ = *(const LAS v4u*)(OS + F.lane * 32), b_ = *(const LAS v4u*)(OS + F.lane * 32 + 16); bf16* dst_ = Og_ + ((size_t)co * 64 + F.lane) * 16; *(GAS v4u*)dst_ = a_; *(GAS v4u*)(dst_ + 8) = b_; }
                    asm volatile("s_waitcnt lgkmcnt(0)" ::: "memory");
                }
            }
            LDS_BARRIER();
        }
    }
    __syncthreads();
}
__device__ __forceinline__ void phase_seq(Frame& F, int l) {
    for (int u = blockIdx.x; u < 112; u += F.G) {
        if (u < 64) { const int bh = u >> 2, vb = u & 3; seq_rw(F, bh >> 2, bh & 3, vb, F.ws + WS_REC_RW + (size_t)(bh * 64) * REC_RW); }
        else { const int v = u - 64, mm = v % 3, bh = v / 3; seq_unit<false>(F, mm == 2 ? 3 : mm, bh >> 2, bh & 3, 0, F.ws + WS_REC_GL + (size_t)((mm * 16 + bh) * 64) * REC_GL); }
    }
}
struct PostRaw { v4u o0, o1; v4u y0, y1; v4u x0, x1, x2, x3, x4, x5, x6, x7; };
__device__ __forceinline__ void post_load(Frame& F, PostRaw& R, int t, int m, int c0) {
    const bf16* P = WSP(const bf16, WS_P);
    const bf16* Ob = WSP(const bf16, WS_O) + (size_t)m * TOK * 256 + (size_t)t * 256 + c0;
    R.o0 = *(const GAS v4u*)(Ob); R.o1 = *(const GAS v4u*)(Ob + 8);
    { const int bb = t >> 12, tb = t & (SEQ - 1), hh = c0 >> 6, qq = (c0 >> 4) & 3; const bf16* oi = WSP(const bf16, WS_OI) + (m == 2 ? ((size_t)((bb * 4 + hh) * 4 + qq) * SEQ + tb) * 16 : OI_GEN + ((size_t)(((m == 3 ? 2 : m) * 16 + bb * 4 + hh)) * SEQ + tb) * 64 + 16 * qq);
      R.y0 = *(const GAS v4u*)oi; R.y1 = *(const GAS v4u*)(oi + 8); }
    const v4u zz = (v4u){0u, 0u, 0u, 0u}; R.x2 = zz; R.x3 = zz; R.x4 = zz; R.x5 = zz; R.x6 = zz; R.x7 = zz;
    if (m != 2) { const int gc = (m == 0 ? HG_G : m == 1 ? GL_R : RT_G) + c0; R.x0 = *(const GAS v4u*)(P + (size_t)t * NP + gc); R.x1 = *(const GAS v4u*)(P + (size_t)t * NP + gc + 8); }
    else { const size_t ob = (size_t)t * 256 + c0;
        R.x0 = *(const GAS v4u*)(WSP(const bf16, WS_RWR) + ob); R.x1 = *(const GAS v4u*)(WSP(const bf16, WS_RWR) + ob + 8); R.x2 = *(const GAS v4u*)(WSP(const bf16, WS_RWK) + ob); R.x3 = *(const GAS v4u*)(WSP(const bf16, WS_RWK) + ob + 8);
        R.x4 = *(const GAS v4u*)(WSP(const bf16, WS_RWV) + ob); R.x5 = *(const GAS v4u*)(WSP(const bf16, WS_RWV) + ob + 8); R.x6 = *(const GAS v4u*)(WSP(const bf16, WS_RWG) + ob); R.x7 = *(const GAS v4u*)(WSP(const bf16, WS_RWG) + ob + 8); }
}
__device__ __forceinline__ void unpack16(const v4u a, const v4u b, float (&f)[16]) { float x[8], y[8]; unpack8(a, x); unpack8(b, y);
#pragma unroll
    for (int j = 0; j < 8; ++j) { f[j] = x[j]; f[8 + j] = y[j]; } }
__device__ __forceinline__ void phase_post(Frame& F, int l) {
    const int gw = F.vcu * NWAVES + F.wave, NGW = F.G * NWAVES;
    const int m = F.lane >> 4, h = (F.lane >> 2) & 3, qd = F.lane & 3; const int c0 = 64 * h + 16 * qd;
    bf16* Y = WSP(bf16, WS_Y);
    PostRaw cur, nxt;
    if (gw < TOK) post_load(F, cur, gw, m, c0);
    for (int t = gw; t < TOK; t += NGW) {
        if (t + NGW < TOK) post_load(F, nxt, t + NGW, m, c0);
        float o[16], oi[16];
        unpack16(cur.o0, cur.o1, o);
        unpack16(cur.y0, cur.y1, oi);
        float s1 = 0.f, s2 = 0.f;
#pragma unroll
        for (int j = 0; j < 16; ++j) { o[j] += oi[j]; s1 += o[j]; s2 += o[j] * o[j]; }
        s1 = sum4(s1); s2 = sum4(s2);
        float y[16];
        if (m < 2) {
            const float rs = rsqrtf(s2 * (1.f / 64.f) + 1e-6f); const float* ng = INF(m == 0 ? 9 : 12) + l * 64 + 16 * qd;
            float g[16]; unpack16(cur.x0, cur.x1, g);
#pragma unroll
            for (int j = 0; j < 16; ++j) y[j] = o[j] * rs * ng[j] * (g[j] * sigm(g[j]));
        } else if (m == 2) {
            const float mean = s1 * (1.f / 64.f); float var = s2 * (1.f / 64.f) - mean * mean; var = fmaxf(var, 0.f); const float rs = rsqrtf(var + 64e-5f);
            float r[16], k[16], v[16], g[16]; unpack16(cur.x0, cur.x1, r); unpack16(cur.x2, cur.x3, k); unpack16(cur.x4, cur.x5, v); unpack16(cur.x6, cur.x7, g);
            const float* rk = INF(21) + l * 256 + c0; const float* lg = INF(22) + l * 256 + c0; const float* lb = INF(23) + l * 256 + c0;
            float bon = 0.f;
#pragma unroll
            for (int j = 0; j < 16; ++j) bon += r[j] * k[j] * rk[j];
            bon = sum4(bon);
#pragma unroll
            for (int j = 0; j < 16; ++j) y[j] = ((o[j] - mean) * rs * lg[j] + lb[j] + bon * v[j]) * g[j];
        } else {
            const float mean = s1 * (1.f / 64.f); float var = s2 * (1.f / 64.f) - mean * mean; var = fmaxf(var, 0.f); const float rs = rsqrtf(var + 1e-5f);
            float g[16]; unpack16(cur.x0, cur.x1, g);
#pragma unroll
            for (int j = 0; j < 16; ++j) y[j] = (g[j] * sigm(g[j])) * ((o[j] - mean) * rs);
        }
        v4u w0, w1; w0.x = pk2(y[0], y[1]); w0.y = pk2(y[2], y[3]); w0.z = pk2(y[4], y[5]); w0.w = pk2(y[6], y[7]); w1.x = pk2(y[8], y[9]); w1.y = pk2(y[10], y[11]); w1.z = pk2(y[12], y[13]); w1.w = pk2(y[14], y[15]);
        GAS v4u* yo = (GAS v4u*)(Y + (size_t)t * D + 256 * m + c0); yo[0] = w0; yo[1] = w1;
        cur = nxt;
    }
}
template <int MODE> struct LnRaw { v2u h[4]; v2u d1[4], d2[4]; float g1, g2; };
template <int MODE> __device__ __forceinline__ void ln_load(Frame& F, LnRaw<MODE>& R, int m) {
    const GAS v2u* hr = (const GAS v2u*)(WSP(const bf16, WS_HB) + (size_t)m * D) + F.lane;
#pragma unroll
    for (int j = 0; j < 4; ++j) R.h[j] = hr[64 * j];
    if (MODE == 0) { const GAS v2u* ar = (const GAS v2u*)(WSP(const bf16, WS_MIX) + (size_t)m * D) + F.lane;
#pragma unroll
        for (int j = 0; j < 4; ++j) R.d1[j] = ar[64 * j]; }
    else { const bf16* DOUT = WSP(const bf16, WS_DOUT); const float* GATE = WSP(const float, WS_GATE); R.g1 = GATE[2 * m]; R.g2 = GATE[2 * m + 1];
#pragma unroll
        for (int j = 0; j < 4; ++j) { R.d1[j] = ((const GAS v2u*)(DOUT + (size_t)(2 * m) * D))[F.lane + 64 * j]; R.d2[j] = ((const GAS v2u*)(DOUT + (size_t)(2 * m + 1) * D))[F.lane + 64 * j]; } }
}
template <int MODE, bool ROUTE, bool Q8 = false> __device__ __forceinline__ void phase_ln(Frame& F, const float* gw_, const float* bw_, const float* router, int mi, const bool final_out = false) {
    const int gw = F.vcu * NWAVES + F.wave, NGW = F.G * NWAVES;
    bf16* hb = WSP(bf16, WS_HB); float* GATE = WSP(float, WS_GATE);
    LAS float* RT = (LAS float*)F.lds;
    if (ROUTE) { for (int i = F.tid; i < D * NE; i += NWAVES * 64) RT[(i & 7) * D + (i >> 3)] = router[i]; __syncthreads(); }
    f32x4 gv[4], bv[4];
#pragma unroll
    for (int j = 0; j < 4; ++j) { gv[j] = ((const GAS f32x4*)gw_)[F.lane + 64 * j]; bv[j] = ((const GAS f32x4*)bw_)[F.lane + 64 * j]; }
    LnRaw<MODE> cur, nxt;
    if (gw < TOK) ln_load<MODE>(F, cur, gw);
    for (int m = gw; m < TOK; m += NGW) {
        if (m + NGW < TOK) ln_load<MODE>(F, nxt, m + NGW);
        GAS f32x4* hr = (GAS f32x4*)(F.h + (size_t)m * D) + F.lane;
        f32x4 v[4]; float s = 0.f;
#pragma unroll
        for (int j = 0; j < 4; ++j) {
            f32x4 a;
            if (MODE == 0) { const v2u d1 = cur.d1[j]; a = (f32x4){bflo(d1.x), bfhi(d1.x), bflo(d1.y), bfhi(d1.y)}; }
            else { const v2u d1 = cur.d1[j], d2 = cur.d2[j]; const float g1 = cur.g1, g2 = cur.g2;
                a.x = g1 * bflo(d1.x) + g2 * bflo(d2.x); a.y = g1 * bfhi(d1.x) + g2 * bfhi(d2.x); a.z = g1 * bflo(d1.y) + g2 * bflo(d2.y); a.w = g1 * bfhi(d1.y) + g2 * bfhi(d2.y); }
            const v2u hq = cur.h[j]; const f32x4 hv = (f32x4){bflo(hq.x), bfhi(hq.x), bflo(hq.y), bfhi(hq.y)};
            v[j] = hv * DN_ALPHA + a; s += (v[j].x + v[j].y) + (v[j].z + v[j].w); }
        const float mean = wave_sum(s) * (1.f / D); float s2 = 0.f;
#pragma unroll
        for (int j = 0; j < 4; ++j) { v[j] = v[j] - mean; s2 += (v[j].x * v[j].x + v[j].y * v[j].y) + (v[j].z * v[j].z + v[j].w * v[j].w); }
        const float rstd = 1.f / sqrtf(wave_sum(s2) * (1.f / D) + 1e-5f);
        GAS v2u* o8 = (GAS v2u*)(hb + (size_t)m * D) + F.lane;
#pragma unroll
        for (int j = 0; j < 4; ++j) { v[j] = v[j] * rstd * gv[j] + bv[j]; if (final_out) hr[64 * j] = v[j]; v2u w; w.x = pk2(v[j].x, v[j].y); w.y = pk2(v[j].z, v[j].w); o8[64 * j] = w; }
        if (Q8) { float am = 0.f;
#pragma unroll
            for (int j = 0; j < 4; ++j) { const f32x4 a = __builtin_elementwise_abs(v[j]); am = fmaxf(am, fmaxf(fmaxf(a.x, a.y), fmaxf(a.z, a.w))); }
            am = wave_max(am); const float inv = am > 0.f ? 127.f / am : 0.f;
            GAS unsigned* q8 = (GAS unsigned*)(WSP(unsigned char, WS_H8) + (size_t)m * D) + F.lane;
#pragma unroll
            for (int j = 0; j < 4; ++j) q8[64 * j] = pack_i8(v[j].x * inv, v[j].y * inv, v[j].z * inv, v[j].w * inv);
            if (F.lane == 0) WSP(float, WS_RS)[m] = am * (1.f / 127.f); }
        if (ROUTE) {
            float lg[8];
#pragma unroll
            for (int e = 0; e < 8; ++e) { float a = 0.f;
#pragma unroll
                for (int j = 0; j < 4; ++j) { const f32x4 r = *(const LAS f32x4*)(RT + e * D + 4 * (F.lane + 64 * j)); a += (v[j].x * r.x + v[j].y * r.y) + (v[j].z * r.z + v[j].w * r.w); }
                lg[e] = wave_sum(a); }
            int e1 = 0; float l1 = lg[0];
#pragma unroll
            for (int e = 1; e < 8; ++e) if (lg[e] > l1) { l1 = lg[e]; e1 = e; }
            int e2 = -1; float l2 = -3.0e38f;
#pragma unroll
            for (int e = 0; e < 8; ++e) if (e != e1 && lg[e] > l2) { l2 = lg[e]; e2 = e; }
            if (F.lane == 0) {
                const float p2 = __expf(l2 - l1); const float ga = 1.f / (1.f + p2);
                GATE[2 * m] = ga; GATE[2 * m + 1] = p2 * ga;
                int* list = WSP(int, WS_LIST) + (size_t)mi * NE * TOK;
                const unsigned p1 = __hip_atomic_fetch_add((unsigned*)(F.ctl + CW_CNT + (mi * 8 + e1) * 64), 1u, RLX_AGENT); list[e1 * TOK + p1] = 2 * m;
                const unsigned q2 = __hip_atomic_fetch_add((unsigned*)(F.ctl + CW_CNT + (mi * 8 + e2) * 64), 1u, RLX_AGENT); list[e2 * TOK + q2] = 2 * m + 1;
            }
        }
        cur = nxt;
    }
}
__device__ __forceinline__ void phase_gather(Frame& F, int mi) {
    int cnt[8], poff[9]; poff[0] = 0;
    unsigned* cb_ = (unsigned*)(F.ctl + CW_CNT + mi * 8 * 64); asm volatile("" : "+s"(cb_));
#pragma unroll
    for (int e = 0; e < 8; ++e) { cnt[e] = (int)__hip_atomic_load(cb_ + e * 64, RLX_AGENT); poff[e + 1] = poff[e] + ((cnt[e] + 255) >> 8); }
    const int npan = poff[8];
    int* tab = WSP(int, WS_TAB) + mi * TAB_STRIDE;
    if (blockIdx.x == 0) {
        for (int P = F.tid; P < npan; P += NWAVES * 64) { int e = 0, pe = 0, ce = cnt[0];
#pragma unroll
            for (int j = 1; j < 8; ++j) if (P >= poff[j]) { e = j; pe = poff[j]; ce = cnt[j]; }
            tab[4 * P] = e; tab[4 * P + 1] = 256 * (P - pe); tab[4 * P + 2] = ce; tab[4 * P + 3] = 0; }
        if (F.tid == 0) tab[640] = npan;
    }
    const int gw = F.vcu * NWAVES + F.wave, NGW = F.G * NWAVES;
    const int* list = WSP(const int, WS_LIST) + (size_t)mi * NE * TOK; const bf16* hb = WSP(const bf16, WS_HB); bf16* HP = WSP(bf16, WS_HPERM);
    for (int row = gw; row < 256 * npan; row += NGW) { const int P = row >> 8; int e = 0, pe = 0, ce = cnt[0];
#pragma unroll
        for (int j = 1; j < 8; ++j) if (P >= poff[j]) { e = j; pe = poff[j]; ce = cnt[j]; }
        const int r = row - 256 * pe; const int tok = (r < ce) ? (list[e * TOK + r] >> 1) : 0;
        const GAS v4u* s = (const GAS v4u*)(hb + (size_t)tok * D) + F.lane; GAS v4u* d = (GAS v4u*)(HP + (size_t)row * D) + F.lane; d[0] = s[0]; d[64] = s[64]; }
}
struct Args { const void* in[36]; int ph_lo, ph_hi; };
__global__ void __launch_bounds__(NWAVES * 64, 2) mk_fwd(Args args) {
    extern __shared__ __attribute__((aligned(16))) unsigned char lds[];
    Frame F;
    F.lds = (LAS unsigned char*)lds;
    F.MISC = (volatile LAS unsigned*)(F.lds + MISC_OFF);
    F.tid = threadIdx.x; F.lane = F.tid & 63; F.wave = __builtin_amdgcn_readfirstlane(F.tid >> 6);
    const int wave_k = F.wave;
    F.G = gridDim.x; { const int bx = blockIdx.x; F.vcu = (F.G % 8 == 0) ? (bx % 8) * (F.G / 8) + bx / 8 : bx; }
    F.in = args.in; F.ws = (unsigned char*)ldptr(F.in, 35); F.h = (float*)ldptr(F.in, 34);
    F.ctl = (gu32*)(F.ws + WS_CTL);
    for (int u = F.tid; u < (LDS_BYTES - LDSCTL_OFF) / 4; u += NWAVES * 64) ((LAS unsigned*)(F.lds + LDSCTL_OFF))[u] = 0u;
    __syncthreads();
    XcdBarrier bar; bar.bar = (unsigned*)(F.ctl + CW_BAR); bar.x = 0; bar.st = nullptr; bar.wv = 0;
    if (!MK_PER_PHASE) bar = xcd_barrier_post((unsigned*)(F.ctl + CW_BAR), F.MISC + 8);
    const int lo = args.ph_lo, hi = args.ph_hi;
#define IN(k) (lo <= (k) && (k) < hi)
#define PHASE_BEGIN() do { int t_ = wave_k * 64 + lane_id_now(); asm volatile("" : "+v"(t_)); F.tid = t_; F.lane = t_ & 63; F.wave = wave_k; \
        F.ws = (unsigned char*)ldptr(F.in, 35); F.ctl = (gu32*)(F.ws + WS_CTL); F.h = (float*)ldptr(F.in, 34); } while (0)
#define SEAM(k) do { if (IN(k) && IN((k) + 1)) { xcd_barrier(bar); if (DUPMASK & 4096) xcd_barrier(bar); } } while (0)
    for (int l = 0; l < DEPTH; ++l) {
        const int pb = l * NPH; const bool moe = (l & 1); const int mi = l >> 1;
#define PH(k) (((PHMASK >> (k)) & 1) && IN(pb + (k)))
        if (l == 0) { if (PH(0)) { PHASE_BEGIN(); phase_weights<0>(F, 0); } SEAM(pb + 0); }
        if (PH(1)) for (int rep_ = 0; rep_ < ((((DUPMASK >> 1) & 1) && ((DUPL >> l) & 1)) ? 2 : 1); ++rep_) { PHASE_BEGIN(); if (rep_) __syncthreads();
            pg8::Gemm g{WSP(const bf16, WS_HB), WSP(const bf16, WS_WIN), TOK, NP, D}; pg8::StaticOrder S; S.init(TOK, NP, F.G, (int)blockIdx.x);
            pg8::EpiBf16 E{WSP(bf16, WS_P), NP};
            pg8::gemm_phase<pg8::EpiBf16, pg8::StaticOrder, true, true>(F.lds, g, S, E, F.wave);
        } SEAM(pb + 1);
        if (PH(3)) { PHASE_BEGIN(); phase_chunkpre(F, l); if (DUPMASK & 8) { __syncthreads(); phase_chunkpre(F, l); } } SEAM(pb + 3);
        if (PH(4)) { PHASE_BEGIN(); phase_seq(F, l); if (DUPMASK & 16) { __syncthreads(); phase_seq(F, l); }
            if (((int)blockIdx.x >= 112 || F.G <= 112)) { const int sv = F.vcu, sg = F.G; if (sg > 112) { F.vcu = (int)blockIdx.x - 112; F.G = sg - 112; } phase_absmax(F, l); if ((DUPMASK & 8192) && ((DUPL >> l) & 1)) phase_absmax(F, l); F.vcu = sv; F.G = sg; }
            if (l + 1 < DEPTH && (int)blockIdx.x >= 112 && F.G > 112) { const int sv = F.vcu, sg = F.G; F.vcu = (int)blockIdx.x - 112; F.G = sg - 112; phase_weights<0>(F, l + 1); F.vcu = sv; F.G = sg; }
        } SEAM(pb + 4);
        if (PH(5)) { PHASE_BEGIN(); phase_post(F, l); __syncthreads(); phase_weights<1>(F, l); if (DUPMASK & 32) { __syncthreads(); phase_weights<1>(F, l); } } SEAM(pb + 5);
        if (PH(6)) for (int rep_ = 0; rep_ < ((((DUPMASK >> 6) & 1) && ((DUPL >> l) & 1)) ? 2 : 1); ++rep_) { PHASE_BEGIN(); if (rep_) __syncthreads();
            pg8::Gemm g{WSP(const bf16, WS_Y), WSP(const bf16, (l & 1) ? WS_WOUT2 : WS_WOUT), TOK, D, D}; pg8::StaticOrder S; S.init(TOK, D, F.G, (int)blockIdx.x);
            pg8::EpiBf16 E{WSP(bf16, WS_MIX), D};
            pg8::gemm_phase<pg8::EpiBf16, pg8::StaticOrder, false, true>(F.lds, g, S, E, F.wave);
        } SEAM(pb + 6);
        if (PH(7)) { PHASE_BEGIN();
            if (moe) phase_ln<0, true, true>(F, INF(4) + l * D, INF(5) + l * D, INF(30) + (size_t)mi * D * NE, mi);
            else phase_ln<0, false, true>(F, INF(4) + l * D, INF(5) + l * D, nullptr, 0);
        } SEAM(pb + 7);
        if (PH(9)) for (int rep_ = 0; rep_ < ((((DUPMASK >> 9) & 1) && ((DUPL >> l) & 1)) ? 2 : 1); ++rep_) { PHASE_BEGIN(); if (rep_) __syncthreads();
            if (STAG9 > 0 && (((int)blockIdx.x >> 3) & 1)) { const unsigned long long t0_ = __builtin_amdgcn_s_memrealtime(); while (__builtin_amdgcn_s_memrealtime() - t0_ < (unsigned long long)STAG9) __builtin_amdgcn_s_sleep(8); }
            if (!moe) { pg8::Gemm g{WSP(const bf16, WS_H8), WSP(const bf16, WS_WUP), TOK, 2 * FFD, D / 2}; pg8::StaticOrder S; S.init(TOK, 2 * FFD, F.G, (int)blockIdx.x);
                pg8::EpiSwiGLU8<false> E{WSP(unsigned char, WS_HID), FFD, 22, WSP(const float, WS_RS), __uint_as_float(__hip_atomic_load((unsigned*)(F.ctl + CW_AMAX + l * 64), RLX_AGENT)) * (1.f / 127.f), pg8::MoeMap{}};
                pg8::gemm_phase<pg8::EpiSwiGLU8<false>, pg8::StaticOrder, true, true, 1>(F.lds, g, S, E, F.wave);
            } else { pg8::MoeOrder<true> S; S.M.init((const unsigned*)(F.ctl + CW_CNT + mi * 8 * 64), WSP(const int, WS_LIST) + (size_t)mi * NE * TOK); const int npan = S.M.poff[8];
                S.tpg = 11; S.G = F.G; S.c = (int)blockIdx.x; S.nunits = npan * 11; S.rowbytes = D;
                pg8::Gemm g{WSP(const bf16, WS_H8), WSP(const bf16, WS_WUP), 256 * npan, 2 * FFE, D / 2};
                pg8::EpiSwiGLU8<true> E{WSP(unsigned char, WS_HID), FFEP, 11, WSP(const float, WS_RS), __uint_as_float(__hip_atomic_load((unsigned*)(F.ctl + CW_AMAX + l * 64), RLX_AGENT)) * (1.f / 127.f), S.M};
                pg8::gemm_phase<pg8::EpiSwiGLU8<true>, pg8::MoeOrder<true>, true, true, 1>(F.lds, g, S, E, F.wave);
            }
        } SEAM(pb + 9);
        if (PH(10)) for (int rep_ = 0; rep_ < ((((DUPMASK >> 10) & 1) && ((DUPL >> l) & 1)) ? 2 : 1); ++rep_) { PHASE_BEGIN(); if (rep_) __syncthreads();
            float qsd_, invd; f8_scale(__uint_as_float(__hip_atomic_load((unsigned*)(F.ctl + CW_AMAXD + l * 64), RLX_AGENT)), qsd_, invd);
            if (!moe) { pg8::Gemm g{WSP(const bf16, WS_HID), WSP(const bf16, WS_WDN), TOK, D, FFD / 2}; pg8::StaticOrder S; S.init(TOK, D, F.G, (int)blockIdx.x);
                pg8::EpiBf16S E{WSP(bf16, WS_MIX), D, invd};
                pg8::gemm_phase<pg8::EpiBf16S, pg8::StaticOrder, false, true, 2>(F.lds, g, S, E, F.wave);
            } else { pg8::MoeOrder<false> S; S.M.init((const unsigned*)(F.ctl + CW_CNT + mi * 8 * 64), WSP(const int, WS_LIST) + (size_t)mi * NE * TOK); const int npan = S.M.poff[8];
                S.tpg = 4; S.G = F.G; S.c = (int)blockIdx.x; S.nunits = npan * 4; S.rowbytes = 0;
                pg8::Gemm g{WSP(const bf16, WS_HID), WSP(const bf16, WS_WDN), 256 * npan, D, FFEP / 2};
                pg8::EpiScatter E{WSP(bf16, WS_DOUT), S.M, invd};
                pg8::gemm_phase<pg8::EpiScatter, pg8::MoeOrder<false>, true, true, 2>(F.lds, g, S, E, F.wave);
            }
        } SEAM(pb + 10);
        if (PH(11)) { PHASE_BEGIN();
            if (moe) phase_ln<1, false>(F, INF(6) + l * D, INF(7) + l * D, nullptr, 0, l == DEPTH - 1);
            else phase_ln<0, false>(F, INF(6) + l * D, INF(7) + l * D, nullptr, 0, l == DEPTH - 1);
            if (l + 1 < DEPTH && F.G <= 112) { __syncthreads(); phase_weights<0>(F, l + 1); }
        } SEAM(pb + 11);
#undef PH
    }
#undef IN
#undef SEAM
}

extern "C" void kernel_launch(void* const* d_in, const int* in_sizes, int n_in, void* d_out, int out_size, void* d_ws, size_t ws_size, hipStream_t stream) {
    static int grid = 0;
    if (grid == 0) {
        if (n_in != 34 || out_size != TOK * D || ws_size < WS_END) { fprintf(stderr, "kernel_launch: unexpected shapes (n_in %d, out %d, ws %zu)\n", n_in, out_size, ws_size); grid = -1; return; }
        int dev = 0, cus = 0, per_cu = 0;
        if (hipGetDevice(&dev) != hipSuccess || hipDeviceGetAttribute(&cus, hipDeviceAttributeMultiprocessorCount, dev) != hipSuccess) { grid = -1; return; }
        if (hipFuncSetAttribute((const void*)mk_fwd, hipFuncAttributeMaxDynamicSharedMemorySize, LDS_BYTES) != hipSuccess) { fprintf(stderr, "kernel_launch: hipFuncSetAttribute failed\n"); grid = -1; return; }
        if (hipOccupancyMaxActiveBlocksPerMultiprocessor(&per_cu, (const void*)mk_fwd, NWAVES * 64, LDS_BYTES) != hipSuccess || per_cu < 1) fprintf(stderr, "kernel_launch: occupancy query reports %d\n", per_cu);
        (void)hipGetLastError();
        grid = cus;
    }
    if (grid < 0) return;
    if (hipMemsetAsync((char*)d_ws + WS_CTL, 0, CTL_ZERO_BYTES, stream) != hipSuccess) return;
    Args a{};
    for (int i = 0; i < 34; ++i) a.in[i] = d_in[i];
    a.in[34] = d_out; a.in[35] = d_ws;
#if MK_PER_PHASE
    for (int p = 0; p < NPHASES; ++p) { a.ph_lo = p; a.ph_hi = p + 1; hipLaunchKernelGGL(mk_fwd, dim3(grid), dim3(NWAVES * 64), LDS_BYTES, stream, a); }
#else
    a.ph_lo = 0; a.ph_hi = NPHASES; hipLaunchKernelGGL(mk_fwd, dim3(grid), dim3(NWAVES * 64), LDS_BYTES, stream, a);
#endif
}
```

```cpp
#include <hip/hip_runtime.h>
#include <cstdio>
#include <cstdint>
#ifndef PHMASK
#define PHMASK 0xfff
#endif
#ifndef DUPMASK
#define DUPMASK 0
#endif
#ifndef DUPL
#define DUPL 0xf
#endif
#ifndef STAG9
#define STAG9 0
#endif
#ifndef MK_PER_PHASE
#define MK_PER_PHASE 0
#endif
__device__ __forceinline__ int lane_id_now() { unsigned m_ = ~0u; asm volatile("" : "+s"(m_)); return (int)__builtin_amdgcn_mbcnt_hi(m_, __builtin_amdgcn_mbcnt_lo(m_, 0u)); }
namespace pg8 {
#define PG8_LAS __attribute__((address_space(3)))
typedef unsigned short bf16_t;
typedef short bf16x8 __attribute__((ext_vector_type(8)));
typedef float f32x4 __attribute__((ext_vector_type(4)));
typedef unsigned u32x4 __attribute__((ext_vector_type(4)));
constexpr int BM = 256, BK = 64, HALF = 128, HTB = HALF * BK * 2  , STAGE_BYTES = 8 * HTB, NXCD = 8, WGM = 8;

__host__ __device__ __forceinline__ int lds_byte(int r, int c) { const int st = (r >> 4) * 2 + (c >> 5), rr = r & 15, cc = c & 31, ob = rr * 64 + cc * 2; return st * 1024 + (ob ^ (((ob >> 9) & 1) << 5)); }
__host__ __device__ __forceinline__ void stage_rc(int b, int& R, int& C) { const int st = b / 1024, sb = b % 1024, swz = sb ^ (((sb >> 9) & 1) << 5); R = (st >> 1) * 16 + swz / 64; C = (st & 1) * 32 + (swz % 64) / 2; }
__host__ __device__ __forceinline__ int perm32(int rho) { const int n = rho >> 4, i = rho & 15; return 8 * (i >> 2) + 4 * n + (i & 3); }

struct Unit { int pm, pn; };
struct Gemm { const bf16_t* A; const bf16_t* Bt; int M, N, K; };

struct StaticOrder {
    static constexpr bool GATHER = false;
    int nM, nN, nwg, G, c;
    __device__ __forceinline__ unsigned a_off(const Unit&, int) const { return 0u; }
    __host__ __device__ void init(int M, int N, int G_, int c_) { nM = M / BM; nN = N / BM; nwg = nM * nN; G = G_; c = c_; }
    __host__ __device__ bool next(int i, Unit& u) const {
        const long L = (long)i * G + c; if (L >= nwg) return false;
        int wgid = (int)L; { const int q = nwg / NXCD, r = nwg % NXCD, xcd = wgid % NXCD, off = wgid / NXCD; wgid = (xcd < r ? xcd * (q + 1) : r * (q + 1) + (xcd - r) * q) + off; }
        const int nig = WGM * nN, gid = wgid / nig, fm = gid * WGM, gsz = (nM - fm) < WGM ? (nM - fm) : WGM;
        u.pm = fm + ((wgid % nig) % gsz); u.pn = (wgid % nig) / gsz; return true;
    }
    __device__ __forceinline__ void a_ready(const Unit&) const {}
    __device__ __forceinline__ void done(const Unit&) const {}
};
__device__ __forceinline__ unsigned cvt_pk_bf16(float lo, float hi) { unsigned r; asm volatile("v_cvt_pk_bf16_f32 %0, %1, %2" : "=v"(r) : "v"(lo), "v"(hi)); return r; }
typedef float f32x2 __attribute__((ext_vector_type(2)));
struct EpiBf16 {
    static constexpr bool PERM = true, AFTER_DRAIN = false;
    bf16_t* O; int ldc;
    __device__ __forceinline__ void operator()(const f32x4 (&acc)[2][2][4][2], const Unit& u, int wr, int wc, int fr, int fq) const {
        const int row0 = u.pm * BM + wr * 64 + fr; const int col0 = u.pn * BM + wc * 32 + 8 * fq;
#pragma unroll
        for (int ai = 0; ai < 2; ++ai)
#pragma unroll
            for (int m = 0; m < 4; ++m) { bf16_t* rowp = O + (size_t)(row0 + ai * HALF + m * 16) * ldc + col0;
#pragma unroll
                for (int bj = 0; bj < 2; ++bj) { const f32x4 v0 = acc[ai][bj][m][0], v1 = acc[ai][bj][m][1];
                    u32x4 w; w.x = cvt_pk_bf16(v0[0], v0[1]); w.y = cvt_pk_bf16(v0[2], v0[3]); w.z = cvt_pk_bf16(v1[0], v1[1]); w.w = cvt_pk_bf16(v1[2], v1[3]);
                    *(u32x4*)(rowp + bj * HALF) = w; } }
    }
};
struct EpiBf16S {
    static constexpr bool PERM = true, AFTER_DRAIN = false;
    bf16_t* O; int ldc; float sc;
    __device__ __forceinline__ void operator()(const f32x4 (&acc)[2][2][4][2], const Unit& u, int wr, int wc, int fr, int fq) const {
        const int row0 = u.pm * BM + wr * 64 + fr; const int col0 = u.pn * BM + wc * 32 + 8 * fq;
#pragma unroll
        for (int ai = 0; ai < 2; ++ai)
#pragma unroll
            for (int m = 0; m < 4; ++m) { bf16_t* rowp = O + (size_t)(row0 + ai * HALF + m * 16) * ldc + col0;
#pragma unroll
                for (int bj = 0; bj < 2; ++bj) { const f32x4 v0 = acc[ai][bj][m][0] * sc, v1 = acc[ai][bj][m][1] * sc;
                    u32x4 w; w.x = cvt_pk_bf16(v0[0], v0[1]); w.y = cvt_pk_bf16(v0[2], v0[3]); w.z = cvt_pk_bf16(v1[0], v1[1]); w.w = cvt_pk_bf16(v1[2], v1[3]);
                    *(u32x4*)(rowp + bj * HALF) = w; } }
    }
};
struct EpiF32 {
    static constexpr bool PERM = false, AFTER_DRAIN = false;
    float* C; int ldc;
    __device__ __forceinline__ void operator()(const f32x4 (&acc)[2][2][4][2], const Unit& u, int wr, int wc, int fr, int fq) const {
        const int row0 = u.pm * BM + wr * 64 + fr, col0 = u.pn * BM + wc * 32 + 4 * fq;
#pragma unroll
        for (int ai = 0; ai < 2; ++ai)
#pragma unroll
            for (int m = 0; m < 4; ++m) { float* rowp = C + (size_t)(row0 + ai * HALF + m * 16) * ldc + col0;
#pragma unroll
                for (int bj = 0; bj < 2; ++bj)
#pragma unroll
                    for (int n = 0; n < 2; ++n) *(f32x4*)(rowp + bj * HALF + n * 16) = acc[ai][bj][m][n]; }
    }
};
__device__ __forceinline__ float silu_f(float x) { return x * __builtin_amdgcn_rcpf(1.0f + __expf(-x)); }
struct EpiSwiGLU {
    static constexpr bool PERM = true, AFTER_DRAIN = false;
    bf16_t* O; int ldc; int tiles_per_group;
    __device__ __forceinline__ void operator()(const f32x4 (&acc)[2][2][4][2], const Unit& u, int wr, int wc, int fr, int fq) const {
        const int row0 = u.pm * BM + wr * 64 + fr; const int pnl = u.pn % tiles_per_group; const int col0 = pnl * HALF + wc * 32 + 8 * fq;
#pragma unroll
        for (int ai = 0; ai < 2; ++ai)
#pragma unroll
            for (int m = 0; m < 4; ++m) { bf16_t* rowp = O + (size_t)(row0 + ai * HALF + m * 16) * ldc + col0;
                float h[8];
#pragma unroll
                for (int n = 0; n < 2; ++n)
#pragma unroll
                    for (int j = 0; j < 4; ++j) h[4 * n + j] = silu_f(acc[ai][0][m][n][j]) * acc[ai][1][m][n][j];
                u32x4 w; w.x = cvt_pk_bf16(h[0], h[1]); w.y = cvt_pk_bf16(h[2], h[3]); w.z = cvt_pk_bf16(h[4], h[5]); w.w = cvt_pk_bf16(h[6], h[7]);
                *(u32x4*)rowp = w; }
    }
};
struct MoeMap {
    int cnt[8], poff[9]; const int* list;
    __device__ __forceinline__ void init(const unsigned* counters, const int* list_) { list = list_; poff[0] = 0;
#pragma unroll
        for (int e = 0; e < 8; ++e) { cnt[e] = __builtin_amdgcn_readfirstlane((int)__hip_atomic_load(counters + e * 64, __ATOMIC_RELAXED, __HIP_MEMORY_SCOPE_AGENT));     poff[e + 1] = poff[e] + ((cnt[e] + 255) >> 8); } }
    __device__ __forceinline__ void locate(int P, int& e, int& lr, int& ce) const { e = 0; int pe = 0; ce = cnt[0];
#pragma unroll
        for (int j = 1; j < 8; ++j) if (P >= poff[j]) { e = j; pe = poff[j]; ce = cnt[j]; }
        lr = 256 * (P - pe); }
};
template <bool MOE> struct EpiSwiGLU8 {
    static constexpr bool PERM = true, AFTER_DRAIN = false;
    unsigned char* O; int ldc; int tiles_per_group; const float* rs; float sw; MoeMap M;
    __device__ __forceinline__ void operator()(const f32x4 (&acc)[2][2][4][2], const Unit& u, int wr, int wc, int fr, int fq) const {
        const int row0 = u.pm * BM + wr * 64 + fr; const int pnl = u.pn % tiles_per_group; const int col0 = pnl * HALF + wc * 32 + 8 * fq;
        float sc[2][4];
        if constexpr (MOE) { int e, lr, ce; M.locate(u.pm, e, lr, ce); const int* lst = M.list + e * 16384;
#pragma unroll
            for (int ai = 0; ai < 2; ++ai)
#pragma unroll
                for (int m = 0; m < 4; ++m) { const int r = lr + wr * 64 + fr + ai * HALF + m * 16; sc[ai][m] = rs[(r < ce) ? (lst[r] >> 1) : 0] * sw; }
        } else {
#pragma unroll
            for (int ai = 0; ai < 2; ++ai)
#pragma unroll
                for (int m = 0; m < 4; ++m) sc[ai][m] = rs[row0 + ai * HALF + m * 16] * sw;
        }
#pragma unroll
        for (int ai = 0; ai < 2; ++ai)
#pragma unroll
            for (int m = 0; m < 4; ++m) { unsigned char* rowp = O + (size_t)(row0 + ai * HALF + m * 16) * ldc + col0;
                float h[8];
#pragma unroll
                for (int n = 0; n < 2; ++n)
#pragma unroll
                    for (int j = 0; j < 4; ++j) { const float ag = acc[ai][0][m][n][j], au = acc[ai][1][m][n][j]; const float g = (float)__float_as_int(ag) * sc[ai][m], up = (float)__float_as_int(au) * sc[ai][m]; h[4 * n + j] = __builtin_fminf(__builtin_fmaxf(silu_f(g) * up, -448.f), 448.f); }
                unsigned w0 = 0u, w1 = 0u; w0 = __builtin_amdgcn_cvt_pk_fp8_f32(h[0], h[1], w0, false); w0 = __builtin_amdgcn_cvt_pk_fp8_f32(h[2], h[3], w0, true); w1 = __builtin_amdgcn_cvt_pk_fp8_f32(h[4], h[5], w1, false); w1 = __builtin_amdgcn_cvt_pk_fp8_f32(h[6], h[7], w1, true);
                typedef unsigned u32x2_ __attribute__((ext_vector_type(2))); u32x2_ w; w.x = w0; w.y = w1; *(u32x2_*)rowp = w;
                if (MOE && pnl == tiles_per_group - 1) { u32x2_ z; z.x = 0u; z.y = 0u; *(u32x2_*)(rowp + HALF) = z; } }
    }
};
struct EpiScatter {
    static constexpr bool PERM = true, AFTER_DRAIN = false;
    bf16_t* O; MoeMap M; float sc;
    __device__ __forceinline__ void operator()(const f32x4 (&acc)[2][2][4][2], const Unit& u, int wr, int wc, int fr, int fq) const {
        int e, lr, cnt; M.locate(u.pm, e, lr, cnt);
        const int pnl = u.pn & 3; const int col0 = pnl * BM + wc * 32 + 8 * fq; const int* lst = M.list + e * 16384;
#pragma unroll
        for (int ai = 0; ai < 2; ++ai)
#pragma unroll
            for (int m = 0; m < 4; ++m) { const int r = lr + wr * 64 + fr + ai * HALF + m * 16;
                if (r < cnt) { const int slot = lst[r]; bf16_t* rowp = O + (size_t)slot * 1024 + col0;
#pragma unroll
                    for (int bj = 0; bj < 2; ++bj) { const f32x4 v0 = acc[ai][bj][m][0] * sc, v1 = acc[ai][bj][m][1] * sc;
                        u32x4 w; w.x = cvt_pk_bf16(v0[0], v0[1]); w.y = cvt_pk_bf16(v0[2], v0[3]); w.z = cvt_pk_bf16(v1[0], v1[1]); w.w = cvt_pk_bf16(v1[2], v1[3]);
                        *(u32x4*)(rowp + bj * HALF) = w; } } }
    }
};
template <bool GATHER_> struct MoeOrder {
    static constexpr bool GATHER = GATHER_;
    MoeMap M; int tpg, G, c, nunits; unsigned rowbytes;
    __device__ __forceinline__ bool next(int i, Unit& u) const {
        const int L = i * G + c; if (L >= nunits) return false;
        int wgid = L; { const int q = nunits / NXCD, r = nunits % NXCD, xcd = wgid % NXCD, off = wgid / NXCD; wgid = (xcd < r ? xcd * (q + 1) : r * (q + 1) + (xcd - r) * q) + off; }
        const int P = wgid / tpg, pnl = wgid - P * tpg; int e, lr, ce; M.locate(P, e, lr, ce);
        u.pm = P; u.pn = e * tpg + pnl; return true;
    }
    __device__ __forceinline__ unsigned a_off(const Unit& u, int row) const {
        int e, lr, ce; M.locate(u.pm, e, lr, ce); const int r = lr + row; const int tok = (r < ce) ? (M.list[e * 16384 + r] >> 1) : 0; return (unsigned)tok * rowbytes; }
    __device__ __forceinline__ void a_ready(const Unit&) const {}
    __device__ __forceinline__ void done(const Unit&) const {}
};
typedef int i32x4 __attribute__((ext_vector_type(4))); typedef int i32x8 __attribute__((ext_vector_type(8)));
template <class Epi, class Sched, bool ALIGN_EPI = false, bool SP2 = false, int MT = 0  >
__device__ __forceinline__ void gemm_phase(PG8_LAS unsigned char* lds, const Gemm g, const Sched& S, const Epi& E, const int wave_in) {
    int tid_ = wave_in * 64 + lane_id_now(); asm volatile("" : "+v"(tid_));
    const int tid = tid_, wid = __builtin_amdgcn_readfirstlane(tid >> 6), lane = tid & 63, wr = wid >> 2, wc = wid & 3, fr = lane & 15, fq = lane >> 4;
    const int K = g.K, nt = K / BK;
    unsigned voffA[2], voffB[2];
#pragma unroll
    for (int i = 0; i < 2; ++i) { int R, C; stage_rc(tid * 16 + i * 8192, R, C); const int Rb = Epi::PERM ? ((R & ~31) + perm32(R & 31)) : R;
        voffA[i] = (unsigned)(R * K + C) * 2u; voffB[i] = (unsigned)(Rb * K + C) * 2u; }
    static_assert(!Sched::GATHER || SP2, "A-row gather is implemented for the SP2 loop");
    unsigned aoc[2][2], aon[2][2];
#define PG8_GOFF(dst, u) do { _Pragma("unroll") for (int _i = 0; _i < 2; ++_i) { int R_, C_; stage_rc(tid * 16 + _i * 8192, R_, C_); _Pragma("unroll") for (int _h = 0; _h < 2; ++_h) dst[_h][_i] = S.a_off(u, _h * HALF + R_) + (unsigned)(C_ * 2); } } while (0)
#define PG8_STAGE_A(bufoff, gbase, kofs, h, nx) do { if constexpr (Sched::GATHER) { const unsigned vo_[2] = {(nx) ? aon[h][0] : aoc[h][0], (nx) ? aon[h][1] : aoc[h][1]}; PG8_STAGE(bufoff, (const char*)g.A + (kofs), vo_); } else { PG8_STAGE(bufoff, gbase, voffA); } } while (0)
    const size_t kstep = (size_t)(BK * 2);
    const size_t hstep = (size_t)HALF * K * 2;
    const size_t tstep = 2 * hstep;
    const unsigned ldsw = (unsigned)wid * 1024u;
    const int aoff = lds_byte(wr * 64 + fr, fq * 8), boff = lds_byte(wc * 32 + fr, fq * 8);
#define PG8_SA(b, h) (((b) * 2 + (h)) * HTB)
#define PG8_SB(b, h) ((4 + (b) * 2 + (h)) * HTB)
#define PG8_STAGE(bufoff, gbase, voff) do { _Pragma("unroll") for (int _i = 0; _i < 2; ++_i) { unsigned o_ = (voff)[_i]; asm volatile("" : "+v"(o_));     \
        __builtin_amdgcn_global_load_lds((const unsigned*)((const char*)(gbase) + o_), (PG8_LAS unsigned*)(lds + (bufoff) + ldsw + _i * 8192), 16, 0, 0); } } while (0)
#define PG8_LDA(dst, b, h) do { _Pragma("unroll") for (int m = 0; m < 4; ++m) _Pragma("unroll") for (int k = 0; k < 2; ++k) dst[m][k] = *(const PG8_LAS bf16x8*)(lds + PG8_SA(b, h) + aoff + m * 2048 + k * 1024); } while (0)
#define PG8_LDB(dst, b, h) do { _Pragma("unroll") for (int n = 0; n < 2; ++n) _Pragma("unroll") for (int k = 0; k < 2; ++k) dst[n][k] = *(const PG8_LAS bf16x8*)(lds + PG8_SB(b, h) + boff + n * 2048 + k * 1024); } while (0)
#define PG8_MMA(ai, bj, At, Bt) do { __builtin_amdgcn_s_setprio(1); _Pragma("unroll") for (int m = 0; m < 4; ++m) _Pragma("unroll") for (int n = 0; n < 2; ++n) _Pragma("unroll") for (int k = 0; k < 2; ++k) \
        { if constexpr (MT == 0) acc[ai][bj][m][n] = __builtin_amdgcn_mfma_f32_16x16x32_bf16(Bt[n][k], At[m][k], acc[ai][bj][m][n], 0, 0, 0); \
          else if constexpr (MT == 1) acc[ai][bj][m][n] = __builtin_bit_cast(f32x4, __builtin_amdgcn_mfma_i32_16x16x64_i8(__builtin_bit_cast(i32x4, Bt[n][k]), __builtin_bit_cast(i32x4, At[m][k]), __builtin_bit_cast(i32x4, acc[ai][bj][m][n]), 0, 0, 0)); \
          else { if (k == 0) { const i32x8 b8_ = __builtin_shufflevector(__builtin_bit_cast(i32x4, Bt[n][0]), __builtin_bit_cast(i32x4, Bt[n][1]), 0, 1, 2, 3, 4, 5, 6, 7), a8_ = __builtin_shufflevector(__builtin_bit_cast(i32x4, At[m][0]), __builtin_bit_cast(i32x4, At[m][1]), 0, 1, 2, 3, 4, 5, 6, 7); \
              asm volatile("v_mfma_f32_16x16x128_f8f6f4 %0, %1, %2, %0" : "+v"(acc[ai][bj][m][n]) : "v"(b8_), "v"(a8_)); } } }     \
        __builtin_amdgcn_s_setprio(0); } while (0)
#define PG8_WAIT_V(n) asm volatile("s_waitcnt vmcnt(" #n ")" ::: "memory")
#define PG8_WAIT_L(n) asm volatile("s_waitcnt lgkmcnt(" #n ")" ::: "memory")
#define PG8_BAR __builtin_amdgcn_s_barrier()
#define PG8_SCHED __builtin_amdgcn_sched_barrier(0)
    Unit cur, nxt; int ui = 0;
    if (!S.next(0, cur)) return;
    f32x4 acc[2][2][4][2];
#pragma unroll
    for (int a = 0; a < 2; ++a)
#pragma unroll
        for (int b = 0; b < 2; ++b)
#pragma unroll
            for (int m = 0; m < 4; ++m)
#pragma unroll
                for (int n = 0; n < 2; ++n) acc[a][b][m][n] = (f32x4){0.f, 0.f, 0.f, 0.f};
    bf16x8 At[4][2], B0[2][2], B1[2][2];
    const char* cA = (const char*)g.A + (size_t)cur.pm * tstep; const char* cB = (const char*)g.Bt + (size_t)cur.pn * tstep;
    S.a_ready(cur);
    if constexpr (SP2) {
        if constexpr (Sched::GATHER) { PG8_GOFF(aoc, cur); }
        PG8_STAGE(PG8_SB(0, 0), cB, voffB); PG8_STAGE(PG8_SB(0, 1), cB + hstep, voffB); PG8_STAGE_A(PG8_SA(0, 0), cA, (size_t)0, 0, false); PG8_STAGE_A(PG8_SA(0, 1), cA + hstep, (size_t)0, 1, false);
        if (wr == 1) PG8_BAR;
        PG8_WAIT_V(2); PG8_BAR;
        PG8_STAGE(PG8_SB(1, 0), cB + kstep, voffB); PG8_STAGE_A(PG8_SA(1, 0), cA + kstep, kstep, 0, false); PG8_STAGE(PG8_SB(1, 1), cB + hstep + kstep, voffB);
        PG8_WAIT_V(6); PG8_BAR;
    } else {
        PG8_STAGE(PG8_SB(0, 0), cB, voffB); PG8_STAGE(PG8_SA(0, 0), cA, voffA); PG8_STAGE(PG8_SB(0, 1), cB + hstep, voffB); PG8_STAGE(PG8_SA(0, 1), cA + hstep, voffA);
        if (wr == 1) PG8_BAR;
        PG8_WAIT_V(4); PG8_BAR;
        PG8_STAGE(PG8_SB(1, 0), cB + kstep, voffB); PG8_STAGE(PG8_SA(1, 0), cA + kstep, voffA); PG8_STAGE(PG8_SB(1, 1), cB + hstep + kstep, voffB);
        PG8_WAIT_V(6); PG8_BAR;
    }
    for (;;) {
        const bool has_next = S.next(ui + 1, nxt);
        const char* nA = has_next ? (const char*)g.A + (size_t)nxt.pm * tstep : cA; const char* nB = has_next ? (const char*)g.Bt + (size_t)nxt.pn * tstep : cB;
        for (int t = 0; t < nt; t += 2) {
            const bool last = (t == nt - 2);
            const char* a1 = cA + (size_t)(t + 1) * kstep;
            const char* a2 = last ? nA : cA + (size_t)(t + 2) * kstep; const char* b2 = last ? nB : cB + (size_t)(t + 2) * kstep;
            const char* a3 = a2 + kstep; const char* b3 = b2 + kstep;
            if (last && has_next) S.a_ready(nxt);
            const size_t ko2 = last ? (size_t)0 : (size_t)(t + 2) * kstep;
            if constexpr (Sched::GATHER) { if (last) { if (has_next) { PG8_GOFF(aon, nxt); } else { _Pragma("unroll") for (int _h = 0; _h < 2; ++_h) { aon[_h][0] = aoc[_h][0]; aon[_h][1] = aoc[_h][1]; } } } }
            if constexpr (SP2) {
            PG8_LDB(B0, 0, 0); PG8_LDB(B1, 0, 1); PG8_SCHED; PG8_LDA(At, 0, 0); PG8_STAGE_A(PG8_SA(1, 1), a1 + hstep, (size_t)(t + 1) * kstep, 1, false);
            PG8_WAIT_V(8); PG8_WAIT_L(0); PG8_BAR; PG8_MMA(0, 0, At, B0); PG8_MMA(0, 1, At, B1); PG8_BAR; PG8_SCHED;
            PG8_LDA(At, 0, 1); PG8_STAGE(PG8_SB(0, 0), b2, voffB); PG8_STAGE(PG8_SB(0, 1), b2 + hstep, voffB); PG8_STAGE_A(PG8_SA(0, 0), a2, ko2, 0, last);
            PG8_WAIT_V(8); PG8_WAIT_L(0); PG8_BAR; PG8_MMA(1, 0, At, B0); PG8_MMA(1, 1, At, B1); PG8_BAR; PG8_SCHED;
            PG8_LDB(B0, 1, 0); PG8_LDB(B1, 1, 1); PG8_SCHED; PG8_LDA(At, 1, 0); PG8_STAGE_A(PG8_SA(0, 1), a2 + hstep, ko2, 1, last);
            PG8_WAIT_V(8); PG8_WAIT_L(0); PG8_BAR; PG8_MMA(0, 0, At, B0); PG8_MMA(0, 1, At, B1); PG8_BAR; PG8_SCHED;
            PG8_LDA(At, 1, 1); PG8_STAGE(PG8_SB(1, 0), b3, voffB); PG8_STAGE(PG8_SB(1, 1), b3 + hstep, voffB); PG8_STAGE_A(PG8_SA(1, 0), a3, ko2 + kstep, 0, last);
            PG8_WAIT_V(8); PG8_WAIT_L(0); PG8_BAR; PG8_MMA(1, 0, At, B0); PG8_MMA(1, 1, At, B1); PG8_BAR; PG8_SCHED;
            } else {
            PG8_LDB(B0, 0, 0); PG8_SCHED; PG8_LDA(At, 0, 0); PG8_STAGE(PG8_SA(1, 1), a1 + hstep, voffA);
            PG8_WAIT_L(8); PG8_BAR; PG8_WAIT_L(0); PG8_MMA(0, 0, At, B0); PG8_BAR; PG8_SCHED;
            PG8_LDB(B1, 0, 1); PG8_STAGE(PG8_SB(0, 0), b2, voffB);
            PG8_BAR; PG8_WAIT_L(0); PG8_MMA(0, 1, At, B1); PG8_BAR;
            PG8_LDA(At, 0, 1); PG8_STAGE(PG8_SA(0, 0), a2, voffA);
            PG8_BAR; PG8_WAIT_L(0); PG8_MMA(1, 0, At, B0); PG8_BAR; PG8_SCHED;
            PG8_STAGE(PG8_SB(0, 1), b2 + hstep, voffB);
            PG8_WAIT_V(6); PG8_BAR; PG8_MMA(1, 1, At, B1); PG8_BAR;
            PG8_LDB(B0, 1, 0); PG8_SCHED; PG8_LDA(At, 1, 0); PG8_STAGE(PG8_SA(0, 1), a2 + hstep, voffA);
            PG8_WAIT_L(8); PG8_BAR; PG8_WAIT_L(0); PG8_MMA(0, 0, At, B0); PG8_BAR; PG8_SCHED;
            PG8_LDB(B1, 1, 1); PG8_STAGE(PG8_SB(1, 0), b3, voffB);
            PG8_BAR; PG8_WAIT_L(0); PG8_MMA(0, 1, At, B1); PG8_BAR;
            PG8_LDA(At, 1, 1); PG8_STAGE(PG8_SA(1, 0), a3, voffA);
            PG8_BAR; PG8_WAIT_L(0); PG8_MMA(1, 0, At, B0); PG8_BAR; PG8_SCHED;
            PG8_STAGE(PG8_SB(1, 1), b3 + hstep, voffB);
            PG8_WAIT_V(6); PG8_BAR; PG8_MMA(1, 1, At, B1); PG8_BAR;
            }
        }
        if constexpr (MT == 2) { asm volatile("s_nop 15\n\ts_nop 15" ::: "memory"); }
        if constexpr (ALIGN_EPI) { if (wr == 0) PG8_BAR; }
        if constexpr (!Epi::AFTER_DRAIN) { E(acc, cur, wr, wc, fr, fq); S.done(cur); }
        if (!has_next) break;
#pragma unroll
        for (int a = 0; a < 2; ++a)
#pragma unroll
            for (int b = 0; b < 2; ++b)
#pragma unroll
                for (int m = 0; m < 4; ++m)
#pragma unroll
                    for (int n = 0; n < 2; ++n) acc[a][b][m][n] = (f32x4){0.f, 0.f, 0.f, 0.f};
        cur = nxt; cA = nA; cB = nB; ++ui;
        if constexpr (Sched::GATHER) { _Pragma("unroll") for (int _h = 0; _h < 2; ++_h) { aoc[_h][0] = aon[_h][0]; aoc[_h][1] = aon[_h][1]; } }
        if constexpr (ALIGN_EPI) { if (wr == 1) PG8_BAR; }
    }
    PG8_WAIT_V(0);
    if constexpr (!ALIGN_EPI) { if (wr == 0) PG8_BAR; }
    PG8_BAR;
    if constexpr (Epi::AFTER_DRAIN) { E.fused(acc, cur, wr, wc, fr, fq, lds, wid, lane); S.done(cur); }
#undef PG8_SA
#undef PG8_SB
#undef PG8_STAGE
#undef PG8_STAGE_A
#undef PG8_GOFF
#undef PG8_LDA
#undef PG8_LDB
#undef PG8_MMA
#undef PG8_WAIT_V
#undef PG8_WAIT_L
#undef PG8_BAR
#undef PG8_SCHED
}
}
constexpr int NWAVES = 8;
constexpr int TOK = 16384, SEQ = 4096, D = 1024, NP = 4096, INC = 3888, DEPTH = 4;
constexpr int HG_Q = 0, HG_F = 256, HG_I = 512, HG_G = 768;
constexpr int GL_Q = 1024, GL_K = 1152, GL_V = 1280, GL_GLR = 1536, GL_R = 1552;
constexpr int RW_BASE = 1808, RW_R = 1808, RW_K = 2064, RW_V = 2320, RW_WLR = 2576, RW_ALR = 2640, RW_GLR = 2704;
constexpr int RT_Q = 2864, RT_K = 3120, RT_V = 3376, RT_G = 3632;
constexpr int GL_GX = 3904;
constexpr int FFD = 2816, FFE = 1408, NE = 8, FFEP = 1536;
constexpr float DN_ALPHA = 1.6817928305074290f;
constexpr int NPH = 12;
constexpr int NPHASES = NPH * DEPTH;
constexpr size_t MiB = 1u << 20;
constexpr size_t WS_CTL = 0, CTL_ZERO_BYTES = 1 * MiB;
constexpr size_t WS_LIST = 1 * MiB;
constexpr size_t WS_GATE = 2 * MiB;
constexpr size_t WS_TAB = 3 * MiB;
constexpr size_t WS_WIN = 4 * MiB, WS_WOUT = 12 * MiB, WS_WUP = 14 * MiB, WS_WDN = 58 * MiB;
constexpr size_t WS_HB = 80 * MiB;
constexpr size_t WS_MIX = 112 * MiB;
constexpr size_t WS_O = WS_MIX;
constexpr size_t WS_OI = 144 * MiB;
constexpr size_t OI_GEN = 64 * 4096 * 16;
constexpr size_t WS_VF = 176 * MiB;
constexpr size_t WS_P = 184 * MiB;
constexpr size_t WS_RWW = 312 * MiB;
constexpr size_t WS_RWR = 328 * MiB, WS_RWK = 336 * MiB, WS_RWV = 344 * MiB, WS_RWKK = 352 * MiB, WS_RWB = 360 * MiB, WS_RWG = 368 * MiB;
constexpr size_t WS_Y = 376 * MiB;
constexpr size_t WS_CS = 461 * MiB;
constexpr size_t WS_HID = 184 * MiB;
constexpr size_t WS_DOUT = 280 * MiB;
constexpr size_t WS_HPERM = 344 * MiB;
constexpr size_t WS_H8 = 344 * MiB;
constexpr size_t WS_RS = 360 * MiB;
constexpr size_t WS_WOUT2 = 465 * MiB;
constexpr size_t WS_END = 467 * MiB;
constexpr int CW_BAR = 4096;
constexpr int CW_CNT = 16384;
constexpr int CW_AMAX = 20480;
constexpr int CW_AMAXD = 24576;
constexpr int TAB_STRIDE = 4 * 160 + 16;
constexpr size_t WS_LORA = 2 * MiB + 512 * 1024;
constexpr int LO_W2 = 0, LO_A2 = 256 * 64, LO_G2 = 2 * 256 * 64, LO_V1 = LO_G2 + 256 * 160, LO_V2 = LO_V1 + 32 * 256, LO_END = LO_V2 + 256 * 32;
constexpr int RING_BYTES = 131072, LDSCTL_OFF = 146432, MISC_OFF = LDSCTL_OFF + 320, LDS_BYTES = 147456;
#define GAS __attribute__((address_space(1)))
#define LAS __attribute__((address_space(3)))
typedef unsigned short bf16;
typedef unsigned v4u __attribute__((ext_vector_type(4)));
typedef unsigned v2u __attribute__((ext_vector_type(2)));
typedef float f32x4 __attribute__((ext_vector_type(4)));
typedef short bf16x8 __attribute__((ext_vector_type(8)));
typedef GAS unsigned gu32;
#define RLX_AGENT __ATOMIC_RELAXED, __HIP_MEMORY_SCOPE_AGENT
#define LDS_WAIT() asm volatile("s_waitcnt lgkmcnt(0)" ::: "memory")
#define VM_WAIT() asm volatile("s_waitcnt vmcnt(0)" ::: "memory")
#define LDS_BARRIER() do { asm volatile("s_waitcnt lgkmcnt(0)" ::: "memory"); __builtin_amdgcn_s_barrier(); asm volatile("" ::: "memory"); } while (0)
typedef float f32x2_t __attribute__((ext_vector_type(2))); typedef __bf16 bf16x2_t __attribute__((ext_vector_type(2)));
__device__ __forceinline__ unsigned pk2(float lo, float hi) { f32x2_t v = {lo, hi}; bf16x2_t b = __builtin_convertvector(v, bf16x2_t); return __builtin_bit_cast(unsigned, b); }
__device__ __forceinline__ unsigned f2bf(float f) { return pk2(f, f) & 0xffffu; }
__device__ __forceinline__ float bflo(unsigned w) { return __builtin_bit_cast(float, w << 16); }
__device__ __forceinline__ float bfhi(unsigned w) { return __builtin_bit_cast(float, w & 0xffff0000u); }
__device__ __forceinline__ float bf1(bf16 b) { return __builtin_bit_cast(float, ((unsigned)b) << 16); }
__device__ __forceinline__ void unpack8(const v4u w, float (&f)[8]) { f[0] = bflo(w.x); f[1] = bfhi(w.x); f[2] = bflo(w.y); f[3] = bfhi(w.y); f[4] = bflo(w.z); f[5] = bfhi(w.z); f[6] = bflo(w.w); f[7] = bfhi(w.w); }
__device__ __forceinline__ v4u pack8(const float (&f)[8]) { v4u w; w.x = pk2(f[0], f[1]); w.y = pk2(f[2], f[3]); w.z = pk2(f[4], f[5]); w.w = pk2(f[6], f[7]); return w; }
__device__ __forceinline__ float sigm(float x) { return __builtin_amdgcn_rcpf(1.0f + __expf(-x)); }
template <int CTRL> __device__ __forceinline__ float dpp(float x) { return __builtin_bit_cast(float, __builtin_amdgcn_mov_dpp(__builtin_bit_cast(int, x), CTRL, 0xf, 0xf, true)); }
__device__ __forceinline__ float sum16(float x) { x += dpp<0xB1>(x); x += dpp<0x4E>(x); x += dpp<0x141>(x); x += dpp<0x128>(x); return x; }
__device__ __forceinline__ float sum4(float x) { x += dpp<0xB1>(x); x += dpp<0x4E>(x); return x; }
__device__ __forceinline__ float wave_sum(float x) {
    x = sum16(x);
    auto s = __builtin_amdgcn_permlane16_swap(__float_as_uint(x), __float_as_uint(x), false, false); x = __uint_as_float(s[0]) + __uint_as_float(s[1]);
    auto t = __builtin_amdgcn_permlane32_swap(__float_as_uint(x), __float_as_uint(x), false, false); return __uint_as_float(t[0]) + __uint_as_float(t[1]);
}
__device__ __forceinline__ float wave_max(float x) {
    x = fmaxf(x, dpp<0xB1>(x)); x = fmaxf(x, dpp<0x4E>(x)); x = fmaxf(x, dpp<0x141>(x)); x = fmaxf(x, dpp<0x128>(x));
    auto s = __builtin_amdgcn_permlane16_swap(__float_as_uint(x), __float_as_uint(x), false, false); x = fmaxf(__uint_as_float(s[0]), __uint_as_float(s[1]));
    auto t = __builtin_amdgcn_permlane32_swap(__float_as_uint(x), __float_as_uint(x), false, false); return fmaxf(__uint_as_float(t[0]), __uint_as_float(t[1]));
}
__device__ __forceinline__ unsigned pack_i8(float a, float b, float c, float d) {
    const int ia = (int)__builtin_rintf(a), ib = (int)__builtin_rintf(b), ic = (int)__builtin_rintf(c), id = (int)__builtin_rintf(d);
    return ((unsigned)ia & 255u) | (((unsigned)ib & 255u) << 8) | (((unsigned)ic & 255u) << 16) | ((unsigned)id << 24);
}
__device__ const double INVF2PI[32] = {0.15915494309189535, 0.11934937021124886, 0.08949940160889101, 0.06711508300522726, 0.050329212104487035, 0.03774158471741977, 0.0283021958306234, 0.02122365276477766, 0.015915494309189534, 0.011934937021124886, 0.008949940160889102, 0.006711508300522725, 0.005032921210448704, 0.003774158471741977, 0.00283021958306234, 0.0021223652764777662, 0.0015915494309189536, 0.0011934937021124885, 0.0008949940160889102, 0.0006711508300522726, 0.0005032921210448703, 0.00037741584717419774, 0.00028302195830623395, 0.0002122365276477766, 0.00015915494309189535, 0.00011934937021124886, 8.949940160889102e-05, 6.711508300522725e-05, 5.0329212104487035e-05, 3.774158471741978e-05, 2.8302195830623396e-05, 2.122365276477766e-05};
#define XB_TMO      128
#define XB_XCNT(j)  (256  + 64 * (j))
#define XB_XSUB(j)  (1280 + 64 * (j))
#define XB_XGEN(j)  (2304 + 64 * (j))
#define XB_TOP      3328
#define XB_TOPGEN   3392
#define XCD_BAR_WORDS 3456
#define XB_SPIN_CAP (1u << 18)

__device__ __forceinline__ unsigned xb_ld(unsigned* p)              { return __hip_atomic_load(p, __ATOMIC_RELAXED, __HIP_MEMORY_SCOPE_AGENT); }
__device__ __forceinline__ unsigned xb_add(unsigned* p, unsigned v) { return __hip_atomic_fetch_add(p, v, __ATOMIC_RELAXED, __HIP_MEMORY_SCOPE_AGENT); }
__device__ __forceinline__ unsigned xb_xcc_id() { return (unsigned)__builtin_amdgcn_s_getreg((3 << 11) | 20) & 0xFu; }
#define XB_SPIN(cond, bar) do { unsigned _sp = 0; while (cond) { __builtin_amdgcn_s_sleep(1); \
    if ((++_sp & 255u) == 0u) { if (xb_ld(&(bar)[XB_TMO])) break; if (_sp > XB_SPIN_CAP) { atomicAdd(&(bar)[XB_TMO], 1u); break; } } } } while (0)

struct XcdBarrier {
    unsigned* bar; unsigned x;
    volatile LAS unsigned* st;
    int wv;
};

__device__ __forceinline__ XcdBarrier xcd_barrier_post(unsigned* bar, volatile LAS unsigned* st) {
    XcdBarrier b; b.bar = bar; b.x = xb_xcc_id(); b.st = st; b.wv = __builtin_amdgcn_readfirstlane((int)threadIdx.x >> 6);
    if (threadIdx.x == 0) (void)xb_add(&bar[XB_XCNT(b.x)], 1u);
    return b;
}
__device__ __forceinline__ void xcd_barrier_complete(unsigned* bar, unsigned x, unsigned& nloc, unsigned& nx) {
    const unsigned G = gridDim.x * gridDim.y * gridDim.z;
    unsigned sum, cnt, mine, sp = 0u;
    for (;;) {
        sum = 0u; cnt = 0u; mine = 0u;
#pragma unroll 1
        for (unsigned j = 0; j < 16; ++j) { const unsigned c = xb_ld(&bar[XB_XCNT(j)]); sum += c; cnt += (c > 0u) ? 1u : 0u; mine = (j == x) ? c : mine; }
        if (sum == G) break;
        __builtin_amdgcn_s_sleep(1);
        if ((++sp & 255u) == 0u) { if (xb_ld(&bar[XB_TMO])) break; if (sp > XB_SPIN_CAP) { atomicAdd(&bar[XB_TMO], 1u); break; } }
    }
    nloc = mine > 0u ? mine : 1u; nx = cnt > 0u ? cnt : 1u;
}

__device__ __forceinline__ void xcd_barrier(const XcdBarrier& b) {
    asm volatile("s_waitcnt vmcnt(0)" ::: "memory");
    __syncthreads();
    if (b.wv == 0 && lane_id_now() == 0) {
        unsigned* bar = b.bar;
        __builtin_amdgcn_s_waitcnt(0);
        unsigned nloc = b.st[0], nx = b.st[1];
        if (nloc == 0u) { xcd_barrier_complete(bar, b.x, nloc, nx); b.st[0] = nloc; b.st[1] = nx; }
        const unsigned old = xb_add(&bar[XB_XSUB(b.x)], 1u);
        const unsigned gen = old / nloc;
        if (old + 1u == (gen + 1u) * nloc) {
            __builtin_amdgcn_fence(__ATOMIC_RELEASE, "agent");
            asm volatile("s_waitcnt vmcnt(0)" ::: "memory");
            const unsigned og = xb_add(&bar[XB_TOP], 1u);
            const unsigned tg = og / nx;
            if (og + 1u == (tg + 1u) * nx) xb_add(&bar[XB_TOPGEN], 1u);
            else XB_SPIN(xb_ld(&bar[XB_TOPGEN]) == tg, bar);
            __builtin_amdgcn_fence(__ATOMIC_ACQUIRE, "agent");
            xb_add(&bar[XB_XGEN(b.x)], 1u);
            asm volatile("s_waitcnt vmcnt(0)" ::: "memory");
        } else {
            XB_SPIN(xb_ld(&bar[XB_XGEN(b.x)]) == gen, bar);
            __builtin_amdgcn_fence(__ATOMIC_ACQUIRE, "agent");
            asm volatile("s_waitcnt vmcnt(0)" ::: "memory");
        }
    }
    __syncthreads();
}
struct Frame {
    LAS unsigned char* lds;
    volatile LAS unsigned* MISC;
    gu32* ctl;
    int tid, lane, wave;
    int vcu, G;
    unsigned char* ws;
    const void* const* in;
    float* h;
};
__device__ __forceinline__ const void* ldptr(const void* const* tab, int k) { int z; asm volatile("s_mov_b32 %0, 0" : "=s"(z)); return tab[k + z]; }
#define INF(k) ((const float*)ldptr(F.in, k))
#define WSP(T, off) ((T*)(F.ws + (off)))

__device__ __forceinline__ void xpose_item(const float* W, int ldw, int nvalid, int k0, int n0, bf16* WT, int ldt, int drow0, LAS float* scr, int lane) {
    { float t_[32]; const int n = n0 + (lane & 31);
#pragma unroll
      for (int i = 0; i < 32; ++i) { const int kk = 2 * i + (lane >> 5); t_[i] = (n < nvalid) ? W[(size_t)(k0 + kk) * ldw + n] : 0.f; }
#pragma unroll
      for (int i = 0; i < 32; ++i) { const int kk = 2 * i + (lane >> 5); scr[kk * 33 + (lane & 31)] = t_[i]; } }
    LDS_WAIT(); asm volatile("" ::: "memory");
    const int c = lane & 7;
#pragma unroll
    for (int j = 0; j < 4; ++j) { const int n = (lane >> 3) + 8 * j; const LAS float* s = scr + (8 * c) * 33 + n;
        v4u o; o.x = pk2(s[0 * 33], s[1 * 33]); o.y = pk2(s[2 * 33], s[3 * 33]); o.z = pk2(s[4 * 33], s[5 * 33]); o.w = pk2(s[6 * 33], s[7 * 33]);
        *(GAS v4u*)(WT + (size_t)(drow0 + n) * ldt + k0 + 8 * c) = o; }
    LDS_WAIT(); asm volatile("" ::: "memory");
}
__device__ __forceinline__ void xpose_item8(const float* W, int ldw, int k0, int n0, unsigned char* WT, int ldt, int drow0, float qs, LAS float* scr, int lane) {
    { float t_[32]; const int n = n0 + (lane & 31);
#pragma unroll
      for (int i = 0; i < 32; ++i) { const int kk = 2 * i + (lane >> 5); t_[i] = W[(size_t)(k0 + kk) * ldw + n]; }
#pragma unroll
      for (int i = 0; i < 32; ++i) { const int kk = 2 * i + (lane >> 5); scr[kk * 33 + (lane & 31)] = t_[i]; } }
    LDS_WAIT(); asm volatile("" ::: "memory");
    const int c = lane & 7;
#pragma unroll
    for (int j = 0; j < 4; ++j) { const int n = (lane >> 3) + 8 * j; const LAS float* s = scr + (8 * c) * 33 + n;
        v2u o; o.x = pack_i8(s[0 * 33] * qs, s[1 * 33] * qs, s[2 * 33] * qs, s[3 * 33] * qs); o.y = pack_i8(s[4 * 33] * qs, s[5 * 33] * qs, s[6 * 33] * qs, s[7 * 33] * qs);
        *(GAS v2u*)(WT + (size_t)(drow0 + n) * ldt + k0 + 8 * c) = o; }
    LDS_WAIT(); asm volatile("" ::: "memory");
}
__device__ __forceinline__ void f8_scale(float am, float& s, float& inv) {
    const int e = (int)((__float_as_uint(am) >> 23) & 255u) - 127;
    if (am > 0.f && e > -100 && e < 100) { s = __uint_as_float((unsigned)(127 + 7 - e) << 23); inv = __uint_as_float((unsigned)(127 + e - 7) << 23); } else { s = 1.f; inv = 1.f; }
}
__device__ __forceinline__ unsigned pack_f8(float a, float b, float c, float d) {
    unsigned w = 0u; w = __builtin_amdgcn_cvt_pk_fp8_f32(a, b, w, false); w = __builtin_amdgcn_cvt_pk_fp8_f32(c, d, w, true); return w;
}
__device__ __forceinline__ void xpose_item_f8(const float* W, int ldw, int kvalid, int k0, int n0, unsigned char* WT, int ldt, int drow0, float qs, LAS float* scr, int lane) {
    const int c = lane & 7;
    if (k0 >= kvalid) {
#pragma unroll
        for (int j = 0; j < 4; ++j) { const int n = (lane >> 3) + 8 * j; v2u o; o.x = 0u; o.y = 0u; *(GAS v2u*)(WT + (size_t)(drow0 + n) * ldt + k0 + 8 * c) = o; }
        return; }
    { float t_[32]; const int n = n0 + (lane & 31);
#pragma unroll
      for (int i = 0; i < 32; ++i) { const int kk = 2 * i + (lane >> 5); t_[i] = W[(size_t)(k0 + kk) * ldw + n]; }
#pragma unroll
      for (int i = 0; i < 32; ++i) { const int kk = 2 * i + (lane >> 5); scr[kk * 33 + (lane & 31)] = t_[i]; } }
    LDS_WAIT(); asm volatile("" ::: "memory");
#pragma unroll
    for (int j = 0; j < 4; ++j) { const int n = (lane >> 3) + 8 * j; const LAS float* s = scr + (8 * c) * 33 + n;
        v2u o; o.x = pack_f8(s[0 * 33] * qs, s[1 * 33] * qs, s[2 * 33] * qs, s[3 * 33] * qs); o.y = pack_f8(s[4 * 33] * qs, s[5 * 33] * qs, s[6 * 33] * qs, s[7 * 33] * qs);
        *(GAS v2u*)(WT + (size_t)(drow0 + n) * ldt + k0 + 8 * c) = o; }
    LDS_WAIT(); asm volatile("" ::: "memory");
}
__device__ __forceinline__ int gu_row(int n) { return 256 * (n >> 7) + (n & 127); }
template <int PART> __device__ __forceinline__ void phase_weights(Frame& F, int l) {
    LAS float* scr = (LAS float*)(F.lds + F.wave * 16384);
    const int gw = F.vcu * NWAVES + F.wave, NGW = F.G * NWAVES;
    const bool moe = (l & 1); const int fi = l >> 1;
    constexpr int I_IN = 16 * 128, I_OUT = 16 * 32;
    constexpr int I_DG = 16 * 88, I_DD = 44 * 32;
    constexpr int I_MG = 16 * 44, I_MD = 24 * 32;
    const int nitems = PART == 0 ? (I_IN + I_OUT) : (moe ? NE * (2 * I_MG + I_MD) : (2 * I_DG + I_DD));
    float qs8 = 0.f; if (PART == 1) { const float am = __uint_as_float(__hip_atomic_load((unsigned*)(F.ctl + CW_AMAX + l * 64), RLX_AGENT)); qs8 = am > 0.f ? 127.f / am : 0.f; }
    float qsd = 1.f; if (PART == 1) { float inv_; f8_scale(__uint_as_float(__hip_atomic_load((unsigned*)(F.ctl + CW_AMAXD + l * 64), RLX_AGENT)), qsd, inv_); }
    for (int it = gw; it < nitems; it += NGW) {
        int r = it + (PART == 0 ? 0 : I_IN + I_OUT);
        if (r < I_IN) { const int kb = r >> 7, nb = r & 127; if (nb < 122) xpose_item(INF(2) + (size_t)l * D * INC, INC, INC, 64 * kb, 32 * nb, WSP(bf16, WS_WIN), D, 32 * nb, scr, F.lane); continue; } r -= I_IN;
        if (r < I_OUT) { const int kb = r >> 5, nb = r & 31; xpose_item(INF(3) + (size_t)l * D * D, D, D, 64 * kb, 32 * nb, WSP(bf16, (l & 1) ? WS_WOUT2 : WS_WOUT), D, 32 * nb, scr, F.lane); continue; } r -= I_OUT;
        if (!moe) {
            if (r < 2 * I_DG) { const int up = r >= I_DG; if (up) r -= I_DG; const int kb = r / 88, nb = r % 88;
                xpose_item8(INF(up ? 28 : 27) + (size_t)fi * D * FFD, FFD, 64 * kb, 32 * nb, WSP(unsigned char, WS_WUP), D, gu_row(32 * nb) + (up ? 128 : 0), qs8, scr, F.lane); continue; } r -= 2 * I_DG;
            { const int kb = r >> 5, nb = r & 31; xpose_item_f8(INF(29) + (size_t)fi * FFD * D, D, FFD, 64 * kb, 32 * nb, WSP(unsigned char, WS_WDN), FFD, 32 * nb, qsd, scr, F.lane); }
        } else {
            const int per = 2 * I_MG + I_MD; const int e = r / per; r -= e * per;
            if (r < 2 * I_MG) { const int up = r >= I_MG; if (up) r -= I_MG; const int kb = r / 44, nb = r % 44;
                xpose_item8(INF(up ? 32 : 31) + (size_t)(fi * NE + e) * D * FFE, FFE, 64 * kb, 32 * nb, WSP(unsigned char, WS_WUP) + (size_t)e * 2 * FFE * D, D, gu_row(32 * nb) + (up ? 128 : 0), qs8, scr, F.lane); continue; } r -= 2 * I_MG;
            { const int kb = r >> 5, nb = r & 31; xpose_item_f8(INF(33) + (size_t)(fi * NE + e) * FFE * D, D, FFE, 64 * kb, 32 * nb, WSP(unsigned char, WS_WDN) + (size_t)e * D * FFEP, FFEP, 32 * nb, qsd, scr, F.lane); }
        }
    }
    if (PART == 0) {
        const int gt = F.vcu * NWAVES * 64 + F.tid; int NT = F.G * NWAVES * 64; asm volatile("" : "+s"(NT));     const float* win = INF(2) + (size_t)l * D * INC; const float* gw2 = INF(10) + l * 16 * 128; bf16* WT = WSP(bf16, WS_WIN);
        for (int e = gt; e < 128 * D; e += NT) { const int n = e >> 10, d = e & 1023; const float* wr = win + (size_t)d * INC + (GL_GLR - 0); float a = 0.f;
#pragma unroll
            for (int r = 0; r < 16; ++r) a += wr[r] * gw2[r * 128 + n];
            WT[(size_t)(GL_GX + n) * D + d] = (bf16)f2bf(a); }
        if (l == 0) {
            f32x2_t* CS = WSP(f32x2_t, WS_CS); const int* pos = (const int*)ldptr(F.in, 1);
            for (int e = gt; e < TOK * 32; e += NT) { const int t = e >> 5, i = e & 31; const double rev = (double)pos[t] * INVF2PI[i]; const float fr_ = (float)(rev - floor(rev));
                f32x2_t cs; cs.x = __builtin_amdgcn_cosf(fr_); cs.y = __builtin_amdgcn_sinf(fr_); CS[e] = cs; } }
    }
    if (PART == 0) {
        bf16* LO = WSP(bf16, WS_LORA); const int gt = F.vcu * NWAVES * 64 + F.tid; int NT = F.G * NWAVES * 64; asm volatile("" : "+s"(NT));
        const float* w2 = INF(15) + (size_t)l * 64 * 256; const float* a2 = INF(17) + (size_t)l * 64 * 256; const float* g2 = INF(18) + (size_t)l * 160 * 256;
        for (int e = gt; e < LO_END; e += NT) { float v;
            if (e < LO_A2) { const int n = e >> 6, k = e & 63; v = w2[k * 256 + n]; }
            else if (e < LO_G2) { const int q = e - LO_A2, n = q >> 6, k = q & 63; v = a2[k * 256 + n]; }
            else if (e < LO_V1) { const int q = e - LO_G2, n = q / 160, k = q - n * 160; v = g2[k * 256 + n]; }
            else if (e < LO_V2) { const int q = e - LO_V1, n = q >> 8, k = q & 255; v = (l > 0) ? (INF(25) + (size_t)(l - 1) * 256 * 32)[k * 32 + n] : 0.f; }
            else { const int q = e - LO_V2, n = q >> 5, k = q & 31; v = (l > 0) ? (INF(26) + (size_t)(l - 1) * 32 * 256)[k * 256 + n] : 0.f; }
            LO[e] = (bf16)f2bf(v); }
    }
    if (PART == 0 && l == 0) {
        const float* x = INF(0); bf16* hb = WSP(bf16, WS_HB);
        for (int m = gw; m < TOK; m += NGW) {
            const GAS f32x4* xr = (const GAS f32x4*)(x + (size_t)m * D) + F.lane; GAS f32x4* hr = (GAS f32x4*)(F.h + (size_t)m * D) + F.lane; GAS v2u* o8 = (GAS v2u*)(hb + (size_t)m * D) + F.lane;
#pragma unroll
            for (int j = 0; j < 4; ++j) { const f32x4 v = xr[64 * j]; v2u w; w.x = pk2(v.x, v.y); w.y = pk2(v.z, v.w); o8[64 * j] = w; }
        }
    }
}
__device__ __forceinline__ void phase_absmax(Frame& F, int l) {
    const bool moe = (l & 1); const int fi = l >> 1;
    const int n4 = (moe ? NE * D * FFE : D * FFD) / 4;
    const GAS f32x4* g = (const GAS f32x4*)INF(moe ? 31 : 27) + (size_t)fi * n4; const GAS f32x4* u = (const GAS f32x4*)INF(moe ? 32 : 28) + (size_t)fi * n4; const GAS f32x4* dn = (const GAS f32x4*)INF(moe ? 33 : 29) + (size_t)fi * n4;
    const int gt = F.vcu * NWAVES * 64 + F.tid; int NT = F.G * NWAVES * 64; asm volatile("" : "+s"(NT));
    f32x4 mx = (f32x4){0.f, 0.f, 0.f, 0.f}, md = mx;
    for (int i = gt; i < n4; i += 3 * NT) {
        f32x4 a[3], b[3], c[3];
#pragma unroll
        for (int j = 0; j < 3; ++j) { const int ij = (i + j * NT < n4) ? i + j * NT : i; a[j] = g[ij]; b[j] = u[ij]; c[j] = dn[ij]; }
#pragma unroll
        for (int j = 0; j < 3; ++j) { mx = __builtin_elementwise_max(mx, __builtin_elementwise_max(__builtin_elementwise_abs(a[j]), __builtin_elementwise_abs(b[j]))); md = __builtin_elementwise_max(md, __builtin_elementwise_abs(c[j])); }
    }
    const float m = wave_max(fmaxf(fmaxf(mx.x, mx.y), fmaxf(mx.z, mx.w))), m2 = wave_max(fmaxf(fmaxf(md.x, md.y), fmaxf(md.z, md.w)));
    if (F.lane == 0) { __hip_atomic_fetch_max((unsigned*)(F.ctl + CW_AMAX + l * 64), __float_as_uint(m), RLX_AGENT); __hip_atomic_fetch_max((unsigned*)(F.ctl + CW_AMAXD + l * 64), __float_as_uint(m2), RLX_AGENT); }
}
template <int NKS> __device__ __forceinline__ void rw_mm16(f32x4 (&acc)[2][4], const LAS bf16* X, int ldx, int mb0, const bf16* BT, int hh, int lane) {
    const int fr = lane & 15, fq = lane >> 4; constexpr int K = 32 * NKS;
    bf16x8 bfr[NKS][4];
#pragma unroll
    for (int ks = 0; ks < NKS; ++ks)
#pragma unroll
        for (int nb = 0; nb < 4; ++nb) bfr[ks][nb] = *(const GAS bf16x8*)(BT + (size_t)(64 * hh + 16 * nb + fr) * K + 32 * ks + 8 * fq);
#pragma unroll
    for (int ks = 0; ks < NKS; ++ks)
#pragma unroll
        for (int mi = 0; mi < 2; ++mi) { const bf16x8 a = *(const LAS bf16x8*)(X + (16 * (mb0 + mi) + fr) * ldx + 32 * ks + 8 * fq);
#pragma unroll
            for (int nb = 0; nb < 4; ++nb) acc[mi][nb] = __builtin_amdgcn_mfma_f32_16x16x32_bf16(a, bfr[ks][nb], acc[mi][nb], 0, 0, 0); }
}
__device__ __forceinline__ void rwprep_tile(Frame& F, int l, int tile) {
    const bf16* P = WSP(const bf16, WS_P);
    const float* mu = INF(13) + l * 1056;
    LAS bf16* X1 = (LAS bf16*)F.lds; LAS bf16* X2 = X1 + 64 * 72; LAS bf16* X3 = X2 + 64 * 72; LAS bf16* XV = X3 + 64 * 168; LAS bf16* X5 = XV + 64 * 264; LAS bf16* XK = X5 + 64 * 40;
    float* RWW = WSP(float, WS_RWW); bf16* RWR = WSP(bf16, WS_RWR); bf16* RWK = WSP(bf16, WS_RWK); bf16* RWV = WSP(bf16, WS_RWV);
    bf16* RWKK = WSP(bf16, WS_RWKK); bf16* RWB = WSP(bf16, WS_RWB); bf16* RWG = WSP(bf16, WS_RWG); bf16* VF = WSP(bf16, WS_VF);
    const bf16* LORA = WSP(const bf16, WS_LORA);
    int tid_ = F.tid; asm volatile("" : "+v"(tid_));
    const int lane_ = tid_ & 63, wave_ = __builtin_amdgcn_readfirstlane(tid_ >> 6);
    const int fr = lane_ & 15, fq = lane_ >> 4, hh = wave_ & 3, mb0 = 2 * (wave_ >> 2);
    const int t0 = tile * 64;
#pragma unroll
    for (int half = 0; half < 2; ++half) {
        v4u rc[9], rp[9];
#pragma unroll
        for (int i = 0; i < 9; ++i) { const int g = tid_ + (half * 9 + i) * 512; rc[i] = (v4u){0u, 0u, 0u, 0u}; rp[i] = rc[i];
            if (g < 64 * 132) { const int tt = g / 132, cg = g - tt * 132, t = t0 + tt; const int col = RW_BASE + 8 * (cg < 36 ? 96 + cg : cg < 68 ? cg - 36 : cg < 100 ? 64 + (cg - 68) : 32 + (cg - 100));
                rc[i] = *(const GAS v4u*)(P + (size_t)t * NP + col); if ((t & (SEQ - 1)) != 0) rp[i] = *(const GAS v4u*)(P + (size_t)(t - 1) * NP + col); } }
#pragma unroll
        for (int i = 0; i < 9; ++i) { const int g = tid_ + (half * 9 + i) * 512;
            if (g < 64 * 132) { const int tt = g / 132, cg = g - tt * 132, t = t0 + tt; const int rel = 8 * (cg < 36 ? 96 + cg : cg < 68 ? cg - 36 : cg < 100 ? 64 + (cg - 68) : 32 + (cg - 100));
                const f32x4 m0 = *(const GAS f32x4*)(mu + rel), m1 = *(const GAS f32x4*)(mu + rel + 4); const float m[8] = {m0.x, m0.y, m0.z, m0.w, m1.x, m1.y, m1.z, m1.w};
                float cv[8], pv[8], xs[8]; unpack8(rc[i], cv); unpack8(rp[i], pv);
#pragma unroll
                for (int j = 0; j < 8; ++j) xs[j] = cv[j] + (pv[j] - cv[j]) * m[j];
                if (cg < 8) {
#pragma unroll
                    for (int j = 0; j < 8; ++j) { const float e2 = __expf(2.f * xs[j]); xs[j] = 1.f - 2.f * __builtin_amdgcn_rcpf(e2 + 1.f); }
                    *(LAS v4u*)(X1 + tt * 72 + 8 * cg) = pack8(xs);
                } else if (cg < 16) { *(LAS v4u*)(X2 + tt * 72 + 8 * (cg - 8)) = pack8(xs);
                } else if (cg < 36) {
#pragma unroll
                    for (int j = 0; j < 8; ++j) xs[j] = sigm(xs[j]);
                    *(LAS v4u*)(X3 + tt * 168 + 8 * (cg - 16)) = pack8(xs);
                } else if (cg < 68) { *(GAS v4u*)(RWR + (size_t)t * 256 + 8 * (cg - 36)) = pack8(xs);
                } else if (cg < 100) { const v4u w = pack8(xs); *(LAS v4u*)(XV + tt * 264 + 8 * (cg - 68)) = w;
                    if (l == 0) { *(GAS v4u*)(RWV + (size_t)t * 256 + 8 * (cg - 68)) = w; *(GAS v4u*)(VF + (size_t)t * 256 + 8 * (cg - 68)) = w; }
                } else { *(LAS v4u*)(XK + tt * 264 + 8 * (cg - 100)) = pack8(xs); } } }
    }
    __syncthreads();
    {   f32x4 acc[2][4];
#pragma unroll
        for (int mi = 0; mi < 2; ++mi)
#pragma unroll
            for (int nb = 0; nb < 4; ++nb) acc[mi][nb] = (f32x4){0.f, 0.f, 0.f, 0.f};
        rw_mm16<2>(acc, X1, 72, mb0, LORA + LO_W2, hh, lane_);
        const float* w0 = INF(14) + l * 256;
#pragma unroll
        for (int mi = 0; mi < 2; ++mi)
#pragma unroll
            for (int nb = 0; nb < 4; ++nb) { const int col = 64 * hh + 16 * nb + fr; const float w0c = w0[col];
#pragma unroll
                for (int r = 0; r < 4; ++r) { const int t = t0 + 16 * (mb0 + mi) + 4 * fq + r; RWW[(size_t)t * 256 + col] = -0.6065306597126334f * sigm(acc[mi][nb][r] + w0c);     } }
#pragma unroll
        for (int mi = 0; mi < 2; ++mi)
#pragma unroll
            for (int nb = 0; nb < 4; ++nb) acc[mi][nb] = (f32x4){0.f, 0.f, 0.f, 0.f};
        rw_mm16<2>(acc, X2, 72, mb0, LORA + LO_A2, hh, lane_);
        const float* a0 = INF(16) + l * 256; const float* kkw = INF(19) + l * 256; const float* kaw = INF(20) + l * 256;
#pragma unroll
        for (int mi = 0; mi < 2; ++mi) {
            float kr[4][4], kq[4][4], ssq[4] = {0.f, 0.f, 0.f, 0.f};
#pragma unroll
            for (int nb = 0; nb < 4; ++nb) { const int col = 64 * hh + 16 * nb + fr; const float kkc = kkw[col];
#pragma unroll
                for (int r = 0; r < 4; ++r) { const int row = 16 * (mb0 + mi) + 4 * fq + r; kr[nb][r] = bf1(XK[row * 264 + col]); kq[nb][r] = kr[nb][r] * kkc; ssq[r] += kq[nb][r] * kq[nb][r]; } }
#pragma unroll
            for (int r = 0; r < 4; ++r) { ssq[r] = sum16(ssq[r]); ssq[r] = 1.0f / fmaxf(sqrtf(ssq[r]), 1e-12f); }
#pragma unroll
            for (int nb = 0; nb < 4; ++nb) { const int col = 64 * hh + 16 * nb + fr; const float a0c = a0[col], kac = kaw[col];
#pragma unroll
                for (int r = 0; r < 4; ++r) { const int t = t0 + 16 * (mb0 + mi) + 4 * fq + r; const float a = sigm(acc[mi][nb][r] + a0c); const float kk = kq[nb][r] * ssq[r];
                    const size_t o = (size_t)t * 256 + col; RWKK[o] = (bf16)f2bf(kk); RWB[o] = (bf16)f2bf(kk * a); RWK[o] = (bf16)f2bf(kr[nb][r] * (1.f + (a - 1.f) * kac)); } }
        }
#pragma unroll
        for (int mi = 0; mi < 2; ++mi)
#pragma unroll
            for (int nb = 0; nb < 4; ++nb) acc[mi][nb] = (f32x4){0.f, 0.f, 0.f, 0.f};
        rw_mm16<5>(acc, X3, 168, mb0, LORA + LO_G2, hh, lane_);
#pragma unroll
        for (int mi = 0; mi < 2; ++mi)
#pragma unroll
            for (int nb = 0; nb < 4; ++nb) { const int col = 64 * hh + 16 * nb + fr;
#pragma unroll
                for (int r = 0; r < 4; ++r) { const int t = t0 + 16 * (mb0 + mi) + 4 * fq + r; RWG[(size_t)t * 256 + col] = (bf16)f2bf(acc[mi][nb][r]); } }
    }
    if (l > 0) {
        const float* v0 = INF(24) + (l - 1) * 256; const bf16* v1T = LORA + LO_V1; const bf16* v2T = LORA + LO_V2;
        {
            const int mb = wave_ & 3, nb = wave_ >> 2; f32x4 a4 = (f32x4){0.f, 0.f, 0.f, 0.f}; bf16x8 bv[8];
#pragma unroll
            for (int ks = 0; ks < 8; ++ks) bv[ks] = *(const GAS bf16x8*)(v1T + (size_t)(16 * nb + fr) * 256 + 32 * ks + 8 * fq);
#pragma unroll
            for (int ks = 0; ks < 8; ++ks) a4 = __builtin_amdgcn_mfma_f32_16x16x32_bf16(*(const LAS bf16x8*)(XV + (16 * mb + fr) * 264 + 32 * ks + 8 * fq), bv[ks], a4, 0, 0, 0);
#pragma unroll
            for (int r = 0; r < 4; ++r) X5[(16 * mb + 4 * fq + r) * 40 + 16 * nb + fr] = (bf16)f2bf(a4[r]);
        }
        __syncthreads();
        {   f32x4 acc[2][4];
#pragma unroll
            for (int mi = 0; mi < 2; ++mi)
#pragma unroll
                for (int nb = 0; nb < 4; ++nb) acc[mi][nb] = (f32x4){0.f, 0.f, 0.f, 0.f};
            rw_mm16<1>(acc, X5, 40, mb0, v2T, hh, lane_);
#pragma unroll
            for (int mi = 0; mi < 2; ++mi)
#pragma unroll
                for (int nb = 0; nb < 4; ++nb) { const int col = 64 * hh + 16 * nb + fr; const float v0c = v0[col];
#pragma unroll
                    for (int r = 0; r < 4; ++r) { const int row = 16 * (mb0 + mi) + 4 * fq + r; const size_t o = (size_t)(t0 + row) * 256 + col;
                        const float xv = bf1(XV[row * 264 + col]); const float vf = bf1(VF[o]); RWV[o] = (bf16)f2bf(xv + (vf - xv) * sigm(acc[mi][nb][r] + v0c)); } }
        }
    }
    __syncthreads();
}
constexpr int CB = 64 * 66;
constexpr int HB_ = 64 * 72;
constexpr int PRE_H0 = 3 * CB * 4;
constexpr int PV_OFF = (PRE_H0 + 10 * HB_ * 2) / 4;
constexpr int REC_RW = 53760, REC_GL = 16640;
constexpr int RO_QH = 0, RO_AT = 8192, RO_BH = 16384, RO_TT = 24576, RO_MRB = 30720, RO_GAM = 36864, RO_VB = 37376;
constexpr int RO_Y = 0, RO_SK = 0;
constexpr int GO_QH = 0, GO_SK = 8192, GO_GAM = 16384;
#define PBUF(i) ((LAS float*)F.lds + (i) * CB)
#define HBUF(i) ((LAS bf16*)(F.lds + PRE_H0) + (i) * HB_)
__device__ __forceinline__ void nt16(f32x4 (&acc)[2], const LAS bf16* X, const LAS bf16* Y, int mb, int nb0, int lane) {
    const int fr = lane & 15, fq = lane >> 4;
    acc[0] = (f32x4){0.f, 0.f, 0.f, 0.f}; acc[1] = acc[0];
#pragma unroll
    for (int ks = 0; ks < 2; ++ks) { const bf16x8 a = *(const LAS bf16x8*)(X + (16 * mb + fr) * 72 + 32 * ks + 8 * fq);
        const bf16x8 b0 = *(const LAS bf16x8*)(Y + (16 * nb0 + fr) * 72 + 32 * ks + 8 * fq), b1 = *(const LAS bf16x8*)(Y + (16 * nb0 + 16 + fr) * 72 + 32 * ks + 8 * fq);
        acc[0] = __builtin_amdgcn_mfma_f32_16x16x32_bf16(a, b0, acc[0], 0, 0, 0); acc[1] = __builtin_amdgcn_mfma_f32_16x16x32_bf16(a, b1, acc[1], 0, 0, 0); }
}
typedef short v4i16_t __attribute__((ext_vector_type(4)));
__device__ __forceinline__ v2u trr(const LAS bf16* p) { return __builtin_bit_cast(v2u, __builtin_amdgcn_ds_read_tr16_b64_v4i16((LAS v4i16_t*)p)); }
__device__ __forceinline__ bf16x8 trfrag(const LAS bf16* M, int c, int ks, int lane) {
    const int g = lane >> 4, q = (lane & 15) >> 2, p = lane & 3; const LAS bf16* a = M + (32 * ks + 8 * g + q) * 72 + 16 * c + 4 * p;
    const v2u lo = trr(a), hi = trr(a + 4 * 72); v4u w; w.x = lo.x; w.y = lo.y; w.z = hi.x; w.w = hi.y; return __builtin_bit_cast(bf16x8, w);
}
__device__ __forceinline__ void tn16(f32x4 (&acc)[2], const LAS bf16* X, const LAS bf16* Y, int mb, int nb0, int lane) {
    acc[0] = (f32x4){0.f, 0.f, 0.f, 0.f}; acc[1] = acc[0];
#pragma unroll
    for (int ks = 0; ks < 2; ++ks) { const bf16x8 a = trfrag(X, mb, ks, lane), b0 = trfrag(Y, nb0, ks, lane), b1 = trfrag(Y, nb0 + 1, ks, lane);
        acc[0] = __builtin_amdgcn_mfma_f32_16x16x32_bf16(a, b0, acc[0], 0, 0, 0); acc[1] = __builtin_amdgcn_mfma_f32_16x16x32_bf16(a, b1, acc[1], 0, 0, 0); }
}
__device__ __forceinline__ void nn16(f32x4 (&acc)[2], const LAS bf16* A, const LAS bf16* B, int mb, int nb0, int lane) {
    const int fr = lane & 15, fq = lane >> 4;
    acc[0] = (f32x4){0.f, 0.f, 0.f, 0.f}; acc[1] = acc[0];
#pragma unroll
    for (int ks = 0; ks < 2; ++ks) { const bf16x8 a = *(const LAS bf16x8*)(A + (16 * mb + fr) * 72 + 32 * ks + 8 * fq), b0 = trfrag(B, nb0, ks, lane), b1 = trfrag(B, nb0 + 1, ks, lane);
        acc[0] = __builtin_amdgcn_mfma_f32_16x16x32_bf16(a, b0, acc[0], 0, 0, 0); acc[1] = __builtin_amdgcn_mfma_f32_16x16x32_bf16(a, b1, acc[1], 0, 0, 0); }
}
__device__ __forceinline__ void hfrag_tr(const LAS bf16* M, unsigned char* dst, int wave, int lane) {
    const int mb = wave >> 1, ks = wave & 1, g = lane >> 4, q = (lane & 15) >> 2, p = lane & 3; const LAS bf16* a = M + (32 * ks + 4 * g + q) * 72 + 16 * mb + 4 * p;
    const v2u lo = trr(a), hi = trr(a + 16 * 72); v4u w; w.x = lo.x; w.y = lo.y; w.z = hi.x; w.w = hi.y;
    *(GAS v4u*)(dst + ((size_t)wave * 64 + lane) * 16) = w;
}
template <int MASK> __device__ __forceinline__ void hst(const f32x4 (&acc)[2], LAS bf16* S, int mb, int nb0, int lane) {
    const int fr = lane & 15, fq = lane >> 4;
#pragma unroll
    for (int n = 0; n < 2; ++n)
#pragma unroll
        for (int r = 0; r < 4; ++r) { const int row = 16 * mb + 4 * fq + r, col = 16 * (nb0 + n) + fr; float v = acc[n][r];
            if (MASK == 1 && col > row) v = 0.f; if (MASK == 2 && col >= row) v = 0.f; S[row * 72 + col] = (bf16)f2bf(v); }
}
template <int MASK> __device__ __forceinline__ void cst(const f32x4 (&acc)[2], LAS float* S, int mb, int nb0, int lane) {
    const int fr = lane & 15, fq = lane >> 4;
#pragma unroll
    for (int n = 0; n < 2; ++n)
#pragma unroll
        for (int r = 0; r < 4; ++r) { const int row = 16 * mb + 4 * fq + r, col = 16 * (nb0 + n) + fr; float v = acc[n][r];
            if (MASK == 1 && col > row) v = 0.f; if (MASK == 2 && col >= row) v = 0.f; S[row * 66 + col] = v; }
}
__device__ __forceinline__ void hfrag(const LAS bf16* M, const LAS float* colscale, unsigned char* dst, int wave, int lane, int slot = -2) {
    const int mb = wave >> 1, ks = wave & 1, i = lane & 15, q = lane >> 4; const LAS bf16* rowp = M + (16 * mb + i) * 72 + 32 * ks + 4 * q;
    const v2u lo = *(const LAS v2u*)rowp, hi = *(const LAS v2u*)(rowp + 16);
    v4u w; w.x = lo.x; w.y = lo.y; w.z = hi.x; w.w = hi.y;
    if (colscale) { float e[8]; unpack8(w, e); const f32x4 s0 = *(const LAS f32x4*)(colscale + 32 * ks + 4 * q), s1 = *(const LAS f32x4*)(colscale + 32 * ks + 16 + 4 * q);
        e[0] *= s0.x; e[1] *= s0.y; e[2] *= s0.z; e[3] *= s0.w; e[4] *= s1.x; e[5] *= s1.y; e[6] *= s1.z; e[7] *= s1.w; w = pack8(e); }
    if (slot == -2) slot = wave; if (slot >= 0) *(GAS v4u*)(dst + ((size_t)slot * 64 + lane) * 16) = w;
}
__device__ __forceinline__ void cfrag(const LAS float* M, unsigned char* dst, int wave, int lane, int slot) {
    const int mb = wave >> 1, ks = wave & 1, i = lane & 15, q = lane >> 4; float e[8];
#pragma unroll
    for (int jj = 0; jj < 8; ++jj) { const int rho = 32 * ks + (jj < 4 ? 4 * q + jj : 16 + 4 * q + jj - 4); e[jj] = M[(16 * mb + i) * 66 + rho]; }
    if (slot >= 0) *(GAS v4u*)(dst + ((size_t)slot * 64 + lane) * 16) = pack8(e);
}
__device__ __forceinline__ void cacc(const f32x4 (&acc)[2], const LAS float* rowscale, unsigned char* dst, int mb, int nb0, int lane, int vbs = 2048) {
    const int fq = lane >> 4;
#pragma unroll
    for (int n = 0; n < 2; ++n) { float v[4];
#pragma unroll
        for (int r = 0; r < 4; ++r) { v[r] = acc[n][r]; if (rowscale) v[r] *= rowscale[16 * mb + 4 * fq + r]; }
        v2u w; w.x = pk2(v[0], v[1]); w.y = pk2(v[2], v[3]); *(GAS v2u*)(dst + (size_t)(nb0 + n) * vbs + ((size_t)mb * 64 + lane) * 8) = w; }
}
__device__ __forceinline__ void ccumsum(Frame& F, LAS float* CU) {
    LAS float* vec = (LAS float*)F.lds + PV_OFF; LAS float* seg = vec + 128;
    { float run = 0.f;
#pragma unroll
      for (int i = 0; i < 8; ++i) { run += CU[(8 * F.wave + i) * 66 + F.lane]; CU[(8 * F.wave + i) * 66 + F.lane] = run; }
      seg[F.wave * 64 + F.lane] = run; }
    LDS_BARRIER();
    { float off = 0.f;
#pragma unroll
      for (int w = 0; w < 8; ++w) if (w < F.wave) off += seg[w * 64 + F.lane];
#pragma unroll
      for (int i = 0; i < 8; ++i) { const float c = CU[(8 * F.wave + i) * 66 + F.lane] + off; CU[(8 * F.wave + i) * 66 + F.lane] = c; if (8 * F.wave + i == 31) vec[F.lane] = c; if (8 * F.wave + i == 63) vec[64 + F.lane] = c; } }
    LDS_BARRIER();
}
__device__ __forceinline__ f32x4 blk16(f32x4 acc, const LAS float* A, int ar0, int ac0, const LAS float* B, int br0, int bc0, int lane) {
    const int fr = lane & 15, fq = lane >> 4;
#pragma unroll
    for (int s = 0; s < 4; ++s) acc = __builtin_amdgcn_mfma_f32_16x16x4f32(A[(ar0 + fr) * 66 + ac0 + 4 * s + fq], B[(br0 + 4 * s + fq) * 66 + bc0 + fr], acc, 0, 0, 0);
    return acc;
}
__device__ __forceinline__ void blkst(const f32x4 acc, LAS float* S, int r0, int c0, int lane) {
    const int fr = lane & 15, fq = lane >> 4;
#pragma unroll
    for (int r = 0; r < 4; ++r) S[(r0 + 4 * fq + r) * 66 + c0 + fr] = acc[r];
}
__device__ __forceinline__ void tri_inverse(Frame& F, const LAS float* L, LAS float* T, LAS float* W) {
    for (int e = F.tid; e < 64 * 64; e += NWAVES * 64) { const int i = e >> 6, j = e & 63; if ((i >> 4) != (j >> 4)) T[i * 66 + j] = 0.f; }
    if (F.wave == 0) {
        const int d0 = 16 * (F.lane >> 4), c = F.lane & 15; float t[16];
#pragma unroll
        for (int i = 0; i < 16; ++i) { float a = (i == c) ? 1.f : 0.f;
#pragma unroll
            for (int j = 0; j < i; ++j) a += L[(d0 + i) * 66 + d0 + j] * t[j];
            t[i] = a; T[(d0 + i) * 66 + d0 + c] = a; }
    }
    LDS_BARRIER();
#pragma unroll
    for (int d = 1; d <= 3; ++d) {
        if (F.wave < 4 - d) { const int i = d + F.wave, j = F.wave; f32x4 acc = (f32x4){0.f, 0.f, 0.f, 0.f};
#pragma unroll
            for (int k = 0; k < 3; ++k) if (k >= j && k < i) acc = blk16(acc, L, 16 * i, 16 * k, T, 16 * k, 16 * j, F.lane);
            blkst(acc, W, 16 * i, 16 * j, F.lane); }
        LDS_BARRIER();
        if (F.wave < 4 - d) { const int i = d + F.wave, j = F.wave; f32x4 acc = (f32x4){0.f, 0.f, 0.f, 0.f};
            acc = blk16(acc, T, 16 * i, 16 * i, W, 16 * i, 16 * j, F.lane); blkst(acc, T, 16 * i, 16 * j, F.lane); }
        LDS_BARRIER();
    }
}
struct PreRaw { unsigned x[6][8]; f32x2_t cs[8]; };
__device__ __forceinline__ unsigned ldh(const bf16* p) { return (unsigned)*(const GAS bf16*)p; }
#define WSQ(T, off) ((T*)(ws_ + (off)))
__device__ __forceinline__ void pre_load(Frame& F, PreRaw& R, const int MIX, int b, int h, int c) {
    int tid_ = F.tid; asm volatile("" : "+v"(tid_));
    unsigned char* ws_ = F.ws; asm volatile("" : "+s"(ws_));
    const int k = tid_ & 63, w = tid_ >> 6, t0 = b * SEQ + c * 64 + 8 * w;
    const bf16* P = WSQ(const bf16, WS_P) + (size_t)t0 * NP;
#pragma unroll
    for (int s = 0; s < 6; ++s)
#pragma unroll
        for (int i = 0; i < 8; ++i) R.x[s][i] = 0u;
    if (MIX == 0) {
#pragma unroll
        for (int i = 0; i < 8; ++i) { R.x[0][i] = ldh(P + (size_t)i * NP + HG_F + 64 * h + k); R.x[1][i] = ldh(P + (size_t)i * NP + HG_Q + 64 * h + k); R.x[2][i] = ldh(P + (size_t)i * NP + HG_I + 64 * h + k); }
    } else if (MIX == 1) {
#pragma unroll
        for (int i = 0; i < 8; ++i) { R.x[2][i] = ldh(P + (size_t)i * NP + GL_V + 64 * h + k);
            if (k < 32) { R.x[0][i] = ldh(P + (size_t)i * NP + GL_GX + 32 * h + k); R.x[1][i] = ldh(P + (size_t)i * NP + GL_Q + 32 * h + k); R.x[3][i] = ldh(P + (size_t)i * NP + GL_K + 32 * h + k); } }
    } else if (MIX == 2) { const size_t o = (size_t)t0 * 256 + 64 * h + k;
#pragma unroll
        for (int i = 0; i < 8; ++i) { R.x[0][i] = __float_as_uint(*(const GAS float*)(WSQ(const float, WS_RWW) + o + i * 256)); R.x[1][i] = ldh(WSQ(const bf16, WS_RWR) + o + i * 256); R.x[2][i] = ldh(WSQ(const bf16, WS_RWV) + o + i * 256);
            R.x[3][i] = ldh(WSQ(const bf16, WS_RWK) + o + i * 256); R.x[4][i] = ldh(WSQ(const bf16, WS_RWKK) + o + i * 256); R.x[5][i] = ldh(WSQ(const bf16, WS_RWB) + o + i * 256); }
    } else { const int k31 = k & 31; const f32x2_t* CS = WSQ(const f32x2_t, WS_CS) + (size_t)t0 * 32 + k31;
#pragma unroll
        for (int i = 0; i < 8; ++i) { R.x[0][i] = ldh(P + (size_t)i * NP + RT_Q + 64 * h + k31); R.x[1][i] = ldh(P + (size_t)i * NP + RT_Q + 64 * h + 32 + k31); R.x[2][i] = ldh(P + (size_t)i * NP + RT_V + 64 * h + k);
            R.x[3][i] = ldh(P + (size_t)i * NP + RT_K + 64 * h + k31); R.x[4][i] = ldh(P + (size_t)i * NP + RT_K + 64 * h + 32 + k31); R.cs[i] = *(const GAS f32x2_t*)(CS + i * 32); }
    }
}
__device__ __forceinline__ float ubf(unsigned u) { return __uint_as_float(u << 16); }
__device__ __forceinline__ v4u pack8v(const float (&f)[8]) { v4u w; w.x = pk2(f[0], f[1]); w.y = pk2(f[2], f[3]); w.z = pk2(f[4], f[5]); w.w = pk2(f[6], f[7]); return w; }
__device__ __forceinline__ void hfrag_trs(const LAS bf16* M, const LAS float* scale, unsigned char* dst, int wave, int lane) {
    const int mb = wave >> 1, ks = wave & 1, g = lane >> 4, q = (lane & 15) >> 2, p = lane & 3; const LAS bf16* a = M + (32 * ks + 4 * g + q) * 72 + 16 * mb + 4 * p;
    const v2u lo = trr(a), hi = trr(a + 16 * 72); v4u w; w.x = lo.x; w.y = lo.y; w.z = hi.x; w.w = hi.y;
    float e[8]; unpack8(w, e); const f32x4 s0 = *(const LAS f32x4*)(scale + 32 * ks + 4 * g), s1 = *(const LAS f32x4*)(scale + 32 * ks + 16 + 4 * g);
    e[0] *= s0.x; e[1] *= s0.y; e[2] *= s0.z; e[3] *= s0.w; e[4] *= s1.x; e[5] *= s1.y; e[6] *= s1.z; e[7] *= s1.w;
    *(GAS v4u*)(dst + ((size_t)wave * 64 + lane) * 16) = pack8(e);
}
__device__ __forceinline__ void chunk_pre(Frame& F, PreRaw& R, int l, const int MIX, int b, int h, int c, unsigned char* rec, const int nMIX, int nh) {
    const int t0 = b * SEQ + c * 64;
    LAS float* SEG = PBUF(0); LAS float* LL = PBUF(1); LAS float* T32 = PBUF(2); LAS float* WW = PBUF(0);
    LAS bf16* A1 = HBUF(0); LAS bf16* R1 = HBUF(1); LAS bf16* B1 = HBUF(2); LAS bf16* K1 = HBUF(3); LAS bf16* KeT = HBUF(4); LAS bf16* VT = HBUF(5); LAS bf16* BeT = HBUF(6); LAS bf16* M1 = HBUF(7); LAS bf16* M2 = HBUF(8); LAS bf16* M3 = HBUF(9);
    LAS float* vec = (LAS float*)F.lds + PV_OFF; LAS float* ecm = vec + 640;
    int tid_ = F.tid; asm volatile("" : "+v"(tid_));
    unsigned char* ws_ = F.ws; asm volatile("" : "+s"(ws_));
    const int lane_ = tid_ & 63, wave_ = __builtin_amdgcn_readfirstlane(tid_ >> 6);
    const int k_ = lane_;
    const int mb = wave_ >> 1, nb0 = 2 * (wave_ & 1), fr = lane_ & 15, fq = lane_ >> 4;
    float q[8], kx[8], lw[8], v[8], av[8], bv[8];
    if (MIX == 0) {
        const float* lg = INF(8); const int cch = 64 * h + k_;
        const float x0 = lg[cch], x1 = lg[256 + cch], x2 = lg[512 + cch], x3 = lg[768 + cch]; const float mx = fmaxf(fmaxf(x0, x1), fmaxf(x2, x3));
        const float e0 = __expf(x0 - mx), e1 = __expf(x1 - mx), e2 = __expf(x2 - mx), e3 = __expf(x3 - mx);
        const float lb = ((l >= 1 ? e1 : 0.f) + (l >= 2 ? e2 : 0.f) + (l >= 3 ? e3 : 0.f)) / (e0 + e1 + e2 + e3);
#pragma unroll
        for (int i = 0; i < 8; ++i) { const float fr_ = ubf(R.x[0][i]), qr = ubf(R.x[1][i]); const float w = lb + (1.f - lb) * sigm(fr_); lw[i] = __logf(w); kx[i] = 1.f - w; q[i] = qr * sigm(qr); v[i] = ubf(R.x[2][i]); }
    } else if (MIX == 1) {
        const float gb = (k_ < 32) ? (INF(11) + l * 128)[32 * h + k_] : 0.f;
#pragma unroll
        for (int i = 0; i < 8; ++i) { v[i] = ubf(R.x[2][i]);
            if (k_ < 32) { const float x = ubf(R.x[0][i]) + gb; lw[i] = 0.0625f * (fminf(x, 0.f) - __logf(1.f + __expf(-fabsf(x)))); q[i] = ubf(R.x[1][i]) * 0.17677669529663687f; kx[i] = ubf(R.x[3][i]); }
            else { lw[i] = 0.f; q[i] = 0.f; kx[i] = 0.f; } }
    } else if (MIX == 2) {
#pragma unroll
        for (int i = 0; i < 8; ++i) { lw[i] = __uint_as_float(R.x[0][i]); q[i] = ubf(R.x[1][i]); v[i] = ubf(R.x[2][i]); kx[i] = ubf(R.x[3][i]); av[i] = -ubf(R.x[4][i]); bv[i] = ubf(R.x[5][i]); }
    } else {
        const bool hi = k_ >= 32; const float lgam = __logf(1.f - exp2f(-5.f - (float)h));
#pragma unroll
        for (int i = 0; i < 8; ++i) { const float cs_ = R.cs[i].x, sn = R.cs[i].y; const float q1 = ubf(R.x[0][i]), q2 = ubf(R.x[1][i]), k1 = ubf(R.x[3][i]), k2 = ubf(R.x[4][i]);
            q[i] = hi ? (q1 * sn + q2 * cs_) : (q1 * cs_ - q2 * sn); kx[i] = 0.125f * (hi ? (k1 * sn + k2 * cs_) : (k1 * cs_ - k2 * sn)); lw[i] = lgam; v[i] = ubf(R.x[2][i]); }
    }
    float cu[8]; { float run = 0.f;
#pragma unroll
        for (int i = 0; i < 8; ++i) { run += lw[i]; cu[i] = run; }
        SEG[wave_ * 64 + k_] = run; }
    LDS_BARRIER();
    float cm, ce; { float pre = 0.f, tot = 0.f, mid = 0.f;
#pragma unroll
        for (int w = 0; w < 8; ++w) { const float s = SEG[w * 64 + k_]; if (w < wave_) pre += s; if (w < 4) mid += s; tot += s; }
        cm = mid; ce = tot;
#pragma unroll
        for (int i = 0; i < 8; ++i) cu[i] += pre; }
    {   float e1[8], e2[8], e3[8];
#pragma unroll
        for (int i = 0; i < 8; ++i) { const float ef = __expf(fminf(fmaxf(cu[i] - cm, -80.f), 80.f)); e1[i] = q[i] * ef; e2[i] = kx[i] * __builtin_amdgcn_rcpf(ef); e3[i] = kx[i] * __expf(ce - cu[i]); }
        *(LAS v4u*)(R1 + k_ * 72 + 8 * wave_) = pack8v(e1); *(LAS v4u*)(K1 + k_ * 72 + 8 * wave_) = pack8v(e2); *(LAS v4u*)(KeT + k_ * 72 + 8 * wave_) = pack8v(e3); *(LAS v4u*)(VT + k_ * 72 + 8 * wave_) = pack8v(v);
        if (MIX == 2) {
#pragma unroll
            for (int i = 0; i < 8; ++i) { const float ef = __expf(fminf(fmaxf(cu[i] - cm, -80.f), 80.f)); e1[i] = av[i] * __expf(fminf(fmaxf(cu[i] - lw[i] - cm, -80.f), 80.f)); e2[i] = bv[i] * __builtin_amdgcn_rcpf(ef); e3[i] = bv[i] * __expf(ce - cu[i]); }
            *(LAS v4u*)(A1 + k_ * 72 + 8 * wave_) = pack8v(e1); *(LAS v4u*)(B1 + k_ * 72 + 8 * wave_) = pack8v(e2); *(LAS v4u*)(BeT + k_ * 72 + 8 * wave_) = pack8v(e3); }
        if (wave_ == 0) { ecm[k_] = __expf(cm); *(GAS float*)(rec + (MIX == 2 ? RO_GAM : GO_GAM) + 4 * k_) = __expf(ce); }
    }
    LDS_BARRIER();
    if (nMIX >= 0) pre_load(F, R, nMIX, b, nh, c);
    f32x4 acc[2];
    tn16(acc, R1, K1, mb, nb0, lane_); hst<1>(acc, M1, mb, nb0, lane_);
    hfrag_trs(R1, ecm, rec + (MIX == 2 ? RO_QH : GO_QH), wave_, lane_);
    nt16(acc, KeT, VT, mb, nb0, lane_); if (MIX == 2) cacc(acc, nullptr, rec + RO_VB + 2048, mb, nb0, lane_, 4096); else cacc(acc, nullptr, rec + GO_SK, mb, nb0, lane_);
    if (MIX == 2) {
        tn16(acc, A1, B1, mb, nb0, lane_); cst<2>(acc, LL, mb, nb0, lane_);
        tn16(acc, R1, B1, mb, nb0, lane_); hst<1>(acc, M2, mb, nb0, lane_);
        tn16(acc, A1, K1, mb, nb0, lane_); hst<2>(acc, M3, mb, nb0, lane_);
        hfrag_trs(A1, ecm, rec + RO_AT, wave_, lane_);
        hfrag(BeT, nullptr, rec + RO_BH, wave_, lane_);
    }
    LDS_BARRIER();
    nt16(acc, M1, VT, mb, nb0, lane_);
#pragma unroll
    for (int n = 0; n < 2; ++n)
#pragma unroll
        for (int r = 0; r < 4; ++r) A1[(16 * mb + 4 * fq + r) * 72 + 16 * (nb0 + n) + fr] = (bf16)f2bf(acc[n][r]);
    if (MIX == 2) {
        nt16(acc, M3, VT, mb, nb0, lane_); cacc(acc, nullptr, rec + RO_VB, mb, nb0, lane_, 4096);
        const int t6 = ((wave_ & 1) == 1 && (wave_ >> 1) < 2) ? -1 : ((wave_ >> 1) < 2 ? (wave_ >> 1) : 2 + ((wave_ >> 1) - 2) * 2 + (wave_ & 1));
        hfrag(M2, nullptr, rec + RO_MRB, wave_, lane_, t6);
        tri_inverse(F, LL, T32, WW);
        cfrag(T32, rec + RO_TT, wave_, lane_, t6);
    }
    LDS_BARRIER();
}
constexpr size_t WS_REC_RW = 14 * MiB, WS_REC_GL = 412 * MiB;
__device__ __forceinline__ void oloc_flush(Frame& F, int m, int t0, int h) {
    const int t = F.tid >> 3, pc = F.tid & 7; const v4u w = *(const LAS v4u*)(HBUF(0) + t * 72 + 8 * pc);
    *(GAS v4u*)(WSP(bf16, WS_O) + (size_t)m * TOK * 256 + (size_t)(t0 + t) * 256 + 64 * h + 8 * pc) = w;
}
__device__ __forceinline__ unsigned char* pre_rec(Frame& F, int m, int b, int h, int c) {
    return (m == 2) ? F.ws + WS_REC_RW + (size_t)(((b * 4 + h) * 64) + c) * REC_RW : F.ws + WS_REC_GL + (size_t)((((m == 3 ? 2 : m) * 16 + b * 4 + h) * 64) + c) * REC_GL;
}
__device__ __forceinline__ void phase_chunkpre(Frame& F, int l) {
    for (int tile = F.vcu; tile < TOK / 64; tile += F.G) {
        const int b = tile >> 6, c = tile & 63;
        rwprep_tile(F, l, tile);
        __syncthreads();
        PreRaw cur;
        pre_load(F, cur, 0, b, 0, c);
#pragma unroll 1
        for (int i = 0; i < 16; ++i) {
            const int mo = i >> 2, m = (mo == 2) ? 3 : (mo == 3 ? 2 : mo), h = i & 3;
            const int mo2 = (i + 1) >> 2, m2 = (i + 1 < 16) ? ((mo2 == 2) ? 3 : (mo2 == 3 ? 2 : mo2)) : -1;
            chunk_pre(F, cur, l, m, b, h, c, pre_rec(F, m, b, h, c), m2, (i + 1) & 3);
            oloc_flush(F, m, b * SEQ + c * 64, h);
        }
    }
}
__device__ __forceinline__ bf16x8 pack_b(const f32x4 a, const f32x4 b) { v4u w; w.x = pk2(a.x, a.y); w.y = pk2(a.z, a.w); w.z = pk2(b.x, b.y); w.w = pk2(b.z, b.w); return __builtin_bit_cast(bf16x8, w); }
__device__ __forceinline__ f32x4 unpk4(const v2u w) { return (f32x4){bflo(w.x), bfhi(w.x), bflo(w.y), bfhi(w.y)}; }
template <int NF> struct SeqRegs { v4u r[NF]; v4u tail; };
template <int NF, int NLT, bool TAIL> __device__ __forceinline__ void seq_ld(SeqRegs<NF>& R, const unsigned char* rec, int lt) {
    const GAS v4u* src = (const GAS v4u*)rec;
#pragma unroll
    for (int i = 0; i < NF; ++i) R.r[i] = src[i * NLT + lt];
    if (TAIL && lt < 16) R.tail = src[NF * NLT + lt];
}
template <int NF, int NLT, bool TAIL> __device__ __forceinline__ void seq_st(const SeqRegs<NF>& R, LAS unsigned char* slot, int lt) {
    LAS v4u* dst = (LAS v4u*)slot;
#pragma unroll
    for (int i = 0; i < NF; ++i) dst[i * NLT + lt] = R.r[i];
    if (TAIL && lt < 16) dst[NF * NLT + lt] = R.tail;
}
template <bool RW> __device__ __forceinline__ void seq_unit(Frame& F, int mix, int b, int h, int vb_, const unsigned char* recs) {
    constexpr int REC = RW ? REC_RW : REC_GL, SLOT = 61440, NCW = RW ? 1 : 4, LW0 = RW ? 2 : 4, NLT = (8 - LW0) * 64, NF = REC / (NLT * 16); constexpr bool TAIL = (REC % (NLT * 16)) != 0;
    static_assert(REC % (NLT * 16) == 0 || REC % (NLT * 16) == 256, "record = NF loader rounds (+ 256 B)");
    const bool loader = F.wave >= LW0, compute = F.wave < NCW; const int lt = F.tid - 64 * LW0;
    SeqRegs<NF> RA, RB;
    if (loader) { seq_ld<NF, NLT, TAIL>(RA, recs, lt); seq_st<NF, NLT, TAIL>(RA, F.lds, lt); seq_ld<NF, NLT, TAIL>(RB, recs + (size_t)1 * REC, lt); seq_ld<NF, NLT, TAIL>(RA, recs + (size_t)2 * REC, lt); }
    __syncthreads();
    f32x4 S[4];
#pragma unroll
    for (int kb = 0; kb < 4; ++kb) S[kb] = (f32x4){0.f, 0.f, 0.f, 0.f};
    const int vb = RW ? vb_ : (F.wave & 3), fr = F.lane & 15, fq = F.lane >> 4;
    bf16* Og_ = WSP(bf16, WS_OI) + OI_GEN + (size_t)(((mix == 3 ? 2 : mix) * 16 + b * 4 + h)) * (SEQ * 64);
    constexpr int OSO = 122880;
#define SEQ_FLUSH(cc) do { const LAS unsigned char* osr_ = F.lds + OSO + ((cc) & 1) * 8192 + (16 * vb + (F.lane >> 2)) * 128 + (F.lane & 3) * 32; bf16* dst_ = Og_ + ((size_t)(cc) * 64 + 16 * vb + (F.lane >> 2)) * 64 + (F.lane & 3) * 16; \
        const v4u a_ = *(const LAS v4u*)osr_, b_ = *(const LAS v4u*)(osr_ + 16); *(GAS v4u*)dst_ = a_; *(GAS v4u*)(dst_ + 8) = b_; } while (0)
#pragma unroll 1
    for (int c2 = 0; c2 < 64; c2 += 2) {
#pragma unroll
        for (int par = 0; par < 2; ++par) {
            const int c = c2 + par;
            if (loader) {
                if (par == 0) { seq_st<NF, NLT, TAIL>(RB, F.lds + SLOT, lt); if (c + 3 < 64) seq_ld<NF, NLT, TAIL>(RB, recs + (size_t)(c + 3) * REC, lt); }
                else { if (c + 1 < 64) seq_st<NF, NLT, TAIL>(RA, F.lds, lt); if (c + 3 < 64) seq_ld<NF, NLT, TAIL>(RA, recs + (size_t)(c + 3) * REC, lt); }
            } else if (compute) {
                const LAS unsigned char* R = F.lds + par * SLOT;
                const f32x4 z = (f32x4){0.f, 0.f, 0.f, 0.f};
                if (c > 0) SEQ_FLUSH(c - 1);
                bf16x8 fqh[8];
#pragma unroll
                for (int f = 0; f < 8; ++f) fqh[f] = *(const LAS bf16x8*)(R + (RW ? RO_QH : GO_QH) + (f * 64 + F.lane) * 16);
                bf16x8 bS[2]; bS[0] = pack_b(S[0], S[1]); bS[1] = pack_b(S[2], S[3]);
                asm volatile("s_waitcnt lgkmcnt(0)" ::: "memory"); __builtin_amdgcn_sched_barrier(0);
                f32x4 O[4]; bf16x8 bU[2];
#pragma unroll
                for (int mb = 0; mb < 4; ++mb) { O[mb] = z;
#pragma unroll
                    for (int ks = 0; ks < 2; ++ks) O[mb] = __builtin_amdgcn_mfma_f32_16x16x32_bf16(fqh[mb * 2 + ks], bS[ks], O[mb], 0, 0, 0); }
                if (RW) {
                    f32x4 X[4], U[4];
#pragma unroll
                    for (int mb = 0; mb < 4; ++mb) { X[mb] = unpk4(*(const LAS v2u*)(R + RO_Y + ((vb * 4 + mb) * 64 + F.lane) * 8));
#pragma unroll
                        for (int ks = 0; ks < 2; ++ks) X[mb] = __builtin_amdgcn_mfma_f32_16x16x32_bf16(*(const LAS bf16x8*)(R + RO_AT + ((mb * 2 + ks) * 64 + F.lane) * 16), bS[ks], X[mb], 0, 0, 0); }
                    bf16x8 bX[2]; bX[0] = pack_b(X[0], X[1]); bX[1] = pack_b(X[2], X[3]);
#pragma unroll
                    for (int mb = 0; mb < 4; ++mb) { U[mb] = z;
#pragma unroll
                        for (int ks = 0; ks < 2; ++ks) if (!(ks == 1 && mb < 2)) U[mb] = __builtin_amdgcn_mfma_f32_16x16x32_bf16(*(const LAS bf16x8*)(R + RO_TT + ((mb * 2 + ks) * 64 + F.lane) * 16), bX[ks], U[mb], 0, 0, 0); }
                    bU[0] = pack_b(U[0], U[1]); bU[1] = pack_b(U[2], U[3]);
#pragma unroll
                    for (int mb = 0; mb < 4; ++mb)
#pragma unroll
                        for (int ks = 0; ks < 2; ++ks) if (!(ks == 1 && mb < 2)) O[mb] = __builtin_amdgcn_mfma_f32_16x16x32_bf16(*(const LAS bf16x8*)(R + RO_MRB + ((mb * 2 + ks) * 64 + F.lane) * 16), bU[ks], O[mb], 0, 0, 0);
                }
#pragma unroll
                for (int kb = 0; kb < 4; ++kb) { const f32x4 g = *(const LAS f32x4*)(R + (RW ? RO_GAM : GO_GAM) + (16 * kb + 4 * fq) * 4); const f32x4 sk = unpk4(*(const LAS v2u*)(R + (RW ? RO_SK : GO_SK) + ((vb * 4 + kb) * 64 + F.lane) * 8));
                    f32x4 n = S[kb] * g + sk;
                    if (RW) {
#pragma unroll
                        for (int ks = 0; ks < 2; ++ks) n = __builtin_amdgcn_mfma_f32_16x16x32_bf16(*(const LAS bf16x8*)(R + RO_BH + ((kb * 2 + ks) * 64 + F.lane) * 16), bU[ks], n, 0, 0, 0);
                    }
                    S[kb] = n; }
#pragma unroll
                for (int mb = 0; mb < 4; ++mb)
#pragma unroll
                    for (int r = 0; r < 4; ++r) *(LAS bf16*)(F.lds + OSO + par * 8192 + (16 * mb + 4 * fq + r) * 128 + (16 * vb + fr) * 2) = (bf16)f2bf(O[mb][r]);
            }
            LDS_BARRIER();
        }
    }
    if (compute) SEQ_FLUSH(63);
#undef SEQ_FLUSH
    __syncthreads();
}
__device__ __forceinline__ int tri6(int mb, int ks) { return mb < 2 ? mb : 2 + (mb - 2) * 2 + ks; }
struct SeqRegs4 { v4u r[6]; v4u t; };
__device__ __forceinline__ void seq4_ld(SeqRegs4& R, const unsigned char* rec, int vb, int lt) {
    const GAS v4u* src = (const GAS v4u*)rec;
#pragma unroll
    for (int i = 0; i < 6; ++i) R.r[i] = src[i * 384 + lt];
    if (lt < 16) R.t = src[6 * 384 + lt];
    if (lt >= 128) R.t = *(const GAS v4u*)(rec + RO_VB + vb * 4096 + (lt - 128) * 16);
}
__device__ __forceinline__ void seq4_st(const SeqRegs4& R, LAS unsigned char* slot, int lt) {
    LAS v4u* dst = (LAS v4u*)slot;
#pragma unroll
    for (int i = 0; i < 6; ++i) dst[i * 384 + lt] = R.r[i];
    if (lt < 16) dst[6 * 384 + lt] = R.t;
    if (lt >= 128) *(LAS v4u*)(slot + 37120 + (lt - 128) * 16) = R.t;
}
__device__ __forceinline__ void seq_rw(Frame& F, int b, int h, int vb, const unsigned char* recs) {
    constexpr int REC = REC_RW, SLOT = 41216, EXO = 3 * SLOT;
    const bool loader = F.wave >= 2; const int lt = F.tid - 128;
    SeqRegs4 RA, RB;
    if (loader) { seq4_ld(RA, recs, vb, lt); seq4_st(RA, F.lds, lt); seq4_ld(RB, recs + (size_t)1 * REC, vb, lt); seq4_ld(RA, recs + (size_t)2 * REC, vb, lt); }
    __syncthreads();
    f32x4 S[4];
#pragma unroll
    for (int kb = 0; kb < 4; ++kb) S[kb] = (f32x4){0.f, 0.f, 0.f, 0.f};
    const int fr = F.lane & 15, fq = F.lane >> 4;
    bf16* Og_ = WSP(bf16, WS_OI) + (size_t)((b * 4 + h) * 4 + vb) * (SEQ * 16);
    LAS unsigned char* OS = F.lds + EXO + 8192;
#pragma unroll 1
    for (int c2 = 0; c2 < 66; c2 += 2) {
#pragma unroll
        for (int par = 0; par < 2; ++par) {
            const int c = c2 + par;
            if (loader) {
                if (c + 1 < 64) { LAS unsigned char* dst = F.lds + ((c + 1) % 3) * SLOT; if (par == 0) seq4_st(RB, dst, lt); else seq4_st(RA, dst, lt); }
                if (c + 3 < 64) { if (par == 0) seq4_ld(RB, recs + (size_t)(c + 3) * REC, vb, lt); else seq4_ld(RA, recs + (size_t)(c + 3) * REC, vb, lt); }
            } else if (F.wave == 0) {
                if (c < 64) {
                    const LAS unsigned char* R = F.lds + (c % 3) * SLOT; LAS unsigned char* EX = F.lds + EXO + par * 4096;
                    const f32x4 z = (f32x4){0.f, 0.f, 0.f, 0.f};
                    v2u yv[4]; bf16x8 fat[8], ftt[6];
#pragma unroll
                    for (int mb = 0; mb < 4; ++mb) yv[mb] = *(const LAS v2u*)(R + 37120 + (mb * 64 + F.lane) * 8);
#pragma unroll
                    for (int f = 0; f < 8; ++f) fat[f] = *(const LAS bf16x8*)(R + RO_AT + (f * 64 + F.lane) * 16);
                    bf16x8 bS[2]; bS[0] = pack_b(S[0], S[1]); bS[1] = pack_b(S[2], S[3]);
                    *(LAS bf16x8*)(EX + F.lane * 16) = bS[0]; *(LAS bf16x8*)(EX + 1024 + F.lane * 16) = bS[1];
                    asm volatile("s_waitcnt lgkmcnt(0)" ::: "memory"); __builtin_amdgcn_sched_barrier(0);
                    f32x4 X[4], U[4];
#pragma unroll
                    for (int mb = 0; mb < 4; ++mb) { X[mb] = unpk4(yv[mb]);
#pragma unroll
                        for (int ks = 0; ks < 2; ++ks) X[mb] = __builtin_amdgcn_mfma_f32_16x16x32_bf16(fat[mb * 2 + ks], bS[ks], X[mb], 0, 0, 0); }
                    __builtin_amdgcn_sched_barrier(0);
                    bf16x8 fbh[8]; f32x4 gm[4]; v2u skv[4];
#pragma unroll
                    for (int f = 0; f < 6; ++f) ftt[f] = *(const LAS bf16x8*)(R + RO_TT + (f * 64 + F.lane) * 16);
#pragma unroll
                    for (int f = 0; f < 8; ++f) fbh[f] = *(const LAS bf16x8*)(R + RO_BH + (f * 64 + F.lane) * 16);
#pragma unroll
                    for (int kb = 0; kb < 4; ++kb) { gm[kb] = *(const LAS f32x4*)(R + RO_GAM + (16 * kb + 4 * fq) * 4); skv[kb] = *(const LAS v2u*)(R + 37120 + 2048 + (kb * 64 + F.lane) * 8); }
                    __builtin_amdgcn_sched_barrier(0);
                    bf16x8 bX[2]; bX[0] = pack_b(X[0], X[1]); bX[1] = pack_b(X[2], X[3]);
#pragma unroll
                    for (int mb = 0; mb < 4; ++mb) { U[mb] = z;
#pragma unroll
                        for (int ks = 0; ks < 2; ++ks) if (!(ks == 1 && mb < 2)) U[mb] = __builtin_amdgcn_mfma_f32_16x16x32_bf16(ftt[tri6(mb, ks)], bX[ks], U[mb], 0, 0, 0); }
                    bf16x8 bU[2]; bU[0] = pack_b(U[0], U[1]); bU[1] = pack_b(U[2], U[3]);
                    *(LAS bf16x8*)(EX + 2048 + F.lane * 16) = bU[0]; *(LAS bf16x8*)(EX + 3072 + F.lane * 16) = bU[1];
                    asm volatile("s_waitcnt lgkmcnt(0)" ::: "memory"); __builtin_amdgcn_sched_barrier(0);
#pragma unroll
                    for (int kb = 0; kb < 4; ++kb) { f32x4 n = S[kb] * gm[kb] + unpk4(skv[kb]);
#pragma unroll
                        for (int ks = 0; ks < 2; ++ks) n = __builtin_amdgcn_mfma_f32_16x16x32_bf16(fbh[kb * 2 + ks], bU[ks], n, 0, 0, 0);
                        S[kb] = n; }
                }
            } else {
                if (c >= 1 && c <= 64) {
                    const int co = c - 1; const LAS unsigned char* R = F.lds + (co % 3) * SLOT; const LAS unsigned char* EX = F.lds + EXO + (par ^ 1) * 4096;
                    bf16x8 fq_[8], fm[6];
#pragma unroll
                    for (int f = 0; f < 8; ++f) fq_[f] = *(const LAS bf16x8*)(R + RO_QH + (f * 64 + F.lane) * 16);
#pragma unroll
                    for (int f = 0; f < 6; ++f) fm[f] = *(const LAS bf16x8*)(R + RO_MRB + (f * 64 + F.lane) * 16);
                    const bf16x8 bS0 = *(const LAS bf16x8*)(EX + F.lane * 16), bS1 = *(const LAS bf16x8*)(EX + 1024 + F.lane * 16), bU0 = *(const LAS bf16x8*)(EX + 2048 + F.lane * 16), bU1 = *(const LAS bf16x8*)(EX + 3072 + F.lane * 16);
                    asm volatile("s_waitcnt lgkmcnt(0)" ::: "memory"); __builtin_amdgcn_sched_barrier(0);
                    f32x4 O[4];
#pragma unroll
                    for (int mb = 0; mb < 4; ++mb) { O[mb] = (f32x4){0.f, 0.f, 0.f, 0.f};
                        O[mb] = __builtin_amdgcn_mfma_f32_16x16x32_bf16(fq_[mb * 2], bS0, O[mb], 0, 0, 0);
                        O[mb] = __builtin_amdgcn_mfma_f32_16x16x32_bf16(fq_[mb * 2 + 1], bS1, O[mb], 0, 0, 0);
                        O[mb] = __builtin_amdgcn_mfma_f32_16x16x32_bf16(fm[tri6(mb, 0)], bU0, O[mb], 0, 0, 0);
                        if (mb >= 2) O[mb] = __builtin_amdgcn_mfma_f32_16x16x32_bf16(fm[tri6(mb, 1)], bU1, O[mb], 0, 0, 0); }
#pragma unroll
                    for (int mb = 0; mb < 4; ++mb)
#pragma unroll
                        for (int r = 0; r < 4; ++r) *(LAS bf16*)(OS + (16 * mb + 4 * fq + r) * 32 + fr * 2) = (bf16)f2bf(O[mb][r]);
                    asm volatile("s_waitcnt lgkmcnt(0)" ::: "memory");
                    { const v4u a_ = *(const LAS v4u*)(OS + F.lane * 32), b_ = *(const LAS v4u*)(OS + F.lane * 32 + 16); bf16* dst_ = Og_ + ((size_t)co * 64 + F.lane) * 16; *(GAS v4u*)dst_ = a_; *(GAS v4u*)(dst_ + 8) = b_; }
                    asm volatile("s_waitcnt lgkmcnt(0)" ::: "memory");
                }
            }
            LDS_BARRIER();
        }
    }
    __syncthreads();
}
__device__ __forceinline__ void phase_seq(Frame& F, int l) {
    for (int u = blockIdx.x; u < 112; u += F.G) {
        if (u < 64) { const int bh = u >> 2, vb = u & 3; seq_rw(F, bh >> 2, bh & 3, vb, F.ws + WS_REC_RW + (size_t)(bh * 64) * REC_RW); }
        else { const int v = u - 64, mm = v % 3, bh = v / 3; seq_unit<false>(F, mm == 2 ? 3 : mm, bh >> 2, bh & 3, 0, F.ws + WS_REC_GL + (size_t)((mm * 16 + bh) * 64) * REC_GL); }
    }
}
struct PostRaw { v4u o0, o1; v4u y0, y1; v4u x0, x1, x2, x3, x4, x5, x6, x7; };
__device__ __forceinline__ void post_load(Frame& F, PostRaw& R, int t, int m, int c0) {
    const bf16* P = WSP(const bf16, WS_P);
    const bf16* Ob = WSP(const bf16, WS_O) + (size_t)m * TOK * 256 + (size_t)t * 256 + c0;
    R.o0 = *(const GAS v4u*)(Ob); R.o1 = *(const GAS v4u*)(Ob + 8);
    { const int bb = t >> 12, tb = t & (SEQ - 1), hh = c0 >> 6, qq = (c0 >> 4) & 3; const bf16* oi = WSP(const bf16, WS_OI) + (m == 2 ? ((size_t)((bb * 4 + hh) * 4 + qq) * SEQ + tb) * 16 : OI_GEN + ((size_t)(((m == 3 ? 2 : m) * 16 + bb * 4 + hh)) * SEQ + tb) * 64 + 16 * qq);
      R.y0 = *(const GAS v4u*)oi; R.y1 = *(const GAS v4u*)(oi + 8); }
    const v4u zz = (v4u){0u, 0u, 0u, 0u}; R.x2 = zz; R.x3 = zz; R.x4 = zz; R.x5 = zz; R.x6 = zz; R.x7 = zz;
    if (m != 2) { const int gc = (m == 0 ? HG_G : m == 1 ? GL_R : RT_G) + c0; R.x0 = *(const GAS v4u*)(P + (size_t)t * NP + gc); R.x1 = *(const GAS v4u*)(P + (size_t)t * NP + gc + 8); }
    else { const size_t ob = (size_t)t * 256 + c0;
        R.x0 = *(const GAS v4u*)(WSP(const bf16, WS_RWR) + ob); R.x1 = *(const GAS v4u*)(WSP(const bf16, WS_RWR) + ob + 8); R.x2 = *(const GAS v4u*)(WSP(const bf16, WS_RWK) + ob); R.x3 = *(const GAS v4u*)(WSP(const bf16, WS_RWK) + ob + 8);
        R.x4 = *(const GAS v4u*)(WSP(const bf16, WS_RWV) + ob); R.x5 = *(const GAS v4u*)(WSP(const bf16, WS_RWV) + ob + 8); R.x6 = *(const GAS v4u*)(WSP(const bf16, WS_RWG) + ob); R.x7 = *(const GAS v4u*)(WSP(const bf16, WS_RWG) + ob + 8); }
}
__device__ __forceinline__ void unpack16(const v4u a, const v4u b, float (&f)[16]) { float x[8], y[8]; unpack8(a, x); unpack8(b, y);
#pragma unroll
    for (int j = 0; j < 8; ++j) { f[j] = x[j]; f[8 + j] = y[j]; } }
__device__ __forceinline__ void phase_post(Frame& F, int l) {
    const int gw = F.vcu * NWAVES + F.wave, NGW = F.G * NWAVES;
    const int m = F.lane >> 4, h = (F.lane >> 2) & 3, qd = F.lane & 3; const int c0 = 64 * h + 16 * qd;
    bf16* Y = WSP(bf16, WS_Y);
    PostRaw cur, nxt;
    if (gw < TOK) post_load(F, cur, gw, m, c0);
    for (int t = gw; t < TOK; t += NGW) {
        if (t + NGW < TOK) post_load(F, nxt, t + NGW, m, c0);
        float o[16], oi[16];
        unpack16(cur.o0, cur.o1, o);
        unpack16(cur.y0, cur.y1, oi);
        float s1 = 0.f, s2 = 0.f;
#pragma unroll
        for (int j = 0; j < 16; ++j) { o[j] += oi[j]; s1 += o[j]; s2 += o[j] * o[j]; }
        s1 = sum4(s1); s2 = sum4(s2);
        float y[16];
        if (m < 2) {
            const float rs = rsqrtf(s2 * (1.f / 64.f) + 1e-6f); const float* ng = INF(m == 0 ? 9 : 12) + l * 64 + 16 * qd;
            float g[16]; unpack16(cur.x0, cur.x1, g);
#pragma unroll
            for (int j = 0; j < 16; ++j) y[j] = o[j] * rs * ng[j] * (g[j] * sigm(g[j]));
        } else if (m == 2) {
            const float mean = s1 * (1.f / 64.f); float var = s2 * (1.f / 64.f) - mean * mean; var = fmaxf(var, 0.f); const float rs = rsqrtf(var + 64e-5f);
            float r[16], k[16], v[16], g[16]; unpack16(cur.x0, cur.x1, r); unpack16(cur.x2, cur.x3, k); unpack16(cur.x4, cur.x5, v); unpack16(cur.x6, cur.x7, g);
            const float* rk = INF(21) + l * 256 + c0; const float* lg = INF(22) + l * 256 + c0; const float* lb = INF(23) + l * 256 + c0;
            float bon = 0.f;
#pragma unroll
            for (int j = 0; j < 16; ++j) bon += r[j] * k[j] * rk[j];
            bon = sum4(bon);
#pragma unroll
            for (int j = 0; j < 16; ++j) y[j] = ((o[j] - mean) * rs * lg[j] + lb[j] + bon * v[j]) * g[j];
        } else {
            const float mean = s1 * (1.f / 64.f); float var = s2 * (1.f / 64.f) - mean * mean; var = fmaxf(var, 0.f); const float rs = rsqrtf(var + 1e-5f);
            float g[16]; unpack16(cur.x0, cur.x1, g);
#pragma unroll
            for (int j = 0; j < 16; ++j) y[j] = (g[j] * sigm(g[j])) * ((o[j] - mean) * rs);
        }
        v4u w0, w1; w0.x = pk2(y[0], y[1]); w0.y = pk2(y[2], y[3]); w0.z = pk2(y[4], y[5]); w0.w = pk2(y[6], y[7]); w1.x = pk2(y[8], y[9]); w1.y = pk2(y[10], y[11]); w1.z = pk2(y[12], y[13]); w1.w = pk2(y[14], y[15]);
        GAS v4u* yo = (GAS v4u*)(Y + (size_t)t * D + 256 * m + c0); yo[0] = w0; yo[1] = w1;
        cur = nxt;
    }
}
template <int MODE> struct LnRaw { v2u h[4]; v2u d1[4], d2[4]; float g1, g2; };
template <int MODE> __device__ __forceinline__ void ln_load(Frame& F, LnRaw<MODE>& R, int m) {
    const GAS v2u* hr = (const GAS v2u*)(WSP(const bf16, WS_HB) + (size_t)m * D) + F.lane;
#pragma unroll
    for (int j = 0; j < 4; ++j) R.h[j] = hr[64 * j];
    if (MODE == 0) { const GAS v2u* ar = (const GAS v2u*)(WSP(const bf16, WS_MIX) + (size_t)m * D) + F.lane;
#pragma unroll
        for (int j = 0; j < 4; ++j) R.d1[j] = ar[64 * j]; }
    else { const bf16* DOUT = WSP(const bf16, WS_DOUT); const float* GATE = WSP(const float, WS_GATE); R.g1 = GATE[2 * m]; R.g2 = GATE[2 * m + 1];
#pragma unroll
        for (int j = 0; j < 4; ++j) { R.d1[j] = ((const GAS v2u*)(DOUT + (size_t)(2 * m) * D))[F.lane + 64 * j]; R.d2[j] = ((const GAS v2u*)(DOUT + (size_t)(2 * m + 1) * D))[F.lane + 64 * j]; } }
}
template <int MODE, bool ROUTE, bool Q8 = false> __device__ __forceinline__ void phase_ln(Frame& F, const float* gw_, const float* bw_, const float* router, int mi, const bool final_out = false) {
    const int gw = F.vcu * NWAVES + F.wave, NGW = F.G * NWAVES;
    bf16* hb = WSP(bf16, WS_HB); float* GATE = WSP(float, WS_GATE);
    LAS float* RT = (LAS float*)F.lds;
    if (ROUTE) { for (int i = F.tid; i < D * NE; i += NWAVES * 64) RT[(i & 7) * D + (i >> 3)] = router[i]; __syncthreads(); }
    f32x4 gv[4], bv[4];
#pragma unroll
    for (int j = 0; j < 4; ++j) { gv[j] = ((const GAS f32x4*)gw_)[F.lane + 64 * j]; bv[j] = ((const GAS f32x4*)bw_)[F.lane + 64 * j]; }
    LnRaw<MODE> cur, nxt;
    if (gw < TOK) ln_load<MODE>(F, cur, gw);
    for (int m = gw; m < TOK; m += NGW) {
        if (m + NGW < TOK) ln_load<MODE>(F, nxt, m + NGW);
        GAS f32x4* hr = (GAS f32x4*)(F.h + (size_t)m * D) + F.lane;
        f32x4 v[4]; float s = 0.f;
#pragma unroll
        for (int j = 0; j < 4; ++j) {
            f32x4 a;
            if (MODE == 0) { const v2u d1 = cur.d1[j]; a = (f32x4){bflo(d1.x), bfhi(d1.x), bflo(d1.y), bfhi(d1.y)}; }
            else { const v2u d1 = cur.d1[j], d2 = cur.d2[j]; const float g1 = cur.g1, g2 = cur.g2;
                a.x = g1 * bflo(d1.x) + g2 * bflo(d2.x); a.y = g1 * bfhi(d1.x) + g2 * bfhi(d2.x); a.z = g1 * bflo(d1.y) + g2 * bflo(d2.y); a.w = g1 * bfhi(d1.y) + g2 * bfhi(d2.y); }
            const v2u hq = cur.h[j]; const f32x4 hv = (f32x4){bflo(hq.x), bfhi(hq.x), bflo(hq.y), bfhi(hq.y)};
            v[j] = hv * DN_ALPHA + a; s += (v[j].x + v[j].y) + (v[j].z + v[j].w); }
        const float mean = wave_sum(s) * (1.f / D); float s2 = 0.f;
#pragma unroll
        for (int j = 0; j < 4; ++j) { v[j] = v[j] - mean; s2 += (v[j].x * v[j].x + v[j].y * v[j].y) + (v[j].z * v[j].z + v[j].w * v[j].w); }
        const float rstd = 1.f / sqrtf(wave_sum(s2) * (1.f / D) + 1e-5f);
        GAS v2u* o8 = (GAS v2u*)(hb + (size_t)m * D) + F.lane;
#pragma unroll
        for (int j = 0; j < 4; ++j) { v[j] = v[j] * rstd * gv[j] + bv[j]; if (final_out) hr[64 * j] = v[j]; v2u w; w.x = pk2(v[j].x, v[j].y); w.y = pk2(v[j].z, v[j].w); o8[64 * j] = w; }
        if (Q8) { float am = 0.f;
#pragma unroll
            for (int j = 0; j < 4; ++j) { const f32x4 a = __builtin_elementwise_abs(v[j]); am = fmaxf(am, fmaxf(fmaxf(a.x, a.y), fmaxf(a.z, a.w))); }
            am = wave_max(am); const float inv = am > 0.f ? 127.f / am : 0.f;
            GAS unsigned* q8 = (GAS unsigned*)(WSP(unsigned char, WS_H8) + (size_t)m * D) + F.lane;
#pragma unroll
            for (int j = 0; j < 4; ++j) q8[64 * j] = pack_i8(v[j].x * inv, v[j].y * inv, v[j].z * inv, v[j].w * inv);
            if (F.lane == 0) WSP(float, WS_RS)[m] = am * (1.f / 127.f); }
        if (ROUTE) {
            float lg[8];
#pragma unroll
            for (int e = 0; e < 8; ++e) { float a = 0.f;
#pragma unroll
                for (int j = 0; j < 4; ++j) { const f32x4 r = *(const LAS f32x4*)(RT + e * D + 4 * (F.lane + 64 * j)); a += (v[j].x * r.x + v[j].y * r.y) + (v[j].z * r.z + v[j].w * r.w); }
                lg[e] = wave_sum(a); }
            int e1 = 0; float l1 = lg[0];
#pragma unroll
            for (int e = 1; e < 8; ++e) if (lg[e] > l1) { l1 = lg[e]; e1 = e; }
            int e2 = -1; float l2 = -3.0e38f;
#pragma unroll
            for (int e = 0; e < 8; ++e) if (e != e1 && lg[e] > l2) { l2 = lg[e]; e2 = e; }
            if (F.lane == 0) {
                const float p2 = __expf(l2 - l1); const float ga = 1.f / (1.f + p2);
                GATE[2 * m] = ga; GATE[2 * m + 1] = p2 * ga;
                int* list = WSP(int, WS_LIST) + (size_t)mi * NE * TOK;
                const unsigned p1 = __hip_atomic_fetch_add((unsigned*)(F.ctl + CW_CNT + (mi * 8 + e1) * 64), 1u, RLX_AGENT); list[e1 * TOK + p1] = 2 * m;
                const unsigned q2 = __hip_atomic_fetch_add((unsigned*)(F.ctl + CW_CNT + (mi * 8 + e2) * 64), 1u, RLX_AGENT); list[e2 * TOK + q2] = 2 * m + 1;
            }
        }
        cur = nxt;
    }
}
__device__ __forceinline__ void phase_gather(Frame& F, int mi) {
    int cnt[8], poff[9]; poff[0] = 0;
    unsigned* cb_ = (unsigned*)(F.ctl + CW_CNT + mi * 8 * 64); asm volatile("" : "+s"(cb_));
#pragma unroll
    for (int e = 0; e < 8; ++e) { cnt[e] = (int)__hip_atomic_load(cb_ + e * 64, RLX_AGENT); poff[e + 1] = poff[e] + ((cnt[e] + 255) >> 8); }
    const int npan = poff[8];
    int* tab = WSP(int, WS_TAB) + mi * TAB_STRIDE;
    if (blockIdx.x == 0) {
        for (int P = F.tid; P < npan; P += NWAVES * 64) { int e = 0, pe = 0, ce = cnt[0];
#pragma unroll
            for (int j = 1; j < 8; ++j) if (P >= poff[j]) { e = j; pe = poff[j]; ce = cnt[j]; }
            tab[4 * P] = e; tab[4 * P + 1] = 256 * (P - pe); tab[4 * P + 2] = ce; tab[4 * P + 3] = 0; }
        if (F.tid == 0) tab[640] = npan;
    }
    const int gw = F.vcu * NWAVES + F.wave, NGW = F.G * NWAVES;
    const int* list = WSP(const int, WS_LIST) + (size_t)mi * NE * TOK; const bf16* hb = WSP(const bf16, WS_HB); bf16* HP = WSP(bf16, WS_HPERM);
    for (int row = gw; row < 256 * npan; row += NGW) { const int P = row >> 8; int e = 0, pe = 0, ce = cnt[0];
#pragma unroll
        for (int j = 1; j < 8; ++j) if (P >= poff[j]) { e = j; pe = poff[j]; ce = cnt[j]; }
        const int r = row - 256 * pe; const int tok = (r < ce) ? (list[e * TOK + r] >> 1) : 0;
        const GAS v4u* s = (const GAS v4u*)(hb + (size_t)tok * D) + F.lane; GAS v4u* d = (GAS v4u*)(HP + (size_t)row * D) + F.lane; d[0] = s[0]; d[64] = s[64]; }
}
struct Args { const void* in[36]; int ph_lo, ph_hi; };
__global__ void __launch_bounds__(NWAVES * 64, 2) mk_fwd(Args args) {
    extern __shared__ __attribute__((aligned(16))) unsigned char lds[];
    Frame F;
    F.lds = (LAS unsigned char*)lds;
    F.MISC = (volatile LAS unsigned*)(F.lds + MISC_OFF);
    F.tid = threadIdx.x; F.lane = F.tid & 63; F.wave = __builtin_amdgcn_readfirstlane(F.tid >> 6);
    const int wave_k = F.wave;
    F.G = gridDim.x; { const int bx = blockIdx.x; F.vcu = (F.G % 8 == 0) ? (bx % 8) * (F.G / 8) + bx / 8 : bx; }
    F.in = args.in; F.ws = (unsigned char*)ldptr(F.in, 35); F.h = (float*)ldptr(F.in, 34);
    F.ctl = (gu32*)(F.ws + WS_CTL);
    for (int u = F.tid; u < (LDS_BYTES - LDSCTL_OFF) / 4; u += NWAVES * 64) ((LAS unsigned*)(F.lds + LDSCTL_OFF))[u] = 0u;
    __syncthreads();
    XcdBarrier bar; bar.bar = (unsigned*)(F.ctl + CW_BAR); bar.x = 0; bar.st = nullptr; bar.wv = 0;
    if (!MK_PER_PHASE) bar = xcd_barrier_post((unsigned*)(F.ctl + CW_BAR), F.MISC + 8);
    const int lo = args.ph_lo, hi = args.ph_hi;
#define IN(k) (lo <= (k) && (k) < hi)
#define PHASE_BEGIN() do { int t_ = wave_k * 64 + lane_id_now(); asm volatile("" : "+v"(t_)); F.tid = t_; F.lane = t_ & 63; F.wave = wave_k; \
        F.ws = (unsigned char*)ldptr(F.in, 35); F.ctl = (gu32*)(F.ws + WS_CTL); F.h = (float*)ldptr(F.in, 34); } while (0)
#define SEAM(k) do { if (IN(k) && IN((k) + 1)) { xcd_barrier(bar); if (DUPMASK & 4096) xcd_barrier(bar); } } while (0)
    for (int l = 0; l < DEPTH; ++l) {
        const int pb = l * NPH; const bool moe = (l & 1); const int mi = l >> 1;
#define PH(k) (((PHMASK >> (k)) & 1) && IN(pb + (k)))
        if (l == 0) { if (PH(0)) { PHASE_BEGIN(); phase_weights<0>(F, 0); } SEAM(pb + 0); }
        if (PH(1)) for (int rep_ = 0; rep_ < ((((DUPMASK >> 1) & 1) && ((DUPL >> l) & 1)) ? 2 : 1); ++rep_) { PHASE_BEGIN(); if (rep_) __syncthreads();
            pg8::Gemm g{WSP(const bf16, WS_HB), WSP(const bf16, WS_WIN), TOK, NP, D}; pg8::StaticOrder S; S.init(TOK, NP, F.G, (int)blockIdx.x);
            pg8::EpiBf16 E{WSP(bf16, WS_P), NP};
            pg8::gemm_phase<pg8::EpiBf16, pg8::StaticOrder, true, true>(F.lds, g, S, E, F.wave);
        } SEAM(pb + 1);
        if (PH(3)) { PHASE_BEGIN(); phase_chunkpre(F, l); if (DUPMASK & 8) { __syncthreads(); phase_chunkpre(F, l); } } SEAM(pb + 3);
        if (PH(4)) { PHASE_BEGIN(); phase_seq(F, l); if (DUPMASK & 16) { __syncthreads(); phase_seq(F, l); }
            if (((int)blockIdx.x >= 112 || F.G <= 112)) { const int sv = F.vcu, sg = F.G; if (sg > 112) { F.vcu = (int)blockIdx.x - 112; F.G = sg - 112; } phase_absmax(F, l); if ((DUPMASK & 8192) && ((DUPL >> l) & 1)) phase_absmax(F, l); F.vcu = sv; F.G = sg; }
            if (l + 1 < DEPTH && (int)blockIdx.x >= 112 && F.G > 112) { const int sv = F.vcu, sg = F.G; F.vcu = (int)blockIdx.x - 112; F.G = sg - 112; phase_weights<0>(F, l + 1); F.vcu = sv; F.G = sg; }
        } SEAM(pb + 4);
        if (PH(5)) { PHASE_BEGIN(); phase_post(F, l); __syncthreads(); phase_weights<1>(F, l); if (DUPMASK & 32) { __syncthreads(); phase_weights<1>(F, l); } } SEAM(pb + 5);
        if (PH(6)) for (int rep_ = 0; rep_ < ((((DUPMASK >> 6) & 1) && ((DUPL >> l) & 1)) ? 2 : 1); ++rep_) { PHASE_BEGIN(); if (rep_) __syncthreads();
            pg8::Gemm g{WSP(const bf16, WS_Y), WSP(const bf16, (l & 1) ? WS_WOUT2 : WS_WOUT), TOK, D, D}; pg8::StaticOrder S; S.init(TOK, D, F.G, (int)blockIdx.x);
            pg8::EpiBf16 E{WSP(bf16, WS_MIX), D};
            pg8::gemm_phase<pg8::EpiBf16, pg8::StaticOrder, false, true>(F.lds, g, S, E, F.wave);
        } SEAM(pb + 6);
        if (PH(7)) { PHASE_BEGIN();
            if (moe) phase_ln<0, true, true>(F, INF(4) + l * D, INF(5) + l * D, INF(30) + (size_t)mi * D * NE, mi);
            else phase_ln<0, false, true>(F, INF(4) + l * D, INF(5) + l * D, nullptr, 0);
        } SEAM(pb + 7);
        if (PH(9)) for (int rep_ = 0; rep_ < ((((DUPMASK >> 9) & 1) && ((DUPL >> l) & 1)) ? 2 : 1); ++rep_) { PHASE_BEGIN(); if (rep_) __syncthreads();
            if (STAG9 > 0 && (((int)blockIdx.x >> 3) & 1)) { const unsigned long long t0_ = __builtin_amdgcn_s_memrealtime(); while (__builtin_amdgcn_s_memrealtime() - t0_ < (unsigned long long)STAG9) __builtin_amdgcn_s_sleep(8); }
            if (!moe) { pg8::Gemm g{WSP(const bf16, WS_H8), WSP(const bf16, WS_WUP), TOK, 2 * FFD, D / 2}; pg8::StaticOrder S; S.init(TOK, 2 * FFD, F.G, (int)blockIdx.x);
                pg8::EpiSwiGLU8<false> E{WSP(unsigned char, WS_HID), FFD, 22, WSP(const float, WS_RS), __uint_as_float(__hip_atomic_load((unsigned*)(F.ctl + CW_AMAX + l * 64), RLX_AGENT)) * (1.f / 127.f), pg8::MoeMap{}};
                pg8::gemm_phase<pg8::EpiSwiGLU8<false>, pg8::StaticOrder, true, true, 1>(F.lds, g, S, E, F.wave);
            } else { pg8::MoeOrder<true> S; S.M.init((const unsigned*)(F.ctl + CW_CNT + mi * 8 * 64), WSP(const int, WS_LIST) + (size_t)mi * NE * TOK); const int npan = S.M.poff[8];
                S.tpg = 11; S.G = F.G; S.c = (int)blockIdx.x; S.nunits = npan * 11; S.rowbytes = D;
                pg8::Gemm g{WSP(const bf16, WS_H8), WSP(const bf16, WS_WUP), 256 * npan, 2 * FFE, D / 2};
                pg8::EpiSwiGLU8<true> E{WSP(unsigned char, WS_HID), FFEP, 11, WSP(const float, WS_RS), __uint_as_float(__hip_atomic_load((unsigned*)(F.ctl + CW_AMAX + l * 64), RLX_AGENT)) * (1.f / 127.f), S.M};
                pg8::gemm_phase<pg8::EpiSwiGLU8<true>, pg8::MoeOrder<true>, true, true, 1>(F.lds, g, S, E, F.wave);
            }
        } SEAM(pb + 9);
        if (PH(10)) for (int rep_ = 0; rep_ < ((((DUPMASK >> 10) & 1) && ((DUPL >> l) & 1)) ? 2 : 1); ++rep_) { PHASE_BEGIN(); if (rep_) __syncthreads();
            float qsd_, invd; f8_scale(__uint_as_float(__hip_atomic_load((unsigned*)(F.ctl + CW_AMAXD + l * 64), RLX_AGENT)), qsd_, invd);
            if (!moe) { pg8::Gemm g{WSP(const bf16, WS_HID), WSP(const bf16, WS_WDN), TOK, D, FFD / 2}; pg8::StaticOrder S; S.init(TOK, D, F.G, (int)blockIdx.x);
                pg8::EpiBf16S E{WSP(bf16, WS_MIX), D, invd};
                pg8::gemm_phase<pg8::EpiBf16S, pg8::StaticOrder, false, true, 2>(F.lds, g, S, E, F.wave);
            } else { pg8::MoeOrder<false> S; S.M.init((const unsigned*)(F.ctl + CW_CNT + mi * 8 * 64), WSP(const int, WS_LIST) + (size_t)mi * NE * TOK); const int npan = S.M.poff[8];
                S.tpg = 4; S.G = F.G; S.c = (int)blockIdx.x; S.nunits = npan * 4; S.rowbytes = 0;
                pg8::Gemm g{WSP(const bf16, WS_HID), WSP(const bf16, WS_WDN), 256 * npan, D, FFEP / 2};
                pg8::EpiScatter E{WSP(bf16, WS_DOUT), S.M, invd};
                pg8::gemm_phase<pg8::EpiScatter, pg8::MoeOrder<false>, true, true, 2>(F.lds, g, S, E, F.wave);
            }
        } SEAM(pb + 10);
        if (PH(11)) { PHASE_BEGIN();
            if (moe) phase_ln<1, false>(F, INF(6) + l * D, INF(7) + l * D, nullptr, 0, l == DEPTH - 1);
            else phase_ln<0, false>(F, INF(6) + l * D, INF(7) + l * D, nullptr, 0, l == DEPTH - 1);
            if (l + 1 < DEPTH && F.G <= 112) { __syncthreads(); phase_weights<0>(F, l + 1); }
        } SEAM(pb + 11);
#undef PH
    }
#undef IN
#undef SEAM
}

extern "C" void kernel_launch(void* const* d_in, const int* in_sizes, int n_in, void* d_out, int out_size, void* d_ws, size_t ws_size, hipStream_t stream) {
    static int grid = 0;
    if (grid == 0) {
        if (n_in != 34 || out_size != TOK * D || ws_size < WS_END) { fprintf(stderr, "kernel_launch: unexpected shapes (n_in %d, out %d, ws %zu)\n", n_in, out_size, ws_size); grid = -1; return; }
        int dev = 0, cus = 0, per_cu = 0;
        if (hipGetDevice(&dev) != hipSuccess || hipDeviceGetAttribute(&cus, hipDeviceAttributeMultiprocessorCount, dev) != hipSuccess) { grid = -1; return; }
        if (hipFuncSetAttribute((const void*)mk_fwd, hipFuncAttributeMaxDynamicSharedMemorySize, LDS_BYTES) != hipSuccess) { fprintf(stderr, "kernel_launch: hipFuncSetAttribute failed\n"); grid = -1; return; }
        if (hipOccupancyMaxActiveBlocksPerMultiprocessor(&per_cu, (const void*)mk_fwd, NWAVES * 64, LDS_BYTES) != hipSuccess || per_cu < 1) fprintf(stderr, "kernel_launch: occupancy query reports %d\n", per_cu);
        (void)hipGetLastError();
        grid = cus;
    }
    if (grid < 0) return;
    if (hipMemsetAsync((char*)d_ws + WS_CTL, 0, CTL_ZERO_BYTES, stream) != hipSuccess) return;
    Args a{};
    for (int i = 0; i < 34; ++i) a.in[i] = d_in[i];
    a.in[34] = d_out; a.in[35] = d_ws;
#if MK_PER_PHASE
    for (int p = 0; p < NPHASES; ++p) { a.ph_lo = p; a.ph_hi = p + 1; hipLaunchKernelGGL(mk_fwd, dim3(grid), dim3(NWAVES * 64), LDS_BYTES, stream, a); }
#else
    a.ph_lo = 0; a.ph_hi = NPHASES; hipLaunchKernelGGL(mk_fwd, dim3(grid), dim3(NWAVES * 64), LDS_BYTES, stream, a);
#endif
}
```

```cpp
#include <hip/hip_runtime.h>
#include <cstdio>
#include <cstdint>
#ifndef PHMASK
#define PHMASK 0xfff
#endif
#ifndef DUPMASK
#define DUPMASK 0
#endif
#ifndef DUPL
#define DUPL 0xf
#endif
#ifndef STAG9
#define STAG9 0
#endif
#ifndef MK_PER_PHASE
#define MK_PER_PHASE 0
#endif
__device__ __forceinline__ int lane_id_now() { unsigned m_ = ~0u; asm volatile("" : "+s"(m_)); return (int)__builtin_amdgcn_mbcnt_hi(m_, __builtin_amdgcn_mbcnt_lo(m_, 0u)); }
namespace pg8 {
#define PG8_LAS __attribute__((address_space(3)))
typedef unsigned short bf16_t;
typedef short bf16x8 __attribute__((ext_vector_type(8)));
typedef float f32x4 __attribute__((ext_vector_type(4)));
typedef unsigned u32x4 __attribute__((ext_vector_type(4)));
constexpr int BM = 256, BK = 64, HALF = 128, HTB = HALF * BK * 2  , STAGE_BYTES = 8 * HTB, NXCD = 8, WGM = 8;

__host__ __device__ __forceinline__ int lds_byte(int r, int c) { const int st = (r >> 4) * 2 + (c >> 5), rr = r & 15, cc = c & 31, ob = rr * 64 + cc * 2; return st * 1024 + (ob ^ (((ob >> 9) & 1) << 5)); }
__host__ __device__ __forceinline__ void stage_rc(int b, int& R, int& C) { const int st = b / 1024, sb = b % 1024, swz = sb ^ (((sb >> 9) & 1) << 5); R = (st >> 1) * 16 + swz / 64; C = (st & 1) * 32 + (swz % 64) / 2; }
__host__ __device__ __forceinline__ int perm32(int rho) { const int n = rho >> 4, i = rho & 15; return 8 * (i >> 2) + 4 * n + (i & 3); }

struct Unit { int pm, pn; };
struct Gemm { const bf16_t* A; const bf16_t* Bt; int M, N, K; };

struct StaticOrder {
    static constexpr bool GATHER = false;
    int nM, nN, nwg, G, c;
    __device__ __forceinline__ unsigned a_off(const Unit&, int) const { return 0u; }
    __host__ __device__ void init(int M, int N, int G_, int c_) { nM = M / BM; nN = N / BM; nwg = nM * nN; G = G_; c = c_; }
    __host__ __device__ bool next(int i, Unit& u) const {
        const long L = (long)i * G + c; if (L >= nwg) return false;
        int wgid = (int)L; { const int q = nwg / NXCD, r = nwg % NXCD, xcd = wgid % NXCD, off = wgid / NXCD; wgid = (xcd < r ? xcd * (q + 1) : r * (q + 1) + (xcd - r) * q) + off; }
        const int nig = WGM * nN, gid = wgid / nig, fm = gid * WGM, gsz = (nM - fm) < WGM ? (nM - fm) : WGM;
        u.pm = fm + ((wgid % nig) % gsz); u.pn = (wgid % nig) / gsz; return true;
    }
    __device__ __forceinline__ void a_ready(const Unit&) const {}
    __device__ __forceinline__ void done(const Unit&) const {}
};
__device__ __forceinline__ unsigned cvt_pk_bf16(float lo, float hi) { unsigned r; asm volatile("v_cvt_pk_bf16_f32 %0, %1, %2" : "=v"(r) : "v"(lo), "v"(hi)); return r; }
typedef float f32x2 __attribute__((ext_vector_type(2)));
struct EpiBf16 {
    static constexpr bool PERM = true, AFTER_DRAIN = false;
    bf16_t* O; int ldc;
    __device__ __forceinline__ void operator()(const f32x4 (&acc)[2][2][4][2], const Unit& u, int wr, int wc, int fr, int fq) const {
        const int row0 = u.pm * BM + wr * 64 + fr; const int col0 = u.pn * BM + wc * 32 + 8 * fq;
#pragma unroll
        for (int ai = 0; ai < 2; ++ai)
#pragma unroll
            for (int m = 0; m < 4; ++m) { bf16_t* rowp = O + (size_t)(row0 + ai * HALF + m * 16) * ldc + col0;
#pragma unroll
                for (int bj = 0; bj < 2; ++bj) { const f32x4 v0 = acc[ai][bj][m][0], v1 = acc[ai][bj][m][1];
                    u32x4 w; w.x = cvt_pk_bf16(v0[0], v0[1]); w.y = cvt_pk_bf16(v0[2], v0[3]); w.z = cvt_pk_bf16(v1[0], v1[1]); w.w = cvt_pk_bf16(v1[2], v1[3]);
                    *(u32x4*)(rowp + bj * HALF) = w; } }
    }
};
struct EpiBf16S {
    static constexpr bool PERM = true, AFTER_DRAIN = false;
    bf16_t* O; int ldc; float sc;
    __device__ __forceinline__ void operator()(const f32x4 (&acc)[2][2][4][2], const Unit& u, int wr, int wc, int fr, int fq) const {
        const int row0 = u.pm * BM + wr * 64 + fr; const int col0 = u.pn * BM + wc * 32 + 8 * fq;
#pragma unroll
        for (int ai = 0; ai < 2; ++ai)
#pragma unroll
            for (int m = 0; m < 4; ++m) { bf16_t* rowp = O + (size_t)(row0 + ai * HALF + m * 16) * ldc + col0;
#pragma unroll
                for (int bj = 0; bj < 2; ++bj) { const f32x4 v0 = acc[ai][bj][m][0] * sc, v1 = acc[ai][bj][m][1] * sc;
                    u32x4 w; w.x = cvt_pk_bf16(v0[0], v0[1]); w.y = cvt_pk_bf16(v0[2], v0[3]); w.z = cvt_pk_bf16(v1[0], v1[1]); w.w = cvt_pk_bf16(v1[2], v1[3]);
                    *(u32x4*)(rowp + bj * HALF) = w; } }
    }
};
struct EpiF32 {
    static constexpr bool PERM = false, AFTER_DRAIN = false;
    float* C; int ldc;
    __device__ __forceinline__ void operator()(const f32x4 (&acc)[2][2][4][2], const Unit& u, int wr, int wc, int fr, int fq) const {
        const int row0 = u.pm * BM + wr * 64 + fr, col0 = u.pn * BM + wc * 32 + 4 * fq;
#pragma unroll
        for (int ai = 0; ai < 2; ++ai)
#pragma unroll
            for (int m = 0; m < 4; ++m) { float* rowp = C + (size_t)(row0 + ai * HALF + m * 16) * ldc + col0;
#pragma unroll
                for (int bj = 0; bj < 2; ++bj)
#pragma unroll
                    for (int n = 0; n < 2; ++n) *(f32x4*)(rowp + bj * HALF + n * 16) = acc[ai][bj][m][n]; }
    }
};
__device__ __forceinline__ float silu_f(float x) { return x * __builtin_amdgcn_rcpf(1.0f + __expf(-x)); }
struct EpiSwiGLU {
    static constexpr bool PERM = true, AFTER_DRAIN = false;
    bf16_t* O; int ldc; int tiles_per_group;
    __device__ __forceinline__ void operator()(const f32x4 (&acc)[2][2][4][2], const Unit& u, int wr, int wc, int fr, int fq) const {
        const int row0 = u.pm * BM + wr * 64 + fr; const int pnl = u.pn % tiles_per_group; const int col0 = pnl * HALF + wc * 32 + 8 * fq;
#pragma unroll
        for (int ai = 0; ai < 2; ++ai)
#pragma unroll
            for (int m = 0; m < 4; ++m) { bf16_t* rowp = O + (size_t)(row0 + ai * HALF + m * 16) * ldc + col0;
                float h[8];
#pragma unroll
                for (int n = 0; n < 2; ++n)
#pragma unroll
                    for (int j = 0; j < 4; ++j) h[4 * n + j] = silu_f(acc[ai][0][m][n][j]) * acc[ai][1][m][n][j];
                u32x4 w; w.x = cvt_pk_bf16(h[0], h[1]); w.y = cvt_pk_bf16(h[2], h[3]); w.z = cvt_pk_bf16(h[4], h[5]); w.w = cvt_pk_bf16(h[6], h[7]);
                *(u32x4*)rowp = w; }
    }
};
struct MoeMap {
    int cnt[8], poff[9]; const int* list;
    __device__ __forceinline__ void init(const unsigned* counters, const int* list_) { list = list_; poff[0] = 0;
#pragma unroll
        for (int e = 0; e < 8; ++e) { cnt[e] = __builtin_amdgcn_readfirstlane((int)__hip_atomic_load(counters + e * 64, __ATOMIC_RELAXED, __HIP_MEMORY_SCOPE_AGENT));     poff[e + 1] = poff[e] + ((cnt[e] + 255) >> 8); } }
    __device__ __forceinline__ void locate(int P, int& e, int& lr, int& ce) const { e = 0; int pe = 0; ce = cnt[0];
#pragma unroll
        for (int j = 1; j < 8; ++j) if (P >= poff[j]) { e = j; pe = poff[j]; ce = cnt[j]; }
        lr = 256 * (P - pe); }
};
template <bool MOE> struct EpiSwiGLU8 {
    static constexpr bool PERM = true, AFTER_DRAIN = false;
    unsigned char* O; int ldc; int tiles_per_group; const float* rs; float sw; MoeMap M;
    __device__ __forceinline__ void operator()(const f32x4 (&acc)[2][2][4][2], const Unit& u, int wr, int wc, int fr, int fq) const {
        const int row0 = u.pm * BM + wr * 64 + fr; const int pnl = u.pn % tiles_per_group; const int col0 = pnl * HALF + wc * 32 + 8 * fq;
        float sc[2][4];
        if constexpr (MOE) { int e, lr, ce; M.locate(u.pm, e, lr, ce); const int* lst = M.list + e * 16384;
#pragma unroll
            for (int ai = 0; ai < 2; ++ai)
#pragma unroll
                for (int m = 0; m < 4; ++m) { const int r = lr + wr * 64 + fr + ai * HALF + m * 16; sc[ai][m] = rs[(r < ce) ? (lst[r] >> 1) : 0] * sw; }
        } else {
#pragma unroll
            for (int ai = 0; ai < 2; ++ai)
#pragma unroll
                for (int m = 0; m < 4; ++m) sc[ai][m] = rs[row0 + ai * HALF + m * 16] * sw;
        }
#pragma unroll
        for (int ai = 0; ai < 2; ++ai)
#pragma unroll
            for (int m = 0; m < 4; ++m) { unsigned char* rowp = O + (size_t)(row0 + ai * HALF + m * 16) * ldc + col0;
                float h[8];
#pragma unroll
                for (int n = 0; n < 2; ++n)
#pragma unroll
                    for (int j = 0; j < 4; ++j) { const float ag = acc[ai][0][m][n][j], au = acc[ai][1][m][n][j]; const float g = (float)__float_as_int(ag) * sc[ai][m], up = (float)__float_as_int(au) * sc[ai][m]; h[4 * n + j] = __builtin_fminf(__builtin_fmaxf(silu_f(g) * up, -448.f), 448.f); }
                unsigned w0 = 0u, w1 = 0u; w0 = __builtin_amdgcn_cvt_pk_fp8_f32(h[0], h[1], w0, false); w0 = __builtin_amdgcn_cvt_pk_fp8_f32(h[2], h[3], w0, true); w1 = __builtin_amdgcn_cvt_pk_fp8_f32(h[4], h[5], w1, false); w1 = __builtin_amdgcn_cvt_pk_fp8_f32(h[6], h[7], w1, true);
                typedef unsigned u32x2_ __attribute__((ext_vector_type(2))); u32x2_ w; w.x = w0; w.y = w1; *(u32x2_*)rowp = w;
                if (MOE && pnl == tiles_per_group - 1) { u32x2_ z; z.x = 0u; z.y = 0u; *(u32x2_*)(rowp + HALF) = z; } }
    }
};
struct EpiScatter {
    static constexpr bool PERM = true, AFTER_DRAIN = false;
    bf16_t* O; MoeMap M; float sc;
    __device__ __forceinline__ void operator()(const f32x4 (&acc)[2][2][4][2], const Unit& u, int wr, int wc, int fr, int fq) const {
        int e, lr, cnt; M.locate(u.pm, e, lr, cnt);
        const int pnl = u.pn & 3; const int col0 = pnl * BM + wc * 32 + 8 * fq; const int* lst = M.list + e * 16384;
#pragma unroll
        for (int ai = 0; ai < 2; ++ai)
#pragma unroll
            for (int m = 0; m < 4; ++m) { const int r = lr + wr * 64 + fr + ai * HALF + m * 16;
                if (r < cnt) { const int slot = lst[r]; bf16_t* rowp = O + (size_t)slot * 1024 + col0;
#pragma unroll
                    for (int bj = 0; bj < 2; ++bj) { const f32x4 v0 = acc[ai][bj][m][0] * sc, v1 = acc[ai][bj][m][1] * sc;
                        u32x4 w; w.x = cvt_pk_bf16(v0[0], v0[1]); w.y = cvt_pk_bf16(v0[2], v0[3]); w.z = cvt_pk_bf16(v1[0], v1[1]); w.w = cvt_pk_bf16(v1[2], v1[3]);
                        *(u32x4*)(rowp + bj * HALF) = w; } } }
    }
};
template <bool GATHER_> struct MoeOrder {
    static constexpr bool GATHER = GATHER_;
    MoeMap M; int tpg, G, c, nunits; unsigned rowbytes;
    __device__ __forceinline__ bool next(int i, Unit& u) const {
        const int L = i * G + c; if (L >= nunits) return false;
        int wgid = L; { const int q = nunits / NXCD, r = nunits % NXCD, xcd = wgid % NXCD, off = wgid / NXCD; wgid = (xcd < r ? xcd * (q + 1) : r * (q + 1) + (xcd - r) * q) + off; }
        const int P = wgid / tpg, pnl = wgid - P * tpg; int e, lr, ce; M.locate(P, e, lr, ce);
        u.pm = P; u.pn = e * tpg + pnl; return true;
    }
    __device__ __forceinline__ unsigned a_off(const Unit& u, int row) const {
        int e, lr, ce; M.locate(u.pm, e, lr, ce); const int r = lr + row; const int tok = (r < ce) ? (M.list[e * 16384 + r] >> 1) : 0; return (unsigned)tok * rowbytes; }
    __device__ __forceinline__ void a_ready(const Unit&) const {}
    __device__ __forceinline__ void done(const Unit&) const {}
};
typedef int i32x4 __attribute__((ext_vector_type(4))); typedef int i32x8 __attribute__((ext_vector_type(8)));
template <class Epi, class Sched, bool ALIGN_EPI = false, bool SP2 = false, int MT = 0  >
__device__ __forceinline__ void gemm_phase(PG8_LAS unsigned char* lds, const Gemm g, const Sched& S, const Epi& E, const int wave_in) {
    int tid_ = wave_in * 64 + lane_id_now(); asm volatile("" : "+v"(tid_));
    const int tid = tid_, wid = __builtin_amdgcn_readfirstlane(tid >> 6), lane = tid & 63, wr = wid >> 2, wc = wid & 3, fr = lane & 15, fq = lane >> 4;
    const int K = g.K, nt = K / BK;
    unsigned voffA[2], voffB[2];
#pragma unroll
    for (int i = 0; i < 2; ++i) { int R, C; stage_rc(tid * 16 + i * 8192, R, C); const int Rb = Epi::PERM ? ((R & ~31) + perm32(R & 31)) : R;
        voffA[i] = (unsigned)(R * K + C) * 2u; voffB[i] = (unsigned)(Rb * K + C) * 2u; }
    static_assert(!Sched::GATHER || SP2, "A-row gather is implemented for the SP2 loop");
    unsigned aoc[2][2], aon[2][2];
#define PG8_GOFF(dst, u) do { _Pragma("unroll") for (int _i = 0; _i < 2; ++_i) { int R_, C_; stage_rc(tid * 16 + _i * 8192, R_, C_); _Pragma("unroll") for (int _h = 0; _h < 2; ++_h) dst[_h][_i] = S.a_off(u, _h * HALF + R_) + (unsigned)(C_ * 2); } } while (0)
#define PG8_STAGE_A(bufoff, gbase, kofs, h, nx) do { if constexpr (Sched::GATHER) { const unsigned vo_[2] = {(nx) ? aon[h][0] : aoc[h][0], (nx) ? aon[h][1] : aoc[h][1]}; PG8_STAGE(bufoff, (const char*)g.A + (kofs), vo_); } else { PG8_STAGE(bufoff, gbase, voffA); } } while (0)
    const size_t kstep = (size_t)(BK * 2);
    const size_t hstep = (size_t)HALF * K * 2;
    const size_t tstep = 2 * hstep;
    const unsigned ldsw = (unsigned)wid * 1024u;
    const int aoff = lds_byte(wr * 64 + fr, fq * 8), boff = lds_byte(wc * 32 + fr, fq * 8);
#define PG8_SA(b, h) (((b) * 2 + (h)) * HTB)
#define PG8_SB(b, h) ((4 + (b) * 2 + (h)) * HTB)
#define PG8_STAGE(bufoff, gbase, voff) do { _Pragma("unroll") for (int _i = 0; _i < 2; ++_i) { unsigned o_ = (voff)[_i]; asm volatile("" : "+v"(o_));     \
        __builtin_amdgcn_global_load_lds((const unsigned*)((const char*)(gbase) + o_), (PG8_LAS unsigned*)(lds + (bufoff) + ldsw + _i * 8192), 16, 0, 0); } } while (0)
#define PG8_LDA(dst, b, h) do { _Pragma("unroll") for (int m = 0; m < 4; ++m) _Pragma("unroll") for (int k = 0; k < 2; ++k) dst[m][k] = *(const PG8_LAS bf16x8*)(lds + PG8_SA(b, h) + aoff + m * 2048 + k * 1024); } while (0)
#define PG8_LDB(dst, b, h) do { _Pragma("unroll") for (int n = 0; n < 2; ++n) _Pragma("unroll") for (int k = 0; k < 2; ++k) dst[n][k] = *(const PG8_LAS bf16x8*)(lds + PG8_SB(b, h) + boff + n * 2048 + k * 1024); } while (0)
#define PG8_MMA(ai, bj, At, Bt) do { __builtin_amdgcn_s_setprio(1); _Pragma("unroll") for (int m = 0; m < 4; ++m) _Pragma("unroll") for (int n = 0; n < 2; ++n) _Pragma("unroll") for (int k = 0; k < 2; ++k) \
        { if constexpr (MT == 0) acc[ai][bj][m][n] = __builtin_amdgcn_mfma_f32_16x16x32_bf16(Bt[n][k], At[m][k], acc[ai][bj][m][n], 0, 0, 0); \
          else if constexpr (MT == 1) acc[ai][bj][m][n] = __builtin_bit_cast(f32x4, __builtin_amdgcn_mfma_i32_16x16x64_i8(__builtin_bit_cast(i32x4, Bt[n][k]), __builtin_bit_cast(i32x4, At[m][k]), __builtin_bit_cast(i32x4, acc[ai][bj][m][n]), 0, 0, 0)); \
          else { if (k == 0) { const i32x8 b8_ = __builtin_shufflevector(__builtin_bit_cast(i32x4, Bt[n][0]), __builtin_bit_cast(i32x4, Bt[n][1]), 0, 1, 2, 3, 4, 5, 6, 7), a8_ = __builtin_shufflevector(__builtin_bit_cast(i32x4, At[m][0]), __builtin_bit_cast(i32x4, At[m][1]), 0, 1, 2, 3, 4, 5, 6, 7); \
              asm volatile("v_mfma_f32_16x16x128_f8f6f4 %0, %1, %2, %0" : "+v"(acc[ai][bj][m][n]) : "v"(b8_), "v"(a8_)); } } }     \
        __builtin_amdgcn_s_setprio(0); } while (0)
#define PG8_WAIT_V(n) asm volatile("s_waitcnt vmcnt(" #n ")" ::: "memory")
#define PG8_WAIT_L(n) asm volatile("s_waitcnt lgkmcnt(" #n ")" ::: "memory")
#define PG8_BAR __builtin_amdgcn_s_barrier()
#define PG8_SCHED __builtin_amdgcn_sched_barrier(0)
    Unit cur, nxt; int ui = 0;
    if (!S.next(0, cur)) return;
    f32x4 acc[2][2][4][2];
#pragma unroll
    for (int a = 0; a < 2; ++a)
#pragma unroll
        for (int b = 0; b < 2; ++b)
#pragma unroll
            for (int m = 0; m < 4; ++m)
#pragma unroll
                for (int n = 0; n < 2; ++n) acc[a][b][m][n] = (f32x4){0.f, 0.f, 0.f, 0.f};
    bf16x8 At[4][2], B0[2][2], B1[2][2];
    const char* cA = (const char*)g.A + (size_t)cur.pm * tstep; const char* cB = (const char*)g.Bt + (size_t)cur.pn * tstep;
    S.a_ready(cur);
    if constexpr (SP2) {
        if constexpr (Sched::GATHER) { PG8_GOFF(aoc, cur); }
        PG8_STAGE(PG8_SB(0, 0), cB, voffB); PG8_STAGE(PG8_SB(0, 1), cB + hstep, voffB); PG8_STAGE_A(PG8_SA(0, 0), cA, (size_t)0, 0, false); PG8_STAGE_A(PG8_SA(0, 1), cA + hstep, (size_t)0, 1, false);
        if (wr == 1) PG8_BAR;
        PG8_WAIT_V(2); PG8_BAR;
        PG8_STAGE(PG8_SB(1, 0), cB + kstep, voffB); PG8_STAGE_A(PG8_SA(1, 0), cA + kstep, kstep, 0, false); PG8_STAGE(PG8_SB(1, 1), cB + hstep + kstep, voffB);
        PG8_WAIT_V(6); PG8_BAR;
    } else {
        PG8_STAGE(PG8_SB(0, 0), cB, voffB); PG8_STAGE(PG8_SA(0, 0), cA, voffA); PG8_STAGE(PG8_SB(0, 1), cB + hstep, voffB); PG8_STAGE(PG8_SA(0, 1), cA + hstep, voffA);
        if (wr == 1) PG8_BAR;
        PG8_WAIT_V(4); PG8_BAR;
        PG8_STAGE(PG8_SB(1, 0), cB + kstep, voffB); PG8_STAGE(PG8_SA(1, 0), cA + kstep, voffA); PG8_STAGE(PG8_SB(1, 1), cB + hstep + kstep, voffB);
        PG8_WAIT_V(6); PG8_BAR;
    }
    for (;;) {
        const bool has_next = S.next(ui + 1, nxt);
        const char* nA = has_next ? (const char*)g.A + (size_t)nxt.pm * tstep : cA; const char* nB = has_next ? (const char*)g.Bt + (size_t)nxt.pn * tstep : cB;
        for (int t = 0; t < nt; t += 2) {
            const bool last = (t == nt - 2);
            const char* a1 = cA + (size_t)(t + 1) * kstep;
            const char* a2 = last ? nA : cA + (size_t)(t + 2) * kstep; const char* b2 = last ? nB : cB + (size_t)(t + 2) * kstep;
            const char* a3 = a2 + kstep; const char* b3 = b2 + kstep;
            if (last && has_next) S.a_ready(nxt);
            const size_t ko2 = last ? (size_t)0 : (size_t)(t + 2) * kstep;
            if constexpr (Sched::GATHER) { if (last) { if (has_next) { PG8_GOFF(aon, nxt); } else { _Pragma("unroll") for (int _h = 0; _h < 2; ++_h) { aon[_h][0] = aoc[_h][0]; aon[_h][1] = aoc[_h][1]; } } } }
            if constexpr (SP2) {
            PG8_LDB(B0, 0, 0); PG8_LDB(B1, 0, 1); PG8_SCHED; PG8_LDA(At, 0, 0); PG8_STAGE_A(PG8_SA(1, 1), a1 + hstep, (size_t)(t + 1) * kstep, 1, false);
            PG8_WAIT_V(8); PG8_WAIT_L(0); PG8_BAR; PG8_MMA(0, 0, At, B0); PG8_MMA(0, 1, At, B1); PG8_BAR; PG8_SCHED;
            PG8_LDA(At, 0, 1); PG8_STAGE(PG8_SB(0, 0), b2, voffB); PG8_STAGE(PG8_SB(0, 1), b2 + hstep, voffB); PG8_STAGE_A(PG8_SA(0, 0), a2, ko2, 0, last);
            PG8_WAIT_V(8); PG8_WAIT_L(0); PG8_BAR; PG8_MMA(1, 0, At, B0); PG8_MMA(1, 1, At, B1); PG8_BAR; PG8_SCHED;
            PG8_LDB(B0, 1, 0); PG8_LDB(B1, 1, 1); PG8_SCHED; PG8_LDA(At, 1, 0); PG8_STAGE_A(PG8_SA(0, 1), a2 + hstep, ko2, 1, last);
            PG8_WAIT_V(8); PG8_WAIT_L(0); PG8_BAR; PG8_MMA(0, 0, At, B0); PG8_MMA(0, 1, At, B1); PG8_BAR; PG8_SCHED;
            PG8_LDA(At, 1, 1); PG8_STAGE(PG8_SB(1, 0), b3, voffB); PG8_STAGE(PG8_SB(1, 1), b3 + hstep, voffB); PG8_STAGE_A(PG8_SA(1, 0), a3, ko2 + kstep, 0, last);
            PG8_WAIT_V(8); PG8_WAIT_L(0); PG8_BAR; PG8_MMA(1, 0, At, B0); PG8_MMA(1, 1, At, B1); PG8_BAR; PG8_SCHED;
            } else {
            PG8_LDB(B0, 0, 0); PG8_SCHED; PG8_LDA(At, 0, 0); PG8_STAGE(PG8_SA(1, 1), a1 + hstep, voffA);
            PG8_WAIT_L(8); PG8_BAR; PG8_WAIT_L(0); PG8_MMA(0, 0, At, B0); PG8_BAR; PG8_SCHED;
            PG8_LDB(B1, 0, 1); PG8_STAGE(PG8_SB(0, 0), b2, voffB);
            PG8_BAR; PG8_WAIT_L(0); PG8_MMA(0, 1, At, B1); PG8_BAR;
            PG8_LDA(At, 0, 1); PG8_STAGE(PG8_SA(0, 0), a2, voffA);
            PG8_BAR; PG8_WAIT_L(0); PG8_MMA(1, 0, At, B0); PG8_BAR; PG8_SCHED;
            PG8_STAGE(PG8_SB(0, 1), b2 + hstep, voffB);
            PG8_WAIT_V(6); PG8_BAR; PG8_MMA(1, 1, At, B1); PG8_BAR;
            PG8_LDB(B0, 1, 0); PG8_SCHED; PG8_LDA(At, 1, 0); PG8_STAGE(PG8_SA(0, 1), a2 + hstep, voffA);
            PG8_WAIT_L(8); PG8_BAR; PG8_WAIT_L(0); PG8_MMA(0, 0, At, B0); PG8_BAR; PG8_SCHED;
            PG8_LDB(B1, 1, 1); PG8_STAGE(PG8_SB(1, 0), b3, voffB);
            PG8_BAR; PG8_WAIT_L(0); PG8_MMA(0, 1, At, B1); PG8_BAR;
            PG8_LDA(At, 1, 1); PG8_STAGE(PG8_SA(1, 0), a3, voffA);
            PG8_BAR; PG8_WAIT_L(0); PG8_MMA(1, 0, At, B0); PG8_BAR; PG8_SCHED;
            PG8_STAGE(PG8_SB(1, 1), b3 + hstep, voffB);
            PG8_WAIT_V(6); PG8_BAR; PG8_MMA(1, 1, At, B1); PG8_BAR;
            }
        }
        if constexpr (MT == 2) { asm volatile("s_nop 15\n\ts_nop 15" ::: "memory"); }
        if constexpr (ALIGN_EPI) { if (wr == 0) PG8_BAR; }
        if constexpr (!Epi::AFTER_DRAIN) { E(acc, cur, wr, wc, fr, fq); S.done(cur); }
        if (!has_next) break;
#pragma unroll
        for (int a = 0; a < 2; ++a)
#pragma unroll
            for (int b = 0; b < 2; ++b)
#pragma unroll
                for (int m = 0; m < 4; ++m)
#pragma unroll
                    for (int n = 0; n < 2; ++n) acc[a][b][m][n] = (f32x4){0.f, 0.f, 0.f, 0.f};
        cur = nxt; cA = nA; cB = nB; ++ui;
        if constexpr (Sched::GATHER) { _Pragma("unroll") for (int _h = 0; _h < 2; ++_h) { aoc[_h][0] = aon[_h][0]; aoc[_h][1] = aon[_h][1]; } }
        if constexpr (ALIGN_EPI) { if (wr == 1) PG8_BAR; }
    }
    PG8_WAIT_V(0);
    if constexpr (!ALIGN_EPI) { if (wr == 0) PG8_BAR; }
    PG8_BAR;
    if constexpr (Epi::AFTER_DRAIN) { E.fused(acc, cur, wr, wc, fr, fq, lds, wid, lane); S.done(cur); }
#undef PG8_SA
#undef PG8_SB
#undef PG8_STAGE
#undef PG8_STAGE_A
#undef PG8_GOFF
#undef PG8_LDA
#undef PG8_LDB
#undef PG8_MMA
#undef PG8_WAIT_V
#undef PG8_WAIT_L
#undef PG8_BAR
#undef PG8_SCHED
}
}
constexpr int NWAVES = 8;
constexpr int TOK = 16384, SEQ = 4096, D = 1024, NP = 4096, INC = 3888, DEPTH = 4;
constexpr int HG_Q = 0, HG_F = 256, HG_I = 512, HG_G = 768;
constexpr int GL_Q = 1024, GL_K = 1152, GL_V = 1280, GL_GLR = 1536, GL_R = 1552;
constexpr int RW_BASE = 1808, RW_R = 1808, RW_K = 2064, RW_V = 2320, RW_WLR = 2576, RW_ALR = 2640, RW_GLR = 2704;
constexpr int RT_Q = 2864, RT_K = 3120, RT_V = 3376, RT_G = 3632;
constexpr int GL_GX = 3904;
constexpr int FFD = 2816, FFE = 1408, NE = 8, FFEP = 1536;
constexpr float DN_ALPHA = 1.6817928305074290f;
constexpr int NPH = 12;
constexpr int NPHASES = NPH * DEPTH;
constexpr size_t MiB = 1u << 20;
constexpr size_t WS_CTL = 0, CTL_ZERO_BYTES = 1 * MiB;
constexpr size_t WS_LIST = 1 * MiB;
constexpr size_t WS_GATE = 2 * MiB;
constexpr size_t WS_TAB = 3 * MiB;
constexpr size_t WS_WIN = 4 * MiB, WS_WOUT = 12 * MiB, WS_WUP = 14 * MiB, WS_WDN = 58 * MiB;
constexpr size_t WS_HB = 80 * MiB;
constexpr size_t WS_MIX = 112 * MiB;
constexpr size_t WS_O = WS_MIX;
constexpr size_t WS_OI = 144 * MiB;
constexpr size_t OI_GEN = 64 * 4096 * 16;
constexpr size_t WS_VF = 176 * MiB;
constexpr size_t WS_P = 184 * MiB;
constexpr size_t WS_RWW = 312 * MiB;
constexpr size_t WS_RWR = 328 * MiB, WS_RWK = 336 * MiB, WS_RWV = 344 * MiB, WS_RWKK = 352 * MiB, WS_RWB = 360 * MiB, WS_RWG = 368 * MiB;
constexpr size_t WS_Y = 376 * MiB;
constexpr size_t WS_CS = 461 * MiB;
constexpr size_t WS_HID = 184 * MiB;
constexpr size_t WS_DOUT = 280 * MiB;
constexpr size_t WS_HPERM = 344 * MiB;
constexpr size_t WS_H8 = 344 * MiB;
constexpr size_t WS_RS = 360 * MiB;
constexpr size_t WS_WOUT2 = 465 * MiB;
constexpr size_t WS_END = 467 * MiB;
constexpr int CW_BAR = 4096;
constexpr int CW_CNT = 16384;
constexpr int CW_AMAX = 20480;
constexpr int CW_AMAXD = 24576;
constexpr int TAB_STRIDE = 4 * 160 + 16;
constexpr size_t WS_LORA = 2 * MiB + 512 * 1024;
constexpr int LO_W2 = 0, LO_A2 = 256 * 64, LO_G2 = 2 * 256 * 64, LO_V1 = LO_G2 + 256 * 160, LO_V2 = LO_V1 + 32 * 256, LO_END = LO_V2 + 256 * 32;
constexpr int RING_BYTES = 131072, LDSCTL_OFF = 146432, MISC_OFF = LDSCTL_OFF + 320, LDS_BYTES = 147456;
#define GAS __attribute__((address_space(1)))
#define LAS __attribute__((address_space(3)))
typedef unsigned short bf16;
typedef unsigned v4u __attribute__((ext_vector_type(4)));
typedef unsigned v2u __attribute__((ext_vector_type(2)));
typedef float f32x4 __attribute__((ext_vector_type(4)));
typedef short bf16x8 __attribute__((ext_vector_type(8)));
typedef GAS unsigned gu32;
#define RLX_AGENT __ATOMIC_RELAXED, __HIP_MEMORY_SCOPE_AGENT
#define LDS_WAIT() asm volatile("s_waitcnt lgkmcnt(0)" ::: "memory")
#define VM_WAIT() asm volatile("s_waitcnt vmcnt(0)" ::: "memory")
#define LDS_BARRIER() do { asm volatile("s_waitcnt lgkmcnt(0)" ::: "memory"); __builtin_amdgcn_s_barrier(); asm volatile("" ::: "memory"); } while (0)
typedef float f32x2_t __attribute__((ext_vector_type(2))); typedef __bf16 bf16x2_t __attribute__((ext_vector_type(2)));
__device__ __forceinline__ unsigned pk2(float lo, float hi) { f32x2_t v = {lo, hi}; bf16x2_t b = __builtin_convertvector(v, bf16x2_t); return __builtin_bit_cast(unsigned, b); }
__device__ __forceinline__ unsigned f2bf(float f) { return pk2(f, f) & 0xffffu; }
__device__ __forceinline__ float bflo(unsigned w) { return __builtin_bit_cast(float, w << 16); }
__device__ __forceinline__ float bfhi(unsigned w) { return __builtin_bit_cast(float, w & 0xffff0000u); }
__device__ __forceinline__ float bf1(bf16 b) { return __builtin_bit_cast(float, ((unsigned)b) << 16); }
__device__ __forceinline__ void unpack8(const v4u w, float (&f)[8]) { f[0] = bflo(w.x); f[1] = bfhi(w.x); f[2] = bflo(w.y); f[3] = bfhi(w.y); f[4] = bflo(w.z); f[5] = bfhi(w.z); f[6] = bflo(w.w); f[7] = bfhi(w.w); }
__device__ __forceinline__ v4u pack8(const float (&f)[8]) { v4u w; w.x = pk2(f[0], f[1]); w.y = pk2(f[2], f[3]); w.z = pk2(f[4], f[5]); w.w = pk2(f[6], f[7]); return w; }
__device__ __forceinline__ float sigm(float x) { return __builtin_amdgcn_rcpf(1.0f + __expf(-x)); }
template <int CTRL> __device__ __forceinline__ float dpp(float x) { return __builtin_bit_cast(float, __builtin_amdgcn_mov_dpp(__builtin_bit_cast(int, x), CTRL, 0xf, 0xf, true)); }
__device__ __forceinline__ float sum16(float x) { x += dpp<0xB1>(x); x += dpp<0x4E>(x); x += dpp<0x141>(x); x += dpp<0x128>(x); return x; }
__device__ __forceinline__ float sum4(float x) { x += dpp<0xB1>(x); x += dpp<0x4E>(x); return x; }
__device__ __forceinline__ float wave_sum(float x) {
    x = sum16(x);
    auto s = __builtin_amdgcn_permlane16_swap(__float_as_uint(x), __float_as_uint(x), false, false); x = __uint_as_float(s[0]) + __uint_as_float(s[1]);
    auto t = __builtin_amdgcn_permlane32_swap(__float_as_uint(x), __float_as_uint(x), false, false); return __uint_as_float(t[0]) + __uint_as_float(t[1]);
}
__device__ __forceinline__ float wave_max(float x) {
    x = fmaxf(x, dpp<0xB1>(x)); x = fmaxf(x, dpp<0x4E>(x)); x = fmaxf(x, dpp<0x141>(x)); x = fmaxf(x, dpp<0x128>(x));
    auto s = __builtin_amdgcn_permlane16_swap(__float_as_uint(x), __float_as_uint(x), false, false); x = fmaxf(__uint_as_float(s[0]), __uint_as_float(s[1]));
    auto t = __builtin_amdgcn_permlane32_swap(__float_as_uint(x), __float_as_uint(x), false, false); return fmaxf(__uint_as_float(t[0]), __uint_as_float(t[1]));
}
__device__ __forceinline__ unsigned pack_i8(float a, float b, float c, float d) {
    const int ia = (int)__builtin_rintf(a), ib = (int)__builtin_rintf(b), ic = (int)__builtin_rintf(c), id = (int)__builtin_rintf(d);
    return ((unsigned)ia & 255u) | (((unsigned)ib & 255u) << 8) | (((unsigned)ic & 255u) << 16) | ((unsigned)id << 24);
}
__device__ const double INVF2PI[32] = {0.15915494309189535, 0.11934937021124886, 0.08949940160889101, 0.06711508300522726, 0.050329212104487035, 0.03774158471741977, 0.0283021958306234, 0.02122365276477766, 0.015915494309189534, 0.011934937021124886, 0.008949940160889102, 0.006711508300522725, 0.005032921210448704, 0.003774158471741977, 0.00283021958306234, 0.0021223652764777662, 0.0015915494309189536, 0.0011934937021124885, 0.0008949940160889102, 0.0006711508300522726, 0.0005032921210448703, 0.00037741584717419774, 0.00028302195830623395, 0.0002122365276477766, 0.00015915494309189535, 0.00011934937021124886, 8.949940160889102e-05, 6.711508300522725e-05, 5.0329212104487035e-05, 3.774158471741978e-05, 2.8302195830623396e-05, 2.122365276477766e-05};
#define XB_TMO      128
#define XB_XCNT(j)  (256  + 64 * (j))
#define XB_XSUB(j)  (1280 + 64 * (j))
#define XB_XGEN(j)  (2304 + 64 * (j))
#define XB_TOP      3328
#define XB_TOPGEN   3392
#define XCD_BAR_WORDS 3456
#define XB_SPIN_CAP (1u << 18)

__device__ __forceinline__ unsigned xb_ld(unsigned* p)              { return __hip_atomic_load(p, __ATOMIC_RELAXED, __HIP_MEMORY_SCOPE_AGENT); }
__device__ __forceinline__ unsigned xb_add(unsigned* p, unsigned v) { return __hip_atomic_fetch_add(p, v, __ATOMIC_RELAXED, __HIP_MEMORY_SCOPE_AGENT); }
__device__ __forceinline__ unsigned xb_xcc_id() { return (unsigned)__builtin_amdgcn_s_getreg((3 << 11) | 20) & 0xFu; }
#define XB_SPIN(cond, bar) do { unsigned _sp = 0; while (cond) { __builtin_amdgcn_s_sleep(1); \
    if ((++_sp & 255u) == 0u) { if (xb_ld(&(bar)[XB_TMO])) break; if (_sp > XB_SPIN_CAP) { atomicAdd(&(bar)[XB_TMO], 1u); break; } } } } while (0)

struct XcdBarrier {
    unsigned* bar; unsigned x;
    volatile LAS unsigned* st;
    int wv;
};

__device__ __forceinline__ XcdBarrier xcd_barrier_post(unsigned* bar, volatile LAS unsigned* st) {
    XcdBarrier b; b.bar = bar; b.x = xb_xcc_id(); b.st = st; b.wv = __builtin_amdgcn_readfirstlane((int)threadIdx.x >> 6);
    if (threadIdx.x == 0) (void)xb_add(&bar[XB_XCNT(b.x)], 1u);
    return b;
}
__device__ __forceinline__ void xcd_barrier_complete(unsigned* bar, unsigned x, unsigned& nloc, unsigned& nx) {
    const unsigned G = gridDim.x * gridDim.y * gridDim.z;
    unsigned sum, cnt, mine, sp = 0u;
    for (;;) {
        sum = 0u; cnt = 0u; mine = 0u;
#pragma unroll 1
        for (unsigned j = 0; j < 16; ++j) { const unsigned c = xb_ld(&bar[XB_XCNT(j)]); sum += c; cnt += (c > 0u) ? 1u : 0u; mine = (j == x) ? c : mine; }
        if (sum == G) break;
        __builtin_amdgcn_s_sleep(1);
        if ((++sp & 255u) == 0u) { if (xb_ld(&bar[XB_TMO])) break; if (sp > XB_SPIN_CAP) { atomicAdd(&bar[XB_TMO], 1u); break; } }
    }
    nloc = mine > 0u ? mine : 1u; nx = cnt > 0u ? cnt : 1u;
}

__device__ __forceinline__ void xcd_barrier(const XcdBarrier& b) {
    asm volatile("s_waitcnt vmcnt(0)" ::: "memory");
    __syncthreads();
    if (b.wv == 0 && lane_id_now() == 0) {
        unsigned* bar = b.bar;
        __builtin_amdgcn_s_waitcnt(0);
        unsigned nloc = b.st[0], nx = b.st[1];
        if (nloc == 0u) { xcd_barrier_complete(bar, b.x, nloc, nx); b.st[0] = nloc; b.st[1] = nx; }
        const unsigned old = xb_add(&bar[XB_XSUB(b.x)], 1u);
        const unsigned gen = old / nloc;
        if (old + 1u == (gen + 1u) * nloc) {
            __builtin_amdgcn_fence(__ATOMIC_RELEASE, "agent");
            asm volatile("s_waitcnt vmcnt(0)" ::: "memory");
            const unsigned og = xb_add(&bar[XB_TOP], 1u);
            const unsigned tg = og / nx;
            if (og + 1u == (tg + 1u) * nx) xb_add(&bar[XB_TOPGEN], 1u);
            else XB_SPIN(xb_ld(&bar[XB_TOPGEN]) == tg, bar);
            __builtin_amdgcn_fence(__ATOMIC_ACQUIRE, "agent");
            xb_add(&bar[XB_XGEN(b.x)], 1u);
            asm volatile("s_waitcnt vmcnt(0)" ::: "memory");
        } else {
            XB_SPIN(xb_ld(&bar[XB_XGEN(b.x)]) == gen, bar);
            __builtin_amdgcn_fence(__ATOMIC_ACQUIRE, "agent");
            asm volatile("s_waitcnt vmcnt(0)" ::: "memory");
        }
    }
    __syncthreads();
}
struct Frame {
    LAS unsigned char* lds;
    volatile LAS unsigned* MISC;
    gu32* ctl;
    int tid, lane, wave;
    int vcu, G;
    unsigned char* ws;
    const void* const* in;
    float* h;
};
__device__ __forceinline__ const void* ldptr(const void* const* tab, int k) { int z; asm volatile("s_mov_b32 %0, 0" : "=s"(z)); return tab[k + z]; }
#define INF(k) ((const float*)ldptr(F.in, k))
#define WSP(T, off) ((T*)(F.ws + (off)))

__device__ __forceinline__ void xpose_item(const float* W, int ldw, int nvalid, int k0, int n0, bf16* WT, int ldt, int drow0, LAS float* scr, int lane) {
    { float t_[32]; const int n = n0 + (lane & 31);
#pragma unroll
      for (int i = 0; i < 32; ++i) { const int kk = 2 * i + (lane >> 5); t_[i] = (n < nvalid) ? W[(size_t)(k0 + kk) * ldw + n] : 0.f; }
#pragma unroll
      for (int i = 0; i < 32; ++i) { const int kk = 2 * i + (lane >> 5); scr[kk * 33 + (lane & 31)] = t_[i]; } }
    LDS_WAIT(); asm volatile("" ::: "memory");
    const int c = lane & 7;
#pragma unroll
    for (int j = 0; j < 4; ++j) { const int n = (lane >> 3) + 8 * j; const LAS float* s = scr + (8 * c) * 33 + n;
        v4u o; o.x = pk2(s[0 * 33], s[1 * 33]); o.y = pk2(s[2 * 33], s[3 * 33]); o.z = pk2(s[4 * 33], s[5 * 33]); o.w = pk2(s[6 * 33], s[7 * 33]);
        *(GAS v4u*)(WT + (size_t)(drow0 + n) * ldt + k0 + 8 * c) = o; }
    LDS_WAIT(); asm volatile("" ::: "memory");
}
__device__ __forceinline__ void xpose_item8(const float* W, int ldw, int k0, int n0, unsigned char* WT, int ldt, int drow0, float qs, LAS float* scr, int lane) {
    { float t_[32]; const int n = n0 + (lane & 31);
#pragma unroll
      for (int i = 0; i < 32; ++i) { const int kk = 2 * i + (lane >> 5); t_[i] = W[(size_t)(k0 + kk) * ldw + n]; }
#pragma unroll
      for (int i = 0; i < 32; ++i) { const int kk = 2 * i + (lane >> 5); scr[kk * 33 + (lane & 31)] = t_[i]; } }
    LDS_WAIT(); asm volatile("" ::: "memory");
    const int c = lane & 7;
#pragma unroll
    for (int j = 0; j < 4; ++j) { const int n = (lane >> 3) + 8 * j; const LAS float* s = scr + (8 * c) * 33 + n;
        v2u o; o.x = pack_i8(s[0 * 33] * qs, s[1 * 33] * qs, s[2 * 33] * qs, s[3 * 33] * qs); o.y = pack_i8(s[4 * 33] * qs, s[5 * 33] * qs, s[6 * 33] * qs, s[7 * 33] * qs);
        *(GAS v2u*)(WT + (size_t)(drow0 + n) * ldt + k0 + 8 * c) = o; }
    LDS_WAIT(); asm volatile("" ::: "memory");
}
__device__ __forceinline__ void f8_scale(float am, float& s, float& inv) {
    const int e = (int)((__float_as_uint(am) >> 23) & 255u) - 127;
    if (am > 0.f && e > -100 && e < 100) { s = __uint_as_float((unsigned)(127 + 7 - e) << 23); inv = __uint_as_float((unsigned)(127 + e - 7) << 23); } else { s = 1.f; inv = 1.f; }
}
__device__ __forceinline__ unsigned pack_f8(float a, float b, float c, float d) {
    unsigned w = 0u; w = __builtin_amdgcn_cvt_pk_fp8_f32(a, b, w, false); w = __builtin_amdgcn_cvt_pk_fp8_f32(c, d, w, true); return w;
}
__device__ __forceinline__ void xpose_item_f8(const float* W, int ldw, int kvalid, int k0, int n0, unsigned char* WT, int ldt, int drow0, float qs, LAS float* scr, int lane) {
    const int c = lane & 7;
    if (k0 >= kvalid) {
#pragma unroll
        for (int j = 0; j < 4; ++j) { const int n = (lane >> 3) + 8 * j; v2u o; o.x = 0u; o.y = 0u; *(GAS v2u*)(WT + (size_t)(drow0 + n) * ldt + k0 + 8 * c) = o; }
        return; }
    { float t_[32]; const int n = n0 + (lane & 31);
#pragma unroll
      for (int i = 0; i < 32; ++i) { const int kk = 2 * i + (lane >> 5); t_[i] = W[(size_t)(k0 + kk) * ldw + n]; }
#pragma unroll
      for (int i = 0; i < 32; ++i) { const int kk = 2 * i + (lane >> 5); scr[kk * 33 + (lane & 31)] = t_[i]; } }
    LDS_WAIT(); asm volatile("" ::: "memory");
#pragma unroll
    for (int j = 0; j < 4; ++j) { const int n = (lane >> 3) + 8 * j; const LAS float* s = scr + (8 * c) * 33 + n;
        v2u o; o.x = pack_f8(s[0 * 33] * qs, s[1 * 33] * qs, s[2 * 33] * qs, s[3 * 33] * qs); o.y = pack_f8(s[4 * 33] * qs, s[5 * 33] * qs, s[6 * 33] * qs, s[7 * 33] * qs);
        *(GAS v2u*)(WT + (size_t)(drow0 + n) * ldt + k0 + 8 * c) = o; }
    LDS_WAIT(); asm volatile("" ::: "memory");
}
__device__ __forceinline__ int gu_row(int n) { return 256 * (n >> 7) + (n & 127); }
template <int PART> __device__ __forceinline__ void phase_weights(Frame& F, int l) {
    LAS float* scr = (LAS float*)(F.lds + F.wave * 16384);
    const int gw = F.vcu * NWAVES + F.wave, NGW = F.G * NWAVES;
    const bool moe = (l & 1); const int fi = l >> 1;
    constexpr int I_IN = 16 * 128, I_OUT = 16 * 32;
    constexpr int I_DG = 16 * 88, I_DD = 44 * 32;
    constexpr int I_MG = 16 * 44, I_MD = 24 * 32;
    const int nitems = PART == 0 ? (I_IN + I_OUT) : (moe ? NE * (2 * I_MG + I_MD) : (2 * I_DG + I_DD));
    float qs8 = 0.f; if (PART == 1) { const float am = __uint_as_float(__hip_atomic_load((unsigned*)(F.ctl + CW_AMAX + l * 64), RLX_AGENT)); qs8 = am > 0.f ? 127.f / am : 0.f; }
    float qsd = 1.f; if (PART == 1) { float inv_; f8_scale(__uint_as_float(__hip_atomic_load((unsigned*)(F.ctl + CW_AMAXD + l * 64), RLX_AGENT)), qsd, inv_); }
    for (int it = gw; it < nitems; it += NGW) {
        int r = it + (PART == 0 ? 0 : I_IN + I_OUT);
        if (r < I_IN) { const int kb = r >> 7, nb = r & 127; if (nb < 122) xpose_item(INF(2) + (size_t)l * D * INC, INC, INC, 64 * kb, 32 * nb, WSP(bf16, WS_WIN), D, 32 * nb, scr, F.lane); continue; } r -= I_IN;
        if (r < I_OUT) { const int kb = r >> 5, nb = r & 31; xpose_item(INF(3) + (size_t)l * D * D, D, D, 64 * kb, 32 * nb, WSP(bf16, (l & 1) ? WS_WOUT2 : WS_WOUT), D, 32 * nb, scr, F.lane); continue; } r -= I_OUT;
        if (!moe) {
            if (r < 2 * I_DG) { const int up = r >= I_DG; if (up) r -= I_DG; const int kb = r / 88, nb = r % 88;
                xpose_item8(INF(up ? 28 : 27) + (size_t)fi * D * FFD, FFD, 64 * kb, 32 * nb, WSP(unsigned char, WS_WUP), D, gu_row(32 * nb) + (up ? 128 : 0), qs8, scr, F.lane); continue; } r -= 2 * I_DG;
            { const int kb = r >> 5, nb = r & 31; xpose_item_f8(INF(29) + (size_t)fi * FFD * D, D, FFD, 64 * kb, 32 * nb, WSP(unsigned char, WS_WDN), FFD, 32 * nb, qsd, scr, F.lane); }
        } else {
            const int per = 2 * I_MG + I_MD; const int e = r / per; r -= e * per;
            if (r < 2 * I_MG) { const int up = r >= I_MG; if (up) r -= I_MG; const int kb = r / 44, nb = r % 44;
                xpose_item8(INF(up ? 32 : 31) + (size_t)(fi * NE + e) * D * FFE, FFE, 64 * kb, 32 * nb, WSP(unsigned char, WS_WUP) + (size_t)e * 2 * FFE * D, D, gu_row(32 * nb) + (up ? 128 : 0), qs8, scr, F.lane); continue; } r -= 2 * I_MG;
            { const int kb = r >> 5, nb = r & 31; xpose_item_f8(INF(33) + (size_t)(fi * NE + e) * FFE * D, D, FFE, 64 * kb, 32 * nb, WSP(unsigned char, WS_WDN) + (size_t)e * D * FFEP, FFEP, 32 * nb, qsd, scr, F.lane); }
        }
    }
    if (PART == 0) {
        const int gt = F.vcu * NWAVES * 64 + F.tid; int NT = F.G * NWAVES * 64; asm volatile("" : "+s"(NT));     const float* win = INF(2) + (size_t)l * D * INC; const float* gw2 = INF(10) + l * 16 * 128; bf16* WT = WSP(bf16, WS_WIN);
        for (int e = gt; e < 128 * D; e += NT) { const int n = e >> 10, d = e & 1023; const float* wr = win + (size_t)d * INC + (GL_GLR - 0); float a = 0.f;
#pragma unroll
            for (int r = 0; r < 16; ++r) a += wr[r] * gw2[r * 128 + n];
            WT[(size_t)(GL_GX + n) * D + d] = (bf16)f2bf(a); }
        if (l == 0) {
            f32x2_t* CS = WSP(f32x2_t, WS_CS); const int* pos = (const int*)ldptr(F.in, 1);
            for (int e = gt; e < TOK * 32; e += NT) { const int t = e >> 5, i = e & 31; const double rev = (double)pos[t] * INVF2PI[i]; const float fr_ = (float)(rev - floor(rev));
                f32x2_t cs; cs.x = __builtin_amdgcn_cosf(fr_); cs.y = __builtin_amdgcn_sinf(fr_); CS[e] = cs; } }
    }
    if (PART == 0) {
        bf16* LO = WSP(bf16, WS_LORA); const int gt = F.vcu * NWAVES * 64 + F.tid; int NT = F.G * NWAVES * 64; asm volatile("" : "+s"(NT));
        const float* w2 = INF(15) + (size_t)l * 64 * 256; const float* a2 = INF(17) + (size_t)l * 64 * 256; const float* g2 = INF(18) + (size_t)l * 160 * 256;
        for (int e = gt; e < LO_END; e += NT) { float v;
            if (e < LO_A2) { const int n = e >> 6, k = e & 63; v = w2[k * 256 + n]; }
            else if (e < LO_G2) { const int q = e - LO_A2, n = q >> 6, k = q & 63; v = a2[k * 256 + n]; }
            else if (e < LO_V1) { const int q = e - LO_G2, n = q / 160, k = q - n * 160; v = g2[k * 256 + n]; }
            else if (e < LO_V2) { const int q = e - LO_V1, n = q >> 8, k = q & 255; v = (l > 0) ? (INF(25) + (size_t)(l - 1) * 256 * 32)[k * 32 + n] : 0.f; }
            else { const int q = e - LO_V2, n = q >> 5, k = q & 31; v = (l > 0) ? (INF(26) + (size_t)(l - 1) * 32 * 256)[k * 256 + n] : 0.f; }
            LO[e] = (bf16)f2bf(v); }
    }
    if (PART == 0 && l == 0) {
        const float* x = INF(0); bf16* hb = WSP(bf16, WS_HB);
        for (int m = gw; m < TOK; m += NGW) {
            const GAS f32x4* xr = (const GAS f32x4*)(x + (size_t)m * D) + F.lane; GAS f32x4* hr = (GAS f32x4*)(F.h + (size_t)m * D) + F.lane; GAS v2u* o8 = (GAS v2u*)(hb + (size_t)m * D) + F.lane;
#pragma unroll
            for (int j = 0; j < 4; ++j) { const f32x4 v = xr[64 * j]; v2u w; w.x = pk2(v.x, v.y); w.y = pk2(v.z, v.w); o8[64 * j] = w; }
        }
    }
}
__device__ __forceinline__ void phase_absmax(Frame& F, int l) {
    const bool moe = (l & 1); const int fi = l >> 1;
    const int n4 = (moe ? NE * D * FFE : D * FFD) / 4;
    const GAS f32x4* g = (const GAS f32x4*)INF(moe ? 31 : 27) + (size_t)fi * n4; const GAS f32x4* u = (const GAS f32x4*)INF(moe ? 32 : 28) + (size_t)fi * n4; const GAS f32x4* dn = (const GAS f32x4*)INF(moe ? 33 : 29) + (size_t)fi * n4;
    const int gt = F.vcu * NWAVES * 64 + F.tid; int NT = F.G * NWAVES * 64; asm volatile("" : "+s"(NT));
    f32x4 mx = (f32x4){0.f, 0.f, 0.f, 0.f}, md = mx;
    for (int i = gt; i < n4; i += 3 * NT) {
        f32x4 a[3], b[3], c[3];
#pragma unroll
        for (int j = 0; j < 3; ++j) { const int ij = (i + j * NT < n4) ? i + j * NT : i; a[j] = g[ij]; b[j] = u[ij]; c[j] = dn[ij]; }
#pragma unroll
        for (int j = 0; j < 3; ++j) { mx = __builtin_elementwise_max(mx, __builtin_elementwise_max(__builtin_elementwise_abs(a[j]), __builtin_elementwise_abs(b[j]))); md = __builtin_elementwise_max(md, __builtin_elementwise_abs(c[j])); }
    }
    const float m = wave_max(fmaxf(fmaxf(mx.x, mx.y), fmaxf(mx.z, mx.w))), m2 = wave_max(fmaxf(fmaxf(md.x, md.y), fmaxf(md.z, md.w)));
    if (F.lane == 0) { __hip_atomic_fetch_max((unsigned*)(F.ctl + CW_AMAX + l * 64), __float_as_uint(m), RLX_AGENT); __hip_atomic_fetch_max((unsigned*)(F.ctl + CW_AMAXD + l * 64), __float_as_uint(m2), RLX_AGENT); }
}
template <int NKS> __device__ __forceinline__ void rw_mm16(f32x4 (&acc)[2][4], const LAS bf16* X, int ldx, int mb0, const bf16* BT, int hh, int lane) {
    const int fr = lane & 15, fq = lane >> 4; constexpr int K = 32 * NKS;
    bf16x8 bfr[NKS][4];
#pragma unroll
    for (int ks = 0; ks < NKS; ++ks)
#pragma unroll
        for (int nb = 0; nb < 4; ++nb) bfr[ks][nb] = *(const GAS bf16x8*)(BT + (size_t)(64 * hh + 16 * nb + fr) * K + 32 * ks + 8 * fq);
#pragma unroll
    for (int ks = 0; ks < NKS; ++ks)
#pragma unroll
        for (int mi = 0; mi < 2; ++mi) { const bf16x8 a = *(const LAS bf16x8*)(X + (16 * (mb0 + mi) + fr) * ldx + 32 * ks + 8 * fq);
#pragma unroll
            for (int nb = 0; nb < 4; ++nb) acc[mi][nb] = __builtin_amdgcn_mfma_f32_16x16x32_bf16(a, bfr[ks][nb], acc[mi][nb], 0, 0, 0); }
}
__device__ __forceinline__ void rwprep_tile(Frame& F, int l, int tile) {
    const bf16* P = WSP(const bf16, WS_P);
    const float* mu = INF(13) + l * 1056;
    LAS bf16* X1 = (LAS bf16*)F.lds; LAS bf16* X2 = X1 + 64 * 72; LAS bf16* X3 = X2 + 64 * 72; LAS bf16* XV = X3 + 64 * 168; LAS bf16* X5 = XV + 64 * 264; LAS bf16* XK = X5 + 64 * 40;
    float* RWW = WSP(float, WS_RWW); bf16* RWR = WSP(bf16, WS_RWR); bf16* RWK = WSP(bf16, WS_RWK); bf16* RWV = WSP(bf16, WS_RWV);
    bf16* RWKK = WSP(bf16, WS_RWKK); bf16* RWB = WSP(bf16, WS_RWB); bf16* RWG = WSP(bf16, WS_RWG); bf16* VF = WSP(bf16, WS_VF);
    const bf16* LORA = WSP(const bf16, WS_LORA);
    int tid_ = F.tid; asm volatile("" : "+v"(tid_));
    const int lane_ = tid_ & 63, wave_ = __builtin_amdgcn_readfirstlane(tid_ >> 6);
    const int fr = lane_ & 15, fq = lane_ >> 4, hh = wave_ & 3, mb0 = 2 * (wave_ >> 2);
    const int t0 = tile * 64;
#pragma unroll
    for (int half = 0; half < 2; ++half) {
        v4u rc[9], rp[9];
#pragma unroll
        for (int i = 0; i < 9; ++i) { const int g = tid_ + (half * 9 + i) * 512; rc[i] = (v4u){0u, 0u, 0u, 0u}; rp[i] = rc[i];
            if (g < 64 * 132) { const int tt = g / 132, cg = g - tt * 132, t = t0 + tt; const int col = RW_BASE + 8 * (cg < 36 ? 96 + cg : cg < 68 ? cg - 36 : cg < 100 ? 64 + (cg - 68) : 32 + (cg - 100));
                rc[i] = *(const GAS v4u*)(P + (size_t)t * NP + col); if ((t & (SEQ - 1)) != 0) rp[i] = *(const GAS v4u*)(P + (size_t)(t - 1) * NP + col); } }
#pragma unroll
        for (int i = 0; i < 9; ++i) { const int g = tid_ + (half * 9 + i) * 512;
            if (g < 64 * 132) { const int tt = g / 132, cg = g - tt * 132, t = t0 + tt; const int rel = 8 * (cg < 36 ? 96 + cg : cg < 68 ? cg - 36 : cg < 100 ? 64 + (cg - 68) : 32 + (cg - 100));
                const f32x4 m0 = *(const GAS f32x4*)(mu + rel), m1 = *(const GAS f32x4*)(mu + rel + 4); const float m[8] = {m0.x, m0.y, m0.z, m0.w, m1.x, m1.y, m1.z, m1.w};
                float cv[8], pv[8], xs[8]; unpack8(rc[i], cv); unpack8(rp[i], pv);
#pragma unroll
                for (int j = 0; j < 8; ++j) xs[j] = cv[j] + (pv[j] - cv[j]) * m[j];
                if (cg < 8) {
#pragma unroll
                    for (int j = 0; j < 8; ++j) { const float e2 = __expf(2.f * xs[j]); xs[j] = 1.f - 2.f * __builtin_amdgcn_rcpf(e2 + 1.f); }
                    *(LAS v4u*)(X1 + tt * 72 + 8 * cg) = pack8(xs);
                } else if (cg < 16) { *(LAS v4u*)(X2 + tt * 72 + 8 * (cg - 8)) = pack8(xs);
                } else if (cg < 36) {
#pragma unroll
                    for (int j = 0; j < 8; ++j) xs[j] = sigm(xs[j]);
                    *(LAS v4u*)(X3 + tt * 168 + 8 * (cg - 16)) = pack8(xs);
                } else if (cg < 68) { *(GAS v4u*)(RWR + (size_t)t * 256 + 8 * (cg - 36)) = pack8(xs);
                } else if (cg < 100) { const v4u w = pack8(xs); *(LAS v4u*)(XV + tt * 264 + 8 * (cg - 68)) = w;
                    if (l == 0) { *(GAS v4u*)(RWV + (size_t)t * 256 + 8 * (cg - 68)) = w; *(GAS v4u*)(VF + (size_t)t * 256 + 8 * (cg - 68)) = w; }
                } else { *(LAS v4u*)(XK + tt * 264 + 8 * (cg - 100)) = pack8(xs); } } }
    }
    __syncthreads();
    {   f32x4 acc[2][4];
#pragma unroll
        for (int mi = 0; mi < 2; ++mi)
#pragma unroll
            for (int nb = 0; nb < 4; ++nb) acc[mi][nb] = (f32x4){0.f, 0.f, 0.f, 0.f};
        rw_mm16<2>(acc, X1, 72, mb0, LORA + LO_W2, hh, lane_);
        const float* w0 = INF(14) + l * 256;
#pragma unroll
        for (int mi = 0; mi < 2; ++mi)
#pragma unroll
            for (int nb = 0; nb < 4; ++nb) { const int col = 64 * hh + 16 * nb + fr; const float w0c = w0[col];
#pragma unroll
                for (int r = 0; r < 4; ++r) { const int t = t0 + 16 * (mb0 + mi) + 4 * fq + r; RWW[(size_t)t * 256 + col] = -0.6065306597126334f * sigm(acc[mi][nb][r] + w0c);     } }
#pragma unroll
        for (int mi = 0; mi < 2; ++mi)
#pragma unroll
            for (int nb = 0; nb < 4; ++nb) acc[mi][nb] = (f32x4){0.f, 0.f, 0.f, 0.f};
        rw_mm16<2>(acc, X2, 72, mb0, LORA + LO_A2, hh, lane_);
        const float* a0 = INF(16) + l * 256; const float* kkw = INF(19) + l * 256; const float* kaw = INF(20) + l * 256;
#pragma unroll
        for (int mi = 0; mi < 2; ++mi) {
            float kr[4][4], kq[4][4], ssq[4] = {0.f, 0.f, 0.f, 0.f};
#pragma unroll
            for (int nb = 0; nb < 4; ++nb) { const int col = 64 * hh + 16 * nb + fr; const float kkc = kkw[col];
#pragma unroll
                for (int r = 0; r < 4; ++r) { const int row = 16 * (mb0 + mi) + 4 * fq + r; kr[nb][r] = bf1(XK[row * 264 + col]); kq[nb][r] = kr[nb][r] * kkc; ssq[r] += kq[nb][r] * kq[nb][r]; } }
#pragma unroll
            for (int r = 0; r < 4; ++r) { ssq[r] = sum16(ssq[r]); ssq[r] = 1.0f / fmaxf(sqrtf(ssq[r]), 1e-12f); }
#pragma unroll
            for (int nb = 0; nb < 4; ++nb) { const int col = 64 * hh + 16 * nb + fr; const float a0c = a0[col], kac = kaw[col];
#pragma unroll
                for (int r = 0; r < 4; ++r) { const int t = t0 + 16 * (mb0 + mi) + 4 * fq + r; const float a = sigm(acc[mi][nb][r] + a0c); const float kk = kq[nb][r] * ssq[r];
                    const size_t o = (size_t)t * 256 + col; RWKK[o] = (bf16)f2bf(kk); RWB[o] = (bf16)f2bf(kk * a); RWK[o] = (bf16)f2bf(kr[nb][r] * (1.f + (a - 1.f) * kac)); } }
        }
#pragma unroll
        for (int mi = 0; mi < 2; ++mi)
#pragma unroll
            for (int nb = 0; nb < 4; ++nb) acc[mi][nb] = (f32x4){0.f, 0.f, 0.f, 0.f};
        rw_mm16<5>(acc, X3, 168, mb0, LORA + LO_G2, hh, lane_);
#pragma unroll
        for (int mi = 0; mi < 2; ++mi)
#pragma unroll
            for (int nb = 0; nb < 4; ++nb) { const int col = 64 * hh + 16 * nb + fr;
#pragma unroll
                for (int r = 0; r < 4; ++r) { const int t = t0 + 16 * (mb0 + mi) + 4 * fq + r; RWG[(size_t)t * 256 + col] = (bf16)f2bf(acc[mi][nb][r]); } }
    }
    if (l > 0) {
        const float* v0 = INF(24) + (l - 1) * 256; const bf16* v1T = LORA + LO_V1; const bf16* v2T = LORA + LO_V2;
        {
            const int mb = wave_ & 3, nb = wave_ >> 2; f32x4 a4 = (f32x4){0.f, 0.f, 0.f, 0.f}; bf16x8 bv[8];
#pragma unroll
            for (int ks = 0; ks < 8; ++ks) bv[ks] = *(const GAS bf16x8*)(v1T + (size_t)(16 * nb + fr) * 256 + 32 * ks + 8 * fq);
#pragma unroll
            for (int ks = 0; ks < 8; ++ks) a4 = __builtin_amdgcn_mfma_f32_16x16x32_bf16(*(const LAS bf16x8*)(XV + (16 * mb + fr) * 264 + 32 * ks + 8 * fq), bv[ks], a4, 0, 0, 0);
#pragma unroll
            for (int r = 0; r < 4; ++r) X5[(16 * mb + 4 * fq + r) * 40 + 16 * nb + fr] = (bf16)f2bf(a4[r]);
        }
        __syncthreads();
        {   f32x4 acc[2][4];
#pragma unroll
            for (int mi = 0; mi < 2; ++mi)
#pragma unroll
                for (int nb = 0; nb < 4; ++nb) acc[mi][nb] = (f32x4){0.f, 0.f, 0.f, 0.f};
            rw_mm16<1>(acc, X5, 40, mb0, v2T, hh, lane_);
#pragma unroll
            for (int mi = 0; mi < 2; ++mi)
#pragma unroll
                for (int nb = 0; nb < 4; ++nb) { const int col = 64 * hh + 16 * nb + fr; const float v0c = v0[col];
#pragma unroll
                    for (int r = 0; r < 4; ++r) { const int row = 16 * (mb0 + mi) + 4 * fq + r; const size_t o = (size_t)(t0 + row) * 256 + col;
                        const float xv = bf1(XV[row * 264 + col]); const float vf = bf1(VF[o]); RWV[o] = (bf16)f2bf(xv + (vf - xv) * sigm(acc[mi][nb][r] + v0c)); } }
        }
    }
    __syncthreads();
}
constexpr int CB = 64 * 66;
constexpr int HB_ = 64 * 72;
constexpr int PRE_H0 = 3 * CB * 4;
constexpr int PV_OFF = (PRE_H0 + 10 * HB_ * 2) / 4;
constexpr int REC_RW = 53760, REC_GL = 16640;
constexpr int RO_QH = 0, RO_AT = 8192, RO_BH = 16384, RO_TT = 24576, RO_MRB = 30720, RO_GAM = 36864, RO_VB = 37376;
constexpr int RO_Y = 0, RO_SK = 0;
constexpr int GO_QH = 0, GO_SK = 8192, GO_GAM = 16384;
#define PBUF(i) ((LAS float*)F.lds + (i) * CB)
#define HBUF(i) ((LAS bf16*)(F.lds + PRE_H0) + (i) * HB_)
__device__ __forceinline__ void nt16(f32x4 (&acc)[2], const LAS bf16* X, const LAS bf16* Y, int mb, int nb0, int lane) {
    const int fr = lane & 15, fq = lane >> 4;
    acc[0] = (f32x4){0.f, 0.f, 0.f, 0.f}; acc[1] = acc[0];
#pragma unroll
    for (int ks = 0; ks < 2; ++ks) { const bf16x8 a = *(const LAS bf16x8*)(X + (16 * mb + fr) * 72 + 32 * ks + 8 * fq);
        const bf16x8 b0 = *(const LAS bf16x8*)(Y + (16 * nb0 + fr) * 72 + 32 * ks + 8 * fq), b1 = *(const LAS bf16x8*)(Y + (16 * nb0 + 16 + fr) * 72 + 32 * ks + 8 * fq);
        acc[0] = __builtin_amdgcn_mfma_f32_16x16x32_bf16(a, b0, acc[0], 0, 0, 0); acc[1] = __builtin_amdgcn_mfma_f32_16x16x32_bf16(a, b1, acc[1], 0, 0, 0); }
}
typedef short v4i16_t __attribute__((ext_vector_type(4)));
__device__ __forceinline__ v2u trr(const LAS bf16* p) { return __builtin_bit_cast(v2u, __builtin_amdgcn_ds_read_tr16_b64_v4i16((LAS v4i16_t*)p)); }
__device__ __forceinline__ bf16x8 trfrag(const LAS bf16* M, int c, int ks, int lane) {
    const int g = lane >> 4, q = (lane & 15) >> 2, p = lane & 3; const LAS bf16* a = M + (32 * ks + 8 * g + q) * 72 + 16 * c + 4 * p;
    const v2u lo = trr(a), hi = trr(a + 4 * 72); v4u w; w.x = lo.x; w.y = lo.y; w.z = hi.x; w.w = hi.y; return __builtin_bit_cast(bf16x8, w);
}
__device__ __forceinline__ void tn16(f32x4 (&acc)[2], const LAS bf16* X, const LAS bf16* Y, int mb, int nb0, int lane) {
    acc[0] = (f32x4){0.f, 0.f, 0.f, 0.f}; acc[1] = acc[0];
#pragma unroll
    for (int ks = 0; ks < 2; ++ks) { const bf16x8 a = trfrag(X, mb, ks, lane), b0 = trfrag(Y, nb0, ks, lane), b1 = trfrag(Y, nb0 + 1, ks, lane);
        acc[0] = __builtin_amdgcn_mfma_f32_16x16x32_bf16(a, b0, acc[0], 0, 0, 0); acc[1] = __builtin_amdgcn_mfma_f32_16x16x32_bf16(a, b1, acc[1], 0, 0, 0); }
}
__device__ __forceinline__ void nn16(f32x4 (&acc)[2], const LAS bf16* A, const LAS bf16* B, int mb, int nb0, int lane) {
    const int fr = lane & 15, fq = lane >> 4;
    acc[0] = (f32x4){0.f, 0.f, 0.f, 0.f}; acc[1] = acc[0];
#pragma unroll
    for (int ks = 0; ks < 2; ++ks) { const bf16x8 a = *(const LAS bf16x8*)(A + (16 * mb + fr) * 72 + 32 * ks + 8 * fq), b0 = trfrag(B, nb0, ks, lane), b1 = trfrag(B, nb0 + 1, ks, lane);
        acc[0] = __builtin_amdgcn_mfma_f32_16x16x32_bf16(a, b0, acc[0], 0, 0, 0); acc[1] = __builtin_amdgcn_mfma_f32_16x16x32_bf16(a, b1, acc[1], 0, 0, 0); }
}
__device__ __forceinline__ void hfrag_tr(const LAS bf16* M, unsigned char* dst, int wave, int lane) {
    const int mb = wave >> 1, ks = wave & 1, g = lane >> 4, q = (lane & 15) >> 2, p = lane & 3; const LAS bf16* a = M + (32 * ks + 4 * g + q) * 72 + 16 * mb + 4 * p;
    const v2u lo = trr(a), hi = trr(a + 16 * 72); v4u w; w.x = lo.x; w.y = lo.y; w.z = hi.x; w.w = hi.y;
    *(GAS v4u*)(dst + ((size_t)wave * 64 + lane) * 16) = w;
}
template <int MASK> __device__ __forceinline__ void hst(const f32x4 (&acc)[2], LAS bf16* S, int mb, int nb0, int lane) {
    const int fr = lane & 15, fq = lane >> 4;
#pragma unroll
    for (int n = 0; n < 2; ++n)
#pragma unroll
        for (int r = 0; r < 4; ++r) { const int row = 16 * mb + 4 * fq + r, col = 16 * (nb0 + n) + fr; float v = acc[n][r];
            if (MASK == 1 && col > row) v = 0.f; if (MASK == 2 && col >= row) v = 0.f; S[row * 72 + col] = (bf16)f2bf(v); }
}
template <int MASK> __device__ __forceinline__ void cst(const f32x4 (&acc)[2], LAS float* S, int mb, int nb0, int lane) {
    const int fr = lane & 15, fq = lane >> 4;
#pragma unroll
    for (int n = 0; n < 2; ++n)
#pragma unroll
        for (int r = 0; r < 4; ++r) { const int row = 16 * mb + 4 * fq + r, col = 16 * (nb0 + n) + fr; float v = acc[n][r];
            if (MASK == 1 && col > row) v = 0.f; if (MASK == 2 && col >= row) v = 0.f; S[row * 66 + col] = v; }
}
__device__ __forceinline__ void hfrag(const LAS bf16* M, const LAS float* colscale, unsigned char* dst, int wave, int lane, int slot = -2) {
    const int mb = wave >> 1, ks = wave & 1, i = lane & 15, q = lane >> 4; const LAS bf16* rowp = M + (16 * mb + i) * 72 + 32 * ks + 4 * q;
    const v2u lo = *(const LAS v2u*)rowp, hi = *(const LAS v2u*)(rowp + 16);
    v4u w; w.x = lo.x; w.y = lo.y; w.z = hi.x; w.w = hi.y;
    if (colscale) { float e[8]; unpack8(w, e); const f32x4 s0 = *(const LAS f32x4*)(colscale + 32 * ks + 4 * q), s1 = *(const LAS f32x4*)(colscale + 32 * ks + 16 + 4 * q);
        e[0] *= s0.x; e[1] *= s0.y; e[2] *= s0.z; e[3] *= s0.w; e[4] *= s1.x; e[5] *= s1.y; e[6] *= s1.z; e[7] *= s1.w; w = pack8(e); }
    if (slot == -2) slot = wave; if (slot >= 0) *(GAS v4u*)(dst + ((size_t)slot * 64 + lane) * 16) = w;
}
__device__ __forceinline__ void cfrag(const LAS float* M, unsigned char* dst, int wave, int lane, int slot) {
    const int mb = wave >> 1, ks = wave & 1, i = lane & 15, q = lane >> 4; float e[8];
#pragma unroll
    for (int jj = 0; jj < 8; ++jj) { const int rho = 32 * ks + (jj < 4 ? 4 * q + jj : 16 + 4 * q + jj - 4); e[jj] = M[(16 * mb + i) * 66 + rho]; }
    if (slot >= 0) *(GAS v4u*)(dst + ((size_t)slot * 64 + lane) * 16) = pack8(e);
}
__device__ __forceinline__ void cacc(const f32x4 (&acc)[2], const LAS float* rowscale, unsigned char* dst, int mb, int nb0, int lane, int vbs = 2048) {
    const int fq = lane >> 4;
#pragma unroll
    for (int n = 0; n < 2; ++n) { float v[4];
#pragma unroll
        for (int r = 0; r < 4; ++r) { v[r] = acc[n][r]; if (rowscale) v[r] *= rowscale[16 * mb + 4 * fq + r]; }
        v2u w; w.x = pk2(v[0], v[1]); w.y = pk2(v[2], v[3]); *(GAS v2u*)(dst + (size_t)(nb0 + n) * vbs + ((size_t)mb * 64 + lane) * 8) = w; }
}
__device__ __forceinline__ void ccumsum(Frame& F, LAS float* CU) {
    LAS float* vec = (LAS float*)F.lds + PV_OFF; LAS float* seg = vec + 128;
    { float run = 0.f;
#pragma unroll
      for (int i = 0; i < 8; ++i) { run += CU[(8 * F.wave + i) * 66 + F.lane]; CU[(8 * F.wave + i) * 66 + F.lane] = run; }
      seg[F.wave * 64 + F.lane] = run; }
    LDS_BARRIER();
    { float off = 0.f;
#pragma unroll
      for (int w = 0; w < 8; ++w) if (w < F.wave) off += seg[w * 64 + F.lane];
#pragma unroll
      for (int i = 0; i < 8; ++i) { const float c = CU[(8 * F.wave + i) * 66 + F.lane] + off; CU[(8 * F.wave + i) * 66 + F.lane] = c; if (8 * F.wave + i == 31) vec[F.lane] = c; if (8 * F.wave + i == 63) vec[64 + F.lane] = c; } }
    LDS_BARRIER();
}
__device__ __forceinline__ f32x4 blk16(f32x4 acc, const LAS float* A, int ar0, int ac0, const LAS float* B, int br0, int bc0, int lane) {
    const int fr = lane & 15, fq = lane >> 4;
#pragma unroll
    for (int s = 0; s < 4; ++s) acc = __builtin_amdgcn_mfma_f32_16x16x4f32(A[(ar0 + fr) * 66 + ac0 + 4 * s + fq], B[(br0 + 4 * s + fq) * 66 + bc0 + fr], acc, 0, 0, 0);
    return acc;
}
__device__ __forceinline__ void blkst(const f32x4 acc, LAS float* S, int r0, int c0, int lane) {
    const int fr = lane & 15, fq = lane >> 4;
#pragma unroll
    for (int r = 0; r < 4; ++r) S[(r0 + 4 * fq + r) * 66 + c0 + fr] = acc[r];
}
__device__ __forceinline__ void tri_inverse(Frame& F, const LAS float* L, LAS float* T, LAS float* W) {
    for (int e = F.tid; e < 64 * 64; e += NWAVES * 64) { const int i = e >> 6, j = e & 63; if ((i >> 4) != (j >> 4)) T[i * 66 + j] = 0.f; }
    if (F.wave == 0) {
        const int d0 = 16 * (F.lane >> 4), c = F.lane & 15; float t[16];
#pragma unroll
        for (int i = 0; i < 16; ++i) { float a = (i == c) ? 1.f : 0.f;
#pragma unroll
            for (int j = 0; j < i; ++j) a += L[(d0 + i) * 66 + d0 + j] * t[j];
            t[i] = a; T[(d0 + i) * 66 + d0 + c] = a; }
    }
    LDS_BARRIER();
#pragma unroll
    for (int d = 1; d <= 3; ++d) {
        if (F.wave < 4 - d) { const int i = d + F.wave, j = F.wave; f32x4 acc = (f32x4){0.f, 0.f, 0.f, 0.f};
#pragma unroll
            for (int k = 0; k < 3; ++k) if (k >= j && k < i) acc = blk16(acc, L, 16 * i, 16 * k, T, 16 * k, 16 * j, F.lane);
            blkst(acc, W, 16 * i, 16 * j, F.lane); }
        LDS_BARRIER();
        if (F.wave < 4 - d) { const int i = d + F.wave, j = F.wave; f32x4 acc = (f32x4){0.f, 0.f, 0.f, 0.f};
            acc = blk16(acc, T, 16 * i, 16 * i, W, 16 * i, 16 * j, F.lane); blkst(acc, T, 16 * i, 16 * j, F.lane); }
        LDS_BARRIER();
    }
}
struct PreRaw { unsigned x[6][8]; f32x2_t cs[8]; };
__device__ __forceinline__ unsigned ldh(const bf16* p) { return (unsigned)*(const GAS bf16*)p; }
#define WSQ(T, off) ((T*)(ws_ + (off)))
__device__ __forceinline__ void pre_load(Frame& F, PreRaw& R, const int MIX, int b, int h, int c) {
    int tid_ = F.tid; asm volatile("" : "+v"(tid_));
    unsigned char* ws_ = F.ws; asm volatile("" : "+s"(ws_));
    const int k = tid_ & 63, w = tid_ >> 6, t0 = b * SEQ + c * 64 + 8 * w;
    const bf16* P = WSQ(const bf16, WS_P) + (size_t)t0 * NP;
#pragma unroll
    for (int s = 0; s < 6; ++s)
#pragma unroll
        for (int i = 0; i < 8; ++i) R.x[s][i] = 0u;
    if (MIX == 0) {
#pragma unroll
        for (int i = 0; i < 8; ++i) { R.x[0][i] = ldh(P + (size_t)i * NP + HG_F + 64 * h + k); R.x[1][i] = ldh(P + (size_t)i * NP + HG_Q + 64 * h + k); R.x[2][i] = ldh(P + (size_t)i * NP + HG_I + 64 * h + k); }
    } else if (MIX == 1) {
#pragma unroll
        for (int i = 0; i < 8; ++i) { R.x[2][i] = ldh(P + (size_t)i * NP + GL_V + 64 * h + k);
            if (k < 32) { R.x[0][i] = ldh(P + (size_t)i * NP + GL_GX + 32 * h + k); R.x[1][i] = ldh(P + (size_t)i * NP + GL_Q + 32 * h + k); R.x[3][i] = ldh(P + (size_t)i * NP + GL_K + 32 * h + k); } }
    } else if (MIX == 2) { const size_t o = (size_t)t0 * 256 + 64 * h + k;
#pragma unroll
        for (int i = 0; i < 8; ++i) { R.x[0][i] = __float_as_uint(*(const GAS float*)(WSQ(const float, WS_RWW) + o + i * 256)); R.x[1][i] = ldh(WSQ(const bf16, WS_RWR) + o + i * 256); R.x[2][i] = ldh(WSQ(const bf16, WS_RWV) + o + i * 256);
            R.x[3][i] = ldh(WSQ(const bf16, WS_RWK) + o + i * 256); R.x[4][i] = ldh(WSQ(const bf16, WS_RWKK) + o + i * 256); R.x[5][i] = ldh(WSQ(const bf16, WS_RWB) + o + i * 256); }
    } else { const int k31 = k & 31; const f32x2_t* CS = WSQ(const f32x2_t, WS_CS) + (size_t)t0 * 32 + k31;
#pragma unroll
        for (int i = 0; i < 8; ++i) { R.x[0][i] = ldh(P + (size_t)i * NP + RT_Q + 64 * h + k31); R.x[1][i] = ldh(P + (size_t)i * NP + RT_Q + 64 * h + 32 + k31); R.x[2][i] = ldh(P + (size_t)i * NP + RT_V + 64 * h + k);
            R.x[3][i] = ldh(P + (size_t)i * NP + RT_K + 64 * h + k31); R.x[4][i] = ldh(P + (size_t)i * NP + RT_K + 64 * h + 32 + k31); R.cs[i] = *(const GAS f32x2_t*)(CS + i * 32); }
    }
}
__device__ __forceinline__ float ubf(unsigned u) { return __uint_as_float(u << 16); }
__device__ __forceinline__ v4u pack8v(const float (&f)[8]) { v4u w; w.x = pk2(f[0], f[1]); w.y = pk2(f[2], f[3]); w.z = pk2(f[4], f[5]); w.w = pk2(f[6], f[7]); return w; }
__device__ __forceinline__ void hfrag_trs(const LAS bf16* M, const LAS float* scale, unsigned char* dst, int wave, int lane) {
    const int mb = wave >> 1, ks = wave & 1, g = lane >> 4, q = (lane & 15) >> 2, p = lane & 3; const LAS bf16* a = M + (32 * ks + 4 * g + q) * 72 + 16 * mb + 4 * p;
    const v2u lo = trr(a), hi = trr(a + 16 * 72); v4u w; w.x = lo.x; w.y = lo.y; w.z = hi.x; w.w = hi.y;
    float e[8]; unpack8(w, e); const f32x4 s0 = *(const LAS f32x4*)(scale + 32 * ks + 4 * g), s1 = *(const LAS f32x4*)(scale + 32 * ks + 16 + 4 * g);
    e[0] *= s0.x; e[1] *= s0.y; e[2] *= s0.z; e[3] *= s0.w; e[4] *= s1.x; e[5] *= s1.y; e[6] *= s1.z; e[7] *= s1.w;
    *(GAS v4u*)(dst + ((size_t)wave * 64 + lane) * 16) = pack8(e);
}
__device__ __forceinline__ void chunk_pre(Frame& F, PreRaw& R, int l, const int MIX, int b, int h, int c, unsigned char* rec, const int nMIX, int nh) {
    const int t0 = b * SEQ + c * 64;
    LAS float* SEG = PBUF(0); LAS float* LL = PBUF(1); LAS float* T32 = PBUF(2); LAS float* WW = PBUF(0);
    LAS bf16* A1 = HBUF(0); LAS bf16* R1 = HBUF(1); LAS bf16* B1 = HBUF(2); LAS bf16* K1 = HBUF(3); LAS bf16* KeT = HBUF(4); LAS bf16* VT = HBUF(5); LAS bf16* BeT = HBUF(6); LAS bf16* M1 = HBUF(7); LAS bf16* M2 = HBUF(8); LAS bf16* M3 = HBUF(9);
    LAS float* vec = (LAS float*)F.lds + PV_OFF; LAS float* ecm = vec + 640;
    int tid_ = F.tid; asm volatile("" : "+v"(tid_));
    unsigned char* ws_ = F.ws; asm volatile("" : "+s"(ws_));
    const int lane_ = tid_ & 63, wave_ = __builtin_amdgcn_readfirstlane(tid_ >> 6);
    const int k_ = lane_;
    const int mb = wave_ >> 1, nb0 = 2 * (wave_ & 1), fr = lane_ & 15, fq = lane_ >> 4;
    float q[8], kx[8], lw[8], v[8], av[8], bv[8];
    if (MIX == 0) {
        const float* lg = INF(8); const int cch = 64 * h + k_;
        const float x0 = lg[cch], x1 = lg[256 + cch], x2 = lg[512 + cch], x3 = lg[768 + cch]; const float mx = fmaxf(fmaxf(x0, x1), fmaxf(x2, x3));
        const float e0 = __expf(x0 - mx), e1 = __expf(x1 - mx), e2 = __expf(x2 - mx), e3 = __expf(x3 - mx);
        const float lb = ((l >= 1 ? e1 : 0.f) + (l >= 2 ? e2 : 0.f) + (l >= 3 ? e3 : 0.f)) / (e0 + e1 + e2 + e3);
#pragma unroll
        for (int i = 0; i < 8; ++i) { const float fr_ = ubf(R.x[0][i]), qr = ubf(R.x[1][i]); const float w = lb + (1.f - lb) * sigm(fr_); lw[i] = __logf(w); kx[i] = 1.f - w; q[i] = qr * sigm(qr); v[i] = ubf(R.x[2][i]); }
    } else if (MIX == 1) {
        const float gb = (k_ < 32) ? (INF(11) + l * 128)[32 * h + k_] : 0.f;
#pragma unroll
        for (int i = 0; i < 8; ++i) { v[i] = ubf(R.x[2][i]);
            if (k_ < 32) { const float x = ubf(R.x[0][i]) + gb; lw[i] = 0.0625f * (fminf(x, 0.f) - __logf(1.f + __expf(-fabsf(x)))); q[i] = ubf(R.x[1][i]) * 0.17677669529663687f; kx[i] = ubf(R.x[3][i]); }
            else { lw[i] = 0.f; q[i] = 0.f; kx[i] = 0.f; } }
    } else if (MIX == 2) {
#pragma unroll
        for (int i = 0; i < 8; ++i) { lw[i] = __uint_as_float(R.x[0][i]); q[i] = ubf(R.x[1][i]); v[i] = ubf(R.x[2][i]); kx[i] = ubf(R.x[3][i]); av[i] = -ubf(R.x[4][i]); bv[i] = ubf(R.x[5][i]); }
    } else {
        const bool hi = k_ >= 32; const float lgam = __logf(1.f - exp2f(-5.f - (float)h));
#pragma unroll
        for (int i = 0; i < 8; ++i) { const float cs_ = R.cs[i].x, sn = R.cs[i].y; const float q1 = ubf(R.x[0][i]), q2 = ubf(R.x[1][i]), k1 = ubf(R.x[3][i]), k2 = ubf(R.x[4][i]);
            q[i] = hi ? (q1 * sn + q2 * cs_) : (q1 * cs_ - q2 * sn); kx[i] = 0.125f * (hi ? (k1 * sn + k2 * cs_) : (k1 * cs_ - k2 * sn)); lw[i] = lgam; v[i] = ubf(R.x[2][i]); }
    }
    float cu[8]; { float run = 0.f;
#pragma unroll
        for (int i = 0; i < 8; ++i) { run += lw[i]; cu[i] = run; }
        SEG[wave_ * 64 + k_] = run; }
    LDS_BARRIER();
    float cm, ce; { float pre = 0.f, tot = 0.f, mid = 0.f;
#pragma unroll
        for (int w = 0; w < 8; ++w) { const float s = SEG[w * 64 + k_]; if (w < wave_) pre += s; if (w < 4) mid += s; tot += s; }
        cm = mid; ce = tot;
#pragma unroll
        for (int i = 0; i < 8; ++i) cu[i] += pre; }
    {   float e1[8], e2[8], e3[8];
#pragma unroll
        for (int i = 0; i < 8; ++i) { const float ef = __expf(fminf(fmaxf(cu[i] - cm, -80.f), 80.f)); e1[i] = q[i] * ef; e2[i] = kx[i] * __builtin_amdgcn_rcpf(ef); e3[i] = kx[i] * __expf(ce - cu[i]); }
        *(LAS v4u*)(R1 + k_ * 72 + 8 * wave_) = pack8v(e1); *(LAS v4u*)(K1 + k_ * 72 + 8 * wave_) = pack8v(e2); *(LAS v4u*)(KeT + k_ * 72 + 8 * wave_) = pack8v(e3); *(LAS v4u*)(VT + k_ * 72 + 8 * wave_) = pack8v(v);
        if (MIX == 2) {
#pragma unroll
            for (int i = 0; i < 8; ++i) { const float ef = __expf(fminf(fmaxf(cu[i] - cm, -80.f), 80.f)); e1[i] = av[i] * __expf(fminf(fmaxf(cu[i] - lw[i] - cm, -80.f), 80.f)); e2[i] = bv[i] * __builtin_amdgcn_rcpf(ef); e3[i] = bv[i] * __expf(ce - cu[i]); }
            *(LAS v4u*)(A1 + k_ * 72 + 8 * wave_) = pack8v(e1); *(LAS v4u*)(B1 + k_ * 72 + 8 * wave_) = pack8v(e2); *(LAS v4u*)(BeT + k_ * 72 + 8 * wave_) = pack8v(e3); }
        if (wave_ == 0) { ecm[k_] = __expf(cm); *(GAS float*)(rec + (MIX == 2 ? RO_GAM : GO_GAM) + 4 * k_) = __expf(ce); }
    }
    LDS_BARRIER();
    if (nMIX >= 0) pre_load(F, R, nMIX, b, nh, c);
    f32x4 acc[2];
    tn16(acc, R1, K1, mb, nb0, lane_); hst<1>(acc, M1, mb, nb0, lane_);
    hfrag_trs(R1, ecm, rec + (MIX == 2 ? RO_QH : GO_QH), wave_, lane_);
    nt16(acc, KeT, VT, mb, nb0, lane_); if (MIX == 2) cacc(acc, nullptr, rec + RO_VB + 2048, mb, nb0, lane_, 4096); else cacc(acc, nullptr, rec + GO_SK, mb, nb0, lane_);
    if (MIX == 2) {
        tn16(acc, A1, B1, mb, nb0, lane_); cst<2>(acc, LL, mb, nb0, lane_);
        tn16(acc, R1, B1, mb, nb0, lane_); hst<1>(acc, M2, mb, nb0, lane_);
        tn16(acc, A1, K1, mb, nb0, lane_); hst<2>(acc, M3, mb, nb0, lane_);
        hfrag_trs(A1, ecm, rec + RO_AT, wave_, lane_);
        hfrag(BeT, nullptr, rec + RO_BH, wave_, lane_);
    }
    LDS_BARRIER();
    nt16(acc, M1, VT, mb, nb0, lane_);
#pragma unroll
    for (int n = 0; n < 2; ++n)
#pragma unroll
        for (int r = 0; r < 4; ++r) A1[(16 * mb + 4 * fq + r) * 72 + 16 * (nb0 + n) + fr] = (bf16)f2bf(acc[n][r]);
    if (MIX == 2) {
        nt16(acc, M3, VT, mb, nb0, lane_); cacc(acc, nullptr, rec + RO_VB, mb, nb0, lane_, 4096);
        const int t6 = ((wave_ & 1) == 1 && (wave_ >> 1) < 2) ? -1 : ((wave_ >> 1) < 2 ? (wave_ >> 1) : 2 + ((wave_ >> 1) - 2) * 2 + (wave_ & 1));
        hfrag(M2, nullptr, rec + RO_MRB, wave_, lane_, t6);
        tri_inverse(F, LL, T32, WW);
        cfrag(T32, rec + RO_TT, wave_, lane_, t6);
    }
    LDS_BARRIER();
}
constexpr size_t WS_REC_RW = 14 * MiB, WS_REC_GL = 412 * MiB;
__device__ __forceinline__ void oloc_flush(Frame& F, int m, int t0, int h) {
    const int t = F.tid >> 3, pc = F.tid & 7; const v4u w = *(const LAS v4u*)(HBUF(0) + t * 72 + 8 * pc);
    *(GAS v4u*)(WSP(bf16, WS_O) + (size_t)m * TOK * 256 + (size_t)(t0 + t) * 256 + 64 * h + 8 * pc) = w;
}
__device__ __forceinline__ unsigned char* pre_rec(Frame& F, int m, int b, int h, int c) {
    return (m == 2) ? F.ws + WS_REC_RW + (size_t)(((b * 4 + h) * 64) + c) * REC_RW : F.ws + WS_REC_GL + (size_t)((((m == 3 ? 2 : m) * 16 + b * 4 + h) * 64) + c) * REC_GL;
}
__device__ __forceinline__ void phase_chunkpre(Frame& F, int l) {
    for (int tile = F.vcu; tile < TOK / 64; tile += F.G) {
        const int b = tile >> 6, c = tile & 63;
        rwprep_tile(F, l, tile);
        __syncthreads();
        PreRaw cur;
        pre_load(F, cur, 0, b, 0, c);
#pragma unroll 1
        for (int i = 0; i < 16; ++i) {
            const int mo = i >> 2, m = (mo == 2) ? 3 : (mo == 3 ? 2 : mo), h = i & 3;
            const int mo2 = (i + 1) >> 2, m2 = (i + 1 < 16) ? ((mo2 == 2) ? 3 : (mo2 == 3 ? 2 : mo2)) : -1;
            chunk_pre(F, cur, l, m, b, h, c, pre_rec(F, m, b, h, c), m2, (i + 1) & 3);
            oloc_flush(F, m, b * SEQ + c * 64, h);
        }
    }
}
__device__ __forceinline__ bf16x8 pack_b(const f32x4 a, const f32x4 b) { v4u w; w.x = pk2(a.x, a.y); w.y = pk2(a.z, a.w); w.z = pk2(b.x, b.y); w.w = pk2(b.z, b.w); return __builtin_bit_cast(bf16x8, w); }
__device__ __forceinline__ f32x4 unpk4(const v2u w) { return (f32x4){bflo(w.x), bfhi(w.x), bflo(w.y), bfhi(w.y)}; }
template <int NF> struct SeqRegs { v4u r[NF]; v4u tail; };
template <int NF, int NLT, bool TAIL> __device__ __forceinline__ void seq_ld(SeqRegs<NF>& R, const unsigned char* rec, int lt) {
    const GAS v4u* src = (const GAS v4u*)rec;
#pragma unroll
    for (int i = 0; i < NF; ++i) R.r[i] = src[i * NLT + lt];
    if (TAIL && lt < 16) R.tail = src[NF * NLT + lt];
}
template <int NF, int NLT, bool TAIL> __device__ __forceinline__ void seq_st(const SeqRegs<NF>& R, LAS unsigned char* slot, int lt) {
    LAS v4u* dst = (LAS v4u*)slot;
#pragma unroll
    for (int i = 0; i < NF; ++i) dst[i * NLT + lt] = R.r[i];
    if (TAIL && lt < 16) dst[NF * NLT + lt] = R.tail;
}
template <bool RW> __device__ __forceinline__ void seq_unit(Frame& F, int mix, int b, int h, int vb_, const unsigned char* recs) {
    constexpr int REC = RW ? REC_RW : REC_GL, SLOT = 61440, NCW = RW ? 1 : 4, LW0 = RW ? 2 : 4, NLT = (8 - LW0) * 64, NF = REC / (NLT * 16); constexpr bool TAIL = (REC % (NLT * 16)) != 0;
    static_assert(REC % (NLT * 16) == 0 || REC % (NLT * 16) == 256, "record = NF loader rounds (+ 256 B)");
    const bool loader = F.wave >= LW0, compute = F.wave < NCW; const int lt = F.tid - 64 * LW0;
    SeqRegs<NF> RA, RB;
    if (loader) { seq_ld<NF, NLT, TAIL>(RA, recs, lt); seq_st<NF, NLT, TAIL>(RA, F.lds, lt); seq_ld<NF, NLT, TAIL>(RB, recs + (size_t)1 * REC, lt); seq_ld<NF, NLT, TAIL>(RA, recs + (size_t)2 * REC, lt); }
    __syncthreads();
    f32x4 S[4];
#pragma unroll
    for (int kb = 0; kb < 4; ++kb) S[kb] = (f32x4){0.f, 0.f, 0.f, 0.f};
    const int vb = RW ? vb_ : (F.wave & 3), fr = F.lane & 15, fq = F.lane >> 4;
    bf16* Og_ = WSP(bf16, WS_OI) + OI_GEN + (size_t)(((mix == 3 ? 2 : mix) * 16 + b * 4 + h)) * (SEQ * 64);
    constexpr int OSO = 122880;
#define SEQ_FLUSH(cc) do { const LAS unsigned char* osr_ = F.lds + OSO + ((cc) & 1) * 8192 + (16 * vb + (F.lane >> 2)) * 128 + (F.lane & 3) * 32; bf16* dst_ = Og_ + ((size_t)(cc) * 64 + 16 * vb + (F.lane >> 2)) * 64 + (F.lane & 3) * 16; \
        const v4u a_ = *(const LAS v4u*)osr_, b_ = *(const LAS v4u*)(osr_ + 16); *(GAS v4u*)dst_ = a_; *(GAS v4u*)(dst_ + 8) = b_; } while (0)
#pragma unroll 1
    for (int c2 = 0; c2 < 64; c2 += 2) {
#pragma unroll
        for (int par = 0; par < 2; ++par) {
            const int c = c2 + par;
            if (loader) {
                if (par == 0) { seq_st<NF, NLT, TAIL>(RB, F.lds + SLOT, lt); if (c + 3 < 64) seq_ld<NF, NLT, TAIL>(RB, recs + (size_t)(c + 3) * REC, lt); }
                else { if (c + 1 < 64) seq_st<NF, NLT, TAIL>(RA, F.lds, lt); if (c + 3 < 64) seq_ld<NF, NLT, TAIL>(RA, recs + (size_t)(c + 3) * REC, lt); }
            } else if (compute) {
                const LAS unsigned char* R = F.lds + par * SLOT;
                const f32x4 z = (f32x4){0.f, 0.f, 0.f, 0.f};
                if (c > 0) SEQ_FLUSH(c - 1);
                bf16x8 fqh[8];
#pragma unroll
                for (int f = 0; f < 8; ++f) fqh[f] = *(const LAS bf16x8*)(R + (RW ? RO_QH : GO_QH) + (f * 64 + F.lane) * 16);
                bf16x8 bS[2]; bS[0] = pack_b(S[0], S[1]); bS[1] = pack_b(S[2], S[3]);
                asm volatile("s_waitcnt lgkmcnt(0)" ::: "memory"); __builtin_amdgcn_sched_barrier(0);
                f32x4 O[4]; bf16x8 bU[2];
#pragma unroll
                for (int mb = 0; mb < 4; ++mb) { O[mb] = z;
#pragma unroll
                    for (int ks = 0; ks < 2; ++ks) O[mb] = __builtin_amdgcn_mfma_f32_16x16x32_bf16(fqh[mb * 2 + ks], bS[ks], O[mb], 0, 0, 0); }
                if (RW) {
                    f32x4 X[4], U[4];
#pragma unroll
                    for (int mb = 0; mb < 4; ++mb) { X[mb] = unpk4(*(const LAS v2u*)(R + RO_Y + ((vb * 4 + mb) * 64 + F.lane) * 8));
#pragma unroll
                        for (int ks = 0; ks < 2; ++ks) X[mb] = __builtin_amdgcn_mfma_f32_16x16x32_bf16(*(const LAS bf16x8*)(R + RO_AT + ((mb * 2 + ks) * 64 + F.lane) * 16), bS[ks], X[mb], 0, 0, 0); }
                    bf16x8 bX[2]; bX[0] = pack_b(X[0], X[1]); bX[1] = pack_b(X[2], X[3]);
#pragma unroll
                    for (int mb = 0; mb < 4; ++mb) { U[mb] = z;
#pragma unroll
                        for (int ks = 0; ks < 2; ++ks) if (!(ks == 1 && mb < 2)) U[mb] = __builtin_amdgcn_mfma_f32_16x16x32_bf16(*(const LAS bf16x8*)(R + RO_TT + ((mb * 2 + ks) * 64 + F.lane) * 16), bX[ks], U[mb], 0, 0, 0); }
                    bU[0] = pack_b(U[0], U[1]); bU[1] = pack_b(U[2], U[3]);
#pragma unroll
                    for (int mb = 0; mb < 4; ++mb)
#pragma unroll
                        for (int ks = 0; ks < 2; ++ks) if (!(ks == 1 && mb < 2)) O[mb] = __builtin_amdgcn_mfma_f32_16x16x32_bf16(*(const LAS bf16x8*)(R + RO_MRB + ((mb * 2 + ks) * 64 + F.lane) * 16), bU[ks], O[mb], 0, 0, 0);
                }
#pragma unroll
                for (int kb = 0; kb < 4; ++kb) { const f32x4 g = *(const LAS f32x4*)(R + (RW ? RO_GAM : GO_GAM) + (16 * kb + 4 * fq) * 4); const f32x4 sk = unpk4(*(const LAS v2u*)(R + (RW ? RO_SK : GO_SK) + ((vb * 4 + kb) * 64 + F.lane) * 8));
                    f32x4 n = S[kb] * g + sk;
                    if (RW) {
#pragma unroll
                        for (int ks = 0; ks < 2; ++ks) n = __builtin_amdgcn_mfma_f32_16x16x32_bf16(*(const LAS bf16x8*)(R + RO_BH + ((kb * 2 + ks) * 64 + F.lane) * 16), bU[ks], n, 0, 0, 0);
                    }
                    S[kb] = n; }
#pragma unroll
                for (int mb = 0; mb < 4; ++mb)
#pragma unroll
                    for (int r = 0; r < 4; ++r) *(LAS bf16*)(F.lds + OSO + par * 8192 + (16 * mb + 4 * fq + r) * 128 + (16 * vb + fr) * 2) = (bf16)f2bf(O[mb][r]);
            }
            LDS_BARRIER();
        }
    }
    if (compute) SEQ_FLUSH(63);
#undef SEQ_FLUSH
    __syncthreads();
}
__device__ __forceinline__ int tri6(int mb, int ks) { return mb < 2 ? mb : 2 + (mb - 2) * 2 + ks; }
struct SeqRegs4 { v4u r[6]; v4u t; };
__device__ __forceinline__ void seq4_ld(SeqRegs4& R, const unsigned char* rec, int vb, int lt) {
    const GAS v4u* src = (const GAS v4u*)rec;
#pragma unroll
    for (int i = 0; i < 6; ++i) R.r[i] = src[i * 384 + lt];
    if (lt < 16) R.t = src[6 * 384 + lt];
    if (lt >= 128) R.t = *(const GAS v4u*)(rec + RO_VB + vb * 4096 + (lt - 128) * 16);
}
__device__ __forceinline__ void seq4_st(const SeqRegs4& R, LAS unsigned char* slot, int lt) {
    LAS v4u* dst = (LAS v4u*)slot;
#pragma unroll
    for (int i = 0; i < 6; ++i) dst[i * 384 + lt] = R.r[i];
    if (lt < 16) dst[6 * 384 + lt] = R.t;
    if (lt >= 128) *(LAS v4u*)(slot + 37120 + (lt - 128) * 16) = R.t;
}
__device__ __forceinline__ void seq_rw(Frame& F, int b, int h, int vb, const unsigned char* recs) {
    constexpr int REC = REC_RW, SLOT = 41216, EXO = 3 * SLOT;
    const bool loader = F.wave >= 2; const int lt = F.tid - 128;
    SeqRegs4 RA, RB;
    if (loader) { seq4_ld(RA, recs, vb, lt); seq4_st(RA, F.lds, lt); seq4_ld(RB, recs + (size_t)1 * REC, vb, lt); seq4_ld(RA, recs + (size_t)2 * REC, vb, lt); }
    __syncthreads();
    f32x4 S[4];
#pragma unroll
    for (int kb = 0; kb < 4; ++kb) S[kb] = (f32x4){0.f, 0.f, 0.f, 0.f};
    const int fr = F.lane & 15, fq = F.lane >> 4;
    bf16* Og_ = WSP(bf16, WS_OI) + (size_t)((b * 4 + h) * 4 + vb) * (SEQ * 16);
    LAS unsigned char* OS = F.lds + EXO + 8192;
    constexpr int PFD = 8; LAS unsigned* PFDUMMY = (LAS unsigned*)(F.lds + EXO + 8192 + 2048);
#define SEQ_PF(cp) do { const unsigned char* rp_ = recs + (size_t)(cp) * REC; const int li_ = F.lane; \
        __builtin_amdgcn_global_load_lds((const unsigned*)(rp_ + vb * 9216 + li_ * 128), PFDUMMY, 4, 0, 0); \
        const unsigned o2_ = li_ < 8 ? (unsigned)(vb * 9216 + (64 + li_) * 128) : li_ < 40 ? (unsigned)(RO_VB + vb * 4096 + (li_ - 8) * 128) : (unsigned)(RO_GAM + ((li_ - 40) & 1) * 128); \
        __builtin_amdgcn_global_load_lds((const unsigned*)(rp_ + o2_), PFDUMMY + 64, 4, 0, 0); } while (0)
    if (F.wave == 1) {
#pragma unroll 1
        for (int cp = 3; cp < PFD; ++cp) SEQ_PF(cp); }
#pragma unroll 1
    for (int c2 = 0; c2 < 66; c2 += 2) {
#pragma unroll
        for (int par = 0; par < 2; ++par) {
            const int c = c2 + par;
            if (loader) {
                if (c + 1 < 64) { LAS unsigned char* dst = F.lds + ((c + 1) % 3) * SLOT; if (par == 0) seq4_st(RB, dst, lt); else seq4_st(RA, dst, lt); }
                if (c + 3 < 64) { if (par == 0) seq4_ld(RB, recs + (size_t)(c + 3) * REC, vb, lt); else seq4_ld(RA, recs + (size_t)(c + 3) * REC, vb, lt); }
            } else if (F.wave == 0) {
                if (c < 64) {
                    const LAS unsigned char* R = F.lds + (c % 3) * SLOT; LAS unsigned char* EX = F.lds + EXO + par * 4096;
                    const f32x4 z = (f32x4){0.f, 0.f, 0.f, 0.f};
                    v2u yv[4]; bf16x8 fat[8], ftt[6];
#pragma unroll
                    for (int mb = 0; mb < 4; ++mb) yv[mb] = *(const LAS v2u*)(R + 37120 + (mb * 64 + F.lane) * 8);
#pragma unroll
                    for (int f = 0; f < 8; ++f) fat[f] = *(const LAS bf16x8*)(R + RO_AT + (f * 64 + F.lane) * 16);
                    bf16x8 bS[2]; bS[0] = pack_b(S[0], S[1]); bS[1] = pack_b(S[2], S[3]);
                    *(LAS bf16x8*)(EX + F.lane * 16) = bS[0]; *(LAS bf16x8*)(EX + 1024 + F.lane * 16) = bS[1];
                    asm volatile("s_waitcnt lgkmcnt(0)" ::: "memory"); __builtin_amdgcn_sched_barrier(0);
                    f32x4 X[4], U[4];
#pragma unroll
                    for (int mb = 0; mb < 4; ++mb) { X[mb] = unpk4(yv[mb]);
#pragma unroll
                        for (int ks = 0; ks < 2; ++ks) X[mb] = __builtin_amdgcn_mfma_f32_16x16x32_bf16(fat[mb * 2 + ks], bS[ks], X[mb], 0, 0, 0); }
                    __builtin_amdgcn_sched_barrier(0);
                    bf16x8 fbh[8]; f32x4 gm[4]; v2u skv[4];
#pragma unroll
                    for (int f = 0; f < 6; ++f) ftt[f] = *(const LAS bf16x8*)(R + RO_TT + (f * 64 + F.lane) * 16);
#pragma unroll
                    for (int f = 0; f < 8; ++f) fbh[f] = *(const LAS bf16x8*)(R + RO_BH + (f * 64 + F.lane) * 16);
#pragma unroll
                    for (int kb = 0; kb < 4; ++kb) { gm[kb] = *(const LAS f32x4*)(R + RO_GAM + (16 * kb + 4 * fq) * 4); skv[kb] = *(const LAS v2u*)(R + 37120 + 2048 + (kb * 64 + F.lane) * 8); }
                    __builtin_amdgcn_sched_barrier(0);
                    bf16x8 bX[2]; bX[0] = pack_b(X[0], X[1]); bX[1] = pack_b(X[2], X[3]);
#pragma unroll
                    for (int mb = 0; mb < 4; ++mb) { U[mb] = z;
#pragma unroll
                        for (int ks = 0; ks < 2; ++ks) if (!(ks == 1 && mb < 2)) U[mb] = __builtin_amdgcn_mfma_f32_16x16x32_bf16(ftt[tri6(mb, ks)], bX[ks], U[mb], 0, 0, 0); }
                    bf16x8 bU[2]; bU[0] = pack_b(U[0], U[1]); bU[1] = pack_b(U[2], U[3]);
                    *(LAS bf16x8*)(EX + 2048 + F.lane * 16) = bU[0]; *(LAS bf16x8*)(EX + 3072 + F.lane * 16) = bU[1];
                    asm volatile("s_waitcnt lgkmcnt(0)" ::: "memory"); __builtin_amdgcn_sched_barrier(0);
#pragma unroll
                    for (int kb = 0; kb < 4; ++kb) { f32x4 n = S[kb] * gm[kb] + unpk4(skv[kb]);
#pragma unroll
                        for (int ks = 0; ks < 2; ++ks) n = __builtin_amdgcn_mfma_f32_16x16x32_bf16(fbh[kb * 2 + ks], bU[ks], n, 0, 0, 0);
                        S[kb] = n; }
                }
            } else {
                if (c + PFD < 64) SEQ_PF(c + PFD);
                if (c >= 1 && c <= 64) {
                    const int co = c - 1; const LAS unsigned char* R = F.lds + (co % 3) * SLOT; const LAS unsigned char* EX = F.lds + EXO + (par ^ 1) * 4096;
                    bf16x8 fq_[8], fm[6];
#pragma unroll
                    for (int f = 0; f < 8; ++f) fq_[f] = *(const LAS bf16x8*)(R + RO_QH + (f * 64 + F.lane) * 16);
#pragma unroll
                    for (int f = 0; f < 6; ++f) fm[f] = *(const LAS bf16x8*)(R + RO_MRB + (f * 64 + F.lane) * 16);
                    const bf16x8 bS0 = *(const LAS bf16x8*)(EX + F.lane * 16), bS1 = *(const LAS bf16x8*)(EX + 1024 + F.lane * 16), bU0 = *(const LAS bf16x8*)(EX + 2048 + F.lane * 16), bU1 = *(const LAS bf16x8*)(EX + 3072 + F.lane * 16);
                    asm volatile("s_waitcnt lgkmcnt(0)" ::: "memory"); __builtin_amdgcn_sched_barrier(0);
                    f32x4 O[4];
#pragma unroll
                    for (int mb = 0; mb < 4; ++mb) { O[mb] = (f32x4){0.f, 0.f, 0.f, 0.f};
                        O[mb] = __builtin_amdgcn_mfma_f32_16x16x32_bf16(fq_[mb * 2], bS0, O[mb], 0, 0, 0);
                        O[mb] = __builtin_amdgcn_mfma_f32_16x16x32_bf16(fq_[mb * 2 + 1], bS1, O[mb], 0, 0, 0);
                        O[mb] = __builtin_amdgcn_mfma_f32_16x16x32_bf16(fm[tri6(mb, 0)], bU0, O[mb], 0, 0, 0);
                        if (mb >= 2) O[mb] = __builtin_amdgcn_mfma_f32_16x16x32_bf16(fm[tri6(mb, 1)], bU1, O[mb], 0, 0, 0); }
#pragma unroll
                    for (int mb = 0; mb < 4; ++mb)
#pragma unroll
                        for (int r = 0; r < 4; ++r) *(LAS bf16*)(OS + (16 * mb + 4 * fq + r) * 32 + fr * 2) = (bf16)f2bf(O[mb][r]);
                    asm volatile("s_waitcnt lgkmcnt(0)" ::: "memory");
                    { const v4u a_ = *(const LAS v4u*)(OS + F.lane * 32), b_ = *(const LAS v4u*)(OS + F.lane * 32 + 16); bf16* dst_ = Og_ + ((size_t)co * 64 + F.lane) * 16; *(GAS v4u*)dst_ = a_; *(GAS v4u*)(dst_ + 8) = b_; }
                    asm volatile("s_waitcnt lgkmcnt(0)" ::: "memory");
                }
            }
            LDS_BARRIER();
        }
    }
#undef SEQ_PF
    VM_WAIT();
    __syncthreads();
}
__device__ __forceinline__ void phase_seq(Frame& F, int l) {
    for (int u = blockIdx.x; u < 112; u += F.G) {
        if (u < 64) { const int bh = (u & 7) * 2 + (u >> 5), vb = (u >> 3) & 3;
            seq_rw(F, bh >> 2, bh & 3, vb, F.ws + WS_REC_RW + (size_t)(bh * 64) * REC_RW); }
        else { const int v = u - 64, mm = v % 3, bh = v / 3; seq_unit<false>(F, mm == 2 ? 3 : mm, bh >> 2, bh & 3, 0, F.ws + WS_REC_GL + (size_t)((mm * 16 + bh) * 64) * REC_GL); }
    }
}
struct PostRaw { v4u o0, o1; v4u y0, y1; v4u x0, x1, x2, x3, x4, x5, x6, x7; };
__device__ __forceinline__ void post_load(Frame& F, PostRaw& R, int t, int m, int c0) {
    const bf16* P = WSP(const bf16, WS_P);
    const bf16* Ob = WSP(const bf16, WS_O) + (size_t)m * TOK * 256 + (size_t)t * 256 + c0;
    R.o0 = *(const GAS v4u*)(Ob); R.o1 = *(const GAS v4u*)(Ob + 8);
    { const int bb = t >> 12, tb = t & (SEQ - 1), hh = c0 >> 6, qq = (c0 >> 4) & 3; const bf16* oi = WSP(const bf16, WS_OI) + (m == 2 ? ((size_t)((bb * 4 + hh) * 4 + qq) * SEQ + tb) * 16 : OI_GEN + ((size_t)(((m == 3 ? 2 : m) * 16 + bb * 4 + hh)) * SEQ + tb) * 64 + 16 * qq);
      R.y0 = *(const GAS v4u*)oi; R.y1 = *(const GAS v4u*)(oi + 8); }
    const v4u zz = (v4u){0u, 0u, 0u, 0u}; R.x2 = zz; R.x3 = zz; R.x4 = zz; R.x5 = zz; R.x6 = zz; R.x7 = zz;
    if (m != 2) { const int gc = (m == 0 ? HG_G : m == 1 ? GL_R : RT_G) + c0; R.x0 = *(const GAS v4u*)(P + (size_t)t * NP + gc); R.x1 = *(const GAS v4u*)(P + (size_t)t * NP + gc + 8); }
    else { const size_t ob = (size_t)t * 256 + c0;
        R.x0 = *(const GAS v4u*)(WSP(const bf16, WS_RWR) + ob); R.x1 = *(const GAS v4u*)(WSP(const bf16, WS_RWR) + ob + 8); R.x2 = *(const GAS v4u*)(WSP(const bf16, WS_RWK) + ob); R.x3 = *(const GAS v4u*)(WSP(const bf16, WS_RWK) + ob + 8);
        R.x4 = *(const GAS v4u*)(WSP(const bf16, WS_RWV) + ob); R.x5 = *(const GAS v4u*)(WSP(const bf16, WS_RWV) + ob + 8); R.x6 = *(const GAS v4u*)(WSP(const bf16, WS_RWG) + ob); R.x7 = *(const GAS v4u*)(WSP(const bf16, WS_RWG) + ob + 8); }
}
__device__ __forceinline__ void unpack16(const v4u a, const v4u b, float (&f)[16]) { float x[8], y[8]; unpack8(a, x); unpack8(b, y);
#pragma unroll
    for (int j = 0; j < 8; ++j) { f[j] = x[j]; f[8 + j] = y[j]; } }
__device__ __forceinline__ void phase_post(Frame& F, int l) {
    const int gw = F.vcu * NWAVES + F.wave, NGW = F.G * NWAVES;
    const int m = F.lane >> 4, h = (F.lane >> 2) & 3, qd = F.lane & 3; const int c0 = 64 * h + 16 * qd;
    bf16* Y = WSP(bf16, WS_Y);
    PostRaw cur, nxt;
    if (gw < TOK) post_load(F, cur, gw, m, c0);
    for (int t = gw; t < TOK; t += NGW) {
        if (t + NGW < TOK) post_load(F, nxt, t + NGW, m, c0);
        float o[16], oi[16];
        unpack16(cur.o0, cur.o1, o);
        unpack16(cur.y0, cur.y1, oi);
        float s1 = 0.f, s2 = 0.f;
#pragma unroll
        for (int j = 0; j < 16; ++j) { o[j] += oi[j]; s1 += o[j]; s2 += o[j] * o[j]; }
        s1 = sum4(s1); s2 = sum4(s2);
        float y[16];
        if (m < 2) {
            const float rs = rsqrtf(s2 * (1.f / 64.f) + 1e-6f); const float* ng = INF(m == 0 ? 9 : 12) + l * 64 + 16 * qd;
            float g[16]; unpack16(cur.x0, cur.x1, g);
#pragma unroll
            for (int j = 0; j < 16; ++j) y[j] = o[j] * rs * ng[j] * (g[j] * sigm(g[j]));
        } else if (m == 2) {
            const float mean = s1 * (1.f / 64.f); float var = s2 * (1.f / 64.f) - mean * mean; var = fmaxf(var, 0.f); const float rs = rsqrtf(var + 64e-5f);
            float r[16], k[16], v[16], g[16]; unpack16(cur.x0, cur.x1, r); unpack16(cur.x2, cur.x3, k); unpack16(cur.x4, cur.x5, v); unpack16(cur.x6, cur.x7, g);
            const float* rk = INF(21) + l * 256 + c0; const float* lg = INF(22) + l * 256 + c0; const float* lb = INF(23) + l * 256 + c0;
            float bon = 0.f;
#pragma unroll
            for (int j = 0; j < 16; ++j) bon += r[j] * k[j] * rk[j];
            bon = sum4(bon);
#pragma unroll
            for (int j = 0; j < 16; ++j) y[j] = ((o[j] - mean) * rs * lg[j] + lb[j] + bon * v[j]) * g[j];
        } else {
            const float mean = s1 * (1.f / 64.f); float var = s2 * (1.f / 64.f) - mean * mean; var = fmaxf(var, 0.f); const float rs = rsqrtf(var + 1e-5f);
            float g[16]; unpack16(cur.x0, cur.x1, g);
#pragma unroll
            for (int j = 0; j < 16; ++j) y[j] = (g[j] * sigm(g[j])) * ((o[j] - mean) * rs);
        }
        v4u w0, w1; w0.x = pk2(y[0], y[1]); w0.y = pk2(y[2], y[3]); w0.z = pk2(y[4], y[5]); w0.w = pk2(y[6], y[7]); w1.x = pk2(y[8], y[9]); w1.y = pk2(y[10], y[11]); w1.z = pk2(y[12], y[13]); w1.w = pk2(y[14], y[15]);
        GAS v4u* yo = (GAS v4u*)(Y + (size_t)t * D + 256 * m + c0); yo[0] = w0; yo[1] = w1;
        cur = nxt;
    }
}
template <int MODE> struct LnRaw { v2u h[4]; v2u d1[4], d2[4]; float g1, g2; };
template <int MODE> __device__ __forceinline__ void ln_load(Frame& F, LnRaw<MODE>& R, int m) {
    const GAS v2u* hr = (const GAS v2u*)(WSP(const bf16, WS_HB) + (size_t)m * D) + F.lane;
#pragma unroll
    for (int j = 0; j < 4; ++j) R.h[j] = hr[64 * j];
    if (MODE == 0) { const GAS v2u* ar = (const GAS v2u*)(WSP(const bf16, WS_MIX) + (size_t)m * D) + F.lane;
#pragma unroll
        for (int j = 0; j < 4; ++j) R.d1[j] = ar[64 * j]; }
    else { const bf16* DOUT = WSP(const bf16, WS_DOUT); const float* GATE = WSP(const float, WS_GATE); R.g1 = GATE[2 * m]; R.g2 = GATE[2 * m + 1];
#pragma unroll
        for (int j = 0; j < 4; ++j) { R.d1[j] = ((const GAS v2u*)(DOUT + (size_t)(2 * m) * D))[F.lane + 64 * j]; R.d2[j] = ((const GAS v2u*)(DOUT + (size_t)(2 * m + 1) * D))[F.lane + 64 * j]; } }
}
template <int MODE, bool ROUTE, bool Q8 = false, int DRY = 0> __device__ __forceinline__ void phase_ln(Frame& F, const float* gw_, const float* bw_, const float* router, int mi, const bool final_out = false) {
    const int gw = F.vcu * NWAVES + F.wave, NGW = F.G * NWAVES;
    bf16* hb = WSP(bf16, DRY == 1 ? WS_DOUT : DRY == 2 ? WS_Y : WS_HB); float* GATE = WSP(float, WS_GATE);
    LAS float* RT = (LAS float*)F.lds;
    if (ROUTE) { for (int i = F.tid; i < D * NE; i += NWAVES * 64) RT[(i & 7) * D + (i >> 3)] = router[i]; __syncthreads(); }
    f32x4 gv[4], bv[4];
#pragma unroll
    for (int j = 0; j < 4; ++j) { gv[j] = ((const GAS f32x4*)gw_)[F.lane + 64 * j]; bv[j] = ((const GAS f32x4*)bw_)[F.lane + 64 * j]; }
    LnRaw<MODE> cur, nxt;
    if (gw < TOK) ln_load<MODE>(F, cur, gw);
    for (int m = gw; m < TOK; m += NGW) {
        if (m + NGW < TOK) ln_load<MODE>(F, nxt, m + NGW);
        GAS f32x4* hr = (GAS f32x4*)(F.h + (size_t)m * D) + F.lane;
        f32x4 v[4]; float s = 0.f;
#pragma unroll
        for (int j = 0; j < 4; ++j) {
            f32x4 a;
            if (MODE == 0) { const v2u d1 = cur.d1[j]; a = (f32x4){bflo(d1.x), bfhi(d1.x), bflo(d1.y), bfhi(d1.y)}; }
            else { const v2u d1 = cur.d1[j], d2 = cur.d2[j]; const float g1 = cur.g1, g2 = cur.g2;
                a.x = g1 * bflo(d1.x) + g2 * bflo(d2.x); a.y = g1 * bfhi(d1.x) + g2 * bfhi(d2.x); a.z = g1 * bflo(d1.y) + g2 * bflo(d2.y); a.w = g1 * bfhi(d1.y) + g2 * bfhi(d2.y); }
            const v2u hq = cur.h[j]; const f32x4 hv = (f32x4){bflo(hq.x), bfhi(hq.x), bflo(hq.y), bfhi(hq.y)};
            v[j] = hv * DN_ALPHA + a; s += (v[j].x + v[j].y) + (v[j].z + v[j].w); }
        const float mean = wave_sum(s) * (1.f / D); float s2 = 0.f;
#pragma unroll
        for (int j = 0; j < 4; ++j) { v[j] = v[j] - mean; s2 += (v[j].x * v[j].x + v[j].y * v[j].y) + (v[j].z * v[j].z + v[j].w * v[j].w); }
        const float rstd = 1.f / sqrtf(wave_sum(s2) * (1.f / D) + 1e-5f);
        GAS v2u* o8 = (GAS v2u*)(hb + (size_t)m * D) + F.lane;
#pragma unroll
        for (int j = 0; j < 4; ++j) { v[j] = v[j] * rstd * gv[j] + bv[j]; if (final_out) hr[64 * j] = v[j]; v2u w; w.x = pk2(v[j].x, v[j].y); w.y = pk2(v[j].z, v[j].w); o8[64 * j] = w; }
        if (Q8) { float am = 0.f;
#pragma unroll
            for (int j = 0; j < 4; ++j) { const f32x4 a = __builtin_elementwise_abs(v[j]); am = fmaxf(am, fmaxf(fmaxf(a.x, a.y), fmaxf(a.z, a.w))); }
            am = wave_max(am); const float inv = am > 0.f ? 127.f / am : 0.f;
            GAS unsigned* q8 = (GAS unsigned*)(WSP(unsigned char, DRY ? WS_DOUT + 32 * MiB : WS_H8) + (size_t)m * D) + F.lane;
#pragma unroll
            for (int j = 0; j < 4; ++j) q8[64 * j] = pack_i8(v[j].x * inv, v[j].y * inv, v[j].z * inv, v[j].w * inv);
            if (F.lane == 0) WSP(float, DRY ? WS_DOUT + 48 * MiB : WS_RS)[m] = am * (1.f / 127.f); }
        if (ROUTE) {
            float lg[8];
#pragma unroll
            for (int e = 0; e < 8; ++e) { float a = 0.f;
#pragma unroll
                for (int j = 0; j < 4; ++j) { const f32x4 r = *(const LAS f32x4*)(RT + e * D + 4 * (F.lane + 64 * j)); a += (v[j].x * r.x + v[j].y * r.y) + (v[j].z * r.z + v[j].w * r.w); }
                lg[e] = wave_sum(a); }
            int e1 = 0; float l1 = lg[0];
#pragma unroll
            for (int e = 1; e < 8; ++e) if (lg[e] > l1) { l1 = lg[e]; e1 = e; }
            int e2 = -1; float l2 = -3.0e38f;
#pragma unroll
            for (int e = 0; e < 8; ++e) if (e != e1 && lg[e] > l2) { l2 = lg[e]; e2 = e; }
            if (F.lane == 0) {
                const float p2 = __expf(l2 - l1); const float ga = 1.f / (1.f + p2);
                GATE[2 * m] = ga; GATE[2 * m + 1] = p2 * ga;
                int* list = WSP(int, WS_LIST) + (size_t)mi * NE * TOK;
                const unsigned p1 = __hip_atomic_fetch_add((unsigned*)(F.ctl + CW_CNT + (mi * 8 + e1) * 64), 1u, RLX_AGENT); list[e1 * TOK + p1] = 2 * m;
                const unsigned q2 = __hip_atomic_fetch_add((unsigned*)(F.ctl + CW_CNT + (mi * 8 + e2) * 64), 1u, RLX_AGENT); list[e2 * TOK + q2] = 2 * m + 1;
            }
        }
        cur = nxt;
    }
}
__device__ __forceinline__ void phase_gather(Frame& F, int mi) {
    int cnt[8], poff[9]; poff[0] = 0;
    unsigned* cb_ = (unsigned*)(F.ctl + CW_CNT + mi * 8 * 64); asm volatile("" : "+s"(cb_));
#pragma unroll
    for (int e = 0; e < 8; ++e) { cnt[e] = (int)__hip_atomic_load(cb_ + e * 64, RLX_AGENT); poff[e + 1] = poff[e] + ((cnt[e] + 255) >> 8); }
    const int npan = poff[8];
    int* tab = WSP(int, WS_TAB) + mi * TAB_STRIDE;
    if (blockIdx.x == 0) {
        for (int P = F.tid; P < npan; P += NWAVES * 64) { int e = 0, pe = 0, ce = cnt[0];
#pragma unroll
            for (int j = 1; j < 8; ++j) if (P >= poff[j]) { e = j; pe = poff[j]; ce = cnt[j]; }
            tab[4 * P] = e; tab[4 * P + 1] = 256 * (P - pe); tab[4 * P + 2] = ce; tab[4 * P + 3] = 0; }
        if (F.tid == 0) tab[640] = npan;
    }
    const int gw = F.vcu * NWAVES + F.wave, NGW = F.G * NWAVES;
    const int* list = WSP(const int, WS_LIST) + (size_t)mi * NE * TOK; const bf16* hb = WSP(const bf16, WS_HB); bf16* HP = WSP(bf16, WS_HPERM);
    for (int row = gw; row < 256 * npan; row += NGW) { const int P = row >> 8; int e = 0, pe = 0, ce = cnt[0];
#pragma unroll
        for (int j = 1; j < 8; ++j) if (P >= poff[j]) { e = j; pe = poff[j]; ce = cnt[j]; }
        const int r = row - 256 * pe; const int tok = (r < ce) ? (list[e * TOK + r] >> 1) : 0;
        const GAS v4u* s = (const GAS v4u*)(hb + (size_t)tok * D) + F.lane; GAS v4u* d = (GAS v4u*)(HP + (size_t)row * D) + F.lane; d[0] = s[0]; d[64] = s[64]; }
}
struct Args { const void* in[36]; int ph_lo, ph_hi; };
__global__ void __launch_bounds__(NWAVES * 64, 2) mk_fwd(Args args) {
    extern __shared__ __attribute__((aligned(16))) unsigned char lds[];
    Frame F;
    F.lds = (LAS unsigned char*)lds;
    F.MISC = (volatile LAS unsigned*)(F.lds + MISC_OFF);
    F.tid = threadIdx.x; F.lane = F.tid & 63; F.wave = __builtin_amdgcn_readfirstlane(F.tid >> 6);
    const int wave_k = F.wave;
    F.G = gridDim.x; { const int bx = blockIdx.x; F.vcu = (F.G % 8 == 0) ? (bx % 8) * (F.G / 8) + bx / 8 : bx; }
    F.in = args.in; F.ws = (unsigned char*)ldptr(F.in, 35); F.h = (float*)ldptr(F.in, 34);
    F.ctl = (gu32*)(F.ws + WS_CTL);
    for (int u = F.tid; u < (LDS_BYTES - LDSCTL_OFF) / 4; u += NWAVES * 64) ((LAS unsigned*)(F.lds + LDSCTL_OFF))[u] = 0u;
    __syncthreads();
    XcdBarrier bar; bar.bar = (unsigned*)(F.ctl + CW_BAR); bar.x = 0; bar.st = nullptr; bar.wv = 0;
    if (!MK_PER_PHASE) bar = xcd_barrier_post((unsigned*)(F.ctl + CW_BAR), F.MISC + 8);
    const int lo = args.ph_lo, hi = args.ph_hi;
#define IN(k) (lo <= (k) && (k) < hi)
#define PHASE_BEGIN() do { int t_ = wave_k * 64 + lane_id_now(); asm volatile("" : "+v"(t_)); F.tid = t_; F.lane = t_ & 63; F.wave = wave_k; \
        F.ws = (unsigned char*)ldptr(F.in, 35); F.ctl = (gu32*)(F.ws + WS_CTL); F.h = (float*)ldptr(F.in, 34); } while (0)
#define SEAM(k) do { if (IN(k) && IN((k) + 1)) { xcd_barrier(bar); if (DUPMASK & 4096) xcd_barrier(bar); } } while (0)
    for (int l = 0; l < DEPTH; ++l) {
        const int pb = l * NPH; const bool moe = (l & 1); const int mi = l >> 1;
#define PH(k) (((PHMASK >> (k)) & 1) && IN(pb + (k)))
        if (l == 0) { if (PH(0)) { PHASE_BEGIN(); phase_weights<0>(F, 0); } SEAM(pb + 0); }
        if (PH(1)) for (int rep_ = 0; rep_ < ((((DUPMASK >> 1) & 1) && ((DUPL >> l) & 1)) ? 2 : 1); ++rep_) { PHASE_BEGIN(); if (rep_) __syncthreads();
            pg8::Gemm g{WSP(const bf16, WS_HB), WSP(const bf16, WS_WIN), TOK, NP, D}; pg8::StaticOrder S; S.init(TOK, NP, F.G, (int)blockIdx.x);
            pg8::EpiBf16 E{WSP(bf16, WS_P), NP};
            pg8::gemm_phase<pg8::EpiBf16, pg8::StaticOrder, true, true>(F.lds, g, S, E, F.wave);
        } SEAM(pb + 1);
        if (PH(3)) { PHASE_BEGIN(); phase_chunkpre(F, l); if (DUPMASK & 8) { __syncthreads(); phase_chunkpre(F, l); } } SEAM(pb + 3);
        if (PH(4)) { PHASE_BEGIN(); phase_seq(F, l); if (DUPMASK & 16) { __syncthreads(); phase_seq(F, l); }
            if (((int)blockIdx.x >= 112 || F.G <= 112)) { const int sv = F.vcu, sg = F.G; if (sg > 112) { F.vcu = (int)blockIdx.x - 112; F.G = sg - 112; } phase_absmax(F, l); if ((DUPMASK & 8192) && ((DUPL >> l) & 1)) phase_absmax(F, l); F.vcu = sv; F.G = sg; }
            if (l + 1 < DEPTH && (int)blockIdx.x >= 112 && F.G > 112) { const int sv = F.vcu, sg = F.G; F.vcu = (int)blockIdx.x - 112; F.G = sg - 112; phase_weights<0>(F, l + 1); F.vcu = sv; F.G = sg; }
        } SEAM(pb + 4);
        if (PH(5)) { PHASE_BEGIN(); phase_post(F, l); __syncthreads(); if ((DUPMASK & 16384) && ((DUPL >> l) & 1)) { phase_post(F, l); __syncthreads(); } phase_weights<1>(F, l); if (DUPMASK & 32) { __syncthreads(); phase_weights<1>(F, l); } } SEAM(pb + 5);
        if (PH(6)) for (int rep_ = 0; rep_ < ((((DUPMASK >> 6) & 1) && ((DUPL >> l) & 1)) ? 2 : 1); ++rep_) { PHASE_BEGIN(); if (rep_) __syncthreads();
            pg8::Gemm g{WSP(const bf16, WS_Y), WSP(const bf16, (l & 1) ? WS_WOUT2 : WS_WOUT), TOK, D, D}; pg8::StaticOrder S; S.init(TOK, D, F.G, (int)blockIdx.x);
            pg8::EpiBf16 E{WSP(bf16, WS_MIX), D};
            pg8::gemm_phase<pg8::EpiBf16, pg8::StaticOrder, false, true>(F.lds, g, S, E, F.wave);
        } SEAM(pb + 6);
        if (PH(7)) { PHASE_BEGIN();
            if ((DUPMASK & 128) && ((DUPL >> l) & 1)) { phase_ln<0, false, true, 1>(F, INF(4) + l * D, INF(5) + l * D, nullptr, 0); __syncthreads(); }
            if (moe) phase_ln<0, true, true>(F, INF(4) + l * D, INF(5) + l * D, INF(30) + (size_t)mi * D * NE, mi);
            else phase_ln<0, false, true>(F, INF(4) + l * D, INF(5) + l * D, nullptr, 0);
        } SEAM(pb + 7);
        if (PH(9)) for (int rep_ = 0; rep_ < ((((DUPMASK >> 9) & 1) && ((DUPL >> l) & 1)) ? 2 : 1); ++rep_) { PHASE_BEGIN(); if (rep_) __syncthreads();
            if (STAG9 > 0 && (((int)blockIdx.x >> 3) & 1)) { const unsigned long long t0_ = __builtin_amdgcn_s_memrealtime(); while (__builtin_amdgcn_s_memrealtime() - t0_ < (unsigned long long)STAG9) __builtin_amdgcn_s_sleep(8); }
            if (!moe) { pg8::Gemm g{WSP(const bf16, WS_H8), WSP(const bf16, WS_WUP), TOK, 2 * FFD, D / 2}; pg8::StaticOrder S; S.init(TOK, 2 * FFD, F.G, (int)blockIdx.x);
                pg8::EpiSwiGLU8<false> E{WSP(unsigned char, WS_HID), FFD, 22, WSP(const float, WS_RS), __uint_as_float(__hip_atomic_load((unsigned*)(F.ctl + CW_AMAX + l * 64), RLX_AGENT)) * (1.f / 127.f), pg8::MoeMap{}};
                pg8::gemm_phase<pg8::EpiSwiGLU8<false>, pg8::StaticOrder, true, true, 1>(F.lds, g, S, E, F.wave);
            } else { pg8::MoeOrder<true> S; S.M.init((const unsigned*)(F.ctl + CW_CNT + mi * 8 * 64), WSP(const int, WS_LIST) + (size_t)mi * NE * TOK); const int npan = S.M.poff[8];
                S.tpg = 11; S.G = F.G; S.c = (int)blockIdx.x; S.nunits = npan * 11; S.rowbytes = D;
                pg8::Gemm g{WSP(const bf16, WS_H8), WSP(const bf16, WS_WUP), 256 * npan, 2 * FFE, D / 2};
                pg8::EpiSwiGLU8<true> E{WSP(unsigned char, WS_HID), FFEP, 11, WSP(const float, WS_RS), __uint_as_float(__hip_atomic_load((unsigned*)(F.ctl + CW_AMAX + l * 64), RLX_AGENT)) * (1.f / 127.f), S.M};
                pg8::gemm_phase<pg8::EpiSwiGLU8<true>, pg8::MoeOrder<true>, true, true, 1>(F.lds, g, S, E, F.wave);
            }
        } SEAM(pb + 9);
        if (PH(10)) for (int rep_ = 0; rep_ < ((((DUPMASK >> 10) & 1) && ((DUPL >> l) & 1)) ? 2 : 1); ++rep_) { PHASE_BEGIN(); if (rep_) __syncthreads();
            float qsd_, invd; f8_scale(__uint_as_float(__hip_atomic_load((unsigned*)(F.ctl + CW_AMAXD + l * 64), RLX_AGENT)), qsd_, invd);
            if (!moe) { pg8::Gemm g{WSP(const bf16, WS_HID), WSP(const bf16, WS_WDN), TOK, D, FFD / 2}; pg8::StaticOrder S; S.init(TOK, D, F.G, (int)blockIdx.x);
                pg8::EpiBf16S E{WSP(bf16, WS_MIX), D, invd};
                pg8::gemm_phase<pg8::EpiBf16S, pg8::StaticOrder, false, true, 2>(F.lds, g, S, E, F.wave);
            } else { pg8::MoeOrder<false> S; S.M.init((const unsigned*)(F.ctl + CW_CNT + mi * 8 * 64), WSP(const int, WS_LIST) + (size_t)mi * NE * TOK); const int npan = S.M.poff[8];
                S.tpg = 4; S.G = F.G; S.c = (int)blockIdx.x; S.nunits = npan * 4; S.rowbytes = 0;
                pg8::Gemm g{WSP(const bf16, WS_HID), WSP(const bf16, WS_WDN), 256 * npan, D, FFEP / 2};
                pg8::EpiScatter E{WSP(bf16, WS_DOUT), S.M, invd};
                pg8::gemm_phase<pg8::EpiScatter, pg8::MoeOrder<false>, true, true, 2>(F.lds, g, S, E, F.wave);
            }
        } SEAM(pb + 10);
        if (PH(11)) { PHASE_BEGIN();
            if ((DUPMASK & 2048) && ((DUPL >> l) & 1)) { if (moe) phase_ln<1, false, false, 2>(F, INF(6) + l * D, INF(7) + l * D, nullptr, 0); else phase_ln<0, false, false, 2>(F, INF(6) + l * D, INF(7) + l * D, nullptr, 0); __syncthreads(); }
            if (moe) phase_ln<1, false>(F, INF(6) + l * D, INF(7) + l * D, nullptr, 0, l == DEPTH - 1);
            else phase_ln<0, false>(F, INF(6) + l * D, INF(7) + l * D, nullptr, 0, l == DEPTH - 1);
            if (l + 1 < DEPTH && F.G <= 112) { __syncthreads(); phase_weights<0>(F, l + 1); }
        } SEAM(pb + 11);
#undef PH
    }
#undef IN
#undef SEAM
}

extern "C" void kernel_launch(void* const* d_in, const int* in_sizes, int n_in, void* d_out, int out_size, void* d_ws, size_t ws_size, hipStream_t stream) {
    static int grid = 0;
    if (grid == 0) {
        if (n_in != 34 || out_size != TOK * D || ws_size < WS_END) { fprintf(stderr, "kernel_launch: unexpected shapes (n_in %d, out %d, ws %zu)\n", n_in, out_size, ws_size); grid = -1; return; }
        int dev = 0, cus = 0, per_cu = 0;
        if (hipGetDevice(&dev) != hipSuccess || hipDeviceGetAttribute(&cus, hipDeviceAttributeMultiprocessorCount, dev) != hipSuccess) { grid = -1; return; }
        if (hipFuncSetAttribute((const void*)mk_fwd, hipFuncAttributeMaxDynamicSharedMemorySize, LDS_BYTES) != hipSuccess) { fprintf(stderr, "kernel_launch: hipFuncSetAttribute failed\n"); grid = -1; return; }
        if (hipOccupancyMaxActiveBlocksPerMultiprocessor(&per_cu, (const void*)mk_fwd, NWAVES * 64, LDS_BYTES) != hipSuccess || per_cu < 1) fprintf(stderr, "kernel_launch: occupancy query reports %d\n", per_cu);
        (void)hipGetLastError();
        grid = cus;
    }
    if (grid < 0) return;
    if (hipMemsetAsync((char*)d_ws + WS_CTL, 0, CTL_ZERO_BYTES, stream) != hipSuccess) return;
    Args a{};
    for (int i = 0; i < 34; ++i) a.in[i] = d_in[i];
    a.in[34] = d_out; a.in[35] = d_ws;
#if MK_PER_PHASE
    for (int p = 0; p < NPHASES; ++p) { a.ph_lo = p; a.ph_hi = p + 1; hipLaunchKernelGGL(mk_fwd, dim3(grid), dim3(NWAVES * 64), LDS_BYTES, stream, a); }
#else
    a.ph_lo = 0; a.ph_hi = NPHASES; hipLaunchKernelGGL(mk_fwd, dim3(grid), dim3(NWAVES * 64), LDS_BYTES, stream, a);
#endif
}
```

```cpp
#include <hip/hip_runtime.h>
#include <cstdio>
#include <cstdint>
#ifndef PHMASK
#define PHMASK 0xfff
#endif
#ifndef DUPMASK
#define DUPMASK 0
#endif
#ifndef DUPL
#define DUPL 0xf
#endif
#ifndef STAG9
#define STAG9 0
#endif
#ifndef MK_PER_PHASE
#define MK_PER_PHASE 0
#endif
__device__ __forceinline__ int lane_id_now() { unsigned m_ = ~0u; asm volatile("" : "+s"(m_)); return (int)__builtin_amdgcn_mbcnt_hi(m_, __builtin_amdgcn_mbcnt_lo(m_, 0u)); }
namespace pg8 {
#define PG8_LAS __attribute__((address_space(3)))
typedef unsigned short bf16_t;
typedef short bf16x8 __attribute__((ext_vector_type(8)));
typedef float f32x4 __attribute__((ext_vector_type(4)));
typedef unsigned u32x4 __attribute__((ext_vector_type(4)));
constexpr int BM = 256, BK = 64, HALF = 128, HTB = HALF * BK * 2  , STAGE_BYTES = 8 * HTB, NXCD = 8, WGM = 8;

__host__ __device__ __forceinline__ int lds_byte(int r, int c) { const int st = (r >> 4) * 2 + (c >> 5), rr = r & 15, cc = c & 31, ob = rr * 64 + cc * 2; return st * 1024 + (ob ^ (((ob >> 9) & 1) << 5)); }
__host__ __device__ __forceinline__ void stage_rc(int b, int& R, int& C) { const int st = b / 1024, sb = b % 1024, swz = sb ^ (((sb >> 9) & 1) << 5); R = (st >> 1) * 16 + swz / 64; C = (st & 1) * 32 + (swz % 64) / 2; }
__host__ __device__ __forceinline__ int perm32(int rho) { const int n = rho >> 4, i = rho & 15; return 8 * (i >> 2) + 4 * n + (i & 3); }

struct Unit { int pm, pn; };
struct Gemm { const bf16_t* A; const bf16_t* Bt; int M, N, K; };

struct StaticOrder {
    static constexpr bool GATHER = false;
    int nM, nN, nwg, G, c;
    __device__ __forceinline__ unsigned a_off(const Unit&, int) const { return 0u; }
    __host__ __device__ void init(int M, int N, int G_, int c_) { nM = M / BM; nN = N / BM; nwg = nM * nN; G = G_; c = c_; }
    __host__ __device__ bool next(int i, Unit& u) const {
        const long L = (long)i * G + c; if (L >= nwg) return false;
        int wgid = (int)L; { const int q = nwg / NXCD, r = nwg % NXCD, xcd = wgid % NXCD, off = wgid / NXCD; wgid = (xcd < r ? xcd * (q + 1) : r * (q + 1) + (xcd - r) * q) + off; }
        const int nig = WGM * nN, gid = wgid / nig, fm = gid * WGM, gsz = (nM - fm) < WGM ? (nM - fm) : WGM;
        u.pm = fm + ((wgid % nig) % gsz); u.pn = (wgid % nig) / gsz; return true;
    }
    __device__ __forceinline__ void a_ready(const Unit&) const {}
    __device__ __forceinline__ void done(const Unit&) const {}
};
__device__ __forceinline__ unsigned cvt_pk_bf16(float lo, float hi) { unsigned r; asm volatile("v_cvt_pk_bf16_f32 %0, %1, %2" : "=v"(r) : "v"(lo), "v"(hi)); return r; }
typedef float f32x2 __attribute__((ext_vector_type(2)));
struct EpiBf16 {
    static constexpr bool PERM = true, AFTER_DRAIN = false;
    bf16_t* O; int ldc;
    __device__ __forceinline__ void operator()(const f32x4 (&acc)[2][2][4][2], const Unit& u, int wr, int wc, int fr, int fq) const {
        const int row0 = u.pm * BM + wr * 64 + fr; const int col0 = u.pn * BM + wc * 32 + 8 * fq;
#pragma unroll
        for (int ai = 0; ai < 2; ++ai)
#pragma unroll
            for (int m = 0; m < 4; ++m) { bf16_t* rowp = O + (size_t)(row0 + ai * HALF + m * 16) * ldc + col0;
#pragma unroll
                for (int bj = 0; bj < 2; ++bj) { const f32x4 v0 = acc[ai][bj][m][0], v1 = acc[ai][bj][m][1];
                    u32x4 w; w.x = cvt_pk_bf16(v0[0], v0[1]); w.y = cvt_pk_bf16(v0[2], v0[3]); w.z = cvt_pk_bf16(v1[0], v1[1]); w.w = cvt_pk_bf16(v1[2], v1[3]);
                    *(u32x4*)(rowp + bj * HALF) = w; } }
    }
};
struct EpiBf16S {
    static constexpr bool PERM = true, AFTER_DRAIN = false;
    bf16_t* O; int ldc; float sc;
    __device__ __forceinline__ void operator()(const f32x4 (&acc)[2][2][4][2], const Unit& u, int wr, int wc, int fr, int fq) const {
        const int row0 = u.pm * BM + wr * 64 + fr; const int col0 = u.pn * BM + wc * 32 + 8 * fq;
#pragma unroll
        for (int ai = 0; ai < 2; ++ai)
#pragma unroll
            for (int m = 0; m < 4; ++m) { bf16_t* rowp = O + (size_t)(row0 + ai * HALF + m * 16) * ldc + col0;
#pragma unroll
                for (int bj = 0; bj < 2; ++bj) { const f32x4 v0 = acc[ai][bj][m][0] * sc, v1 = acc[ai][bj][m][1] * sc;
                    u32x4 w; w.x = cvt_pk_bf16(v0[0], v0[1]); w.y = cvt_pk_bf16(v0[2], v0[3]); w.z = cvt_pk_bf16(v1[0], v1[1]); w.w = cvt_pk_bf16(v1[2], v1[3]);
                    *(u32x4*)(rowp + bj * HALF) = w; } }
    }
};
struct EpiF32 {
    static constexpr bool PERM = false, AFTER_DRAIN = false;
    float* C; int ldc;
    __device__ __forceinline__ void operator()(const f32x4 (&acc)[2][2][4][2], const Unit& u, int wr, int wc, int fr, int fq) const {
        const int row0 = u.pm * BM + wr * 64 + fr, col0 = u.pn * BM + wc * 32 + 4 * fq;
#pragma unroll
        for (int ai = 0; ai < 2; ++ai)
#pragma unroll
            for (int m = 0; m < 4; ++m) { float* rowp = C + (size_t)(row0 + ai * HALF + m * 16) * ldc + col0;
#pragma unroll
                for (int bj = 0; bj < 2; ++bj)
#pragma unroll
                    for (int n = 0; n < 2; ++n) *(f32x4*)(rowp + bj * HALF + n * 16) = acc[ai][bj][m][n]; }
    }
};
__device__ __forceinline__ float silu_f(float x) { return x * __builtin_amdgcn_rcpf(1.0f + __expf(-x)); }
struct EpiSwiGLU {
    static constexpr bool PERM = true, AFTER_DRAIN = false;
    bf16_t* O; int ldc; int tiles_per_group;
    __device__ __forceinline__ void operator()(const f32x4 (&acc)[2][2][4][2], const Unit& u, int wr, int wc, int fr, int fq) const {
        const int row0 = u.pm * BM + wr * 64 + fr; const int pnl = u.pn % tiles_per_group; const int col0 = pnl * HALF + wc * 32 + 8 * fq;
#pragma unroll
        for (int ai = 0; ai < 2; ++ai)
#pragma unroll
            for (int m = 0; m < 4; ++m) { bf16_t* rowp = O + (size_t)(row0 + ai * HALF + m * 16) * ldc + col0;
                float h[8];
#pragma unroll
                for (int n = 0; n < 2; ++n)
#pragma unroll
                    for (int j = 0; j < 4; ++j) h[4 * n + j] = silu_f(acc[ai][0][m][n][j]) * acc[ai][1][m][n][j];
                u32x4 w; w.x = cvt_pk_bf16(h[0], h[1]); w.y = cvt_pk_bf16(h[2], h[3]); w.z = cvt_pk_bf16(h[4], h[5]); w.w = cvt_pk_bf16(h[6], h[7]);
                *(u32x4*)rowp = w; }
    }
};
struct MoeMap {
    int cnt[8], poff[9]; const int* list;
    __device__ __forceinline__ void init(const unsigned* counters, const int* list_) { list = list_; poff[0] = 0;
#pragma unroll
        for (int e = 0; e < 8; ++e) { cnt[e] = __builtin_amdgcn_readfirstlane((int)__hip_atomic_load(counters + e * 64, __ATOMIC_RELAXED, __HIP_MEMORY_SCOPE_AGENT));     poff[e + 1] = poff[e] + ((cnt[e] + 255) >> 8); } }
    __device__ __forceinline__ void locate(int P, int& e, int& lr, int& ce) const { e = 0; int pe = 0; ce = cnt[0];
#pragma unroll
        for (int j = 1; j < 8; ++j) if (P >= poff[j]) { e = j; pe = poff[j]; ce = cnt[j]; }
        lr = 256 * (P - pe); }
};
template <bool MOE> struct EpiSwiGLU8 {
    static constexpr bool PERM = true, AFTER_DRAIN = false;
    unsigned char* O; int ldc; int tiles_per_group; const float* rs; float sw; MoeMap M;
    __device__ __forceinline__ void operator()(const f32x4 (&acc)[2][2][4][2], const Unit& u, int wr, int wc, int fr, int fq) const {
        const int row0 = u.pm * BM + wr * 64 + fr; const int pnl = u.pn % tiles_per_group; const int col0 = pnl * HALF + wc * 32 + 8 * fq;
        float sc[2][4];
        if constexpr (MOE) { int e, lr, ce; M.locate(u.pm, e, lr, ce); const int* lst = M.list + e * 16384;
#pragma unroll
            for (int ai = 0; ai < 2; ++ai)
#pragma unroll
                for (int m = 0; m < 4; ++m) { const int r = lr + wr * 64 + fr + ai * HALF + m * 16; sc[ai][m] = rs[(r < ce) ? (lst[r] >> 1) : 0] * sw; }
        } else {
#pragma unroll
            for (int ai = 0; ai < 2; ++ai)
#pragma unroll
                for (int m = 0; m < 4; ++m) sc[ai][m] = rs[row0 + ai * HALF + m * 16] * sw;
        }
#pragma unroll
        for (int ai = 0; ai < 2; ++ai)
#pragma unroll
            for (int m = 0; m < 4; ++m) { unsigned char* rowp = O + (size_t)(row0 + ai * HALF + m * 16) * ldc + col0;
                float h[8];
#pragma unroll
                for (int n = 0; n < 2; ++n)
#pragma unroll
                    for (int j = 0; j < 4; ++j) { const float ag = acc[ai][0][m][n][j], au = acc[ai][1][m][n][j]; const float g = (float)__float_as_int(ag) * sc[ai][m], up = (float)__float_as_int(au) * sc[ai][m]; h[4 * n + j] = __builtin_fminf(__builtin_fmaxf(silu_f(g) * up, -448.f), 448.f); }
                unsigned w0 = 0u, w1 = 0u; w0 = __builtin_amdgcn_cvt_pk_fp8_f32(h[0], h[1], w0, false); w0 = __builtin_amdgcn_cvt_pk_fp8_f32(h[2], h[3], w0, true); w1 = __builtin_amdgcn_cvt_pk_fp8_f32(h[4], h[5], w1, false); w1 = __builtin_amdgcn_cvt_pk_fp8_f32(h[6], h[7], w1, true);
                typedef unsigned u32x2_ __attribute__((ext_vector_type(2))); u32x2_ w; w.x = w0; w.y = w1; *(u32x2_*)rowp = w;
                if (MOE && pnl == tiles_per_group - 1) { u32x2_ z; z.x = 0u; z.y = 0u; *(u32x2_*)(rowp + HALF) = z; } }
    }
};
struct EpiScatter {
    static constexpr bool PERM = true, AFTER_DRAIN = false;
    bf16_t* O; MoeMap M; float sc;
    __device__ __forceinline__ void operator()(const f32x4 (&acc)[2][2][4][2], const Unit& u, int wr, int wc, int fr, int fq) const {
        int e, lr, cnt; M.locate(u.pm, e, lr, cnt);
        const int pnl = u.pn & 3; const int col0 = pnl * BM + wc * 32 + 8 * fq; const int* lst = M.list + e * 16384;
#pragma unroll
        for (int ai = 0; ai < 2; ++ai)
#pragma unroll
            for (int m = 0; m < 4; ++m) { const int r = lr + wr * 64 + fr + ai * HALF + m * 16;
                if (r < cnt) { const int slot = lst[r]; bf16_t* rowp = O + (size_t)slot * 1024 + col0;
#pragma unroll
                    for (int bj = 0; bj < 2; ++bj) { const f32x4 v0 = acc[ai][bj][m][0] * sc, v1 = acc[ai][bj][m][1] * sc;
                        u32x4 w; w.x = cvt_pk_bf16(v0[0], v0[1]); w.y = cvt_pk_bf16(v0[2], v0[3]); w.z = cvt_pk_bf16(v1[0], v1[1]); w.w = cvt_pk_bf16(v1[2], v1[3]);
                        *(u32x4*)(rowp + bj * HALF) = w; } } }
    }
};
template <bool GATHER_> struct MoeOrder {
    static constexpr bool GATHER = GATHER_;
    MoeMap M; int tpg, G, c, nunits; unsigned rowbytes;
    __device__ __forceinline__ bool next(int i, Unit& u) const {
        const int L = i * G + c; if (L >= nunits) return false;
        int wgid = L; { const int q = nunits / NXCD, r = nunits % NXCD, xcd = wgid % NXCD, off = wgid / NXCD; wgid = (xcd < r ? xcd * (q + 1) : r * (q + 1) + (xcd - r) * q) + off; }
        const int P = wgid / tpg, pnl = wgid - P * tpg; int e, lr, ce; M.locate(P, e, lr, ce);
        u.pm = P; u.pn = e * tpg + pnl; return true;
    }
    __device__ __forceinline__ unsigned a_off(const Unit& u, int row) const {
        int e, lr, ce; M.locate(u.pm, e, lr, ce); const int r = lr + row; const int tok = (r < ce) ? (M.list[e * 16384 + r] >> 1) : 0; return (unsigned)tok * rowbytes; }
    __device__ __forceinline__ void a_ready(const Unit&) const {}
    __device__ __forceinline__ void done(const Unit&) const {}
};
typedef int i32x4 __attribute__((ext_vector_type(4))); typedef int i32x8 __attribute__((ext_vector_type(8)));
template <class Epi, class Sched, bool ALIGN_EPI = false, bool SP2 = false, int MT = 0  >
__device__ __forceinline__ void gemm_phase(PG8_LAS unsigned char* lds, const Gemm g, const Sched& S, const Epi& E, const int wave_in) {
    int tid_ = wave_in * 64 + lane_id_now(); asm volatile("" : "+v"(tid_));
    const int tid = tid_, wid = __builtin_amdgcn_readfirstlane(tid >> 6), lane = tid & 63, wr = wid >> 2, wc = wid & 3, fr = lane & 15, fq = lane >> 4;
    const int K = g.K, nt = K / BK;
    unsigned voffA[2], voffB[2];
#pragma unroll
    for (int i = 0; i < 2; ++i) { int R, C; stage_rc(tid * 16 + i * 8192, R, C); const int Rb = Epi::PERM ? ((R & ~31) + perm32(R & 31)) : R;
        voffA[i] = (unsigned)(R * K + C) * 2u; voffB[i] = (unsigned)(Rb * K + C) * 2u; }
    static_assert(!Sched::GATHER || SP2, "A-row gather is implemented for the SP2 loop");
    unsigned aoc[2][2], aon[2][2];
#define PG8_GOFF(dst, u) do { _Pragma("unroll") for (int _i = 0; _i < 2; ++_i) { int R_, C_; stage_rc(tid * 16 + _i * 8192, R_, C_); _Pragma("unroll") for (int _h = 0; _h < 2; ++_h) dst[_h][_i] = S.a_off(u, _h * HALF + R_) + (unsigned)(C_ * 2); } } while (0)
#define PG8_STAGE_A(bufoff, gbase, kofs, h, nx) do { if constexpr (Sched::GATHER) { const unsigned vo_[2] = {(nx) ? aon[h][0] : aoc[h][0], (nx) ? aon[h][1] : aoc[h][1]}; PG8_STAGE(bufoff, (const char*)g.A + (kofs), vo_); } else { PG8_STAGE(bufoff, gbase, voffA); } } while (0)
    const size_t kstep = (size_t)(BK * 2);
    const size_t hstep = (size_t)HALF * K * 2;
    const size_t tstep = 2 * hstep;
    const unsigned ldsw = (unsigned)wid * 1024u;
    const int aoff = lds_byte(wr * 64 + fr, fq * 8), boff = lds_byte(wc * 32 + fr, fq * 8);
#define PG8_SA(b, h) (((b) * 2 + (h)) * HTB)
#define PG8_SB(b, h) ((4 + (b) * 2 + (h)) * HTB)
#define PG8_STAGE(bufoff, gbase, voff) do { _Pragma("unroll") for (int _i = 0; _i < 2; ++_i) { unsigned o_ = (voff)[_i]; asm volatile("" : "+v"(o_));     \
        __builtin_amdgcn_global_load_lds((const unsigned*)((const char*)(gbase) + o_), (PG8_LAS unsigned*)(lds + (bufoff) + ldsw + _i * 8192), 16, 0, 0); } } while (0)
#define PG8_LDA(dst, b, h) do { _Pragma("unroll") for (int m = 0; m < 4; ++m) _Pragma("unroll") for (int k = 0; k < 2; ++k) dst[m][k] = *(const PG8_LAS bf16x8*)(lds + PG8_SA(b, h) + aoff + m * 2048 + k * 1024); } while (0)
#define PG8_LDB(dst, b, h) do { _Pragma("unroll") for (int n = 0; n < 2; ++n) _Pragma("unroll") for (int k = 0; k < 2; ++k) dst[n][k] = *(const PG8_LAS bf16x8*)(lds + PG8_SB(b, h) + boff + n * 2048 + k * 1024); } while (0)
#define PG8_MMA(ai, bj, At, Bt) do { __builtin_amdgcn_s_setprio(1); _Pragma("unroll") for (int m = 0; m < 4; ++m) _Pragma("unroll") for (int n = 0; n < 2; ++n) _Pragma("unroll") for (int k = 0; k < 2; ++k) \
        { if constexpr (MT == 0) acc[ai][bj][m][n] = __builtin_amdgcn_mfma_f32_16x16x32_bf16(Bt[n][k], At[m][k], acc[ai][bj][m][n], 0, 0, 0); \
          else if constexpr (MT == 1) acc[ai][bj][m][n] = __builtin_bit_cast(f32x4, __builtin_amdgcn_mfma_i32_16x16x64_i8(__builtin_bit_cast(i32x4, Bt[n][k]), __builtin_bit_cast(i32x4, At[m][k]), __builtin_bit_cast(i32x4, acc[ai][bj][m][n]), 0, 0, 0)); \
          else { if (k == 0) { const i32x8 b8_ = __builtin_shufflevector(__builtin_bit_cast(i32x4, Bt[n][0]), __builtin_bit_cast(i32x4, Bt[n][1]), 0, 1, 2, 3, 4, 5, 6, 7), a8_ = __builtin_shufflevector(__builtin_bit_cast(i32x4, At[m][0]), __builtin_bit_cast(i32x4, At[m][1]), 0, 1, 2, 3, 4, 5, 6, 7); \
              asm volatile("v_mfma_f32_16x16x128_f8f6f4 %0, %1, %2, %0" : "+v"(acc[ai][bj][m][n]) : "v"(b8_), "v"(a8_)); } } }     \
        __builtin_amdgcn_s_setprio(0); } while (0)
#define PG8_WAIT_V(n) asm volatile("s_waitcnt vmcnt(" #n ")" ::: "memory")
#define PG8_WAIT_L(n) asm volatile("s_waitcnt lgkmcnt(" #n ")" ::: "memory")
#define PG8_BAR __builtin_amdgcn_s_barrier()
#define PG8_SCHED __builtin_amdgcn_sched_barrier(0)
    Unit cur, nxt; int ui = 0;
    if (!S.next(0, cur)) return;
    f32x4 acc[2][2][4][2];
#pragma unroll
    for (int a = 0; a < 2; ++a)
#pragma unroll
        for (int b = 0; b < 2; ++b)
#pragma unroll
            for (int m = 0; m < 4; ++m)
#pragma unroll
                for (int n = 0; n < 2; ++n) acc[a][b][m][n] = (f32x4){0.f, 0.f, 0.f, 0.f};
    bf16x8 At[4][2], B0[2][2], B1[2][2];
    const char* cA = (const char*)g.A + (size_t)cur.pm * tstep; const char* cB = (const char*)g.Bt + (size_t)cur.pn * tstep;
    S.a_ready(cur);
    if constexpr (SP2) {
        if constexpr (Sched::GATHER) { PG8_GOFF(aoc, cur); }
        PG8_STAGE(PG8_SB(0, 0), cB, voffB); PG8_STAGE(PG8_SB(0, 1), cB + hstep, voffB); PG8_STAGE_A(PG8_SA(0, 0), cA, (size_t)0, 0, false); PG8_STAGE_A(PG8_SA(0, 1), cA + hstep, (size_t)0, 1, false);
        if (wr == 1) PG8_BAR;
        PG8_WAIT_V(2); PG8_BAR;
        PG8_STAGE(PG8_SB(1, 0), cB + kstep, voffB); PG8_STAGE_A(PG8_SA(1, 0), cA + kstep, kstep, 0, false); PG8_STAGE(PG8_SB(1, 1), cB + hstep + kstep, voffB);
        PG8_WAIT_V(6); PG8_BAR;
    } else {
        PG8_STAGE(PG8_SB(0, 0), cB, voffB); PG8_STAGE(PG8_SA(0, 0), cA, voffA); PG8_STAGE(PG8_SB(0, 1), cB + hstep, voffB); PG8_STAGE(PG8_SA(0, 1), cA + hstep, voffA);
        if (wr == 1) PG8_BAR;
        PG8_WAIT_V(4); PG8_BAR;
        PG8_STAGE(PG8_SB(1, 0), cB + kstep, voffB); PG8_STAGE(PG8_SA(1, 0), cA + kstep, voffA); PG8_STAGE(PG8_SB(1, 1), cB + hstep + kstep, voffB);
        PG8_WAIT_V(6); PG8_BAR;
    }
    for (;;) {
        const bool has_next = S.next(ui + 1, nxt);
        const char* nA = has_next ? (const char*)g.A + (size_t)nxt.pm * tstep : cA; const char* nB = has_next ? (const char*)g.Bt + (size_t)nxt.pn * tstep : cB;
        for (int t = 0; t < nt; t += 2) {
            const bool last = (t == nt - 2);
            const char* a1 = cA + (size_t)(t + 1) * kstep;
            const char* a2 = last ? nA : cA + (size_t)(t + 2) * kstep; const char* b2 = last ? nB : cB + (size_t)(t + 2) * kstep;
            const char* a3 = a2 + kstep; const char* b3 = b2 + kstep;
            if (last && has_next) S.a_ready(nxt);
            const size_t ko2 = last ? (size_t)0 : (size_t)(t + 2) * kstep;
            if constexpr (Sched::GATHER) { if (last) { if (has_next) { PG8_GOFF(aon, nxt); } else { _Pragma("unroll") for (int _h = 0; _h < 2; ++_h) { aon[_h][0] = aoc[_h][0]; aon[_h][1] = aoc[_h][1]; } } } }
            if constexpr (SP2) {
            PG8_LDB(B0, 0, 0); PG8_LDB(B1, 0, 1); PG8_SCHED; PG8_LDA(At, 0, 0); PG8_STAGE_A(PG8_SA(1, 1), a1 + hstep, (size_t)(t + 1) * kstep, 1, false);
            PG8_WAIT_V(8); PG8_WAIT_L(0); PG8_BAR; PG8_MMA(0, 0, At, B0); PG8_MMA(0, 1, At, B1); PG8_BAR; PG8_SCHED;
            PG8_LDA(At, 0, 1); PG8_STAGE(PG8_SB(0, 0), b2, voffB); PG8_STAGE(PG8_SB(0, 1), b2 + hstep, voffB); PG8_STAGE_A(PG8_SA(0, 0), a2, ko2, 0, last);
            PG8_WAIT_V(8); PG8_WAIT_L(0); PG8_BAR; PG8_MMA(1, 0, At, B0); PG8_MMA(1, 1, At, B1); PG8_BAR; PG8_SCHED;
            PG8_LDB(B0, 1, 0); PG8_LDB(B1, 1, 1); PG8_SCHED; PG8_LDA(At, 1, 0); PG8_STAGE_A(PG8_SA(0, 1), a2 + hstep, ko2, 1, last);
            PG8_WAIT_V(8); PG8_WAIT_L(0); PG8_BAR; PG8_MMA(0, 0, At, B0); PG8_MMA(0, 1, At, B1); PG8_BAR; PG8_SCHED;
            PG8_LDA(At, 1, 1); PG8_STAGE(PG8_SB(1, 0), b3, voffB); PG8_STAGE(PG8_SB(1, 1), b3 + hstep, voffB); PG8_STAGE_A(PG8_SA(1, 0), a3, ko2 + kstep, 0, last);
            PG8_WAIT_V(8); PG8_WAIT_L(0); PG8_BAR; PG8_MMA(1, 0, At, B0); PG8_MMA(1, 1, At, B1); PG8_BAR; PG8_SCHED;
            } else {
            PG8_LDB(B0, 0, 0); PG8_SCHED; PG8_LDA(At, 0, 0); PG8_STAGE(PG8_SA(1, 1), a1 + hstep, voffA);
            PG8_WAIT_L(8); PG8_BAR; PG8_WAIT_L(0); PG8_MMA(0, 0, At, B0); PG8_BAR; PG8_SCHED;
            PG8_LDB(B1, 0, 1); PG8_STAGE(PG8_SB(0, 0), b2, voffB);
            PG8_BAR; PG8_WAIT_L(0); PG8_MMA(0, 1, At, B1); PG8_BAR;
            PG8_LDA(At, 0, 1); PG8_STAGE(PG8_SA(0, 0), a2, voffA);
            PG8_BAR; PG8_WAIT_L(0); PG8_MMA(1, 0, At, B0); PG8_BAR; PG8_SCHED;
            PG8_STAGE(PG8_SB(0, 1), b2 + hstep, voffB);
            PG8_WAIT_V(6); PG8_BAR; PG8_MMA(1, 1, At, B1); PG8_BAR;
            PG8_LDB(B0, 1, 0); PG8_SCHED; PG8_LDA(At, 1, 0); PG8_STAGE(PG8_SA(0, 1), a2 + hstep, voffA);
            PG8_WAIT_L(8); PG8_BAR; PG8_WAIT_L(0); PG8_MMA(0, 0, At, B0); PG8_BAR; PG8_SCHED;
            PG8_LDB(B1, 1, 1); PG8_STAGE(PG8_SB(1, 0), b3, voffB);
            PG8_BAR; PG8_WAIT_L(0); PG8_MMA(0, 1, At, B1); PG8_BAR;
            PG8_LDA(At, 1, 1); PG8_STAGE(PG8_SA(1, 0), a3, voffA);
            PG8_BAR; PG8_WAIT_L(0); PG8_MMA(1, 0, At, B0); PG8_BAR; PG8_SCHED;
            PG8_STAGE(PG8_SB(1, 1), b3 + hstep, voffB);
            PG8_WAIT_V(6); PG8_BAR; PG8_MMA(1, 1, At, B1); PG8_BAR;
            }
        }
        if constexpr (MT == 2) { asm volatile("s_nop 15\n\ts_nop 15" ::: "memory"); }
        if constexpr (ALIGN_EPI) { if (wr == 0) PG8_BAR; }
        if constexpr (!Epi::AFTER_DRAIN) { E(acc, cur, wr, wc, fr, fq); S.done(cur); }
        if (!has_next) break;
#pragma unroll
        for (int a = 0; a < 2; ++a)
#pragma unroll
            for (int b = 0; b < 2; ++b)
#pragma unroll
                for (int m = 0; m < 4; ++m)
#pragma unroll
                    for (int n = 0; n < 2; ++n) acc[a][b][m][n] = (f32x4){0.f, 0.f, 0.f, 0.f};
        cur = nxt; cA = nA; cB = nB; ++ui;
        if constexpr (Sched::GATHER) { _Pragma("unroll") for (int _h = 0; _h < 2; ++_h) { aoc[_h][0] = aon[_h][0]; aoc[_h][1] = aon[_h][1]; } }
        if constexpr (ALIGN_EPI) { if (wr == 1) PG8_BAR; }
    }
    PG8_WAIT_V(0);
    if constexpr (!ALIGN_EPI) { if (wr == 0) PG8_BAR; }
    PG8_BAR;
    if constexpr (Epi::AFTER_DRAIN) { E.fused(acc, cur, wr, wc, fr, fq, lds, wid, lane); S.done(cur); }
#undef PG8_SA
#undef PG8_SB
#undef PG8_STAGE
#undef PG8_STAGE_A
#undef PG8_GOFF
#undef PG8_LDA
#undef PG8_LDB
#undef PG8_MMA
#undef PG8_WAIT_V
#undef PG8_WAIT_L
#undef PG8_BAR
#undef PG8_SCHED
}
}
constexpr int NWAVES = 8;
constexpr int TOK = 16384, SEQ = 4096, D = 1024, NP = 4096, INC = 3888, DEPTH = 4;
constexpr int HG_Q = 0, HG_F = 256, HG_I = 512, HG_G = 768;
constexpr int GL_Q = 1024, GL_K = 1152, GL_V = 1280, GL_GLR = 1536, GL_R = 1552;
constexpr int RW_BASE = 1808, RW_R = 1808, RW_K = 2064, RW_V = 2320, RW_WLR = 2576, RW_ALR = 2640, RW_GLR = 2704;
constexpr int RT_Q = 2864, RT_K = 3120, RT_V = 3376, RT_G = 3632;
constexpr int GL_GX = 3904;
constexpr int FFD = 2816, FFE = 1408, NE = 8, FFEP = 1536;
constexpr float DN_ALPHA = 1.6817928305074290f;
constexpr int NPH = 12;
constexpr int NPHASES = NPH * DEPTH;
constexpr size_t MiB = 1u << 20;
constexpr size_t WS_CTL = 0, CTL_ZERO_BYTES = 1 * MiB;
constexpr size_t WS_LIST = 1 * MiB;
constexpr size_t WS_GATE = 2 * MiB;
constexpr size_t WS_TAB = 3 * MiB;
constexpr size_t WS_WIN = 4 * MiB, WS_WOUT = 12 * MiB, WS_WUP = 14 * MiB, WS_WDN = 58 * MiB;
constexpr size_t WS_HB = 80 * MiB;
constexpr size_t WS_MIX = 112 * MiB;
constexpr size_t WS_O = WS_MIX;
constexpr size_t WS_OI = 144 * MiB;
constexpr size_t OI_GEN = 64 * 4096 * 16;
constexpr size_t WS_VF = 176 * MiB;
constexpr size_t WS_P = 184 * MiB;
constexpr size_t WS_RWW = 312 * MiB;
constexpr size_t WS_RWR = 328 * MiB, WS_RWK = 336 * MiB, WS_RWV = 344 * MiB, WS_RWKK = 352 * MiB, WS_RWB = 360 * MiB, WS_RWG = 368 * MiB;
constexpr size_t WS_Y = 376 * MiB;
constexpr size_t WS_CS = 461 * MiB;
constexpr size_t WS_HID = 184 * MiB;
constexpr size_t WS_DOUT = 280 * MiB;
constexpr size_t WS_HPERM = 344 * MiB;
constexpr size_t WS_H8 = 344 * MiB;
constexpr size_t WS_RS = 360 * MiB;
constexpr size_t WS_WOUT2 = 465 * MiB;
constexpr size_t WS_END = 467 * MiB;
constexpr int CW_BAR = 4096;
constexpr int CW_CNT = 16384;
constexpr int CW_AMAX = 20480;
constexpr int CW_AMAXD = 24576;
constexpr int TAB_STRIDE = 4 * 160 + 16;
constexpr size_t WS_LORA = 2 * MiB + 512 * 1024;
constexpr int LO_W2 = 0, LO_A2 = 256 * 64, LO_G2 = 2 * 256 * 64, LO_V1 = LO_G2 + 256 * 160, LO_V2 = LO_V1 + 32 * 256, LO_END = LO_V2 + 256 * 32;
constexpr int RING_BYTES = 131072, LDSCTL_OFF = 146432, MISC_OFF = LDSCTL_OFF + 320, LDS_BYTES = 147456;
#define GAS __attribute__((address_space(1)))
#define LAS __attribute__((address_space(3)))
typedef unsigned short bf16;
typedef unsigned v4u __attribute__((ext_vector_type(4)));
typedef unsigned v2u __attribute__((ext_vector_type(2)));
typedef float f32x4 __attribute__((ext_vector_type(4)));
typedef short bf16x8 __attribute__((ext_vector_type(8)));
typedef GAS unsigned gu32;
#define RLX_AGENT __ATOMIC_RELAXED, __HIP_MEMORY_SCOPE_AGENT
#define LDS_WAIT() asm volatile("s_waitcnt lgkmcnt(0)" ::: "memory")
#define VM_WAIT() asm volatile("s_waitcnt vmcnt(0)" ::: "memory")
#define LDS_BARRIER() do { asm volatile("s_waitcnt lgkmcnt(0)" ::: "memory"); __builtin_amdgcn_s_barrier(); asm volatile("" ::: "memory"); } while (0)
typedef float f32x2_t __attribute__((ext_vector_type(2))); typedef __bf16 bf16x2_t __attribute__((ext_vector_type(2)));
__device__ __forceinline__ unsigned pk2(float lo, float hi) { f32x2_t v = {lo, hi}; bf16x2_t b = __builtin_convertvector(v, bf16x2_t); return __builtin_bit_cast(unsigned, b); }
__device__ __forceinline__ unsigned f2bf(float f) { return pk2(f, f) & 0xffffu; }
__device__ __forceinline__ float bflo(unsigned w) { return __builtin_bit_cast(float, w << 16); }
__device__ __forceinline__ float bfhi(unsigned w) { return __builtin_bit_cast(float, w & 0xffff0000u); }
__device__ __forceinline__ float bf1(bf16 b) { return __builtin_bit_cast(float, ((unsigned)b) << 16); }
__device__ __forceinline__ void unpack8(const v4u w, float (&f)[8]) { f[0] = bflo(w.x); f[1] = bfhi(w.x); f[2] = bflo(w.y); f[3] = bfhi(w.y); f[4] = bflo(w.z); f[5] = bfhi(w.z); f[6] = bflo(w.w); f[7] = bfhi(w.w); }
__device__ __forceinline__ v4u pack8(const float (&f)[8]) { v4u w; w.x = pk2(f[0], f[1]); w.y = pk2(f[2], f[3]); w.z = pk2(f[4], f[5]); w.w = pk2(f[6], f[7]); return w; }
__device__ __forceinline__ float sigm(float x) { return __builtin_amdgcn_rcpf(1.0f + __expf(-x)); }
template <int CTRL> __device__ __forceinline__ float dpp(float x) { return __builtin_bit_cast(float, __builtin_amdgcn_mov_dpp(__builtin_bit_cast(int, x), CTRL, 0xf, 0xf, true)); }
__device__ __forceinline__ float sum16(float x) { x += dpp<0xB1>(x); x += dpp<0x4E>(x); x += dpp<0x141>(x); x += dpp<0x128>(x); return x; }
__device__ __forceinline__ float sum4(float x) { x += dpp<0xB1>(x); x += dpp<0x4E>(x); return x; }
__device__ __forceinline__ float wave_sum(float x) {
    x = sum16(x);
    auto s = __builtin_amdgcn_permlane16_swap(__float_as_uint(x), __float_as_uint(x), false, false); x = __uint_as_float(s[0]) + __uint_as_float(s[1]);
    auto t = __builtin_amdgcn_permlane32_swap(__float_as_uint(x), __float_as_uint(x), false, false); return __uint_as_float(t[0]) + __uint_as_float(t[1]);
}
__device__ __forceinline__ float wave_max(float x) {
    x = fmaxf(x, dpp<0xB1>(x)); x = fmaxf(x, dpp<0x4E>(x)); x = fmaxf(x, dpp<0x141>(x)); x = fmaxf(x, dpp<0x128>(x));
    auto s = __builtin_amdgcn_permlane16_swap(__float_as_uint(x), __float_as_uint(x), false, false); x = fmaxf(__uint_as_float(s[0]), __uint_as_float(s[1]));
    auto t = __builtin_amdgcn_permlane32_swap(__float_as_uint(x), __float_as_uint(x), false, false); return fmaxf(__uint_as_float(t[0]), __uint_as_float(t[1]));
}
__device__ __forceinline__ unsigned pack_i8(float a, float b, float c, float d) {
    const int ia = (int)__builtin_rintf(a), ib = (int)__builtin_rintf(b), ic = (int)__builtin_rintf(c), id = (int)__builtin_rintf(d);
    return ((unsigned)ia & 255u) | (((unsigned)ib & 255u) << 8) | (((unsigned)ic & 255u) << 16) | ((unsigned)id << 24);
}
__device__ const double INVF2PI[32] = {0.15915494309189535, 0.11934937021124886, 0.08949940160889101, 0.06711508300522726, 0.050329212104487035, 0.03774158471741977, 0.0283021958306234, 0.02122365276477766, 0.015915494309189534, 0.011934937021124886, 0.008949940160889102, 0.006711508300522725, 0.005032921210448704, 0.003774158471741977, 0.00283021958306234, 0.0021223652764777662, 0.0015915494309189536, 0.0011934937021124885, 0.0008949940160889102, 0.0006711508300522726, 0.0005032921210448703, 0.00037741584717419774, 0.00028302195830623395, 0.0002122365276477766, 0.00015915494309189535, 0.00011934937021124886, 8.949940160889102e-05, 6.711508300522725e-05, 5.0329212104487035e-05, 3.774158471741978e-05, 2.8302195830623396e-05, 2.122365276477766e-05};
#define XB_TMO      128
#define XB_XCNT(j)  (256  + 64 * (j))
#define XB_XSUB(j)  (1280 + 64 * (j))
#define XB_XGEN(j)  (2304 + 64 * (j))
#define XB_TOP      3328
#define XB_TOPGEN   3392
#define XCD_BAR_WORDS 3456
#define XB_SPIN_CAP (1u << 18)

__device__ __forceinline__ unsigned xb_ld(unsigned* p)              { return __hip_atomic_load(p, __ATOMIC_RELAXED, __HIP_MEMORY_SCOPE_AGENT); }
__device__ __forceinline__ unsigned xb_add(unsigned* p, unsigned v) { return __hip_atomic_fetch_add(p, v, __ATOMIC_RELAXED, __HIP_MEMORY_SCOPE_AGENT); }
__device__ __forceinline__ unsigned xb_xcc_id() { return (unsigned)__builtin_amdgcn_s_getreg((3 << 11) | 20) & 0xFu; }
#define XB_SPIN(cond, bar) do { unsigned _sp = 0; while (cond) { __builtin_amdgcn_s_sleep(1); \
    if ((++_sp & 255u) == 0u) { if (xb_ld(&(bar)[XB_TMO])) break; if (_sp > XB_SPIN_CAP) { atomicAdd(&(bar)[XB_TMO], 1u); break; } } } } while (0)

struct XcdBarrier {
    unsigned* bar; unsigned x;
    volatile LAS unsigned* st;
    int wv;
};

__device__ __forceinline__ XcdBarrier xcd_barrier_post(unsigned* bar, volatile LAS unsigned* st) {
    XcdBarrier b; b.bar = bar; b.x = xb_xcc_id(); b.st = st; b.wv = __builtin_amdgcn_readfirstlane((int)threadIdx.x >> 6);
    if (threadIdx.x == 0) (void)xb_add(&bar[XB_XCNT(b.x)], 1u);
    return b;
}
__device__ __forceinline__ void xcd_barrier_complete(unsigned* bar, unsigned x, unsigned& nloc, unsigned& nx) {
    const unsigned G = gridDim.x * gridDim.y * gridDim.z;
    unsigned sum, cnt, mine, sp = 0u;
    for (;;) {
        sum = 0u; cnt = 0u; mine = 0u;
#pragma unroll 1
        for (unsigned j = 0; j < 16; ++j) { const unsigned c = xb_ld(&bar[XB_XCNT(j)]); sum += c; cnt += (c > 0u) ? 1u : 0u; mine = (j == x) ? c : mine; }
        if (sum == G) break;
        __builtin_amdgcn_s_sleep(1);
        if ((++sp & 255u) == 0u) { if (xb_ld(&bar[XB_TMO])) break; if (sp > XB_SPIN_CAP) { atomicAdd(&bar[XB_TMO], 1u); break; } }
    }
    nloc = mine > 0u ? mine : 1u; nx = cnt > 0u ? cnt : 1u;
}

__device__ __forceinline__ void xcd_barrier(const XcdBarrier& b) {
    asm volatile("s_waitcnt vmcnt(0)" ::: "memory");
    __syncthreads();
    if (b.wv == 0 && lane_id_now() == 0) {
        unsigned* bar = b.bar;
        __builtin_amdgcn_s_waitcnt(0);
        unsigned nloc = b.st[0], nx = b.st[1];
        if (nloc == 0u) { xcd_barrier_complete(bar, b.x, nloc, nx); b.st[0] = nloc; b.st[1] = nx; }
        const unsigned old = xb_add(&bar[XB_XSUB(b.x)], 1u);
        const unsigned gen = old / nloc;
        if (old + 1u == (gen + 1u) * nloc) {
            __builtin_amdgcn_fence(__ATOMIC_RELEASE, "agent");
            asm volatile("s_waitcnt vmcnt(0)" ::: "memory");
            const unsigned og = xb_add(&bar[XB_TOP], 1u);
            const unsigned tg = og / nx;
            if (og + 1u == (tg + 1u) * nx) xb_add(&bar[XB_TOPGEN], 1u);
            else XB_SPIN(xb_ld(&bar[XB_TOPGEN]) == tg, bar);
            __builtin_amdgcn_fence(__ATOMIC_ACQUIRE, "agent");
            xb_add(&bar[XB_XGEN(b.x)], 1u);
            asm volatile("s_waitcnt vmcnt(0)" ::: "memory");
        } else {
            XB_SPIN(xb_ld(&bar[XB_XGEN(b.x)]) == gen, bar);
            __builtin_amdgcn_fence(__ATOMIC_ACQUIRE, "agent");
            asm volatile("s_waitcnt vmcnt(0)" ::: "memory");
        }
    }
    __syncthreads();
}
struct Frame {
    LAS unsigned char* lds;
    volatile LAS unsigned* MISC;
    gu32* ctl;
    int tid, lane, wave;
    int vcu, G;
    unsigned char* ws;
    const void* const* in;
    float* h;
};
__device__ __forceinline__ const void* ldptr(const void* const* tab, int k) { int z; asm volatile("s_mov_b32 %0, 0" : "=s"(z)); return tab[k + z]; }
#define INF(k) ((const float*)ldptr(F.in, k))
#define WSP(T, off) ((T*)(F.ws + (off)))

__device__ __forceinline__ void xpose_item(const float* W, int ldw, int nvalid, int k0, int n0, bf16* WT, int ldt, int drow0, LAS float* scr, int lane) {
    { float t_[32]; const int n = n0 + (lane & 31);
#pragma unroll
      for (int i = 0; i < 32; ++i) { const int kk = 2 * i + (lane >> 5); t_[i] = (n < nvalid) ? W[(size_t)(k0 + kk) * ldw + n] : 0.f; }
#pragma unroll
      for (int i = 0; i < 32; ++i) { const int kk = 2 * i + (lane >> 5); scr[kk * 33 + (lane & 31)] = t_[i]; } }
    LDS_WAIT(); asm volatile("" ::: "memory");
    const int c = lane & 7;
#pragma unroll
    for (int j = 0; j < 4; ++j) { const int n = (lane >> 3) + 8 * j; const LAS float* s = scr + (8 * c) * 33 + n;
        v4u o; o.x = pk2(s[0 * 33], s[1 * 33]); o.y = pk2(s[2 * 33], s[3 * 33]); o.z = pk2(s[4 * 33], s[5 * 33]); o.w = pk2(s[6 * 33], s[7 * 33]);
        *(GAS v4u*)(WT + (size_t)(drow0 + n) * ldt + k0 + 8 * c) = o; }
    LDS_WAIT(); asm volatile("" ::: "memory");
}
__device__ __forceinline__ void xpose_item8(const float* W, int ldw, int k0, int n0, unsigned char* WT, int ldt, int drow0, float qs, LAS float* scr, int lane) {
    { float t_[32]; const int n = n0 + (lane & 31);
#pragma unroll
      for (int i = 0; i < 32; ++i) { const int kk = 2 * i + (lane >> 5); t_[i] = W[(size_t)(k0 + kk) * ldw + n]; }
#pragma unroll
      for (int i = 0; i < 32; ++i) { const int kk = 2 * i + (lane >> 5); scr[kk * 33 + (lane & 31)] = t_[i]; } }
    LDS_WAIT(); asm volatile("" ::: "memory");
    const int c = lane & 7;
#pragma unroll
    for (int j = 0; j < 4; ++j) { const int n = (lane >> 3) + 8 * j; const LAS float* s = scr + (8 * c) * 33 + n;
        v2u o; o.x = pack_i8(s[0 * 33] * qs, s[1 * 33] * qs, s[2 * 33] * qs, s[3 * 33] * qs); o.y = pack_i8(s[4 * 33] * qs, s[5 * 33] * qs, s[6 * 33] * qs, s[7 * 33] * qs);
        *(GAS v2u*)(WT + (size_t)(drow0 + n) * ldt + k0 + 8 * c) = o; }
    LDS_WAIT(); asm volatile("" ::: "memory");
}
__device__ __forceinline__ void f8_scale(float am, float& s, float& inv) {
    const int e = (int)((__float_as_uint(am) >> 23) & 255u) - 127;
    if (am > 0.f && e > -100 && e < 100) { s = __uint_as_float((unsigned)(127 + 7 - e) << 23); inv = __uint_as_float((unsigned)(127 + e - 7) << 23); } else { s = 1.f; inv = 1.f; }
}
__device__ __forceinline__ unsigned pack_f8(float a, float b, float c, float d) {
    unsigned w = 0u; w = __builtin_amdgcn_cvt_pk_fp8_f32(a, b, w, false); w = __builtin_amdgcn_cvt_pk_fp8_f32(c, d, w, true); return w;
}
__device__ __forceinline__ void xpose_item_f8(const float* W, int ldw, int kvalid, int k0, int n0, unsigned char* WT, int ldt, int drow0, float qs, LAS float* scr, int lane) {
    const int c = lane & 7;
    if (k0 >= kvalid) {
#pragma unroll
        for (int j = 0; j < 4; ++j) { const int n = (lane >> 3) + 8 * j; v2u o; o.x = 0u; o.y = 0u; *(GAS v2u*)(WT + (size_t)(drow0 + n) * ldt + k0 + 8 * c) = o; }
        return; }
    { float t_[32]; const int n = n0 + (lane & 31);
#pragma unroll
      for (int i = 0; i < 32; ++i) { const int kk = 2 * i + (lane >> 5); t_[i] = W[(size_t)(k0 + kk) * ldw + n]; }
#pragma unroll
      for (int i = 0; i < 32; ++i) { const int kk = 2 * i + (lane >> 5); scr[kk * 33 + (lane & 31)] = t_[i]; } }
    LDS_WAIT(); asm volatile("" ::: "memory");
#pragma unroll
    for (int j = 0; j < 4; ++j) { const int n = (lane >> 3) + 8 * j; const LAS float* s = scr + (8 * c) * 33 + n;
        v2u o; o.x = pack_f8(s[0 * 33] * qs, s[1 * 33] * qs, s[2 * 33] * qs, s[3 * 33] * qs); o.y = pack_f8(s[4 * 33] * qs, s[5 * 33] * qs, s[6 * 33] * qs, s[7 * 33] * qs);
        *(GAS v2u*)(WT + (size_t)(drow0 + n) * ldt + k0 + 8 * c) = o; }
    LDS_WAIT(); asm volatile("" ::: "memory");
}
__device__ __forceinline__ int gu_row(int n) { return 256 * (n >> 7) + (n & 127); }
template <int PART> __device__ __forceinline__ void phase_weights(Frame& F, int l) {
    LAS float* scr = (LAS float*)(F.lds + F.wave * 16384);
    const int gw = F.vcu * NWAVES + F.wave, NGW = F.G * NWAVES;
    const bool moe = (l & 1); const int fi = l >> 1;
    constexpr int I_IN = 16 * 128, I_OUT = 16 * 32;
    constexpr int I_DG = 16 * 88, I_DD = 44 * 32;
    constexpr int I_MG = 16 * 44, I_MD = 24 * 32;
    const int nitems = PART == 0 ? (I_IN + I_OUT) : (moe ? NE * (2 * I_MG + I_MD) : (2 * I_DG + I_DD));
    float qs8 = 0.f; if (PART == 1) { const float am = __uint_as_float(__hip_atomic_load((unsigned*)(F.ctl + CW_AMAX + l * 64), RLX_AGENT)); qs8 = am > 0.f ? 127.f / am : 0.f; }
    float qsd = 1.f; if (PART == 1) { float inv_; f8_scale(__uint_as_float(__hip_atomic_load((unsigned*)(F.ctl + CW_AMAXD + l * 64), RLX_AGENT)), qsd, inv_); }
    for (int it = gw; it < nitems; it += NGW) {
        int r = it + (PART == 0 ? 0 : I_IN + I_OUT);
        if (r < I_IN) { const int kb = r >> 7, nb = r & 127; if (nb < 122) xpose_item(INF(2) + (size_t)l * D * INC, INC, INC, 64 * kb, 32 * nb, WSP(bf16, WS_WIN), D, 32 * nb, scr, F.lane); continue; } r -= I_IN;
        if (r < I_OUT) { const int kb = r >> 5, nb = r & 31; xpose_item(INF(3) + (size_t)l * D * D, D, D, 64 * kb, 32 * nb, WSP(bf16, (l & 1) ? WS_WOUT2 : WS_WOUT), D, 32 * nb, scr, F.lane); continue; } r -= I_OUT;
        if (!moe) {
            if (r < 2 * I_DG) { const int up = r >= I_DG; if (up) r -= I_DG; const int kb = r / 88, nb = r % 88;
                xpose_item8(INF(up ? 28 : 27) + (size_t)fi * D * FFD, FFD, 64 * kb, 32 * nb, WSP(unsigned char, WS_WUP), D, gu_row(32 * nb) + (up ? 128 : 0), qs8, scr, F.lane); continue; } r -= 2 * I_DG;
            { const int kb = r >> 5, nb = r & 31; xpose_item_f8(INF(29) + (size_t)fi * FFD * D, D, FFD, 64 * kb, 32 * nb, WSP(unsigned char, WS_WDN), FFD, 32 * nb, qsd, scr, F.lane); }
        } else {
            const int per = 2 * I_MG + I_MD; const int e = r / per; r -= e * per;
            if (r < 2 * I_MG) { const int up = r >= I_MG; if (up) r -= I_MG; const int kb = r / 44, nb = r % 44;
                xpose_item8(INF(up ? 32 : 31) + (size_t)(fi * NE + e) * D * FFE, FFE, 64 * kb, 32 * nb, WSP(unsigned char, WS_WUP) + (size_t)e * 2 * FFE * D, D, gu_row(32 * nb) + (up ? 128 : 0), qs8, scr, F.lane); continue; } r -= 2 * I_MG;
            { const int kb = r >> 5, nb = r & 31; xpose_item_f8(INF(33) + (size_t)(fi * NE + e) * FFE * D, D, FFE, 64 * kb, 32 * nb, WSP(unsigned char, WS_WDN) + (size_t)e * D * FFEP, FFEP, 32 * nb, qsd, scr, F.lane); }
        }
    }
    if (PART == 0) {
        const int gt = F.vcu * NWAVES * 64 + F.tid; int NT = F.G * NWAVES * 64; asm volatile("" : "+s"(NT));     const float* win = INF(2) + (size_t)l * D * INC; const float* gw2 = INF(10) + l * 16 * 128; bf16* WT = WSP(bf16, WS_WIN);
        for (int e = gt; e < 128 * D; e += NT) { const int n = e >> 10, d = e & 1023; const float* wr = win + (size_t)d * INC + (GL_GLR - 0); float a = 0.f;
#pragma unroll
            for (int r = 0; r < 16; ++r) a += wr[r] * gw2[r * 128 + n];
            WT[(size_t)(GL_GX + n) * D + d] = (bf16)f2bf(a); }
        if (l == 0) {
            f32x2_t* CS = WSP(f32x2_t, WS_CS); const int* pos = (const int*)ldptr(F.in, 1);
            for (int e = gt; e < TOK * 32; e += NT) { const int t = e >> 5, i = e & 31; const double rev = (double)pos[t] * INVF2PI[i]; const float fr_ = (float)(rev - floor(rev));
                f32x2_t cs; cs.x = __builtin_amdgcn_cosf(fr_); cs.y = __builtin_amdgcn_sinf(fr_); CS[e] = cs; } }
    }
    if (PART == 0) {
        bf16* LO = WSP(bf16, WS_LORA); const int gt = F.vcu * NWAVES * 64 + F.tid; int NT = F.G * NWAVES * 64; asm volatile("" : "+s"(NT));
        const float* w2 = INF(15) + (size_t)l * 64 * 256; const float* a2 = INF(17) + (size_t)l * 64 * 256; const float* g2 = INF(18) + (size_t)l * 160 * 256;
        for (int e = gt; e < LO_END; e += NT) { float v;
            if (e < LO_A2) { const int n = e >> 6, k = e & 63; v = w2[k * 256 + n]; }
            else if (e < LO_G2) { const int q = e - LO_A2, n = q >> 6, k = q & 63; v = a2[k * 256 + n]; }
            else if (e < LO_V1) { const int q = e - LO_G2, n = q / 160, k = q - n * 160; v = g2[k * 256 + n]; }
            else if (e < LO_V2) { const int q = e - LO_V1, n = q >> 8, k = q & 255; v = (l > 0) ? (INF(25) + (size_t)(l - 1) * 256 * 32)[k * 32 + n] : 0.f; }
            else { const int q = e - LO_V2, n = q >> 5, k = q & 31; v = (l > 0) ? (INF(26) + (size_t)(l - 1) * 32 * 256)[k * 256 + n] : 0.f; }
            LO[e] = (bf16)f2bf(v); }
    }
    if (PART == 0 && l == 0) {
        const float* x = INF(0); bf16* hb = WSP(bf16, WS_HB);
        for (int m = gw; m < TOK; m += NGW) {
            const GAS f32x4* xr = (const GAS f32x4*)(x + (size_t)m * D) + F.lane; GAS f32x4* hr = (GAS f32x4*)(F.h + (size_t)m * D) + F.lane; GAS v2u* o8 = (GAS v2u*)(hb + (size_t)m * D) + F.lane;
#pragma unroll
            for (int j = 0; j < 4; ++j) { const f32x4 v = xr[64 * j]; v2u w; w.x = pk2(v.x, v.y); w.y = pk2(v.z, v.w); o8[64 * j] = w; }
        }
    }
}
__device__ __forceinline__ void phase_absmax(Frame& F, int l) {
    const bool moe = (l & 1); const int fi = l >> 1;
    const int n4 = (moe ? NE * D * FFE : D * FFD) / 4;
    const GAS f32x4* g = (const GAS f32x4*)INF(moe ? 31 : 27) + (size_t)fi * n4; const GAS f32x4* u = (const GAS f32x4*)INF(moe ? 32 : 28) + (size_t)fi * n4; const GAS f32x4* dn = (const GAS f32x4*)INF(moe ? 33 : 29) + (size_t)fi * n4;
    const int gt = F.vcu * NWAVES * 64 + F.tid; int NT = F.G * NWAVES * 64; asm volatile("" : "+s"(NT));
    f32x4 mx = (f32x4){0.f, 0.f, 0.f, 0.f}, md = mx;
    for (int i = gt; i < n4; i += 3 * NT) {
        f32x4 a[3], b[3], c[3];
#pragma unroll
        for (int j = 0; j < 3; ++j) { const int ij = (i + j * NT < n4) ? i + j * NT : i; a[j] = g[ij]; b[j] = u[ij]; c[j] = dn[ij]; }
#pragma unroll
        for (int j = 0; j < 3; ++j) { mx = __builtin_elementwise_max(mx, __builtin_elementwise_max(__builtin_elementwise_abs(a[j]), __builtin_elementwise_abs(b[j]))); md = __builtin_elementwise_max(md, __builtin_elementwise_abs(c[j])); }
    }
    const float m = wave_max(fmaxf(fmaxf(mx.x, mx.y), fmaxf(mx.z, mx.w))), m2 = wave_max(fmaxf(fmaxf(md.x, md.y), fmaxf(md.z, md.w)));
    if (F.lane == 0) { __hip_atomic_fetch_max((unsigned*)(F.ctl + CW_AMAX + l * 64), __float_as_uint(m), RLX_AGENT); __hip_atomic_fetch_max((unsigned*)(F.ctl + CW_AMAXD + l * 64), __float_as_uint(m2), RLX_AGENT); }
}
template <int NKS> __device__ __forceinline__ void rw_mm16(f32x4 (&acc)[2][4], const LAS bf16* X, int ldx, int mb0, const bf16* BT, int hh, int lane) {
    const int fr = lane & 15, fq = lane >> 4; constexpr int K = 32 * NKS;
    bf16x8 bfr[NKS][4];
#pragma unroll
    for (int ks = 0; ks < NKS; ++ks)
#pragma unroll
        for (int nb = 0; nb < 4; ++nb) bfr[ks][nb] = *(const GAS bf16x8*)(BT + (size_t)(64 * hh + 16 * nb + fr) * K + 32 * ks + 8 * fq);
#pragma unroll
    for (int ks = 0; ks < NKS; ++ks)
#pragma unroll
        for (int mi = 0; mi < 2; ++mi) { const bf16x8 a = *(const LAS bf16x8*)(X + (16 * (mb0 + mi) + fr) * ldx + 32 * ks + 8 * fq);
#pragma unroll
            for (int nb = 0; nb < 4; ++nb) acc[mi][nb] = __builtin_amdgcn_mfma_f32_16x16x32_bf16(a, bfr[ks][nb], acc[mi][nb], 0, 0, 0); }
}
__device__ __forceinline__ void rwprep_tile(Frame& F, int l, int tile) {
    const bf16* P = WSP(const bf16, WS_P);
    const float* mu = INF(13) + l * 1056;
    LAS bf16* X1 = (LAS bf16*)F.lds; LAS bf16* X2 = X1 + 64 * 72; LAS bf16* X3 = X2 + 64 * 72; LAS bf16* XV = X3 + 64 * 168; LAS bf16* X5 = XV + 64 * 264; LAS bf16* XK = X5 + 64 * 40;
    float* RWW = WSP(float, WS_RWW); bf16* RWR = WSP(bf16, WS_RWR); bf16* RWK = WSP(bf16, WS_RWK); bf16* RWV = WSP(bf16, WS_RWV);
    bf16* RWKK = WSP(bf16, WS_RWKK); bf16* RWB = WSP(bf16, WS_RWB); bf16* RWG = WSP(bf16, WS_RWG); bf16* VF = WSP(bf16, WS_VF);
    const bf16* LORA = WSP(const bf16, WS_LORA);
    int tid_ = F.tid; asm volatile("" : "+v"(tid_));
    const int lane_ = tid_ & 63, wave_ = __builtin_amdgcn_readfirstlane(tid_ >> 6);
    const int fr = lane_ & 15, fq = lane_ >> 4, hh = wave_ & 3, mb0 = 2 * (wave_ >> 2);
    const int t0 = tile * 64;
#pragma unroll
    for (int half = 0; half < 2; ++half) {
        v4u rc[9], rp[9];
#pragma unroll
        for (int i = 0; i < 9; ++i) { const int g = tid_ + (half * 9 + i) * 512; rc[i] = (v4u){0u, 0u, 0u, 0u}; rp[i] = rc[i];
            if (g < 64 * 132) { const int tt = g / 132, cg = g - tt * 132, t = t0 + tt; const int col = RW_BASE + 8 * (cg < 36 ? 96 + cg : cg < 68 ? cg - 36 : cg < 100 ? 64 + (cg - 68) : 32 + (cg - 100));
                rc[i] = *(const GAS v4u*)(P + (size_t)t * NP + col); if ((t & (SEQ - 1)) != 0) rp[i] = *(const GAS v4u*)(P + (size_t)(t - 1) * NP + col); } }
#pragma unroll
        for (int i = 0; i < 9; ++i) { const int g = tid_ + (half * 9 + i) * 512;
            if (g < 64 * 132) { const int tt = g / 132, cg = g - tt * 132, t = t0 + tt; const int rel = 8 * (cg < 36 ? 96 + cg : cg < 68 ? cg - 36 : cg < 100 ? 64 + (cg - 68) : 32 + (cg - 100));
                const f32x4 m0 = *(const GAS f32x4*)(mu + rel), m1 = *(const GAS f32x4*)(mu + rel + 4); const float m[8] = {m0.x, m0.y, m0.z, m0.w, m1.x, m1.y, m1.z, m1.w};
                float cv[8], pv[8], xs[8]; unpack8(rc[i], cv); unpack8(rp[i], pv);
#pragma unroll
                for (int j = 0; j < 8; ++j) xs[j] = cv[j] + (pv[j] - cv[j]) * m[j];
                if (cg < 8) {
#pragma unroll
                    for (int j = 0; j < 8; ++j) { const float e2 = __expf(2.f * xs[j]); xs[j] = 1.f - 2.f * __builtin_amdgcn_rcpf(e2 + 1.f); }
                    *(LAS v4u*)(X1 + tt * 72 + 8 * cg) = pack8(xs);
                } else if (cg < 16) { *(LAS v4u*)(X2 + tt * 72 + 8 * (cg - 8)) = pack8(xs);
                } else if (cg < 36) {
#pragma unroll
                    for (int j = 0; j < 8; ++j) xs[j] = sigm(xs[j]);
                    *(LAS v4u*)(X3 + tt * 168 + 8 * (cg - 16)) = pack8(xs);
                } else if (cg < 68) { *(GAS v4u*)(RWR + (size_t)t * 256 + 8 * (cg - 36)) = pack8(xs);
                } else if (cg < 100) { const v4u w = pack8(xs); *(LAS v4u*)(XV + tt * 264 + 8 * (cg - 68)) = w;
                    if (l == 0) { *(GAS v4u*)(RWV + (size_t)t * 256 + 8 * (cg - 68)) = w; *(GAS v4u*)(VF + (size_t)t * 256 + 8 * (cg - 68)) = w; }
                } else { *(LAS v4u*)(XK + tt * 264 + 8 * (cg - 100)) = pack8(xs); } } }
    }
    __syncthreads();
    {   f32x4 acc[2][4];
#pragma unroll
        for (int mi = 0; mi < 2; ++mi)
#pragma unroll
            for (int nb = 0; nb < 4; ++nb) acc[mi][nb] = (f32x4){0.f, 0.f, 0.f, 0.f};
        rw_mm16<2>(acc, X1, 72, mb0, LORA + LO_W2, hh, lane_);
        const float* w0 = INF(14) + l * 256;
#pragma unroll
        for (int mi = 0; mi < 2; ++mi)
#pragma unroll
            for (int nb = 0; nb < 4; ++nb) { const int col = 64 * hh + 16 * nb + fr; const float w0c = w0[col];
#pragma unroll
                for (int r = 0; r < 4; ++r) { const int t = t0 + 16 * (mb0 + mi) + 4 * fq + r; RWW[(size_t)t * 256 + col] = -0.6065306597126334f * sigm(acc[mi][nb][r] + w0c);     } }
#pragma unroll
        for (int mi = 0; mi < 2; ++mi)
#pragma unroll
            for (int nb = 0; nb < 4; ++nb) acc[mi][nb] = (f32x4){0.f, 0.f, 0.f, 0.f};
        rw_mm16<2>(acc, X2, 72, mb0, LORA + LO_A2, hh, lane_);
        const float* a0 = INF(16) + l * 256; const float* kkw = INF(19) + l * 256; const float* kaw = INF(20) + l * 256;
#pragma unroll
        for (int mi = 0; mi < 2; ++mi) {
            float kr[4][4], kq[4][4], ssq[4] = {0.f, 0.f, 0.f, 0.f};
#pragma unroll
            for (int nb = 0; nb < 4; ++nb) { const int col = 64 * hh + 16 * nb + fr; const float kkc = kkw[col];
#pragma unroll
                for (int r = 0; r < 4; ++r) { const int row = 16 * (mb0 + mi) + 4 * fq + r; kr[nb][r] = bf1(XK[row * 264 + col]); kq[nb][r] = kr[nb][r] * kkc; ssq[r] += kq[nb][r] * kq[nb][r]; } }
#pragma unroll
            for (int r = 0; r < 4; ++r) { ssq[r] = sum16(ssq[r]); ssq[r] = 1.0f / fmaxf(sqrtf(ssq[r]), 1e-12f); }
#pragma unroll
            for (int nb = 0; nb < 4; ++nb) { const int col = 64 * hh + 16 * nb + fr; const float a0c = a0[col], kac = kaw[col];
#pragma unroll
                for (int r = 0; r < 4; ++r) { const int t = t0 + 16 * (mb0 + mi) + 4 * fq + r; const float a = sigm(acc[mi][nb][r] + a0c); const float kk = kq[nb][r] * ssq[r];
                    const size_t o = (size_t)t * 256 + col; RWKK[o] = (bf16)f2bf(kk); RWB[o] = (bf16)f2bf(kk * a); RWK[o] = (bf16)f2bf(kr[nb][r] * (1.f + (a - 1.f) * kac)); } }
        }
#pragma unroll
        for (int mi = 0; mi < 2; ++mi)
#pragma unroll
            for (int nb = 0; nb < 4; ++nb) acc[mi][nb] = (f32x4){0.f, 0.f, 0.f, 0.f};
        rw_mm16<5>(acc, X3, 168, mb0, LORA + LO_G2, hh, lane_);
#pragma unroll
        for (int mi = 0; mi < 2; ++mi)
#pragma unroll
            for (int nb = 0; nb < 4; ++nb) { const int col = 64 * hh + 16 * nb + fr;
#pragma unroll
                for (int r = 0; r < 4; ++r) { const int t = t0 + 16 * (mb0 + mi) + 4 * fq + r; RWG[(size_t)t * 256 + col] = (bf16)f2bf(acc[mi][nb][r]); } }
    }
    if (l > 0) {
        const float* v0 = INF(24) + (l - 1) * 256; const bf16* v1T = LORA + LO_V1; const bf16* v2T = LORA + LO_V2;
        {
            const int mb = wave_ & 3, nb = wave_ >> 2; f32x4 a4 = (f32x4){0.f, 0.f, 0.f, 0.f}; bf16x8 bv[8];
#pragma unroll
            for (int ks = 0; ks < 8; ++ks) bv[ks] = *(const GAS bf16x8*)(v1T + (size_t)(16 * nb + fr) * 256 + 32 * ks + 8 * fq);
#pragma unroll
            for (int ks = 0; ks < 8; ++ks) a4 = __builtin_amdgcn_mfma_f32_16x16x32_bf16(*(const LAS bf16x8*)(XV + (16 * mb + fr) * 264 + 32 * ks + 8 * fq), bv[ks], a4, 0, 0, 0);
#pragma unroll
            for (int r = 0; r < 4; ++r) X5[(16 * mb + 4 * fq + r) * 40 + 16 * nb + fr] = (bf16)f2bf(a4[r]);
        }
        __syncthreads();
        {   f32x4 acc[2][4];
#pragma unroll
            for (int mi = 0; mi < 2; ++mi)
#pragma unroll
                for (int nb = 0; nb < 4; ++nb) acc[mi][nb] = (f32x4){0.f, 0.f, 0.f, 0.f};
            rw_mm16<1>(acc, X5, 40, mb0, v2T, hh, lane_);
#pragma unroll
            for (int mi = 0; mi < 2; ++mi)
#pragma unroll
                for (int nb = 0; nb < 4; ++nb) { const int col = 64 * hh + 16 * nb + fr; const float v0c = v0[col];
#pragma unroll
                    for (int r = 0; r < 4; ++r) { const int row = 16 * (mb0 + mi) + 4 * fq + r; const size_t o = (size_t)(t0 + row) * 256 + col;
                        const float xv = bf1(XV[row * 264 + col]); const float vf = bf1(VF[o]); RWV[o] = (bf16)f2bf(xv + (vf - xv) * sigm(acc[mi][nb][r] + v0c)); } }
        }
    }
    __syncthreads();
}
constexpr int CB = 64 * 66;
constexpr int HB_ = 64 * 72;
constexpr int PRE_H0 = 3 * CB * 4;
constexpr int PV_OFF = (PRE_H0 + 10 * HB_ * 2) / 4;
constexpr int REC_RW = 53760, REC_GL = 16640;
constexpr int RO_QH = 0, RO_AT = 8192, RO_BH = 16384, RO_TT = 24576, RO_MRB = 30720, RO_GAM = 36864, RO_VB = 37376;
constexpr int RO_Y = 0, RO_SK = 0;
constexpr int GO_QH = 0, GO_SK = 8192, GO_GAM = 16384;
#define PBUF(i) ((LAS float*)F.lds + (i) * CB)
#define HBUF(i) ((LAS bf16*)(F.lds + PRE_H0) + (i) * HB_)
__device__ __forceinline__ void nt16(f32x4 (&acc)[2], const LAS bf16* X, const LAS bf16* Y, int mb, int nb0, int lane) {
    const int fr = lane & 15, fq = lane >> 4;
    acc[0] = (f32x4){0.f, 0.f, 0.f, 0.f}; acc[1] = acc[0];
#pragma unroll
    for (int ks = 0; ks < 2; ++ks) { const bf16x8 a = *(const LAS bf16x8*)(X + (16 * mb + fr) * 72 + 32 * ks + 8 * fq);
        const bf16x8 b0 = *(const LAS bf16x8*)(Y + (16 * nb0 + fr) * 72 + 32 * ks + 8 * fq), b1 = *(const LAS bf16x8*)(Y + (16 * nb0 + 16 + fr) * 72 + 32 * ks + 8 * fq);
        acc[0] = __builtin_amdgcn_mfma_f32_16x16x32_bf16(a, b0, acc[0], 0, 0, 0); acc[1] = __builtin_amdgcn_mfma_f32_16x16x32_bf16(a, b1, acc[1], 0, 0, 0); }
}
typedef short v4i16_t __attribute__((ext_vector_type(4)));
__device__ __forceinline__ v2u trr(const LAS bf16* p) { return __builtin_bit_cast(v2u, __builtin_amdgcn_ds_read_tr16_b64_v4i16((LAS v4i16_t*)p)); }
__device__ __forceinline__ bf16x8 trfrag(const LAS bf16* M, int c, int ks, int lane) {
    const int g = lane >> 4, q = (lane & 15) >> 2, p = lane & 3; const LAS bf16* a = M + (32 * ks + 8 * g + q) * 72 + 16 * c + 4 * p;
    const v2u lo = trr(a), hi = trr(a + 4 * 72); v4u w; w.x = lo.x; w.y = lo.y; w.z = hi.x; w.w = hi.y; return __builtin_bit_cast(bf16x8, w);
}
__device__ __forceinline__ void tn16(f32x4 (&acc)[2], const LAS bf16* X, const LAS bf16* Y, int mb, int nb0, int lane) {
    acc[0] = (f32x4){0.f, 0.f, 0.f, 0.f}; acc[1] = acc[0];
#pragma unroll
    for (int ks = 0; ks < 2; ++ks) { const bf16x8 a = trfrag(X, mb, ks, lane), b0 = trfrag(Y, nb0, ks, lane), b1 = trfrag(Y, nb0 + 1, ks, lane);
        acc[0] = __builtin_amdgcn_mfma_f32_16x16x32_bf16(a, b0, acc[0], 0, 0, 0); acc[1] = __builtin_amdgcn_mfma_f32_16x16x32_bf16(a, b1, acc[1], 0, 0, 0); }
}
__device__ __forceinline__ void nn16(f32x4 (&acc)[2], const LAS bf16* A, const LAS bf16* B, int mb, int nb0, int lane) {
    const int fr = lane & 15, fq = lane >> 4;
    acc[0] = (f32x4){0.f, 0.f, 0.f, 0.f}; acc[1] = acc[0];
#pragma unroll
    for (int ks = 0; ks < 2; ++ks) { const bf16x8 a = *(const LAS bf16x8*)(A + (16 * mb + fr) * 72 + 32 * ks + 8 * fq), b0 = trfrag(B, nb0, ks, lane), b1 = trfrag(B, nb0 + 1, ks, lane);
        acc[0] = __builtin_amdgcn_mfma_f32_16x16x32_bf16(a, b0, acc[0], 0, 0, 0); acc[1] = __builtin_amdgcn_mfma_f32_16x16x32_bf16(a, b1, acc[1], 0, 0, 0); }
}
__device__ __forceinline__ void hfrag_tr(const LAS bf16* M, unsigned char* dst, int wave, int lane) {
    const int mb = wave >> 1, ks = wave & 1, g = lane >> 4, q = (lane & 15) >> 2, p = lane & 3; const LAS bf16* a = M + (32 * ks + 4 * g + q) * 72 + 16 * mb + 4 * p;
    const v2u lo = trr(a), hi = trr(a + 16 * 72); v4u w; w.x = lo.x; w.y = lo.y; w.z = hi.x; w.w = hi.y;
    *(GAS v4u*)(dst + ((size_t)wave * 64 + lane) * 16) = w;
}
template <int MASK> __device__ __forceinline__ void hst(const f32x4 (&acc)[2], LAS bf16* S, int mb, int nb0, int lane) {
    const int fr = lane & 15, fq = lane >> 4;
#pragma unroll
    for (int n = 0; n < 2; ++n)
#pragma unroll
        for (int r = 0; r < 4; ++r) { const int row = 16 * mb + 4 * fq + r, col = 16 * (nb0 + n) + fr; float v = acc[n][r];
            if (MASK == 1 && col > row) v = 0.f; if (MASK == 2 && col >= row) v = 0.f; S[row * 72 + col] = (bf16)f2bf(v); }
}
template <int MASK> __device__ __forceinline__ void cst(const f32x4 (&acc)[2], LAS float* S, int mb, int nb0, int lane) {
    const int fr = lane & 15, fq = lane >> 4;
#pragma unroll
    for (int n = 0; n < 2; ++n)
#pragma unroll
        for (int r = 0; r < 4; ++r) { const int row = 16 * mb + 4 * fq + r, col = 16 * (nb0 + n) + fr; float v = acc[n][r];
            if (MASK == 1 && col > row) v = 0.f; if (MASK == 2 && col >= row) v = 0.f; S[row * 66 + col] = v; }
}
__device__ __forceinline__ void hfrag(const LAS bf16* M, const LAS float* colscale, unsigned char* dst, int wave, int lane, int slot = -2) {
    const int mb = wave >> 1, ks = wave & 1, i = lane & 15, q = lane >> 4; const LAS bf16* rowp = M + (16 * mb + i) * 72 + 32 * ks + 4 * q;
    const v2u lo = *(const LAS v2u*)rowp, hi = *(const LAS v2u*)(rowp + 16);
    v4u w; w.x = lo.x; w.y = lo.y; w.z = hi.x; w.w = hi.y;
    if (colscale) { float e[8]; unpack8(w, e); const f32x4 s0 = *(const LAS f32x4*)(colscale + 32 * ks + 4 * q), s1 = *(const LAS f32x4*)(colscale + 32 * ks + 16 + 4 * q);
        e[0] *= s0.x; e[1] *= s0.y; e[2] *= s0.z; e[3] *= s0.w; e[4] *= s1.x; e[5] *= s1.y; e[6] *= s1.z; e[7] *= s1.w; w = pack8(e); }
    if (slot == -2) slot = wave; if (slot >= 0) *(GAS v4u*)(dst + ((size_t)slot * 64 + lane) * 16) = w;
}
__device__ __forceinline__ void cfrag(const LAS float* M, unsigned char* dst, int wave, int lane, int slot) {
    const int mb = wave >> 1, ks = wave & 1, i = lane & 15, q = lane >> 4; float e[8];
#pragma unroll
    for (int jj = 0; jj < 8; ++jj) { const int rho = 32 * ks + (jj < 4 ? 4 * q + jj : 16 + 4 * q + jj - 4); e[jj] = M[(16 * mb + i) * 66 + rho]; }
    if (slot >= 0) *(GAS v4u*)(dst + ((size_t)slot * 64 + lane) * 16) = pack8(e);
}
__device__ __forceinline__ void cacc(const f32x4 (&acc)[2], const LAS float* rowscale, unsigned char* dst, int mb, int nb0, int lane, int vbs = 2048) {
    const int fq = lane >> 4;
#pragma unroll
    for (int n = 0; n < 2; ++n) { float v[4];
#pragma unroll
        for (int r = 0; r < 4; ++r) { v[r] = acc[n][r]; if (rowscale) v[r] *= rowscale[16 * mb + 4 * fq + r]; }
        v2u w; w.x = pk2(v[0], v[1]); w.y = pk2(v[2], v[3]); *(GAS v2u*)(dst + (size_t)(nb0 + n) * vbs + ((size_t)mb * 64 + lane) * 8) = w; }
}
__device__ __forceinline__ void ccumsum(Frame& F, LAS float* CU) {
    LAS float* vec = (LAS float*)F.lds + PV_OFF; LAS float* seg = vec + 128;
    { float run = 0.f;
#pragma unroll
      for (int i = 0; i < 8; ++i) { run += CU[(8 * F.wave + i) * 66 + F.lane]; CU[(8 * F.wave + i) * 66 + F.lane] = run; }
      seg[F.wave * 64 + F.lane] = run; }
    LDS_BARRIER();
    { float off = 0.f;
#pragma unroll
      for (int w = 0; w < 8; ++w) if (w < F.wave) off += seg[w * 64 + F.lane];
#pragma unroll
      for (int i = 0; i < 8; ++i) { const float c = CU[(8 * F.wave + i) * 66 + F.lane] + off; CU[(8 * F.wave + i) * 66 + F.lane] = c; if (8 * F.wave + i == 31) vec[F.lane] = c; if (8 * F.wave + i == 63) vec[64 + F.lane] = c; } }
    LDS_BARRIER();
}
__device__ __forceinline__ f32x4 blk16(f32x4 acc, const LAS float* A, int ar0, int ac0, const LAS float* B, int br0, int bc0, int lane) {
    const int fr = lane & 15, fq = lane >> 4;
#pragma unroll
    for (int s = 0; s < 4; ++s) acc = __builtin_amdgcn_mfma_f32_16x16x4f32(A[(ar0 + fr) * 66 + ac0 + 4 * s + fq], B[(br0 + 4 * s + fq) * 66 + bc0 + fr], acc, 0, 0, 0);
    return acc;
}
__device__ __forceinline__ void blkst(const f32x4 acc, LAS float* S, int r0, int c0, int lane) {
    const int fr = lane & 15, fq = lane >> 4;
#pragma unroll
    for (int r = 0; r < 4; ++r) S[(r0 + 4 * fq + r) * 66 + c0 + fr] = acc[r];
}
__device__ __forceinline__ void tri_inverse(Frame& F, const LAS float* L, LAS float* T, LAS float* W) {
    for (int e = F.tid; e < 64 * 64; e += NWAVES * 64) { const int i = e >> 6, j = e & 63; if ((i >> 4) != (j >> 4)) T[i * 66 + j] = 0.f; }
    if (F.wave == 0) {
        const int d0 = 16 * (F.lane >> 4), c = F.lane & 15; float t[16];
#pragma unroll
        for (int i = 0; i < 16; ++i) { float a = (i == c) ? 1.f : 0.f;
#pragma unroll
            for (int j = 0; j < i; ++j) a += L[(d0 + i) * 66 + d0 + j] * t[j];
            t[i] = a; T[(d0 + i) * 66 + d0 + c] = a; }
    }
    LDS_BARRIER();
#pragma unroll
    for (int d = 1; d <= 3; ++d) {
        if (F.wave < 4 - d) { const int i = d + F.wave, j = F.wave; f32x4 acc = (f32x4){0.f, 0.f, 0.f, 0.f};
#pragma unroll
            for (int k = 0; k < 3; ++k) if (k >= j && k < i) acc = blk16(acc, L, 16 * i, 16 * k, T, 16 * k, 16 * j, F.lane);
            blkst(acc, W, 16 * i, 16 * j, F.lane); }
        LDS_BARRIER();
        if (F.wave < 4 - d) { const int i = d + F.wave, j = F.wave; f32x4 acc = (f32x4){0.f, 0.f, 0.f, 0.f};
            acc = blk16(acc, T, 16 * i, 16 * i, W, 16 * i, 16 * j, F.lane); blkst(acc, T, 16 * i, 16 * j, F.lane); }
        LDS_BARRIER();
    }
}
struct PreRaw { v4u x0, x1, x2, x3, x4, x5, f0, f1; float p0, p1, p2, p3; };
__device__ __forceinline__ v4u ld16(const void* p) { return *(const GAS v4u*)p; }
#define WSQ(T, off) ((T*)(ws_ + (off)))
__device__ __forceinline__ void pre_load(Frame& F, PreRaw& R, const int MIX, int b, int h, int c, int l) {
    int tid_ = F.tid; asm volatile("" : "+v"(tid_));
    unsigned char* ws_ = F.ws; asm volatile("" : "+s"(ws_));
    const int row = tid_ >> 3, pc = tid_ & 7; const size_t t = (size_t)(b * SEQ + c * 64 + row);
    const bf16* P = WSQ(const bf16, WS_P) + t * NP + 8 * pc;
    const v4u z = (v4u){0u, 0u, 0u, 0u};
    R.x0 = z; R.x1 = z; R.x2 = z; R.x3 = z; R.x4 = z; R.x5 = z; R.f0 = z; R.f1 = z;
    const int kch = 16 * ((tid_ >> 6) & 3) + (tid_ & 15);
    if (MIX == 0) { R.x0 = ld16(P + HG_F + 64 * h); R.x1 = ld16(P + HG_Q + 64 * h); R.x2 = ld16(P + HG_I + 64 * h); }
    else if (MIX == 1) { R.x2 = ld16(P + GL_V + 64 * h); const bf16* P3 = P - 8 * (pc & 4); R.x0 = ld16(P3 + GL_GX + 32 * h); R.x1 = ld16(P3 + GL_Q + 32 * h); R.x3 = ld16(P3 + GL_K + 32 * h); }
    else if (MIX == 2) { const size_t o = t * 256 + 64 * h + 8 * pc;
        R.x1 = ld16(WSQ(const bf16, WS_RWR) + o); R.x2 = ld16(WSQ(const bf16, WS_RWV) + o); R.x3 = ld16(WSQ(const bf16, WS_RWK) + o); R.x4 = ld16(WSQ(const bf16, WS_RWKK) + o); R.x5 = ld16(WSQ(const bf16, WS_RWB) + o);
        R.f0 = ld16(WSQ(const float, WS_RWW) + o); R.f1 = ld16(WSQ(const float, WS_RWW) + o + 4); }
    else { R.x0 = ld16(P + RT_Q + 64 * h); R.x2 = ld16(P + RT_V + 64 * h); R.x3 = ld16(P + RT_K + 64 * h);
        const float* cs = WSQ(const float, WS_CS) + t * 64 + 8 * pc; R.f0 = ld16(cs); R.f1 = ld16(cs + 4); }
    {
        const float* pp = (MIX == 0) ? INF(8) + 64 * h + kch : (MIX == 1) ? INF(11) + l * 128 + 32 * (h & 3) + (kch & 31) : INF(8); const int ps = (MIX == 0) ? 256 : 0;
        R.p0 = pp[0]; R.p1 = pp[ps]; R.p2 = pp[2 * ps]; R.p3 = pp[3 * ps]; }
}
__device__ __forceinline__ float ubf(unsigned u) { return __uint_as_float(u << 16); }
__device__ __forceinline__ v4u pack8v(const float (&f)[8]) { v4u w; w.x = pk2(f[0], f[1]); w.y = pk2(f[2], f[3]); w.z = pk2(f[4], f[5]); w.w = pk2(f[6], f[7]); return w; }
__device__ __forceinline__ void hfrag_trs(const LAS bf16* M, const LAS float* scale, unsigned char* dst, int wave, int lane) {
    const int mb = wave >> 1, ks = wave & 1, g = lane >> 4, q = (lane & 15) >> 2, p = lane & 3; const LAS bf16* a = M + (32 * ks + 4 * g + q) * 72 + 16 * mb + 4 * p;
    const v2u lo = trr(a), hi = trr(a + 16 * 72); v4u w; w.x = lo.x; w.y = lo.y; w.z = hi.x; w.w = hi.y;
    float e[8]; unpack8(w, e); const f32x4 s0 = *(const LAS f32x4*)(scale + 32 * ks + 4 * g), s1 = *(const LAS f32x4*)(scale + 32 * ks + 16 + 4 * g);
    e[0] *= s0.x; e[1] *= s0.y; e[2] *= s0.z; e[3] *= s0.w; e[4] *= s1.x; e[5] *= s1.y; e[6] *= s1.z; e[7] *= s1.w;
    *(GAS v4u*)(dst + ((size_t)wave * 64 + lane) * 16) = pack8(e);
}
__device__ __forceinline__ void chunk_pre(Frame& F, PreRaw& R, int l, const int MIX, int b, int h, int c, unsigned char* rec, const int nMIX, int nh) {
    const int t0 = b * SEQ + c * 64;
    LAS float* SEG = PBUF(0); LAS float* LL = PBUF(1); LAS float* T32 = PBUF(2); LAS float* WW = PBUF(0);
    LAS bf16* A1 = HBUF(0); LAS bf16* R1 = HBUF(1); LAS bf16* B1 = HBUF(2); LAS bf16* K1 = HBUF(3); LAS bf16* KeT = HBUF(4); LAS bf16* VT = HBUF(5); LAS bf16* BeT = HBUF(6); LAS bf16* M1 = HBUF(7); LAS bf16* M2 = HBUF(8); LAS bf16* M3 = HBUF(9);
    LAS float* vec = (LAS float*)F.lds + PV_OFF; LAS float* ecm = vec + 640;
    int tid_ = F.tid; asm volatile("" : "+v"(tid_));
    unsigned char* ws_ = F.ws; asm volatile("" : "+s"(ws_));
    const int lane_ = tid_ & 63, wave_ = __builtin_amdgcn_readfirstlane(tid_ >> 6);
    const int mb = wave_ >> 1, nb0 = 2 * (wave_ & 1), fr = lane_ & 15, fq = lane_ >> 4;
    const int cc = wave_ & 3, ks = wave_ >> 2; const int k_ = 16 * cc + fr, sb = 4 * ks + fq;
    const float px0 = R.p0, px1 = R.p1, px2 = R.p2, px3 = R.p3;
    {   const int row = tid_ >> 3, pc = tid_ & 7; LAS bf16* rb = HBUF(4) + row * 72 + 8 * pc;
        if (MIX == 0) { *(LAS v4u*)(rb) = R.x0; *(LAS v4u*)(rb + HB_) = R.x1; *(LAS v4u*)(rb + 2 * HB_) = R.x2; asm volatile("; raw tiles, mixer 0" ::: "memory"); }
        else if (MIX == 1) { *(LAS v4u*)(rb) = R.x0; *(LAS v4u*)(rb + HB_) = R.x1; *(LAS v4u*)(rb + 2 * HB_) = R.x2; *(LAS v4u*)(rb + 3 * HB_) = R.x3; asm volatile("; raw tiles, mixer 1" ::: "memory"); }
        else if (MIX == 2) { *(LAS v4u*)(rb + HB_) = R.x1; *(LAS v4u*)(rb + 2 * HB_) = R.x2; *(LAS v4u*)(rb + 3 * HB_) = R.x3; *(LAS v4u*)(rb + 4 * HB_) = R.x4; *(LAS v4u*)(rb + 5 * HB_) = R.x5; asm volatile("; raw tiles, mixer 2" ::: "memory"); }
        else { *(LAS v4u*)(rb) = R.x0; *(LAS v4u*)(rb + 2 * HB_) = R.x2; *(LAS v4u*)(rb + 3 * HB_) = R.x3; asm volatile("; raw tiles, mixer 3" ::: "memory"); }
        if (MIX >= 2) { LAS v2u* fb = (LAS v2u*)(PBUF(1) + row * 66 + 8 * pc); v2u a_; a_.x = R.f0.x; a_.y = R.f0.y; fb[0] = a_; a_.x = R.f0.z; a_.y = R.f0.w; fb[1] = a_; a_.x = R.f1.x; a_.y = R.f1.y; fb[2] = a_; a_.x = R.f1.z; a_.y = R.f1.w; fb[3] = a_; }
    }
    pre_load(F, R, nMIX, b, nh, c, l);
    LDS_BARRIER();
    float q[8], kx[8], lw[8], v[8], av[8], bv[8];
    if (MIX == 0) {
        const float x0 = px0, x1 = px1, x2 = px2, x3 = px3; const float mx = fmaxf(fmaxf(x0, x1), fmaxf(x2, x3));
        float fv[8], qv[8]; unpack8(__builtin_bit_cast(v4u, trfrag(HBUF(4), cc, ks, lane_)), fv); unpack8(__builtin_bit_cast(v4u, trfrag(HBUF(5), cc, ks, lane_)), qv); unpack8(__builtin_bit_cast(v4u, trfrag(HBUF(6), cc, ks, lane_)), v);
        const float e0 = __expf(x0 - mx), e1 = __expf(x1 - mx), e2 = __expf(x2 - mx), e3 = __expf(x3 - mx);
        const float lb = ((l >= 1 ? e1 : 0.f) + (l >= 2 ? e2 : 0.f) + (l >= 3 ? e3 : 0.f)) / (e0 + e1 + e2 + e3);
#pragma unroll
        for (int i = 0; i < 8; ++i) { const float fr_ = fv[i], qr = qv[i]; const float w = lb + (1.f - lb) * sigm(fr_); lw[i] = __logf(w); kx[i] = 1.f - w; q[i] = qr * sigm(qr); }
    } else if (MIX == 1) {
        const float gb = px0;
        unpack8(__builtin_bit_cast(v4u, trfrag(HBUF(6), cc, ks, lane_)), v);
        if (cc < 2) {
            float gx[8], qv[8]; unpack8(__builtin_bit_cast(v4u, trfrag(HBUF(4), cc, ks, lane_)), gx); unpack8(__builtin_bit_cast(v4u, trfrag(HBUF(5), cc, ks, lane_)), qv); unpack8(__builtin_bit_cast(v4u, trfrag(HBUF(7), cc, ks, lane_)), kx);
#pragma unroll
            for (int i = 0; i < 8; ++i) { const float x = gx[i] + gb; lw[i] = 0.0625f * (fminf(x, 0.f) - __logf(1.f + __expf(-fabsf(x)))); q[i] = qv[i] * 0.17677669529663687f; }
        } else {
#pragma unroll
            for (int i = 0; i < 8; ++i) { lw[i] = 0.f; q[i] = 0.f; kx[i] = 0.f; } }
    } else if (MIX == 2) {
        unpack8(__builtin_bit_cast(v4u, trfrag(HBUF(5), cc, ks, lane_)), q); unpack8(__builtin_bit_cast(v4u, trfrag(HBUF(6), cc, ks, lane_)), v); unpack8(__builtin_bit_cast(v4u, trfrag(HBUF(7), cc, ks, lane_)), kx);
        unpack8(__builtin_bit_cast(v4u, trfrag(HBUF(8), cc, ks, lane_)), av); unpack8(__builtin_bit_cast(v4u, trfrag(HBUF(9), cc, ks, lane_)), bv);
#pragma unroll
        for (int i = 0; i < 8; ++i) { lw[i] = PBUF(1)[(8 * sb + i) * 66 + k_]; av[i] = -av[i]; }
    } else {
        const bool hi = cc >= 2; const int k31 = 16 * (cc & 1) + fr; const float lgam = __logf(1.f - exp2f(-5.f - (float)h));
        float q1[8], q2[8], k1[8], k2[8]; unpack8(__builtin_bit_cast(v4u, trfrag(HBUF(4), cc & 1, ks, lane_)), q1); unpack8(__builtin_bit_cast(v4u, trfrag(HBUF(4), (cc & 1) + 2, ks, lane_)), q2);
        unpack8(__builtin_bit_cast(v4u, trfrag(HBUF(7), cc & 1, ks, lane_)), k1); unpack8(__builtin_bit_cast(v4u, trfrag(HBUF(7), (cc & 1) + 2, ks, lane_)), k2); unpack8(__builtin_bit_cast(v4u, trfrag(HBUF(6), cc, ks, lane_)), v);
#pragma unroll
        for (int i = 0; i < 8; ++i) { const f32x2_t csv = *(const LAS f32x2_t*)(PBUF(1) + (8 * sb + i) * 66 + 2 * k31); const float cs_ = csv.x, sn = csv.y;
            q[i] = hi ? (q1[i] * sn + q2[i] * cs_) : (q1[i] * cs_ - q2[i] * sn); kx[i] = 0.125f * (hi ? (k1[i] * sn + k2[i] * cs_) : (k1[i] * cs_ - k2[i] * sn)); lw[i] = lgam; }
    }
    float cu[8]; { float run = 0.f;
#pragma unroll
        for (int i = 0; i < 8; ++i) { run += lw[i]; cu[i] = run; }
        SEG[sb * 64 + k_] = run; }
    LDS_BARRIER();
    float cm, ce; { float pre = 0.f, tot = 0.f, mid = 0.f;
#pragma unroll
        for (int w = 0; w < 8; ++w) { const float s = SEG[w * 64 + k_]; if (w < sb) pre += s; if (w < 4) mid += s; tot += s; }
        cm = mid; ce = tot;
#pragma unroll
        for (int i = 0; i < 8; ++i) cu[i] += pre; }
    {   float e1[8], e2[8], e3[8];
#pragma unroll
        for (int i = 0; i < 8; ++i) { const float ef = __expf(fminf(fmaxf(cu[i] - cm, -80.f), 80.f)); e1[i] = q[i] * ef; e2[i] = kx[i] * __builtin_amdgcn_rcpf(ef); e3[i] = kx[i] * __expf(ce - cu[i]); }
        *(LAS v4u*)(R1 + k_ * 72 + 8 * sb) = pack8v(e1); *(LAS v4u*)(K1 + k_ * 72 + 8 * sb) = pack8v(e2); *(LAS v4u*)(KeT + k_ * 72 + 8 * sb) = pack8v(e3); *(LAS v4u*)(VT + k_ * 72 + 8 * sb) = pack8v(v);
        if (MIX == 2) {
#pragma unroll
            for (int i = 0; i < 8; ++i) { const float ef = __expf(fminf(fmaxf(cu[i] - cm, -80.f), 80.f)); e1[i] = av[i] * __expf(fminf(fmaxf(cu[i] - lw[i] - cm, -80.f), 80.f)); e2[i] = bv[i] * __builtin_amdgcn_rcpf(ef); e3[i] = bv[i] * __expf(ce - cu[i]); }
            *(LAS v4u*)(A1 + k_ * 72 + 8 * sb) = pack8v(e1); *(LAS v4u*)(B1 + k_ * 72 + 8 * sb) = pack8v(e2); *(LAS v4u*)(BeT + k_ * 72 + 8 * sb) = pack8v(e3); }
        if (sb == 0) ecm[k_] = __expf(cm);
    }
    LDS_BARRIER();
    { const unsigned u_ = R.x0.x | R.x1.x | R.x2.x | R.x3.x | R.x4.x | R.x5.x | R.f0.x | R.f1.x | __float_as_uint(R.p0) | __float_as_uint(R.p1) | __float_as_uint(R.p2) | __float_as_uint(R.p3); asm volatile("; next item's raw inputs have landed" :: "v"(u_) : "memory"); }
    if (sb == 0) *(GAS float*)(rec + (MIX == 2 ? RO_GAM : GO_GAM) + 4 * k_) = __expf(ce);
    f32x4 acc[2];
    tn16(acc, R1, K1, mb, nb0, lane_); hst<1>(acc, M1, mb, nb0, lane_);
    hfrag_trs(R1, ecm, rec + (MIX == 2 ? RO_QH : GO_QH), wave_, lane_);
    nt16(acc, KeT, VT, mb, nb0, lane_); if (MIX == 2) cacc(acc, nullptr, rec + RO_VB + 2048, mb, nb0, lane_, 4096); else cacc(acc, nullptr, rec + GO_SK, mb, nb0, lane_);
    if (MIX == 2) {
        tn16(acc, A1, B1, mb, nb0, lane_); cst<2>(acc, LL, mb, nb0, lane_);
        tn16(acc, R1, B1, mb, nb0, lane_); hst<1>(acc, M2, mb, nb0, lane_);
        tn16(acc, A1, K1, mb, nb0, lane_); hst<2>(acc, M3, mb, nb0, lane_);
        hfrag_trs(A1, ecm, rec + RO_AT, wave_, lane_);
        hfrag(BeT, nullptr, rec + RO_BH, wave_, lane_);
    }
    LDS_BARRIER();
    nt16(acc, M1, VT, mb, nb0, lane_);
#pragma unroll
    for (int n = 0; n < 2; ++n)
#pragma unroll
        for (int r = 0; r < 4; ++r) A1[(16 * mb + 4 * fq + r) * 72 + 16 * (nb0 + n) + fr] = (bf16)f2bf(acc[n][r]);
    if (MIX == 2) {
        nt16(acc, M3, VT, mb, nb0, lane_); cacc(acc, nullptr, rec + RO_VB, mb, nb0, lane_, 4096);
        const int t6 = ((wave_ & 1) == 1 && (wave_ >> 1) < 2) ? -1 : ((wave_ >> 1) < 2 ? (wave_ >> 1) : 2 + ((wave_ >> 1) - 2) * 2 + (wave_ & 1));
        hfrag(M2, nullptr, rec + RO_MRB, wave_, lane_, t6);
        tri_inverse(F, LL, T32, WW);
        cfrag(T32, rec + RO_TT, wave_, lane_, t6);
    }
    LDS_BARRIER();
}
constexpr size_t WS_REC_RW = 14 * MiB, WS_REC_GL = 412 * MiB;
__device__ __forceinline__ void oloc_flush(Frame& F, int m, int t0, int h) {
    const int t = F.tid >> 3, pc = F.tid & 7; const v4u w = *(const LAS v4u*)(HBUF(0) + t * 72 + 8 * pc);
    *(GAS v4u*)(WSP(bf16, WS_O) + (size_t)m * TOK * 256 + (size_t)(t0 + t) * 256 + 64 * h + 8 * pc) = w;
}
__device__ __forceinline__ unsigned char* pre_rec(Frame& F, int m, int b, int h, int c) {
    return (m == 2) ? F.ws + WS_REC_RW + (size_t)(((b * 4 + h) * 64) + c) * REC_RW : F.ws + WS_REC_GL + (size_t)((((m == 3 ? 2 : m) * 16 + b * 4 + h) * 64) + c) * REC_GL;
}
__device__ __forceinline__ void phase_chunkpre(Frame& F, int l) {
    for (int tile = F.vcu; tile < TOK / 64; tile += F.G) {
        const int b = tile >> 6, c = tile & 63;
        rwprep_tile(F, l, tile);
        PreRaw cur;
        pre_load(F, cur, 0, b, 0, c, l);
        __syncthreads();
        { const unsigned u_ = cur.x0.x | cur.x1.x | cur.x2.x | cur.x3.x | cur.x4.x | cur.x5.x | cur.f0.x | cur.f1.x | __float_as_uint(cur.p0) | __float_as_uint(cur.p1) | __float_as_uint(cur.p2) | __float_as_uint(cur.p3); asm volatile("; first item's raw inputs have landed" :: "v"(u_) : "memory"); }
#pragma unroll 1
        for (int i = 0; i < 16; ++i) {
            const int mo = i >> 2, m = (mo == 2) ? 3 : (mo == 3 ? 2 : mo), h = i & 3;
            const int mo2 = (i + 1) >> 2, m2 = (i + 1 < 16) ? ((mo2 == 2) ? 3 : (mo2 == 3 ? 2 : mo2)) : 0;
            chunk_pre(F, cur, l, m, b, h, c, pre_rec(F, m, b, h, c), m2, (i + 1) & 3);
            oloc_flush(F, m, b * SEQ + c * 64, h);
        }
    }
}
__device__ __forceinline__ bf16x8 pack_b(const f32x4 a, const f32x4 b) { v4u w; w.x = pk2(a.x, a.y); w.y = pk2(a.z, a.w); w.z = pk2(b.x, b.y); w.w = pk2(b.z, b.w); return __builtin_bit_cast(bf16x8, w); }
__device__ __forceinline__ f32x4 unpk4(const v2u w) { return (f32x4){bflo(w.x), bfhi(w.x), bflo(w.y), bfhi(w.y)}; }
template <int NF> struct SeqRegs { v4u r[NF]; v4u tail; };
template <int NF, int NLT, bool TAIL> __device__ __forceinline__ void seq_ld(SeqRegs<NF>& R, const unsigned char* rec, int lt) {
    const GAS v4u* src = (const GAS v4u*)rec;
#pragma unroll
    for (int i = 0; i < NF; ++i) R.r[i] = src[i * NLT + lt];
    if (TAIL && lt < 16) R.tail = src[NF * NLT + lt];
}
template <int NF, int NLT, bool TAIL> __device__ __forceinline__ void seq_st(const SeqRegs<NF>& R, LAS unsigned char* slot, int lt) {
    LAS v4u* dst = (LAS v4u*)slot;
#pragma unroll
    for (int i = 0; i < NF; ++i) dst[i * NLT + lt] = R.r[i];
    if (TAIL && lt < 16) dst[NF * NLT + lt] = R.tail;
}
template <bool RW> __device__ __forceinline__ void seq_unit(Frame& F, int mix, int b, int h, int vb_, const unsigned char* recs) {
    constexpr int REC = RW ? REC_RW : REC_GL, SLOT = 61440, NCW = RW ? 1 : 4, LW0 = RW ? 2 : 4, NLT = (8 - LW0) * 64, NF = REC / (NLT * 16); constexpr bool TAIL = (REC % (NLT * 16)) != 0;
    static_assert(REC % (NLT * 16) == 0 || REC % (NLT * 16) == 256, "record = NF loader rounds (+ 256 B)");
    const bool loader = F.wave >= LW0, compute = F.wave < NCW; const int lt = F.tid - 64 * LW0;
    SeqRegs<NF> RA, RB;
    if (loader) { seq_ld<NF, NLT, TAIL>(RA, recs, lt); seq_st<NF, NLT, TAIL>(RA, F.lds, lt); seq_ld<NF, NLT, TAIL>(RB, recs + (size_t)1 * REC, lt); seq_ld<NF, NLT, TAIL>(RA, recs + (size_t)2 * REC, lt); }
    __syncthreads();
    f32x4 S[4];
#pragma unroll
    for (int kb = 0; kb < 4; ++kb) S[kb] = (f32x4){0.f, 0.f, 0.f, 0.f};
    const int vb = RW ? vb_ : (F.wave & 3), fr = F.lane & 15, fq = F.lane >> 4;
    bf16* Og_ = WSP(bf16, WS_OI) + OI_GEN + (size_t)(((mix == 3 ? 2 : mix) * 16 + b * 4 + h)) * (SEQ * 64);
    constexpr int OSO = 122880;
    constexpr int PFD = 8, NLN = (REC + 127) / 128; LAS unsigned* PFDUMMY = (LAS unsigned*)(F.lds + OSO + 2 * 8192);
#define SEQ_PFG(cp) do { const unsigned char* rp_ = recs + (size_t)(cp) * REC; _Pragma("unroll") for (int j_ = 0; j_ < (NLN + 63) / 64; ++j_) { const int s_ = j_ * 64 + F.lane; \
        __builtin_amdgcn_global_load_lds((const unsigned*)(rp_ + (unsigned)((s_ < NLN ? s_ : NLN - 1) * 128)), PFDUMMY + j_ * 64, 4, 0, 0); } } while (0)
    if (!RW && F.wave == 3) {
#pragma unroll 1
        for (int cp = 3; cp < PFD; ++cp) SEQ_PFG(cp); }
#define SEQ_FLUSH(cc) do { const LAS unsigned char* osr_ = F.lds + OSO + ((cc) & 1) * 8192 + (16 * vb + (F.lane >> 2)) * 128 + (F.lane & 3) * 32; bf16* dst_ = Og_ + ((size_t)(cc) * 64 + 16 * vb + (F.lane >> 2)) * 64 + (F.lane & 3) * 16; \
        const v4u a_ = *(const LAS v4u*)osr_, b_ = *(const LAS v4u*)(osr_ + 16); *(GAS v4u*)dst_ = a_; *(GAS v4u*)(dst_ + 8) = b_; } while (0)
#pragma unroll 1
    for (int c2 = 0; c2 < 64; c2 += 2) {
#pragma unroll
        for (int par = 0; par < 2; ++par) {
            const int c = c2 + par;
            if (loader) {
                if (par == 0) { seq_st<NF, NLT, TAIL>(RB, F.lds + SLOT, lt); if (c + 3 < 64) seq_ld<NF, NLT, TAIL>(RB, recs + (size_t)(c + 3) * REC, lt); }
                else { if (c + 1 < 64) seq_st<NF, NLT, TAIL>(RA, F.lds, lt); if (c + 3 < 64) seq_ld<NF, NLT, TAIL>(RA, recs + (size_t)(c + 3) * REC, lt); }
            } else if (compute) {
                const LAS unsigned char* R = F.lds + par * SLOT;
                const f32x4 z = (f32x4){0.f, 0.f, 0.f, 0.f};
                if (!RW && F.wave == 3 && c + PFD < 64) SEQ_PFG(c + PFD);
                if (c > 0) SEQ_FLUSH(c - 1);
                bf16x8 fqh[8];
#pragma unroll
                for (int f = 0; f < 8; ++f) fqh[f] = *(const LAS bf16x8*)(R + (RW ? RO_QH : GO_QH) + (f * 64 + F.lane) * 16);
                bf16x8 bS[2]; bS[0] = pack_b(S[0], S[1]); bS[1] = pack_b(S[2], S[3]);
                asm volatile("s_waitcnt lgkmcnt(0)" ::: "memory"); __builtin_amdgcn_sched_barrier(0);
                f32x4 O[4]; bf16x8 bU[2];
#pragma unroll
                for (int mb = 0; mb < 4; ++mb) { O[mb] = z;
#pragma unroll
                    for (int ks = 0; ks < 2; ++ks) O[mb] = __builtin_amdgcn_mfma_f32_16x16x32_bf16(fqh[mb * 2 + ks], bS[ks], O[mb], 0, 0, 0); }
                if (RW) {
                    f32x4 X[4], U[4];
#pragma unroll
                    for (int mb = 0; mb < 4; ++mb) { X[mb] = unpk4(*(const LAS v2u*)(R + RO_Y + ((vb * 4 + mb) * 64 + F.lane) * 8));
#pragma unroll
                        for (int ks = 0; ks < 2; ++ks) X[mb] = __builtin_amdgcn_mfma_f32_16x16x32_bf16(*(const LAS bf16x8*)(R + RO_AT + ((mb * 2 + ks) * 64 + F.lane) * 16), bS[ks], X[mb], 0, 0, 0); }
                    bf16x8 bX[2]; bX[0] = pack_b(X[0], X[1]); bX[1] = pack_b(X[2], X[3]);
#pragma unroll
                    for (int mb = 0; mb < 4; ++mb) { U[mb] = z;
#pragma unroll
                        for (int ks = 0; ks < 2; ++ks) if (!(ks == 1 && mb < 2)) U[mb] = __builtin_amdgcn_mfma_f32_16x16x32_bf16(*(const LAS bf16x8*)(R + RO_TT + ((mb * 2 + ks) * 64 + F.lane) * 16), bX[ks], U[mb], 0, 0, 0); }
                    bU[0] = pack_b(U[0], U[1]); bU[1] = pack_b(U[2], U[3]);
#pragma unroll
                    for (int mb = 0; mb < 4; ++mb)
#pragma unroll
                        for (int ks = 0; ks < 2; ++ks) if (!(ks == 1 && mb < 2)) O[mb] = __builtin_amdgcn_mfma_f32_16x16x32_bf16(*(const LAS bf16x8*)(R + RO_MRB + ((mb * 2 + ks) * 64 + F.lane) * 16), bU[ks], O[mb], 0, 0, 0);
                }
#pragma unroll
                for (int kb = 0; kb < 4; ++kb) { const f32x4 g = *(const LAS f32x4*)(R + (RW ? RO_GAM : GO_GAM) + (16 * kb + 4 * fq) * 4); const f32x4 sk = unpk4(*(const LAS v2u*)(R + (RW ? RO_SK : GO_SK) + ((vb * 4 + kb) * 64 + F.lane) * 8));
                    f32x4 n = S[kb] * g + sk;
                    if (RW) {
#pragma unroll
                        for (int ks = 0; ks < 2; ++ks) n = __builtin_amdgcn_mfma_f32_16x16x32_bf16(*(const LAS bf16x8*)(R + RO_BH + ((kb * 2 + ks) * 64 + F.lane) * 16), bU[ks], n, 0, 0, 0);
                    }
                    S[kb] = n; }
#pragma unroll
                for (int mb = 0; mb < 4; ++mb)
#pragma unroll
                    for (int r = 0; r < 4; ++r) *(LAS bf16*)(F.lds + OSO + par * 8192 + (16 * mb + 4 * fq + r) * 128 + (16 * vb + fr) * 2) = (bf16)f2bf(O[mb][r]);
            }
            LDS_BARRIER();
        }
    }
    if (compute) SEQ_FLUSH(63);
#undef SEQ_FLUSH
#undef SEQ_PFG
    VM_WAIT();
    __syncthreads();
}
__device__ __forceinline__ int tri6(int mb, int ks) { return mb < 2 ? mb : 2 + (mb - 2) * 2 + ks; }
struct SeqRegs4 { v4u r[6]; v4u t; };
__device__ __forceinline__ void seq4_ld(SeqRegs4& R, const unsigned char* rec, int vb, int lt) {
    const GAS v4u* src = (const GAS v4u*)rec;
#pragma unroll
    for (int i = 0; i < 6; ++i) R.r[i] = src[i * 384 + lt];
    if (lt < 16) R.t = src[6 * 384 + lt];
    if (lt >= 128) R.t = *(const GAS v4u*)(rec + RO_VB + vb * 4096 + (lt - 128) * 16);
}
__device__ __forceinline__ void seq4_st(const SeqRegs4& R, LAS unsigned char* slot, int lt) {
    LAS v4u* dst = (LAS v4u*)slot;
#pragma unroll
    for (int i = 0; i < 6; ++i) dst[i * 384 + lt] = R.r[i];
    if (lt < 16) dst[6 * 384 + lt] = R.t;
    if (lt >= 128) *(LAS v4u*)(slot + 37120 + (lt - 128) * 16) = R.t;
}
__device__ __forceinline__ void seq_rw(Frame& F, int b, int h, int vb, const unsigned char* recs) {
    constexpr int REC = REC_RW, SLOT = 41216, EXO = 3 * SLOT;
    const bool loader = F.wave >= 2; const int lt = F.tid - 128;
    SeqRegs4 RA, RB;
    if (loader) { seq4_ld(RA, recs, vb, lt); seq4_st(RA, F.lds, lt); seq4_ld(RB, recs + (size_t)1 * REC, vb, lt); seq4_ld(RA, recs + (size_t)2 * REC, vb, lt); }
    __syncthreads();
    f32x4 S[4];
#pragma unroll
    for (int kb = 0; kb < 4; ++kb) S[kb] = (f32x4){0.f, 0.f, 0.f, 0.f};
    const int fr = F.lane & 15, fq = F.lane >> 4;
    bf16* Og_ = WSP(bf16, WS_OI) + (size_t)((b * 4 + h) * 4 + vb) * (SEQ * 16);
    LAS unsigned char* OS = F.lds + EXO + 8192;
    constexpr int PFD = 8; LAS unsigned* PFDUMMY = (LAS unsigned*)(F.lds + EXO + 8192 + 2048);
#define SEQ_PF(cp) do { const unsigned char* rp_ = recs + (size_t)(cp) * REC; const int li_ = F.lane; \
        __builtin_amdgcn_global_load_lds((const unsigned*)(rp_ + vb * 9216 + li_ * 128), PFDUMMY, 4, 0, 0); \
        const unsigned o2_ = li_ < 8 ? (unsigned)(vb * 9216 + (64 + li_) * 128) : li_ < 40 ? (unsigned)(RO_VB + vb * 4096 + (li_ - 8) * 128) : (unsigned)(RO_GAM + ((li_ - 40) & 1) * 128); \
        __builtin_amdgcn_global_load_lds((const unsigned*)(rp_ + o2_), PFDUMMY + 64, 4, 0, 0); } while (0)
    if (F.wave == 1) {
#pragma unroll 1
        for (int cp = 3; cp < PFD; ++cp) SEQ_PF(cp); }
#pragma unroll 1
    for (int c2 = 0; c2 < 66; c2 += 2) {
#pragma unroll
        for (int par = 0; par < 2; ++par) {
            const int c = c2 + par;
            if (loader) {
                if (c + 1 < 64) { LAS unsigned char* dst = F.lds + ((c + 1) % 3) * SLOT; if (par == 0) seq4_st(RB, dst, lt); else seq4_st(RA, dst, lt); }
                if (c + 3 < 64) { if (par == 0) seq4_ld(RB, recs + (size_t)(c + 3) * REC, vb, lt); else seq4_ld(RA, recs + (size_t)(c + 3) * REC, vb, lt); }
            } else if (F.wave == 0) {
                if (c < 64) {
                    const LAS unsigned char* R = F.lds + (c % 3) * SLOT; LAS unsigned char* EX = F.lds + EXO + par * 4096;
                    const f32x4 z = (f32x4){0.f, 0.f, 0.f, 0.f};
                    v2u yv[4]; bf16x8 fat[8], ftt[6];
#pragma unroll
                    for (int mb = 0; mb < 4; ++mb) yv[mb] = *(const LAS v2u*)(R + 37120 + (mb * 64 + F.lane) * 8);
#pragma unroll
                    for (int f = 0; f < 8; ++f) fat[f] = *(const LAS bf16x8*)(R + RO_AT + (f * 64 + F.lane) * 16);
                    bf16x8 bS[2]; bS[0] = pack_b(S[0], S[1]); bS[1] = pack_b(S[2], S[3]);
                    *(LAS bf16x8*)(EX + F.lane * 16) = bS[0]; *(LAS bf16x8*)(EX + 1024 + F.lane * 16) = bS[1];
                    asm volatile("s_waitcnt lgkmcnt(0)" ::: "memory"); __builtin_amdgcn_sched_barrier(0);
                    f32x4 X[4], U[4];
#pragma unroll
                    for (int mb = 0; mb < 4; ++mb) { X[mb] = unpk4(yv[mb]);
#pragma unroll
                        for (int ks = 0; ks < 2; ++ks) X[mb] = __builtin_amdgcn_mfma_f32_16x16x32_bf16(fat[mb * 2 + ks], bS[ks], X[mb], 0, 0, 0); }
                    __builtin_amdgcn_sched_barrier(0);
                    bf16x8 fbh[8]; f32x4 gm[4]; v2u skv[4];
#pragma unroll
                    for (int f = 0; f < 6; ++f) ftt[f] = *(const LAS bf16x8*)(R + RO_TT + (f * 64 + F.lane) * 16);
#pragma unroll
                    for (int f = 0; f < 8; ++f) fbh[f] = *(const LAS bf16x8*)(R + RO_BH + (f * 64 + F.lane) * 16);
#pragma unroll
                    for (int kb = 0; kb < 4; ++kb) { gm[kb] = *(const LAS f32x4*)(R + RO_GAM + (16 * kb + 4 * fq) * 4); skv[kb] = *(const LAS v2u*)(R + 37120 + 2048 + (kb * 64 + F.lane) * 8); }
                    __builtin_amdgcn_sched_barrier(0);
                    bf16x8 bX[2]; bX[0] = pack_b(X[0], X[1]); bX[1] = pack_b(X[2], X[3]);
#pragma unroll
                    for (int mb = 0; mb < 4; ++mb) { U[mb] = z;
#pragma unroll
                        for (int ks = 0; ks < 2; ++ks) if (!(ks == 1 && mb < 2)) U[mb] = __builtin_amdgcn_mfma_f32_16x16x32_bf16(ftt[tri6(mb, ks)], bX[ks], U[mb], 0, 0, 0); }
                    bf16x8 bU[2]; bU[0] = pack_b(U[0], U[1]); bU[1] = pack_b(U[2], U[3]);
                    *(LAS bf16x8*)(EX + 2048 + F.lane * 16) = bU[0]; *(LAS bf16x8*)(EX + 3072 + F.lane * 16) = bU[1];
                    asm volatile("s_waitcnt lgkmcnt(0)" ::: "memory"); __builtin_amdgcn_sched_barrier(0);
#pragma unroll
                    for (int kb = 0; kb < 4; ++kb) { f32x4 n = S[kb] * gm[kb] + unpk4(skv[kb]);
#pragma unroll
                        for (int ks = 0; ks < 2; ++ks) n = __builtin_amdgcn_mfma_f32_16x16x32_bf16(fbh[kb * 2 + ks], bU[ks], n, 0, 0, 0);
                        S[kb] = n; }
                }
            } else {
                if (c + PFD < 64) SEQ_PF(c + PFD);
                if (c >= 1 && c <= 64) {
                    const int co = c - 1; const LAS unsigned char* R = F.lds + (co % 3) * SLOT; const LAS unsigned char* EX = F.lds + EXO + (par ^ 1) * 4096;
                    bf16x8 fq_[8], fm[6];
#pragma unroll
                    for (int f = 0; f < 8; ++f) fq_[f] = *(const LAS bf16x8*)(R + RO_QH + (f * 64 + F.lane) * 16);
#pragma unroll
                    for (int f = 0; f < 6; ++f) fm[f] = *(const LAS bf16x8*)(R + RO_MRB + (f * 64 + F.lane) * 16);
                    const bf16x8 bS0 = *(const LAS bf16x8*)(EX + F.lane * 16), bS1 = *(const LAS bf16x8*)(EX + 1024 + F.lane * 16), bU0 = *(const LAS bf16x8*)(EX + 2048 + F.lane * 16), bU1 = *(const LAS bf16x8*)(EX + 3072 + F.lane * 16);
                    asm volatile("s_waitcnt lgkmcnt(0)" ::: "memory"); __builtin_amdgcn_sched_barrier(0);
                    f32x4 O[4];
#pragma unroll
                    for (int mb = 0; mb < 4; ++mb) { O[mb] = (f32x4){0.f, 0.f, 0.f, 0.f};
                        O[mb] = __builtin_amdgcn_mfma_f32_16x16x32_bf16(fq_[mb * 2], bS0, O[mb], 0, 0, 0);
                        O[mb] = __builtin_amdgcn_mfma_f32_16x16x32_bf16(fq_[mb * 2 + 1], bS1, O[mb], 0, 0, 0);
                        O[mb] = __builtin_amdgcn_mfma_f32_16x16x32_bf16(fm[tri6(mb, 0)], bU0, O[mb], 0, 0, 0);
                        if (mb >= 2) O[mb] = __builtin_amdgcn_mfma_f32_16x16x32_bf16(fm[tri6(mb, 1)], bU1, O[mb], 0, 0, 0); }
#pragma unroll
                    for (int mb = 0; mb < 4; ++mb)
#pragma unroll
                        for (int r = 0; r < 4; ++r) *(LAS bf16*)(OS + (16 * mb + 4 * fq + r) * 32 + fr * 2) = (bf16)f2bf(O[mb][r]);
                    asm volatile("s_waitcnt lgkmcnt(0)" ::: "memory");
                    { const v4u a_ = *(const LAS v4u*)(OS + F.lane * 32), b_ = *(const LAS v4u*)(OS + F.lane * 32 + 16); bf16* dst_ = Og_ + ((size_t)co * 64 + F.lane) * 16; *(GAS v4u*)dst_ = a_; *(GAS v4u*)(dst_ + 8) = b_; }
                    asm volatile("s_waitcnt lgkmcnt(0)" ::: "memory");
                }
            }
            LDS_BARRIER();
        }
    }
#undef SEQ_PF
    VM_WAIT();
    __syncthreads();
}
__device__ __forceinline__ void phase_seq(Frame& F, int l) {
    for (int u = blockIdx.x; u < 112; u += F.G) {
        if (u < 64) { const int bh = (u & 7) * 2 + (u >> 5), vb = (u >> 3) & 3;
            seq_rw(F, bh >> 2, bh & 3, vb, F.ws + WS_REC_RW + (size_t)(bh * 64) * REC_RW); }
        else { const int v = u - 64, mm = v % 3, bh = v / 3; seq_unit<false>(F, mm == 2 ? 3 : mm, bh >> 2, bh & 3, 0, F.ws + WS_REC_GL + (size_t)((mm * 16 + bh) * 64) * REC_GL); }
    }
}
struct PostRaw { v4u o0, o1; v4u y0, y1; v4u x0, x1, x2, x3, x4, x5, x6, x7; };
__device__ __forceinline__ void post_load(Frame& F, PostRaw& R, int t, int m, int c0) {
    const bf16* P = WSP(const bf16, WS_P);
    const bf16* Ob = WSP(const bf16, WS_O) + (size_t)m * TOK * 256 + (size_t)t * 256 + c0;
    R.o0 = *(const GAS v4u*)(Ob); R.o1 = *(const GAS v4u*)(Ob + 8);
    { const int bb = t >> 12, tb = t & (SEQ - 1), hh = c0 >> 6, qq = (c0 >> 4) & 3; const bf16* oi = WSP(const bf16, WS_OI) + (m == 2 ? ((size_t)((bb * 4 + hh) * 4 + qq) * SEQ + tb) * 16 : OI_GEN + ((size_t)(((m == 3 ? 2 : m) * 16 + bb * 4 + hh)) * SEQ + tb) * 64 + 16 * qq);
      R.y0 = *(const GAS v4u*)oi; R.y1 = *(const GAS v4u*)(oi + 8); }
    const v4u zz = (v4u){0u, 0u, 0u, 0u}; R.x2 = zz; R.x3 = zz; R.x4 = zz; R.x5 = zz; R.x6 = zz; R.x7 = zz;
    if (m != 2) { const int gc = (m == 0 ? HG_G : m == 1 ? GL_R : RT_G) + c0; R.x0 = *(const GAS v4u*)(P + (size_t)t * NP + gc); R.x1 = *(const GAS v4u*)(P + (size_t)t * NP + gc + 8); }
    else { const size_t ob = (size_t)t * 256 + c0;
        R.x0 = *(const GAS v4u*)(WSP(const bf16, WS_RWR) + ob); R.x1 = *(const GAS v4u*)(WSP(const bf16, WS_RWR) + ob + 8); R.x2 = *(const GAS v4u*)(WSP(const bf16, WS_RWK) + ob); R.x3 = *(const GAS v4u*)(WSP(const bf16, WS_RWK) + ob + 8);
        R.x4 = *(const GAS v4u*)(WSP(const bf16, WS_RWV) + ob); R.x5 = *(const GAS v4u*)(WSP(const bf16, WS_RWV) + ob + 8); R.x6 = *(const GAS v4u*)(WSP(const bf16, WS_RWG) + ob); R.x7 = *(const GAS v4u*)(WSP(const bf16, WS_RWG) + ob + 8); }
}
__device__ __forceinline__ void unpack16(const v4u a, const v4u b, float (&f)[16]) { float x[8], y[8]; unpack8(a, x); unpack8(b, y);
#pragma unroll
    for (int j = 0; j < 8; ++j) { f[j] = x[j]; f[8 + j] = y[j]; } }
__device__ __forceinline__ void phase_post(Frame& F, int l) {
    const int gw = F.vcu * NWAVES + F.wave, NGW = F.G * NWAVES;
    const int m = F.lane >> 4, h = (F.lane >> 2) & 3, qd = F.lane & 3; const int c0 = 64 * h + 16 * qd;
    bf16* Y = WSP(bf16, WS_Y);
    PostRaw cur, nxt;
    if (gw < TOK) post_load(F, cur, gw, m, c0);
    for (int t = gw; t < TOK; t += NGW) {
        if (t + NGW < TOK) post_load(F, nxt, t + NGW, m, c0);
        float o[16], oi[16];
        unpack16(cur.o0, cur.o1, o);
        unpack16(cur.y0, cur.y1, oi);
        float s1 = 0.f, s2 = 0.f;
#pragma unroll
        for (int j = 0; j < 16; ++j) { o[j] += oi[j]; s1 += o[j]; s2 += o[j] * o[j]; }
        s1 = sum4(s1); s2 = sum4(s2);
        float y[16];
        if (m < 2) {
            const float rs = rsqrtf(s2 * (1.f / 64.f) + 1e-6f); const float* ng = INF(m == 0 ? 9 : 12) + l * 64 + 16 * qd;
            float g[16]; unpack16(cur.x0, cur.x1, g);
#pragma unroll
            for (int j = 0; j < 16; ++j) y[j] = o[j] * rs * ng[j] * (g[j] * sigm(g[j]));
        } else if (m == 2) {
            const float mean = s1 * (1.f / 64.f); float var = s2 * (1.f / 64.f) - mean * mean; var = fmaxf(var, 0.f); const float rs = rsqrtf(var + 64e-5f);
            float r[16], k[16], v[16], g[16]; unpack16(cur.x0, cur.x1, r); unpack16(cur.x2, cur.x3, k); unpack16(cur.x4, cur.x5, v); unpack16(cur.x6, cur.x7, g);
            const float* rk = INF(21) + l * 256 + c0; const float* lg = INF(22) + l * 256 + c0; const float* lb = INF(23) + l * 256 + c0;
            float bon = 0.f;
#pragma unroll
            for (int j = 0; j < 16; ++j) bon += r[j] * k[j] * rk[j];
            bon = sum4(bon);
#pragma unroll
            for (int j = 0; j < 16; ++j) y[j] = ((o[j] - mean) * rs * lg[j] + lb[j] + bon * v[j]) * g[j];
        } else {
            const float mean = s1 * (1.f / 64.f); float var = s2 * (1.f / 64.f) - mean * mean; var = fmaxf(var, 0.f); const float rs = rsqrtf(var + 1e-5f);
            float g[16]; unpack16(cur.x0, cur.x1, g);
#pragma unroll
            for (int j = 0; j < 16; ++j) y[j] = (g[j] * sigm(g[j])) * ((o[j] - mean) * rs);
        }
        v4u w0, w1; w0.x = pk2(y[0], y[1]); w0.y = pk2(y[2], y[3]); w0.z = pk2(y[4], y[5]); w0.w = pk2(y[6], y[7]); w1.x = pk2(y[8], y[9]); w1.y = pk2(y[10], y[11]); w1.z = pk2(y[12], y[13]); w1.w = pk2(y[14], y[15]);
        GAS v4u* yo = (GAS v4u*)(Y + (size_t)t * D + 256 * m + c0); yo[0] = w0; yo[1] = w1;
        cur = nxt;
    }
}
template <int MODE> struct LnRaw { v2u h[4]; v2u d1[4], d2[4]; float g1, g2; };
template <int MODE> __device__ __forceinline__ void ln_load(Frame& F, LnRaw<MODE>& R, int m) {
    const GAS v2u* hr = (const GAS v2u*)(WSP(const bf16, WS_HB) + (size_t)m * D) + F.lane;
#pragma unroll
    for (int j = 0; j < 4; ++j) R.h[j] = hr[64 * j];
    if (MODE == 0) { const GAS v2u* ar = (const GAS v2u*)(WSP(const bf16, WS_MIX) + (size_t)m * D) + F.lane;
#pragma unroll
        for (int j = 0; j < 4; ++j) R.d1[j] = ar[64 * j]; }
    else { const bf16* DOUT = WSP(const bf16, WS_DOUT); const float* GATE = WSP(const float, WS_GATE); R.g1 = GATE[2 * m]; R.g2 = GATE[2 * m + 1];
#pragma unroll
        for (int j = 0; j < 4; ++j) { R.d1[j] = ((const GAS v2u*)(DOUT + (size_t)(2 * m) * D))[F.lane + 64 * j]; R.d2[j] = ((const GAS v2u*)(DOUT + (size_t)(2 * m + 1) * D))[F.lane + 64 * j]; } }
}
template <int MODE, bool ROUTE, bool Q8 = false, int DRY = 0> __device__ __forceinline__ void phase_ln(Frame& F, const float* gw_, const float* bw_, const float* router, int mi, const bool final_out = false) {
    const int gw = F.vcu * NWAVES + F.wave, NGW = F.G * NWAVES;
    bf16* hb = WSP(bf16, DRY == 1 ? WS_DOUT : DRY == 2 ? WS_Y : WS_HB); float* GATE = WSP(float, WS_GATE);
    LAS float* RT = (LAS float*)F.lds;
    if (ROUTE) { for (int i = F.tid; i < D * NE; i += NWAVES * 64) RT[(i & 7) * D + (i >> 3)] = router[i]; __syncthreads(); }
    f32x4 gv[4], bv[4];
#pragma unroll
    for (int j = 0; j < 4; ++j) { gv[j] = ((const GAS f32x4*)gw_)[F.lane + 64 * j]; bv[j] = ((const GAS f32x4*)bw_)[F.lane + 64 * j]; }
    LnRaw<MODE> cur, nxt;
    if (gw < TOK) ln_load<MODE>(F, cur, gw);
    for (int m = gw; m < TOK; m += NGW) {
        if (m + NGW < TOK) ln_load<MODE>(F, nxt, m + NGW);
        GAS f32x4* hr = (GAS f32x4*)(F.h + (size_t)m * D) + F.lane;
        f32x4 v[4]; float s = 0.f;
#pragma unroll
        for (int j = 0; j < 4; ++j) {
            f32x4 a;
            if (MODE == 0) { const v2u d1 = cur.d1[j]; a = (f32x4){bflo(d1.x), bfhi(d1.x), bflo(d1.y), bfhi(d1.y)}; }
            else { const v2u d1 = cur.d1[j], d2 = cur.d2[j]; const float g1 = cur.g1, g2 = cur.g2;
                a.x = g1 * bflo(d1.x) + g2 * bflo(d2.x); a.y = g1 * bfhi(d1.x) + g2 * bfhi(d2.x); a.z = g1 * bflo(d1.y) + g2 * bflo(d2.y); a.w = g1 * bfhi(d1.y) + g2 * bfhi(d2.y); }
            const v2u hq = cur.h[j]; const f32x4 hv = (f32x4){bflo(hq.x), bfhi(hq.x), bflo(hq.y), bfhi(hq.y)};
            v[j] = hv * DN_ALPHA + a; s += (v[j].x + v[j].y) + (v[j].z + v[j].w); }
        const float mean = wave_sum(s) * (1.f / D); float s2 = 0.f;
#pragma unroll
        for (int j = 0; j < 4; ++j) { v[j] = v[j] - mean; s2 += (v[j].x * v[j].x + v[j].y * v[j].y) + (v[j].z * v[j].z + v[j].w * v[j].w); }
        const float rstd = 1.f / sqrtf(wave_sum(s2) * (1.f / D) + 1e-5f);
        GAS v2u* o8 = (GAS v2u*)(hb + (size_t)m * D) + F.lane;
#pragma unroll
        for (int j = 0; j < 4; ++j) { v[j] = v[j] * rstd * gv[j] + bv[j]; if (final_out) hr[64 * j] = v[j]; v2u w; w.x = pk2(v[j].x, v[j].y); w.y = pk2(v[j].z, v[j].w); o8[64 * j] = w; }
        if (Q8) { float am = 0.f;
#pragma unroll
            for (int j = 0; j < 4; ++j) { const f32x4 a = __builtin_elementwise_abs(v[j]); am = fmaxf(am, fmaxf(fmaxf(a.x, a.y), fmaxf(a.z, a.w))); }
            am = wave_max(am); const float inv = am > 0.f ? 127.f / am : 0.f;
            GAS unsigned* q8 = (GAS unsigned*)(WSP(unsigned char, DRY ? WS_DOUT + 32 * MiB : WS_H8) + (size_t)m * D) + F.lane;
#pragma unroll
            for (int j = 0; j < 4; ++j) q8[64 * j] = pack_i8(v[j].x * inv, v[j].y * inv, v[j].z * inv, v[j].w * inv);
            if (F.lane == 0) WSP(float, DRY ? WS_DOUT + 48 * MiB : WS_RS)[m] = am * (1.f / 127.f); }
        if (ROUTE) {
            float lg[8];
#pragma unroll
            for (int e = 0; e < 8; ++e) { float a = 0.f;
#pragma unroll
                for (int j = 0; j < 4; ++j) { const f32x4 r = *(const LAS f32x4*)(RT + e * D + 4 * (F.lane + 64 * j)); a += (v[j].x * r.x + v[j].y * r.y) + (v[j].z * r.z + v[j].w * r.w); }
                lg[e] = wave_sum(a); }
            int e1 = 0; float l1 = lg[0];
#pragma unroll
            for (int e = 1; e < 8; ++e) if (lg[e] > l1) { l1 = lg[e]; e1 = e; }
            int e2 = -1; float l2 = -3.0e38f;
#pragma unroll
            for (int e = 0; e < 8; ++e) if (e != e1 && lg[e] > l2) { l2 = lg[e]; e2 = e; }
            if (F.lane == 0) {
                const float p2 = __expf(l2 - l1); const float ga = 1.f / (1.f + p2);
                GATE[2 * m] = ga; GATE[2 * m + 1] = p2 * ga;
                int* list = WSP(int, WS_LIST) + (size_t)mi * NE * TOK;
                const unsigned p1 = __hip_atomic_fetch_add((unsigned*)(F.ctl + CW_CNT + (mi * 8 + e1) * 64), 1u, RLX_AGENT); list[e1 * TOK + p1] = 2 * m;
                const unsigned q2 = __hip_atomic_fetch_add((unsigned*)(F.ctl + CW_CNT + (mi * 8 + e2) * 64), 1u, RLX_AGENT); list[e2 * TOK + q2] = 2 * m + 1;
            }
        }
        cur = nxt;
    }
}
__device__ __forceinline__ void phase_gather(Frame& F, int mi) {
    int cnt[8], poff[9]; poff[0] = 0;
    unsigned* cb_ = (unsigned*)(F.ctl + CW_CNT + mi * 8 * 64); asm volatile("" : "+s"(cb_));
#pragma unroll
    for (int e = 0; e < 8; ++e) { cnt[e] = (int)__hip_atomic_load(cb_ + e * 64, RLX_AGENT); poff[e + 1] = poff[e] + ((cnt[e] + 255) >> 8); }
    const int npan = poff[8];
    int* tab = WSP(int, WS_TAB) + mi * TAB_STRIDE;
    if (blockIdx.x == 0) {
        for (int P = F.tid; P < npan; P += NWAVES * 64) { int e = 0, pe = 0, ce = cnt[0];
#pragma unroll
            for (int j = 1; j < 8; ++j) if (P >= poff[j]) { e = j; pe = poff[j]; ce = cnt[j]; }
            tab[4 * P] = e; tab[4 * P + 1] = 256 * (P - pe); tab[4 * P + 2] = ce; tab[4 * P + 3] = 0; }
        if (F.tid == 0) tab[640] = npan;
    }
    const int gw = F.vcu * NWAVES + F.wave, NGW = F.G * NWAVES;
    const int* list = WSP(const int, WS_LIST) + (size_t)mi * NE * TOK; const bf16* hb = WSP(const bf16, WS_HB); bf16* HP = WSP(bf16, WS_HPERM);
    for (int row = gw; row < 256 * npan; row += NGW) { const int P = row >> 8; int e = 0, pe = 0, ce = cnt[0];
#pragma unroll
        for (int j = 1; j < 8; ++j) if (P >= poff[j]) { e = j; pe = poff[j]; ce = cnt[j]; }
        const int r = row - 256 * pe; const int tok = (r < ce) ? (list[e * TOK + r] >> 1) : 0;
        const GAS v4u* s = (const GAS v4u*)(hb + (size_t)tok * D) + F.lane; GAS v4u* d = (GAS v4u*)(HP + (size_t)row * D) + F.lane; d[0] = s[0]; d[64] = s[64]; }
}
struct Args { const void* in[36]; int ph_lo, ph_hi; };
__global__ void __launch_bounds__(NWAVES * 64, 2) mk_fwd(Args args) {
    extern __shared__ __attribute__((aligned(16))) unsigned char lds[];
    Frame F;
    F.lds = (LAS unsigned char*)lds;
    F.MISC = (volatile LAS unsigned*)(F.lds + MISC_OFF);
    F.tid = threadIdx.x; F.lane = F.tid & 63; F.wave = __builtin_amdgcn_readfirstlane(F.tid >> 6);
    const int wave_k = F.wave;
    F.G = gridDim.x; { const int bx = blockIdx.x; F.vcu = (F.G % 8 == 0) ? (bx % 8) * (F.G / 8) + bx / 8 : bx; }
    F.in = args.in; F.ws = (unsigned char*)ldptr(F.in, 35); F.h = (float*)ldptr(F.in, 34);
    F.ctl = (gu32*)(F.ws + WS_CTL);
    for (int u = F.tid; u < (LDS_BYTES - LDSCTL_OFF) / 4; u += NWAVES * 64) ((LAS unsigned*)(F.lds + LDSCTL_OFF))[u] = 0u;
    __syncthreads();
    XcdBarrier bar; bar.bar = (unsigned*)(F.ctl + CW_BAR); bar.x = 0; bar.st = nullptr; bar.wv = 0;
    if (!MK_PER_PHASE) bar = xcd_barrier_post((unsigned*)(F.ctl + CW_BAR), F.MISC + 8);
    const int lo = args.ph_lo, hi = args.ph_hi;
#define IN(k) (lo <= (k) && (k) < hi)
#define PHASE_BEGIN() do { int t_ = wave_k * 64 + lane_id_now(); asm volatile("" : "+v"(t_)); F.tid = t_; F.lane = t_ & 63; F.wave = wave_k; \
        F.ws = (unsigned char*)ldptr(F.in, 35); F.ctl = (gu32*)(F.ws + WS_CTL); F.h = (float*)ldptr(F.in, 34); } while (0)
#define SEAM(k) do { if (IN(k) && IN((k) + 1)) { xcd_barrier(bar); if (DUPMASK & 4096) xcd_barrier(bar); } } while (0)
    for (int l = 0; l < DEPTH; ++l) {
        const int pb = l * NPH; const bool moe = (l & 1); const int mi = l >> 1;
#define PH(k) (((PHMASK >> (k)) & 1) && IN(pb + (k)))
        if (l == 0) { if (PH(0)) { PHASE_BEGIN(); phase_weights<0>(F, 0); } SEAM(pb + 0); }
        if (PH(1)) for (int rep_ = 0; rep_ < ((((DUPMASK >> 1) & 1) && ((DUPL >> l) & 1)) ? 2 : 1); ++rep_) { PHASE_BEGIN(); if (rep_) __syncthreads();
            pg8::Gemm g{WSP(const bf16, WS_HB), WSP(const bf16, WS_WIN), TOK, NP, D}; pg8::StaticOrder S; S.init(TOK, NP, F.G, (int)blockIdx.x);
            pg8::EpiBf16 E{WSP(bf16, WS_P), NP};
            pg8::gemm_phase<pg8::EpiBf16, pg8::StaticOrder, true, true>(F.lds, g, S, E, F.wave);
        } SEAM(pb + 1);
        if (PH(3)) { PHASE_BEGIN(); phase_chunkpre(F, l); if (DUPMASK & 8) { __syncthreads(); phase_chunkpre(F, l); } } SEAM(pb + 3);
        if (PH(4)) { PHASE_BEGIN(); phase_seq(F, l); if (DUPMASK & 16) { __syncthreads(); phase_seq(F, l); }
            if (((int)blockIdx.x >= 112 || F.G <= 112)) { const int sv = F.vcu, sg = F.G; if (sg > 112) { F.vcu = (int)blockIdx.x - 112; F.G = sg - 112; } phase_absmax(F, l); if ((DUPMASK & 8192) && ((DUPL >> l) & 1)) phase_absmax(F, l); F.vcu = sv; F.G = sg; }
            if (l + 1 < DEPTH && (int)blockIdx.x >= 112 && F.G > 112) { const int sv = F.vcu, sg = F.G; F.vcu = (int)blockIdx.x - 112; F.G = sg - 112; phase_weights<0>(F, l + 1); F.vcu = sv; F.G = sg; }
        } SEAM(pb + 4);
        if (PH(5)) { PHASE_BEGIN(); phase_post(F, l); __syncthreads(); if ((DUPMASK & 16384) && ((DUPL >> l) & 1)) { phase_post(F, l); __syncthreads(); } phase_weights<1>(F, l); if (DUPMASK & 32) { __syncthreads(); phase_weights<1>(F, l); } } SEAM(pb + 5);
        if (PH(6)) for (int rep_ = 0; rep_ < ((((DUPMASK >> 6) & 1) && ((DUPL >> l) & 1)) ? 2 : 1); ++rep_) { PHASE_BEGIN(); if (rep_) __syncthreads();
            pg8::Gemm g{WSP(const bf16, WS_Y), WSP(const bf16, (l & 1) ? WS_WOUT2 : WS_WOUT), TOK, D, D}; pg8::StaticOrder S; S.init(TOK, D, F.G, (int)blockIdx.x);
            pg8::EpiBf16 E{WSP(bf16, WS_MIX), D};
            pg8::gemm_phase<pg8::EpiBf16, pg8::StaticOrder, false, true>(F.lds, g, S, E, F.wave);
        } SEAM(pb + 6);
        if (PH(7)) { PHASE_BEGIN();
            if ((DUPMASK & 128) && ((DUPL >> l) & 1)) { phase_ln<0, false, true, 1>(F, INF(4) + l * D, INF(5) + l * D, nullptr, 0); __syncthreads(); }
            if (moe) phase_ln<0, true, true>(F, INF(4) + l * D, INF(5) + l * D, INF(30) + (size_t)mi * D * NE, mi);
            else phase_ln<0, false, true>(F, INF(4) + l * D, INF(5) + l * D, nullptr, 0);
        } SEAM(pb + 7);
        if (PH(9)) for (int rep_ = 0; rep_ < ((((DUPMASK >> 9) & 1) && ((DUPL >> l) & 1)) ? 2 : 1); ++rep_) { PHASE_BEGIN(); if (rep_) __syncthreads();
            if (STAG9 > 0 && (((int)blockIdx.x >> 3) & 1)) { const unsigned long long t0_ = __builtin_amdgcn_s_memrealtime(); while (__builtin_amdgcn_s_memrealtime() - t0_ < (unsigned long long)STAG9) __builtin_amdgcn_s_sleep(8); }
            if (!moe) { pg8::Gemm g{WSP(const bf16, WS_H8), WSP(const bf16, WS_WUP), TOK, 2 * FFD, D / 2}; pg8::StaticOrder S; S.init(TOK, 2 * FFD, F.G, (int)blockIdx.x);
                pg8::EpiSwiGLU8<false> E{WSP(unsigned char, WS_HID), FFD, 22, WSP(const float, WS_RS), __uint_as_float(__hip_atomic_load((unsigned*)(F.ctl + CW_AMAX + l * 64), RLX_AGENT)) * (1.f / 127.f), pg8::MoeMap{}};
                pg8::gemm_phase<pg8::EpiSwiGLU8<false>, pg8::StaticOrder, true, true, 1>(F.lds, g, S, E, F.wave);
            } else { pg8::MoeOrder<true> S; S.M.init((const unsigned*)(F.ctl + CW_CNT + mi * 8 * 64), WSP(const int, WS_LIST) + (size_t)mi * NE * TOK); const int npan = S.M.poff[8];
                S.tpg = 11; S.G = F.G; S.c = (int)blockIdx.x; S.nunits = npan * 11; S.rowbytes = D;
                pg8::Gemm g{WSP(const bf16, WS_H8), WSP(const bf16, WS_WUP), 256 * npan, 2 * FFE, D / 2};
                pg8::EpiSwiGLU8<true> E{WSP(unsigned char, WS_HID), FFEP, 11, WSP(const float, WS_RS), __uint_as_float(__hip_atomic_load((unsigned*)(F.ctl + CW_AMAX + l * 64), RLX_AGENT)) * (1.f / 127.f), S.M};
                pg8::gemm_phase<pg8::EpiSwiGLU8<true>, pg8::MoeOrder<true>, true, true, 1>(F.lds, g, S, E, F.wave);
            }
        } SEAM(pb + 9);
        if (PH(10)) for (int rep_ = 0; rep_ < ((((DUPMASK >> 10) & 1) && ((DUPL >> l) & 1)) ? 2 : 1); ++rep_) { PHASE_BEGIN(); if (rep_) __syncthreads();
            float qsd_, invd; f8_scale(__uint_as_float(__hip_atomic_load((unsigned*)(F.ctl + CW_AMAXD + l * 64), RLX_AGENT)), qsd_, invd);
            if (!moe) { pg8::Gemm g{WSP(const bf16, WS_HID), WSP(const bf16, WS_WDN), TOK, D, FFD / 2}; pg8::StaticOrder S; S.init(TOK, D, F.G, (int)blockIdx.x);
                pg8::EpiBf16S E{WSP(bf16, WS_MIX), D, invd};
                pg8::gemm_phase<pg8::EpiBf16S, pg8::StaticOrder, false, true, 2>(F.lds, g, S, E, F.wave);
            } else { pg8::MoeOrder<false> S; S.M.init((const unsigned*)(F.ctl + CW_CNT + mi * 8 * 64), WSP(const int, WS_LIST) + (size_t)mi * NE * TOK); const int npan = S.M.poff[8];
                S.tpg = 4; S.G = F.G; S.c = (int)blockIdx.x; S.nunits = npan * 4; S.rowbytes = 0;
                pg8::Gemm g{WSP(const bf16, WS_HID), WSP(const bf16, WS_WDN), 256 * npan, D, FFEP / 2};
                pg8::EpiScatter E{WSP(bf16, WS_DOUT), S.M, invd};
                pg8::gemm_phase<pg8::EpiScatter, pg8::MoeOrder<false>, true, true, 2>(F.lds, g, S, E, F.wave);
            }
        } SEAM(pb + 10);
        if (PH(11)) { PHASE_BEGIN();
            if ((DUPMASK & 2048) && ((DUPL >> l) & 1)) { if (moe) phase_ln<1, false, false, 2>(F, INF(6) + l * D, INF(7) + l * D, nullptr, 0); else phase_ln<0, false, false, 2>(F, INF(6) + l * D, INF(7) + l * D, nullptr, 0); __syncthreads(); }
            if (moe) phase_ln<1, false>(F, INF(6) + l * D, INF(7) + l * D, nullptr, 0, l == DEPTH - 1);
            else phase_ln<0, false>(F, INF(6) + l * D, INF(7) + l * D, nullptr, 0, l == DEPTH - 1);
            if (l + 1 < DEPTH && F.G <= 112) { __syncthreads(); phase_weights<0>(F, l + 1); }
        } SEAM(pb + 11);
#undef PH
    }
#undef IN
#undef SEAM
}

extern "C" void kernel_launch(void* const* d_in, const int* in_sizes, int n_in, void* d_out, int out_size, void* d_ws, size_t ws_size, hipStream_t stream) {
    static int grid = 0;
    if (grid == 0) {
        if (n_in != 34 || out_size != TOK * D || ws_size < WS_END) { fprintf(stderr, "kernel_launch: unexpected shapes (n_in %d, out %d, ws %zu)\n", n_in, out_size, ws_size); grid = -1; return; }
        int dev = 0, cus = 0, per_cu = 0;
        if (hipGetDevice(&dev) != hipSuccess || hipDeviceGetAttribute(&cus, hipDeviceAttributeMultiprocessorCount, dev) != hipSuccess) { grid = -1; return; }
        if (hipFuncSetAttribute((const void*)mk_fwd, hipFuncAttributeMaxDynamicSharedMemorySize, LDS_BYTES) != hipSuccess) { fprintf(stderr, "kernel_launch: hipFuncSetAttribute failed\n"); grid = -1; return; }
        if (hipOccupancyMaxActiveBlocksPerMultiprocessor(&per_cu, (const void*)mk_fwd, NWAVES * 64, LDS_BYTES) != hipSuccess || per_cu < 1) fprintf(stderr, "kernel_launch: occupancy query reports %d\n", per_cu);
        (void)hipGetLastError();
        grid = cus;
    }
    if (grid < 0) return;
    if (hipMemsetAsync((char*)d_ws + WS_CTL, 0, CTL_ZERO_BYTES, stream) != hipSuccess) return;
    Args a{};
    for (int i = 0; i < 34; ++i) a.in[i] = d_in[i];
    a.in[34] = d_out; a.in[35] = d_ws;
#if MK_PER_PHASE
    for (int p = 0; p < NPHASES; ++p) { a.ph_lo = p; a.ph_hi = p + 1; hipLaunchKernelGGL(mk_fwd, dim3(grid), dim3(NWAVES * 64), LDS_BYTES, stream, a); }
#else
    a.ph_lo = 0; a.ph_hi = NPHASES; hipLaunchKernelGGL(mk_fwd, dim3(grid), dim3(NWAVES * 64), LDS_BYTES, stream, a);
#endif
}
```
